# Optimizing an MI355X kernel written in HIP

```python
import math
import jax, jax.numpy as jnp
from jax import lax
import numpy as np

D_MODEL = 1024
BATCH = 8
SEQ = 2048
DEPTH = 4
DEC_BATCH = 128
DEC_SEQ = 8
PAST_LEN = 16384
PAGE_SIZE = 128

N_MIXERS = 4
ALPHA = (2 * DEPTH) ** 0.25
BETA = (8 * DEPTH) ** -0.25
LN_EPS = 1e-5
RMS_EPS = 1e-5

S5_WIDTH = D_MODEL
S5_GROUP = 16
S5_GROUPS = S5_WIDTH // S5_GROUP
S5_STATE = 64

POOL_WIDTH = D_MODEL
POOL_WINDOWS = (2, 4, 8, 16)
POOL_GROUP = POOL_WIDTH // len(POOL_WINDOWS)
POOL_BUF = max(POOL_WINDOWS) - 1

CMLP_WIDTH = D_MODEL
CMLP_CHUNK = 128
CMLP_HEADS = 4
CMLP_HEAD_DIM = CMLP_WIDTH // CMLP_HEADS

SSD_INNER = 2 * D_MODEL
SSD_HEAD_DIM = 64
SSD_HEADS = SSD_INNER // SSD_HEAD_DIM
SSD_STATE = 128
SSD_GROUPS = 4
SSD_CONV = 4
SSD_CHUNK = 128
SSD_CONV_DIM = SSD_INNER + 2 * SSD_GROUPS * SSD_STATE
SSD_PROJ = SSD_INNER + SSD_CONV_DIM + SSD_HEADS

PEER_HEADS = 8
PEER_NKEYS = 128
PEER_EXPERTS = PEER_NKEYS * PEER_NKEYS
PEER_TOPK = 16
PEER_QDIM = 256
PEER_HALF = PEER_QDIM // 2
PEER_BLOCK = 128

kernel_name = 'hybrid_s5_pool_gmlp_ssd_peer_step'


def layer_norm(x, g, b):
    xf = x.astype(jnp.float32)
    mu = jnp.mean(xf, axis=-1, keepdims=True)
    var = jnp.mean(jnp.square(xf - mu), axis=-1, keepdims=True)
    y = (xf - mu) * lax.rsqrt(var + LN_EPS) * g.astype(jnp.float32) + b.astype(jnp.float32)
    return y.astype(x.dtype)


def _cmul(ar, ai, br, bi):
    return ar * br - ai * bi, ar * bi + ai * br


def _s5_combine(e1, e2):
    a1r, a1i, b1r, b1i = e1
    a2r, a2i, b2r, b2i = e2
    ar, ai = _cmul(a2r, a2i, a1r, a1i)
    br, bi = _cmul(a2r, a2i, b1r, b1i)
    return ar, ai, br + b2r, bi + b2i


def s5_mixer(x, h0_re, h0_im, w_in, a_re, a_im, log_dt, b_re, b_im, c_re, c_im, d_skip,
             w_glu, b_glu, w_out):
    f32 = jnp.float32
    bsz, L, _ = x.shape
    u = (x @ w_in).astype(f32)
    ug = u.reshape(bsz, L, S5_GROUPS, S5_GROUP)
    dt = jnp.exp(log_dt.astype(f32))[:, None]
    lam_r, lam_i = a_re.astype(f32), a_im.astype(f32)
    mag = jnp.exp(lam_r * dt)
    lb_r, lb_i = mag * jnp.cos(lam_i * dt), mag * jnp.sin(lam_i * dt)
    den = lam_r * lam_r + lam_i * lam_i
    f_r = ((lb_r - 1.0) * lam_r + lb_i * lam_i) / den
    f_i = (lb_i * lam_r - (lb_r - 1.0) * lam_i) / den
    bb_r, bb_i = _cmul(f_r[..., None], f_i[..., None], b_re.astype(f32), b_im.astype(f32))
    bu_r = jnp.einsum('blgi,gpi->blgp', ug, bb_r)
    bu_i = jnp.einsum('blgi,gpi->blgp', ug, bb_i)
    h0r, h0i = h0_re.astype(f32), h0_im.astype(f32)
    bu_r = bu_r.at[:, 0].add(lb_r * h0r - lb_i * h0i)
    bu_i = bu_i.at[:, 0].add(lb_r * h0i + lb_i * h0r)
    a_r = jnp.broadcast_to(lb_r, bu_r.shape)
    a_i = jnp.broadcast_to(lb_i, bu_i.shape)
    _, _, h_r, h_i = lax.associative_scan(_s5_combine, (a_r, a_i, bu_r, bu_i), axis=1)
    y = (jnp.einsum('blgp,gip->blgi', h_r, c_re.astype(f32))
         - jnp.einsum('blgp,gip->blgi', h_i, c_im.astype(f32)))
    y = y.reshape(bsz, L, S5_WIDTH) + d_skip.astype(f32) * u
    g = jax.nn.gelu(y).astype(x.dtype)
    out = g * jax.nn.sigmoid(g @ w_glu + b_glu)
    return out @ w_out, h_r[:, -1], h_i[:, -1]


def pool_mixer(x, buf, pos0, w_in, w_grp, scale, w_out):
    f32 = jnp.float32
    bsz, L, _ = x.shape
    u = x @ w_in
    ctx = jnp.concatenate([buf.astype(u.dtype), u], axis=1)
    cs = jnp.pad(jnp.cumsum(ctx.astype(f32), axis=1), ((0, 0), (1, 0), (0, 0)))
    pos = pos0 + jnp.arange(L)
    means = []
    for gi, w in enumerate(POOL_WINDOWS):
        c0, c1 = gi * POOL_GROUP, (gi + 1) * POOL_GROUP
        win_sum = (cs[:, POOL_BUF + 1:POOL_BUF + 1 + L, c0:c1]
                   - cs[:, POOL_BUF + 1 - w:POOL_BUF + 1 - w + L, c0:c1])
        cnt = jnp.minimum(pos + 1, w).astype(f32)[None, :, None]
        means.append(win_sum / cnt)
    pooled = (jnp.concatenate(means, axis=-1) - u.astype(f32)).reshape(
        bsz, L, len(POOL_WINDOWS), POOL_GROUP)
    mixed = jnp.einsum('blgc,gcd->blgd', pooled, w_grp.astype(f32)).reshape(bsz, L, POOL_WIDTH)
    out = (mixed * scale.astype(f32)).astype(x.dtype)
    return out @ w_out, ctx[:, -POOL_BUF:]


def chunk_mlp_mixer(x, w_in, b_in, ln_g, ln_b, w_s, b_s, w_out):
    bsz, L, _ = x.shape
    z = jax.nn.gelu(x @ w_in + b_in)
    u, v = z[..., :CMLP_WIDTH], z[..., CMLP_WIDTH:]
    v = layer_norm(v, ln_g, ln_b)
    q = min(L, CMLP_CHUNK)
    n_chunks = L // q
    causal = jnp.tril(jnp.ones((q, q), dtype=bool))
    ws = jnp.where(causal[None], w_s[:, :q, :q], 0.0).astype(v.dtype)
    vc = v.reshape(bsz, n_chunks, q, CMLP_HEADS, CMLP_HEAD_DIM)
    mixed = (jnp.einsum('hts,bcshd->bcthd', ws, vc)
             + jnp.transpose(b_s[:, :q])[None, None, :, :, None])
    out = u * mixed.reshape(bsz, L, CMLP_WIDTH)
    return out @ w_out, v


def ssd_scan(xs, dt, a, bm, cm, h0, q):
    f32 = jnp.float32
    bsz, L, _, _ = xs.shape
    nc = L // q
    hpg = SSD_HEADS // SSD_GROUPS
    x = xs.astype(f32).reshape(bsz, nc, q, SSD_GROUPS, hpg, SSD_HEAD_DIM)
    dtc = dt.reshape(bsz, nc, q, SSD_GROUPS, hpg)
    bc = bm.astype(f32).reshape(bsz, nc, q, SSD_GROUPS, SSD_STATE)
    cc = cm.astype(f32).reshape(bsz, nc, q, SSD_GROUPS, SSD_STATE)
    a_cs = jnp.cumsum(dtc * a.reshape(SSD_GROUPS, hpg), axis=2)
    causal = jnp.tril(jnp.ones((q, q), dtype=bool))[:, :, None, None]
    seg = a_cs[:, :, :, None] - a_cs[:, :, None, :]
    decay = jnp.exp(jnp.where(causal, seg, -jnp.inf))
    xdt = x * dtc[..., None]
    cb = jnp.einsum('bctgn,bcsgn->bctsg', cc, bc)
    y_diag = jnp.einsum('bctsg,bctsgj,bcsgjp->bctgjp', cb, decay, xdt)
    decay_end = jnp.exp(a_cs[:, :, -1:] - a_cs)
    states = jnp.einsum('bcsgn,bcsgj,bcsgjp->bcgjpn', bc, decay_end, xdt)
    chunk_decay = jnp.exp(a_cs[:, :, -1])

    def step(h, inp):
        st, dec = inp
        return h * dec[..., None, None] + st, h

    h_init = h0.astype(f32).reshape(bsz, SSD_GROUPS, hpg, SSD_HEAD_DIM, SSD_STATE)
    h_last, h_prev = lax.scan(step, h_init,
                              (jnp.moveaxis(states, 1, 0), jnp.moveaxis(chunk_decay, 1, 0)))
    h_prev = jnp.moveaxis(h_prev, 0, 1)
    y_off = jnp.einsum('bctgn,bcgjpn,bctgj->bctgjp', cc, h_prev, jnp.exp(a_cs))
    y = (y_diag + y_off).reshape(bsz, L, SSD_HEADS, SSD_HEAD_DIM)
    return y, h_last.reshape(bsz, SSD_HEADS, SSD_HEAD_DIM, SSD_STATE)


def ssd_mixer(x, conv_buf, h0, w_in, conv_w, conv_b, dt_bias, a_log, d_skip, norm_g, w_out):
    f32 = jnp.float32
    bsz, L, _ = x.shape
    proj = x @ w_in
    z = proj[..., :SSD_INNER]
    xbc = proj[..., SSD_INNER:SSD_INNER + SSD_CONV_DIM]
    dt_raw = proj[..., SSD_INNER + SSD_CONV_DIM:]
    ctx = jnp.concatenate([conv_buf.astype(xbc.dtype), xbc], axis=1)
    conv = conv_b
    for k in range(SSD_CONV):
        conv = conv + ctx[:, k:k + L] * conv_w[k]
    xbc = jax.nn.silu(conv)
    gn = SSD_GROUPS * SSD_STATE
    xs = xbc[..., :SSD_INNER].reshape(bsz, L, SSD_HEADS, SSD_HEAD_DIM)
    bm = xbc[..., SSD_INNER:SSD_INNER + gn].reshape(bsz, L, SSD_GROUPS, SSD_STATE)
    cm = xbc[..., SSD_INNER + gn:].reshape(bsz, L, SSD_GROUPS, SSD_STATE)
    dt = jax.nn.softplus(dt_raw.astype(f32) + dt_bias.astype(f32))
    a = -jnp.exp(a_log.astype(f32))
    q = SSD_CHUNK if L % SSD_CHUNK == 0 else L
    y, h_last = ssd_scan(xs, dt, a, bm, cm, h0, q)
    y = y + d_skip.astype(f32)[:, None] * xs.astype(f32)
    yg = (y.reshape(bsz, L, SSD_INNER) * jax.nn.silu(z.astype(f32))).reshape(
        bsz, L, SSD_GROUPS, SSD_INNER // SSD_GROUPS)
    yg = yg * lax.rsqrt(jnp.mean(jnp.square(yg), axis=-1, keepdims=True) + RMS_EPS)
    y = (yg.reshape(bsz, L, SSD_INNER) * norm_g.astype(f32)).astype(x.dtype)
    return y @ w_out, ctx[:, -(SSD_CONV - 1):], h_last


def peer_ffn(x, w_q, sub_keys, expert_u, expert_v):
    f32 = jnp.float32
    shp = x.shape
    xt = x.reshape(-1, D_MODEL)
    T = xt.shape[0]
    nb = -(-T // PEER_BLOCK)
    xt = jnp.pad(xt, ((0, nb * PEER_BLOCK - T), (0, 0))).reshape(nb, PEER_BLOCK, D_MODEL)
    keys = sub_keys.astype(f32)

    def block(xb):
        q = (xb @ w_q).astype(f32).reshape(PEER_BLOCK, PEER_HEADS, 2, PEER_HALF)
        s = jnp.einsum('thid,hind->thin', q, keys)
        top_s, top_i = lax.top_k(s, PEER_TOPK)
        cand_s = top_s[:, :, 0, :, None] + top_s[:, :, 1, None, :]
        cand_i = top_i[:, :, 0, :, None] * PEER_NKEYS + top_i[:, :, 1, None, :]
        best_s, best_j = lax.top_k(cand_s.reshape(PEER_BLOCK, PEER_HEADS, -1), PEER_TOPK)
        idx = jnp.take_along_axis(cand_i.reshape(PEER_BLOCK, PEER_HEADS, -1), best_j, axis=-1)
        gate = jax.nn.softmax(best_s, axis=-1)
        u = expert_u[idx]
        v = expert_v[idx]
        act = jax.nn.gelu(jnp.einsum('td,thkd->thk', xb, u).astype(f32))
        return jnp.einsum('thk,thkd->td', (gate * act).astype(xb.dtype), v)

    out = lax.map(block, xt)
    return out.reshape(-1, D_MODEL)[:T].reshape(shp)


def trunk(h, pos0, s5_h_re, s5_h_im, pool_buf, ssd_conv_buf, ssd_h,
          s5_w_in, s5_a_re, s5_a_im, s5_log_dt, s5_b_re, s5_b_im, s5_c_re, s5_c_im, s5_d,
          s5_w_glu, s5_b_glu, s5_w_out,
          pool_w_in, pool_w_grp, pool_scale, pool_w_out,
          cmlp_w_in, cmlp_b_in, cmlp_ln_g, cmlp_ln_b, cmlp_w_s, cmlp_b_s, cmlp_w_out,
          ssd_w_in, ssd_conv_w, ssd_conv_b, ssd_dt_bias, ssd_a_log, ssd_d, ssd_norm_g, ssd_w_out,
          ln1_g, ln1_b, ln2_g, ln2_b, peer_w_q, peer_keys, peer_u, peer_v):
    cmlp_v = None
    for i in range(DEPTH):
        kind = i % N_MIXERS
        if kind == 0:
            mix, s5_h_re, s5_h_im = s5_mixer(h, s5_h_re, s5_h_im, s5_w_in, s5_a_re, s5_a_im,
                                             s5_log_dt, s5_b_re, s5_b_im, s5_c_re, s5_c_im,
                                             s5_d, s5_w_glu, s5_b_glu, s5_w_out)
        elif kind == 1:
            mix, pool_buf = pool_mixer(h, pool_buf, pos0, pool_w_in, pool_w_grp, pool_scale,
                                       pool_w_out)
        elif kind == 2:
            mix, cmlp_v = chunk_mlp_mixer(h, cmlp_w_in, cmlp_b_in, cmlp_ln_g, cmlp_ln_b,
                                          cmlp_w_s, cmlp_b_s, cmlp_w_out)
        else:
            mix, ssd_conv_buf, ssd_h = ssd_mixer(h, ssd_conv_buf, ssd_h, ssd_w_in, ssd_conv_w,
                                                 ssd_conv_b, ssd_dt_bias, ssd_a_log, ssd_d,
                                                 ssd_norm_g, ssd_w_out)
        h = layer_norm(ALPHA * h + mix, ln1_g[i], ln1_b[i])
        ffn = peer_ffn(h, peer_w_q[i], peer_keys[i], peer_u[i], peer_v[i])
        h = layer_norm(ALPHA * h + ffn, ln2_g[i], ln2_b[i])
    return h, s5_h_re, s5_h_im, pool_buf, cmlp_v, ssd_conv_buf, ssd_h


def setup_inputs(seed: int = 0) -> dict:
    key = jax.random.key(seed)
    ks = iter(jax.random.split(key, 64))

    def nrm(shape, scale=1.0):
        return jax.random.normal(next(ks), shape, jnp.float32) * scale

    def unif(shape, lo, hi):
        return jax.random.uniform(next(ks), shape, jnp.float32, lo, hi)

    p = {}
    p['x_prompt'] = nrm((BATCH, SEQ, D_MODEL))
    p['x_sample'] = nrm((DEC_BATCH, DEC_SEQ, D_MODEL))
    p['state_s5_re'] = nrm((DEC_BATCH, S5_GROUPS, S5_STATE), 0.2)
    p['state_s5_im'] = nrm((DEC_BATCH, S5_GROUPS, S5_STATE), 0.2)
    p['state_pool'] = nrm((DEC_BATCH, POOL_BUF, POOL_WIDTH))
    p['state_ssd_conv'] = nrm((DEC_BATCH, SSD_CONV - 1, SSD_CONV_DIM))
    p['state_ssd'] = nrm((DEC_BATCH, SSD_HEADS, SSD_HEAD_DIM, SSD_STATE), 0.5)
    n_idx = jnp.arange(S5_STATE, dtype=jnp.float32)[None, :]
    p['s5_w_in'] = nrm((D_MODEL, S5_WIDTH), D_MODEL ** -0.5)
    p['s5_a_re'] = -0.5 + nrm((S5_GROUPS, S5_STATE), 0.01)
    p['s5_a_im'] = math.pi * n_idx + nrm((S5_GROUPS, S5_STATE), 0.01)
    p['s5_log_dt'] = unif((S5_GROUPS,), math.log(1e-3), math.log(1e-1))
    p['s5_b_re'] = nrm((S5_GROUPS, S5_STATE, S5_GROUP), (2 * S5_GROUP) ** -0.5)
    p['s5_b_im'] = nrm((S5_GROUPS, S5_STATE, S5_GROUP), (2 * S5_GROUP) ** -0.5)
    p['s5_c_re'] = nrm((S5_GROUPS, S5_GROUP, S5_STATE), S5_STATE ** -0.5)
    p['s5_c_im'] = nrm((S5_GROUPS, S5_GROUP, S5_STATE), S5_STATE ** -0.5)
    p['s5_d'] = nrm((S5_WIDTH,))
    p['s5_w_glu'] = nrm((S5_WIDTH, S5_WIDTH), S5_WIDTH ** -0.5)
    p['s5_b_glu'] = nrm((S5_WIDTH,), 0.01)
    p['s5_w_out'] = nrm((S5_WIDTH, D_MODEL), BETA * S5_WIDTH ** -0.5)
    p['pool_w_in'] = nrm((D_MODEL, POOL_WIDTH), D_MODEL ** -0.5)
    p['pool_w_grp'] = nrm((len(POOL_WINDOWS), POOL_GROUP, POOL_GROUP), POOL_GROUP ** -0.5)
    p['pool_scale'] = 1.0 + nrm((POOL_WIDTH,), 0.01)
    p['pool_w_out'] = nrm((POOL_WIDTH, D_MODEL), BETA * POOL_WIDTH ** -0.5)
    p['cmlp_w_in'] = nrm((D_MODEL, 2 * CMLP_WIDTH), D_MODEL ** -0.5)
    p['cmlp_b_in'] = nrm((2 * CMLP_WIDTH,), 0.01)
    p['cmlp_ln_g'] = 1.0 + nrm((CMLP_WIDTH,), 0.01)
    p['cmlp_ln_b'] = nrm((CMLP_WIDTH,), 0.01)
    p['cmlp_w_s'] = nrm((CMLP_HEADS, CMLP_CHUNK, CMLP_CHUNK), 0.5 * CMLP_CHUNK ** -0.5)
    p['cmlp_b_s'] = 1.0 + nrm((CMLP_HEADS, CMLP_CHUNK), 0.1)
    p['cmlp_w_out'] = nrm((CMLP_WIDTH, D_MODEL), BETA * CMLP_WIDTH ** -0.5)
    dt0 = jnp.exp(unif((SSD_HEADS,), math.log(1e-3), math.log(1e-1)))
    p['ssd_w_in'] = nrm((D_MODEL, SSD_PROJ), D_MODEL ** -0.5)
    p['ssd_conv_w'] = nrm((SSD_CONV, SSD_CONV_DIM), SSD_CONV ** -0.5)
    p['ssd_conv_b'] = nrm((SSD_CONV_DIM,), 0.01)
    p['ssd_dt_bias'] = dt0 + jnp.log(-jnp.expm1(-dt0))
    p['ssd_a_log'] = jnp.log(unif((SSD_HEADS,), 1.0, 16.0))
    p['ssd_d'] = 1.0 + nrm((SSD_HEADS,), 0.01)
    p['ssd_norm_g'] = 1.0 + nrm((SSD_INNER,), 0.01)
    p['ssd_w_out'] = nrm((SSD_INNER, D_MODEL), BETA * SSD_INNER ** -0.5)
    p['ln1_g'] = 1.0 + nrm((DEPTH, D_MODEL), 0.01)
    p['ln1_b'] = nrm((DEPTH, D_MODEL), 0.01)
    p['ln2_g'] = 1.0 + nrm((DEPTH, D_MODEL), 0.01)
    p['ln2_b'] = nrm((DEPTH, D_MODEL), 0.01)
    p['peer_w_q'] = nrm((DEPTH, D_MODEL, PEER_HEADS * PEER_QDIM), D_MODEL ** -0.5)
    p['peer_keys'] = nrm((DEPTH, PEER_HEADS, 2, PEER_NKEYS, PEER_HALF), PEER_HALF ** -0.5)
    p['peer_u'] = nrm((DEPTH, PEER_EXPERTS, D_MODEL), D_MODEL ** -0.5)
    p['peer_v'] = nrm((DEPTH, PEER_EXPERTS, D_MODEL), BETA * PEER_HEADS ** -0.5)
    return p


def reference(x_prompt, x_sample, state_s5_re, state_s5_im, state_pool, state_ssd_conv, state_ssd,
              s5_w_in, s5_a_re, s5_a_im, s5_log_dt, s5_b_re, s5_b_im, s5_c_re, s5_c_im, s5_d,
              s5_w_glu, s5_b_glu, s5_w_out,
              pool_w_in, pool_w_grp, pool_scale, pool_w_out,
              cmlp_w_in, cmlp_b_in, cmlp_ln_g, cmlp_ln_b, cmlp_w_s, cmlp_b_s, cmlp_w_out,
              ssd_w_in, ssd_conv_w, ssd_conv_b, ssd_dt_bias, ssd_a_log, ssd_d, ssd_norm_g, ssd_w_out,
              ln1_g, ln1_b, ln2_g, ln2_b, peer_w_q, peer_keys, peer_u, peer_v):
    weights = (s5_w_in, s5_a_re, s5_a_im, s5_log_dt, s5_b_re, s5_b_im, s5_c_re, s5_c_im, s5_d,
               s5_w_glu, s5_b_glu, s5_w_out,
               pool_w_in, pool_w_grp, pool_scale, pool_w_out,
               cmlp_w_in, cmlp_b_in, cmlp_ln_g, cmlp_ln_b, cmlp_w_s, cmlp_b_s, cmlp_w_out,
               ssd_w_in, ssd_conv_w, ssd_conv_b, ssd_dt_bias, ssd_a_log, ssd_d, ssd_norm_g, ssd_w_out,
               ln1_g, ln1_b, ln2_g, ln2_b, peer_w_q, peer_keys, peer_u, peer_v)
    f32 = jnp.float32
    bp = x_prompt.shape[0]
    (y_prompt, s5_re_p, s5_im_p, pool_p, _, conv_p, ssd_p) = trunk(
        x_prompt, 0,
        jnp.zeros((bp, S5_GROUPS, S5_STATE), f32),
        jnp.zeros((bp, S5_GROUPS, S5_STATE), f32),
        jnp.zeros((bp, POOL_BUF, POOL_WIDTH), x_prompt.dtype),
        jnp.zeros((bp, SSD_CONV - 1, SSD_CONV_DIM), x_prompt.dtype),
        jnp.zeros((bp, SSD_HEADS, SSD_HEAD_DIM, SSD_STATE), f32),
        *weights)
    (y_sample, s5_re_s, s5_im_s, pool_s, cmlp_v_s, conv_s, ssd_s) = trunk(
        x_sample, PAST_LEN, state_s5_re, state_s5_im, state_pool, state_ssd_conv, state_ssd,
        *weights)
    return (y_prompt, y_sample, s5_re_p, s5_im_p, pool_p, conv_p, ssd_p,
            s5_re_s, s5_im_s, pool_s, cmlp_v_s, conv_s, ssd_s)
```

```cpp
#include <hip/hip_runtime.h>
#include <math.h>

namespace {
constexpr int D = 1024, T = 17408, TP = 16384;
constexpr float ALPHA = 1.6817928305074290f;
constexpr float LN_EPS = 1e-5f, RMS_EPS = 1e-5f;

__device__ __forceinline__ void tok_info(int t, int& s, int& l, int& tok0, int& L) {
    if (t < TP) { s = t >> 11; l = t & 2047; tok0 = s << 11; L = 2048; }
    else { int b = (t - TP) >> 3; s = 8 + b; l = (t - TP) & 7; tok0 = TP + (b << 3); L = 8; }
}
__device__ __forceinline__ void seq_info(int s, int& tok0, int& L) {
    if (s < 8) { tok0 = s << 11; L = 2048; } else { tok0 = TP + ((s - 8) << 3); L = 8; }
}
__device__ __forceinline__ float gelu_f(float x) { return 0.5f * x * (1.f + tanhf(0.7978845608028654f * (x + 0.044715f * x * x * x))); }
__device__ __forceinline__ float sigmoid_f(float x) { return 1.f / (1.f + __expf(-x)); }
__device__ __forceinline__ float silu_f(float x) { return x * sigmoid_f(x); }
__device__ __forceinline__ float wave_sum(float v) {
#pragma unroll
    for (int o = 32; o >= 1; o >>= 1) v += __shfl_xor(v, o);
    return v;
}

template <bool TB>
__global__ void __launch_bounds__(256) gemm_naive(const float* __restrict__ A, int lda, const float* __restrict__ W, int ldw,
                                                  float* __restrict__ C, int ldc, int M, int N, int K, const float* __restrict__ bias) {
    __shared__ float sA[16][65];
    __shared__ float sB[16][65];
    const int tx = threadIdx.x & 15, ty = threadIdx.x >> 4;
    const int m0 = blockIdx.y * 64, n0 = blockIdx.x * 64;
    float acc[4][4];
#pragma unroll
    for (int i = 0; i < 4; ++i)
#pragma unroll
        for (int j = 0; j < 4; ++j) acc[i][j] = 0.f;
    for (int k0 = 0; k0 < K; k0 += 16) {
#pragma unroll
        for (int i = 0; i < 4; ++i) {
            int e = threadIdx.x + i * 256;
            int r = e >> 4, c = e & 15;
            sA[c][r] = (m0 + r < M) ? A[(size_t)(m0 + r) * lda + k0 + c] : 0.f;
            if (TB) {
                sB[c][r] = (n0 + r < N) ? W[(size_t)(n0 + r) * ldw + k0 + c] : 0.f;
            } else {
                int rk = e >> 6, cn = e & 63;
                sB[rk][cn] = (n0 + cn < N) ? W[(size_t)(k0 + rk) * ldw + n0 + cn] : 0.f;
            }
        }
        __syncthreads();
#pragma unroll
        for (int k = 0; k < 16; ++k) {
            float a[4], b[4];
#pragma unroll
            for (int i = 0; i < 4; ++i) { a[i] = sA[k][ty * 4 + i]; b[i] = sB[k][tx * 4 + i]; }
#pragma unroll
            for (int i = 0; i < 4; ++i)
#pragma unroll
                for (int j = 0; j < 4; ++j) acc[i][j] += a[i] * b[j];
        }
        __syncthreads();
    }
#pragma unroll
    for (int i = 0; i < 4; ++i)
#pragma unroll
        for (int j = 0; j < 4; ++j) {
            int m = m0 + ty * 4 + i, n = n0 + tx * 4 + j;
            if (m < M && n < N) C[(size_t)m * ldc + n] = acc[i][j] + (bias ? bias[n] : 0.f);
        }
}

__global__ void s5_prep(const float* a_re, const float* a_im, const float* log_dt, const float* b_re, const float* b_im,
                        float* lb_r, float* lb_i, float* bb_r, float* bb_i) {
    int gp = blockIdx.x * blockDim.x + threadIdx.x;
    if (gp >= 64 * 64) return;
    int g = gp >> 6;
    float dt = expf(log_dt[g]);
    float lr = a_re[gp], li = a_im[gp];
    float mag = expf(lr * dt);
    float br = mag * cosf(li * dt), bi = mag * sinf(li * dt);
    float den = lr * lr + li * li;
    float fr = ((br - 1.f) * lr + bi * li) / den;
    float fi = (bi * lr - (br - 1.f) * li) / den;
    lb_r[gp] = br; lb_i[gp] = bi;
    for (int i = 0; i < 16; ++i) {
        float xr = b_re[gp * 16 + i], xi = b_im[gp * 16 + i];
        bb_r[gp * 16 + i] = fr * xr - fi * xi;
        bb_i[gp * 16 + i] = fr * xi + fi * xr;
    }
}

__global__ void __launch_bounds__(64) s5_scan(const float* __restrict__ u, const float* __restrict__ lb_r, const float* __restrict__ lb_i,
                                              const float* __restrict__ bb_r, const float* __restrict__ bb_i,
                                              const float* __restrict__ c_re, const float* __restrict__ c_im, const float* __restrict__ dsk,
                                              const float* __restrict__ st_re, const float* __restrict__ st_im,
                                              float* __restrict__ gout, float* __restrict__ o_re_p, float* __restrict__ o_im_p,
                                              float* __restrict__ o_re_s, float* __restrict__ o_im_s) {
    const int s = blockIdx.x >> 6, g = blockIdx.x & 63, p = threadIdx.x;
    int tok0, L; seq_info(s, tok0, L);
    float br[16], bi[16], cr[16], ci[16];
#pragma unroll
    for (int i = 0; i < 16; ++i) {
        br[i] = bb_r[(g * 64 + p) * 16 + i]; bi[i] = bb_i[(g * 64 + p) * 16 + i];
        cr[i] = c_re[(g * 16 + i) * 64 + p]; ci[i] = c_im[(g * 16 + i) * 64 + p];
    }
    const float lr = lb_r[g * 64 + p], li = lb_i[g * 64 + p];
    float hr = 0.f, hi = 0.f;
    if (s >= 8) { hr = st_re[((s - 8) * 64 + g) * 64 + p]; hi = st_im[((s - 8) * 64 + g) * 64 + p]; }
    const float dk = dsk[g * 16 + (p & 15)];
    for (int t = 0; t < L; ++t) {
        const float* ur = u + (size_t)(tok0 + t) * D + g * 16;
        float bur = 0.f, bui = 0.f;
#pragma unroll
        for (int i = 0; i < 16; ++i) { float uv = ur[i]; bur += uv * br[i]; bui += uv * bi[i]; }
        float nr = lr * hr - li * hi + bur, ni = lr * hi + li * hr + bui;
        hr = nr; hi = ni;
        float yv = 0.f;
#pragma unroll
        for (int i = 0; i < 16; ++i) {
            float v = wave_sum(hr * cr[i] - hi * ci[i]);
            if (p == i) yv = v;
        }
        if (p < 16) {
            float y = yv + dk * ur[p];
            gout[(size_t)(tok0 + t) * D + g * 16 + p] = gelu_f(y);
        }
    }
    if (s < 8) { o_re_p[(s * 64 + g) * 64 + p] = hr; o_im_p[(s * 64 + g) * 64 + p] = hi; }
    else { o_re_s[((s - 8) * 64 + g) * 64 + p] = hr; o_im_s[((s - 8) * 64 + g) * 64 + p] = hi; }
}

__global__ void glu_kernel(const float* g, const float* z, float* out, size_t n) {
    size_t i = (size_t)blockIdx.x * blockDim.x + threadIdx.x;
    if (i < n) out[i] = g[i] * sigmoid_f(z[i]);
}

__global__ void __launch_bounds__(256) resid_ln(const float* h, const float* __restrict__ mix, const float* __restrict__ g,
                                                const float* __restrict__ b, float* out) {
    const int t = blockIdx.x * 4 + (threadIdx.x >> 6), lane = threadIdx.x & 63;
    if (t >= T) return;
    float v[16];
    float s = 0.f;
#pragma unroll
    for (int k = 0; k < 16; ++k) { int c = k * 64 + lane; v[k] = ALPHA * h[(size_t)t * D + c] + mix[(size_t)t * D + c]; s += v[k]; }
    const float mean = wave_sum(s) * (1.f / D);
    float q = 0.f;
#pragma unroll
    for (int k = 0; k < 16; ++k) { float d = v[k] - mean; q += d * d; }
    const float rstd = rsqrtf(wave_sum(q) * (1.f / D) + LN_EPS);
#pragma unroll
    for (int k = 0; k < 16; ++k) { int c = k * 64 + lane; out[(size_t)t * D + c] = (v[k] - mean) * rstd * g[c] + b[c]; }
}

__global__ void pool_core(const float* __restrict__ u, const float* __restrict__ st_pool, float* __restrict__ pooled) {
    size_t i = (size_t)blockIdx.x * blockDim.x + threadIdx.x;
    if (i >= (size_t)T * D) return;
    const int t = (int)(i >> 10), c = (int)(i & 1023);
    int s, l, tok0, L; tok_info(t, s, l, tok0, L);
    const int gi = c >> 8, w = 2 << gi;
    float sum = 0.f;
    for (int k = 0; k < w; ++k) {
        int ll = l - k;
        float val;
        if (ll >= 0) val = u[(size_t)(tok0 + ll) * D + c];
        else val = (s >= 8) ? st_pool[((size_t)(s - 8) * 15 + (15 + ll)) * D + c] : 0.f;
        sum += val;
    }
    const int pos = (s >= 8 ? 16384 : 0) + l;
    const float cnt = (float)min(pos + 1, w);
    pooled[i] = sum / cnt - u[i];
}
__global__ void pool_state_out(const float* __restrict__ u, const float* __restrict__ st_pool, float* __restrict__ o_p, float* __restrict__ o_s) {
    size_t i = (size_t)blockIdx.x * blockDim.x + threadIdx.x;
    if (i >= (size_t)136 * 15 * D) return;
    const int c = (int)(i & 1023); const int j = (int)((i >> 10) % 15); const int s = (int)(i / (15 * 1024));
    if (s < 8) o_p[((size_t)s * 15 + j) * D + c] = u[(size_t)(s * 2048 + 2033 + j) * D + c];
    else {
        const int b = s - 8;
        float v = (j < 7) ? st_pool[((size_t)b * 15 + 8 + j) * D + c] : u[(size_t)(TP + b * 8 + (j - 7)) * D + c];
        o_s[((size_t)b * 15 + j) * D + c] = v;
    }
}
__global__ void colscale(float* __restrict__ x, const float* __restrict__ scale, size_t n) {
    size_t i = (size_t)blockIdx.x * blockDim.x + threadIdx.x;
    if (i < n) x[i] *= scale[i & 1023];
}

__global__ void gelu_inplace(float* __restrict__ x, size_t n) {
    size_t i = (size_t)blockIdx.x * blockDim.x + threadIdx.x;
    if (i < n) x[i] = gelu_f(x[i]);
}
__global__ void __launch_bounds__(256) cmlp_ln(float* __restrict__ z, const float* __restrict__ g, const float* __restrict__ b, float* __restrict__ o_v_s) {
    const int t = blockIdx.x * 4 + (threadIdx.x >> 6), lane = threadIdx.x & 63;
    if (t >= T) return;
    float* vr = z + (size_t)t * 2048 + 1024;
    float v[16]; float s = 0.f;
#pragma unroll
    for (int k = 0; k < 16; ++k) { v[k] = vr[k * 64 + lane]; s += v[k]; }
    const float mean = wave_sum(s) * (1.f / D);
    float q = 0.f;
#pragma unroll
    for (int k = 0; k < 16; ++k) { float d = v[k] - mean; q += d * d; }
    const float rstd = rsqrtf(wave_sum(q) * (1.f / D) + LN_EPS);
#pragma unroll
    for (int k = 0; k < 16; ++k) {
        int c = k * 64 + lane; float o = (v[k] - mean) * rstd * g[c] + b[c];
        vr[c] = o;
        if (t >= TP) o_v_s[(size_t)(t - TP) * D + c] = o;
    }
}
__global__ void cmlp_mix(const float* __restrict__ z, const float* __restrict__ w_s, const float* __restrict__ b_s, float* __restrict__ out) {
    size_t i = (size_t)blockIdx.x * blockDim.x + threadIdx.x;
    if (i >= (size_t)T * D) return;
    const int t = (int)(i >> 10), c = (int)(i & 1023);
    int s, l, tok0, L; tok_info(t, s, l, tok0, L);
    const int hd = c >> 8;
    const int tp = (L >= 128) ? (l & 127) : l;
    const int base = t - tp;
    float acc = b_s[hd * 128 + tp];
    const float* wr = w_s + ((size_t)hd * 128 + tp) * 128;
    for (int sp = 0; sp <= tp; ++sp) acc += wr[sp] * z[(size_t)(base + sp) * 2048 + 1024 + c];
    out[i] = z[(size_t)t * 2048 + c] * acc;
}

constexpr int PROJ = 5152, CONVD = 3072;
__global__ void ssd_conv(const float* __restrict__ proj, const float* __restrict__ st_conv, const float* __restrict__ conv_w,
                         const float* __restrict__ conv_b, float* __restrict__ xbc_c) {
    size_t i = (size_t)blockIdx.x * blockDim.x + threadIdx.x;
    if (i >= (size_t)T * CONVD) return;
    const int t = (int)(i / CONVD), c = (int)(i % CONVD);
    int s, l, tok0, L; tok_info(t, s, l, tok0, L);
    float acc = conv_b[c];
#pragma unroll
    for (int k = 0; k < 4; ++k) {
        int src = l + k - 3;
        float v;
        if (src >= 0) v = proj[(size_t)(tok0 + src) * PROJ + 2048 + c];
        else v = (s >= 8) ? st_conv[((size_t)(s - 8) * 3 + (l + k)) * CONVD + c] : 0.f;
        acc += v * conv_w[k * CONVD + c];
    }
    xbc_c[i] = silu_f(acc);
}
__global__ void ssd_conv_state_out(const float* __restrict__ proj, float* __restrict__ o_p, float* __restrict__ o_s) {
    size_t i = (size_t)blockIdx.x * blockDim.x + threadIdx.x;
    if (i >= (size_t)136 * 3 * CONVD) return;
    const int c = (int)(i % CONVD); const int j = (int)((i / CONVD) % 3); const int s = (int)(i / (3 * CONVD));
    if (s < 8) o_p[((size_t)s * 3 + j) * CONVD + c] = proj[(size_t)(s * 2048 + 2045 + j) * PROJ + 2048 + c];
    else { const int b = s - 8; o_s[((size_t)b * 3 + j) * CONVD + c] = proj[(size_t)(TP + b * 8 + 5 + j) * PROJ + 2048 + c]; }
}
__global__ void __launch_bounds__(256) ssd_scan(const float* __restrict__ proj, const float* __restrict__ xbc_c, const float* __restrict__ dt_bias,
                                                const float* __restrict__ a_log, const float* __restrict__ dsk, const float* __restrict__ st_ssd,
                                                float* __restrict__ y, float* __restrict__ o_p, float* __restrict__ o_s) {
    const int s = blockIdx.x >> 5, hd = blockIdx.x & 31, p = threadIdx.x >> 2, nq = threadIdx.x & 3, g = hd >> 3;
    int tok0, L; seq_info(s, tok0, L);
    float h[32];
    if (s >= 8) {
        const float* sp = st_ssd + (((size_t)(s - 8) * 32 + hd) * 64 + p) * 128 + nq * 32;
#pragma unroll
        for (int i = 0; i < 32; ++i) h[i] = sp[i];
    } else {
#pragma unroll
        for (int i = 0; i < 32; ++i) h[i] = 0.f;
    }
    const float a = -expf(a_log[hd]), dtb = dt_bias[hd], dk = dsk[hd];
    for (int t = 0; t < L; ++t) {
        const size_t tok = (size_t)(tok0 + t);
        float dr = proj[tok * PROJ + 5120 + hd] + dtb;
        float dtv = (dr > 20.f) ? dr : log1pf(expf(dr));
        float dA = expf(dtv * a);
        float xv = xbc_c[tok * CONVD + hd * 64 + p];
        float coef = dtv * xv;
        const float* Bp = xbc_c + tok * CONVD + 2048 + g * 128 + nq * 32;
        const float* Cp = xbc_c + tok * CONVD + 2560 + g * 128 + nq * 32;
        float yp = 0.f;
#pragma unroll
        for (int i = 0; i < 32; ++i) { h[i] = h[i] * dA + coef * Bp[i]; yp += Cp[i] * h[i]; }
        yp += __shfl_xor(yp, 1); yp += __shfl_xor(yp, 2);
        if (nq == 0) y[tok * 2048 + hd * 64 + p] = yp + dk * xv;
    }
    float* op = (s < 8) ? (o_p + (((size_t)s * 32 + hd) * 64 + p) * 128 + nq * 32) : (o_s + (((size_t)(s - 8) * 32 + hd) * 64 + p) * 128 + nq * 32);
#pragma unroll
    for (int i = 0; i < 32; ++i) op[i] = h[i];
}
__global__ void __launch_bounds__(256) ssd_gate_norm(const float* __restrict__ y, const float* __restrict__ proj, const float* __restrict__ norm_g,
                                                     float* __restrict__ out) {
    const int t = blockIdx.x; const int c0 = threadIdx.x * 8;
    float v[8]; float q = 0.f;
#pragma unroll
    for (int k = 0; k < 8; ++k) { float zz = proj[(size_t)t * PROJ + c0 + k]; v[k] = y[(size_t)t * 2048 + c0 + k] * silu_f(zz); q += v[k] * v[k]; }
    const float r = rsqrtf(wave_sum(q) * (1.f / 512.f) + RMS_EPS);
#pragma unroll
    for (int k = 0; k < 8; ++k) out[(size_t)t * 2048 + c0 + k] = v[k] * r * norm_g[c0 + k];
}

__global__ void __launch_bounds__(256) peer_topk(const float* __restrict__ sc, int* __restrict__ idx_out, float* __restrict__ gate_out) {
    const int th = blockIdx.x * blockDim.x + threadIdx.x;
    if (th >= T * 8) return;
    const float* s0 = sc + (size_t)th * 256;
    float ls[2][16]; int li[2][16];
#pragma unroll
    for (int sd = 0; sd < 2; ++sd) {
#pragma unroll
        for (int k = 0; k < 16; ++k) { ls[sd][k] = -INFINITY; li[sd][k] = 0; }
        for (int n = 0; n < 128; ++n) {
            float x = s0[sd * 128 + n]; int xi = n;
#pragma unroll
            for (int k = 0; k < 16; ++k) {
                bool gt = x > ls[sd][k];
                float ts = gt ? x : ls[sd][k]; int ti = gt ? xi : li[sd][k];
                x = gt ? ls[sd][k] : x; xi = gt ? li[sd][k] : xi;
                ls[sd][k] = ts; li[sd][k] = ti;
            }
        }
    }
    float bs[16]; int bi[16];
#pragma unroll
    for (int k = 0; k < 16; ++k) { bs[k] = -INFINITY; bi[k] = 0; }
#pragma unroll
    for (int i = 0; i < 16; ++i)
#pragma unroll
        for (int j = 0; j < 16; ++j) {
            if ((i + 1) * (j + 1) <= 16) {
                float x = ls[0][i] + ls[1][j]; int xi = li[0][i] * 128 + li[1][j];
#pragma unroll
                for (int k = 0; k < 16; ++k) {
                    bool gt = x > bs[k];
                    float ts = gt ? x : bs[k]; int ti = gt ? xi : bi[k];
                    x = gt ? bs[k] : x; xi = gt ? bi[k] : xi;
                    bs[k] = ts; bi[k] = ti;
                }
            }
        }
    float mx = bs[0], den = 0.f; float e[16];
#pragma unroll
    for (int k = 0; k < 16; ++k) { e[k] = __expf(bs[k] - mx); den += e[k]; }
    const float inv = 1.f / den;
#pragma unroll
    for (int k = 0; k < 16; ++k) { idx_out[(size_t)th * 16 + k] = bi[k]; gate_out[(size_t)th * 16 + k] = e[k] * inv; }
}
__global__ void __launch_bounds__(256) peer_gather(const float* __restrict__ x, const int* __restrict__ idx, const float* __restrict__ gate,
                                                   const float* __restrict__ eu, const float* __restrict__ ev, float* __restrict__ ffn) {
    const int t = blockIdx.x * 4 + (threadIdx.x >> 6), lane = threadIdx.x & 63;
    if (t >= T) return;
    float4 xv[4], acc[4];
#pragma unroll
    for (int k = 0; k < 4; ++k) { xv[k] = *(const float4*)(x + (size_t)t * D + (k * 64 + lane) * 4); acc[k] = make_float4(0.f, 0.f, 0.f, 0.f); }
    for (int e = 0; e < 128; ++e) {
        const int id = idx[(size_t)t * 128 + e]; const float gt = gate[(size_t)t * 128 + e];
        const float* ur = eu + (size_t)id * D; const float* vr = ev + (size_t)id * D;
        float d = 0.f;
#pragma unroll
        for (int k = 0; k < 4; ++k) { float4 uu = *(const float4*)(ur + (k * 64 + lane) * 4); d += uu.x * xv[k].x + uu.y * xv[k].y + uu.z * xv[k].z + uu.w * xv[k].w; }
        d = wave_sum(d);
        const float w = gt * gelu_f(d);
#pragma unroll
        for (int k = 0; k < 4; ++k) { float4 vv = *(const float4*)(vr + (k * 64 + lane) * 4); acc[k].x += w * vv.x; acc[k].y += w * vv.y; acc[k].z += w * vv.z; acc[k].w += w * vv.w; }
    }
#pragma unroll
    for (int k = 0; k < 4; ++k) *(float4*)(ffn + (size_t)t * D + (k * 64 + lane) * 4) = acc[k];
}

inline void gemm(hipStream_t st, bool tb, const float* A, int lda, const float* W, int ldw, float* C, int ldc, int M, int N, int K, const float* bias) {
    dim3 grid((N + 63) / 64, (M + 63) / 64);
    if (tb) gemm_naive<true><<<grid, 256, 0, st>>>(A, lda, W, ldw, C, ldc, M, N, K, bias);
    else gemm_naive<false><<<grid, 256, 0, st>>>(A, lda, W, ldw, C, ldc, M, N, K, bias);
}
inline unsigned nb(size_t n, int b = 256) { return (unsigned)((n + b - 1) / b); }
}

extern "C" void kernel_launch(void* const* d_in, const int* in_sizes, int n_in, void* d_out, int out_size, void* d_ws, size_t ws_size,
                              hipStream_t stream) {
    auto in = [&](int i) { return (const float*)d_in[i]; };
    float* out = (float*)d_out;
    float* o_y = out;
    float* o_s5re_p = out + 17825792;
    float* o_s5im_p = o_s5re_p + 32768;
    float* o_pool_p = o_s5im_p + 32768;
    float* o_conv_p = o_pool_p + 122880;
    float* o_ssd_p = o_conv_p + 73728;
    float* o_s5re_s = o_ssd_p + 2097152;
    float* o_s5im_s = o_s5re_s + 524288;
    float* o_pool_s = o_s5im_s + 524288;
    float* o_cmlpv_s = o_pool_s + 1966080;
    float* o_conv_s = o_cmlpv_s + 1048576;
    float* o_ssd_s = o_conv_s + 1179648;

    float* ws = (float*)d_ws;
    const size_t TD = (size_t)T * D;
    float* H = ws;
    float* A1 = H + TD;
    float* A2 = A1 + TD;
    float* A3 = A2 + TD;
    float* BIG = A3 + TD;
    float* SM = BIG + (size_t)T * PROJ;
    float* lb_r = SM, *lb_i = SM + 4096, *bb_r = SM + 8192, *bb_i = SM + 8192 + 65536;
    int* IDX = (int*)(SM + 8192 + 2 * 65536);
    float* GATE = (float*)(IDX + (size_t)T * 128);
    float* Q = BIG; float* SC = BIG + (size_t)T * 2048;

    hipMemcpyAsync(H, in(0), (size_t)TP * D * 4, hipMemcpyDeviceToDevice, stream);
    hipMemcpyAsync(H + (size_t)TP * D, in(1), (size_t)1024 * D * 4, hipMemcpyDeviceToDevice, stream);

    for (int layer = 0; layer < 4; ++layer) {
        if (layer == 0) {
            s5_prep<<<16, 256, 0, stream>>>(in(8), in(9), in(10), in(11), in(12), lb_r, lb_i, bb_r, bb_i);
            gemm(stream, false, H, D, in(7), D, A1, D, T, D, D, nullptr);
            s5_scan<<<136 * 64, 64, 0, stream>>>(A1, lb_r, lb_i, bb_r, bb_i, in(13), in(14), in(15), in(2), in(3), A2,
                                                o_s5re_p, o_s5im_p, o_s5re_s, o_s5im_s);
            gemm(stream, false, A2, D, in(16), D, A1, D, T, D, D, in(17));
            glu_kernel<<<nb(TD), 256, 0, stream>>>(A2, A1, A2, TD);
            gemm(stream, false, A2, D, in(18), D, A3, D, T, D, D, nullptr);
        } else if (layer == 1) {
            gemm(stream, false, H, D, in(19), D, A1, D, T, D, D, nullptr);
            pool_core<<<nb(TD), 256, 0, stream>>>(A1, in(4), A2);
            pool_state_out<<<nb((size_t)136 * 15 * D), 256, 0, stream>>>(A1, in(4), o_pool_p, o_pool_s);
            for (int g = 0; g < 4; ++g)
                gemm(stream, false, A2 + g * 256, D, in(20) + (size_t)g * 65536, 256, A1 + g * 256, D, T, 256, 256, nullptr);
            colscale<<<nb(TD), 256, 0, stream>>>(A1, in(21), TD);
            gemm(stream, false, A1, D, in(22), D, A3, D, T, D, D, nullptr);
        } else if (layer == 2) {
            gemm(stream, false, H, D, in(23), 2048, BIG, 2048, T, 2048, D, in(24));
            gelu_inplace<<<nb((size_t)T * 2048), 256, 0, stream>>>(BIG, (size_t)T * 2048);
            cmlp_ln<<<T / 4, 256, 0, stream>>>(BIG, in(25), in(26), o_cmlpv_s);
            cmlp_mix<<<nb(TD), 256, 0, stream>>>(BIG, in(27), in(28), A1);
            gemm(stream, false, A1, D, in(29), D, A3, D, T, D, D, nullptr);
        } else {
            gemm(stream, false, H, D, in(30), PROJ, BIG, PROJ, T, PROJ, D, nullptr);
            float* XC = A1;
            ssd_conv<<<nb((size_t)T * CONVD), 256, 0, stream>>>(BIG, in(5), in(31), in(32), XC);
            ssd_conv_state_out<<<nb((size_t)136 * 3 * CONVD), 256, 0, stream>>>(BIG, o_conv_p, o_conv_s);
            float* Y = SM + 8192 + 2 * 65536 + (size_t)T * 256 + 1024;
            ssd_scan<<<136 * 32, 256, 0, stream>>>(BIG, XC, in(33), in(34), in(35), in(6), Y, o_ssd_p, o_ssd_s);
            float* YN = Y + (size_t)T * 2048;
            ssd_gate_norm<<<T, 256, 0, stream>>>(Y, BIG, in(36), YN);
            gemm(stream, false, YN, 2048, in(37), D, A3, D, T, D, 2048, nullptr);
        }
        resid_ln<<<T / 4, 256, 0, stream>>>(H, A3, in(38) + layer * D, in(39) + layer * D, H);
        gemm(stream, false, H, D, in(42) + (size_t)layer * D * 2048, 2048, Q, 2048, T, 2048, D, nullptr);
        for (int hs = 0; hs < 16; ++hs)
            gemm(stream, true, Q + hs * 128, 2048, in(43) + ((size_t)layer * 16 + hs) * 16384, 128, SC + hs * 128, 2048, T, 128, 128, nullptr);
        peer_topk<<<nb((size_t)T * 8), 256, 0, stream>>>(SC, IDX, GATE);
        peer_gather<<<T / 4, 256, 0, stream>>>(H, IDX, GATE, in(44) + (size_t)layer * 16384 * D, in(45) + (size_t)layer * 16384 * D, A3);
        resid_ln<<<T / 4, 256, 0, stream>>>(H, A3, in(40) + layer * D, in(41) + layer * D, (layer == 3) ? o_y : H);
    }
}
```

```cpp
#include <hip/hip_runtime.h>
#include <hip/hip_cooperative_groups.h>
#include <cstdio>
#include <cstdint>
#include <math.h>
namespace cg = cooperative_groups;

namespace pg8 {
#define PG8_LAS __attribute__((address_space(3)))
typedef unsigned short bf16_t;
typedef short bf16x8 __attribute__((ext_vector_type(8)));
typedef float f32x4 __attribute__((ext_vector_type(4)));
typedef unsigned u32x4 __attribute__((ext_vector_type(4)));
constexpr int BM = 256, BK = 64, HALF = 128, HTB = HALF * BK * 2, STAGE_BYTES = 8 * HTB, NXCD = 8, WGM = 8;
__host__ __device__ __forceinline__ int lds_byte(int r, int c) { const int st = (r >> 4) * 2 + (c >> 5), rr = r & 15, cc = c & 31, ob = rr * 64 + cc * 2; return st * 1024 + (ob ^ (((ob >> 9) & 1) << 5)); }
__host__ __device__ __forceinline__ void stage_rc(int b, int& R, int& C) { const int st = b / 1024, sb = b % 1024, swz = sb ^ (((sb >> 9) & 1) << 5); R = (st >> 1) * 16 + swz / 64; C = (st & 1) * 32 + (swz % 64) / 2; }
__host__ __device__ __forceinline__ int perm32(int rho) { const int n = rho >> 4, i = rho & 15; return 8 * (i >> 2) + 4 * n + (i & 3); }
struct Unit { int pm, pn; };
struct Gemm { const bf16_t* A; const bf16_t* Bt; int M, N, K, lda, a_pn_off; };
struct StaticOrder {
    int nM, nN, nwg, G, c;
    __host__ __device__ void init(int M, int N, int G_, int c_) { nM = M / BM; nN = N / BM; nwg = nM * nN; G = G_; c = c_; }
    __host__ __device__ bool next(int i, Unit& u) const {
        const long L = (long)i * G + c; if (L >= nwg) return false;
        int wgid = (int)L; { const int q = nwg / NXCD, r = nwg % NXCD, xcd = wgid % NXCD, off = wgid / NXCD; wgid = (xcd < r ? xcd * (q + 1) : r * (q + 1) + (xcd - r) * q) + off; }
        const int nig = WGM * nN, gid = wgid / nig, fm = gid * WGM, gsz = (nM - fm) < WGM ? (nM - fm) : WGM;
        u.pm = fm + ((wgid % nig) % gsz); u.pn = (wgid % nig) / gsz; return true;
    }
    __device__ __forceinline__ void a_ready(const Unit&) const {}
    __device__ __forceinline__ void done(const Unit&) const {}
};
__device__ __forceinline__ unsigned cvt_pk_bf16(float lo, float hi) { unsigned r; asm volatile("v_cvt_pk_bf16_f32 %0, %1, %2" : "=v"(r) : "v"(lo), "v"(hi)); return r; }
template <class Epi, class Sched, bool ALIGN_EPI = false, bool SP2 = false>
__device__ __forceinline__ void gemm_phase(PG8_LAS unsigned char* lds, const Gemm g, const Sched& S, const Epi& E, int tid_in) {
    int tid_ = tid_in; asm volatile("" : "+v"(tid_));
    const int tid = tid_, wid = __builtin_amdgcn_readfirstlane(tid >> 6), lane = tid & 63, wr = wid >> 2, wc = wid & 3, fr = lane & 15, fq = lane >> 4;
    const int K = g.K, nt = K / BK;
    unsigned voffA[2], voffB[2];
#pragma unroll
    for (int i = 0; i < 2; ++i) { int R, C; stage_rc(tid * 16 + i * 8192, R, C); const int Rb = Epi::PERM ? ((R & ~31) + perm32(R & 31)) : R;
        voffA[i] = (unsigned)(R * g.lda + C) * 2u; voffB[i] = (unsigned)(Rb * K + C) * 2u; }
    const size_t kstep = (size_t)(BK * 2);
    const size_t hstepA = (size_t)HALF * g.lda * 2, tstepA = 2 * hstepA;
    const size_t hstepB = (size_t)HALF * K * 2, tstepB = 2 * hstepB;
    const size_t apn = (size_t)g.a_pn_off * 2;
    const unsigned ldsw = (unsigned)wid * 1024u;
    const int aoff = lds_byte(wr * 64 + fr, fq * 8), boff = lds_byte(wc * 32 + fr, fq * 8);
#define PG8_SA(b, h) (((b) * 2 + (h)) * HTB)
#define PG8_SB(b, h) ((4 + (b) * 2 + (h)) * HTB)
#define PG8_STAGE(bufoff, gbase, voff) do { _Pragma("unroll") for (int _i = 0; _i < 2; ++_i) \
        __builtin_amdgcn_global_load_lds((const unsigned*)((const char*)(gbase) + (voff)[_i]), (PG8_LAS unsigned*)(lds + (bufoff) + ldsw + _i * 8192), 16, 0, 0); } while (0)
#define PG8_LDA(dst, b, h) do { _Pragma("unroll") for (int m = 0; m < 4; ++m) _Pragma("unroll") for (int k = 0; k < 2; ++k) dst[m][k] = *(const PG8_LAS bf16x8*)(lds + PG8_SA(b, h) + aoff + m * 2048 + k * 1024); } while (0)
#define PG8_LDB(dst, b, h) do { _Pragma("unroll") for (int n = 0; n < 2; ++n) _Pragma("unroll") for (int k = 0; k < 2; ++k) dst[n][k] = *(const PG8_LAS bf16x8*)(lds + PG8_SB(b, h) + boff + n * 2048 + k * 1024); } while (0)
#define PG8_MMA(ai, bj, At, Bt) do { __builtin_amdgcn_s_setprio(1); _Pragma("unroll") for (int m = 0; m < 4; ++m) _Pragma("unroll") for (int n = 0; n < 2; ++n) _Pragma("unroll") for (int k = 0; k < 2; ++k) \
        acc[ai][bj][m][n] = __builtin_amdgcn_mfma_f32_16x16x32_bf16(Bt[n][k], At[m][k], acc[ai][bj][m][n], 0, 0, 0); __builtin_amdgcn_s_setprio(0); } while (0)
#define PG8_WAIT_V(n) asm volatile("s_waitcnt vmcnt(" #n ")" ::: "memory")
#define PG8_WAIT_L(n) asm volatile("s_waitcnt lgkmcnt(" #n ")" ::: "memory")
#define PG8_BAR __builtin_amdgcn_s_barrier()
#define PG8_SCHED __builtin_amdgcn_sched_barrier(0)
    Unit cur, nxt; int ui = 0;
    if (!S.next(0, cur)) return;
    f32x4 acc[2][2][4][2];
#pragma unroll
    for (int a = 0; a < 2; ++a)
#pragma unroll
        for (int b = 0; b < 2; ++b)
#pragma unroll
            for (int m = 0; m < 4; ++m)
#pragma unroll
                for (int n = 0; n < 2; ++n) acc[a][b][m][n] = (f32x4){0.f, 0.f, 0.f, 0.f};
    bf16x8 At[4][2], B0[2][2], B1[2][2];
    const char* cA = (const char*)g.A + (size_t)cur.pm * tstepA + (size_t)cur.pn * apn; const char* cB = (const char*)g.Bt + (size_t)cur.pn * tstepB;
    S.a_ready(cur);
    if constexpr (SP2) {
        PG8_STAGE(PG8_SB(0, 0), cB, voffB); PG8_STAGE(PG8_SB(0, 1), cB + hstepB, voffB); PG8_STAGE(PG8_SA(0, 0), cA, voffA); PG8_STAGE(PG8_SA(0, 1), cA + hstepA, voffA);
        if (wr == 1) PG8_BAR;
        PG8_WAIT_V(2); PG8_BAR;
        PG8_STAGE(PG8_SB(1, 0), cB + kstep, voffB); PG8_STAGE(PG8_SA(1, 0), cA + kstep, voffA); PG8_STAGE(PG8_SB(1, 1), cB + hstepB + kstep, voffB);
        PG8_WAIT_V(6); PG8_BAR;
    } else {
        PG8_STAGE(PG8_SB(0, 0), cB, voffB); PG8_STAGE(PG8_SA(0, 0), cA, voffA); PG8_STAGE(PG8_SB(0, 1), cB + hstepB, voffB); PG8_STAGE(PG8_SA(0, 1), cA + hstepA, voffA);
        if (wr == 1) PG8_BAR;
        PG8_WAIT_V(4); PG8_BAR;
        PG8_STAGE(PG8_SB(1, 0), cB + kstep, voffB); PG8_STAGE(PG8_SA(1, 0), cA + kstep, voffA); PG8_STAGE(PG8_SB(1, 1), cB + hstepB + kstep, voffB);
        PG8_WAIT_V(6); PG8_BAR;
    }
    for (;;) {
        const bool has_next = S.next(ui + 1, nxt);
        const char* nA = has_next ? (const char*)g.A + (size_t)nxt.pm * tstepA + (size_t)nxt.pn * apn : cA; const char* nB = has_next ? (const char*)g.Bt + (size_t)nxt.pn * tstepB : cB;
#pragma nounroll
        for (int t = 0; t < nt; t += 2) {
            const bool last = (t == nt - 2);
            const char* a1 = cA + (size_t)(t + 1) * kstep;
            const char* a2 = last ? nA : cA + (size_t)(t + 2) * kstep; const char* b2 = last ? nB : cB + (size_t)(t + 2) * kstep;
            const char* a3 = a2 + kstep; const char* b3 = b2 + kstep;
            if (last && has_next) S.a_ready(nxt);
            if constexpr (SP2) {
            PG8_LDB(B0, 0, 0); PG8_LDB(B1, 0, 1); PG8_SCHED; PG8_LDA(At, 0, 0); PG8_STAGE(PG8_SA(1, 1), a1 + hstepA, voffA);
            PG8_WAIT_V(8); PG8_WAIT_L(0); PG8_BAR; PG8_MMA(0, 0, At, B0); PG8_MMA(0, 1, At, B1); PG8_BAR; PG8_SCHED;
            PG8_LDA(At, 0, 1); PG8_STAGE(PG8_SB(0, 0), b2, voffB); PG8_STAGE(PG8_SB(0, 1), b2 + hstepB, voffB); PG8_STAGE(PG8_SA(0, 0), a2, voffA);
            PG8_WAIT_V(8); PG8_WAIT_L(0); PG8_BAR; PG8_MMA(1, 0, At, B0); PG8_MMA(1, 1, At, B1); PG8_BAR; PG8_SCHED;
            PG8_LDB(B0, 1, 0); PG8_LDB(B1, 1, 1); PG8_SCHED; PG8_LDA(At, 1, 0); PG8_STAGE(PG8_SA(0, 1), a2 + hstepA, voffA);
            PG8_WAIT_V(8); PG8_WAIT_L(0); PG8_BAR; PG8_MMA(0, 0, At, B0); PG8_MMA(0, 1, At, B1); PG8_BAR; PG8_SCHED;
            PG8_LDA(At, 1, 1); PG8_STAGE(PG8_SB(1, 0), b3, voffB); PG8_STAGE(PG8_SB(1, 1), b3 + hstepB, voffB); PG8_STAGE(PG8_SA(1, 0), a3, voffA);
            PG8_WAIT_V(8); PG8_WAIT_L(0); PG8_BAR; PG8_MMA(1, 0, At, B0); PG8_MMA(1, 1, At, B1); PG8_BAR; PG8_SCHED;
            } else {
            PG8_LDB(B0, 0, 0); PG8_SCHED; PG8_LDA(At, 0, 0); PG8_STAGE(PG8_SA(1, 1), a1 + hstepA, voffA);
            PG8_WAIT_L(8); PG8_BAR; PG8_WAIT_L(0); PG8_MMA(0, 0, At, B0); PG8_BAR; PG8_SCHED;
            PG8_LDB(B1, 0, 1); PG8_STAGE(PG8_SB(0, 0), b2, voffB);
            PG8_BAR; PG8_WAIT_L(0); PG8_MMA(0, 1, At, B1); PG8_BAR;
            PG8_LDA(At, 0, 1); PG8_STAGE(PG8_SA(0, 0), a2, voffA);
            PG8_BAR; PG8_WAIT_L(0); PG8_MMA(1, 0, At, B0); PG8_BAR; PG8_SCHED;
            PG8_STAGE(PG8_SB(0, 1), b2 + hstepB, voffB);
            PG8_WAIT_V(6); PG8_BAR; PG8_MMA(1, 1, At, B1); PG8_BAR;
            PG8_LDB(B0, 1, 0); PG8_SCHED; PG8_LDA(At, 1, 0); PG8_STAGE(PG8_SA(0, 1), a2 + hstepA, voffA);
            PG8_WAIT_L(8); PG8_BAR; PG8_WAIT_L(0); PG8_MMA(0, 0, At, B0); PG8_BAR; PG8_SCHED;
            PG8_LDB(B1, 1, 1); PG8_STAGE(PG8_SB(1, 0), b3, voffB);
            PG8_BAR; PG8_WAIT_L(0); PG8_MMA(0, 1, At, B1); PG8_BAR;
            PG8_LDA(At, 1, 1); PG8_STAGE(PG8_SA(1, 0), a3, voffA);
            PG8_BAR; PG8_WAIT_L(0); PG8_MMA(1, 0, At, B0); PG8_BAR; PG8_SCHED;
            PG8_STAGE(PG8_SB(1, 1), b3 + hstepB, voffB);
            PG8_WAIT_V(6); PG8_BAR; PG8_MMA(1, 1, At, B1); PG8_BAR;
            }
        }
        if constexpr (ALIGN_EPI) { if (wr == 0) PG8_BAR; }
        if constexpr (!Epi::AFTER_DRAIN) { E(acc, cur, wr, wc, fr, fq); S.done(cur); }
        if (!has_next) break;
#pragma unroll
        for (int a = 0; a < 2; ++a)
#pragma unroll
            for (int b = 0; b < 2; ++b)
#pragma unroll
                for (int m = 0; m < 4; ++m)
#pragma unroll
                    for (int n = 0; n < 2; ++n) acc[a][b][m][n] = (f32x4){0.f, 0.f, 0.f, 0.f};
        cur = nxt; cA = nA; cB = nB; ++ui;
        if constexpr (ALIGN_EPI) { if (wr == 1) PG8_BAR; }
    }
    PG8_WAIT_V(0);
    if constexpr (!ALIGN_EPI) { if (wr == 0) PG8_BAR; }
    PG8_BAR;
    if constexpr (Epi::AFTER_DRAIN) { E.fused(acc, cur, wr, wc, fr, fq, lds, wid, lane); S.done(cur); }
#undef PG8_SA
#undef PG8_SB
#undef PG8_STAGE
#undef PG8_LDA
#undef PG8_LDB
#undef PG8_MMA
#undef PG8_WAIT_V
#undef PG8_WAIT_L
#undef PG8_BAR
#undef PG8_SCHED
}
}

namespace mk {
#define LAS __attribute__((address_space(3)))
typedef unsigned short bf16;
typedef unsigned v4u __attribute__((ext_vector_type(4)));
typedef unsigned v2u __attribute__((ext_vector_type(2)));
typedef float f32x4 __attribute__((ext_vector_type(4)));
typedef short bf16x8 __attribute__((ext_vector_type(8)));
using bf16x2 = __attribute__((ext_vector_type(2))) __bf16;

constexpr int D = 1024, T = 17408, TP = 16384, NWAVES = 8, NTHR = 512;
constexpr float ALPHA = 1.6817928305074290f;
constexpr float LN_EPS = 1e-5f, RMS_EPS = 1e-5f;
constexpr int LDS_BYTES = 160 * 1024;
constexpr int NPROJ = 5376, CONVD = 3072;

constexpr size_t MiB = 1u << 20;
constexpr size_t WS_W_S5IN = 0, WS_W_S5GLU = 2 * MiB, WS_W_S5OUT = 4 * MiB, WS_W_PIN = 6 * MiB, WS_W_PGRP = 8 * MiB, WS_W_POUT = 9 * MiB,
                 WS_W_CIN = 11 * MiB, WS_W_COUT = 15 * MiB, WS_W_SIN = 17 * MiB  , WS_W_SOUT = 28 * MiB, WS_W_PQ = 32 * MiB  ,
                 WS_KEYS = 48 * MiB  , WS_SMALL = 50 * MiB, WS_CTL = 52 * MiB  ;
constexpr size_t CTL_BYTES = 16384;
constexpr int MISC_OFF = LDS_BYTES - 64;
constexpr size_t WS_EU = 64 * MiB, WS_EV = 96 * MiB;
constexpr size_t WS_H32 = 128 * MiB, WS_R32 = 196 * MiB, WS_HB = 264 * MiB, WS_A0 = 298 * MiB, WS_A1 = 332 * MiB, WS_A2 = 366 * MiB;
constexpr size_t WS_Q = 400 * MiB  , WS_IDX = 468 * MiB  , WS_GATE = 477 * MiB  , WS_DT = 486 * MiB  ;
constexpr size_t WS_XBC = 490 * MiB  , WS_XC = 592 * MiB  , WS_Y = 694 * MiB  , WS_YN = 762 * MiB  , WS_END = 830 * MiB;
constexpr size_t SM_LBR = 0, SM_LBI = 4096, SM_BBR = 8192, SM_BBI = 8192 + 65536;

struct Params { const float* in[46]; float* out; unsigned char* ws; };

__device__ __forceinline__ unsigned f2bf(float f) { unsigned u = __builtin_bit_cast(unsigned, f); return (u + 0x7fffu + ((u >> 16) & 1u)) >> 16; }
__device__ __forceinline__ unsigned pk2(float lo, float hi) { return pg8::cvt_pk_bf16(lo, hi); }
__device__ __forceinline__ float bflo(unsigned w) { return __builtin_bit_cast(float, w << 16); }
__device__ __forceinline__ float bfhi(unsigned w) { return __builtin_bit_cast(float, w & 0xffff0000u); }
__device__ __forceinline__ float bf2f(bf16 b) { return __builtin_bit_cast(float, ((unsigned)b) << 16); }
__device__ __forceinline__ float sigmoid_f(float x) { return 1.f / (1.f + __expf(-x)); }
__device__ __forceinline__ float silu_f(float x) { return x * sigmoid_f(x); }
__device__ __forceinline__ float gelu_f(float x) { return x * sigmoid_f(1.5957691216057308f * (x + 0.044715f * x * x * x)); }
__device__ __forceinline__ float shx(float v, int o, int lane) { return __builtin_bit_cast(float, __builtin_amdgcn_ds_bpermute((lane ^ o) << 2, __builtin_bit_cast(int, v))); }
__device__ __forceinline__ float wave_sum(float v, int lane) {
#pragma unroll
    for (int o = 32; o >= 1; o >>= 1) v += shx(v, o, lane);
    return v;
}
__device__ __forceinline__ float dot2(unsigned w, unsigned x, float acc) { return __builtin_amdgcn_fdot2_f32_bf16(__builtin_bit_cast(bf16x2, w), __builtin_bit_cast(bf16x2, x), acc, false); }
__device__ __forceinline__ float reduce16(const float (&p)[16], int lane) {
    const bool b5 = lane & 32, b4 = lane & 16, b3 = lane & 8, b2 = lane & 4;
    float q[8], r[4], s[2], t;
#pragma unroll
    for (int i = 0; i < 8; ++i) { const float keep = b5 ? p[i + 8] : p[i], send = b5 ? p[i] : p[i + 8]; q[i] = keep + shx(send, 32, lane); }
#pragma unroll
    for (int i = 0; i < 4; ++i) { const float keep = b4 ? q[i + 4] : q[i], send = b4 ? q[i] : q[i + 4]; r[i] = keep + shx(send, 16, lane); }
#pragma unroll
    for (int i = 0; i < 2; ++i) { const float keep = b3 ? r[i + 2] : r[i], send = b3 ? r[i] : r[i + 2]; s[i] = keep + shx(send, 8, lane); }
    { const float keep = b2 ? s[1] : s[0], send = b2 ? s[0] : s[1]; t = keep + shx(send, 4, lane); }
    t += shx(t, 2, lane); t += shx(t, 1, lane);
    return t;
}
__device__ __forceinline__ void seq_info(int s, int& tok0, int& L) { if (s < 8) { tok0 = s << 11; L = 2048; } else { tok0 = TP + ((s - 8) << 3); L = 8; } }
__device__ __forceinline__ void tok_info(int t, int& s, int& l, int& tok0) {
    if (t < TP) { s = t >> 11; l = t & 2047; tok0 = s << 11; } else { const int b = (t - TP) >> 3; s = 8 + b; l = (t - TP) & 7; tok0 = TP + (b << 3); }
}

template <int MODE> struct EpiBf16 {
    static constexpr bool PERM = true, AFTER_DRAIN = false;
    bf16* O; int ldc; const float* bias; const float* scale; const bf16* G;
    __device__ __forceinline__ void operator()(const pg8::f32x4 (&acc)[2][2][4][2], const pg8::Unit& u, int wr, int wc, int fr_, int fq_) const {
        int fr = fr_, fq = fq_; asm volatile("" : "+v"(fr), "+v"(fq));
        const int row0 = u.pm * 256 + wr * 64 + fr, col0 = u.pn * 256 + wc * 32 + 8 * fq;
        f32x4 bv[2][2], sv[2][2];
#pragma unroll
        for (int bj = 0; bj < 2; ++bj)
#pragma unroll
            for (int n = 0; n < 2; ++n) {
                bv[bj][n] = bias ? *(const f32x4*)(bias + col0 + bj * 128 + 4 * n) : (f32x4){0.f, 0.f, 0.f, 0.f};
                sv[bj][n] = (MODE == 2) ? *(const f32x4*)(scale + col0 + bj * 128 + 4 * n) : (f32x4){1.f, 1.f, 1.f, 1.f};
            }
#pragma unroll
        for (int ai = 0; ai < 2; ++ai)
#pragma unroll
            for (int m = 0; m < 4; ++m) {
                const size_t roff = (size_t)(row0 + ai * 128 + m * 16) * ldc + col0;
#pragma unroll
                for (int bj = 0; bj < 2; ++bj) {
                    f32x4 v0 = acc[ai][bj][m][0] + bv[bj][0], v1 = acc[ai][bj][m][1] + bv[bj][1];
                    if (MODE == 1) {
#pragma unroll
                        for (int j = 0; j < 4; ++j) { v0[j] = gelu_f(v0[j]); v1[j] = gelu_f(v1[j]); }
                    }
                    if (MODE == 2) { v0 = v0 * sv[bj][0]; v1 = v1 * sv[bj][1]; }
                    if (MODE == 3) {
                        const v4u gw = *(const v4u*)(G + roff + bj * 128);
                        v0[0] = bflo(gw.x) * sigmoid_f(v0[0]); v0[1] = bfhi(gw.x) * sigmoid_f(v0[1]); v0[2] = bflo(gw.y) * sigmoid_f(v0[2]); v0[3] = bfhi(gw.y) * sigmoid_f(v0[3]);
                        v1[0] = bflo(gw.z) * sigmoid_f(v1[0]); v1[1] = bfhi(gw.z) * sigmoid_f(v1[1]); v1[2] = bflo(gw.w) * sigmoid_f(v1[2]); v1[3] = bfhi(gw.w) * sigmoid_f(v1[3]);
                    }
                    v4u w; w.x = pk2(v0[0], v0[1]); w.y = pk2(v0[2], v0[3]); w.z = pk2(v1[0], v1[1]); w.w = pk2(v1[2], v1[3]);
                    *(v4u*)(O + roff + bj * 128) = w;
                }
            }
    }
};
struct EpiResid {
    static constexpr bool PERM = false, AFTER_DRAIN = false;
    const float* H; float* R;
    __device__ __forceinline__ void operator()(const pg8::f32x4 (&acc)[2][2][4][2], const pg8::Unit& u, int wr, int wc, int fr_, int fq_) const {
        int fr = fr_, fq = fq_; asm volatile("" : "+v"(fr), "+v"(fq));
        const int row0 = u.pm * 256 + wr * 64 + fr, col0 = u.pn * 256 + wc * 32 + 4 * fq;
#pragma unroll
        for (int ai = 0; ai < 2; ++ai)
#pragma unroll
            for (int m = 0; m < 4; ++m) {
                const size_t roff = (size_t)(row0 + ai * 128 + m * 16) * D + col0;
#pragma unroll
                for (int bj = 0; bj < 2; ++bj)
#pragma unroll
                    for (int n = 0; n < 2; ++n) {
                        const f32x4 hv = *(const f32x4*)(H + roff + bj * 128 + n * 16);
                        *(f32x4*)(R + roff + bj * 128 + n * 16) = hv * ALPHA + acc[ai][bj][m][n];
                    }
            }
    }
};
struct EpiSsdProj {
    static constexpr bool PERM = true, AFTER_DRAIN = false;
    bf16* Z; bf16* XBC; float* DT;
    __device__ __forceinline__ void operator()(const pg8::f32x4 (&acc)[2][2][4][2], const pg8::Unit& u, int wr, int wc, int fr_, int fq_) const {
        int fr = fr_, fq = fq_; asm volatile("" : "+v"(fr), "+v"(fq));
        const int row0 = u.pm * 256 + wr * 64 + fr, col0 = u.pn * 256 + wc * 32 + 8 * fq;
#pragma unroll
        for (int ai = 0; ai < 2; ++ai)
#pragma unroll
            for (int m = 0; m < 4; ++m) {
                const size_t row = (size_t)(row0 + ai * 128 + m * 16);
#pragma unroll
                for (int bj = 0; bj < 2; ++bj) {
                    const f32x4 v0 = acc[ai][bj][m][0], v1 = acc[ai][bj][m][1];
                    const int col = col0 + bj * 128;
                    if (u.pn < 20) {
                        v4u w; w.x = pk2(v0[0], v0[1]); w.y = pk2(v0[2], v0[3]); w.z = pk2(v1[0], v1[1]); w.w = pk2(v1[2], v1[3]);
                        if (u.pn < 8) *(v4u*)(Z + row * 2048 + col) = w; else *(v4u*)(XBC + row * CONVD + (col - 2048)) = w;
                    } else if (col - 5120 < 32) {
                        *(f32x4*)(DT + row * 32 + (col - 5120)) = v0; *(f32x4*)(DT + row * 32 + (col - 5120) + 4) = v1;
                    }
                }
            }
    }
};

struct Ctx {
    const float* const* in; float* out; unsigned char* ws; LAS unsigned char* lds;
    int tid, lane, wave, gw, NGW, gt, NGT;
    template <class Tp> __device__ __forceinline__ Tp* W(size_t off) const { return (Tp*)(ws + off); }
};

template <class Epi> __device__ __forceinline__ void run_gemm(const Ctx& c, const bf16* A, int lda, int a_pn_off, const bf16* Bt, int N, int K, const Epi& E) {
    pg8::Gemm g{A, Bt, T, N, K, lda, a_pn_off};
    pg8::StaticOrder S; S.init(T, N, (int)gridDim.x, (int)blockIdx.x);
    pg8::gemm_phase<Epi, pg8::StaticOrder, false, false>(c.lds, g, S, E, c.tid);
}

__device__ __forceinline__ void transpose_item(const float* __restrict__ Wm, int K, int N, bf16* WT, LAS float* scr, int item, int lane) {
    const int nblk = N / 32, kb = item / nblk, nb = item % nblk, k0 = 64 * kb, n0 = 32 * nb;
#pragma unroll 8
    for (int i = 0; i < 32; ++i) { const int kk = 2 * i + (lane >> 5); scr[kk * 33 + (lane & 31)] = Wm[(size_t)(k0 + kk) * N + n0 + (lane & 31)]; }
    asm volatile("s_waitcnt lgkmcnt(0)" ::: "memory");
    const int cc = lane & 7;
#pragma unroll
    for (int j = 0; j < 4; ++j) {
        const int n = (lane >> 3) + 8 * j; const LAS float* s = scr + (8 * cc) * 33 + n;
        v4u o; o.x = pk2(s[0 * 33], s[1 * 33]); o.y = pk2(s[2 * 33], s[3 * 33]); o.z = pk2(s[4 * 33], s[5 * 33]); o.w = pk2(s[6 * 33], s[7 * 33]);
        *(v4u*)(WT + (size_t)(n0 + n) * K + k0 + 8 * cc) = o;
    }
    asm volatile("s_waitcnt lgkmcnt(0)" ::: "memory");
}
__device__ __forceinline__ void transpose_mat(const Ctx& c, const float* Wm, int K, int N, bf16* WT) {
    LAS float* scr = (LAS float*)(c.lds + c.wave * 16384);
    const int nitems = (K / 64) * (N / 32);
    for (int it = c.gw; it < nitems; it += c.NGW) transpose_item(Wm, K, N, WT, scr, it, c.lane);
}
__device__ __forceinline__ void cvt_copy(const Ctx& c, const float* __restrict__ src, bf16* dst, size_t n) {
    for (size_t i = (size_t)c.gt * 8; i < n; i += (size_t)c.NGT * 8) {
        const f32x4 a = *(const f32x4*)(src + i), b = *(const f32x4*)(src + i + 4);
        v4u w; w.x = pk2(a[0], a[1]); w.y = pk2(a[2], a[3]); w.z = pk2(b[0], b[1]); w.w = pk2(b[2], b[3]);
        *(v4u*)(dst + i) = w;
    }
}
__device__ __forceinline__ void cvt_tables(const Ctx& c, int layer) {
    cvt_copy(c, c.in[44] + (size_t)layer * 16384 * D, c.W<bf16>(WS_EU), (size_t)16384 * D);
    cvt_copy(c, c.in[45] + (size_t)layer * 16384 * D, c.W<bf16>(WS_EV), (size_t)16384 * D);
}
__device__ __forceinline__ void prologue(const Ctx& c) {
    transpose_mat(c, c.in[7], 1024, 1024, c.W<bf16>(WS_W_S5IN));
    transpose_mat(c, c.in[16], 1024, 1024, c.W<bf16>(WS_W_S5GLU));
    transpose_mat(c, c.in[18], 1024, 1024, c.W<bf16>(WS_W_S5OUT));
    transpose_mat(c, c.in[19], 1024, 1024, c.W<bf16>(WS_W_PIN));
    for (int g = 0; g < 4; ++g) transpose_mat(c, c.in[20] + (size_t)g * 65536, 256, 256, c.W<bf16>(WS_W_PGRP) + (size_t)g * 65536);
    transpose_mat(c, c.in[22], 1024, 1024, c.W<bf16>(WS_W_POUT));
    transpose_mat(c, c.in[23], 1024, 2048, c.W<bf16>(WS_W_CIN));
    transpose_mat(c, c.in[29], 1024, 1024, c.W<bf16>(WS_W_COUT));
    transpose_mat(c, c.in[30], 1024, 5152, c.W<bf16>(WS_W_SIN));
    transpose_mat(c, c.in[37], 2048, 1024, c.W<bf16>(WS_W_SOUT));
    for (int l = 0; l < 4; ++l) transpose_mat(c, c.in[42] + (size_t)l * 1024 * 2048, 1024, 2048, c.W<bf16>(WS_W_PQ) + (size_t)l * 2048 * 1024);
    {
        v4u* z = (v4u*)(c.W<bf16>(WS_W_SIN) + (size_t)5152 * 1024);
        for (int i = c.gt; i < 224 * 1024 / 8; i += c.NGT) z[i] = (v4u){0u, 0u, 0u, 0u};
    }
    cvt_copy(c, c.in[43], c.W<bf16>(WS_KEYS), (size_t)4 * 8 * 2 * 128 * 128);
    {
        float* H = c.W<float>(WS_H32); bf16* HB = c.W<bf16>(WS_HB);
        for (size_t i = (size_t)c.gt * 8; i < (size_t)T * D; i += (size_t)c.NGT * 8) {
            const float* src = (i < (size_t)TP * D) ? (c.in[0] + i) : (c.in[1] + (i - (size_t)TP * D));
            const f32x4 a = *(const f32x4*)(src), b = *(const f32x4*)(src + 4);
            *(f32x4*)(H + i) = a; *(f32x4*)(H + i + 4) = b;
            v4u w; w.x = pk2(a[0], a[1]); w.y = pk2(a[2], a[3]); w.z = pk2(b[0], b[1]); w.w = pk2(b[2], b[3]);
            *(v4u*)(HB + i) = w;
        }
    }
    if (c.gt < 4096) {
        const int gp = c.gt, g = gp >> 6;
        float* sm = c.W<float>(WS_SMALL);
        const float dt = expf(c.in[10][g]);
        const float lr = c.in[8][gp], li = c.in[9][gp];
        const float mag = expf(lr * dt);
        const float br = mag * cosf(li * dt), bi = mag * sinf(li * dt);
        const float den = lr * lr + li * li;
        const float fr = ((br - 1.f) * lr + bi * li) / den, fi = (bi * lr - (br - 1.f) * li) / den;
        sm[SM_LBR + gp] = br; sm[SM_LBI + gp] = bi;
        for (int i = 0; i < 16; ++i) {
            const float xr = c.in[11][gp * 16 + i], xi = c.in[12][gp * 16 + i];
            sm[SM_BBR + gp * 16 + i] = fr * xr - fi * xi; sm[SM_BBI + gp * 16 + i] = fr * xi + fi * xr;
        }
    }
    cvt_tables(c, 0);
}

__device__ __forceinline__ void ln_row_store(const f32x4 (&v)[4], float mean, float rstd, const float* __restrict__ g, const float* __restrict__ b, float* o32, bf16* ob, int lane) {
#pragma unroll
    for (int h = 0; h < 2; ++h) {
        const int c0 = h * 512 + 8 * lane;
        const f32x4 g0 = *(const f32x4*)(g + c0), g1 = *(const f32x4*)(g + c0 + 4), b0 = *(const f32x4*)(b + c0), b1 = *(const f32x4*)(b + c0 + 4);
        const f32x4 o0 = (v[2 * h] - mean) * rstd * g0 + b0, o1 = (v[2 * h + 1] - mean) * rstd * g1 + b1;
        *(f32x4*)(o32 + c0) = o0; *(f32x4*)(o32 + c0 + 4) = o1;
        if (ob) { v4u w; w.x = pk2(o0[0], o0[1]); w.y = pk2(o0[2], o0[3]); w.z = pk2(o1[0], o1[1]); w.w = pk2(o1[2], o1[3]); *(v4u*)(ob + c0) = w; }
    }
}
__device__ __forceinline__ void ln_stats(const f32x4 (&v)[4], float& mean, float& rstd, int lane) {
    float s = 0.f;
#pragma unroll
    for (int k = 0; k < 4; ++k) s += (v[k][0] + v[k][1]) + (v[k][2] + v[k][3]);
    mean = wave_sum(s, lane) * (1.f / D);
    float q = 0.f;
#pragma unroll
    for (int k = 0; k < 4; ++k) { const f32x4 d = v[k] - mean; q += (d[0] * d[0] + d[1] * d[1]) + (d[2] * d[2] + d[3] * d[3]); }
    rstd = rsqrtf(wave_sum(q, lane) * (1.f / D) + LN_EPS);
}
__device__ __forceinline__ void phase_ln1(const Ctx& c, int layer) {
    const float* R = c.W<float>(WS_R32); float* H = c.W<float>(WS_H32); bf16* HB = c.W<bf16>(WS_HB);
    const float* g = c.in[38] + layer * D; const float* b = c.in[39] + layer * D;
    for (int t = c.gw; t < T; t += c.NGW) {
        f32x4 v[4];
#pragma unroll
        for (int h = 0; h < 2; ++h) { v[2 * h] = *(const f32x4*)(R + (size_t)t * D + h * 512 + 8 * c.lane); v[2 * h + 1] = *(const f32x4*)(R + (size_t)t * D + h * 512 + 8 * c.lane + 4); }
        float mean, rstd; ln_stats(v, mean, rstd, c.lane);
        ln_row_store(v, mean, rstd, g, b, H + (size_t)t * D, HB + (size_t)t * D, c.lane);
    }
}

__device__ __forceinline__ void phase_s5scan(const Ctx& c) {
    const bf16* U = c.W<bf16>(WS_A0); bf16* G = c.W<bf16>(WS_A1);
    const float* sm = c.W<float>(WS_SMALL);
    float* out = c.out;
    float* o_re_p = out + 17825792, *o_im_p = o_re_p + 32768, *o_re_s = out + 17825792 + 32768 * 2 + 122880 + 73728 + 2097152, *o_im_s = o_re_s + 524288;
    const int p = c.lane;
    const int wslot = c.wave * (int)gridDim.x + (int)blockIdx.x;
    for (int unit = wslot; unit < 136 * 64; unit += c.NGW) {
        const int s = unit >> 6, g = unit & 63;
        int tok0, L; seq_info(s, tok0, L);
        float br[16], bi[16], cr[16], ci[16];
#pragma unroll
        for (int i = 0; i < 16; ++i) {
            br[i] = sm[SM_BBR + (g * 64 + p) * 16 + i]; bi[i] = sm[SM_BBI + (g * 64 + p) * 16 + i];
            cr[i] = c.in[13][(g * 16 + i) * 64 + p]; ci[i] = c.in[14][(g * 16 + i) * 64 + p];
        }
        const float lr = sm[SM_LBR + g * 64 + p], li = sm[SM_LBI + g * 64 + p];
        float hr = 0.f, hi = 0.f;
        if (s >= 8) { hr = c.in[2][((s - 8) * 64 + g) * 64 + p]; hi = c.in[3][((s - 8) * 64 + g) * 64 + p]; }
        const int io = (p >> 2) & 15;
        const float dk = c.in[15][g * 16 + io];
        const bf16* up = U + (size_t)tok0 * D + g * 16;
        v4u ua = *(const v4u*)(up), ub = *(const v4u*)(up + 8);
        for (int t = 0; t < L; ++t) {
            const v4u ca = ua, cb = ub;
            if (t + 1 < L) { ua = *(const v4u*)(up + (size_t)(t + 1) * D); ub = *(const v4u*)(up + (size_t)(t + 1) * D + 8); }
            float uv[16];
            uv[0] = bflo(ca.x); uv[1] = bfhi(ca.x); uv[2] = bflo(ca.y); uv[3] = bfhi(ca.y); uv[4] = bflo(ca.z); uv[5] = bfhi(ca.z); uv[6] = bflo(ca.w); uv[7] = bfhi(ca.w);
            uv[8] = bflo(cb.x); uv[9] = bfhi(cb.x); uv[10] = bflo(cb.y); uv[11] = bfhi(cb.y); uv[12] = bflo(cb.z); uv[13] = bfhi(cb.z); uv[14] = bflo(cb.w); uv[15] = bfhi(cb.w);
            float bur = 0.f, bui = 0.f;
#pragma unroll
            for (int i = 0; i < 16; ++i) { bur += uv[i] * br[i]; bui += uv[i] * bi[i]; }
            const float nr = lr * hr - li * hi + bur, ni = lr * hi + li * hr + bui;
            hr = nr; hi = ni;
            float pv[16];
#pragma unroll
            for (int i = 0; i < 16; ++i) pv[i] = hr * cr[i] - hi * ci[i];
            const float tot = reduce16(pv, p);
            float usel = uv[0];
#pragma unroll
            for (int i = 1; i < 16; ++i) usel = (io == i) ? uv[i] : usel;
            if ((p & 3) == 0) G[(size_t)(tok0 + t) * D + g * 16 + io] = (bf16)f2bf(gelu_f(tot + dk * usel));
        }
        if (s < 8) { o_re_p[(s * 64 + g) * 64 + p] = hr; o_im_p[(s * 64 + g) * 64 + p] = hi; }
        else { o_re_s[((s - 8) * 64 + g) * 64 + p] = hr; o_im_s[((s - 8) * 64 + g) * 64 + p] = hi; }
    }
}

__device__ __forceinline__ void phase_pool(const Ctx& c) {
    const bf16* U = c.W<bf16>(WS_A0); bf16* P = c.W<bf16>(WS_A1);
    float* o_p = c.out + 17825792 + 65536, *o_s = c.out + 17825792 + 65536 + 122880 + 73728 + 2097152 + 1048576;
    for (size_t i = (size_t)c.gt; i < (size_t)T * 128; i += (size_t)c.NGT) {
        const int t = (int)(i >> 7), c0 = (int)(i & 127) * 8;
        int s, l, tok0; tok_info(t, s, l, tok0);
        const int w = 2 << (c0 >> 8);
        float sum[8];
#pragma unroll
        for (int j = 0; j < 8; ++j) sum[j] = 0.f;
        float cur[8];
        for (int k = 0; k < w; ++k) {
            const int ll = l - k;
            if (ll >= 0) {
                const v4u q = *(const v4u*)(U + (size_t)(tok0 + ll) * D + c0);
                const float f[8] = {bflo(q.x), bfhi(q.x), bflo(q.y), bfhi(q.y), bflo(q.z), bfhi(q.z), bflo(q.w), bfhi(q.w)};
#pragma unroll
                for (int j = 0; j < 8; ++j) { sum[j] += f[j]; if (k == 0) cur[j] = f[j]; }
            } else if (s >= 8) {
                const float* sp = c.in[4] + ((size_t)(s - 8) * 15 + (15 + ll)) * D + c0;
                const f32x4 a = *(const f32x4*)sp, b = *(const f32x4*)(sp + 4);
                sum[0] += a[0]; sum[1] += a[1]; sum[2] += a[2]; sum[3] += a[3]; sum[4] += b[0]; sum[5] += b[1]; sum[6] += b[2]; sum[7] += b[3];
            }
        }
        const int pos = (s >= 8 ? 16384 : 0) + l;
        const float inv = 1.f / (float)min(pos + 1, w);
        v4u o; o.x = pk2(sum[0] * inv - cur[0], sum[1] * inv - cur[1]); o.y = pk2(sum[2] * inv - cur[2], sum[3] * inv - cur[3]);
        o.z = pk2(sum[4] * inv - cur[4], sum[5] * inv - cur[5]); o.w = pk2(sum[6] * inv - cur[6], sum[7] * inv - cur[7]);
        *(v4u*)(P + (size_t)t * D + c0) = o;
    }
    for (size_t i = (size_t)c.gt; i < (size_t)136 * 15 * D; i += (size_t)c.NGT) {
        const int ch = (int)(i & 1023); const int j = (int)((i >> 10) % 15); const int s = (int)(i / (15 * 1024));
        if (s < 8) o_p[((size_t)s * 15 + j) * D + ch] = bf2f(U[(size_t)(s * 2048 + 2033 + j) * D + ch]);
        else { const int b = s - 8; o_s[((size_t)b * 15 + j) * D + ch] = (j < 7) ? c.in[4][((size_t)b * 15 + 8 + j) * D + ch] : bf2f(U[(size_t)(TP + b * 8 + (j - 7)) * D + ch]); }
    }
}

__device__ __forceinline__ void phase_cmlp_ln(const Ctx& c) {
    bf16* Z = c.W<bf16>(WS_Q);
    float* o_v = c.out + 17825792 + 65536 + 122880 + 73728 + 2097152 + 1048576 + 1966080;
    const float* g = c.in[25]; const float* b = c.in[26];
    for (int t = c.gw; t < T; t += c.NGW) {
        bf16* vr = Z + (size_t)t * 2048 + 1024;
        f32x4 v[4];
#pragma unroll
        for (int h = 0; h < 2; ++h) {
            const v4u q = *(const v4u*)(vr + h * 512 + 8 * c.lane);
            v[2 * h] = (f32x4){bflo(q.x), bfhi(q.x), bflo(q.y), bfhi(q.y)}; v[2 * h + 1] = (f32x4){bflo(q.z), bfhi(q.z), bflo(q.w), bfhi(q.w)};
        }
        float mean, rstd; ln_stats(v, mean, rstd, c.lane);
#pragma unroll
        for (int h = 0; h < 2; ++h) {
            const int c0 = h * 512 + 8 * c.lane;
            const f32x4 g0 = *(const f32x4*)(g + c0), g1 = *(const f32x4*)(g + c0 + 4), b0 = *(const f32x4*)(b + c0), b1 = *(const f32x4*)(b + c0 + 4);
            const f32x4 o0 = (v[2 * h] - mean) * rstd * g0 + b0, o1 = (v[2 * h + 1] - mean) * rstd * g1 + b1;
            v4u w; w.x = pk2(o0[0], o0[1]); w.y = pk2(o0[2], o0[3]); w.z = pk2(o1[0], o1[1]); w.w = pk2(o1[2], o1[3]);
            *(v4u*)(vr + c0) = w;
            if (t >= TP) { *(f32x4*)(o_v + (size_t)(t - TP) * D + c0) = o0; *(f32x4*)(o_v + (size_t)(t - TP) * D + c0 + 4) = o1; }
        }
    }
}
__device__ __forceinline__ void phase_cmlp_mix(const Ctx& c) {
    const bf16* Z = c.W<bf16>(WS_Q); bf16* O = c.W<bf16>(WS_A1);
    for (size_t i = (size_t)c.gt; i < (size_t)T * 128; i += (size_t)c.NGT) {
        const int t = (int)(i >> 7), c0 = (int)(i & 127) * 8;
        int s, l, tok0; tok_info(t, s, l, tok0);
        const int hd = c0 >> 8, tp = (s < 8) ? (l & 127) : l, base = t - tp;
        float acc[8];
        const float bs = c.in[28][hd * 128 + tp];
#pragma unroll
        for (int j = 0; j < 8; ++j) acc[j] = bs;
        const float* wr = c.in[27] + ((size_t)hd * 128 + tp) * 128;
        for (int sp = 0; sp <= tp; ++sp) {
            const float w = wr[sp];
            const v4u q = *(const v4u*)(Z + (size_t)(base + sp) * 2048 + 1024 + c0);
            acc[0] += w * bflo(q.x); acc[1] += w * bfhi(q.x); acc[2] += w * bflo(q.y); acc[3] += w * bfhi(q.y);
            acc[4] += w * bflo(q.z); acc[5] += w * bfhi(q.z); acc[6] += w * bflo(q.w); acc[7] += w * bfhi(q.w);
        }
        const v4u uq = *(const v4u*)(Z + (size_t)t * 2048 + c0);
        v4u o; o.x = pk2(bflo(uq.x) * acc[0], bfhi(uq.x) * acc[1]); o.y = pk2(bflo(uq.y) * acc[2], bfhi(uq.y) * acc[3]);
        o.z = pk2(bflo(uq.z) * acc[4], bfhi(uq.z) * acc[5]); o.w = pk2(bflo(uq.w) * acc[6], bfhi(uq.w) * acc[7]);
        *(v4u*)(O + (size_t)t * D + c0) = o;
    }
}

__device__ __forceinline__ void phase_ssd_conv(const Ctx& c) {
    const bf16* X = c.W<bf16>(WS_XBC); bf16* XC = c.W<bf16>(WS_XC);
    float* o_p = c.out + 17825792 + 65536 + 122880, *o_s = c.out + 17825792 + 65536 + 122880 + 73728 + 2097152 + 1048576 + 1966080 + 1048576;
    for (size_t i = (size_t)c.gt; i < (size_t)T * (CONVD / 8); i += (size_t)c.NGT) {
        const int t = (int)(i / (CONVD / 8)), c0 = (int)(i % (CONVD / 8)) * 8;
        int s, l, tok0; tok_info(t, s, l, tok0);
        float acc[8];
        { const f32x4 a = *(const f32x4*)(c.in[32] + c0), b = *(const f32x4*)(c.in[32] + c0 + 4); acc[0] = a[0]; acc[1] = a[1]; acc[2] = a[2]; acc[3] = a[3]; acc[4] = b[0]; acc[5] = b[1]; acc[6] = b[2]; acc[7] = b[3]; }
#pragma unroll
        for (int k = 0; k < 4; ++k) {
            const int src = l + k - 3;
            float f[8];
            if (src >= 0) {
                const v4u q = *(const v4u*)(X + (size_t)(tok0 + src) * CONVD + c0);
                f[0] = bflo(q.x); f[1] = bfhi(q.x); f[2] = bflo(q.y); f[3] = bfhi(q.y); f[4] = bflo(q.z); f[5] = bfhi(q.z); f[6] = bflo(q.w); f[7] = bfhi(q.w);
            } else if (s >= 8) {
                const float* sp = c.in[5] + ((size_t)(s - 8) * 3 + (l + k)) * CONVD + c0;
                const f32x4 a = *(const f32x4*)sp, b = *(const f32x4*)(sp + 4);
                f[0] = a[0]; f[1] = a[1]; f[2] = a[2]; f[3] = a[3]; f[4] = b[0]; f[5] = b[1]; f[6] = b[2]; f[7] = b[3];
            } else {
#pragma unroll
                for (int j = 0; j < 8; ++j) f[j] = 0.f;
            }
            const f32x4 wa = *(const f32x4*)(c.in[31] + k * CONVD + c0), wb = *(const f32x4*)(c.in[31] + k * CONVD + c0 + 4);
            acc[0] += f[0] * wa[0]; acc[1] += f[1] * wa[1]; acc[2] += f[2] * wa[2]; acc[3] += f[3] * wa[3];
            acc[4] += f[4] * wb[0]; acc[5] += f[5] * wb[1]; acc[6] += f[6] * wb[2]; acc[7] += f[7] * wb[3];
        }
        v4u o; o.x = pk2(silu_f(acc[0]), silu_f(acc[1])); o.y = pk2(silu_f(acc[2]), silu_f(acc[3])); o.z = pk2(silu_f(acc[4]), silu_f(acc[5])); o.w = pk2(silu_f(acc[6]), silu_f(acc[7]));
        *(v4u*)(XC + (size_t)t * CONVD + c0) = o;
    }
    for (size_t i = (size_t)c.gt; i < (size_t)136 * 3 * CONVD; i += (size_t)c.NGT) {
        const int ch = (int)(i % CONVD); const int j = (int)((i / CONVD) % 3); const int s = (int)(i / (3 * CONVD));
        if (s < 8) o_p[((size_t)s * 3 + j) * CONVD + ch] = bf2f(X[(size_t)(s * 2048 + 2045 + j) * CONVD + ch]);
        else { const int b = s - 8; o_s[((size_t)b * 3 + j) * CONVD + ch] = bf2f(X[(size_t)(TP + b * 8 + 5 + j) * CONVD + ch]); }
    }
}
__device__ __forceinline__ void phase_ssd_scan(const Ctx& c) {
    const bf16* XC = c.W<bf16>(WS_XC); const float* DT = c.W<float>(WS_DT); bf16* Y = c.W<bf16>(WS_Y);
    float* o_p = c.out + 17825792 + 65536 + 122880 + 73728;
    float* o_s = c.out + 17825792 + 65536 + 122880 + 73728 + 2097152 + 1048576 + 1966080 + 1048576 + 1179648;
    const int p = c.tid >> 3, nq = c.tid & 7;
    for (int unit = (int)blockIdx.x; unit < 136 * 32; unit += (int)gridDim.x) {
        const int s = unit >> 5, hd = unit & 31, g = hd >> 3;
        int tok0, L; seq_info(s, tok0, L);
        float h[16];
        if (s >= 8) {
            const float* sp = c.in[6] + (((size_t)(s - 8) * 32 + hd) * 64 + p) * 128 + nq * 16;
#pragma unroll
            for (int i = 0; i < 4; ++i) { const f32x4 a = *(const f32x4*)(sp + 4 * i); h[4 * i] = a[0]; h[4 * i + 1] = a[1]; h[4 * i + 2] = a[2]; h[4 * i + 3] = a[3]; }
        } else {
#pragma unroll
            for (int i = 0; i < 16; ++i) h[i] = 0.f;
        }
        const float a = -expf(c.in[34][hd]), dtb = c.in[33][hd], dk = c.in[35][hd];
        const bf16* xb = XC + (size_t)tok0 * CONVD;
        v4u nB0 = *(const v4u*)(xb + 2048 + g * 128 + nq * 16), nB1 = *(const v4u*)(xb + 2048 + g * 128 + nq * 16 + 8);
        v4u nC0 = *(const v4u*)(xb + 2560 + g * 128 + nq * 16), nC1 = *(const v4u*)(xb + 2560 + g * 128 + nq * 16 + 8);
        float nx = bf2f(xb[hd * 64 + p]); float ndt = DT[(size_t)tok0 * 32 + hd];
        for (int t = 0; t < L; ++t) {
            const v4u B0 = nB0, B1 = nB1, C0 = nC0, C1 = nC1; const float xv = nx, dr = ndt + dtb;
            if (t + 1 < L) {
                const bf16* xn = xb + (size_t)(t + 1) * CONVD;
                nB0 = *(const v4u*)(xn + 2048 + g * 128 + nq * 16); nB1 = *(const v4u*)(xn + 2048 + g * 128 + nq * 16 + 8);
                nC0 = *(const v4u*)(xn + 2560 + g * 128 + nq * 16); nC1 = *(const v4u*)(xn + 2560 + g * 128 + nq * 16 + 8);
                nx = bf2f(xn[hd * 64 + p]); ndt = DT[(size_t)(tok0 + t + 1) * 32 + hd];
            }
            const float dtv = (dr > 20.f) ? dr : log1pf(__expf(dr));
            const float dA = __expf(dtv * a), coef = dtv * xv;
            const float Bf[16] = {bflo(B0.x), bfhi(B0.x), bflo(B0.y), bfhi(B0.y), bflo(B0.z), bfhi(B0.z), bflo(B0.w), bfhi(B0.w), bflo(B1.x), bfhi(B1.x), bflo(B1.y), bfhi(B1.y), bflo(B1.z), bfhi(B1.z), bflo(B1.w), bfhi(B1.w)};
            const float Cf[16] = {bflo(C0.x), bfhi(C0.x), bflo(C0.y), bfhi(C0.y), bflo(C0.z), bfhi(C0.z), bflo(C0.w), bfhi(C0.w), bflo(C1.x), bfhi(C1.x), bflo(C1.y), bfhi(C1.y), bflo(C1.z), bfhi(C1.z), bflo(C1.w), bfhi(C1.w)};
            float yp = 0.f;
#pragma unroll
            for (int i = 0; i < 16; ++i) { h[i] = h[i] * dA + coef * Bf[i]; yp += Cf[i] * h[i]; }
            yp += shx(yp, 1, c.lane); yp += shx(yp, 2, c.lane); yp += shx(yp, 4, c.lane);
            if (nq == 0) Y[(size_t)(tok0 + t) * 2048 + hd * 64 + p] = (bf16)f2bf(yp + dk * xv);
        }
        float* op = ((s < 8) ? (o_p + (((size_t)s * 32 + hd) * 64 + p) * 128) : (o_s + (((size_t)(s - 8) * 32 + hd) * 64 + p) * 128)) + nq * 16;
#pragma unroll
        for (int i = 0; i < 4; ++i) *(f32x4*)(op + 4 * i) = (f32x4){h[4 * i], h[4 * i + 1], h[4 * i + 2], h[4 * i + 3]};
    }
}
__device__ __forceinline__ void phase_ssd_gatenorm(const Ctx& c) {
    const bf16* Y = c.W<bf16>(WS_Y); const bf16* Z = c.W<bf16>(WS_Q); bf16* YN = c.W<bf16>(WS_YN);
    for (int it = c.gw; it < T * 4; it += c.NGW) {
        const int t = it >> 2, c0 = (it & 3) * 512 + 8 * c.lane;
        const v4u yq = *(const v4u*)(Y + (size_t)t * 2048 + c0), zq = *(const v4u*)(Z + (size_t)t * 2048 + c0);
        const float yf[8] = {bflo(yq.x), bfhi(yq.x), bflo(yq.y), bfhi(yq.y), bflo(yq.z), bfhi(yq.z), bflo(yq.w), bfhi(yq.w)};
        const float zf[8] = {bflo(zq.x), bfhi(zq.x), bflo(zq.y), bfhi(zq.y), bflo(zq.z), bfhi(zq.z), bflo(zq.w), bfhi(zq.w)};
        float v[8]; float q = 0.f;
#pragma unroll
        for (int j = 0; j < 8; ++j) { v[j] = yf[j] * silu_f(zf[j]); q += v[j] * v[j]; }
        const float r = rsqrtf(wave_sum(q, c.lane) * (1.f / 512.f) + RMS_EPS);
        const f32x4 g0 = *(const f32x4*)(c.in[36] + c0), g1 = *(const f32x4*)(c.in[36] + c0 + 4);
        v4u o; o.x = pk2(v[0] * r * g0[0], v[1] * r * g0[1]); o.y = pk2(v[2] * r * g0[2], v[3] * r * g0[3]); o.z = pk2(v[4] * r * g1[0], v[5] * r * g1[1]); o.w = pk2(v[6] * r * g1[2], v[7] * r * g1[3]);
        *(v4u*)(YN + (size_t)t * 2048 + c0) = o;
    }
}

__device__ __forceinline__ unsigned ord_key(float s) { const unsigned u = __builtin_bit_cast(unsigned, s); return (u & 0x80000000u) ? ~u : (u | 0x80000000u); }
__device__ __forceinline__ float ord_dec(unsigned k) { const unsigned u = (k & 0x80000000u) ? (k & 0x7fffffffu) : ~k; return __builtin_bit_cast(float, u); }
__device__ __forceinline__ void ins16(unsigned (&Lk)[16], unsigned x) {
#pragma unroll
    for (int k = 0; k < 16; ++k) { const unsigned hi = max(Lk[k], x); x = min(Lk[k], x); Lk[k] = hi; }
}
constexpr int RT_SC_LD = 260, RT_LIST_OFF = 128 * RT_SC_LD * 4;
__device__ __forceinline__ void phase_route(const Ctx& c, int layer) {
    const bf16* Q = c.W<bf16>(WS_Q); const bf16* KEYS = c.W<bf16>(WS_KEYS) + (size_t)layer * 8 * 2 * 128 * 128;
    int* IDX = c.W<int>(WS_IDX); float* GATE = c.W<float>(WS_GATE);
    LAS float* sc = (LAS float*)c.lds; LAS unsigned* lists = (LAS unsigned*)(c.lds + RT_LIST_OFF);
    const int fr = c.lane & 15, fq = c.lane >> 4;
    for (int task = (int)blockIdx.x; task < 136 * 8; task += (int)gridDim.x) {
        const int tt = task >> 3, h = task & 7, tok0 = tt * 128;
        {
            const bf16* qrow = Q + (size_t)(tok0 + 16 * c.wave + fr) * 2048 + h * 256 + 8 * fq;
#pragma unroll
            for (int side = 0; side < 2; ++side) {
                bf16x8 qf[4];
#pragma unroll
                for (int ks = 0; ks < 4; ++ks) qf[ks] = *(const bf16x8*)(qrow + side * 128 + ks * 32);
                const bf16* kb = KEYS + ((size_t)(h * 2 + side) * 128 + fr) * 128 + 8 * fq;
#pragma unroll
                for (int nt = 0; nt < 8; ++nt) {
                    f32x4 acc = {0.f, 0.f, 0.f, 0.f};
#pragma unroll
                    for (int ks = 0; ks < 4; ++ks) {
                        const bf16x8 kf = *(const bf16x8*)(kb + (size_t)nt * 16 * 128 + ks * 32);
                        acc = __builtin_amdgcn_mfma_f32_16x16x32_bf16(kf, qf[ks], acc, 0, 0, 0);
                    }
                    *(LAS f32x4*)(sc + (16 * c.wave + fr) * RT_SC_LD + side * 128 + nt * 16 + 4 * fq) = acc;
                }
            }
        }
        __syncthreads();
        if (c.tid < 256) {
            const int token = c.tid & 127, side = c.tid >> 7;
            unsigned Lk[16];
#pragma unroll
            for (int k = 0; k < 16; ++k) Lk[k] = 0u;
            const LAS float* row = sc + token * RT_SC_LD + side * 128;
            for (int n4 = 0; n4 < 32; ++n4) {
                const f32x4 v = *(const LAS f32x4*)(row + n4 * 4);
#pragma unroll
                for (int j = 0; j < 4; ++j) ins16(Lk, (ord_key(v[j]) & ~127u) | (unsigned)(127 - (n4 * 4 + j)));
            }
#pragma unroll
            for (int k = 0; k < 16; ++k) lists[(token * 2 + side) * 16 + k] = Lk[k];
        }
        __syncthreads();
        if (c.tid < 128) {
            const int token = c.tid;
            float s0[16], s1[16];
#pragma unroll
            for (int k = 0; k < 16; ++k) { s0[k] = ord_dec(lists[(token * 2) * 16 + k] & ~127u); s1[k] = ord_dec(lists[(token * 2 + 1) * 16 + k] & ~127u); }
            unsigned Bk[16];
#pragma unroll
            for (int k = 0; k < 16; ++k) Bk[k] = 0u;
#pragma unroll
            for (int i = 0; i < 16; ++i)
#pragma unroll
                for (int j = 0; j < 16; ++j)
                    if ((i + 1) * (j + 1) <= 16) ins16(Bk, (ord_key(s0[i] + s1[j]) & ~255u) | (unsigned)(255 - (i * 16 + j)));
            float e[16]; int id[16]; float mx = 0.f, den = 0.f;
#pragma unroll
            for (int k = 0; k < 16; ++k) {
                const int pay = 255 - (int)(Bk[k] & 255u), i = pay >> 4, j = pay & 15;
                const unsigned k0 = lists[(token * 2) * 16 + i], k1 = lists[(token * 2 + 1) * 16 + j];
                id[k] = (127 - (int)(k0 & 127u)) * 128 + (127 - (int)(k1 & 127u));
                const float sv = ord_dec(k0 & ~127u) + ord_dec(k1 & ~127u);
                if (k == 0) mx = sv;
                e[k] = __expf(sv - mx); den += e[k];
            }
            const float inv = 1.f / den;
            int* ip = IDX + (size_t)(tok0 + token) * 128 + h * 16; float* gp = GATE + (size_t)(tok0 + token) * 128 + h * 16;
#pragma unroll
            for (int k = 0; k < 4; ++k) {
                *(int4*)(ip + 4 * k) = make_int4(id[4 * k], id[4 * k + 1], id[4 * k + 2], id[4 * k + 3]);
                *(f32x4*)(gp + 4 * k) = (f32x4){e[4 * k] * inv, e[4 * k + 1] * inv, e[4 * k + 2] * inv, e[4 * k + 3] * inv};
            }
        }
        __syncthreads();
    }
}

__device__ __forceinline__ void phase_gather(const Ctx& c, int layer) {
    const bf16* EU = c.W<bf16>(WS_EU); const bf16* EV = c.W<bf16>(WS_EV); const bf16* HBr = c.W<bf16>(WS_HB);
    const int* IDX = c.W<int>(WS_IDX); const float* GATE = c.W<float>(WS_GATE);
    float* H = c.W<float>(WS_H32); bf16* HB = c.W<bf16>(WS_HB);
    const float* g = c.in[40] + layer * D; const float* b = c.in[41] + layer * D;
    const int lane = c.lane;
    for (int t = c.gw; t < T; t += c.NGW) {
        const v4u xa = *(const v4u*)(HBr + (size_t)t * D + 8 * lane), xb = *(const v4u*)(HBr + (size_t)t * D + 512 + 8 * lane);
        float acc[16];
#pragma unroll
        for (int i = 0; i < 16; ++i) acc[i] = 0.f;
        for (int bt = 0; bt < 8; ++bt) {
            const int myidx = IDX[(size_t)t * 128 + bt * 16 + (lane & 15)];
            const float mygate = GATE[(size_t)t * 128 + bt * 16 + ((lane >> 2) & 15)];
            float pv[16];
#pragma unroll
            for (int e = 0; e < 16; ++e) {
                const int id = __builtin_amdgcn_readlane(myidx, e);
                const bf16* row = EU + (size_t)id * D + 8 * lane;
                const v4u ua = *(const v4u*)(row), ub = *(const v4u*)(row + 512);
                float d0 = dot2(ua.x, xa.x, 0.f), d1 = dot2(ua.y, xa.y, 0.f);
                d0 = dot2(ua.z, xa.z, d0); d1 = dot2(ua.w, xa.w, d1);
                d0 = dot2(ub.x, xb.x, d0); d1 = dot2(ub.y, xb.y, d1);
                d0 = dot2(ub.z, xb.z, d0); d1 = dot2(ub.w, xb.w, d1);
                pv[e] = d0 + d1;
            }
            const float tot = reduce16(pv, lane);
            const float w = mygate * gelu_f(tot);
#pragma unroll
            for (int e = 0; e < 16; ++e) {
                const int id = __builtin_amdgcn_readlane(myidx, e);
                const float we = __builtin_bit_cast(float, __builtin_amdgcn_readlane(__builtin_bit_cast(int, w), 4 * e));
                const bf16* row = EV + (size_t)id * D + 8 * lane;
                const v4u va = *(const v4u*)(row), vb = *(const v4u*)(row + 512);
                acc[0] += we * bflo(va.x); acc[1] += we * bfhi(va.x); acc[2] += we * bflo(va.y); acc[3] += we * bfhi(va.y);
                acc[4] += we * bflo(va.z); acc[5] += we * bfhi(va.z); acc[6] += we * bflo(va.w); acc[7] += we * bfhi(va.w);
                acc[8] += we * bflo(vb.x); acc[9] += we * bfhi(vb.x); acc[10] += we * bflo(vb.y); acc[11] += we * bfhi(vb.y);
                acc[12] += we * bflo(vb.z); acc[13] += we * bfhi(vb.z); acc[14] += we * bflo(vb.w); acc[15] += we * bfhi(vb.w);
            }
        }
        f32x4 v[4];
#pragma unroll
        for (int hh = 0; hh < 2; ++hh) {
            const f32x4 h0 = *(const f32x4*)(H + (size_t)t * D + hh * 512 + 8 * lane), h1 = *(const f32x4*)(H + (size_t)t * D + hh * 512 + 8 * lane + 4);
            v[2 * hh] = h0 * ALPHA + (f32x4){acc[8 * hh], acc[8 * hh + 1], acc[8 * hh + 2], acc[8 * hh + 3]};
            v[2 * hh + 1] = h1 * ALPHA + (f32x4){acc[8 * hh + 4], acc[8 * hh + 5], acc[8 * hh + 6], acc[8 * hh + 7]};
        }
        float mean, rstd; ln_stats(v, mean, rstd, c.lane);
        if (layer == 3) ln_row_store(v, mean, rstd, g, b, c.out + (size_t)t * D, (bf16*)nullptr, lane);
        else ln_row_store(v, mean, rstd, g, b, H + (size_t)t * D, HB + (size_t)t * D, lane);
    }
}


#define XB_TMO      128
#define XB_XCNT(j)  (256  + 64 * (j))
#define XB_XSUB(j)  (1280 + 64 * (j))
#define XB_XGEN(j)  (2304 + 64 * (j))
#define XB_TOP      3328
#define XB_TOPGEN   3392
#define XCD_BAR_WORDS 3456
#define XB_SPIN_CAP (1u << 22)
__device__ __forceinline__ unsigned xb_ld(unsigned* p)              { return __hip_atomic_load(p, __ATOMIC_RELAXED, __HIP_MEMORY_SCOPE_AGENT); }
__device__ __forceinline__ unsigned xb_add(unsigned* p, unsigned v) { return __hip_atomic_fetch_add(p, v, __ATOMIC_RELAXED, __HIP_MEMORY_SCOPE_AGENT); }
__device__ __forceinline__ unsigned xb_xcc_id() { return (unsigned)__builtin_amdgcn_s_getreg((3 << 11) | 20) & 0xFu; }
#define XB_SPIN(cond, bar) do { unsigned _sp = 0; while (cond) { __builtin_amdgcn_s_sleep(1); \
    if ((++_sp & 255u) == 0u) { if (xb_ld(&(bar)[XB_TMO])) break; if (_sp > XB_SPIN_CAP) { atomicAdd(&(bar)[XB_TMO], 1u); break; } } } } while (0)
struct XcdBarrier { unsigned* bar; unsigned x; volatile LAS unsigned* st; };
__device__ __forceinline__ XcdBarrier xcd_barrier_post(unsigned* bar, volatile LAS unsigned* st) {
    XcdBarrier b; b.bar = bar; b.x = xb_xcc_id(); b.st = st;
    if (threadIdx.x == 0) (void)xb_add(&bar[XB_XCNT(b.x)], 1u);
    return b;
}
__device__ __forceinline__ void xcd_barrier_complete(unsigned* bar, unsigned x, unsigned& nloc, unsigned& nx) {
    const unsigned G = gridDim.x * gridDim.y * gridDim.z;
    unsigned sum, cnt, mine, sp = 0u;
    for (;;) {
        sum = 0u; cnt = 0u; mine = 0u;
#pragma unroll
        for (unsigned j = 0; j < 16; ++j) { const unsigned cc = xb_ld(&bar[XB_XCNT(j)]); sum += cc; cnt += (cc > 0u) ? 1u : 0u; mine = (j == x) ? cc : mine; }
        if (sum == G) break;
        __builtin_amdgcn_s_sleep(1);
        if ((++sp & 255u) == 0u) { if (xb_ld(&bar[XB_TMO])) break; if (sp > XB_SPIN_CAP) { atomicAdd(&bar[XB_TMO], 1u); break; } }
    }
    nloc = mine > 0u ? mine : 1u; nx = cnt > 0u ? cnt : 1u;
}
__device__ __forceinline__ void xcd_barrier(const XcdBarrier& b, int tid) {
    asm volatile("s_waitcnt vmcnt(0)" ::: "memory");
    __syncthreads();
    if (tid == 0) {
        unsigned* bar = b.bar;
        __builtin_amdgcn_s_waitcnt(0);
        unsigned nloc = b.st[0], nx = b.st[1];
        if (nloc == 0u) { xcd_barrier_complete(bar, b.x, nloc, nx); b.st[0] = nloc; b.st[1] = nx; }
        const unsigned old = xb_add(&bar[XB_XSUB(b.x)], 1u);
        const unsigned gen = old / nloc;
        if (old + 1u == (gen + 1u) * nloc) {
            __builtin_amdgcn_fence(__ATOMIC_RELEASE, "agent");
            asm volatile("s_waitcnt vmcnt(0)" ::: "memory");
            const unsigned og = xb_add(&bar[XB_TOP], 1u);
            const unsigned tg = og / nx;
            if (og + 1u == (tg + 1u) * nx) xb_add(&bar[XB_TOPGEN], 1u);
            else XB_SPIN(xb_ld(&bar[XB_TOPGEN]) == tg, bar);
            __builtin_amdgcn_fence(__ATOMIC_ACQUIRE, "agent");
            xb_add(&bar[XB_XGEN(b.x)], 1u);
            asm volatile("s_waitcnt vmcnt(0)" ::: "memory");
        } else {
            XB_SPIN(xb_ld(&bar[XB_XGEN(b.x)]) == gen, bar);
            __builtin_amdgcn_fence(__ATOMIC_ACQUIRE, "agent");
            asm volatile("s_waitcnt vmcnt(0)" ::: "memory");
        }
    }
    __syncthreads();
}

__global__ void __launch_bounds__(NTHR, 2) mega(Params P) {
    extern __shared__ __attribute__((aligned(16))) unsigned char lds_raw[];
    cg::grid_group grid = cg::this_grid();
    Ctx c;
    c.in = P.in; c.out = P.out; c.ws = P.ws; c.lds = (LAS unsigned char*)lds_raw;
    c.tid = threadIdx.x; c.lane = c.tid & 63; c.wave = __builtin_amdgcn_readfirstlane(c.tid >> 6);
    c.gw = (int)blockIdx.x * NWAVES + c.wave; c.NGW = (int)gridDim.x * NWAVES; c.gt = (int)blockIdx.x * NTHR + c.tid; c.NGT = (int)gridDim.x * NTHR;
#define RF() do { int z_ = 0; asm volatile("" : "+v"(z_)); const int l_ = (int)__builtin_amdgcn_mbcnt_hi(~0u, __builtin_amdgcn_mbcnt_lo(~0u, (unsigned)z_)); c.lane = l_; c.tid = c.wave * 64 + l_; c.gt = (int)blockIdx.x * NTHR + c.tid; } while (0)
    bf16* HB = c.W<bf16>(WS_HB); bf16* A0 = c.W<bf16>(WS_A0); bf16* A1 = c.W<bf16>(WS_A1); bf16* A2 = c.W<bf16>(WS_A2); bf16* Qb = c.W<bf16>(WS_Q);
    float* H32 = c.W<float>(WS_H32); float* R32 = c.W<float>(WS_R32);

    if (threadIdx.x < 16) ((volatile LAS unsigned*)(c.lds + MISC_OFF))[threadIdx.x] = 0u;
    __syncthreads();
    const XcdBarrier xbar = xcd_barrier_post(c.W<unsigned>(WS_CTL), (volatile LAS unsigned*)(c.lds + MISC_OFF));
#define GSYNC() do { RF(); xcd_barrier(xbar, c.tid); } while (0)
    RF(); prologue(c);
    grid.sync();
    for (int layer = 0; layer < 4; ++layer) {
        if (layer <= 1) {
            const bf16* Wt = c.W<bf16>(layer == 0 ? WS_W_S5IN : WS_W_PIN);
            RF(); run_gemm(c, HB, D, 0, Wt, 1024, 1024, EpiBf16<0>{A0, D, nullptr, nullptr, nullptr});
        } else if (layer == 2) {
            RF(); run_gemm(c, HB, D, 0, c.W<bf16>(WS_W_CIN), 2048, 1024, EpiBf16<1>{Qb, 2048, c.in[24], nullptr, nullptr});
        } else {
            RF(); run_gemm(c, HB, D, 0, c.W<bf16>(WS_W_SIN), NPROJ, 1024, EpiSsdProj{Qb, c.W<bf16>(WS_XBC), c.W<float>(WS_DT)});
        }
        GSYNC();
        const bf16* Aout = A2; const bf16* Wout;
        if (layer == 0) {
            RF(); phase_s5scan(c);
            GSYNC();
            RF(); run_gemm(c, A1, D, 0, c.W<bf16>(WS_W_S5GLU), 1024, 1024, EpiBf16<3>{A2, D, c.in[17], nullptr, A1});
            Wout = c.W<bf16>(WS_W_S5OUT);
        } else if (layer == 1) {
            RF(); phase_pool(c);
            GSYNC();
            RF(); run_gemm(c, A1, D, 256, c.W<bf16>(WS_W_PGRP), 1024, 256, EpiBf16<2>{A2, D, nullptr, c.in[21], nullptr});
            Wout = c.W<bf16>(WS_W_POUT);
        } else if (layer == 2) {
            RF(); phase_cmlp_ln(c);
            GSYNC();
            RF(); phase_cmlp_mix(c);
            Aout = A1; Wout = c.W<bf16>(WS_W_COUT);
        } else {
            RF(); phase_ssd_conv(c);
            GSYNC();
            RF(); phase_ssd_scan(c);
            GSYNC();
            RF(); phase_ssd_gatenorm(c);
            Aout = c.W<bf16>(WS_YN); Wout = c.W<bf16>(WS_W_SOUT);
        }
        GSYNC();
        if (layer == 3) { RF(); run_gemm(c, Aout, 2048, 0, Wout, 1024, 2048, EpiResid{H32, R32}); }
        else { RF(); run_gemm(c, Aout, 1024, 0, Wout, 1024, 1024, EpiResid{H32, R32}); }
        GSYNC();
        RF(); phase_ln1(c, layer);
        GSYNC();
        RF(); run_gemm(c, HB, D, 0, c.W<bf16>(WS_W_PQ) + (size_t)layer * 2048 * 1024, 2048, 1024, EpiBf16<0>{Qb, 2048, nullptr, nullptr, nullptr});
        GSYNC();
        RF(); phase_route(c, layer);
        RF(); if (layer > 0) cvt_tables(c, layer);
        GSYNC();
        RF(); phase_gather(c, layer);
        GSYNC();
    }
}
}

extern "C" void kernel_launch(void* const* d_in, const int* in_sizes, int n_in, void* d_out, int out_size, void* d_ws, size_t ws_size, hipStream_t stream) {
    static int grid = 0;
    if (grid == 0) {
        int dev = 0, cus = 0, per_cu = 0;
        if (hipGetDevice(&dev) != hipSuccess || hipDeviceGetAttribute(&cus, hipDeviceAttributeMultiprocessorCount, dev) != hipSuccess) { fprintf(stderr, "kernel_launch: device query failed\n"); grid = -1; return; }
        if (hipFuncSetAttribute((const void*)mk::mega, hipFuncAttributeMaxDynamicSharedMemorySize, mk::LDS_BYTES) != hipSuccess) { fprintf(stderr, "kernel_launch: hipFuncSetAttribute failed\n"); grid = -1; return; }
        if (hipOccupancyMaxActiveBlocksPerMultiprocessor(&per_cu, (const void*)mk::mega, mk::NTHR, mk::LDS_BYTES) != hipSuccess || per_cu < 1) { fprintf(stderr, "kernel_launch: occupancy query says %d blocks per CU\n", per_cu); grid = -1; return; }
        grid = cus;
        if (ws_size < mk::WS_END) { fprintf(stderr, "kernel_launch: workspace too small (%zu < %zu)\n", ws_size, (size_t)mk::WS_END); grid = -1; return; }
    }
    if (grid < 0) return;
    mk::Params p{};
    for (int i = 0; i < 46; ++i) p.in[i] = (const float*)d_in[i];
    p.out = (float*)d_out; p.ws = (unsigned char*)d_ws;
    if (hipMemsetAsync((char*)d_ws + mk::WS_CTL, 0, mk::CTL_BYTES, stream) != hipSuccess) { fprintf(stderr, "kernel_launch: memset failed\n"); return; }
    void* args[] = {&p};
    hipError_t e = hipLaunchCooperativeKernel((const void*)mk::mega, dim3(grid), dim3(mk::NTHR), args, mk::LDS_BYTES, stream);
    if (e != hipSuccess) fprintf(stderr, "cooperative launch failed: %s (grid %d)\n", hipGetErrorString(e), grid);
}
```

```cpp
#include <hip/hip_runtime.h>
#include <hip/hip_cooperative_groups.h>
#include <cstdio>
#include <cstdint>
#include <math.h>
namespace cg = cooperative_groups;

namespace pg8 {
#define PG8_LAS __attribute__((address_space(3)))
typedef unsigned short bf16_t;
typedef short bf16x8 __attribute__((ext_vector_type(8)));
typedef float f32x4 __attribute__((ext_vector_type(4)));
typedef unsigned u32x4 __attribute__((ext_vector_type(4)));
constexpr int BM = 256, BK = 64, HALF = 128, HTB = HALF * BK * 2, STAGE_BYTES = 8 * HTB, NXCD = 8, WGM = 8;
__host__ __device__ __forceinline__ int lds_byte(int r, int c) { const int st = (r >> 4) * 2 + (c >> 5), rr = r & 15, cc = c & 31, ob = rr * 64 + cc * 2; return st * 1024 + (ob ^ (((ob >> 9) & 1) << 5)); }
__host__ __device__ __forceinline__ void stage_rc(int b, int& R, int& C) { const int st = b / 1024, sb = b % 1024, swz = sb ^ (((sb >> 9) & 1) << 5); R = (st >> 1) * 16 + swz / 64; C = (st & 1) * 32 + (swz % 64) / 2; }
__host__ __device__ __forceinline__ int perm32(int rho) { const int n = rho >> 4, i = rho & 15; return 8 * (i >> 2) + 4 * n + (i & 3); }
struct Unit { int pm, pn; };
struct Gemm { const bf16_t* A; const bf16_t* Bt; int M, N, K, lda, a_pn_off; };
struct StaticOrder {
    int nM, nN, nwg, G, c;
    __host__ __device__ void init(int M, int N, int G_, int c_) { nM = M / BM; nN = N / BM; nwg = nM * nN; G = G_; c = c_; }
    __host__ __device__ bool next(int i, Unit& u) const {
        const long L = (long)i * G + c; if (L >= nwg) return false;
        int wgid = (int)L; { const int q = nwg / NXCD, r = nwg % NXCD, xcd = wgid % NXCD, off = wgid / NXCD; wgid = (xcd < r ? xcd * (q + 1) : r * (q + 1) + (xcd - r) * q) + off; }
        const int nig = WGM * nN, gid = wgid / nig, fm = gid * WGM, gsz = (nM - fm) < WGM ? (nM - fm) : WGM;
        u.pm = fm + ((wgid % nig) % gsz); u.pn = (wgid % nig) / gsz; return true;
    }
    __device__ __forceinline__ void a_ready(const Unit&) const {}
    __device__ __forceinline__ void done(const Unit&) const {}
};
__device__ __forceinline__ unsigned cvt_pk_bf16(float lo, float hi) { unsigned r; asm volatile("v_cvt_pk_bf16_f32 %0, %1, %2" : "=v"(r) : "v"(lo), "v"(hi)); return r; }
template <class Epi, class Sched, bool ALIGN_EPI = false, bool SP2 = false>
__device__ __forceinline__ void gemm_phase(PG8_LAS unsigned char* lds, const Gemm g, const Sched& S, const Epi& E, int tid_in) {
    int tid_ = tid_in; asm volatile("" : "+v"(tid_));
    const int tid = tid_, wid = __builtin_amdgcn_readfirstlane(tid >> 6), lane = tid & 63, wr = wid >> 2, wc = wid & 3, fr = lane & 15, fq = lane >> 4;
    const int K = g.K, nt = K / BK;
    unsigned voffA[2], voffB[2];
#pragma unroll
    for (int i = 0; i < 2; ++i) { int R, C; stage_rc(tid * 16 + i * 8192, R, C); const int Rb = Epi::PERM ? ((R & ~31) + perm32(R & 31)) : R;
        voffA[i] = (unsigned)(R * g.lda + C) * 2u; voffB[i] = (unsigned)(Rb * K + C) * 2u; }
    const size_t kstep = (size_t)(BK * 2);
    const size_t hstepA = (size_t)HALF * g.lda * 2, tstepA = 2 * hstepA;
    const size_t hstepB = (size_t)HALF * K * 2, tstepB = 2 * hstepB;
    const size_t apn = (size_t)g.a_pn_off * 2;
    const unsigned ldsw = (unsigned)wid * 1024u;
    const int aoff = lds_byte(wr * 64 + fr, fq * 8), boff = lds_byte(wc * 32 + fr, fq * 8);
#define PG8_SA(b, h) (((b) * 2 + (h)) * HTB)
#define PG8_SB(b, h) ((4 + (b) * 2 + (h)) * HTB)
#define PG8_STAGE(bufoff, gbase, voff) do { _Pragma("unroll") for (int _i = 0; _i < 2; ++_i) \
        __builtin_amdgcn_global_load_lds((const unsigned*)((const char*)(gbase) + (voff)[_i]), (PG8_LAS unsigned*)(lds + (bufoff) + ldsw + _i * 8192), 16, 0, 0); } while (0)
#define PG8_LDA(dst, b, h) do { _Pragma("unroll") for (int m = 0; m < 4; ++m) _Pragma("unroll") for (int k = 0; k < 2; ++k) dst[m][k] = *(const PG8_LAS bf16x8*)(lds + PG8_SA(b, h) + aoff + m * 2048 + k * 1024); } while (0)
#define PG8_LDB(dst, b, h) do { _Pragma("unroll") for (int n = 0; n < 2; ++n) _Pragma("unroll") for (int k = 0; k < 2; ++k) dst[n][k] = *(const PG8_LAS bf16x8*)(lds + PG8_SB(b, h) + boff + n * 2048 + k * 1024); } while (0)
#define PG8_MMA(ai, bj, At, Bt) do { __builtin_amdgcn_s_setprio(1); _Pragma("unroll") for (int m = 0; m < 4; ++m) _Pragma("unroll") for (int n = 0; n < 2; ++n) _Pragma("unroll") for (int k = 0; k < 2; ++k) \
        acc[ai][bj][m][n] = __builtin_amdgcn_mfma_f32_16x16x32_bf16(Bt[n][k], At[m][k], acc[ai][bj][m][n], 0, 0, 0); __builtin_amdgcn_s_setprio(0); } while (0)
#define PG8_WAIT_V(n) asm volatile("s_waitcnt vmcnt(" #n ")" ::: "memory")
#define PG8_WAIT_L(n) asm volatile("s_waitcnt lgkmcnt(" #n ")" ::: "memory")
#define PG8_BAR __builtin_amdgcn_s_barrier()
#define PG8_SCHED __builtin_amdgcn_sched_barrier(0)
    Unit cur, nxt; int ui = 0;
    if (!S.next(0, cur)) return;
    f32x4 acc[2][2][4][2];
#pragma unroll
    for (int a = 0; a < 2; ++a)
#pragma unroll
        for (int b = 0; b < 2; ++b)
#pragma unroll
            for (int m = 0; m < 4; ++m)
#pragma unroll
                for (int n = 0; n < 2; ++n) acc[a][b][m][n] = (f32x4){0.f, 0.f, 0.f, 0.f};
    bf16x8 At[4][2], B0[2][2], B1[2][2];
    const char* cA = (const char*)g.A + (size_t)cur.pm * tstepA + (size_t)cur.pn * apn; const char* cB = (const char*)g.Bt + (size_t)cur.pn * tstepB;
    S.a_ready(cur);
    if constexpr (SP2) {
        PG8_STAGE(PG8_SB(0, 0), cB, voffB); PG8_STAGE(PG8_SB(0, 1), cB + hstepB, voffB); PG8_STAGE(PG8_SA(0, 0), cA, voffA); PG8_STAGE(PG8_SA(0, 1), cA + hstepA, voffA);
        if (wr == 1) PG8_BAR;
        PG8_WAIT_V(2); PG8_BAR;
        PG8_STAGE(PG8_SB(1, 0), cB + kstep, voffB); PG8_STAGE(PG8_SA(1, 0), cA + kstep, voffA); PG8_STAGE(PG8_SB(1, 1), cB + hstepB + kstep, voffB);
        PG8_WAIT_V(6); PG8_BAR;
    } else {
        PG8_STAGE(PG8_SB(0, 0), cB, voffB); PG8_STAGE(PG8_SA(0, 0), cA, voffA); PG8_STAGE(PG8_SB(0, 1), cB + hstepB, voffB); PG8_STAGE(PG8_SA(0, 1), cA + hstepA, voffA);
        if (wr == 1) PG8_BAR;
        PG8_WAIT_V(4); PG8_BAR;
        PG8_STAGE(PG8_SB(1, 0), cB + kstep, voffB); PG8_STAGE(PG8_SA(1, 0), cA + kstep, voffA); PG8_STAGE(PG8_SB(1, 1), cB + hstepB + kstep, voffB);
        PG8_WAIT_V(6); PG8_BAR;
    }
    for (;;) {
        const bool has_next = S.next(ui + 1, nxt);
        const char* nA = has_next ? (const char*)g.A + (size_t)nxt.pm * tstepA + (size_t)nxt.pn * apn : cA; const char* nB = has_next ? (const char*)g.Bt + (size_t)nxt.pn * tstepB : cB;
#pragma nounroll
        for (int t = 0; t < nt; t += 2) {
            const bool last = (t == nt - 2);
            const char* a1 = cA + (size_t)(t + 1) * kstep;
            const char* a2 = last ? nA : cA + (size_t)(t + 2) * kstep; const char* b2 = last ? nB : cB + (size_t)(t + 2) * kstep;
            const char* a3 = a2 + kstep; const char* b3 = b2 + kstep;
            if (last && has_next) S.a_ready(nxt);
            if constexpr (SP2) {
            PG8_LDB(B0, 0, 0); PG8_LDB(B1, 0, 1); PG8_SCHED; PG8_LDA(At, 0, 0); PG8_STAGE(PG8_SA(1, 1), a1 + hstepA, voffA);
            PG8_WAIT_V(8); PG8_WAIT_L(0); PG8_BAR; PG8_MMA(0, 0, At, B0); PG8_MMA(0, 1, At, B1); PG8_BAR; PG8_SCHED;
            PG8_LDA(At, 0, 1); PG8_STAGE(PG8_SB(0, 0), b2, voffB); PG8_STAGE(PG8_SB(0, 1), b2 + hstepB, voffB); PG8_STAGE(PG8_SA(0, 0), a2, voffA);
            PG8_WAIT_V(8); PG8_WAIT_L(0); PG8_BAR; PG8_MMA(1, 0, At, B0); PG8_MMA(1, 1, At, B1); PG8_BAR; PG8_SCHED;
            PG8_LDB(B0, 1, 0); PG8_LDB(B1, 1, 1); PG8_SCHED; PG8_LDA(At, 1, 0); PG8_STAGE(PG8_SA(0, 1), a2 + hstepA, voffA);
            PG8_WAIT_V(8); PG8_WAIT_L(0); PG8_BAR; PG8_MMA(0, 0, At, B0); PG8_MMA(0, 1, At, B1); PG8_BAR; PG8_SCHED;
            PG8_LDA(At, 1, 1); PG8_STAGE(PG8_SB(1, 0), b3, voffB); PG8_STAGE(PG8_SB(1, 1), b3 + hstepB, voffB); PG8_STAGE(PG8_SA(1, 0), a3, voffA);
            PG8_WAIT_V(8); PG8_WAIT_L(0); PG8_BAR; PG8_MMA(1, 0, At, B0); PG8_MMA(1, 1, At, B1); PG8_BAR; PG8_SCHED;
            } else {
            PG8_LDB(B0, 0, 0); PG8_SCHED; PG8_LDA(At, 0, 0); PG8_STAGE(PG8_SA(1, 1), a1 + hstepA, voffA);
            PG8_WAIT_L(8); PG8_BAR; PG8_WAIT_L(0); PG8_MMA(0, 0, At, B0); PG8_BAR; PG8_SCHED;
            PG8_LDB(B1, 0, 1); PG8_STAGE(PG8_SB(0, 0), b2, voffB);
            PG8_BAR; PG8_WAIT_L(0); PG8_MMA(0, 1, At, B1); PG8_BAR;
            PG8_LDA(At, 0, 1); PG8_STAGE(PG8_SA(0, 0), a2, voffA);
            PG8_BAR; PG8_WAIT_L(0); PG8_MMA(1, 0, At, B0); PG8_BAR; PG8_SCHED;
            PG8_STAGE(PG8_SB(0, 1), b2 + hstepB, voffB);
            PG8_WAIT_V(6); PG8_BAR; PG8_MMA(1, 1, At, B1); PG8_BAR;
            PG8_LDB(B0, 1, 0); PG8_SCHED; PG8_LDA(At, 1, 0); PG8_STAGE(PG8_SA(0, 1), a2 + hstepA, voffA);
            PG8_WAIT_L(8); PG8_BAR; PG8_WAIT_L(0); PG8_MMA(0, 0, At, B0); PG8_BAR; PG8_SCHED;
            PG8_LDB(B1, 1, 1); PG8_STAGE(PG8_SB(1, 0), b3, voffB);
            PG8_BAR; PG8_WAIT_L(0); PG8_MMA(0, 1, At, B1); PG8_BAR;
            PG8_LDA(At, 1, 1); PG8_STAGE(PG8_SA(1, 0), a3, voffA);
            PG8_BAR; PG8_WAIT_L(0); PG8_MMA(1, 0, At, B0); PG8_BAR; PG8_SCHED;
            PG8_STAGE(PG8_SB(1, 1), b3 + hstepB, voffB);
            PG8_WAIT_V(6); PG8_BAR; PG8_MMA(1, 1, At, B1); PG8_BAR;
            }
        }
        if constexpr (ALIGN_EPI) { if (wr == 0) PG8_BAR; }
        if constexpr (!Epi::AFTER_DRAIN) { E(acc, cur, wr, wc, fr, fq); S.done(cur); }
        if (!has_next) break;
#pragma unroll
        for (int a = 0; a < 2; ++a)
#pragma unroll
            for (int b = 0; b < 2; ++b)
#pragma unroll
                for (int m = 0; m < 4; ++m)
#pragma unroll
                    for (int n = 0; n < 2; ++n) acc[a][b][m][n] = (f32x4){0.f, 0.f, 0.f, 0.f};
        cur = nxt; cA = nA; cB = nB; ++ui;
        if constexpr (ALIGN_EPI) { if (wr == 1) PG8_BAR; }
    }
    PG8_WAIT_V(0);
    if constexpr (!ALIGN_EPI) { if (wr == 0) PG8_BAR; }
    PG8_BAR;
    if constexpr (Epi::AFTER_DRAIN) { E.fused(acc, cur, wr, wc, fr, fq, lds, wid, lane); S.done(cur); }
#undef PG8_SA
#undef PG8_SB
#undef PG8_STAGE
#undef PG8_LDA
#undef PG8_LDB
#undef PG8_MMA
#undef PG8_WAIT_V
#undef PG8_WAIT_L
#undef PG8_BAR
#undef PG8_SCHED
}
}

#ifndef PR_GATHER
#define PR_GATHER 1
#endif
#ifndef PR_ROUTE
#define PR_ROUTE 1
#endif
#ifndef PR_S5
#define PR_S5 1
#endif
#ifndef PR_SSD
#define PR_SSD 1
#endif
#ifndef PR_GEMM
#define PR_GEMM 1
#endif
#ifndef PR_MISC
#define PR_MISC 1
#endif
namespace mk {
#define LAS __attribute__((address_space(3)))
typedef unsigned short bf16;
typedef unsigned v4u __attribute__((ext_vector_type(4)));
typedef unsigned v2u __attribute__((ext_vector_type(2)));
typedef float f32x4 __attribute__((ext_vector_type(4)));
typedef short bf16x8 __attribute__((ext_vector_type(8)));
using bf16x2 = __attribute__((ext_vector_type(2))) __bf16;

constexpr int D = 1024, T = 17408, TP = 16384, NWAVES = 8, NTHR = 512;
constexpr float ALPHA = 1.6817928305074290f;
constexpr float LN_EPS = 1e-5f, RMS_EPS = 1e-5f;
constexpr int LDS_BYTES = 160 * 1024;
constexpr int NPROJ = 5376, CONVD = 3072;

constexpr size_t MiB = 1u << 20;
constexpr size_t WS_W_S5IN = 0, WS_W_S5GLU = 2 * MiB, WS_W_S5OUT = 4 * MiB, WS_W_PIN = 6 * MiB, WS_W_PGRP = 8 * MiB, WS_W_POUT = 9 * MiB,
                 WS_W_CIN = 11 * MiB, WS_W_COUT = 15 * MiB, WS_W_SIN = 17 * MiB  , WS_W_SOUT = 28 * MiB, WS_W_PQ = 32 * MiB  ,
                 WS_KEYS = 48 * MiB  , WS_SMALL = 50 * MiB, WS_CTL = 52 * MiB  ;
constexpr size_t CTL_BYTES = 16384;
constexpr int MISC_OFF = LDS_BYTES - 64;
constexpr size_t WS_EU = 64 * MiB, WS_EV = 96 * MiB;
constexpr size_t WS_H32 = 128 * MiB, WS_R32 = 196 * MiB, WS_HB = 264 * MiB, WS_A0 = 298 * MiB, WS_A1 = 332 * MiB, WS_A2 = 366 * MiB;
constexpr size_t WS_Q = 400 * MiB  , WS_IDX = 468 * MiB  , WS_GATE = 477 * MiB  , WS_DT = 486 * MiB  ;
constexpr size_t WS_XBC = 490 * MiB  , WS_XC = 592 * MiB  , WS_Y = 694 * MiB  , WS_YN = 762 * MiB  , WS_SCU = 830 * MiB  , WS_END = 839 * MiB;
constexpr size_t SM_LBR = 0, SM_LBI = 4096, SM_BBR = 8192, SM_BBI = 8192 + 65536, SM_ISU = 8192 + 131072, SM_ISV = SM_ISU + 16384;

struct Params { const float* in[46]; float* out; unsigned char* ws; };

__device__ __forceinline__ unsigned f2bf(float f) { unsigned u = __builtin_bit_cast(unsigned, f); return (u + 0x7fffu + ((u >> 16) & 1u)) >> 16; }
__device__ __forceinline__ unsigned pk2(float lo, float hi) { return pg8::cvt_pk_bf16(lo, hi); }
__device__ __forceinline__ float bflo(unsigned w) { return __builtin_bit_cast(float, w << 16); }
__device__ __forceinline__ float bfhi(unsigned w) { return __builtin_bit_cast(float, w & 0xffff0000u); }
__device__ __forceinline__ float bf2f(bf16 b) { return __builtin_bit_cast(float, ((unsigned)b) << 16); }
__device__ __forceinline__ float sigmoid_f(float x) { return 1.f / (1.f + __expf(-x)); }
__device__ __forceinline__ float silu_f(float x) { return x * sigmoid_f(x); }
__device__ __forceinline__ float gelu_f(float x) { return x * sigmoid_f(1.5957691216057308f * (x + 0.044715f * x * x * x)); }
__device__ __forceinline__ float shx(float v, int o, int lane) { return __builtin_bit_cast(float, __builtin_amdgcn_ds_bpermute((lane ^ o) << 2, __builtin_bit_cast(int, v))); }
__device__ __forceinline__ float wave_sum(float v, int lane) {
#pragma unroll
    for (int o = 32; o >= 1; o >>= 1) v += shx(v, o, lane);
    return v;
}
__device__ __forceinline__ float dot2(unsigned w, unsigned x, float acc) { return __builtin_amdgcn_fdot2_f32_bf16(__builtin_bit_cast(bf16x2, w), __builtin_bit_cast(bf16x2, x), acc, false); }
__device__ __forceinline__ float reduce16(const float (&p)[16], int lane) {
    const bool b5 = lane & 32, b4 = lane & 16, b3 = lane & 8, b2 = lane & 4;
    float q[8], r[4], s[2], t;
#pragma unroll
    for (int i = 0; i < 8; ++i) { const float keep = b5 ? p[i + 8] : p[i], send = b5 ? p[i] : p[i + 8]; q[i] = keep + shx(send, 32, lane); }
#pragma unroll
    for (int i = 0; i < 4; ++i) { const float keep = b4 ? q[i + 4] : q[i], send = b4 ? q[i] : q[i + 4]; r[i] = keep + shx(send, 16, lane); }
#pragma unroll
    for (int i = 0; i < 2; ++i) { const float keep = b3 ? r[i + 2] : r[i], send = b3 ? r[i] : r[i + 2]; s[i] = keep + shx(send, 8, lane); }
    { const float keep = b2 ? s[1] : s[0], send = b2 ? s[0] : s[1]; t = keep + shx(send, 4, lane); }
    t += shx(t, 2, lane); t += shx(t, 1, lane);
    return t;
}
__device__ __forceinline__ void seq_info(int s, int& tok0, int& L) { if (s < 8) { tok0 = s << 11; L = 2048; } else { tok0 = TP + ((s - 8) << 3); L = 8; } }
__device__ __forceinline__ void tok_info(int t, int& s, int& l, int& tok0) {
    if (t < TP) { s = t >> 11; l = t & 2047; tok0 = s << 11; } else { const int b = (t - TP) >> 3; s = 8 + b; l = (t - TP) & 7; tok0 = TP + (b << 3); }
}

template <int MODE> struct EpiBf16 {
    static constexpr bool PERM = true, AFTER_DRAIN = false;
    bf16* O; int ldc; const float* bias; const float* scale; const bf16* G;
    __device__ __forceinline__ void operator()(const pg8::f32x4 (&acc)[2][2][4][2], const pg8::Unit& u, int wr, int wc, int fr_, int fq_) const {
        int fr = fr_, fq = fq_; asm volatile("" : "+v"(fr), "+v"(fq));
        const int row0 = u.pm * 256 + wr * 64 + fr, col0 = u.pn * 256 + wc * 32 + 8 * fq;
        f32x4 bv[2][2], sv[2][2];
#pragma unroll
        for (int bj = 0; bj < 2; ++bj)
#pragma unroll
            for (int n = 0; n < 2; ++n) {
                bv[bj][n] = bias ? *(const f32x4*)(bias + col0 + bj * 128 + 4 * n) : (f32x4){0.f, 0.f, 0.f, 0.f};
                sv[bj][n] = (MODE == 2) ? *(const f32x4*)(scale + col0 + bj * 128 + 4 * n) : (f32x4){1.f, 1.f, 1.f, 1.f};
            }
#pragma unroll
        for (int ai = 0; ai < 2; ++ai)
#pragma unroll
            for (int m = 0; m < 4; ++m) {
                const size_t roff = (size_t)(row0 + ai * 128 + m * 16) * ldc + col0;
#pragma unroll
                for (int bj = 0; bj < 2; ++bj) {
                    f32x4 v0 = acc[ai][bj][m][0] + bv[bj][0], v1 = acc[ai][bj][m][1] + bv[bj][1];
                    if (MODE == 1) {
#pragma unroll
                        for (int j = 0; j < 4; ++j) { v0[j] = gelu_f(v0[j]); v1[j] = gelu_f(v1[j]); }
                    }
                    if (MODE == 2) { v0 = v0 * sv[bj][0]; v1 = v1 * sv[bj][1]; }
                    if (MODE == 3) {
                        const v4u gw = *(const v4u*)(G + roff + bj * 128);
                        v0[0] = bflo(gw.x) * sigmoid_f(v0[0]); v0[1] = bfhi(gw.x) * sigmoid_f(v0[1]); v0[2] = bflo(gw.y) * sigmoid_f(v0[2]); v0[3] = bfhi(gw.y) * sigmoid_f(v0[3]);
                        v1[0] = bflo(gw.z) * sigmoid_f(v1[0]); v1[1] = bfhi(gw.z) * sigmoid_f(v1[1]); v1[2] = bflo(gw.w) * sigmoid_f(v1[2]); v1[3] = bfhi(gw.w) * sigmoid_f(v1[3]);
                    }
                    v4u w; w.x = pk2(v0[0], v0[1]); w.y = pk2(v0[2], v0[3]); w.z = pk2(v1[0], v1[1]); w.w = pk2(v1[2], v1[3]);
                    *(v4u*)(O + roff + bj * 128) = w;
                }
            }
    }
};
struct EpiResid {
    static constexpr bool PERM = false, AFTER_DRAIN = false;
    const float* H; float* R;
    __device__ __forceinline__ void operator()(const pg8::f32x4 (&acc)[2][2][4][2], const pg8::Unit& u, int wr, int wc, int fr_, int fq_) const {
        int fr = fr_, fq = fq_; asm volatile("" : "+v"(fr), "+v"(fq));
        const int row0 = u.pm * 256 + wr * 64 + fr, col0 = u.pn * 256 + wc * 32 + 4 * fq;
#pragma unroll
        for (int ai = 0; ai < 2; ++ai)
#pragma unroll
            for (int m = 0; m < 4; ++m) {
                const size_t roff = (size_t)(row0 + ai * 128 + m * 16) * D + col0;
#pragma unroll
                for (int bj = 0; bj < 2; ++bj)
#pragma unroll
                    for (int n = 0; n < 2; ++n) {
                        const f32x4 hv = *(const f32x4*)(H + roff + bj * 128 + n * 16);
                        *(f32x4*)(R + roff + bj * 128 + n * 16) = hv * ALPHA + acc[ai][bj][m][n];
                    }
            }
    }
};
struct EpiSsdProj {
    static constexpr bool PERM = true, AFTER_DRAIN = false;
    bf16* Z; bf16* XBC; float* DT;
    __device__ __forceinline__ void operator()(const pg8::f32x4 (&acc)[2][2][4][2], const pg8::Unit& u, int wr, int wc, int fr_, int fq_) const {
        int fr = fr_, fq = fq_; asm volatile("" : "+v"(fr), "+v"(fq));
        const int row0 = u.pm * 256 + wr * 64 + fr, col0 = u.pn * 256 + wc * 32 + 8 * fq;
#pragma unroll
        for (int ai = 0; ai < 2; ++ai)
#pragma unroll
            for (int m = 0; m < 4; ++m) {
                const size_t row = (size_t)(row0 + ai * 128 + m * 16);
#pragma unroll
                for (int bj = 0; bj < 2; ++bj) {
                    const f32x4 v0 = acc[ai][bj][m][0], v1 = acc[ai][bj][m][1];
                    const int col = col0 + bj * 128;
                    if (u.pn < 20) {
                        v4u w; w.x = pk2(v0[0], v0[1]); w.y = pk2(v0[2], v0[3]); w.z = pk2(v1[0], v1[1]); w.w = pk2(v1[2], v1[3]);
                        if (u.pn < 8) *(v4u*)(Z + row * 2048 + col) = w; else *(v4u*)(XBC + row * CONVD + (col - 2048)) = w;
                    } else if (col - 5120 < 32) {
                        *(f32x4*)(DT + row * 32 + (col - 5120)) = v0; *(f32x4*)(DT + row * 32 + (col - 5120) + 4) = v1;
                    }
                }
            }
    }
};

struct Ctx {
    const float* const* in; float* out; unsigned char* ws; LAS unsigned char* lds;
    int tid, lane, wave, gw, NGW, gt, NGT;
    template <class Tp> __device__ __forceinline__ Tp* W(size_t off) const { return (Tp*)(ws + off); }
};

template <class Epi> __device__ __forceinline__ void run_gemm(const Ctx& c, const bf16* A, int lda, int a_pn_off, const bf16* Bt, int N, int K, const Epi& E) {
    pg8::Gemm g{A, Bt, T, N, K, lda, a_pn_off};
    pg8::StaticOrder S; S.init(T, N, (int)gridDim.x, (int)blockIdx.x);
    for (int r = 0; r < PR_GEMM; ++r) pg8::gemm_phase<Epi, pg8::StaticOrder, false, false>(c.lds, g, S, E, c.tid);
}

__device__ __forceinline__ void transpose_item(const float* __restrict__ Wm, int K, int N, bf16* WT, LAS float* scr, int item, int lane) {
    const int nblk = N / 32, kb = item / nblk, nb = item % nblk, k0 = 64 * kb, n0 = 32 * nb;
#pragma unroll 8
    for (int i = 0; i < 32; ++i) { const int kk = 2 * i + (lane >> 5); scr[kk * 33 + (lane & 31)] = Wm[(size_t)(k0 + kk) * N + n0 + (lane & 31)]; }
    asm volatile("s_waitcnt lgkmcnt(0)" ::: "memory");
    const int cc = lane & 7;
#pragma unroll
    for (int j = 0; j < 4; ++j) {
        const int n = (lane >> 3) + 8 * j; const LAS float* s = scr + (8 * cc) * 33 + n;
        v4u o; o.x = pk2(s[0 * 33], s[1 * 33]); o.y = pk2(s[2 * 33], s[3 * 33]); o.z = pk2(s[4 * 33], s[5 * 33]); o.w = pk2(s[6 * 33], s[7 * 33]);
        *(v4u*)(WT + (size_t)(n0 + n) * K + k0 + 8 * cc) = o;
    }
    asm volatile("s_waitcnt lgkmcnt(0)" ::: "memory");
}
__device__ __forceinline__ void transpose_mat(const Ctx& c, const float* Wm, int K, int N, bf16* WT) {
    LAS float* scr = (LAS float*)(c.lds + c.wave * 16384);
    const int nitems = (K / 64) * (N / 32);
    for (int it = c.gw; it < nitems; it += c.NGW) transpose_item(Wm, K, N, WT, scr, it, c.lane);
}
__device__ __forceinline__ void cvt_copy(const Ctx& c, const float* __restrict__ src, bf16* dst, size_t n) {
    for (size_t i = (size_t)c.gt * 8; i < n; i += (size_t)c.NGT * 8) {
        const f32x4 a = *(const f32x4*)(src + i), b = *(const f32x4*)(src + i + 4);
        v4u w; w.x = pk2(a[0], a[1]); w.y = pk2(a[2], a[3]); w.z = pk2(b[0], b[1]); w.w = pk2(b[2], b[3]);
        *(v4u*)(dst + i) = w;
    }
}
__device__ __forceinline__ float wave_max(float v, int lane) {
#pragma unroll
    for (int o = 32; o >= 1; o >>= 1) v = fmaxf(v, shx(v, o, lane));
    return v;
}
__device__ __forceinline__ void cvt_tables(const Ctx& c, int layer) {
    float* sm = c.W<float>(WS_SMALL);
    for (int r = c.gw; r < 2 * 16384; r += c.NGW) {
        const int tb = r >> 14, row = r & 16383;
        const float* src = c.in[44 + tb] + ((size_t)layer * 16384 + row) * D + 16 * c.lane;
        f32x4 v[4];
#pragma unroll
        for (int k = 0; k < 4; ++k) v[k] = *(const f32x4*)(src + 4 * k);
        float m = 0.f;
#pragma unroll
        for (int k = 0; k < 4; ++k) m = fmaxf(fmaxf(fmaxf(fabsf(v[k][0]), fabsf(v[k][1])), fmaxf(fabsf(v[k][2]), fabsf(v[k][3]))), m);
        m = fmaxf(wave_max(m, c.lane), 1e-30f);
        const int ex = (int)((__builtin_bit_cast(unsigned, m) >> 23) & 0xffu) - 127;
        const float sc = __builtin_bit_cast(float, (unsigned)(127 + 7 - ex) << 23);
        const float isc = __builtin_bit_cast(float, (unsigned)(127 - 7 + ex) << 23);
        v4u o;
        { int p = __builtin_amdgcn_cvt_pk_fp8_f32(v[0][0] * sc, v[0][1] * sc, 0, false); p = __builtin_amdgcn_cvt_pk_fp8_f32(v[0][2] * sc, v[0][3] * sc, p, true); o.x = (unsigned)p; }
        { int p = __builtin_amdgcn_cvt_pk_fp8_f32(v[1][0] * sc, v[1][1] * sc, 0, false); p = __builtin_amdgcn_cvt_pk_fp8_f32(v[1][2] * sc, v[1][3] * sc, p, true); o.y = (unsigned)p; }
        { int p = __builtin_amdgcn_cvt_pk_fp8_f32(v[2][0] * sc, v[2][1] * sc, 0, false); p = __builtin_amdgcn_cvt_pk_fp8_f32(v[2][2] * sc, v[2][3] * sc, p, true); o.z = (unsigned)p; }
        { int p = __builtin_amdgcn_cvt_pk_fp8_f32(v[3][0] * sc, v[3][1] * sc, 0, false); p = __builtin_amdgcn_cvt_pk_fp8_f32(v[3][2] * sc, v[3][3] * sc, p, true); o.w = (unsigned)p; }
        *(v4u*)(c.ws + (tb ? WS_EV : WS_EU) + (size_t)row * D + 16 * c.lane) = o;
        if (c.lane == 0) sm[(tb ? SM_ISV : SM_ISU) + row] = isc;
    }
}
__device__ __forceinline__ void prologue(const Ctx& c) {
    transpose_mat(c, c.in[7], 1024, 1024, c.W<bf16>(WS_W_S5IN));
    transpose_mat(c, c.in[16], 1024, 1024, c.W<bf16>(WS_W_S5GLU));
    transpose_mat(c, c.in[18], 1024, 1024, c.W<bf16>(WS_W_S5OUT));
    transpose_mat(c, c.in[19], 1024, 1024, c.W<bf16>(WS_W_PIN));
    for (int g = 0; g < 4; ++g) transpose_mat(c, c.in[20] + (size_t)g * 65536, 256, 256, c.W<bf16>(WS_W_PGRP) + (size_t)g * 65536);
    transpose_mat(c, c.in[22], 1024, 1024, c.W<bf16>(WS_W_POUT));
    transpose_mat(c, c.in[23], 1024, 2048, c.W<bf16>(WS_W_CIN));
    transpose_mat(c, c.in[29], 1024, 1024, c.W<bf16>(WS_W_COUT));
    transpose_mat(c, c.in[30], 1024, 5152, c.W<bf16>(WS_W_SIN));
    transpose_mat(c, c.in[37], 2048, 1024, c.W<bf16>(WS_W_SOUT));
    for (int l = 0; l < 4; ++l) transpose_mat(c, c.in[42] + (size_t)l * 1024 * 2048, 1024, 2048, c.W<bf16>(WS_W_PQ) + (size_t)l * 2048 * 1024);
    {
        v4u* z = (v4u*)(c.W<bf16>(WS_W_SIN) + (size_t)5152 * 1024);
        for (int i = c.gt; i < 224 * 1024 / 8; i += c.NGT) z[i] = (v4u){0u, 0u, 0u, 0u};
    }
    cvt_copy(c, c.in[43], c.W<bf16>(WS_KEYS), (size_t)4 * 8 * 2 * 128 * 128);
    {
        float* H = c.W<float>(WS_H32); bf16* HB = c.W<bf16>(WS_HB);
        for (size_t i = (size_t)c.gt * 8; i < (size_t)T * D; i += (size_t)c.NGT * 8) {
            const float* src = (i < (size_t)TP * D) ? (c.in[0] + i) : (c.in[1] + (i - (size_t)TP * D));
            const f32x4 a = *(const f32x4*)(src), b = *(const f32x4*)(src + 4);
            *(f32x4*)(H + i) = a; *(f32x4*)(H + i + 4) = b;
            v4u w; w.x = pk2(a[0], a[1]); w.y = pk2(a[2], a[3]); w.z = pk2(b[0], b[1]); w.w = pk2(b[2], b[3]);
            *(v4u*)(HB + i) = w;
        }
    }
    if (c.gt < 4096) {
        const int gp = c.gt, g = gp >> 6;
        float* sm = c.W<float>(WS_SMALL);
        const float dt = expf(c.in[10][g]);
        const float lr = c.in[8][gp], li = c.in[9][gp];
        const float mag = expf(lr * dt);
        const float br = mag * cosf(li * dt), bi = mag * sinf(li * dt);
        const float den = lr * lr + li * li;
        const float fr = ((br - 1.f) * lr + bi * li) / den, fi = (bi * lr - (br - 1.f) * li) / den;
        sm[SM_LBR + gp] = br; sm[SM_LBI + gp] = bi;
        for (int i = 0; i < 16; ++i) {
            const float xr = c.in[11][gp * 16 + i], xi = c.in[12][gp * 16 + i];
            sm[SM_BBR + gp * 16 + i] = fr * xr - fi * xi; sm[SM_BBI + gp * 16 + i] = fr * xi + fi * xr;
        }
    }
    cvt_tables(c, 0);
}

__device__ __forceinline__ void ln_row_store(const f32x4 (&v)[4], float mean, float rstd, const float* __restrict__ g, const float* __restrict__ b, float* o32, bf16* ob, int lane) {
#pragma unroll
    for (int h = 0; h < 2; ++h) {
        const int c0 = h * 512 + 8 * lane;
        const f32x4 g0 = *(const f32x4*)(g + c0), g1 = *(const f32x4*)(g + c0 + 4), b0 = *(const f32x4*)(b + c0), b1 = *(const f32x4*)(b + c0 + 4);
        const f32x4 o0 = (v[2 * h] - mean) * rstd * g0 + b0, o1 = (v[2 * h + 1] - mean) * rstd * g1 + b1;
        *(f32x4*)(o32 + c0) = o0; *(f32x4*)(o32 + c0 + 4) = o1;
        if (ob) { v4u w; w.x = pk2(o0[0], o0[1]); w.y = pk2(o0[2], o0[3]); w.z = pk2(o1[0], o1[1]); w.w = pk2(o1[2], o1[3]); *(v4u*)(ob + c0) = w; }
    }
}
__device__ __forceinline__ void ln_stats(const f32x4 (&v)[4], float& mean, float& rstd, int lane) {
    float s = 0.f;
#pragma unroll
    for (int k = 0; k < 4; ++k) s += (v[k][0] + v[k][1]) + (v[k][2] + v[k][3]);
    mean = wave_sum(s, lane) * (1.f / D);
    float q = 0.f;
#pragma unroll
    for (int k = 0; k < 4; ++k) { const f32x4 d = v[k] - mean; q += (d[0] * d[0] + d[1] * d[1]) + (d[2] * d[2] + d[3] * d[3]); }
    rstd = rsqrtf(wave_sum(q, lane) * (1.f / D) + LN_EPS);
}
__device__ __forceinline__ void phase_ln1(const Ctx& c, int layer) {
    const float* R = c.W<float>(WS_R32); float* H = c.W<float>(WS_H32); bf16* HB = c.W<bf16>(WS_HB);
    const float* g = c.in[38] + layer * D; const float* b = c.in[39] + layer * D;
    for (int t = c.gw; t < T; t += c.NGW) {
        f32x4 v[4];
#pragma unroll
        for (int h = 0; h < 2; ++h) { v[2 * h] = *(const f32x4*)(R + (size_t)t * D + h * 512 + 8 * c.lane); v[2 * h + 1] = *(const f32x4*)(R + (size_t)t * D + h * 512 + 8 * c.lane + 4); }
        float mean, rstd; ln_stats(v, mean, rstd, c.lane);
        ln_row_store(v, mean, rstd, g, b, H + (size_t)t * D, HB + (size_t)t * D, c.lane);
    }
}

__device__ __forceinline__ void phase_s5scan(const Ctx& c) {
    const bf16* U = c.W<bf16>(WS_A0); bf16* G = c.W<bf16>(WS_A1);
    const float* sm = c.W<float>(WS_SMALL);
    float* out = c.out;
    float* o_re_p = out + 17825792, *o_im_p = o_re_p + 32768, *o_re_s = out + 17825792 + 32768 * 2 + 122880 + 73728 + 2097152, *o_im_s = o_re_s + 524288;
    const int p = c.lane;
    const int wslot = c.wave * (int)gridDim.x + (int)blockIdx.x;
    for (int unit = wslot; unit < 136 * 64; unit += c.NGW) {
        const int s = unit >> 6, g = unit & 63;
        int tok0, L; seq_info(s, tok0, L);
        float br[16], bi[16], cr[16], ci[16];
#pragma unroll
        for (int i = 0; i < 16; ++i) {
            br[i] = sm[SM_BBR + (g * 64 + p) * 16 + i]; bi[i] = sm[SM_BBI + (g * 64 + p) * 16 + i];
            cr[i] = c.in[13][(g * 16 + i) * 64 + p]; ci[i] = c.in[14][(g * 16 + i) * 64 + p];
        }
        const float lr = sm[SM_LBR + g * 64 + p], li = sm[SM_LBI + g * 64 + p];
        float hr = 0.f, hi = 0.f;
        if (s >= 8) { hr = c.in[2][((s - 8) * 64 + g) * 64 + p]; hi = c.in[3][((s - 8) * 64 + g) * 64 + p]; }
        const int io = (p >> 2) & 15;
        const float dk = c.in[15][g * 16 + io];
        const bf16* up = U + (size_t)tok0 * D + g * 16;
        v4u ua = *(const v4u*)(up), ub = *(const v4u*)(up + 8);
        for (int t = 0; t < L; ++t) {
            const v4u ca = ua, cb = ub;
            if (t + 1 < L) { ua = *(const v4u*)(up + (size_t)(t + 1) * D); ub = *(const v4u*)(up + (size_t)(t + 1) * D + 8); }
            float uv[16];
            uv[0] = bflo(ca.x); uv[1] = bfhi(ca.x); uv[2] = bflo(ca.y); uv[3] = bfhi(ca.y); uv[4] = bflo(ca.z); uv[5] = bfhi(ca.z); uv[6] = bflo(ca.w); uv[7] = bfhi(ca.w);
            uv[8] = bflo(cb.x); uv[9] = bfhi(cb.x); uv[10] = bflo(cb.y); uv[11] = bfhi(cb.y); uv[12] = bflo(cb.z); uv[13] = bfhi(cb.z); uv[14] = bflo(cb.w); uv[15] = bfhi(cb.w);
            float bur = 0.f, bui = 0.f;
#pragma unroll
            for (int i = 0; i < 16; ++i) { bur += uv[i] * br[i]; bui += uv[i] * bi[i]; }
            const float nr = lr * hr - li * hi + bur, ni = lr * hi + li * hr + bui;
            hr = nr; hi = ni;
            float pv[16];
#pragma unroll
            for (int i = 0; i < 16; ++i) pv[i] = hr * cr[i] - hi * ci[i];
            const float tot = reduce16(pv, p);
            float usel = uv[0];
#pragma unroll
            for (int i = 1; i < 16; ++i) usel = (io == i) ? uv[i] : usel;
            if ((p & 3) == 0) G[(size_t)(tok0 + t) * D + g * 16 + io] = (bf16)f2bf(gelu_f(tot + dk * usel));
        }
        if (s < 8) { o_re_p[(s * 64 + g) * 64 + p] = hr; o_im_p[(s * 64 + g) * 64 + p] = hi; }
        else { o_re_s[((s - 8) * 64 + g) * 64 + p] = hr; o_im_s[((s - 8) * 64 + g) * 64 + p] = hi; }
    }
}

__device__ __forceinline__ void phase_pool(const Ctx& c) {
    const bf16* U = c.W<bf16>(WS_A0); bf16* P = c.W<bf16>(WS_A1);
    float* o_p = c.out + 17825792 + 65536, *o_s = c.out + 17825792 + 65536 + 122880 + 73728 + 2097152 + 1048576;
    for (size_t i = (size_t)c.gt; i < (size_t)T * 128; i += (size_t)c.NGT) {
        const int t = (int)(i >> 7), c0 = (int)(i & 127) * 8;
        int s, l, tok0; tok_info(t, s, l, tok0);
        const int w = 2 << (c0 >> 8);
        float sum[8];
#pragma unroll
        for (int j = 0; j < 8; ++j) sum[j] = 0.f;
        float cur[8];
        for (int k = 0; k < w; ++k) {
            const int ll = l - k;
            if (ll >= 0) {
                const v4u q = *(const v4u*)(U + (size_t)(tok0 + ll) * D + c0);
                const float f[8] = {bflo(q.x), bfhi(q.x), bflo(q.y), bfhi(q.y), bflo(q.z), bfhi(q.z), bflo(q.w), bfhi(q.w)};
#pragma unroll
                for (int j = 0; j < 8; ++j) { sum[j] += f[j]; if (k == 0) cur[j] = f[j]; }
            } else if (s >= 8) {
                const float* sp = c.in[4] + ((size_t)(s - 8) * 15 + (15 + ll)) * D + c0;
                const f32x4 a = *(const f32x4*)sp, b = *(const f32x4*)(sp + 4);
                sum[0] += a[0]; sum[1] += a[1]; sum[2] += a[2]; sum[3] += a[3]; sum[4] += b[0]; sum[5] += b[1]; sum[6] += b[2]; sum[7] += b[3];
            }
        }
        const int pos = (s >= 8 ? 16384 : 0) + l;
        const float inv = 1.f / (float)min(pos + 1, w);
        v4u o; o.x = pk2(sum[0] * inv - cur[0], sum[1] * inv - cur[1]); o.y = pk2(sum[2] * inv - cur[2], sum[3] * inv - cur[3]);
        o.z = pk2(sum[4] * inv - cur[4], sum[5] * inv - cur[5]); o.w = pk2(sum[6] * inv - cur[6], sum[7] * inv - cur[7]);
        *(v4u*)(P + (size_t)t * D + c0) = o;
    }
    for (size_t i = (size_t)c.gt; i < (size_t)136 * 15 * D; i += (size_t)c.NGT) {
        const int ch = (int)(i & 1023); const int j = (int)((i >> 10) % 15); const int s = (int)(i / (15 * 1024));
        if (s < 8) o_p[((size_t)s * 15 + j) * D + ch] = bf2f(U[(size_t)(s * 2048 + 2033 + j) * D + ch]);
        else { const int b = s - 8; o_s[((size_t)b * 15 + j) * D + ch] = (j < 7) ? c.in[4][((size_t)b * 15 + 8 + j) * D + ch] : bf2f(U[(size_t)(TP + b * 8 + (j - 7)) * D + ch]); }
    }
}

__device__ __forceinline__ void phase_cmlp_ln(const Ctx& c) {
    bf16* Z = c.W<bf16>(WS_Q);
    float* o_v = c.out + 17825792 + 65536 + 122880 + 73728 + 2097152 + 1048576 + 1966080;
    const float* g = c.in[25]; const float* b = c.in[26];
    for (int t = c.gw; t < T; t += c.NGW) {
        bf16* vr = Z + (size_t)t * 2048 + 1024;
        f32x4 v[4];
#pragma unroll
        for (int h = 0; h < 2; ++h) {
            const v4u q = *(const v4u*)(vr + h * 512 + 8 * c.lane);
            v[2 * h] = (f32x4){bflo(q.x), bfhi(q.x), bflo(q.y), bfhi(q.y)}; v[2 * h + 1] = (f32x4){bflo(q.z), bfhi(q.z), bflo(q.w), bfhi(q.w)};
        }
        float mean, rstd; ln_stats(v, mean, rstd, c.lane);
#pragma unroll
        for (int h = 0; h < 2; ++h) {
            const int c0 = h * 512 + 8 * c.lane;
            const f32x4 g0 = *(const f32x4*)(g + c0), g1 = *(const f32x4*)(g + c0 + 4), b0 = *(const f32x4*)(b + c0), b1 = *(const f32x4*)(b + c0 + 4);
            const f32x4 o0 = (v[2 * h] - mean) * rstd * g0 + b0, o1 = (v[2 * h + 1] - mean) * rstd * g1 + b1;
            v4u w; w.x = pk2(o0[0], o0[1]); w.y = pk2(o0[2], o0[3]); w.z = pk2(o1[0], o1[1]); w.w = pk2(o1[2], o1[3]);
            *(v4u*)(vr + c0) = w;
            if (t >= TP) { *(f32x4*)(o_v + (size_t)(t - TP) * D + c0) = o0; *(f32x4*)(o_v + (size_t)(t - TP) * D + c0 + 4) = o1; }
        }
    }
}
__device__ __forceinline__ void phase_cmlp_mix(const Ctx& c) {
    const bf16* Z = c.W<bf16>(WS_Q); bf16* O = c.W<bf16>(WS_A1);
    for (size_t i = (size_t)c.gt; i < (size_t)T * 128; i += (size_t)c.NGT) {
        const int t = (int)(i >> 7), c0 = (int)(i & 127) * 8;
        int s, l, tok0; tok_info(t, s, l, tok0);
        const int hd = c0 >> 8, tp = (s < 8) ? (l & 127) : l, base = t - tp;
        float acc[8];
        const float bs = c.in[28][hd * 128 + tp];
#pragma unroll
        for (int j = 0; j < 8; ++j) acc[j] = bs;
        const float* wr = c.in[27] + ((size_t)hd * 128 + tp) * 128;
        for (int sp = 0; sp <= tp; ++sp) {
            const float w = wr[sp];
            const v4u q = *(const v4u*)(Z + (size_t)(base + sp) * 2048 + 1024 + c0);
            acc[0] += w * bflo(q.x); acc[1] += w * bfhi(q.x); acc[2] += w * bflo(q.y); acc[3] += w * bfhi(q.y);
            acc[4] += w * bflo(q.z); acc[5] += w * bfhi(q.z); acc[6] += w * bflo(q.w); acc[7] += w * bfhi(q.w);
        }
        const v4u uq = *(const v4u*)(Z + (size_t)t * 2048 + c0);
        v4u o; o.x = pk2(bflo(uq.x) * acc[0], bfhi(uq.x) * acc[1]); o.y = pk2(bflo(uq.y) * acc[2], bfhi(uq.y) * acc[3]);
        o.z = pk2(bflo(uq.z) * acc[4], bfhi(uq.z) * acc[5]); o.w = pk2(bflo(uq.w) * acc[6], bfhi(uq.w) * acc[7]);
        *(v4u*)(O + (size_t)t * D + c0) = o;
    }
}

__device__ __forceinline__ void phase_ssd_conv(const Ctx& c) {
    const bf16* X = c.W<bf16>(WS_XBC); bf16* XC = c.W<bf16>(WS_XC);
    float* o_p = c.out + 17825792 + 65536 + 122880, *o_s = c.out + 17825792 + 65536 + 122880 + 73728 + 2097152 + 1048576 + 1966080 + 1048576;
    for (size_t i = (size_t)c.gt; i < (size_t)T * (CONVD / 8); i += (size_t)c.NGT) {
        const int t = (int)(i / (CONVD / 8)), c0 = (int)(i % (CONVD / 8)) * 8;
        int s, l, tok0; tok_info(t, s, l, tok0);
        float acc[8];
        { const f32x4 a = *(const f32x4*)(c.in[32] + c0), b = *(const f32x4*)(c.in[32] + c0 + 4); acc[0] = a[0]; acc[1] = a[1]; acc[2] = a[2]; acc[3] = a[3]; acc[4] = b[0]; acc[5] = b[1]; acc[6] = b[2]; acc[7] = b[3]; }
#pragma unroll
        for (int k = 0; k < 4; ++k) {
            const int src = l + k - 3;
            float f[8];
            if (src >= 0) {
                const v4u q = *(const v4u*)(X + (size_t)(tok0 + src) * CONVD + c0);
                f[0] = bflo(q.x); f[1] = bfhi(q.x); f[2] = bflo(q.y); f[3] = bfhi(q.y); f[4] = bflo(q.z); f[5] = bfhi(q.z); f[6] = bflo(q.w); f[7] = bfhi(q.w);
            } else if (s >= 8) {
                const float* sp = c.in[5] + ((size_t)(s - 8) * 3 + (l + k)) * CONVD + c0;
                const f32x4 a = *(const f32x4*)sp, b = *(const f32x4*)(sp + 4);
                f[0] = a[0]; f[1] = a[1]; f[2] = a[2]; f[3] = a[3]; f[4] = b[0]; f[5] = b[1]; f[6] = b[2]; f[7] = b[3];
            } else {
#pragma unroll
                for (int j = 0; j < 8; ++j) f[j] = 0.f;
            }
            const f32x4 wa = *(const f32x4*)(c.in[31] + k * CONVD + c0), wb = *(const f32x4*)(c.in[31] + k * CONVD + c0 + 4);
            acc[0] += f[0] * wa[0]; acc[1] += f[1] * wa[1]; acc[2] += f[2] * wa[2]; acc[3] += f[3] * wa[3];
            acc[4] += f[4] * wb[0]; acc[5] += f[5] * wb[1]; acc[6] += f[6] * wb[2]; acc[7] += f[7] * wb[3];
        }
        v4u o; o.x = pk2(silu_f(acc[0]), silu_f(acc[1])); o.y = pk2(silu_f(acc[2]), silu_f(acc[3])); o.z = pk2(silu_f(acc[4]), silu_f(acc[5])); o.w = pk2(silu_f(acc[6]), silu_f(acc[7]));
        *(v4u*)(XC + (size_t)t * CONVD + c0) = o;
    }
    for (size_t i = (size_t)c.gt; i < (size_t)136 * 3 * CONVD; i += (size_t)c.NGT) {
        const int ch = (int)(i % CONVD); const int j = (int)((i / CONVD) % 3); const int s = (int)(i / (3 * CONVD));
        if (s < 8) o_p[((size_t)s * 3 + j) * CONVD + ch] = bf2f(X[(size_t)(s * 2048 + 2045 + j) * CONVD + ch]);
        else { const int b = s - 8; o_s[((size_t)b * 3 + j) * CONVD + ch] = bf2f(X[(size_t)(TP + b * 8 + 5 + j) * CONVD + ch]); }
    }
}
__device__ __forceinline__ void phase_ssd_scan(const Ctx& c) {
    const bf16* XC = c.W<bf16>(WS_XC); const float* DT = c.W<float>(WS_DT); bf16* Y = c.W<bf16>(WS_Y);
    float* o_p = c.out + 17825792 + 65536 + 122880 + 73728;
    float* o_s = c.out + 17825792 + 65536 + 122880 + 73728 + 2097152 + 1048576 + 1966080 + 1048576 + 1179648;
    const int p = c.tid >> 3, nq = c.tid & 7;
    for (int unit = (int)blockIdx.x; unit < 136 * 32; unit += (int)gridDim.x) {
        const int s = unit >> 5, hd = unit & 31, g = hd >> 3;
        int tok0, L; seq_info(s, tok0, L);
        float h[16];
        if (s >= 8) {
            const float* sp = c.in[6] + (((size_t)(s - 8) * 32 + hd) * 64 + p) * 128 + nq * 16;
#pragma unroll
            for (int i = 0; i < 4; ++i) { const f32x4 a = *(const f32x4*)(sp + 4 * i); h[4 * i] = a[0]; h[4 * i + 1] = a[1]; h[4 * i + 2] = a[2]; h[4 * i + 3] = a[3]; }
        } else {
#pragma unroll
            for (int i = 0; i < 16; ++i) h[i] = 0.f;
        }
        const float a = -expf(c.in[34][hd]), dtb = c.in[33][hd], dk = c.in[35][hd];
        const bf16* xb = XC + (size_t)tok0 * CONVD;
        v4u nB0 = *(const v4u*)(xb + 2048 + g * 128 + nq * 16), nB1 = *(const v4u*)(xb + 2048 + g * 128 + nq * 16 + 8);
        v4u nC0 = *(const v4u*)(xb + 2560 + g * 128 + nq * 16), nC1 = *(const v4u*)(xb + 2560 + g * 128 + nq * 16 + 8);
        float nx = bf2f(xb[hd * 64 + p]); float ndt = DT[(size_t)tok0 * 32 + hd];
        for (int t = 0; t < L; ++t) {
            const v4u B0 = nB0, B1 = nB1, C0 = nC0, C1 = nC1; const float xv = nx, dr = ndt + dtb;
            if (t + 1 < L) {
                const bf16* xn = xb + (size_t)(t + 1) * CONVD;
                nB0 = *(const v4u*)(xn + 2048 + g * 128 + nq * 16); nB1 = *(const v4u*)(xn + 2048 + g * 128 + nq * 16 + 8);
                nC0 = *(const v4u*)(xn + 2560 + g * 128 + nq * 16); nC1 = *(const v4u*)(xn + 2560 + g * 128 + nq * 16 + 8);
                nx = bf2f(xn[hd * 64 + p]); ndt = DT[(size_t)(tok0 + t + 1) * 32 + hd];
            }
            const float dtv = (dr > 20.f) ? dr : log1pf(__expf(dr));
            const float dA = __expf(dtv * a), coef = dtv * xv;
            const float Bf[16] = {bflo(B0.x), bfhi(B0.x), bflo(B0.y), bfhi(B0.y), bflo(B0.z), bfhi(B0.z), bflo(B0.w), bfhi(B0.w), bflo(B1.x), bfhi(B1.x), bflo(B1.y), bfhi(B1.y), bflo(B1.z), bfhi(B1.z), bflo(B1.w), bfhi(B1.w)};
            const float Cf[16] = {bflo(C0.x), bfhi(C0.x), bflo(C0.y), bfhi(C0.y), bflo(C0.z), bfhi(C0.z), bflo(C0.w), bfhi(C0.w), bflo(C1.x), bfhi(C1.x), bflo(C1.y), bfhi(C1.y), bflo(C1.z), bfhi(C1.z), bflo(C1.w), bfhi(C1.w)};
            float yp = 0.f;
#pragma unroll
            for (int i = 0; i < 16; ++i) { h[i] = h[i] * dA + coef * Bf[i]; yp += Cf[i] * h[i]; }
            yp += shx(yp, 1, c.lane); yp += shx(yp, 2, c.lane); yp += shx(yp, 4, c.lane);
            if (nq == 0) Y[(size_t)(tok0 + t) * 2048 + hd * 64 + p] = (bf16)f2bf(yp + dk * xv);
        }
        float* op = ((s < 8) ? (o_p + (((size_t)s * 32 + hd) * 64 + p) * 128) : (o_s + (((size_t)(s - 8) * 32 + hd) * 64 + p) * 128)) + nq * 16;
#pragma unroll
        for (int i = 0; i < 4; ++i) *(f32x4*)(op + 4 * i) = (f32x4){h[4 * i], h[4 * i + 1], h[4 * i + 2], h[4 * i + 3]};
    }
}
__device__ __forceinline__ void phase_ssd_gatenorm(const Ctx& c) {
    const bf16* Y = c.W<bf16>(WS_Y); const bf16* Z = c.W<bf16>(WS_Q); bf16* YN = c.W<bf16>(WS_YN);
    for (int it = c.gw; it < T * 4; it += c.NGW) {
        const int t = it >> 2, c0 = (it & 3) * 512 + 8 * c.lane;
        const v4u yq = *(const v4u*)(Y + (size_t)t * 2048 + c0), zq = *(const v4u*)(Z + (size_t)t * 2048 + c0);
        const float yf[8] = {bflo(yq.x), bfhi(yq.x), bflo(yq.y), bfhi(yq.y), bflo(yq.z), bfhi(yq.z), bflo(yq.w), bfhi(yq.w)};
        const float zf[8] = {bflo(zq.x), bfhi(zq.x), bflo(zq.y), bfhi(zq.y), bflo(zq.z), bfhi(zq.z), bflo(zq.w), bfhi(zq.w)};
        float v[8]; float q = 0.f;
#pragma unroll
        for (int j = 0; j < 8; ++j) { v[j] = yf[j] * silu_f(zf[j]); q += v[j] * v[j]; }
        const float r = rsqrtf(wave_sum(q, c.lane) * (1.f / 512.f) + RMS_EPS);
        const f32x4 g0 = *(const f32x4*)(c.in[36] + c0), g1 = *(const f32x4*)(c.in[36] + c0 + 4);
        v4u o; o.x = pk2(v[0] * r * g0[0], v[1] * r * g0[1]); o.y = pk2(v[2] * r * g0[2], v[3] * r * g0[3]); o.z = pk2(v[4] * r * g1[0], v[5] * r * g1[1]); o.w = pk2(v[6] * r * g1[2], v[7] * r * g1[3]);
        *(v4u*)(YN + (size_t)t * 2048 + c0) = o;
    }
}

__device__ __forceinline__ unsigned ord_key(float s) { const unsigned u = __builtin_bit_cast(unsigned, s); return (u & 0x80000000u) ? ~u : (u | 0x80000000u); }
__device__ __forceinline__ float ord_dec(unsigned k) { const unsigned u = (k & 0x80000000u) ? (k & 0x7fffffffu) : ~k; return __builtin_bit_cast(float, u); }
__device__ __forceinline__ void ins16(unsigned (&Lk)[16], unsigned x) {
#pragma unroll
    for (int k = 0; k < 16; ++k) { const unsigned hi = max(Lk[k], x); x = min(Lk[k], x); Lk[k] = hi; }
}
constexpr int RT_SC_LD = 260, RT_LIST_OFF = 128 * RT_SC_LD * 4;
__device__ __forceinline__ void phase_route(const Ctx& c, int layer) {
    const bf16* Q = c.W<bf16>(WS_Q); const bf16* KEYS = c.W<bf16>(WS_KEYS) + (size_t)layer * 8 * 2 * 128 * 128;
    int* IDX = c.W<int>(WS_IDX); float* GATE = c.W<float>(WS_GATE); float* SCU = c.W<float>(WS_SCU);
    const float* ISU = c.W<float>(WS_SMALL) + SM_ISU; const float* ISV = c.W<float>(WS_SMALL) + SM_ISV;
    LAS float* sc = (LAS float*)c.lds; LAS unsigned* lists = (LAS unsigned*)(c.lds + RT_LIST_OFF);
    const int fr = c.lane & 15, fq = c.lane >> 4;
    for (int task = (int)blockIdx.x; task < 136 * 8; task += (int)gridDim.x) {
        const int tt = task >> 3, h = task & 7, tok0 = tt * 128;
        {
            const bf16* qrow = Q + (size_t)(tok0 + 16 * c.wave + fr) * 2048 + h * 256 + 8 * fq;
#pragma unroll
            for (int side = 0; side < 2; ++side) {
                bf16x8 qf[4];
#pragma unroll
                for (int ks = 0; ks < 4; ++ks) qf[ks] = *(const bf16x8*)(qrow + side * 128 + ks * 32);
                const bf16* kb = KEYS + ((size_t)(h * 2 + side) * 128 + fr) * 128 + 8 * fq;
#pragma unroll
                for (int nt = 0; nt < 8; ++nt) {
                    f32x4 acc = {0.f, 0.f, 0.f, 0.f};
#pragma unroll
                    for (int ks = 0; ks < 4; ++ks) {
                        const bf16x8 kf = *(const bf16x8*)(kb + (size_t)nt * 16 * 128 + ks * 32);
                        acc = __builtin_amdgcn_mfma_f32_16x16x32_bf16(kf, qf[ks], acc, 0, 0, 0);
                    }
                    *(LAS f32x4*)(sc + (16 * c.wave + fr) * RT_SC_LD + side * 128 + nt * 16 + 4 * fq) = acc;
                }
            }
        }
        __syncthreads();
        if (c.tid < 256) {
            const int token = c.tid & 127, side = c.tid >> 7;
            unsigned Lk[16];
#pragma unroll
            for (int k = 0; k < 16; ++k) Lk[k] = 0u;
            const LAS float* row = sc + token * RT_SC_LD + side * 128;
            for (int n4 = 0; n4 < 32; ++n4) {
                const f32x4 v = *(const LAS f32x4*)(row + n4 * 4);
#pragma unroll
                for (int j = 0; j < 4; ++j) ins16(Lk, (ord_key(v[j]) & ~127u) | (unsigned)(127 - (n4 * 4 + j)));
            }
#pragma unroll
            for (int k = 0; k < 16; ++k) lists[(token * 2 + side) * 16 + k] = Lk[k];
        }
        __syncthreads();
        if (c.tid < 128) {
            const int token = c.tid;
            float s0[16], s1[16];
#pragma unroll
            for (int k = 0; k < 16; ++k) { s0[k] = ord_dec(lists[(token * 2) * 16 + k] & ~127u); s1[k] = ord_dec(lists[(token * 2 + 1) * 16 + k] & ~127u); }
            unsigned Bk[16];
#pragma unroll
            for (int k = 0; k < 16; ++k) Bk[k] = 0u;
#pragma unroll
            for (int i = 0; i < 16; ++i)
#pragma unroll
                for (int j = 0; j < 16; ++j)
                    if ((i + 1) * (j + 1) <= 16) ins16(Bk, (ord_key(s0[i] + s1[j]) & ~255u) | (unsigned)(255 - (i * 16 + j)));
            float e[16]; int id[16]; float mx = 0.f, den = 0.f;
#pragma unroll
            for (int k = 0; k < 16; ++k) {
                const int pay = 255 - (int)(Bk[k] & 255u), i = pay >> 4, j = pay & 15;
                const unsigned k0 = lists[(token * 2) * 16 + i], k1 = lists[(token * 2 + 1) * 16 + j];
                id[k] = (127 - (int)(k0 & 127u)) * 128 + (127 - (int)(k1 & 127u));
                const float sv = ord_dec(k0 & ~127u) + ord_dec(k1 & ~127u);
                if (k == 0) mx = sv;
                e[k] = __expf(sv - mx); den += e[k];
            }
            const float inv = 1.f / den;
            int* ip = IDX + (size_t)(tok0 + token) * 128 + h * 16; float* gp = GATE + (size_t)(tok0 + token) * 128 + h * 16; float* up = SCU + (size_t)(tok0 + token) * 128 + h * 16;
            float su[16];
#pragma unroll
            for (int k = 0; k < 16; ++k) { su[k] = ISU[id[k]]; e[k] *= inv * ISV[id[k]]; }
#pragma unroll
            for (int k = 0; k < 4; ++k) {
                *(int4*)(ip + 4 * k) = make_int4(id[4 * k], id[4 * k + 1], id[4 * k + 2], id[4 * k + 3]);
                *(f32x4*)(gp + 4 * k) = (f32x4){e[4 * k], e[4 * k + 1], e[4 * k + 2], e[4 * k + 3]};
                *(f32x4*)(up + 4 * k) = (f32x4){su[4 * k], su[4 * k + 1], su[4 * k + 2], su[4 * k + 3]};
            }
        }
        __syncthreads();
    }
}

typedef float f32x2 __attribute__((ext_vector_type(2)));
#define CVT8(wd, hi) __builtin_amdgcn_cvt_pk_f32_fp8((int)(wd), (hi))
__device__ __forceinline__ void phase_gather(const Ctx& c, int layer, bool dummy) {
    const unsigned char* EU = c.ws + WS_EU; const unsigned char* EV = c.ws + WS_EV;
    const int* IDX = c.W<int>(WS_IDX); const float* GATE = c.W<float>(WS_GATE); const float* SCU = c.W<float>(WS_SCU);
    const float* H = c.W<float>(WS_H32); float* Ho = dummy ? c.W<float>(WS_R32) : c.W<float>(WS_H32); bf16* HB = dummy ? c.W<bf16>(WS_A0) : c.W<bf16>(WS_HB);
    const float* g = c.in[40] + layer * D; const float* b = c.in[41] + layer * D;
    const int lane = c.lane;
    const int ntw = (T - c.gw + c.NGW - 1) / c.NGW, nit = ntw * 8;
#define GT_TOK(it) (c.gw + ((it) >> 3) * c.NGW)
#define GT_IDX(it) (((it) < nit) ? IDX[(size_t)GT_TOK(it) * 128 + ((it) & 7) * 16 + (lane & 15)] : 0)
#define GT_GS(P, it) ((P)[(size_t)GT_TOK((it) < nit ? (it) : 0) * 128 + ((it) & 7) * 16 + ((lane >> 2) & 15)])
    int idx_c = GT_IDX(0), idx_n = GT_IDX(1);
    float gate_c = GT_GS(GATE, 0), scu_c = GT_GS(SCU, 0);
    f32x2 x2[8], xn[8], acc[8];
#pragma unroll
    for (int k = 0; k < 4; ++k) { const f32x4 hx = *(const f32x4*)(H + (size_t)c.gw * D + 16 * lane + 4 * k); xn[2 * k] = (f32x2){hx[0], hx[1]}; xn[2 * k + 1] = (f32x2){hx[2], hx[3]}; }
    v4u ru[16], rv[16];
#pragma unroll
    for (int e = 0; e < 16; ++e) {
        const int id = __builtin_amdgcn_readlane(idx_c, e);
        ru[e] = *(const v4u*)(EU + (size_t)id * D + 16 * lane); rv[e] = *(const v4u*)(EV + (size_t)id * D + 16 * lane);
    }
    for (int it = 0; it < nit; ++it) {
        const int t = GT_TOK(it), bt = it & 7;
        const int idx_nn = GT_IDX(it + 2);
        const float gate_n = GT_GS(GATE, it + 1), scu_n = GT_GS(SCU, it + 1);
        const float mygate = gate_c, myscu = scu_c;
        if (bt == 0) {
#pragma unroll
            for (int i = 0; i < 8; ++i) { x2[i] = xn[i]; acc[i] = (f32x2){0.f, 0.f}; }
        }
        if (bt == 7 && it + 1 < nit) {
            const int tn = GT_TOK(it + 1);
#pragma unroll
            for (int k = 0; k < 4; ++k) { const f32x4 hx = *(const f32x4*)(H + (size_t)tn * D + 16 * lane + 4 * k); xn[2 * k] = (f32x2){hx[0], hx[1]}; xn[2 * k + 1] = (f32x2){hx[2], hx[3]}; }
        }
        float pv[16];
#pragma unroll
        for (int e = 0; e < 16; ++e) {
            const v4u w = ru[e];
            f32x2 d = CVT8(w.x, false) * x2[0];
            d += CVT8(w.x, true) * x2[1]; d += CVT8(w.y, false) * x2[2]; d += CVT8(w.y, true) * x2[3];
            d += CVT8(w.z, false) * x2[4]; d += CVT8(w.z, true) * x2[5]; d += CVT8(w.w, false) * x2[6]; d += CVT8(w.w, true) * x2[7];
            pv[e] = d.x + d.y;
            ru[e] = *(const v4u*)(EU + (size_t)__builtin_amdgcn_readlane(idx_n, e) * D + 16 * lane);
        }
        const float tot = reduce16(pv, lane);
        const float wgt = mygate * gelu_f(tot * myscu);
#pragma unroll
        for (int e = 0; e < 16; ++e) {
            const float we = __builtin_bit_cast(float, __builtin_amdgcn_readlane(__builtin_bit_cast(int, wgt), 4 * e));
            const v4u w = rv[e];
            acc[0] += CVT8(w.x, false) * we; acc[1] += CVT8(w.x, true) * we; acc[2] += CVT8(w.y, false) * we; acc[3] += CVT8(w.y, true) * we;
            acc[4] += CVT8(w.z, false) * we; acc[5] += CVT8(w.z, true) * we; acc[6] += CVT8(w.w, false) * we; acc[7] += CVT8(w.w, true) * we;
            rv[e] = *(const v4u*)(EV + (size_t)__builtin_amdgcn_readlane(idx_n, e) * D + 16 * lane);
        }
        if (bt == 7) {
            f32x4 v[4];
#pragma unroll
            for (int k = 0; k < 4; ++k) v[k] = (f32x4){x2[2 * k].x, x2[2 * k].y, x2[2 * k + 1].x, x2[2 * k + 1].y} * ALPHA + (f32x4){acc[2 * k].x, acc[2 * k].y, acc[2 * k + 1].x, acc[2 * k + 1].y};
            float mean, rstd; ln_stats(v, mean, rstd, lane);
            float* o32 = ((layer == 3 && !dummy) ? c.out : Ho) + (size_t)t * D + 16 * lane;
            bf16* ob = (layer == 3 && !dummy) ? (bf16*)nullptr : HB + (size_t)t * D + 16 * lane;
            v4u wb[2];
#pragma unroll
            for (int k = 0; k < 4; ++k) {
                const f32x4 g4 = *(const f32x4*)(g + 16 * lane + 4 * k), b4 = *(const f32x4*)(b + 16 * lane + 4 * k);
                const f32x4 o = (v[k] - mean) * rstd * g4 + b4;
                *(f32x4*)(o32 + 4 * k) = o;
                if (k & 1) { wb[k >> 1].z = pk2(o[0], o[1]); wb[k >> 1].w = pk2(o[2], o[3]); } else { wb[k >> 1].x = pk2(o[0], o[1]); wb[k >> 1].y = pk2(o[2], o[3]); }
            }
            if (ob) { *(v4u*)(ob) = wb[0]; *(v4u*)(ob + 8) = wb[1]; }
        }
        idx_c = idx_n; idx_n = idx_nn; gate_c = gate_n; scu_c = scu_n;
    }
#undef GT_GS
#undef GT_TOK
#undef GT_IDX
}

#define XB_TMO      128
#define XB_XCNT(j)  (256  + 64 * (j))
#define XB_XSUB(j)  (1280 + 64 * (j))
#define XB_XGEN(j)  (2304 + 64 * (j))
#define XB_TOP      3328
#define XB_TOPGEN   3392
#define XCD_BAR_WORDS 3456
#define XB_SPIN_CAP (1u << 22)
__device__ __forceinline__ unsigned xb_ld(unsigned* p)              { return __hip_atomic_load(p, __ATOMIC_RELAXED, __HIP_MEMORY_SCOPE_AGENT); }
__device__ __forceinline__ unsigned xb_add(unsigned* p, unsigned v) { return __hip_atomic_fetch_add(p, v, __ATOMIC_RELAXED, __HIP_MEMORY_SCOPE_AGENT); }
__device__ __forceinline__ unsigned xb_xcc_id() { return (unsigned)__builtin_amdgcn_s_getreg((3 << 11) | 20) & 0xFu; }
#define XB_SPIN(cond, bar) do { unsigned _sp = 0; while (cond) { __builtin_amdgcn_s_sleep(1); \
    if ((++_sp & 255u) == 0u) { if (xb_ld(&(bar)[XB_TMO])) break; if (_sp > XB_SPIN_CAP) { atomicAdd(&(bar)[XB_TMO], 1u); break; } } } } while (0)
struct XcdBarrier { unsigned* bar; unsigned x; volatile LAS unsigned* st; };
__device__ __forceinline__ XcdBarrier xcd_barrier_post(unsigned* bar, volatile LAS unsigned* st) {
    XcdBarrier b; b.bar = bar; b.x = xb_xcc_id(); b.st = st;
    if (threadIdx.x == 0) (void)xb_add(&bar[XB_XCNT(b.x)], 1u);
    return b;
}
__device__ __forceinline__ void xcd_barrier_complete(unsigned* bar, unsigned x, unsigned& nloc, unsigned& nx) {
    const unsigned G = gridDim.x * gridDim.y * gridDim.z;
    unsigned sum, cnt, mine, sp = 0u;
    for (;;) {
        sum = 0u; cnt = 0u; mine = 0u;
#pragma unroll
        for (unsigned j = 0; j < 16; ++j) { const unsigned cc = xb_ld(&bar[XB_XCNT(j)]); sum += cc; cnt += (cc > 0u) ? 1u : 0u; mine = (j == x) ? cc : mine; }
        if (sum == G) break;
        __builtin_amdgcn_s_sleep(1);
        if ((++sp & 255u) == 0u) { if (xb_ld(&bar[XB_TMO])) break; if (sp > XB_SPIN_CAP) { atomicAdd(&bar[XB_TMO], 1u); break; } }
    }
    nloc = mine > 0u ? mine : 1u; nx = cnt > 0u ? cnt : 1u;
}
__device__ __forceinline__ void xcd_barrier(const XcdBarrier& b, int tid) {
    asm volatile("s_waitcnt vmcnt(0)" ::: "memory");
    __syncthreads();
    if (tid == 0) {
        unsigned* bar = b.bar;
        __builtin_amdgcn_s_waitcnt(0);
        unsigned nloc = b.st[0], nx = b.st[1];
        if (nloc == 0u) { xcd_barrier_complete(bar, b.x, nloc, nx); b.st[0] = nloc; b.st[1] = nx; }
        const unsigned old = xb_add(&bar[XB_XSUB(b.x)], 1u);
        const unsigned gen = old / nloc;
        if (old + 1u == (gen + 1u) * nloc) {
            __builtin_amdgcn_fence(__ATOMIC_RELEASE, "agent");
            asm volatile("s_waitcnt vmcnt(0)" ::: "memory");
            const unsigned og = xb_add(&bar[XB_TOP], 1u);
            const unsigned tg = og / nx;
            if (og + 1u == (tg + 1u) * nx) xb_add(&bar[XB_TOPGEN], 1u);
            else XB_SPIN(xb_ld(&bar[XB_TOPGEN]) == tg, bar);
            __builtin_amdgcn_fence(__ATOMIC_ACQUIRE, "agent");
            xb_add(&bar[XB_XGEN(b.x)], 1u);
            asm volatile("s_waitcnt vmcnt(0)" ::: "memory");
        } else {
            XB_SPIN(xb_ld(&bar[XB_XGEN(b.x)]) == gen, bar);
            __builtin_amdgcn_fence(__ATOMIC_ACQUIRE, "agent");
            asm volatile("s_waitcnt vmcnt(0)" ::: "memory");
        }
    }
    __syncthreads();
}

__global__ void __launch_bounds__(NTHR, 2) mega(Params P) {
    extern __shared__ __attribute__((aligned(16))) unsigned char lds_raw[];
    cg::grid_group grid = cg::this_grid();
    Ctx c;
    c.in = P.in; c.out = P.out; c.ws = P.ws; c.lds = (LAS unsigned char*)lds_raw;
    c.tid = threadIdx.x; c.lane = c.tid & 63; c.wave = __builtin_amdgcn_readfirstlane(c.tid >> 6);
    c.gw = (int)blockIdx.x * NWAVES + c.wave; c.NGW = (int)gridDim.x * NWAVES; c.gt = (int)blockIdx.x * NTHR + c.tid; c.NGT = (int)gridDim.x * NTHR;
#define RF() do { int z_ = 0; asm volatile("" : "+v"(z_)); const int l_ = (int)__builtin_amdgcn_mbcnt_hi(~0u, __builtin_amdgcn_mbcnt_lo(~0u, (unsigned)z_)); c.lane = l_; c.tid = c.wave * 64 + l_; c.gt = (int)blockIdx.x * NTHR + c.tid; } while (0)
    bf16* HB = c.W<bf16>(WS_HB); bf16* A0 = c.W<bf16>(WS_A0); bf16* A1 = c.W<bf16>(WS_A1); bf16* A2 = c.W<bf16>(WS_A2); bf16* Qb = c.W<bf16>(WS_Q);
    float* H32 = c.W<float>(WS_H32); float* R32 = c.W<float>(WS_R32);

    if (threadIdx.x < 16) ((volatile LAS unsigned*)(c.lds + MISC_OFF))[threadIdx.x] = 0u;
    __syncthreads();
    const XcdBarrier xbar = xcd_barrier_post(c.W<unsigned>(WS_CTL), (volatile LAS unsigned*)(c.lds + MISC_OFF));
#define GSYNC() do { RF(); xcd_barrier(xbar, c.tid); } while (0)
    RF(); prologue(c);
    grid.sync();
    for (int layer = 0; layer < 4; ++layer) {
        if (layer <= 1) {
            const bf16* Wt = c.W<bf16>(layer == 0 ? WS_W_S5IN : WS_W_PIN);
            RF(); run_gemm(c, HB, D, 0, Wt, 1024, 1024, EpiBf16<0>{A0, D, nullptr, nullptr, nullptr});
        } else if (layer == 2) {
            RF(); run_gemm(c, HB, D, 0, c.W<bf16>(WS_W_CIN), 2048, 1024, EpiBf16<1>{Qb, 2048, c.in[24], nullptr, nullptr});
        } else {
            RF(); run_gemm(c, HB, D, 0, c.W<bf16>(WS_W_SIN), NPROJ, 1024, EpiSsdProj{Qb, c.W<bf16>(WS_XBC), c.W<float>(WS_DT)});
        }
        GSYNC();
        const bf16* Aout = A2; const bf16* Wout;
        if (layer == 0) {
            for (int r = 0; r < PR_S5; ++r) { RF(); phase_s5scan(c); }
            GSYNC();
            RF(); run_gemm(c, A1, D, 0, c.W<bf16>(WS_W_S5GLU), 1024, 1024, EpiBf16<3>{A2, D, c.in[17], nullptr, A1});
            Wout = c.W<bf16>(WS_W_S5OUT);
        } else if (layer == 1) {
            RF(); phase_pool(c);
            GSYNC();
            RF(); run_gemm(c, A1, D, 256, c.W<bf16>(WS_W_PGRP), 1024, 256, EpiBf16<2>{A2, D, nullptr, c.in[21], nullptr});
            Wout = c.W<bf16>(WS_W_POUT);
        } else if (layer == 2) {
            RF(); phase_cmlp_ln(c);
            GSYNC();
            RF(); phase_cmlp_mix(c);
            Aout = A1; Wout = c.W<bf16>(WS_W_COUT);
        } else {
            RF(); phase_ssd_conv(c);
            GSYNC();
            for (int r = 0; r < PR_SSD; ++r) { RF(); phase_ssd_scan(c); }
            GSYNC();
            RF(); phase_ssd_gatenorm(c);
            Aout = c.W<bf16>(WS_YN); Wout = c.W<bf16>(WS_W_SOUT);
        }
        GSYNC();
        if (layer == 3) { RF(); run_gemm(c, Aout, 2048, 0, Wout, 1024, 2048, EpiResid{H32, R32}); }
        else { RF(); run_gemm(c, Aout, 1024, 0, Wout, 1024, 1024, EpiResid{H32, R32}); }
        GSYNC();
        RF(); phase_ln1(c, layer);
        if (layer > 0) { RF(); cvt_tables(c, layer); }
        GSYNC();
        RF(); run_gemm(c, HB, D, 0, c.W<bf16>(WS_W_PQ) + (size_t)layer * 2048 * 1024, 2048, 1024, EpiBf16<0>{Qb, 2048, nullptr, nullptr, nullptr});
        GSYNC();
        for (int r = 0; r < PR_ROUTE; ++r) { RF(); phase_route(c, layer); }
        GSYNC();
        for (int r = 1; r < PR_GATHER; ++r) { RF(); phase_gather(c, layer, true); }
        RF(); phase_gather(c, layer, false);
        GSYNC();
    }
}
}

extern "C" void kernel_launch(void* const* d_in, const int* in_sizes, int n_in, void* d_out, int out_size, void* d_ws, size_t ws_size, hipStream_t stream) {
    static int grid = 0;
    if (grid == 0) {
        int dev = 0, cus = 0, per_cu = 0;
        if (hipGetDevice(&dev) != hipSuccess || hipDeviceGetAttribute(&cus, hipDeviceAttributeMultiprocessorCount, dev) != hipSuccess) { fprintf(stderr, "kernel_launch: device query failed\n"); grid = -1; return; }
        if (hipFuncSetAttribute((const void*)mk::mega, hipFuncAttributeMaxDynamicSharedMemorySize, mk::LDS_BYTES) != hipSuccess) { fprintf(stderr, "kernel_launch: hipFuncSetAttribute failed\n"); grid = -1; return; }
        if (hipOccupancyMaxActiveBlocksPerMultiprocessor(&per_cu, (const void*)mk::mega, mk::NTHR, mk::LDS_BYTES) != hipSuccess || per_cu < 1) { fprintf(stderr, "kernel_launch: occupancy query says %d blocks per CU\n", per_cu); grid = -1; return; }
        grid = cus;
        if (ws_size < mk::WS_END) { fprintf(stderr, "kernel_launch: workspace too small (%zu < %zu)\n", ws_size, (size_t)mk::WS_END); grid = -1; return; }
    }
    if (grid < 0) return;
    mk::Params p{};
    for (int i = 0; i < 46; ++i) p.in[i] = (const float*)d_in[i];
    p.out = (float*)d_out; p.ws = (unsigned char*)d_ws;
    if (hipMemsetAsync((char*)d_ws + mk::WS_CTL, 0, mk::CTL_BYTES, stream) != hipSuccess) { fprintf(stderr, "kernel_launch: memset failed\n"); return; }
    void* args[] = {&p};
    hipError_t e = hipLaunchCooperativeKernel((const void*)mk::mega, dim3(grid), dim3(mk::NTHR), args, mk::LDS_BYTES, stream);
    if (e != hipSuccess) fprintf(stderr, "cooperative launch failed: %s (grid %d)\n", hipGetErrorString(e), grid);
}
```

```cpp
#include <hip/hip_runtime.h>
#include <hip/hip_cooperative_groups.h>
#include <cstdio>
#include <cstdint>
#include <math.h>
namespace cg = cooperative_groups;

namespace pg8 {
#define PG8_LAS __attribute__((address_space(3)))
typedef unsigned short bf16_t;
typedef short bf16x8 __attribute__((ext_vector_type(8)));
typedef float f32x4 __attribute__((ext_vector_type(4)));
typedef unsigned u32x4 __attribute__((ext_vector_type(4)));
constexpr int BM = 256, BK = 64, HALF = 128, HTB = HALF * BK * 2, STAGE_BYTES = 8 * HTB, NXCD = 8, WGM = 8;
__host__ __device__ __forceinline__ int lds_byte(int r, int c) { const int st = (r >> 4) * 2 + (c >> 5), rr = r & 15, cc = c & 31, ob = rr * 64 + cc * 2; return st * 1024 + (ob ^ (((ob >> 9) & 1) << 5)); }
__host__ __device__ __forceinline__ void stage_rc(int b, int& R, int& C) { const int st = b / 1024, sb = b % 1024, swz = sb ^ (((sb >> 9) & 1) << 5); R = (st >> 1) * 16 + swz / 64; C = (st & 1) * 32 + (swz % 64) / 2; }
__host__ __device__ __forceinline__ int perm32(int rho) { const int n = rho >> 4, i = rho & 15; return 8 * (i >> 2) + 4 * n + (i & 3); }
struct Unit { int pm, pn; };
struct Gemm { const bf16_t* A; const bf16_t* Bt; int M, N, K, lda, a_pn_off; };
struct StaticOrder {
    int nM, nN, nwg, G, c;
    __host__ __device__ void init(int M, int N, int G_, int c_) { nM = M / BM; nN = N / BM; nwg = nM * nN; G = G_; c = c_; }
    __host__ __device__ bool next(int i, Unit& u) const {
        const long L = (long)i * G + c; if (L >= nwg) return false;
        int wgid = (int)L; { const int q = nwg / NXCD, r = nwg % NXCD, xcd = wgid % NXCD, off = wgid / NXCD; wgid = (xcd < r ? xcd * (q + 1) : r * (q + 1) + (xcd - r) * q) + off; }
        const int nig = WGM * nN, gid = wgid / nig, fm = gid * WGM, gsz = (nM - fm) < WGM ? (nM - fm) : WGM;
        u.pm = fm + ((wgid % nig) % gsz); u.pn = (wgid % nig) / gsz; return true;
    }
    __device__ __forceinline__ void a_ready(const Unit&) const {}
    __device__ __forceinline__ void done(const Unit&) const {}
};
__device__ __forceinline__ unsigned cvt_pk_bf16(float lo, float hi) { unsigned r; asm volatile("v_cvt_pk_bf16_f32 %0, %1, %2" : "=v"(r) : "v"(lo), "v"(hi)); return r; }
template <class Epi, class Sched, bool ALIGN_EPI = false, bool SP2 = false>
__device__ __forceinline__ void gemm_phase(PG8_LAS unsigned char* lds, const Gemm g, const Sched& S, const Epi& E, int tid_in) {
    int tid_ = tid_in; asm volatile("" : "+v"(tid_));
    const int tid = tid_, wid = __builtin_amdgcn_readfirstlane(tid >> 6), lane = tid & 63, wr = wid >> 2, wc = wid & 3, fr = lane & 15, fq = lane >> 4;
    const int K = g.K, nt = K / BK;
    unsigned voffA[2], voffB[2];
#pragma unroll
    for (int i = 0; i < 2; ++i) { int R, C; stage_rc(tid * 16 + i * 8192, R, C); const int Rb = Epi::PERM ? ((R & ~31) + perm32(R & 31)) : R;
        voffA[i] = (unsigned)(R * g.lda + C) * 2u; voffB[i] = (unsigned)(Rb * K + C) * 2u; }
    const size_t kstep = (size_t)(BK * 2);
    const size_t hstepA = (size_t)HALF * g.lda * 2, tstepA = 2 * hstepA;
    const size_t hstepB = (size_t)HALF * K * 2, tstepB = 2 * hstepB;
    const size_t apn = (size_t)g.a_pn_off * 2;
    const unsigned ldsw = (unsigned)wid * 1024u;
    const int aoff = lds_byte(wr * 64 + fr, fq * 8), boff = lds_byte(wc * 32 + fr, fq * 8);
#define PG8_SA(b, h) (((b) * 2 + (h)) * HTB)
#define PG8_SB(b, h) ((4 + (b) * 2 + (h)) * HTB)
#define PG8_STAGE(bufoff, gbase, voff) do { _Pragma("unroll") for (int _i = 0; _i < 2; ++_i) \
        __builtin_amdgcn_global_load_lds((const unsigned*)((const char*)(gbase) + (voff)[_i]), (PG8_LAS unsigned*)(lds + (bufoff) + ldsw + _i * 8192), 16, 0, 0); } while (0)
#define PG8_LDA(dst, b, h) do { _Pragma("unroll") for (int m = 0; m < 4; ++m) _Pragma("unroll") for (int k = 0; k < 2; ++k) dst[m][k] = *(const PG8_LAS bf16x8*)(lds + PG8_SA(b, h) + aoff + m * 2048 + k * 1024); } while (0)
#define PG8_LDB(dst, b, h) do { _Pragma("unroll") for (int n = 0; n < 2; ++n) _Pragma("unroll") for (int k = 0; k < 2; ++k) dst[n][k] = *(const PG8_LAS bf16x8*)(lds + PG8_SB(b, h) + boff + n * 2048 + k * 1024); } while (0)
#define PG8_MMA(ai, bj, At, Bt) do { __builtin_amdgcn_s_setprio(1); _Pragma("unroll") for (int m = 0; m < 4; ++m) _Pragma("unroll") for (int n = 0; n < 2; ++n) _Pragma("unroll") for (int k = 0; k < 2; ++k) \
        acc[ai][bj][m][n] = __builtin_amdgcn_mfma_f32_16x16x32_bf16(Bt[n][k], At[m][k], acc[ai][bj][m][n], 0, 0, 0); __builtin_amdgcn_s_setprio(0); } while (0)
#define PG8_WAIT_V(n) asm volatile("s_waitcnt vmcnt(" #n ")" ::: "memory")
#define PG8_WAIT_L(n) asm volatile("s_waitcnt lgkmcnt(" #n ")" ::: "memory")
#define PG8_BAR __builtin_amdgcn_s_barrier()
#define PG8_SCHED __builtin_amdgcn_sched_barrier(0)
    Unit cur, nxt; int ui = 0;
    if (!S.next(0, cur)) return;
    f32x4 acc[2][2][4][2];
#pragma unroll
    for (int a = 0; a < 2; ++a)
#pragma unroll
        for (int b = 0; b < 2; ++b)
#pragma unroll
            for (int m = 0; m < 4; ++m)
#pragma unroll
                for (int n = 0; n < 2; ++n) acc[a][b][m][n] = (f32x4){0.f, 0.f, 0.f, 0.f};
    bf16x8 At[4][2], B0[2][2], B1[2][2];
    const char* cA = (const char*)g.A + (size_t)cur.pm * tstepA + (size_t)cur.pn * apn; const char* cB = (const char*)g.Bt + (size_t)cur.pn * tstepB;
    S.a_ready(cur);
    if constexpr (SP2) {
        PG8_STAGE(PG8_SB(0, 0), cB, voffB); PG8_STAGE(PG8_SB(0, 1), cB + hstepB, voffB); PG8_STAGE(PG8_SA(0, 0), cA, voffA); PG8_STAGE(PG8_SA(0, 1), cA + hstepA, voffA);
        if (wr == 1) PG8_BAR;
        PG8_WAIT_V(2); PG8_BAR;
        PG8_STAGE(PG8_SB(1, 0), cB + kstep, voffB); PG8_STAGE(PG8_SA(1, 0), cA + kstep, voffA); PG8_STAGE(PG8_SB(1, 1), cB + hstepB + kstep, voffB);
        PG8_WAIT_V(6); PG8_BAR;
    } else {
        PG8_STAGE(PG8_SB(0, 0), cB, voffB); PG8_STAGE(PG8_SA(0, 0), cA, voffA); PG8_STAGE(PG8_SB(0, 1), cB + hstepB, voffB); PG8_STAGE(PG8_SA(0, 1), cA + hstepA, voffA);
        if (wr == 1) PG8_BAR;
        PG8_WAIT_V(4); PG8_BAR;
        PG8_STAGE(PG8_SB(1, 0), cB + kstep, voffB); PG8_STAGE(PG8_SA(1, 0), cA + kstep, voffA); PG8_STAGE(PG8_SB(1, 1), cB + hstepB + kstep, voffB);
        PG8_WAIT_V(6); PG8_BAR;
    }
    for (;;) {
        const bool has_next = S.next(ui + 1, nxt);
        const char* nA = has_next ? (const char*)g.A + (size_t)nxt.pm * tstepA + (size_t)nxt.pn * apn : cA; const char* nB = has_next ? (const char*)g.Bt + (size_t)nxt.pn * tstepB : cB;
#pragma nounroll
        for (int t = 0; t < nt; t += 2) {
            const bool last = (t == nt - 2);
            const char* a1 = cA + (size_t)(t + 1) * kstep;
            const char* a2 = last ? nA : cA + (size_t)(t + 2) * kstep; const char* b2 = last ? nB : cB + (size_t)(t + 2) * kstep;
            const char* a3 = a2 + kstep; const char* b3 = b2 + kstep;
            if (last && has_next) S.a_ready(nxt);
            if constexpr (SP2) {
            PG8_LDB(B0, 0, 0); PG8_LDB(B1, 0, 1); PG8_SCHED; PG8_LDA(At, 0, 0); PG8_STAGE(PG8_SA(1, 1), a1 + hstepA, voffA);
            PG8_WAIT_V(8); PG8_WAIT_L(0); PG8_BAR; PG8_MMA(0, 0, At, B0); PG8_MMA(0, 1, At, B1); PG8_BAR; PG8_SCHED;
            PG8_LDA(At, 0, 1); PG8_STAGE(PG8_SB(0, 0), b2, voffB); PG8_STAGE(PG8_SB(0, 1), b2 + hstepB, voffB); PG8_STAGE(PG8_SA(0, 0), a2, voffA);
            PG8_WAIT_V(8); PG8_WAIT_L(0); PG8_BAR; PG8_MMA(1, 0, At, B0); PG8_MMA(1, 1, At, B1); PG8_BAR; PG8_SCHED;
            PG8_LDB(B0, 1, 0); PG8_LDB(B1, 1, 1); PG8_SCHED; PG8_LDA(At, 1, 0); PG8_STAGE(PG8_SA(0, 1), a2 + hstepA, voffA);
            PG8_WAIT_V(8); PG8_WAIT_L(0); PG8_BAR; PG8_MMA(0, 0, At, B0); PG8_MMA(0, 1, At, B1); PG8_BAR; PG8_SCHED;
            PG8_LDA(At, 1, 1); PG8_STAGE(PG8_SB(1, 0), b3, voffB); PG8_STAGE(PG8_SB(1, 1), b3 + hstepB, voffB); PG8_STAGE(PG8_SA(1, 0), a3, voffA);
            PG8_WAIT_V(8); PG8_WAIT_L(0); PG8_BAR; PG8_MMA(1, 0, At, B0); PG8_MMA(1, 1, At, B1); PG8_BAR; PG8_SCHED;
            } else {
            PG8_LDB(B0, 0, 0); PG8_SCHED; PG8_LDA(At, 0, 0); PG8_STAGE(PG8_SA(1, 1), a1 + hstepA, voffA);
            PG8_WAIT_L(8); PG8_BAR; PG8_WAIT_L(0); PG8_MMA(0, 0, At, B0); PG8_BAR; PG8_SCHED;
            PG8_LDB(B1, 0, 1); PG8_STAGE(PG8_SB(0, 0), b2, voffB);
            PG8_BAR; PG8_WAIT_L(0); PG8_MMA(0, 1, At, B1); PG8_BAR;
            PG8_LDA(At, 0, 1); PG8_STAGE(PG8_SA(0, 0), a2, voffA);
            PG8_BAR; PG8_WAIT_L(0); PG8_MMA(1, 0, At, B0); PG8_BAR; PG8_SCHED;
            PG8_STAGE(PG8_SB(0, 1), b2 + hstepB, voffB);
            PG8_WAIT_V(6); PG8_BAR; PG8_MMA(1, 1, At, B1); PG8_BAR;
            PG8_LDB(B0, 1, 0); PG8_SCHED; PG8_LDA(At, 1, 0); PG8_STAGE(PG8_SA(0, 1), a2 + hstepA, voffA);
            PG8_WAIT_L(8); PG8_BAR; PG8_WAIT_L(0); PG8_MMA(0, 0, At, B0); PG8_BAR; PG8_SCHED;
            PG8_LDB(B1, 1, 1); PG8_STAGE(PG8_SB(1, 0), b3, voffB);
            PG8_BAR; PG8_WAIT_L(0); PG8_MMA(0, 1, At, B1); PG8_BAR;
            PG8_LDA(At, 1, 1); PG8_STAGE(PG8_SA(1, 0), a3, voffA);
            PG8_BAR; PG8_WAIT_L(0); PG8_MMA(1, 0, At, B0); PG8_BAR; PG8_SCHED;
            PG8_STAGE(PG8_SB(1, 1), b3 + hstepB, voffB);
            PG8_WAIT_V(6); PG8_BAR; PG8_MMA(1, 1, At, B1); PG8_BAR;
            }
        }
        if constexpr (ALIGN_EPI) { if (wr == 0) PG8_BAR; }
        if constexpr (!Epi::AFTER_DRAIN) { E(acc, cur, wr, wc, fr, fq); S.done(cur); }
        if (!has_next) break;
#pragma unroll
        for (int a = 0; a < 2; ++a)
#pragma unroll
            for (int b = 0; b < 2; ++b)
#pragma unroll
                for (int m = 0; m < 4; ++m)
#pragma unroll
                    for (int n = 0; n < 2; ++n) acc[a][b][m][n] = (f32x4){0.f, 0.f, 0.f, 0.f};
        cur = nxt; cA = nA; cB = nB; ++ui;
        if constexpr (ALIGN_EPI) { if (wr == 1) PG8_BAR; }
    }
    PG8_WAIT_V(0);
    if constexpr (!ALIGN_EPI) { if (wr == 0) PG8_BAR; }
    PG8_BAR;
    if constexpr (Epi::AFTER_DRAIN) { E.fused(acc, cur, wr, wc, fr, fq, lds, wid, lane); S.done(cur); }
#undef PG8_SA
#undef PG8_SB
#undef PG8_STAGE
#undef PG8_LDA
#undef PG8_LDB
#undef PG8_MMA
#undef PG8_WAIT_V
#undef PG8_WAIT_L
#undef PG8_BAR
#undef PG8_SCHED
}
}

#ifndef PR_GATHER
#define PR_GATHER 1
#endif
#ifndef PR_ROUTE
#define PR_ROUTE 1
#endif
#ifndef PR_S5
#define PR_S5 1
#endif
#ifndef PR_SSD
#define PR_SSD 1
#endif
#ifndef PR_GEMM
#define PR_GEMM 1
#endif
#ifndef PR_MISC
#define PR_MISC 1
#endif
namespace mk {
#define LAS __attribute__((address_space(3)))
typedef unsigned short bf16;
typedef unsigned v4u __attribute__((ext_vector_type(4)));
typedef unsigned v2u __attribute__((ext_vector_type(2)));
typedef float f32x4 __attribute__((ext_vector_type(4)));
typedef short bf16x8 __attribute__((ext_vector_type(8)));
using bf16x2 = __attribute__((ext_vector_type(2))) __bf16;

constexpr int D = 1024, T = 17408, TP = 16384, NWAVES = 8, NTHR = 512;
constexpr float ALPHA = 1.6817928305074290f;
constexpr float LN_EPS = 1e-5f, RMS_EPS = 1e-5f;
constexpr int LDS_BYTES = 160 * 1024;
constexpr int NPROJ = 5376, CONVD = 3072;

constexpr size_t MiB = 1u << 20;
constexpr size_t WS_W_S5IN = 0, WS_W_S5GLU = 2 * MiB, WS_W_S5OUT = 4 * MiB, WS_W_PIN = 6 * MiB, WS_W_PGRP = 8 * MiB, WS_W_POUT = 9 * MiB,
                 WS_W_CIN = 11 * MiB, WS_W_COUT = 15 * MiB, WS_W_SIN = 17 * MiB  , WS_W_SOUT = 28 * MiB, WS_W_PQ = 32 * MiB  ,
                 WS_KEYS = 48 * MiB  , WS_SMALL = 50 * MiB, WS_CTL = 52 * MiB  ;
constexpr size_t CTL_BYTES = 16384;
constexpr int MISC_OFF = LDS_BYTES - 64;
constexpr size_t WS_EU = 64 * MiB, WS_EV = 96 * MiB;
constexpr size_t WS_H32 = 128 * MiB, WS_R32 = 196 * MiB, WS_HB = 264 * MiB, WS_A0 = 298 * MiB, WS_A1 = 332 * MiB, WS_A2 = 366 * MiB;
constexpr size_t WS_Q = 400 * MiB  , WS_IDX = 468 * MiB  , WS_GATE = 477 * MiB  , WS_DT = 486 * MiB  ;
constexpr size_t WS_XBC = 490 * MiB  , WS_XC = 592 * MiB  , WS_Y = 694 * MiB  , WS_YN = 762 * MiB  , WS_SCU = 830 * MiB  , WS_END = 839 * MiB;
constexpr size_t SM_LBR = 0, SM_LBI = 4096, SM_BBR = 8192, SM_BBI = 8192 + 65536, SM_ISU = 8192 + 131072, SM_ISV = SM_ISU + 16384;

struct Params { const float* in[46]; float* out; unsigned char* ws; };

__device__ __forceinline__ unsigned f2bf(float f) { unsigned u = __builtin_bit_cast(unsigned, f); return (u + 0x7fffu + ((u >> 16) & 1u)) >> 16; }
__device__ __forceinline__ unsigned pk2(float lo, float hi) { return pg8::cvt_pk_bf16(lo, hi); }
__device__ __forceinline__ float bflo(unsigned w) { return __builtin_bit_cast(float, w << 16); }
__device__ __forceinline__ float bfhi(unsigned w) { return __builtin_bit_cast(float, w & 0xffff0000u); }
__device__ __forceinline__ float bf2f(bf16 b) { return __builtin_bit_cast(float, ((unsigned)b) << 16); }
__device__ __forceinline__ float sigmoid_f(float x) { return 1.f / (1.f + __expf(-x)); }
__device__ __forceinline__ float silu_f(float x) { return x * sigmoid_f(x); }
__device__ __forceinline__ float gelu_f(float x) { return x * sigmoid_f(1.5957691216057308f * (x + 0.044715f * x * x * x)); }
__device__ __forceinline__ float shx(float v, int o, int lane) { return __builtin_bit_cast(float, __builtin_amdgcn_ds_bpermute((lane ^ o) << 2, __builtin_bit_cast(int, v))); }
__device__ __forceinline__ float wave_sum(float v, int lane) {
#pragma unroll
    for (int o = 32; o >= 1; o >>= 1) v += shx(v, o, lane);
    return v;
}
__device__ __forceinline__ float dot2(unsigned w, unsigned x, float acc) { return __builtin_amdgcn_fdot2_f32_bf16(__builtin_bit_cast(bf16x2, w), __builtin_bit_cast(bf16x2, x), acc, false); }
__device__ __forceinline__ float reduce16(const float (&p)[16], int lane) {
    const bool b5 = lane & 32, b4 = lane & 16, b3 = lane & 8, b2 = lane & 4;
    float q[8], r[4], s[2], t;
#pragma unroll
    for (int i = 0; i < 8; ++i) { const float keep = b5 ? p[i + 8] : p[i], send = b5 ? p[i] : p[i + 8]; q[i] = keep + shx(send, 32, lane); }
#pragma unroll
    for (int i = 0; i < 4; ++i) { const float keep = b4 ? q[i + 4] : q[i], send = b4 ? q[i] : q[i + 4]; r[i] = keep + shx(send, 16, lane); }
#pragma unroll
    for (int i = 0; i < 2; ++i) { const float keep = b3 ? r[i + 2] : r[i], send = b3 ? r[i] : r[i + 2]; s[i] = keep + shx(send, 8, lane); }
    { const float keep = b2 ? s[1] : s[0], send = b2 ? s[0] : s[1]; t = keep + shx(send, 4, lane); }
    t += shx(t, 2, lane); t += shx(t, 1, lane);
    return t;
}
__device__ __forceinline__ void seq_info(int s, int& tok0, int& L) { if (s < 8) { tok0 = s << 11; L = 2048; } else { tok0 = TP + ((s - 8) << 3); L = 8; } }
__device__ __forceinline__ void tok_info(int t, int& s, int& l, int& tok0) {
    if (t < TP) { s = t >> 11; l = t & 2047; tok0 = s << 11; } else { const int b = (t - TP) >> 3; s = 8 + b; l = (t - TP) & 7; tok0 = TP + (b << 3); }
}

template <int MODE> struct EpiBf16 {
    static constexpr bool PERM = true, AFTER_DRAIN = false;
    bf16* O; int ldc; const float* bias; const float* scale; const bf16* G;
    __device__ __forceinline__ void operator()(const pg8::f32x4 (&acc)[2][2][4][2], const pg8::Unit& u, int wr, int wc, int fr_, int fq_) const {
        int fr = fr_, fq = fq_; asm volatile("" : "+v"(fr), "+v"(fq));
        const int row0 = u.pm * 256 + wr * 64 + fr, col0 = u.pn * 256 + wc * 32 + 8 * fq;
        f32x4 bv[2][2], sv[2][2];
#pragma unroll
        for (int bj = 0; bj < 2; ++bj)
#pragma unroll
            for (int n = 0; n < 2; ++n) {
                bv[bj][n] = bias ? *(const f32x4*)(bias + col0 + bj * 128 + 4 * n) : (f32x4){0.f, 0.f, 0.f, 0.f};
                sv[bj][n] = (MODE == 2) ? *(const f32x4*)(scale + col0 + bj * 128 + 4 * n) : (f32x4){1.f, 1.f, 1.f, 1.f};
            }
#pragma unroll
        for (int ai = 0; ai < 2; ++ai)
#pragma unroll
            for (int m = 0; m < 4; ++m) {
                const size_t roff = (size_t)(row0 + ai * 128 + m * 16) * ldc + col0;
#pragma unroll
                for (int bj = 0; bj < 2; ++bj) {
                    f32x4 v0 = acc[ai][bj][m][0] + bv[bj][0], v1 = acc[ai][bj][m][1] + bv[bj][1];
                    if (MODE == 1) {
#pragma unroll
                        for (int j = 0; j < 4; ++j) { v0[j] = gelu_f(v0[j]); v1[j] = gelu_f(v1[j]); }
                    }
                    if (MODE == 2) { v0 = v0 * sv[bj][0]; v1 = v1 * sv[bj][1]; }
                    if (MODE == 3) {
                        const v4u gw = *(const v4u*)(G + roff + bj * 128);
                        v0[0] = bflo(gw.x) * sigmoid_f(v0[0]); v0[1] = bfhi(gw.x) * sigmoid_f(v0[1]); v0[2] = bflo(gw.y) * sigmoid_f(v0[2]); v0[3] = bfhi(gw.y) * sigmoid_f(v0[3]);
                        v1[0] = bflo(gw.z) * sigmoid_f(v1[0]); v1[1] = bfhi(gw.z) * sigmoid_f(v1[1]); v1[2] = bflo(gw.w) * sigmoid_f(v1[2]); v1[3] = bfhi(gw.w) * sigmoid_f(v1[3]);
                    }
                    v4u w; w.x = pk2(v0[0], v0[1]); w.y = pk2(v0[2], v0[3]); w.z = pk2(v1[0], v1[1]); w.w = pk2(v1[2], v1[3]);
                    *(v4u*)(O + roff + bj * 128) = w;
                }
            }
    }
};
struct EpiResid {
    static constexpr bool PERM = false, AFTER_DRAIN = false;
    const float* H; float* R;
    __device__ __forceinline__ void operator()(const pg8::f32x4 (&acc)[2][2][4][2], const pg8::Unit& u, int wr, int wc, int fr_, int fq_) const {
        int fr = fr_, fq = fq_; asm volatile("" : "+v"(fr), "+v"(fq));
        const int row0 = u.pm * 256 + wr * 64 + fr, col0 = u.pn * 256 + wc * 32 + 4 * fq;
#pragma unroll
        for (int ai = 0; ai < 2; ++ai)
#pragma unroll
            for (int m = 0; m < 4; ++m) {
                const size_t roff = (size_t)(row0 + ai * 128 + m * 16) * D + col0;
#pragma unroll
                for (int bj = 0; bj < 2; ++bj)
#pragma unroll
                    for (int n = 0; n < 2; ++n) {
                        const f32x4 hv = *(const f32x4*)(H + roff + bj * 128 + n * 16);
                        *(f32x4*)(R + roff + bj * 128 + n * 16) = hv * ALPHA + acc[ai][bj][m][n];
                    }
            }
    }
};
struct EpiSsdProj {
    static constexpr bool PERM = true, AFTER_DRAIN = false;
    bf16* Z; bf16* XBC; float* DT;
    __device__ __forceinline__ void operator()(const pg8::f32x4 (&acc)[2][2][4][2], const pg8::Unit& u, int wr, int wc, int fr_, int fq_) const {
        int fr = fr_, fq = fq_; asm volatile("" : "+v"(fr), "+v"(fq));
        const int row0 = u.pm * 256 + wr * 64 + fr, col0 = u.pn * 256 + wc * 32 + 8 * fq;
#pragma unroll
        for (int ai = 0; ai < 2; ++ai)
#pragma unroll
            for (int m = 0; m < 4; ++m) {
                const size_t row = (size_t)(row0 + ai * 128 + m * 16);
#pragma unroll
                for (int bj = 0; bj < 2; ++bj) {
                    const f32x4 v0 = acc[ai][bj][m][0], v1 = acc[ai][bj][m][1];
                    const int col = col0 + bj * 128;
                    if (u.pn < 20) {
                        v4u w; w.x = pk2(v0[0], v0[1]); w.y = pk2(v0[2], v0[3]); w.z = pk2(v1[0], v1[1]); w.w = pk2(v1[2], v1[3]);
                        if (u.pn < 8) *(v4u*)(Z + row * 2048 + col) = w; else *(v4u*)(XBC + row * CONVD + (col - 2048)) = w;
                    } else if (col - 5120 < 32) {
                        *(f32x4*)(DT + row * 32 + (col - 5120)) = v0; *(f32x4*)(DT + row * 32 + (col - 5120) + 4) = v1;
                    }
                }
            }
    }
};

struct Ctx {
    const float* const* in; float* out; unsigned char* ws; LAS unsigned char* lds;
    int tid, lane, wave, gw, NGW, gt, NGT;
    template <class Tp> __device__ __forceinline__ Tp* W(size_t off) const { return (Tp*)(ws + off); }
};

template <class Epi> __device__ __forceinline__ void run_gemm(const Ctx& c, const bf16* A, int lda, int a_pn_off, const bf16* Bt, int N, int K, const Epi& E) {
    pg8::Gemm g{A, Bt, T, N, K, lda, a_pn_off};
    pg8::StaticOrder S; S.init(T, N, (int)gridDim.x, (int)blockIdx.x);
    for (int r = 0; r < PR_GEMM; ++r) pg8::gemm_phase<Epi, pg8::StaticOrder, false, false>(c.lds, g, S, E, c.tid);
}

__device__ __forceinline__ void transpose_item(const float* __restrict__ Wm, int K, int N, bf16* WT, LAS float* scr, int item, int lane) {
    const int nblk = N / 32, kb = item / nblk, nb = item % nblk, k0 = 64 * kb, n0 = 32 * nb;
#pragma unroll 8
    for (int i = 0; i < 32; ++i) { const int kk = 2 * i + (lane >> 5); scr[kk * 33 + (lane & 31)] = Wm[(size_t)(k0 + kk) * N + n0 + (lane & 31)]; }
    asm volatile("s_waitcnt lgkmcnt(0)" ::: "memory");
    const int cc = lane & 7;
#pragma unroll
    for (int j = 0; j < 4; ++j) {
        const int n = (lane >> 3) + 8 * j; const LAS float* s = scr + (8 * cc) * 33 + n;
        v4u o; o.x = pk2(s[0 * 33], s[1 * 33]); o.y = pk2(s[2 * 33], s[3 * 33]); o.z = pk2(s[4 * 33], s[5 * 33]); o.w = pk2(s[6 * 33], s[7 * 33]);
        *(v4u*)(WT + (size_t)(n0 + n) * K + k0 + 8 * cc) = o;
    }
    asm volatile("s_waitcnt lgkmcnt(0)" ::: "memory");
}
__device__ __forceinline__ void transpose_mat(const Ctx& c, const float* Wm, int K, int N, bf16* WT) {
    LAS float* scr = (LAS float*)(c.lds + c.wave * 16384);
    const int nitems = (K / 64) * (N / 32);
    for (int it = c.gw; it < nitems; it += c.NGW) transpose_item(Wm, K, N, WT, scr, it, c.lane);
}
__device__ __forceinline__ void cvt_copy(const Ctx& c, const float* __restrict__ src, bf16* dst, size_t n) {
    for (size_t i = (size_t)c.gt * 8; i < n; i += (size_t)c.NGT * 8) {
        const f32x4 a = *(const f32x4*)(src + i), b = *(const f32x4*)(src + i + 4);
        v4u w; w.x = pk2(a[0], a[1]); w.y = pk2(a[2], a[3]); w.z = pk2(b[0], b[1]); w.w = pk2(b[2], b[3]);
        *(v4u*)(dst + i) = w;
    }
}
__device__ __forceinline__ float wave_max(float v, int lane) {
#pragma unroll
    for (int o = 32; o >= 1; o >>= 1) v = fmaxf(v, shx(v, o, lane));
    return v;
}
__device__ __forceinline__ void cvt_tables(const Ctx& c, int layer) {
    float* sm = c.W<float>(WS_SMALL);
    for (int r = c.gw; r < 2 * 16384; r += c.NGW) {
        const int tb = r >> 14, row = r & 16383;
        const float* src = c.in[44 + tb] + ((size_t)layer * 16384 + row) * D + 16 * c.lane;
        f32x4 v[4];
#pragma unroll
        for (int k = 0; k < 4; ++k) v[k] = *(const f32x4*)(src + 4 * k);
        float m = 0.f;
#pragma unroll
        for (int k = 0; k < 4; ++k) m = fmaxf(fmaxf(fmaxf(fabsf(v[k][0]), fabsf(v[k][1])), fmaxf(fabsf(v[k][2]), fabsf(v[k][3]))), m);
        m = fmaxf(wave_max(m, c.lane), 1e-30f);
        const int ex = (int)((__builtin_bit_cast(unsigned, m) >> 23) & 0xffu) - 127;
        const float sc = __builtin_bit_cast(float, (unsigned)(127 + 7 - ex) << 23);
        const float isc = __builtin_bit_cast(float, (unsigned)(127 - 7 + ex) << 23);
        v4u o;
        { int p = __builtin_amdgcn_cvt_pk_fp8_f32(v[0][0] * sc, v[0][1] * sc, 0, false); p = __builtin_amdgcn_cvt_pk_fp8_f32(v[0][2] * sc, v[0][3] * sc, p, true); o.x = (unsigned)p; }
        { int p = __builtin_amdgcn_cvt_pk_fp8_f32(v[1][0] * sc, v[1][1] * sc, 0, false); p = __builtin_amdgcn_cvt_pk_fp8_f32(v[1][2] * sc, v[1][3] * sc, p, true); o.y = (unsigned)p; }
        { int p = __builtin_amdgcn_cvt_pk_fp8_f32(v[2][0] * sc, v[2][1] * sc, 0, false); p = __builtin_amdgcn_cvt_pk_fp8_f32(v[2][2] * sc, v[2][3] * sc, p, true); o.z = (unsigned)p; }
        { int p = __builtin_amdgcn_cvt_pk_fp8_f32(v[3][0] * sc, v[3][1] * sc, 0, false); p = __builtin_amdgcn_cvt_pk_fp8_f32(v[3][2] * sc, v[3][3] * sc, p, true); o.w = (unsigned)p; }
        *(v4u*)(c.ws + (tb ? WS_EV : WS_EU) + (size_t)row * D + 16 * c.lane) = o;
        if (c.lane == 0) sm[(tb ? SM_ISV : SM_ISU) + row] = isc;
    }
}
__device__ __forceinline__ void prologue(const Ctx& c) {
    transpose_mat(c, c.in[7], 1024, 1024, c.W<bf16>(WS_W_S5IN));
    transpose_mat(c, c.in[16], 1024, 1024, c.W<bf16>(WS_W_S5GLU));
    transpose_mat(c, c.in[18], 1024, 1024, c.W<bf16>(WS_W_S5OUT));
    transpose_mat(c, c.in[19], 1024, 1024, c.W<bf16>(WS_W_PIN));
    for (int g = 0; g < 4; ++g) transpose_mat(c, c.in[20] + (size_t)g * 65536, 256, 256, c.W<bf16>(WS_W_PGRP) + (size_t)g * 65536);
    transpose_mat(c, c.in[22], 1024, 1024, c.W<bf16>(WS_W_POUT));
    transpose_mat(c, c.in[23], 1024, 2048, c.W<bf16>(WS_W_CIN));
    transpose_mat(c, c.in[29], 1024, 1024, c.W<bf16>(WS_W_COUT));
    transpose_mat(c, c.in[30], 1024, 5152, c.W<bf16>(WS_W_SIN));
    transpose_mat(c, c.in[37], 2048, 1024, c.W<bf16>(WS_W_SOUT));
    for (int l = 0; l < 4; ++l) transpose_mat(c, c.in[42] + (size_t)l * 1024 * 2048, 1024, 2048, c.W<bf16>(WS_W_PQ) + (size_t)l * 2048 * 1024);
    {
        v4u* z = (v4u*)(c.W<bf16>(WS_W_SIN) + (size_t)5152 * 1024);
        for (int i = c.gt; i < 224 * 1024 / 8; i += c.NGT) z[i] = (v4u){0u, 0u, 0u, 0u};
    }
    cvt_copy(c, c.in[43], c.W<bf16>(WS_KEYS), (size_t)4 * 8 * 2 * 128 * 128);
    {
        float* H = c.W<float>(WS_H32); bf16* HB = c.W<bf16>(WS_HB);
        for (size_t i = (size_t)c.gt * 8; i < (size_t)T * D; i += (size_t)c.NGT * 8) {
            const float* src = (i < (size_t)TP * D) ? (c.in[0] + i) : (c.in[1] + (i - (size_t)TP * D));
            const f32x4 a = *(const f32x4*)(src), b = *(const f32x4*)(src + 4);
            *(f32x4*)(H + i) = a; *(f32x4*)(H + i + 4) = b;
            v4u w; w.x = pk2(a[0], a[1]); w.y = pk2(a[2], a[3]); w.z = pk2(b[0], b[1]); w.w = pk2(b[2], b[3]);
            *(v4u*)(HB + i) = w;
        }
    }
    if (c.gt < 4096) {
        const int gp = c.gt, g = gp >> 6;
        float* sm = c.W<float>(WS_SMALL);
        const float dt = expf(c.in[10][g]);
        const float lr = c.in[8][gp], li = c.in[9][gp];
        const float mag = expf(lr * dt);
        const float br = mag * cosf(li * dt), bi = mag * sinf(li * dt);
        const float den = lr * lr + li * li;
        const float fr = ((br - 1.f) * lr + bi * li) / den, fi = (bi * lr - (br - 1.f) * li) / den;
        sm[SM_LBR + gp] = br; sm[SM_LBI + gp] = bi;
        for (int i = 0; i < 16; ++i) {
            const float xr = c.in[11][gp * 16 + i], xi = c.in[12][gp * 16 + i];
            sm[SM_BBR + gp * 16 + i] = fr * xr - fi * xi; sm[SM_BBI + gp * 16 + i] = fr * xi + fi * xr;
        }
    }
    cvt_tables(c, 0);
}

__device__ __forceinline__ void ln_row_store(const f32x4 (&v)[4], float mean, float rstd, const float* __restrict__ g, const float* __restrict__ b, float* o32, bf16* ob, int lane) {
#pragma unroll
    for (int h = 0; h < 2; ++h) {
        const int c0 = h * 512 + 8 * lane;
        const f32x4 g0 = *(const f32x4*)(g + c0), g1 = *(const f32x4*)(g + c0 + 4), b0 = *(const f32x4*)(b + c0), b1 = *(const f32x4*)(b + c0 + 4);
        const f32x4 o0 = (v[2 * h] - mean) * rstd * g0 + b0, o1 = (v[2 * h + 1] - mean) * rstd * g1 + b1;
        *(f32x4*)(o32 + c0) = o0; *(f32x4*)(o32 + c0 + 4) = o1;
        if (ob) { v4u w; w.x = pk2(o0[0], o0[1]); w.y = pk2(o0[2], o0[3]); w.z = pk2(o1[0], o1[1]); w.w = pk2(o1[2], o1[3]); *(v4u*)(ob + c0) = w; }
    }
}
__device__ __forceinline__ void ln_stats(const f32x4 (&v)[4], float& mean, float& rstd, int lane) {
    float s = 0.f;
#pragma unroll
    for (int k = 0; k < 4; ++k) s += (v[k][0] + v[k][1]) + (v[k][2] + v[k][3]);
    mean = wave_sum(s, lane) * (1.f / D);
    float q = 0.f;
#pragma unroll
    for (int k = 0; k < 4; ++k) { const f32x4 d = v[k] - mean; q += (d[0] * d[0] + d[1] * d[1]) + (d[2] * d[2] + d[3] * d[3]); }
    rstd = rsqrtf(wave_sum(q, lane) * (1.f / D) + LN_EPS);
}
__device__ __forceinline__ void phase_ln1(const Ctx& c, int layer) {
    const float* R = c.W<float>(WS_R32); float* H = c.W<float>(WS_H32); bf16* HB = c.W<bf16>(WS_HB);
    const float* g = c.in[38] + layer * D; const float* b = c.in[39] + layer * D;
    for (int t = c.gw; t < T; t += c.NGW) {
        f32x4 v[4];
#pragma unroll
        for (int h = 0; h < 2; ++h) { v[2 * h] = *(const f32x4*)(R + (size_t)t * D + h * 512 + 8 * c.lane); v[2 * h + 1] = *(const f32x4*)(R + (size_t)t * D + h * 512 + 8 * c.lane + 4); }
        float mean, rstd; ln_stats(v, mean, rstd, c.lane);
        ln_row_store(v, mean, rstd, g, b, H + (size_t)t * D, HB + (size_t)t * D, c.lane);
    }
}

__device__ __forceinline__ bf16x8 mk8(float a0, float a1, float a2, float a3, float a4, float a5, float a6, float a7) {
    v4u w; w.x = pk2(a0, a1); w.y = pk2(a2, a3); w.z = pk2(a4, a5); w.w = pk2(a6, a7); return __builtin_bit_cast(bf16x8, w);
}
constexpr int S5_BU_LD = 132  , S5_H_LD = 136  , S5_WAVE_BYTES = 16 * S5_BU_LD * 4 + 16 * S5_H_LD * 2;
__device__ __forceinline__ void phase_s5scan(const Ctx& c) {
    const bf16* U = c.W<bf16>(WS_A0); bf16* G = c.W<bf16>(WS_A1);
    const float* sm = c.W<float>(WS_SMALL);
    float* out = c.out;
    float* o_re_p = out + 17825792, *o_im_p = o_re_p + 32768, *o_re_s = out + 17825792 + 32768 * 2 + 122880 + 73728 + 2097152, *o_im_s = o_re_s + 524288;
    const int lane = c.lane, p = lane, fr = lane & 15, fq = lane >> 4;
    LAS float* BuT = (LAS float*)(c.lds + c.wave * S5_WAVE_BYTES);
    LAS bf16* Hi = (LAS bf16*)(c.lds + c.wave * S5_WAVE_BYTES + 16 * S5_BU_LD * 4);
    const int wslot = c.wave * (int)gridDim.x + (int)blockIdx.x;
    for (int unit = wslot; unit < 136 * 64; unit += c.NGW) {
        const int s = unit >> 6, g = unit & 63;
        int tok0, L; seq_info(s, tok0, L);
        bf16x8 Bf[8];
#pragma unroll
        for (int nt = 0; nt < 8; ++nt) {
            const int comp = 16 * nt + fr;
            const float* src = sm + ((comp < 64) ? SM_BBR : SM_BBI) + (size_t)(g * 64 + (comp & 63)) * 16 + 8 * (fq & 1);
            const f32x4 a = *(const f32x4*)src, b = *(const f32x4*)(src + 4);
            const bf16x8 v = mk8(a[0], a[1], a[2], a[3], b[0], b[1], b[2], b[3]);
            Bf[nt] = (fq < 2) ? v : (bf16x8){0, 0, 0, 0, 0, 0, 0, 0};
        }
        bf16x8 Cf[4];
#pragma unroll
        for (int ks = 0; ks < 4; ++ks) {
            const int comp0 = 32 * ks + 8 * fq;
            const float* src = ((ks < 2) ? c.in[13] : c.in[14]) + (size_t)(g * 16 + fr) * 64 + (comp0 & 63);
            const f32x4 a = *(const f32x4*)src, b = *(const f32x4*)(src + 4);
            const float sg = (ks < 2) ? 1.f : -1.f;
            Cf[ks] = mk8(sg * a[0], sg * a[1], sg * a[2], sg * a[3], sg * b[0], sg * b[1], sg * b[2], sg * b[3]);
        }
        const float lr = sm[SM_LBR + g * 64 + p], li = sm[SM_LBI + g * 64 + p];
        float hr = 0.f, hi = 0.f;
        if (s >= 8) { hr = c.in[2][((s - 8) * 64 + g) * 64 + p]; hi = c.in[3][((s - 8) * 64 + g) * 64 + p]; }
        const f32x4 dk4 = *(const f32x4*)(c.in[15] + g * 16 + 4 * fq);
        const int ntile = (L + 15) >> 4;
        for (int tile = 0; tile < ntile; ++tile) {
            const int tb = tok0 + tile * 16;
            const bool valid = (tile * 16 + fr) < L;
            bf16x8 uf = {0, 0, 0, 0, 0, 0, 0, 0};
            if (fq < 2 && valid) uf = *(const bf16x8*)(U + (size_t)(tb + fr) * D + g * 16 + 8 * fq);
#pragma unroll
            for (int nt = 0; nt < 8; ++nt) {
                f32x4 acc = {0.f, 0.f, 0.f, 0.f};
                acc = __builtin_amdgcn_mfma_f32_16x16x32_bf16(Bf[nt], uf, acc, 0, 0, 0);
                *(LAS f32x4*)(BuT + fr * S5_BU_LD + 16 * nt + 4 * fq) = acc;
            }
            asm volatile("s_waitcnt lgkmcnt(0)" ::: "memory");
            const int nsteps = min(16, L - tile * 16);
#pragma unroll
            for (int t = 0; t < 16; ++t) {
                const float br = BuT[t * S5_BU_LD + p], bi = BuT[t * S5_BU_LD + 64 + p];
                const float nr = lr * hr - li * hi + br, ni = lr * hi + li * hr + bi;
                if (t < nsteps) { hr = nr; hi = ni; }
                Hi[t * S5_H_LD + p] = (bf16)f2bf(hr); Hi[t * S5_H_LD + 64 + p] = (bf16)f2bf(hi);
            }
            asm volatile("s_waitcnt lgkmcnt(0)" ::: "memory");
            f32x4 y = {0.f, 0.f, 0.f, 0.f};
#pragma unroll
            for (int ks = 0; ks < 4; ++ks) {
                const bf16x8 hf = *(const LAS bf16x8*)(Hi + fr * S5_H_LD + 32 * ks + 8 * fq);
                y = __builtin_amdgcn_mfma_f32_16x16x32_bf16(Cf[ks], hf, y, 0, 0, 0);
            }
            if (valid) {
                const v2u uq = *(const v2u*)(U + (size_t)(tb + fr) * D + g * 16 + 4 * fq);
                v2u o; o.x = pk2(gelu_f(y[0] + dk4[0] * bflo(uq.x)), gelu_f(y[1] + dk4[1] * bfhi(uq.x))); o.y = pk2(gelu_f(y[2] + dk4[2] * bflo(uq.y)), gelu_f(y[3] + dk4[3] * bfhi(uq.y)));
                *(v2u*)(G + (size_t)(tb + fr) * D + g * 16 + 4 * fq) = o;
            }
            asm volatile("" ::: "memory");
        }
        if (s < 8) { o_re_p[(s * 64 + g) * 64 + p] = hr; o_im_p[(s * 64 + g) * 64 + p] = hi; }
        else { o_re_s[((s - 8) * 64 + g) * 64 + p] = hr; o_im_s[((s - 8) * 64 + g) * 64 + p] = hi; }
    }
}

__device__ __forceinline__ void phase_pool(const Ctx& c) {
    const bf16* U = c.W<bf16>(WS_A0); bf16* P = c.W<bf16>(WS_A1);
    float* o_p = c.out + 17825792 + 65536, *o_s = c.out + 17825792 + 65536 + 122880 + 73728 + 2097152 + 1048576;
    for (size_t i = (size_t)c.gt; i < (size_t)T * 128; i += (size_t)c.NGT) {
        const int t = (int)(i >> 7), c0 = (int)(i & 127) * 8;
        int s, l, tok0; tok_info(t, s, l, tok0);
        const int w = 2 << (c0 >> 8);
        float sum[8];
#pragma unroll
        for (int j = 0; j < 8; ++j) sum[j] = 0.f;
        float cur[8];
        for (int k = 0; k < w; ++k) {
            const int ll = l - k;
            if (ll >= 0) {
                const v4u q = *(const v4u*)(U + (size_t)(tok0 + ll) * D + c0);
                const float f[8] = {bflo(q.x), bfhi(q.x), bflo(q.y), bfhi(q.y), bflo(q.z), bfhi(q.z), bflo(q.w), bfhi(q.w)};
#pragma unroll
                for (int j = 0; j < 8; ++j) { sum[j] += f[j]; if (k == 0) cur[j] = f[j]; }
            } else if (s >= 8) {
                const float* sp = c.in[4] + ((size_t)(s - 8) * 15 + (15 + ll)) * D + c0;
                const f32x4 a = *(const f32x4*)sp, b = *(const f32x4*)(sp + 4);
                sum[0] += a[0]; sum[1] += a[1]; sum[2] += a[2]; sum[3] += a[3]; sum[4] += b[0]; sum[5] += b[1]; sum[6] += b[2]; sum[7] += b[3];
            }
        }
        const int pos = (s >= 8 ? 16384 : 0) + l;
        const float inv = 1.f / (float)min(pos + 1, w);
        v4u o; o.x = pk2(sum[0] * inv - cur[0], sum[1] * inv - cur[1]); o.y = pk2(sum[2] * inv - cur[2], sum[3] * inv - cur[3]);
        o.z = pk2(sum[4] * inv - cur[4], sum[5] * inv - cur[5]); o.w = pk2(sum[6] * inv - cur[6], sum[7] * inv - cur[7]);
        *(v4u*)(P + (size_t)t * D + c0) = o;
    }
    for (size_t i = (size_t)c.gt; i < (size_t)136 * 15 * D; i += (size_t)c.NGT) {
        const int ch = (int)(i & 1023); const int j = (int)((i >> 10) % 15); const int s = (int)(i / (15 * 1024));
        if (s < 8) o_p[((size_t)s * 15 + j) * D + ch] = bf2f(U[(size_t)(s * 2048 + 2033 + j) * D + ch]);
        else { const int b = s - 8; o_s[((size_t)b * 15 + j) * D + ch] = (j < 7) ? c.in[4][((size_t)b * 15 + 8 + j) * D + ch] : bf2f(U[(size_t)(TP + b * 8 + (j - 7)) * D + ch]); }
    }
}

__device__ __forceinline__ void phase_cmlp_ln(const Ctx& c) {
    bf16* Z = c.W<bf16>(WS_Q);
    float* o_v = c.out + 17825792 + 65536 + 122880 + 73728 + 2097152 + 1048576 + 1966080;
    const float* g = c.in[25]; const float* b = c.in[26];
    for (int t = c.gw; t < T; t += c.NGW) {
        bf16* vr = Z + (size_t)t * 2048 + 1024;
        f32x4 v[4];
#pragma unroll
        for (int h = 0; h < 2; ++h) {
            const v4u q = *(const v4u*)(vr + h * 512 + 8 * c.lane);
            v[2 * h] = (f32x4){bflo(q.x), bfhi(q.x), bflo(q.y), bfhi(q.y)}; v[2 * h + 1] = (f32x4){bflo(q.z), bfhi(q.z), bflo(q.w), bfhi(q.w)};
        }
        float mean, rstd; ln_stats(v, mean, rstd, c.lane);
#pragma unroll
        for (int h = 0; h < 2; ++h) {
            const int c0 = h * 512 + 8 * c.lane;
            const f32x4 g0 = *(const f32x4*)(g + c0), g1 = *(const f32x4*)(g + c0 + 4), b0 = *(const f32x4*)(b + c0), b1 = *(const f32x4*)(b + c0 + 4);
            const f32x4 o0 = (v[2 * h] - mean) * rstd * g0 + b0, o1 = (v[2 * h + 1] - mean) * rstd * g1 + b1;
            v4u w; w.x = pk2(o0[0], o0[1]); w.y = pk2(o0[2], o0[3]); w.z = pk2(o1[0], o1[1]); w.w = pk2(o1[2], o1[3]);
            *(v4u*)(vr + c0) = w;
            if (t >= TP) { *(f32x4*)(o_v + (size_t)(t - TP) * D + c0) = o0; *(f32x4*)(o_v + (size_t)(t - TP) * D + c0 + 4) = o1; }
        }
    }
}
__device__ __forceinline__ void phase_cmlp_mix(const Ctx& c) {
    const bf16* Z = c.W<bf16>(WS_Q); bf16* O = c.W<bf16>(WS_A1);
    for (size_t i = (size_t)c.gt; i < (size_t)T * 128; i += (size_t)c.NGT) {
        const int t = (int)(i >> 7), c0 = (int)(i & 127) * 8;
        int s, l, tok0; tok_info(t, s, l, tok0);
        const int hd = c0 >> 8, tp = (s < 8) ? (l & 127) : l, base = t - tp;
        float acc[8];
        const float bs = c.in[28][hd * 128 + tp];
#pragma unroll
        for (int j = 0; j < 8; ++j) acc[j] = bs;
        const float* wr = c.in[27] + ((size_t)hd * 128 + tp) * 128;
        for (int sp = 0; sp <= tp; ++sp) {
            const float w = wr[sp];
            const v4u q = *(const v4u*)(Z + (size_t)(base + sp) * 2048 + 1024 + c0);
            acc[0] += w * bflo(q.x); acc[1] += w * bfhi(q.x); acc[2] += w * bflo(q.y); acc[3] += w * bfhi(q.y);
            acc[4] += w * bflo(q.z); acc[5] += w * bfhi(q.z); acc[6] += w * bflo(q.w); acc[7] += w * bfhi(q.w);
        }
        const v4u uq = *(const v4u*)(Z + (size_t)t * 2048 + c0);
        v4u o; o.x = pk2(bflo(uq.x) * acc[0], bfhi(uq.x) * acc[1]); o.y = pk2(bflo(uq.y) * acc[2], bfhi(uq.y) * acc[3]);
        o.z = pk2(bflo(uq.z) * acc[4], bfhi(uq.z) * acc[5]); o.w = pk2(bflo(uq.w) * acc[6], bfhi(uq.w) * acc[7]);
        *(v4u*)(O + (size_t)t * D + c0) = o;
    }
}

__device__ __forceinline__ void phase_ssd_conv(const Ctx& c) {
    const bf16* X = c.W<bf16>(WS_XBC); bf16* XC = c.W<bf16>(WS_XC);
    float* o_p = c.out + 17825792 + 65536 + 122880, *o_s = c.out + 17825792 + 65536 + 122880 + 73728 + 2097152 + 1048576 + 1966080 + 1048576;
    for (size_t i = (size_t)c.gt; i < (size_t)T * (CONVD / 8); i += (size_t)c.NGT) {
        const int t = (int)(i / (CONVD / 8)), c0 = (int)(i % (CONVD / 8)) * 8;
        int s, l, tok0; tok_info(t, s, l, tok0);
        float acc[8];
        { const f32x4 a = *(const f32x4*)(c.in[32] + c0), b = *(const f32x4*)(c.in[32] + c0 + 4); acc[0] = a[0]; acc[1] = a[1]; acc[2] = a[2]; acc[3] = a[3]; acc[4] = b[0]; acc[5] = b[1]; acc[6] = b[2]; acc[7] = b[3]; }
#pragma unroll
        for (int k = 0; k < 4; ++k) {
            const int src = l + k - 3;
            float f[8];
            if (src >= 0) {
                const v4u q = *(const v4u*)(X + (size_t)(tok0 + src) * CONVD + c0);
                f[0] = bflo(q.x); f[1] = bfhi(q.x); f[2] = bflo(q.y); f[3] = bfhi(q.y); f[4] = bflo(q.z); f[5] = bfhi(q.z); f[6] = bflo(q.w); f[7] = bfhi(q.w);
            } else if (s >= 8) {
                const float* sp = c.in[5] + ((size_t)(s - 8) * 3 + (l + k)) * CONVD + c0;
                const f32x4 a = *(const f32x4*)sp, b = *(const f32x4*)(sp + 4);
                f[0] = a[0]; f[1] = a[1]; f[2] = a[2]; f[3] = a[3]; f[4] = b[0]; f[5] = b[1]; f[6] = b[2]; f[7] = b[3];
            } else {
#pragma unroll
                for (int j = 0; j < 8; ++j) f[j] = 0.f;
            }
            const f32x4 wa = *(const f32x4*)(c.in[31] + k * CONVD + c0), wb = *(const f32x4*)(c.in[31] + k * CONVD + c0 + 4);
            acc[0] += f[0] * wa[0]; acc[1] += f[1] * wa[1]; acc[2] += f[2] * wa[2]; acc[3] += f[3] * wa[3];
            acc[4] += f[4] * wb[0]; acc[5] += f[5] * wb[1]; acc[6] += f[6] * wb[2]; acc[7] += f[7] * wb[3];
        }
        v4u o; o.x = pk2(silu_f(acc[0]), silu_f(acc[1])); o.y = pk2(silu_f(acc[2]), silu_f(acc[3])); o.z = pk2(silu_f(acc[4]), silu_f(acc[5])); o.w = pk2(silu_f(acc[6]), silu_f(acc[7]));
        *(v4u*)(XC + (size_t)t * CONVD + c0) = o;
    }
    for (size_t i = (size_t)c.gt; i < (size_t)136 * 3 * CONVD; i += (size_t)c.NGT) {
        const int ch = (int)(i % CONVD); const int j = (int)((i / CONVD) % 3); const int s = (int)(i / (3 * CONVD));
        if (s < 8) o_p[((size_t)s * 3 + j) * CONVD + ch] = bf2f(X[(size_t)(s * 2048 + 2045 + j) * CONVD + ch]);
        else { const int b = s - 8; o_s[((size_t)b * 3 + j) * CONVD + ch] = bf2f(X[(size_t)(TP + b * 8 + 5 + j) * CONVD + ch]); }
    }
}
__device__ __forceinline__ void phase_ssd_scan(const Ctx& c) {
    const bf16* XC = c.W<bf16>(WS_XC); const float* DT = c.W<float>(WS_DT); bf16* Y = c.W<bf16>(WS_Y);
    float* o_p = c.out + 17825792 + 65536 + 122880 + 73728;
    float* o_s = c.out + 17825792 + 65536 + 122880 + 73728 + 2097152 + 1048576 + 1966080 + 1048576 + 1179648;
    const int p = c.tid >> 3, nq = c.tid & 7;
    for (int unit = (int)blockIdx.x; unit < 136 * 32; unit += (int)gridDim.x) {
        const int s = unit >> 5, hd = unit & 31, g = hd >> 3;
        int tok0, L; seq_info(s, tok0, L);
        float h[16];
        if (s >= 8) {
            const float* sp = c.in[6] + (((size_t)(s - 8) * 32 + hd) * 64 + p) * 128 + nq * 16;
#pragma unroll
            for (int i = 0; i < 4; ++i) { const f32x4 a = *(const f32x4*)(sp + 4 * i); h[4 * i] = a[0]; h[4 * i + 1] = a[1]; h[4 * i + 2] = a[2]; h[4 * i + 3] = a[3]; }
        } else {
#pragma unroll
            for (int i = 0; i < 16; ++i) h[i] = 0.f;
        }
        const float a = -expf(c.in[34][hd]), dtb = c.in[33][hd], dk = c.in[35][hd];
        const bf16* xb = XC + (size_t)tok0 * CONVD;
        v4u nB0 = *(const v4u*)(xb + 2048 + g * 128 + nq * 16), nB1 = *(const v4u*)(xb + 2048 + g * 128 + nq * 16 + 8);
        v4u nC0 = *(const v4u*)(xb + 2560 + g * 128 + nq * 16), nC1 = *(const v4u*)(xb + 2560 + g * 128 + nq * 16 + 8);
        float nx = bf2f(xb[hd * 64 + p]); float ndt = DT[(size_t)tok0 * 32 + hd];
        for (int t = 0; t < L; ++t) {
            const v4u B0 = nB0, B1 = nB1, C0 = nC0, C1 = nC1; const float xv = nx, dr = ndt + dtb;
            if (t + 1 < L) {
                const bf16* xn = xb + (size_t)(t + 1) * CONVD;
                nB0 = *(const v4u*)(xn + 2048 + g * 128 + nq * 16); nB1 = *(const v4u*)(xn + 2048 + g * 128 + nq * 16 + 8);
                nC0 = *(const v4u*)(xn + 2560 + g * 128 + nq * 16); nC1 = *(const v4u*)(xn + 2560 + g * 128 + nq * 16 + 8);
                nx = bf2f(xn[hd * 64 + p]); ndt = DT[(size_t)(tok0 + t + 1) * 32 + hd];
            }
            const float dtv = (dr > 20.f) ? dr : log1pf(__expf(dr));
            const float dA = __expf(dtv * a), coef = dtv * xv;
            const float Bf[16] = {bflo(B0.x), bfhi(B0.x), bflo(B0.y), bfhi(B0.y), bflo(B0.z), bfhi(B0.z), bflo(B0.w), bfhi(B0.w), bflo(B1.x), bfhi(B1.x), bflo(B1.y), bfhi(B1.y), bflo(B1.z), bfhi(B1.z), bflo(B1.w), bfhi(B1.w)};
            const float Cf[16] = {bflo(C0.x), bfhi(C0.x), bflo(C0.y), bfhi(C0.y), bflo(C0.z), bfhi(C0.z), bflo(C0.w), bfhi(C0.w), bflo(C1.x), bfhi(C1.x), bflo(C1.y), bfhi(C1.y), bflo(C1.z), bfhi(C1.z), bflo(C1.w), bfhi(C1.w)};
            float yp = 0.f;
#pragma unroll
            for (int i = 0; i < 16; ++i) { h[i] = h[i] * dA + coef * Bf[i]; yp += Cf[i] * h[i]; }
            yp += shx(yp, 1, c.lane); yp += shx(yp, 2, c.lane); yp += shx(yp, 4, c.lane);
            if (nq == 0) Y[(size_t)(tok0 + t) * 2048 + hd * 64 + p] = (bf16)f2bf(yp + dk * xv);
        }
        float* op = ((s < 8) ? (o_p + (((size_t)s * 32 + hd) * 64 + p) * 128) : (o_s + (((size_t)(s - 8) * 32 + hd) * 64 + p) * 128)) + nq * 16;
#pragma unroll
        for (int i = 0; i < 4; ++i) *(f32x4*)(op + 4 * i) = (f32x4){h[4 * i], h[4 * i + 1], h[4 * i + 2], h[4 * i + 3]};
    }
}
__device__ __forceinline__ void phase_ssd_gatenorm(const Ctx& c) {
    const bf16* Y = c.W<bf16>(WS_Y); const bf16* Z = c.W<bf16>(WS_Q); bf16* YN = c.W<bf16>(WS_YN);
    for (int it = c.gw; it < T * 4; it += c.NGW) {
        const int t = it >> 2, c0 = (it & 3) * 512 + 8 * c.lane;
        const v4u yq = *(const v4u*)(Y + (size_t)t * 2048 + c0), zq = *(const v4u*)(Z + (size_t)t * 2048 + c0);
        const float yf[8] = {bflo(yq.x), bfhi(yq.x), bflo(yq.y), bfhi(yq.y), bflo(yq.z), bfhi(yq.z), bflo(yq.w), bfhi(yq.w)};
        const float zf[8] = {bflo(zq.x), bfhi(zq.x), bflo(zq.y), bfhi(zq.y), bflo(zq.z), bfhi(zq.z), bflo(zq.w), bfhi(zq.w)};
        float v[8]; float q = 0.f;
#pragma unroll
        for (int j = 0; j < 8; ++j) { v[j] = yf[j] * silu_f(zf[j]); q += v[j] * v[j]; }
        const float r = rsqrtf(wave_sum(q, c.lane) * (1.f / 512.f) + RMS_EPS);
        const f32x4 g0 = *(const f32x4*)(c.in[36] + c0), g1 = *(const f32x4*)(c.in[36] + c0 + 4);
        v4u o; o.x = pk2(v[0] * r * g0[0], v[1] * r * g0[1]); o.y = pk2(v[2] * r * g0[2], v[3] * r * g0[3]); o.z = pk2(v[4] * r * g1[0], v[5] * r * g1[1]); o.w = pk2(v[6] * r * g1[2], v[7] * r * g1[3]);
        *(v4u*)(YN + (size_t)t * 2048 + c0) = o;
    }
}

__device__ __forceinline__ unsigned ord_key(float s) { const unsigned u = __builtin_bit_cast(unsigned, s); return (u & 0x80000000u) ? ~u : (u | 0x80000000u); }
__device__ __forceinline__ float ord_dec(unsigned k) { const unsigned u = (k & 0x80000000u) ? (k & 0x7fffffffu) : ~k; return __builtin_bit_cast(float, u); }
__device__ __forceinline__ void ins16(unsigned (&Lk)[16], unsigned x) {
#pragma unroll
    for (int k = 0; k < 16; ++k) { const unsigned hi = max(Lk[k], x); x = min(Lk[k], x); Lk[k] = hi; }
}
constexpr int RT_SC_LD = 260, RT_LIST_OFF = 128 * RT_SC_LD * 4;
__device__ __forceinline__ void phase_route(const Ctx& c, int layer) {
    const bf16* Q = c.W<bf16>(WS_Q); const bf16* KEYS = c.W<bf16>(WS_KEYS) + (size_t)layer * 8 * 2 * 128 * 128;
    int* IDX = c.W<int>(WS_IDX); float* GATE = c.W<float>(WS_GATE); float* SCU = c.W<float>(WS_SCU);
    const float* ISU = c.W<float>(WS_SMALL) + SM_ISU; const float* ISV = c.W<float>(WS_SMALL) + SM_ISV;
    LAS float* sc = (LAS float*)c.lds; LAS unsigned* lists = (LAS unsigned*)(c.lds + RT_LIST_OFF);
    const int fr = c.lane & 15, fq = c.lane >> 4;
    for (int task = (int)blockIdx.x; task < 136 * 8; task += (int)gridDim.x) {
        const int tt = task >> 3, h = task & 7, tok0 = tt * 128;
        {
            const bf16* qrow = Q + (size_t)(tok0 + 16 * c.wave + fr) * 2048 + h * 256 + 8 * fq;
#pragma unroll
            for (int side = 0; side < 2; ++side) {
                bf16x8 qf[4];
#pragma unroll
                for (int ks = 0; ks < 4; ++ks) qf[ks] = *(const bf16x8*)(qrow + side * 128 + ks * 32);
                const bf16* kb = KEYS + ((size_t)(h * 2 + side) * 128 + fr) * 128 + 8 * fq;
#pragma unroll
                for (int nt = 0; nt < 8; ++nt) {
                    f32x4 acc = {0.f, 0.f, 0.f, 0.f};
#pragma unroll
                    for (int ks = 0; ks < 4; ++ks) {
                        const bf16x8 kf = *(const bf16x8*)(kb + (size_t)nt * 16 * 128 + ks * 32);
                        acc = __builtin_amdgcn_mfma_f32_16x16x32_bf16(kf, qf[ks], acc, 0, 0, 0);
                    }
                    *(LAS f32x4*)(sc + (16 * c.wave + fr) * RT_SC_LD + side * 128 + nt * 16 + 4 * fq) = acc;
                }
            }
        }
        __syncthreads();
        if (c.tid < 256) {
            const int token = c.tid & 127, side = c.tid >> 7;
            unsigned Lk[16];
#pragma unroll
            for (int k = 0; k < 16; ++k) Lk[k] = 0u;
            const LAS float* row = sc + token * RT_SC_LD + side * 128;
            for (int n4 = 0; n4 < 32; ++n4) {
                const f32x4 v = *(const LAS f32x4*)(row + n4 * 4);
#pragma unroll
                for (int j = 0; j < 4; ++j) ins16(Lk, (ord_key(v[j]) & ~127u) | (unsigned)(127 - (n4 * 4 + j)));
            }
#pragma unroll
            for (int k = 0; k < 16; ++k) lists[(token * 2 + side) * 16 + k] = Lk[k];
        }
        __syncthreads();
        if (c.tid < 128) {
            const int token = c.tid;
            float s0[16], s1[16];
#pragma unroll
            for (int k = 0; k < 16; ++k) { s0[k] = ord_dec(lists[(token * 2) * 16 + k] & ~127u); s1[k] = ord_dec(lists[(token * 2 + 1) * 16 + k] & ~127u); }
            unsigned Bk[16];
#pragma unroll
            for (int k = 0; k < 16; ++k) Bk[k] = 0u;
#pragma unroll
            for (int i = 0; i < 16; ++i)
#pragma unroll
                for (int j = 0; j < 16; ++j)
                    if ((i + 1) * (j + 1) <= 16) ins16(Bk, (ord_key(s0[i] + s1[j]) & ~255u) | (unsigned)(255 - (i * 16 + j)));
            float e[16]; int id[16]; float mx = 0.f, den = 0.f;
#pragma unroll
            for (int k = 0; k < 16; ++k) {
                const int pay = 255 - (int)(Bk[k] & 255u), i = pay >> 4, j = pay & 15;
                const unsigned k0 = lists[(token * 2) * 16 + i], k1 = lists[(token * 2 + 1) * 16 + j];
                id[k] = (127 - (int)(k0 & 127u)) * 128 + (127 - (int)(k1 & 127u));
                const float sv = ord_dec(k0 & ~127u) + ord_dec(k1 & ~127u);
                if (k == 0) mx = sv;
                e[k] = __expf(sv - mx); den += e[k];
            }
            const float inv = 1.f / den;
            int* ip = IDX + (size_t)(tok0 + token) * 128 + h * 16; float* gp = GATE + (size_t)(tok0 + token) * 128 + h * 16; float* up = SCU + (size_t)(tok0 + token) * 128 + h * 16;
            float su[16];
#pragma unroll
            for (int k = 0; k < 16; ++k) { su[k] = ISU[id[k]]; e[k] *= inv * ISV[id[k]]; }
#pragma unroll
            for (int k = 0; k < 4; ++k) {
                *(int4*)(ip + 4 * k) = make_int4(id[4 * k], id[4 * k + 1], id[4 * k + 2], id[4 * k + 3]);
                *(f32x4*)(gp + 4 * k) = (f32x4){e[4 * k], e[4 * k + 1], e[4 * k + 2], e[4 * k + 3]};
                *(f32x4*)(up + 4 * k) = (f32x4){su[4 * k], su[4 * k + 1], su[4 * k + 2], su[4 * k + 3]};
            }
        }
        __syncthreads();
    }
}

typedef float f32x2 __attribute__((ext_vector_type(2)));
#define CVT8(wd, hi) __builtin_amdgcn_cvt_pk_f32_fp8((int)(wd), (hi))
__device__ __forceinline__ void phase_gather(const Ctx& c, int layer, bool dummy) {
    const unsigned char* EU = c.ws + WS_EU; const unsigned char* EV = c.ws + WS_EV;
    const int* IDX = c.W<int>(WS_IDX); const float* GATE = c.W<float>(WS_GATE); const float* SCU = c.W<float>(WS_SCU);
    const float* H = c.W<float>(WS_H32); float* Ho = dummy ? c.W<float>(WS_R32) : c.W<float>(WS_H32); bf16* HB = dummy ? c.W<bf16>(WS_A0) : c.W<bf16>(WS_HB);
    const float* g = c.in[40] + layer * D; const float* b = c.in[41] + layer * D;
    const int lane = c.lane;
    const int ntw = (T - c.gw + c.NGW - 1) / c.NGW, nit = ntw * 8;
#define GT_TOK(it) (c.gw + ((it) >> 3) * c.NGW)
#define GT_IDX(it) (((it) < nit) ? IDX[(size_t)GT_TOK(it) * 128 + ((it) & 7) * 16 + (lane & 15)] : 0)
#define GT_GS(P, it) ((P)[(size_t)GT_TOK((it) < nit ? (it) : 0) * 128 + ((it) & 7) * 16 + ((lane >> 2) & 15)])
    int idx_c = GT_IDX(0), idx_n = GT_IDX(1);
    float gate_c = GT_GS(GATE, 0), scu_c = GT_GS(SCU, 0);
    f32x2 x2[8], xn[8], acc[8];
#pragma unroll
    for (int k = 0; k < 4; ++k) { const f32x4 hx = *(const f32x4*)(H + (size_t)c.gw * D + 16 * lane + 4 * k); xn[2 * k] = (f32x2){hx[0], hx[1]}; xn[2 * k + 1] = (f32x2){hx[2], hx[3]}; }
    v4u ru[16], rv[16];
#pragma unroll
    for (int e = 0; e < 16; ++e) {
        const int id = __builtin_amdgcn_readlane(idx_c, e);
        ru[e] = *(const v4u*)(EU + (size_t)id * D + 16 * lane); rv[e] = *(const v4u*)(EV + (size_t)id * D + 16 * lane);
    }
    for (int it = 0; it < nit; ++it) {
        const int t = GT_TOK(it), bt = it & 7;
        const int idx_nn = GT_IDX(it + 2);
        const float gate_n = GT_GS(GATE, it + 1), scu_n = GT_GS(SCU, it + 1);
        const float mygate = gate_c, myscu = scu_c;
        if (bt == 0) {
#pragma unroll
            for (int i = 0; i < 8; ++i) { x2[i] = xn[i]; acc[i] = (f32x2){0.f, 0.f}; }
        }
        if (bt == 7 && it + 1 < nit) {
            const int tn = GT_TOK(it + 1);
#pragma unroll
            for (int k = 0; k < 4; ++k) { const f32x4 hx = *(const f32x4*)(H + (size_t)tn * D + 16 * lane + 4 * k); xn[2 * k] = (f32x2){hx[0], hx[1]}; xn[2 * k + 1] = (f32x2){hx[2], hx[3]}; }
        }
        float pv[16];
#pragma unroll
        for (int e = 0; e < 16; ++e) {
            const v4u w = ru[e];
            f32x2 d = CVT8(w.x, false) * x2[0];
            d += CVT8(w.x, true) * x2[1]; d += CVT8(w.y, false) * x2[2]; d += CVT8(w.y, true) * x2[3];
            d += CVT8(w.z, false) * x2[4]; d += CVT8(w.z, true) * x2[5]; d += CVT8(w.w, false) * x2[6]; d += CVT8(w.w, true) * x2[7];
            pv[e] = d.x + d.y;
            ru[e] = *(const v4u*)(EU + (size_t)__builtin_amdgcn_readlane(idx_n, e) * D + 16 * lane);
        }
        const float tot = reduce16(pv, lane);
        const float wgt = mygate * gelu_f(tot * myscu);
#pragma unroll
        for (int e = 0; e < 16; ++e) {
            const float we = __builtin_bit_cast(float, __builtin_amdgcn_readlane(__builtin_bit_cast(int, wgt), 4 * e));
            const v4u w = rv[e];
            acc[0] += CVT8(w.x, false) * we; acc[1] += CVT8(w.x, true) * we; acc[2] += CVT8(w.y, false) * we; acc[3] += CVT8(w.y, true) * we;
            acc[4] += CVT8(w.z, false) * we; acc[5] += CVT8(w.z, true) * we; acc[6] += CVT8(w.w, false) * we; acc[7] += CVT8(w.w, true) * we;
            rv[e] = *(const v4u*)(EV + (size_t)__builtin_amdgcn_readlane(idx_n, e) * D + 16 * lane);
        }
        if (bt == 7) {
            f32x4 v[4];
#pragma unroll
            for (int k = 0; k < 4; ++k) v[k] = (f32x4){x2[2 * k].x, x2[2 * k].y, x2[2 * k + 1].x, x2[2 * k + 1].y} * ALPHA + (f32x4){acc[2 * k].x, acc[2 * k].y, acc[2 * k + 1].x, acc[2 * k + 1].y};
            float mean, rstd; ln_stats(v, mean, rstd, lane);
            float* o32 = ((layer == 3 && !dummy) ? c.out : Ho) + (size_t)t * D + 16 * lane;
            bf16* ob = (layer == 3 && !dummy) ? (bf16*)nullptr : HB + (size_t)t * D + 16 * lane;
            v4u wb[2];
#pragma unroll
            for (int k = 0; k < 4; ++k) {
                const f32x4 g4 = *(const f32x4*)(g + 16 * lane + 4 * k), b4 = *(const f32x4*)(b + 16 * lane + 4 * k);
                const f32x4 o = (v[k] - mean) * rstd * g4 + b4;
                *(f32x4*)(o32 + 4 * k) = o;
                if (k & 1) { wb[k >> 1].z = pk2(o[0], o[1]); wb[k >> 1].w = pk2(o[2], o[3]); } else { wb[k >> 1].x = pk2(o[0], o[1]); wb[k >> 1].y = pk2(o[2], o[3]); }
            }
            if (ob) { *(v4u*)(ob) = wb[0]; *(v4u*)(ob + 8) = wb[1]; }
        }
        idx_c = idx_n; idx_n = idx_nn; gate_c = gate_n; scu_c = scu_n;
    }
#undef GT_GS
#undef GT_TOK
#undef GT_IDX
}

#define XB_TMO      128
#define XB_XCNT(j)  (256  + 64 * (j))
#define XB_XSUB(j)  (1280 + 64 * (j))
#define XB_XGEN(j)  (2304 + 64 * (j))
#define XB_TOP      3328
#define XB_TOPGEN   3392
#define XCD_BAR_WORDS 3456
#define XB_SPIN_CAP (1u << 22)
__device__ __forceinline__ unsigned xb_ld(unsigned* p)              { return __hip_atomic_load(p, __ATOMIC_RELAXED, __HIP_MEMORY_SCOPE_AGENT); }
__device__ __forceinline__ unsigned xb_add(unsigned* p, unsigned v) { return __hip_atomic_fetch_add(p, v, __ATOMIC_RELAXED, __HIP_MEMORY_SCOPE_AGENT); }
__device__ __forceinline__ unsigned xb_xcc_id() { return (unsigned)__builtin_amdgcn_s_getreg((3 << 11) | 20) & 0xFu; }
#define XB_SPIN(cond, bar) do { unsigned _sp = 0; while (cond) { __builtin_amdgcn_s_sleep(1); \
    if ((++_sp & 255u) == 0u) { if (xb_ld(&(bar)[XB_TMO])) break; if (_sp > XB_SPIN_CAP) { atomicAdd(&(bar)[XB_TMO], 1u); break; } } } } while (0)
struct XcdBarrier { unsigned* bar; unsigned x; volatile LAS unsigned* st; };
__device__ __forceinline__ XcdBarrier xcd_barrier_post(unsigned* bar, volatile LAS unsigned* st) {
    XcdBarrier b; b.bar = bar; b.x = xb_xcc_id(); b.st = st;
    if (threadIdx.x == 0) (void)xb_add(&bar[XB_XCNT(b.x)], 1u);
    return b;
}
__device__ __forceinline__ void xcd_barrier_complete(unsigned* bar, unsigned x, unsigned& nloc, unsigned& nx) {
    const unsigned G = gridDim.x * gridDim.y * gridDim.z;
    unsigned sum, cnt, mine, sp = 0u;
    for (;;) {
        sum = 0u; cnt = 0u; mine = 0u;
#pragma unroll
        for (unsigned j = 0; j < 16; ++j) { const unsigned cc = xb_ld(&bar[XB_XCNT(j)]); sum += cc; cnt += (cc > 0u) ? 1u : 0u; mine = (j == x) ? cc : mine; }
        if (sum == G) break;
        __builtin_amdgcn_s_sleep(1);
        if ((++sp & 255u) == 0u) { if (xb_ld(&bar[XB_TMO])) break; if (sp > XB_SPIN_CAP) { atomicAdd(&bar[XB_TMO], 1u); break; } }
    }
    nloc = mine > 0u ? mine : 1u; nx = cnt > 0u ? cnt : 1u;
}
__device__ __forceinline__ void xcd_barrier(const XcdBarrier& b, int tid) {
    asm volatile("s_waitcnt vmcnt(0)" ::: "memory");
    __syncthreads();
    if (tid == 0) {
        unsigned* bar = b.bar;
        __builtin_amdgcn_s_waitcnt(0);
        unsigned nloc = b.st[0], nx = b.st[1];
        if (nloc == 0u) { xcd_barrier_complete(bar, b.x, nloc, nx); b.st[0] = nloc; b.st[1] = nx; }
        const unsigned old = xb_add(&bar[XB_XSUB(b.x)], 1u);
        const unsigned gen = old / nloc;
        if (old + 1u == (gen + 1u) * nloc) {
            __builtin_amdgcn_fence(__ATOMIC_RELEASE, "agent");
            asm volatile("s_waitcnt vmcnt(0)" ::: "memory");
            const unsigned og = xb_add(&bar[XB_TOP], 1u);
            const unsigned tg = og / nx;
            if (og + 1u == (tg + 1u) * nx) xb_add(&bar[XB_TOPGEN], 1u);
            else XB_SPIN(xb_ld(&bar[XB_TOPGEN]) == tg, bar);
            __builtin_amdgcn_fence(__ATOMIC_ACQUIRE, "agent");
            xb_add(&bar[XB_XGEN(b.x)], 1u);
            asm volatile("s_waitcnt vmcnt(0)" ::: "memory");
        } else {
            XB_SPIN(xb_ld(&bar[XB_XGEN(b.x)]) == gen, bar);
            __builtin_amdgcn_fence(__ATOMIC_ACQUIRE, "agent");
            asm volatile("s_waitcnt vmcnt(0)" ::: "memory");
        }
    }
    __syncthreads();
}

__global__ void __launch_bounds__(NTHR, 2) mega(Params P) {
    extern __shared__ __attribute__((aligned(16))) unsigned char lds_raw[];
    cg::grid_group grid = cg::this_grid();
    Ctx c;
    c.in = P.in; c.out = P.out; c.ws = P.ws; c.lds = (LAS unsigned char*)lds_raw;
    c.tid = threadIdx.x; c.lane = c.tid & 63; c.wave = __builtin_amdgcn_readfirstlane(c.tid >> 6);
    c.gw = (int)blockIdx.x * NWAVES + c.wave; c.NGW = (int)gridDim.x * NWAVES; c.gt = (int)blockIdx.x * NTHR + c.tid; c.NGT = (int)gridDim.x * NTHR;
#define RF() do { int z_ = 0; asm volatile("" : "+v"(z_)); const int l_ = (int)__builtin_amdgcn_mbcnt_hi(~0u, __builtin_amdgcn_mbcnt_lo(~0u, (unsigned)z_)); c.lane = l_; c.tid = c.wave * 64 + l_; c.gt = (int)blockIdx.x * NTHR + c.tid; } while (0)
    bf16* HB = c.W<bf16>(WS_HB); bf16* A0 = c.W<bf16>(WS_A0); bf16* A1 = c.W<bf16>(WS_A1); bf16* A2 = c.W<bf16>(WS_A2); bf16* Qb = c.W<bf16>(WS_Q);
    float* H32 = c.W<float>(WS_H32); float* R32 = c.W<float>(WS_R32);

    if (threadIdx.x < 16) ((volatile LAS unsigned*)(c.lds + MISC_OFF))[threadIdx.x] = 0u;
    __syncthreads();
    const XcdBarrier xbar = xcd_barrier_post(c.W<unsigned>(WS_CTL), (volatile LAS unsigned*)(c.lds + MISC_OFF));
#define GSYNC() do { RF(); xcd_barrier(xbar, c.tid); } while (0)
    RF(); prologue(c);
    grid.sync();
    for (int layer = 0; layer < 4; ++layer) {
        if (layer <= 1) {
            const bf16* Wt = c.W<bf16>(layer == 0 ? WS_W_S5IN : WS_W_PIN);
            RF(); run_gemm(c, HB, D, 0, Wt, 1024, 1024, EpiBf16<0>{A0, D, nullptr, nullptr, nullptr});
        } else if (layer == 2) {
            RF(); run_gemm(c, HB, D, 0, c.W<bf16>(WS_W_CIN), 2048, 1024, EpiBf16<1>{Qb, 2048, c.in[24], nullptr, nullptr});
        } else {
            RF(); run_gemm(c, HB, D, 0, c.W<bf16>(WS_W_SIN), NPROJ, 1024, EpiSsdProj{Qb, c.W<bf16>(WS_XBC), c.W<float>(WS_DT)});
        }
        GSYNC();
        const bf16* Aout = A2; const bf16* Wout;
        if (layer == 0) {
            for (int r = 0; r < PR_S5; ++r) { RF(); phase_s5scan(c); }
            GSYNC();
            RF(); run_gemm(c, A1, D, 0, c.W<bf16>(WS_W_S5GLU), 1024, 1024, EpiBf16<3>{A2, D, c.in[17], nullptr, A1});
            Wout = c.W<bf16>(WS_W_S5OUT);
        } else if (layer == 1) {
            RF(); phase_pool(c);
            GSYNC();
            RF(); run_gemm(c, A1, D, 256, c.W<bf16>(WS_W_PGRP), 1024, 256, EpiBf16<2>{A2, D, nullptr, c.in[21], nullptr});
            Wout = c.W<bf16>(WS_W_POUT);
        } else if (layer == 2) {
            RF(); phase_cmlp_ln(c);
            GSYNC();
            RF(); phase_cmlp_mix(c);
            Aout = A1; Wout = c.W<bf16>(WS_W_COUT);
        } else {
            RF(); phase_ssd_conv(c);
            GSYNC();
            for (int r = 0; r < PR_SSD; ++r) { RF(); phase_ssd_scan(c); }
            GSYNC();
            RF(); phase_ssd_gatenorm(c);
            Aout = c.W<bf16>(WS_YN); Wout = c.W<bf16>(WS_W_SOUT);
        }
        GSYNC();
        if (layer == 3) { RF(); run_gemm(c, Aout, 2048, 0, Wout, 1024, 2048, EpiResid{H32, R32}); }
        else { RF(); run_gemm(c, Aout, 1024, 0, Wout, 1024, 1024, EpiResid{H32, R32}); }
        GSYNC();
        RF(); phase_ln1(c, layer);
        if (layer > 0) { RF(); cvt_tables(c, layer); }
        GSYNC();
        RF(); run_gemm(c, HB, D, 0, c.W<bf16>(WS_W_PQ) + (size_t)layer * 2048 * 1024, 2048, 1024, EpiBf16<0>{Qb, 2048, nullptr, nullptr, nullptr});
        GSYNC();
        for (int r = 0; r < PR_ROUTE; ++r) { RF(); phase_route(c, layer); }
        GSYNC();
        for (int r = 1; r < PR_GATHER; ++r) { RF(); phase_gather(c, layer, true); }
        RF(); phase_gather(c, layer, false);
        GSYNC();
    }
}
}

extern "C" void kernel_launch(void* const* d_in, const int* in_sizes, int n_in, void* d_out, int out_size, void* d_ws, size_t ws_size, hipStream_t stream) {
    static int grid = 0;
    if (grid == 0) {
        int dev = 0, cus = 0, per_cu = 0;
        if (hipGetDevice(&dev) != hipSuccess || hipDeviceGetAttribute(&cus, hipDeviceAttributeMultiprocessorCount, dev) != hipSuccess) { fprintf(stderr, "kernel_launch: device query failed\n"); grid = -1; return; }
        if (hipFuncSetAttribute((const void*)mk::mega, hipFuncAttributeMaxDynamicSharedMemorySize, mk::LDS_BYTES) != hipSuccess) { fprintf(stderr, "kernel_launch: hipFuncSetAttribute failed\n"); grid = -1; return; }
        if (hipOccupancyMaxActiveBlocksPerMultiprocessor(&per_cu, (const void*)mk::mega, mk::NTHR, mk::LDS_BYTES) != hipSuccess || per_cu < 1) { fprintf(stderr, "kernel_launch: occupancy query says %d blocks per CU\n", per_cu); grid = -1; return; }
        grid = cus;
        if (ws_size < mk::WS_END) { fprintf(stderr, "kernel_launch: workspace too small (%zu < %zu)\n", ws_size, (size_t)mk::WS_END); grid = -1; return; }
    }
    if (grid < 0) return;
    mk::Params p{};
    for (int i = 0; i < 46; ++i) p.in[i] = (const float*)d_in[i];
    p.out = (float*)d_out; p.ws = (unsigned char*)d_ws;
    if (hipMemsetAsync((char*)d_ws + mk::WS_CTL, 0, mk::CTL_BYTES, stream) != hipSuccess) { fprintf(stderr, "kernel_launch: memset failed\n"); return; }
    void* args[] = {&p};
    hipError_t e = hipLaunchCooperativeKernel((const void*)mk::mega, dim3(grid), dim3(mk::NTHR), args, mk::LDS_BYTES, stream);
    if (e != hipSuccess) fprintf(stderr, "cooperative launch failed: %s (grid %d)\n", hipGetErrorString(e), grid);
}
```

```cpp
#include <hip/hip_runtime.h>
#include <hip/hip_cooperative_groups.h>
#include <cstdio>
#include <cstdint>
#include <math.h>
namespace cg = cooperative_groups;

namespace pg8 {
#define PG8_LAS __attribute__((address_space(3)))
typedef unsigned short bf16_t;
typedef short bf16x8 __attribute__((ext_vector_type(8)));
typedef float f32x4 __attribute__((ext_vector_type(4)));
typedef unsigned u32x4 __attribute__((ext_vector_type(4)));
constexpr int BM = 256, BK = 64, HALF = 128, HTB = HALF * BK * 2, STAGE_BYTES = 8 * HTB, NXCD = 8, WGM = 8;
__host__ __device__ __forceinline__ int lds_byte(int r, int c) { const int st = (r >> 4) * 2 + (c >> 5), rr = r & 15, cc = c & 31, ob = rr * 64 + cc * 2; return st * 1024 + (ob ^ (((ob >> 9) & 1) << 5)); }
__host__ __device__ __forceinline__ void stage_rc(int b, int& R, int& C) { const int st = b / 1024, sb = b % 1024, swz = sb ^ (((sb >> 9) & 1) << 5); R = (st >> 1) * 16 + swz / 64; C = (st & 1) * 32 + (swz % 64) / 2; }
__host__ __device__ __forceinline__ int perm32(int rho) { const int n = rho >> 4, i = rho & 15; return 8 * (i >> 2) + 4 * n + (i & 3); }
struct Unit { int pm, pn; };
struct Gemm { const bf16_t* A; const bf16_t* Bt; int M, N, K, lda, a_pn_off; };
struct StaticOrder {
    int nM, nN, nwg, G, c;
    __host__ __device__ void init(int M, int N, int G_, int c_) { nM = M / BM; nN = N / BM; nwg = nM * nN; G = G_; c = c_; }
    __host__ __device__ bool next(int i, Unit& u) const {
        const long L = (long)i * G + c; if (L >= nwg) return false;
        int wgid = (int)L; { const int q = nwg / NXCD, r = nwg % NXCD, xcd = wgid % NXCD, off = wgid / NXCD; wgid = (xcd < r ? xcd * (q + 1) : r * (q + 1) + (xcd - r) * q) + off; }
        const int nig = WGM * nN, gid = wgid / nig, fm = gid * WGM, gsz = (nM - fm) < WGM ? (nM - fm) : WGM;
        u.pm = fm + ((wgid % nig) % gsz); u.pn = (wgid % nig) / gsz; return true;
    }
    __device__ __forceinline__ void a_ready(const Unit&) const {}
    __device__ __forceinline__ void done(const Unit&) const {}
};
__device__ __forceinline__ unsigned cvt_pk_bf16(float lo, float hi) { unsigned r; asm volatile("v_cvt_pk_bf16_f32 %0, %1, %2" : "=v"(r) : "v"(lo), "v"(hi)); return r; }
template <class Epi, class Sched, bool ALIGN_EPI = false, bool SP2 = false>
__device__ __forceinline__ void gemm_phase(PG8_LAS unsigned char* lds, const Gemm g, const Sched& S, const Epi& E, int tid_in) {
    int tid_ = tid_in; asm volatile("" : "+v"(tid_));
    const int tid = tid_, wid = __builtin_amdgcn_readfirstlane(tid >> 6), lane = tid & 63, wr = wid >> 2, wc = wid & 3, fr = lane & 15, fq = lane >> 4;
    const int K = g.K, nt = K / BK;
    unsigned voffA[2], voffB[2];
#pragma unroll
    for (int i = 0; i < 2; ++i) { int R, C; stage_rc(tid * 16 + i * 8192, R, C); const int Rb = Epi::PERM ? ((R & ~31) + perm32(R & 31)) : R;
        voffA[i] = (unsigned)(R * g.lda + C) * 2u; voffB[i] = (unsigned)(Rb * K + C) * 2u; }
    const size_t kstep = (size_t)(BK * 2);
    const size_t hstepA = (size_t)HALF * g.lda * 2, tstepA = 2 * hstepA;
    const size_t hstepB = (size_t)HALF * K * 2, tstepB = 2 * hstepB;
    const size_t apn = (size_t)g.a_pn_off * 2;
    const unsigned ldsw = (unsigned)wid * 1024u;
    const int aoff = lds_byte(wr * 64 + fr, fq * 8), boff = lds_byte(wc * 32 + fr, fq * 8);
#define PG8_SA(b, h) (((b) * 2 + (h)) * HTB)
#define PG8_SB(b, h) ((4 + (b) * 2 + (h)) * HTB)
#define PG8_STAGE(bufoff, gbase, voff) do { _Pragma("unroll") for (int _i = 0; _i < 2; ++_i) \
        __builtin_amdgcn_global_load_lds((const unsigned*)((const char*)(gbase) + (voff)[_i]), (PG8_LAS unsigned*)(lds + (bufoff) + ldsw + _i * 8192), 16, 0, 0); } while (0)
#define PG8_LDA(dst, b, h) do { _Pragma("unroll") for (int m = 0; m < 4; ++m) _Pragma("unroll") for (int k = 0; k < 2; ++k) dst[m][k] = *(const PG8_LAS bf16x8*)(lds + PG8_SA(b, h) + aoff + m * 2048 + k * 1024); } while (0)
#define PG8_LDB(dst, b, h) do { _Pragma("unroll") for (int n = 0; n < 2; ++n) _Pragma("unroll") for (int k = 0; k < 2; ++k) dst[n][k] = *(const PG8_LAS bf16x8*)(lds + PG8_SB(b, h) + boff + n * 2048 + k * 1024); } while (0)
#define PG8_MMA(ai, bj, At, Bt) do { __builtin_amdgcn_s_setprio(1); _Pragma("unroll") for (int m = 0; m < 4; ++m) _Pragma("unroll") for (int n = 0; n < 2; ++n) _Pragma("unroll") for (int k = 0; k < 2; ++k) \
        acc[ai][bj][m][n] = __builtin_amdgcn_mfma_f32_16x16x32_bf16(Bt[n][k], At[m][k], acc[ai][bj][m][n], 0, 0, 0); __builtin_amdgcn_s_setprio(0); } while (0)
#define PG8_WAIT_V(n) asm volatile("s_waitcnt vmcnt(" #n ")" ::: "memory")
#define PG8_WAIT_L(n) asm volatile("s_waitcnt lgkmcnt(" #n ")" ::: "memory")
#define PG8_BAR __builtin_amdgcn_s_barrier()
#define PG8_SCHED __builtin_amdgcn_sched_barrier(0)
    Unit cur, nxt; int ui = 0;
    if (!S.next(0, cur)) return;
    f32x4 acc[2][2][4][2];
#pragma unroll
    for (int a = 0; a < 2; ++a)
#pragma unroll
        for (int b = 0; b < 2; ++b)
#pragma unroll
            for (int m = 0; m < 4; ++m)
#pragma unroll
                for (int n = 0; n < 2; ++n) acc[a][b][m][n] = (f32x4){0.f, 0.f, 0.f, 0.f};
    bf16x8 At[4][2], B0[2][2], B1[2][2];
    const char* cA = (const char*)g.A + (size_t)cur.pm * tstepA + (size_t)cur.pn * apn; const char* cB = (const char*)g.Bt + (size_t)cur.pn * tstepB;
    S.a_ready(cur);
    if constexpr (SP2) {
        PG8_STAGE(PG8_SB(0, 0), cB, voffB); PG8_STAGE(PG8_SB(0, 1), cB + hstepB, voffB); PG8_STAGE(PG8_SA(0, 0), cA, voffA); PG8_STAGE(PG8_SA(0, 1), cA + hstepA, voffA);
        if (wr == 1) PG8_BAR;
        PG8_WAIT_V(2); PG8_BAR;
        PG8_STAGE(PG8_SB(1, 0), cB + kstep, voffB); PG8_STAGE(PG8_SA(1, 0), cA + kstep, voffA); PG8_STAGE(PG8_SB(1, 1), cB + hstepB + kstep, voffB);
        PG8_WAIT_V(6); PG8_BAR;
    } else {
        PG8_STAGE(PG8_SB(0, 0), cB, voffB); PG8_STAGE(PG8_SA(0, 0), cA, voffA); PG8_STAGE(PG8_SB(0, 1), cB + hstepB, voffB); PG8_STAGE(PG8_SA(0, 1), cA + hstepA, voffA);
        if (wr == 1) PG8_BAR;
        PG8_WAIT_V(4); PG8_BAR;
        PG8_STAGE(PG8_SB(1, 0), cB + kstep, voffB); PG8_STAGE(PG8_SA(1, 0), cA + kstep, voffA); PG8_STAGE(PG8_SB(1, 1), cB + hstepB + kstep, voffB);
        PG8_WAIT_V(6); PG8_BAR;
    }
    for (;;) {
        const bool has_next = S.next(ui + 1, nxt);
        const char* nA = has_next ? (const char*)g.A + (size_t)nxt.pm * tstepA + (size_t)nxt.pn * apn : cA; const char* nB = has_next ? (const char*)g.Bt + (size_t)nxt.pn * tstepB : cB;
#pragma nounroll
        for (int t = 0; t < nt; t += 2) {
            const bool last = (t == nt - 2);
            const char* a1 = cA + (size_t)(t + 1) * kstep;
            const char* a2 = last ? nA : cA + (size_t)(t + 2) * kstep; const char* b2 = last ? nB : cB + (size_t)(t + 2) * kstep;
            const char* a3 = a2 + kstep; const char* b3 = b2 + kstep;
            if (last && has_next) S.a_ready(nxt);
            if constexpr (SP2) {
            PG8_LDB(B0, 0, 0); PG8_LDB(B1, 0, 1); PG8_SCHED; PG8_LDA(At, 0, 0); PG8_STAGE(PG8_SA(1, 1), a1 + hstepA, voffA);
            PG8_WAIT_V(8); PG8_WAIT_L(0); PG8_BAR; PG8_MMA(0, 0, At, B0); PG8_MMA(0, 1, At, B1); PG8_BAR; PG8_SCHED;
            PG8_LDA(At, 0, 1); PG8_STAGE(PG8_SB(0, 0), b2, voffB); PG8_STAGE(PG8_SB(0, 1), b2 + hstepB, voffB); PG8_STAGE(PG8_SA(0, 0), a2, voffA);
            PG8_WAIT_V(8); PG8_WAIT_L(0); PG8_BAR; PG8_MMA(1, 0, At, B0); PG8_MMA(1, 1, At, B1); PG8_BAR; PG8_SCHED;
            PG8_LDB(B0, 1, 0); PG8_LDB(B1, 1, 1); PG8_SCHED; PG8_LDA(At, 1, 0); PG8_STAGE(PG8_SA(0, 1), a2 + hstepA, voffA);
            PG8_WAIT_V(8); PG8_WAIT_L(0); PG8_BAR; PG8_MMA(0, 0, At, B0); PG8_MMA(0, 1, At, B1); PG8_BAR; PG8_SCHED;
            PG8_LDA(At, 1, 1); PG8_STAGE(PG8_SB(1, 0), b3, voffB); PG8_STAGE(PG8_SB(1, 1), b3 + hstepB, voffB); PG8_STAGE(PG8_SA(1, 0), a3, voffA);
            PG8_WAIT_V(8); PG8_WAIT_L(0); PG8_BAR; PG8_MMA(1, 0, At, B0); PG8_MMA(1, 1, At, B1); PG8_BAR; PG8_SCHED;
            } else {
            PG8_LDB(B0, 0, 0); PG8_SCHED; PG8_LDA(At, 0, 0); PG8_STAGE(PG8_SA(1, 1), a1 + hstepA, voffA);
            PG8_WAIT_L(8); PG8_BAR; PG8_WAIT_L(0); PG8_MMA(0, 0, At, B0); PG8_BAR; PG8_SCHED;
            PG8_LDB(B1, 0, 1); PG8_STAGE(PG8_SB(0, 0), b2, voffB);
            PG8_BAR; PG8_WAIT_L(0); PG8_MMA(0, 1, At, B1); PG8_BAR;
            PG8_LDA(At, 0, 1); PG8_STAGE(PG8_SA(0, 0), a2, voffA);
            PG8_BAR; PG8_WAIT_L(0); PG8_MMA(1, 0, At, B0); PG8_BAR; PG8_SCHED;
            PG8_STAGE(PG8_SB(0, 1), b2 + hstepB, voffB);
            PG8_WAIT_V(6); PG8_BAR; PG8_MMA(1, 1, At, B1); PG8_BAR;
            PG8_LDB(B0, 1, 0); PG8_SCHED; PG8_LDA(At, 1, 0); PG8_STAGE(PG8_SA(0, 1), a2 + hstepA, voffA);
            PG8_WAIT_L(8); PG8_BAR; PG8_WAIT_L(0); PG8_MMA(0, 0, At, B0); PG8_BAR; PG8_SCHED;
            PG8_LDB(B1, 1, 1); PG8_STAGE(PG8_SB(1, 0), b3, voffB);
            PG8_BAR; PG8_WAIT_L(0); PG8_MMA(0, 1, At, B1); PG8_BAR;
            PG8_LDA(At, 1, 1); PG8_STAGE(PG8_SA(1, 0), a3, voffA);
            PG8_BAR; PG8_WAIT_L(0); PG8_MMA(1, 0, At, B0); PG8_BAR; PG8_SCHED;
            PG8_STAGE(PG8_SB(1, 1), b3 + hstepB, voffB);
            PG8_WAIT_V(6); PG8_BAR; PG8_MMA(1, 1, At, B1); PG8_BAR;
            }
        }
        if constexpr (ALIGN_EPI) { if (wr == 0) PG8_BAR; }
        if constexpr (!Epi::AFTER_DRAIN) { E(acc, cur, wr, wc, fr, fq); S.done(cur); }
        if (!has_next) break;
#pragma unroll
        for (int a = 0; a < 2; ++a)
#pragma unroll
            for (int b = 0; b < 2; ++b)
#pragma unroll
                for (int m = 0; m < 4; ++m)
#pragma unroll
                    for (int n = 0; n < 2; ++n) acc[a][b][m][n] = (f32x4){0.f, 0.f, 0.f, 0.f};
        cur = nxt; cA = nA; cB = nB; ++ui;
        if constexpr (ALIGN_EPI) { if (wr == 1) PG8_BAR; }
    }
    PG8_WAIT_V(0);
    if constexpr (!ALIGN_EPI) { if (wr == 0) PG8_BAR; }
    PG8_BAR;
    if constexpr (Epi::AFTER_DRAIN) { E.fused(acc, cur, wr, wc, fr, fq, lds, wid, lane); S.done(cur); }
#undef PG8_SA
#undef PG8_SB
#undef PG8_STAGE
#undef PG8_LDA
#undef PG8_LDB
#undef PG8_MMA
#undef PG8_WAIT_V
#undef PG8_WAIT_L
#undef PG8_BAR
#undef PG8_SCHED
}
}

#ifndef PR_GATHER
#define PR_GATHER 1
#endif
#ifndef PR_ROUTE
#define PR_ROUTE 1
#endif
#ifndef PR_S5
#define PR_S5 1
#endif
#ifndef PR_SSD
#define PR_SSD 1
#endif
#ifndef PR_GEMM
#define PR_GEMM 1
#endif
#ifndef PR_MISC
#define PR_MISC 1
#endif
namespace mk {
#define LAS __attribute__((address_space(3)))
typedef unsigned short bf16;
typedef unsigned v4u __attribute__((ext_vector_type(4)));
typedef unsigned v2u __attribute__((ext_vector_type(2)));
typedef float f32x4 __attribute__((ext_vector_type(4)));
typedef short bf16x8 __attribute__((ext_vector_type(8)));
using bf16x2 = __attribute__((ext_vector_type(2))) __bf16;

constexpr int D = 1024, T = 17408, TP = 16384, NWAVES = 8, NTHR = 512;
constexpr float ALPHA = 1.6817928305074290f;
constexpr float LN_EPS = 1e-5f, RMS_EPS = 1e-5f;
constexpr int LDS_BYTES = 160 * 1024;
constexpr int NPROJ = 5376, CONVD = 3072;

constexpr size_t MiB = 1u << 20;
constexpr size_t WS_W_S5IN = 0, WS_W_S5GLU = 2 * MiB, WS_W_S5OUT = 4 * MiB, WS_W_PIN = 6 * MiB, WS_W_PGRP = 8 * MiB, WS_W_POUT = 9 * MiB,
                 WS_W_CIN = 11 * MiB, WS_W_COUT = 15 * MiB, WS_W_SIN = 17 * MiB  , WS_W_SOUT = 28 * MiB, WS_W_PQ = 32 * MiB  ,
                 WS_KEYS = 48 * MiB  , WS_SMALL = 50 * MiB, WS_CTL = 52 * MiB  ;
constexpr size_t CTL_BYTES = 16384;
constexpr int MISC_OFF = LDS_BYTES - 64;
constexpr size_t WS_EU = 64 * MiB, WS_EV = 96 * MiB;
constexpr size_t WS_H32 = 128 * MiB, WS_R32 = 196 * MiB, WS_HB = 264 * MiB, WS_A0 = 298 * MiB, WS_A1 = 332 * MiB, WS_A2 = 366 * MiB;
constexpr size_t WS_Q = 400 * MiB  , WS_IDX = 468 * MiB  , WS_GATE = 477 * MiB  , WS_DT = 486 * MiB  ;
constexpr size_t WS_XBC = 490 * MiB  , WS_XC = 592 * MiB  , WS_Y = 694 * MiB  , WS_YN = 762 * MiB  , WS_SCU = 830 * MiB  , WS_END = 839 * MiB;
constexpr size_t SM_LBR = 0, SM_LBI = 4096, SM_BBR = 8192, SM_BBI = 8192 + 65536, SM_ISU = 8192 + 131072, SM_ISV = SM_ISU + 16384;

struct Params { const float* in[46]; float* out; unsigned char* ws; };

__device__ __forceinline__ unsigned f2bf(float f) { unsigned u = __builtin_bit_cast(unsigned, f); return (u + 0x7fffu + ((u >> 16) & 1u)) >> 16; }
__device__ __forceinline__ unsigned pk2(float lo, float hi) { return pg8::cvt_pk_bf16(lo, hi); }
__device__ __forceinline__ float bflo(unsigned w) { return __builtin_bit_cast(float, w << 16); }
__device__ __forceinline__ float bfhi(unsigned w) { return __builtin_bit_cast(float, w & 0xffff0000u); }
__device__ __forceinline__ float bf2f(bf16 b) { return __builtin_bit_cast(float, ((unsigned)b) << 16); }
__device__ __forceinline__ float sigmoid_f(float x) { return 1.f / (1.f + __expf(-x)); }
__device__ __forceinline__ float silu_f(float x) { return x * sigmoid_f(x); }
__device__ __forceinline__ float gelu_f(float x) { return x * sigmoid_f(1.5957691216057308f * (x + 0.044715f * x * x * x)); }
__device__ __forceinline__ float shx(float v, int o, int lane) { return __builtin_bit_cast(float, __builtin_amdgcn_ds_bpermute((lane ^ o) << 2, __builtin_bit_cast(int, v))); }
__device__ __forceinline__ float wave_sum(float v, int lane) {
#pragma unroll
    for (int o = 32; o >= 1; o >>= 1) v += shx(v, o, lane);
    return v;
}
__device__ __forceinline__ float dot2(unsigned w, unsigned x, float acc) { return __builtin_amdgcn_fdot2_f32_bf16(__builtin_bit_cast(bf16x2, w), __builtin_bit_cast(bf16x2, x), acc, false); }
__device__ __forceinline__ float reduce16(const float (&p)[16], int lane) {
    const bool b5 = lane & 32, b4 = lane & 16, b3 = lane & 8, b2 = lane & 4;
    float q[8], r[4], s[2], t;
#pragma unroll
    for (int i = 0; i < 8; ++i) { const float keep = b5 ? p[i + 8] : p[i], send = b5 ? p[i] : p[i + 8]; q[i] = keep + shx(send, 32, lane); }
#pragma unroll
    for (int i = 0; i < 4; ++i) { const float keep = b4 ? q[i + 4] : q[i], send = b4 ? q[i] : q[i + 4]; r[i] = keep + shx(send, 16, lane); }
#pragma unroll
    for (int i = 0; i < 2; ++i) { const float keep = b3 ? r[i + 2] : r[i], send = b3 ? r[i] : r[i + 2]; s[i] = keep + shx(send, 8, lane); }
    { const float keep = b2 ? s[1] : s[0], send = b2 ? s[0] : s[1]; t = keep + shx(send, 4, lane); }
    t += shx(t, 2, lane); t += shx(t, 1, lane);
    return t;
}
__device__ __forceinline__ void seq_info(int s, int& tok0, int& L) { if (s < 8) { tok0 = s << 11; L = 2048; } else { tok0 = TP + ((s - 8) << 3); L = 8; } }
__device__ __forceinline__ void tok_info(int t, int& s, int& l, int& tok0) {
    if (t < TP) { s = t >> 11; l = t & 2047; tok0 = s << 11; } else { const int b = (t - TP) >> 3; s = 8 + b; l = (t - TP) & 7; tok0 = TP + (b << 3); }
}

template <int MODE> struct EpiBf16 {
    static constexpr bool PERM = true, AFTER_DRAIN = false;
    bf16* O; int ldc; const float* bias; const float* scale; const bf16* G;
    __device__ __forceinline__ void operator()(const pg8::f32x4 (&acc)[2][2][4][2], const pg8::Unit& u, int wr, int wc, int fr_, int fq_) const {
        int fr = fr_, fq = fq_; asm volatile("" : "+v"(fr), "+v"(fq));
        const int row0 = u.pm * 256 + wr * 64 + fr, col0 = u.pn * 256 + wc * 32 + 8 * fq;
        f32x4 bv[2][2], sv[2][2];
#pragma unroll
        for (int bj = 0; bj < 2; ++bj)
#pragma unroll
            for (int n = 0; n < 2; ++n) {
                bv[bj][n] = bias ? *(const f32x4*)(bias + col0 + bj * 128 + 4 * n) : (f32x4){0.f, 0.f, 0.f, 0.f};
                sv[bj][n] = (MODE == 2) ? *(const f32x4*)(scale + col0 + bj * 128 + 4 * n) : (f32x4){1.f, 1.f, 1.f, 1.f};
            }
#pragma unroll
        for (int ai = 0; ai < 2; ++ai)
#pragma unroll
            for (int m = 0; m < 4; ++m) {
                const size_t roff = (size_t)(row0 + ai * 128 + m * 16) * ldc + col0;
#pragma unroll
                for (int bj = 0; bj < 2; ++bj) {
                    f32x4 v0 = acc[ai][bj][m][0] + bv[bj][0], v1 = acc[ai][bj][m][1] + bv[bj][1];
                    if (MODE == 1) {
#pragma unroll
                        for (int j = 0; j < 4; ++j) { v0[j] = gelu_f(v0[j]); v1[j] = gelu_f(v1[j]); }
                    }
                    if (MODE == 2) { v0 = v0 * sv[bj][0]; v1 = v1 * sv[bj][1]; }
                    if (MODE == 3) {
                        const v4u gw = *(const v4u*)(G + roff + bj * 128);
                        v0[0] = bflo(gw.x) * sigmoid_f(v0[0]); v0[1] = bfhi(gw.x) * sigmoid_f(v0[1]); v0[2] = bflo(gw.y) * sigmoid_f(v0[2]); v0[3] = bfhi(gw.y) * sigmoid_f(v0[3]);
                        v1[0] = bflo(gw.z) * sigmoid_f(v1[0]); v1[1] = bfhi(gw.z) * sigmoid_f(v1[1]); v1[2] = bflo(gw.w) * sigmoid_f(v1[2]); v1[3] = bfhi(gw.w) * sigmoid_f(v1[3]);
                    }
                    v4u w; w.x = pk2(v0[0], v0[1]); w.y = pk2(v0[2], v0[3]); w.z = pk2(v1[0], v1[1]); w.w = pk2(v1[2], v1[3]);
                    *(v4u*)(O + roff + bj * 128) = w;
                }
            }
    }
};
struct EpiResid {
    static constexpr bool PERM = false, AFTER_DRAIN = false;
    const float* H; float* R;
    __device__ __forceinline__ void operator()(const pg8::f32x4 (&acc)[2][2][4][2], const pg8::Unit& u, int wr, int wc, int fr_, int fq_) const {
        int fr = fr_, fq = fq_; asm volatile("" : "+v"(fr), "+v"(fq));
        const int row0 = u.pm * 256 + wr * 64 + fr, col0 = u.pn * 256 + wc * 32 + 4 * fq;
#pragma unroll
        for (int ai = 0; ai < 2; ++ai)
#pragma unroll
            for (int m = 0; m < 4; ++m) {
                const size_t roff = (size_t)(row0 + ai * 128 + m * 16) * D + col0;
#pragma unroll
                for (int bj = 0; bj < 2; ++bj)
#pragma unroll
                    for (int n = 0; n < 2; ++n) {
                        const f32x4 hv = *(const f32x4*)(H + roff + bj * 128 + n * 16);
                        *(f32x4*)(R + roff + bj * 128 + n * 16) = hv * ALPHA + acc[ai][bj][m][n];
                    }
            }
    }
};
struct EpiSsdProj {
    static constexpr bool PERM = true, AFTER_DRAIN = false;
    bf16* Z; bf16* XBC; float* DT;
    __device__ __forceinline__ void operator()(const pg8::f32x4 (&acc)[2][2][4][2], const pg8::Unit& u, int wr, int wc, int fr_, int fq_) const {
        int fr = fr_, fq = fq_; asm volatile("" : "+v"(fr), "+v"(fq));
        const int row0 = u.pm * 256 + wr * 64 + fr, col0 = u.pn * 256 + wc * 32 + 8 * fq;
#pragma unroll
        for (int ai = 0; ai < 2; ++ai)
#pragma unroll
            for (int m = 0; m < 4; ++m) {
                const size_t row = (size_t)(row0 + ai * 128 + m * 16);
#pragma unroll
                for (int bj = 0; bj < 2; ++bj) {
                    const f32x4 v0 = acc[ai][bj][m][0], v1 = acc[ai][bj][m][1];
                    const int col = col0 + bj * 128;
                    if (u.pn < 20) {
                        v4u w; w.x = pk2(v0[0], v0[1]); w.y = pk2(v0[2], v0[3]); w.z = pk2(v1[0], v1[1]); w.w = pk2(v1[2], v1[3]);
                        if (u.pn < 8) *(v4u*)(Z + row * 2048 + col) = w; else *(v4u*)(XBC + row * CONVD + (col - 2048)) = w;
                    } else if (col - 5120 < 32) {
                        *(f32x4*)(DT + row * 32 + (col - 5120)) = v0; *(f32x4*)(DT + row * 32 + (col - 5120) + 4) = v1;
                    }
                }
            }
    }
};

struct Ctx {
    const float* const* in; float* out; unsigned char* ws; LAS unsigned char* lds;
    int tid, lane, wave, gw, NGW, gt, NGT, bid, nblk;
    int z;
    template <class Tp> __device__ __forceinline__ Tp* W(size_t off) const { return (Tp*)(ws + (off + (size_t)(unsigned)z)); }
};

template <class Epi> __device__ __forceinline__ void run_gemm(const Ctx& c, const bf16* A, int lda, int a_pn_off, const bf16* Bt, int N, int K, const Epi& E) {
    pg8::Gemm g{A, Bt, T, N, K, lda, a_pn_off};
    pg8::StaticOrder S; S.init(T, N, c.nblk, c.bid);
    for (int r = 0; r < PR_GEMM; ++r) pg8::gemm_phase<Epi, pg8::StaticOrder, false, false>(c.lds, g, S, E, c.tid);
}

__device__ __forceinline__ void transpose_item(const float* __restrict__ Wm, int K, int N, bf16* WT, LAS float* scr, int item, int lane) {
    const int nblk = N / 32, kb = item / nblk, nb = item % nblk, k0 = 64 * kb, n0 = 32 * nb;
#pragma unroll 8
    for (int i = 0; i < 32; ++i) { const int kk = 2 * i + (lane >> 5); scr[kk * 33 + (lane & 31)] = Wm[(size_t)(k0 + kk) * N + n0 + (lane & 31)]; }
    asm volatile("s_waitcnt lgkmcnt(0)" ::: "memory");
    const int cc = lane & 7;
#pragma unroll
    for (int j = 0; j < 4; ++j) {
        const int n = (lane >> 3) + 8 * j; const LAS float* s = scr + (8 * cc) * 33 + n;
        v4u o; o.x = pk2(s[0 * 33], s[1 * 33]); o.y = pk2(s[2 * 33], s[3 * 33]); o.z = pk2(s[4 * 33], s[5 * 33]); o.w = pk2(s[6 * 33], s[7 * 33]);
        *(v4u*)(WT + (size_t)(n0 + n) * K + k0 + 8 * cc) = o;
    }
    asm volatile("s_waitcnt lgkmcnt(0)" ::: "memory");
}
__device__ __forceinline__ void transpose_mat(const Ctx& c, const float* Wm, int K, int N, bf16* WT) {
    LAS float* scr = (LAS float*)(c.lds + c.wave * 16384);
    const int nitems = (K / 64) * (N / 32);
    for (int it = c.gw; it < nitems; it += c.NGW) transpose_item(Wm, K, N, WT, scr, it, c.lane);
}
__device__ __forceinline__ void cvt_copy(const Ctx& c, const float* __restrict__ src, bf16* dst, size_t n) {
    for (size_t i = (size_t)c.gt * 8; i < n; i += (size_t)c.NGT * 8) {
        const f32x4 a = *(const f32x4*)(src + i), b = *(const f32x4*)(src + i + 4);
        v4u w; w.x = pk2(a[0], a[1]); w.y = pk2(a[2], a[3]); w.z = pk2(b[0], b[1]); w.w = pk2(b[2], b[3]);
        *(v4u*)(dst + i) = w;
    }
}
__device__ __forceinline__ float wave_max(float v, int lane) {
#pragma unroll
    for (int o = 32; o >= 1; o >>= 1) v = fmaxf(v, shx(v, o, lane));
    return v;
}
__device__ __forceinline__ void cvt_tables(const Ctx& c, int layer) {
    float* sm = c.W<float>(WS_SMALL);
    for (int r = c.gw; r < 2 * 16384; r += c.NGW) {
        const int tb = r >> 14, row = r & 16383;
        const float* src = c.in[c.z + 44 + tb] + ((size_t)layer * 16384 + row) * D + 16 * c.lane;
        f32x4 v[4];
#pragma unroll
        for (int k = 0; k < 4; ++k) v[k] = *(const f32x4*)(src + 4 * k);
        float m = 0.f;
#pragma unroll
        for (int k = 0; k < 4; ++k) m = fmaxf(fmaxf(fmaxf(fabsf(v[k][0]), fabsf(v[k][1])), fmaxf(fabsf(v[k][2]), fabsf(v[k][3]))), m);
        m = fmaxf(wave_max(m, c.lane), 1e-30f);
        const int ex = (int)((__builtin_bit_cast(unsigned, m) >> 23) & 0xffu) - 127;
        const float sc = __builtin_bit_cast(float, (unsigned)(127 + 7 - ex) << 23);
        const float isc = __builtin_bit_cast(float, (unsigned)(127 - 7 + ex) << 23);
        v4u o;
        { int p = __builtin_amdgcn_cvt_pk_fp8_f32(v[0][0] * sc, v[0][1] * sc, 0, false); p = __builtin_amdgcn_cvt_pk_fp8_f32(v[0][2] * sc, v[0][3] * sc, p, true); o.x = (unsigned)p; }
        { int p = __builtin_amdgcn_cvt_pk_fp8_f32(v[1][0] * sc, v[1][1] * sc, 0, false); p = __builtin_amdgcn_cvt_pk_fp8_f32(v[1][2] * sc, v[1][3] * sc, p, true); o.y = (unsigned)p; }
        { int p = __builtin_amdgcn_cvt_pk_fp8_f32(v[2][0] * sc, v[2][1] * sc, 0, false); p = __builtin_amdgcn_cvt_pk_fp8_f32(v[2][2] * sc, v[2][3] * sc, p, true); o.z = (unsigned)p; }
        { int p = __builtin_amdgcn_cvt_pk_fp8_f32(v[3][0] * sc, v[3][1] * sc, 0, false); p = __builtin_amdgcn_cvt_pk_fp8_f32(v[3][2] * sc, v[3][3] * sc, p, true); o.w = (unsigned)p; }
        *(v4u*)(c.ws + (tb ? WS_EV : WS_EU) + (size_t)row * D + 16 * c.lane) = o;
        if (c.lane == 0) sm[(tb ? SM_ISV : SM_ISU) + row] = isc;
    }
}
__device__ __forceinline__ void prologue(const Ctx& c) {
    transpose_mat(c, c.in[c.z + 7], 1024, 1024, c.W<bf16>(WS_W_S5IN));
    transpose_mat(c, c.in[c.z + 16], 1024, 1024, c.W<bf16>(WS_W_S5GLU));
    transpose_mat(c, c.in[c.z + 18], 1024, 1024, c.W<bf16>(WS_W_S5OUT));
    transpose_mat(c, c.in[c.z + 19], 1024, 1024, c.W<bf16>(WS_W_PIN));
    for (int g = 0; g < 4; ++g) transpose_mat(c, c.in[c.z + 20] + (size_t)g * 65536, 256, 256, c.W<bf16>(WS_W_PGRP) + (size_t)g * 65536);
    transpose_mat(c, c.in[c.z + 22], 1024, 1024, c.W<bf16>(WS_W_POUT));
    transpose_mat(c, c.in[c.z + 23], 1024, 2048, c.W<bf16>(WS_W_CIN));
    transpose_mat(c, c.in[c.z + 29], 1024, 1024, c.W<bf16>(WS_W_COUT));
    transpose_mat(c, c.in[c.z + 30], 1024, 5152, c.W<bf16>(WS_W_SIN));
    transpose_mat(c, c.in[c.z + 37], 2048, 1024, c.W<bf16>(WS_W_SOUT));
    for (int l = 0; l < 4; ++l) transpose_mat(c, c.in[c.z + 42] + (size_t)l * 1024 * 2048, 1024, 2048, c.W<bf16>(WS_W_PQ) + (size_t)l * 2048 * 1024);
    {
        v4u* z = (v4u*)(c.W<bf16>(WS_W_SIN) + (size_t)5152 * 1024);
        for (int i = c.gt; i < 224 * 1024 / 8; i += c.NGT) z[i] = (v4u){0u, 0u, 0u, 0u};
    }
    cvt_copy(c, c.in[c.z + 43], c.W<bf16>(WS_KEYS), (size_t)4 * 8 * 2 * 128 * 128);
    {
        float* H = c.W<float>(WS_H32); bf16* HB = c.W<bf16>(WS_HB);
        for (size_t i = (size_t)c.gt * 8; i < (size_t)T * D; i += (size_t)c.NGT * 8) {
            const float* src = (i < (size_t)TP * D) ? (c.in[c.z + 0] + i) : (c.in[c.z + 1] + (i - (size_t)TP * D));
            const f32x4 a = *(const f32x4*)(src), b = *(const f32x4*)(src + 4);
            *(f32x4*)(H + i) = a; *(f32x4*)(H + i + 4) = b;
            v4u w; w.x = pk2(a[0], a[1]); w.y = pk2(a[2], a[3]); w.z = pk2(b[0], b[1]); w.w = pk2(b[2], b[3]);
            *(v4u*)(HB + i) = w;
        }
    }
    if (c.gt < 4096) {
        const int gp = c.gt, g = gp >> 6;
        float* sm = c.W<float>(WS_SMALL);
        const float dt = expf(c.in[c.z + 10][g]);
        const float lr = c.in[c.z + 8][gp], li = c.in[c.z + 9][gp];
        const float mag = expf(lr * dt);
        const float br = mag * cosf(li * dt), bi = mag * sinf(li * dt);
        const float den = lr * lr + li * li;
        const float fr = ((br - 1.f) * lr + bi * li) / den, fi = (bi * lr - (br - 1.f) * li) / den;
        sm[SM_LBR + gp] = br; sm[SM_LBI + gp] = bi;
        for (int i = 0; i < 16; ++i) {
            const float xr = c.in[c.z + 11][gp * 16 + i], xi = c.in[c.z + 12][gp * 16 + i];
            sm[SM_BBR + gp * 16 + i] = fr * xr - fi * xi; sm[SM_BBI + gp * 16 + i] = fr * xi + fi * xr;
        }
    }
    cvt_tables(c, 0);
}

__device__ __forceinline__ void ln_row_store(const f32x4 (&v)[4], float mean, float rstd, const float* __restrict__ g, const float* __restrict__ b, float* o32, bf16* ob, int lane) {
#pragma unroll
    for (int h = 0; h < 2; ++h) {
        const int c0 = h * 512 + 8 * lane;
        const f32x4 g0 = *(const f32x4*)(g + c0), g1 = *(const f32x4*)(g + c0 + 4), b0 = *(const f32x4*)(b + c0), b1 = *(const f32x4*)(b + c0 + 4);
        const f32x4 o0 = (v[2 * h] - mean) * rstd * g0 + b0, o1 = (v[2 * h + 1] - mean) * rstd * g1 + b1;
        *(f32x4*)(o32 + c0) = o0; *(f32x4*)(o32 + c0 + 4) = o1;
        if (ob) { v4u w; w.x = pk2(o0[0], o0[1]); w.y = pk2(o0[2], o0[3]); w.z = pk2(o1[0], o1[1]); w.w = pk2(o1[2], o1[3]); *(v4u*)(ob + c0) = w; }
    }
}
__device__ __forceinline__ void ln_stats(const f32x4 (&v)[4], float& mean, float& rstd, int lane) {
    float s = 0.f;
#pragma unroll
    for (int k = 0; k < 4; ++k) s += (v[k][0] + v[k][1]) + (v[k][2] + v[k][3]);
    mean = wave_sum(s, lane) * (1.f / D);
    float q = 0.f;
#pragma unroll
    for (int k = 0; k < 4; ++k) { const f32x4 d = v[k] - mean; q += (d[0] * d[0] + d[1] * d[1]) + (d[2] * d[2] + d[3] * d[3]); }
    rstd = rsqrtf(wave_sum(q, lane) * (1.f / D) + LN_EPS);
}
__device__ __forceinline__ void phase_ln1(const Ctx& c, int layer) {
    const float* R = c.W<float>(WS_R32); float* H = c.W<float>(WS_H32); bf16* HB = c.W<bf16>(WS_HB);
    const float* g = c.in[c.z + 38] + layer * D; const float* b = c.in[c.z + 39] + layer * D;
    for (int t = c.gw; t < T; t += c.NGW) {
        f32x4 v[4];
#pragma unroll
        for (int h = 0; h < 2; ++h) { v[2 * h] = *(const f32x4*)(R + (size_t)t * D + h * 512 + 8 * c.lane); v[2 * h + 1] = *(const f32x4*)(R + (size_t)t * D + h * 512 + 8 * c.lane + 4); }
        float mean, rstd; ln_stats(v, mean, rstd, c.lane);
        ln_row_store(v, mean, rstd, g, b, H + (size_t)t * D, HB + (size_t)t * D, c.lane);
    }
}

__device__ __forceinline__ bf16x8 mk8(float a0, float a1, float a2, float a3, float a4, float a5, float a6, float a7) {
    v4u w; w.x = pk2(a0, a1); w.y = pk2(a2, a3); w.z = pk2(a4, a5); w.w = pk2(a6, a7); return __builtin_bit_cast(bf16x8, w);
}
constexpr int S5_BU_LD = 132  , S5_H_LD = 136  , S5_WAVE_BYTES = 16 * S5_BU_LD * 4 + 16 * S5_H_LD * 2;
__device__ __forceinline__ void phase_s5scan(const Ctx& c) {
    const bf16* U = c.W<bf16>(WS_A0); bf16* G = c.W<bf16>(WS_A1);
    const float* sm = c.W<float>(WS_SMALL);
    float* out = c.out;
    float* o_re_p = out + 17825792, *o_im_p = o_re_p + 32768, *o_re_s = out + 17825792 + 32768 * 2 + 122880 + 73728 + 2097152, *o_im_s = o_re_s + 524288;
    const int lane = c.lane, p = lane, fr = lane & 15, fq = lane >> 4;
    LAS float* BuT = (LAS float*)(c.lds + c.wave * S5_WAVE_BYTES);
    LAS bf16* Hi = (LAS bf16*)(c.lds + c.wave * S5_WAVE_BYTES + 16 * S5_BU_LD * 4);
    const int wslot = c.wave * c.nblk + c.bid;
    for (int unit = wslot; unit < 136 * 64; unit += c.NGW) {
        const int s = unit >> 6, g = unit & 63;
        int tok0, L; seq_info(s, tok0, L);
        bf16x8 Bf[8];
#pragma unroll
        for (int nt = 0; nt < 8; ++nt) {
            const int comp = 16 * nt + fr;
            const float* src = sm + ((comp < 64) ? SM_BBR : SM_BBI) + (size_t)(g * 64 + (comp & 63)) * 16 + 8 * (fq & 1);
            const f32x4 a = *(const f32x4*)src, b = *(const f32x4*)(src + 4);
            const bf16x8 v = mk8(a[0], a[1], a[2], a[3], b[0], b[1], b[2], b[3]);
            Bf[nt] = (fq < 2) ? v : (bf16x8){0, 0, 0, 0, 0, 0, 0, 0};
        }
        bf16x8 Cf[4];
#pragma unroll
        for (int ks = 0; ks < 4; ++ks) {
            const int comp0 = 32 * ks + 8 * fq;
            const float* src = ((ks < 2) ? c.in[c.z + 13] : c.in[c.z + 14]) + (size_t)(g * 16 + fr) * 64 + (comp0 & 63);
            const f32x4 a = *(const f32x4*)src, b = *(const f32x4*)(src + 4);
            const float sg = (ks < 2) ? 1.f : -1.f;
            Cf[ks] = mk8(sg * a[0], sg * a[1], sg * a[2], sg * a[3], sg * b[0], sg * b[1], sg * b[2], sg * b[3]);
        }
        const float lr = sm[SM_LBR + g * 64 + p], li = sm[SM_LBI + g * 64 + p];
        float hr = 0.f, hi = 0.f;
        if (s >= 8) { hr = c.in[c.z + 2][((s - 8) * 64 + g) * 64 + p]; hi = c.in[c.z + 3][((s - 8) * 64 + g) * 64 + p]; }
        const f32x4 dk4 = *(const f32x4*)(c.in[c.z + 15] + g * 16 + 4 * fq);
        const int ntile = (L + 15) >> 4;
        for (int tile = 0; tile < ntile; ++tile) {
            const int tb = tok0 + tile * 16;
            const bool valid = (tile * 16 + fr) < L;
            bf16x8 uf = {0, 0, 0, 0, 0, 0, 0, 0};
            if (fq < 2 && valid) uf = *(const bf16x8*)(U + (size_t)(tb + fr) * D + g * 16 + 8 * fq);
#pragma unroll
            for (int nt = 0; nt < 8; ++nt) {
                f32x4 acc = {0.f, 0.f, 0.f, 0.f};
                acc = __builtin_amdgcn_mfma_f32_16x16x32_bf16(Bf[nt], uf, acc, 0, 0, 0);
                *(LAS f32x4*)(BuT + fr * S5_BU_LD + 16 * nt + 4 * fq) = acc;
            }
            asm volatile("s_waitcnt lgkmcnt(0)" ::: "memory");
            const int nsteps = min(16, L - tile * 16);
#pragma unroll
            for (int t = 0; t < 16; ++t) {
                const float br = BuT[t * S5_BU_LD + p], bi = BuT[t * S5_BU_LD + 64 + p];
                const float nr = lr * hr - li * hi + br, ni = lr * hi + li * hr + bi;
                if (t < nsteps) { hr = nr; hi = ni; }
                Hi[t * S5_H_LD + p] = (bf16)f2bf(hr); Hi[t * S5_H_LD + 64 + p] = (bf16)f2bf(hi);
            }
            asm volatile("s_waitcnt lgkmcnt(0)" ::: "memory");
            f32x4 y = {0.f, 0.f, 0.f, 0.f};
#pragma unroll
            for (int ks = 0; ks < 4; ++ks) {
                const bf16x8 hf = *(const LAS bf16x8*)(Hi + fr * S5_H_LD + 32 * ks + 8 * fq);
                y = __builtin_amdgcn_mfma_f32_16x16x32_bf16(Cf[ks], hf, y, 0, 0, 0);
            }
            if (valid) {
                const v2u uq = *(const v2u*)(U + (size_t)(tb + fr) * D + g * 16 + 4 * fq);
                v2u o; o.x = pk2(gelu_f(y[0] + dk4[0] * bflo(uq.x)), gelu_f(y[1] + dk4[1] * bfhi(uq.x))); o.y = pk2(gelu_f(y[2] + dk4[2] * bflo(uq.y)), gelu_f(y[3] + dk4[3] * bfhi(uq.y)));
                *(v2u*)(G + (size_t)(tb + fr) * D + g * 16 + 4 * fq) = o;
            }
            asm volatile("" ::: "memory");
        }
        if (s < 8) { o_re_p[(s * 64 + g) * 64 + p] = hr; o_im_p[(s * 64 + g) * 64 + p] = hi; }
        else { o_re_s[((s - 8) * 64 + g) * 64 + p] = hr; o_im_s[((s - 8) * 64 + g) * 64 + p] = hi; }
    }
}

__device__ __forceinline__ void phase_pool(const Ctx& c) {
    const bf16* U = c.W<bf16>(WS_A0); bf16* P = c.W<bf16>(WS_A1);
    float* o_p = c.out + 17825792 + 65536, *o_s = c.out + 17825792 + 65536 + 122880 + 73728 + 2097152 + 1048576;
    for (size_t i = (size_t)c.gt; i < (size_t)T * 128; i += (size_t)c.NGT) {
        const int t = (int)(i >> 7), c0 = (int)(i & 127) * 8;
        int s, l, tok0; tok_info(t, s, l, tok0);
        const int w = 2 << (c0 >> 8);
        float sum[8];
#pragma unroll
        for (int j = 0; j < 8; ++j) sum[j] = 0.f;
        float cur[8];
        for (int k = 0; k < w; ++k) {
            const int ll = l - k;
            if (ll >= 0) {
                const v4u q = *(const v4u*)(U + (size_t)(tok0 + ll) * D + c0);
                const float f[8] = {bflo(q.x), bfhi(q.x), bflo(q.y), bfhi(q.y), bflo(q.z), bfhi(q.z), bflo(q.w), bfhi(q.w)};
#pragma unroll
                for (int j = 0; j < 8; ++j) { sum[j] += f[j]; if (k == 0) cur[j] = f[j]; }
            } else if (s >= 8) {
                const float* sp = c.in[c.z + 4] + ((size_t)(s - 8) * 15 + (15 + ll)) * D + c0;
                const f32x4 a = *(const f32x4*)sp, b = *(const f32x4*)(sp + 4);
                sum[0] += a[0]; sum[1] += a[1]; sum[2] += a[2]; sum[3] += a[3]; sum[4] += b[0]; sum[5] += b[1]; sum[6] += b[2]; sum[7] += b[3];
            }
        }
        const int pos = (s >= 8 ? 16384 : 0) + l;
        const float inv = 1.f / (float)min(pos + 1, w);
        v4u o; o.x = pk2(sum[0] * inv - cur[0], sum[1] * inv - cur[1]); o.y = pk2(sum[2] * inv - cur[2], sum[3] * inv - cur[3]);
        o.z = pk2(sum[4] * inv - cur[4], sum[5] * inv - cur[5]); o.w = pk2(sum[6] * inv - cur[6], sum[7] * inv - cur[7]);
        *(v4u*)(P + (size_t)t * D + c0) = o;
    }
    for (size_t i = (size_t)c.gt; i < (size_t)136 * 15 * D; i += (size_t)c.NGT) {
        const int ch = (int)(i & 1023); const int j = (int)((i >> 10) % 15); const int s = (int)(i / (15 * 1024));
        if (s < 8) o_p[((size_t)s * 15 + j) * D + ch] = bf2f(U[(size_t)(s * 2048 + 2033 + j) * D + ch]);
        else { const int b = s - 8; o_s[((size_t)b * 15 + j) * D + ch] = (j < 7) ? c.in[c.z + 4][((size_t)b * 15 + 8 + j) * D + ch] : bf2f(U[(size_t)(TP + b * 8 + (j - 7)) * D + ch]); }
    }
}

__device__ __forceinline__ void phase_cmlp_ln(const Ctx& c) {
    bf16* Z = c.W<bf16>(WS_Q);
    float* o_v = c.out + 17825792 + 65536 + 122880 + 73728 + 2097152 + 1048576 + 1966080;
    const float* g = c.in[c.z + 25]; const float* b = c.in[c.z + 26];
    for (int t = c.gw; t < T; t += c.NGW) {
        bf16* vr = Z + (size_t)t * 2048 + 1024;
        f32x4 v[4];
#pragma unroll
        for (int h = 0; h < 2; ++h) {
            const v4u q = *(const v4u*)(vr + h * 512 + 8 * c.lane);
            v[2 * h] = (f32x4){bflo(q.x), bfhi(q.x), bflo(q.y), bfhi(q.y)}; v[2 * h + 1] = (f32x4){bflo(q.z), bfhi(q.z), bflo(q.w), bfhi(q.w)};
        }
        float mean, rstd; ln_stats(v, mean, rstd, c.lane);
#pragma unroll
        for (int h = 0; h < 2; ++h) {
            const int c0 = h * 512 + 8 * c.lane;
            const f32x4 g0 = *(const f32x4*)(g + c0), g1 = *(const f32x4*)(g + c0 + 4), b0 = *(const f32x4*)(b + c0), b1 = *(const f32x4*)(b + c0 + 4);
            const f32x4 o0 = (v[2 * h] - mean) * rstd * g0 + b0, o1 = (v[2 * h + 1] - mean) * rstd * g1 + b1;
            v4u w; w.x = pk2(o0[0], o0[1]); w.y = pk2(o0[2], o0[3]); w.z = pk2(o1[0], o1[1]); w.w = pk2(o1[2], o1[3]);
            *(v4u*)(vr + c0) = w;
            if (t >= TP) { *(f32x4*)(o_v + (size_t)(t - TP) * D + c0) = o0; *(f32x4*)(o_v + (size_t)(t - TP) * D + c0 + 4) = o1; }
        }
    }
}
__device__ __forceinline__ void phase_cmlp_mix(const Ctx& c) {
    const bf16* Z = c.W<bf16>(WS_Q); bf16* O = c.W<bf16>(WS_A1);
    for (size_t i = (size_t)c.gt; i < (size_t)T * 128; i += (size_t)c.NGT) {
        const int t = (int)(i >> 7), c0 = (int)(i & 127) * 8;
        int s, l, tok0; tok_info(t, s, l, tok0);
        const int hd = c0 >> 8, tp = (s < 8) ? (l & 127) : l, base = t - tp;
        float acc[8];
        const float bs = c.in[c.z + 28][hd * 128 + tp];
#pragma unroll
        for (int j = 0; j < 8; ++j) acc[j] = bs;
        const float* wr = c.in[c.z + 27] + ((size_t)hd * 128 + tp) * 128;
        for (int sp = 0; sp <= tp; ++sp) {
            const float w = wr[sp];
            const v4u q = *(const v4u*)(Z + (size_t)(base + sp) * 2048 + 1024 + c0);
            acc[0] += w * bflo(q.x); acc[1] += w * bfhi(q.x); acc[2] += w * bflo(q.y); acc[3] += w * bfhi(q.y);
            acc[4] += w * bflo(q.z); acc[5] += w * bfhi(q.z); acc[6] += w * bflo(q.w); acc[7] += w * bfhi(q.w);
        }
        const v4u uq = *(const v4u*)(Z + (size_t)t * 2048 + c0);
        v4u o; o.x = pk2(bflo(uq.x) * acc[0], bfhi(uq.x) * acc[1]); o.y = pk2(bflo(uq.y) * acc[2], bfhi(uq.y) * acc[3]);
        o.z = pk2(bflo(uq.z) * acc[4], bfhi(uq.z) * acc[5]); o.w = pk2(bflo(uq.w) * acc[6], bfhi(uq.w) * acc[7]);
        *(v4u*)(O + (size_t)t * D + c0) = o;
    }
}

__device__ __forceinline__ void phase_ssd_conv(const Ctx& c) {
    const bf16* X = c.W<bf16>(WS_XBC); bf16* XC = c.W<bf16>(WS_XC);
    float* o_p = c.out + 17825792 + 65536 + 122880, *o_s = c.out + 17825792 + 65536 + 122880 + 73728 + 2097152 + 1048576 + 1966080 + 1048576;
    for (size_t i = (size_t)c.gt; i < (size_t)T * (CONVD / 8); i += (size_t)c.NGT) {
        const int t = (int)(i / (CONVD / 8)), c0 = (int)(i % (CONVD / 8)) * 8;
        int s, l, tok0; tok_info(t, s, l, tok0);
        float acc[8];
        { const f32x4 a = *(const f32x4*)(c.in[c.z + 32] + c0), b = *(const f32x4*)(c.in[c.z + 32] + c0 + 4); acc[0] = a[0]; acc[1] = a[1]; acc[2] = a[2]; acc[3] = a[3]; acc[4] = b[0]; acc[5] = b[1]; acc[6] = b[2]; acc[7] = b[3]; }
#pragma unroll
        for (int k = 0; k < 4; ++k) {
            const int src = l + k - 3;
            float f[8];
            if (src >= 0) {
                const v4u q = *(const v4u*)(X + (size_t)(tok0 + src) * CONVD + c0);
                f[0] = bflo(q.x); f[1] = bfhi(q.x); f[2] = bflo(q.y); f[3] = bfhi(q.y); f[4] = bflo(q.z); f[5] = bfhi(q.z); f[6] = bflo(q.w); f[7] = bfhi(q.w);
            } else if (s >= 8) {
                const float* sp = c.in[c.z + 5] + ((size_t)(s - 8) * 3 + (l + k)) * CONVD + c0;
                const f32x4 a = *(const f32x4*)sp, b = *(const f32x4*)(sp + 4);
                f[0] = a[0]; f[1] = a[1]; f[2] = a[2]; f[3] = a[3]; f[4] = b[0]; f[5] = b[1]; f[6] = b[2]; f[7] = b[3];
            } else {
#pragma unroll
                for (int j = 0; j < 8; ++j) f[j] = 0.f;
            }
            const f32x4 wa = *(const f32x4*)(c.in[c.z + 31] + k * CONVD + c0), wb = *(const f32x4*)(c.in[c.z + 31] + k * CONVD + c0 + 4);
            acc[0] += f[0] * wa[0]; acc[1] += f[1] * wa[1]; acc[2] += f[2] * wa[2]; acc[3] += f[3] * wa[3];
            acc[4] += f[4] * wb[0]; acc[5] += f[5] * wb[1]; acc[6] += f[6] * wb[2]; acc[7] += f[7] * wb[3];
        }
        v4u o; o.x = pk2(silu_f(acc[0]), silu_f(acc[1])); o.y = pk2(silu_f(acc[2]), silu_f(acc[3])); o.z = pk2(silu_f(acc[4]), silu_f(acc[5])); o.w = pk2(silu_f(acc[6]), silu_f(acc[7]));
        *(v4u*)(XC + (size_t)t * CONVD + c0) = o;
    }
    for (size_t i = (size_t)c.gt; i < (size_t)136 * 3 * CONVD; i += (size_t)c.NGT) {
        const int ch = (int)(i % CONVD); const int j = (int)((i / CONVD) % 3); const int s = (int)(i / (3 * CONVD));
        if (s < 8) o_p[((size_t)s * 3 + j) * CONVD + ch] = bf2f(X[(size_t)(s * 2048 + 2045 + j) * CONVD + ch]);
        else { const int b = s - 8; o_s[((size_t)b * 3 + j) * CONVD + ch] = bf2f(X[(size_t)(TP + b * 8 + 5 + j) * CONVD + ch]); }
    }
}
constexpr int SD_LD = 136;
constexpr int SD_C = 0, SD_B = 34816, SD_BT = 69632, SD_XT = 104448, SD_HB = 121856, SD_VEC = 139264;
__device__ __forceinline__ float softplus_f(float x) { return (x > 20.f) ? x : log1pf(__expf(x)); }
__device__ __forceinline__ void phase_ssd_scan(const Ctx& c) {
    const bf16* XC = c.W<bf16>(WS_XC); const float* DT = c.W<float>(WS_DT); bf16* Y = c.W<bf16>(WS_Y);
    float* o_p = c.out + 17825792 + 65536 + 122880 + 73728;
    float* o_s = c.out + 17825792 + 65536 + 122880 + 73728 + 2097152 + 1048576 + 1966080 + 1048576 + 1179648;
    const int tid = c.tid, lane = c.lane, w = c.wave, fr = lane & 15, fq = lane >> 4;
    LAS unsigned char* lds = c.lds;
    LAS float* csv = (LAS float*)(lds + SD_VEC); LAS float* dtv = csv + 128;
#define SD_FRAG(img, row, ks) (*(const LAS bf16x8*)(lds + (img) + ((row) * SD_LD + (ks) * 32 + 8 * fq) * 2))
    for (int unit = c.bid; unit < 8 * 32; unit += c.nblk) {
        const int s = unit >> 5, hd = unit & 31, g = hd >> 3;
        const float a = -__expf(c.in[c.z + 34][hd]), dtb = c.in[c.z + 33][hd], dk = c.in[c.z + 35][hd];
        f32x4 hacc[4];
#pragma unroll
        for (int jp = 0; jp < 4; ++jp) hacc[jp] = (f32x4){0.f, 0.f, 0.f, 0.f};
        for (int ch = 0; ch < 16; ++ch) {
            const int tokc = s * 2048 + ch * 128;
            if (w == 0) {
                const float dt0 = softplus_f(DT[(size_t)(tokc + lane) * 32 + hd] + dtb), dt1 = softplus_f(DT[(size_t)(tokc + 64 + lane) * 32 + hd] + dtb);
                float s0 = dt0 * a, s1 = dt1 * a;
#pragma unroll
                for (int o = 1; o < 64; o <<= 1) {
                    const float u0 = __builtin_bit_cast(float, __builtin_amdgcn_ds_bpermute(((lane - o) & 63) << 2, __builtin_bit_cast(int, s0)));
                    const float u1 = __builtin_bit_cast(float, __builtin_amdgcn_ds_bpermute(((lane - o) & 63) << 2, __builtin_bit_cast(int, s1)));
                    if (lane >= o) { s0 += u0; s1 += u1; }
                }
                const float tot0 = __builtin_bit_cast(float, __builtin_amdgcn_readlane(__builtin_bit_cast(int, s0), 63));
                csv[lane] = s0; csv[64 + lane] = tot0 + s1; dtv[lane] = dt0; dtv[64 + lane] = dt1;
            }
#pragma unroll
            for (int k = 0; k < 4; ++k) {
                const int q = tid + 512 * k, row = q >> 4, cc = q & 15;
                const bf16* src = XC + (size_t)(tokc + row) * CONVD + g * 128 + cc * 8;
                *(LAS v4u*)(lds + SD_C + (row * SD_LD + cc * 8) * 2) = *(const v4u*)(src + 2560);
                *(LAS v4u*)(lds + SD_B + (row * SD_LD + cc * 8) * 2) = *(const v4u*)(src + 2048);
            }
#pragma unroll
            for (int jp = 0; jp < 4; ++jp) {
                v2u hq; hq.x = pk2(hacc[jp][0], hacc[jp][1]); hq.y = pk2(hacc[jp][2], hacc[jp][3]);
                *(LAS v2u*)(lds + SD_HB + ((16 * jp + fr) * SD_LD + 16 * w + 4 * fq) * 2) = hq;
            }
            __syncthreads();
            {
                const int srow = tid & 127, qq = tid >> 7;
                const float sc = __expf(csv[127] - csv[srow]) * dtv[srow];
#pragma unroll
                for (int k = 0; k < 4; ++k) {
                    const int n0 = qq * 32 + k * 8;
                    const v4u bq = *(const LAS v4u*)(lds + SD_B + (srow * SD_LD + n0) * 2);
                    const float f[8] = {bflo(bq.x), bfhi(bq.x), bflo(bq.y), bfhi(bq.y), bflo(bq.z), bfhi(bq.z), bflo(bq.w), bfhi(bq.w)};
#pragma unroll
                    for (int j = 0; j < 8; ++j) *(LAS bf16*)(lds + SD_BT + ((n0 + j) * SD_LD + srow) * 2) = (bf16)f2bf(f[j] * sc);
                }
                const bf16* xs = XC + (size_t)(tokc + srow) * CONVD + hd * 64 + qq * 16;
                const v4u x0 = *(const v4u*)xs, x1 = *(const v4u*)(xs + 8);
                const unsigned xw[8] = {x0.x, x0.y, x0.z, x0.w, x1.x, x1.y, x1.z, x1.w};
#pragma unroll
                for (int j = 0; j < 8; ++j) {
                    *(LAS bf16*)(lds + SD_XT + ((qq * 16 + 2 * j) * SD_LD + srow) * 2) = (bf16)(xw[j] & 0xffffu);
                    *(LAS bf16*)(lds + SD_XT + ((qq * 16 + 2 * j + 1) * SD_LD + srow) * 2) = (bf16)(xw[j] >> 16);
                }
            }
            __syncthreads();
            const int jmax = w | 1;
            bf16x8 Cf[4];
#pragma unroll
            for (int ks = 0; ks < 4; ++ks) Cf[ks] = SD_FRAG(SD_C, 16 * w + fr, ks);
            f32x4 acc[8];
#pragma unroll
            for (int j = 0; j < 8; ++j) {
                acc[j] = (f32x4){0.f, 0.f, 0.f, 0.f};
                if (j <= jmax) {
#pragma unroll
                    for (int ks = 0; ks < 4; ++ks) acc[j] = __builtin_amdgcn_mfma_f32_16x16x32_bf16(SD_FRAG(SD_B, 16 * j + fr, ks), Cf[ks], acc[j], 0, 0, 0);
                }
            }
            {
                const float cdec = __expf(csv[127]);
                bf16x8 Bt[4];
#pragma unroll
                for (int ks = 0; ks < 4; ++ks) Bt[ks] = SD_FRAG(SD_BT, 16 * w + fr, ks);
#pragma unroll
                for (int jp = 0; jp < 4; ++jp) {
                    hacc[jp] = hacc[jp] * cdec;
#pragma unroll
                    for (int ks = 0; ks < 4; ++ks) hacc[jp] = __builtin_amdgcn_mfma_f32_16x16x32_bf16(Bt[ks], SD_FRAG(SD_XT, 16 * jp + fr, ks), hacc[jp], 0, 0, 0);
                }
            }
            __syncthreads();
            {
                const int t = 16 * w + fr; const float cst = csv[t];
#pragma unroll
                for (int j = 0; j < 8; ++j) {
                    if (j <= jmax) {
                        const f32x4 css = *(const LAS f32x4*)(csv + 16 * j + 4 * fq), dts = *(const LAS f32x4*)(dtv + 16 * j + 4 * fq);
                        float v[4];
#pragma unroll
                        for (int r = 0; r < 4; ++r) v[r] = (16 * j + 4 * fq + r <= t) ? acc[j][r] * __expf(cst - css[r]) * dts[r] : 0.f;
                        v2u lq; lq.x = pk2(v[0], v[1]); lq.y = pk2(v[2], v[3]);
                        *(LAS v2u*)(lds + SD_B + (t * SD_LD + 16 * j + 4 * fq) * 2) = lq;
                    }
                }
            }
            __syncthreads();
            {
                f32x4 a1[4], a2[4];
#pragma unroll
                for (int jp = 0; jp < 4; ++jp) { a1[jp] = (f32x4){0.f, 0.f, 0.f, 0.f}; a2[jp] = (f32x4){0.f, 0.f, 0.f, 0.f}; }
#pragma unroll
                for (int ks = 0; ks < 4; ++ks) {
                    if (ks <= (w >> 1)) {
                        const bf16x8 Lf = SD_FRAG(SD_B, 16 * w + fr, ks);
#pragma unroll
                        for (int jp = 0; jp < 4; ++jp) a1[jp] = __builtin_amdgcn_mfma_f32_16x16x32_bf16(SD_FRAG(SD_XT, 16 * jp + fr, ks), Lf, a1[jp], 0, 0, 0);
                    }
#pragma unroll
                    for (int jp = 0; jp < 4; ++jp) a2[jp] = __builtin_amdgcn_mfma_f32_16x16x32_bf16(SD_FRAG(SD_HB, 16 * jp + fr, ks), Cf[ks], a2[jp], 0, 0, 0);
                }
                const int t = 16 * w + fr; const float ecs = __expf(csv[t]);
                const size_t tok = (size_t)(tokc + t);
#pragma unroll
                for (int jp = 0; jp < 4; ++jp) {
                    const v2u xq = *(const v2u*)(XC + tok * CONVD + hd * 64 + 16 * jp + 4 * fq);
                    v2u yo; yo.x = pk2(a1[jp][0] + ecs * a2[jp][0] + dk * bflo(xq.x), a1[jp][1] + ecs * a2[jp][1] + dk * bfhi(xq.x));
                    yo.y = pk2(a1[jp][2] + ecs * a2[jp][2] + dk * bflo(xq.y), a1[jp][3] + ecs * a2[jp][3] + dk * bfhi(xq.y));
                    *(v2u*)(Y + tok * 2048 + hd * 64 + 16 * jp + 4 * fq) = yo;
                }
            }
            __syncthreads();
        }
#pragma unroll
        for (int jp = 0; jp < 4; ++jp) *(f32x4*)(o_p + (((size_t)s * 32 + hd) * 64 + 16 * jp + fr) * 128 + 16 * w + 4 * fq) = hacc[jp];
    }
#undef SD_FRAG
    __syncthreads();
    {
        LAS float* Bw = (LAS float*)(lds + w * 8192);
        LAS float* Cw = Bw + 1024;
        for (int unit = c.gw; unit < 128 * 32; unit += c.NGW) {
            const int b = unit >> 5, hd = unit & 31, g = hd >> 3, tok0 = TP + b * 8, p = lane;
            const float a = -__expf(c.in[c.z + 34][hd]), dtb = c.in[c.z + 33][hd], dk = c.in[c.z + 35][hd];
            {
                const int tk = lane >> 3, c0 = (lane & 7) * 16;
                const bf16* src = XC + (size_t)(tok0 + tk) * CONVD + g * 128 + c0;
                const v4u b0 = *(const v4u*)(src + 2048), b1 = *(const v4u*)(src + 2048 + 8), c0v = *(const v4u*)(src + 2560), c1v = *(const v4u*)(src + 2560 + 8);
                LAS float* bd = Bw + tk * 128 + c0; LAS float* cd = Cw + tk * 128 + c0;
                *(LAS f32x4*)(bd) = (f32x4){bflo(b0.x), bfhi(b0.x), bflo(b0.y), bfhi(b0.y)}; *(LAS f32x4*)(bd + 4) = (f32x4){bflo(b0.z), bfhi(b0.z), bflo(b0.w), bfhi(b0.w)};
                *(LAS f32x4*)(bd + 8) = (f32x4){bflo(b1.x), bfhi(b1.x), bflo(b1.y), bfhi(b1.y)}; *(LAS f32x4*)(bd + 12) = (f32x4){bflo(b1.z), bfhi(b1.z), bflo(b1.w), bfhi(b1.w)};
                *(LAS f32x4*)(cd) = (f32x4){bflo(c0v.x), bfhi(c0v.x), bflo(c0v.y), bfhi(c0v.y)}; *(LAS f32x4*)(cd + 4) = (f32x4){bflo(c0v.z), bfhi(c0v.z), bflo(c0v.w), bfhi(c0v.w)};
                *(LAS f32x4*)(cd + 8) = (f32x4){bflo(c1v.x), bfhi(c1v.x), bflo(c1v.y), bfhi(c1v.y)}; *(LAS f32x4*)(cd + 12) = (f32x4){bflo(c1v.z), bfhi(c1v.z), bflo(c1v.w), bfhi(c1v.w)};
            }
            float xv[8], dA[8], coef[8], yv[8];
#pragma unroll
            for (int t = 0; t < 8; ++t) {
                xv[t] = bf2f(XC[(size_t)(tok0 + t) * CONVD + hd * 64 + p]);
                const float dtv_ = softplus_f(DT[(size_t)(tok0 + t) * 32 + hd] + dtb);
                dA[t] = __expf(dtv_ * a); coef[t] = dtv_ * xv[t]; yv[t] = dk * xv[t];
            }
            asm volatile("s_waitcnt lgkmcnt(0)" ::: "memory");
            const float* hin = c.in[c.z + 6] + (((size_t)b * 32 + hd) * 64 + p) * 128;
            float* hout = o_s + (((size_t)b * 32 + hd) * 64 + p) * 128;
#pragma unroll 1
            for (int qt = 0; qt < 4; ++qt) {
                float h[32];
#pragma unroll
                for (int i = 0; i < 8; ++i) { const f32x4 q = *(const f32x4*)(hin + qt * 32 + 4 * i); h[4 * i] = q[0]; h[4 * i + 1] = q[1]; h[4 * i + 2] = q[2]; h[4 * i + 3] = q[3]; }
#pragma unroll
                for (int t = 0; t < 8; ++t) {
                    float ya = 0.f, yb = 0.f;
#pragma unroll
                    for (int i = 0; i < 8; ++i) {
                        const f32x4 bq = *(const LAS f32x4*)(Bw + t * 128 + qt * 32 + 4 * i), cq = *(const LAS f32x4*)(Cw + t * 128 + qt * 32 + 4 * i);
                        h[4 * i] = h[4 * i] * dA[t] + coef[t] * bq[0]; ya += cq[0] * h[4 * i];
                        h[4 * i + 1] = h[4 * i + 1] * dA[t] + coef[t] * bq[1]; yb += cq[1] * h[4 * i + 1];
                        h[4 * i + 2] = h[4 * i + 2] * dA[t] + coef[t] * bq[2]; ya += cq[2] * h[4 * i + 2];
                        h[4 * i + 3] = h[4 * i + 3] * dA[t] + coef[t] * bq[3]; yb += cq[3] * h[4 * i + 3];
                    }
                    yv[t] += ya + yb;
                    asm volatile("" ::: "memory");
                }
#pragma unroll
                for (int i = 0; i < 8; ++i) *(f32x4*)(hout + qt * 32 + 4 * i) = (f32x4){h[4 * i], h[4 * i + 1], h[4 * i + 2], h[4 * i + 3]};
            }
#pragma unroll
            for (int t = 0; t < 8; ++t) Y[(size_t)(tok0 + t) * 2048 + hd * 64 + p] = (bf16)f2bf(yv[t]);
            asm volatile("" ::: "memory");
        }
    }
}
__device__ __forceinline__ void phase_ssd_gatenorm(const Ctx& c) {
    const bf16* Y = c.W<bf16>(WS_Y); const bf16* Z = c.W<bf16>(WS_Q); bf16* YN = c.W<bf16>(WS_YN);
    for (int it = c.gw; it < T * 4; it += c.NGW) {
        const int t = it >> 2, c0 = (it & 3) * 512 + 8 * c.lane;
        const v4u yq = *(const v4u*)(Y + (size_t)t * 2048 + c0), zq = *(const v4u*)(Z + (size_t)t * 2048 + c0);
        const float yf[8] = {bflo(yq.x), bfhi(yq.x), bflo(yq.y), bfhi(yq.y), bflo(yq.z), bfhi(yq.z), bflo(yq.w), bfhi(yq.w)};
        const float zf[8] = {bflo(zq.x), bfhi(zq.x), bflo(zq.y), bfhi(zq.y), bflo(zq.z), bfhi(zq.z), bflo(zq.w), bfhi(zq.w)};
        float v[8]; float q = 0.f;
#pragma unroll
        for (int j = 0; j < 8; ++j) { v[j] = yf[j] * silu_f(zf[j]); q += v[j] * v[j]; }
        const float r = rsqrtf(wave_sum(q, c.lane) * (1.f / 512.f) + RMS_EPS);
        const f32x4 g0 = *(const f32x4*)(c.in[c.z + 36] + c0), g1 = *(const f32x4*)(c.in[c.z + 36] + c0 + 4);
        v4u o; o.x = pk2(v[0] * r * g0[0], v[1] * r * g0[1]); o.y = pk2(v[2] * r * g0[2], v[3] * r * g0[3]); o.z = pk2(v[4] * r * g1[0], v[5] * r * g1[1]); o.w = pk2(v[6] * r * g1[2], v[7] * r * g1[3]);
        *(v4u*)(YN + (size_t)t * 2048 + c0) = o;
    }
}

__device__ __forceinline__ unsigned ord_key(float s) { const unsigned u = __builtin_bit_cast(unsigned, s); return (u & 0x80000000u) ? ~u : (u | 0x80000000u); }
__device__ __forceinline__ float ord_dec(unsigned k) { const unsigned u = (k & 0x80000000u) ? (k & 0x7fffffffu) : ~k; return __builtin_bit_cast(float, u); }
__device__ __forceinline__ void ins16(unsigned (&Lk)[16], unsigned x) {
#pragma unroll
    for (int k = 0; k < 16; ++k) { const unsigned hi = max(Lk[k], x); x = min(Lk[k], x); Lk[k] = hi; }
}
constexpr int RT_SC_LD = 260, RT_LIST_OFF = 128 * RT_SC_LD * 4;
__device__ __forceinline__ void phase_route(const Ctx& c, int layer) {
    const bf16* Q = c.W<bf16>(WS_Q); const bf16* KEYS = c.W<bf16>(WS_KEYS) + (size_t)layer * 8 * 2 * 128 * 128;
    int* IDX = c.W<int>(WS_IDX); float* GATE = c.W<float>(WS_GATE); float* SCU = c.W<float>(WS_SCU);
    const float* ISU = c.W<float>(WS_SMALL) + SM_ISU; const float* ISV = c.W<float>(WS_SMALL) + SM_ISV;
    LAS float* sc = (LAS float*)c.lds; LAS unsigned* lists = (LAS unsigned*)(c.lds + RT_LIST_OFF);
    const int fr = c.lane & 15, fq = c.lane >> 4;
    for (int task = c.bid; task < 136 * 8; task += c.nblk) {
        const int tt = task >> 3, h = task & 7, tok0 = tt * 128;
        {
            const bf16* qrow = Q + (size_t)(tok0 + 16 * c.wave + fr) * 2048 + h * 256 + 8 * fq;
#pragma unroll
            for (int side = 0; side < 2; ++side) {
                bf16x8 qf[4];
#pragma unroll
                for (int ks = 0; ks < 4; ++ks) qf[ks] = *(const bf16x8*)(qrow + side * 128 + ks * 32);
                const bf16* kb = KEYS + ((size_t)(h * 2 + side) * 128 + fr) * 128 + 8 * fq;
#pragma unroll
                for (int nt = 0; nt < 8; ++nt) {
                    f32x4 acc = {0.f, 0.f, 0.f, 0.f};
#pragma unroll
                    for (int ks = 0; ks < 4; ++ks) {
                        const bf16x8 kf = *(const bf16x8*)(kb + (size_t)nt * 16 * 128 + ks * 32);
                        acc = __builtin_amdgcn_mfma_f32_16x16x32_bf16(kf, qf[ks], acc, 0, 0, 0);
                    }
                    *(LAS f32x4*)(sc + (16 * c.wave + fr) * RT_SC_LD + side * 128 + nt * 16 + 4 * fq) = acc;
                }
            }
        }
        __syncthreads();
        if (c.tid < 256) {
            const int token = c.tid & 127, side = c.tid >> 7;
            unsigned Lk[16];
#pragma unroll
            for (int k = 0; k < 16; ++k) Lk[k] = 0u;
            const LAS float* row = sc + token * RT_SC_LD + side * 128;
            for (int n4 = 0; n4 < 32; ++n4) {
                const f32x4 v = *(const LAS f32x4*)(row + n4 * 4);
#pragma unroll
                for (int j = 0; j < 4; ++j) ins16(Lk, (ord_key(v[j]) & ~127u) | (unsigned)(127 - (n4 * 4 + j)));
            }
#pragma unroll
            for (int k = 0; k < 16; ++k) lists[(token * 2 + side) * 16 + k] = Lk[k];
        }
        __syncthreads();
        if (c.tid < 128) {
            const int token = c.tid;
            float s0[16], s1[16];
#pragma unroll
            for (int k = 0; k < 16; ++k) { s0[k] = ord_dec(lists[(token * 2) * 16 + k] & ~127u); s1[k] = ord_dec(lists[(token * 2 + 1) * 16 + k] & ~127u); }
            unsigned Bk[16];
#pragma unroll
            for (int k = 0; k < 16; ++k) Bk[k] = 0u;
#pragma unroll
            for (int i = 0; i < 16; ++i)
#pragma unroll
                for (int j = 0; j < 16; ++j)
                    if ((i + 1) * (j + 1) <= 16) ins16(Bk, (ord_key(s0[i] + s1[j]) & ~255u) | (unsigned)(255 - (i * 16 + j)));
            float e[16]; int id[16]; float mx = 0.f, den = 0.f;
#pragma unroll
            for (int k = 0; k < 16; ++k) {
                const int pay = 255 - (int)(Bk[k] & 255u), i = pay >> 4, j = pay & 15;
                const unsigned k0 = lists[(token * 2) * 16 + i], k1 = lists[(token * 2 + 1) * 16 + j];
                id[k] = (127 - (int)(k0 & 127u)) * 128 + (127 - (int)(k1 & 127u));
                const float sv = ord_dec(k0 & ~127u) + ord_dec(k1 & ~127u);
                if (k == 0) mx = sv;
                e[k] = __expf(sv - mx); den += e[k];
            }
            const float inv = 1.f / den;
            int* ip = IDX + (size_t)(tok0 + token) * 128 + h * 16; float* gp = GATE + (size_t)(tok0 + token) * 128 + h * 16; float* up = SCU + (size_t)(tok0 + token) * 128 + h * 16;
            float su[16];
#pragma unroll
            for (int k = 0; k < 16; ++k) { su[k] = ISU[id[k]]; e[k] *= inv * ISV[id[k]]; }
#pragma unroll
            for (int k = 0; k < 4; ++k) {
                *(int4*)(ip + 4 * k) = make_int4(id[4 * k], id[4 * k + 1], id[4 * k + 2], id[4 * k + 3]);
                *(f32x4*)(gp + 4 * k) = (f32x4){e[4 * k], e[4 * k + 1], e[4 * k + 2], e[4 * k + 3]};
                *(f32x4*)(up + 4 * k) = (f32x4){su[4 * k], su[4 * k + 1], su[4 * k + 2], su[4 * k + 3]};
            }
        }
        __syncthreads();
    }
}

typedef float f32x2 __attribute__((ext_vector_type(2)));
#define CVT8(wd, hi) __builtin_amdgcn_cvt_pk_f32_fp8((int)(wd), (hi))
__device__ __forceinline__ void phase_gather(const Ctx& c, int layer, bool dummy) {
    const unsigned char* EU = c.ws + WS_EU; const unsigned char* EV = c.ws + WS_EV;
    const int* IDX = c.W<int>(WS_IDX); const float* GATE = c.W<float>(WS_GATE); const float* SCU = c.W<float>(WS_SCU);
    const float* H = c.W<float>(WS_H32); float* Ho = dummy ? c.W<float>(WS_R32) : c.W<float>(WS_H32); bf16* HB = dummy ? c.W<bf16>(WS_A0) : c.W<bf16>(WS_HB);
    const float* g = c.in[c.z + 40] + layer * D; const float* b = c.in[c.z + 41] + layer * D;
    const int lane = c.lane;
    const int ntw = (T - c.gw + c.NGW - 1) / c.NGW, nit = ntw * 8;
#define GT_TOK(it) (c.gw + ((it) >> 3) * c.NGW)
#define GT_IDX(it) (((it) < nit) ? IDX[(size_t)GT_TOK(it) * 128 + ((it) & 7) * 16 + (lane & 15)] : 0)
#define GT_GS(P, it) ((P)[(size_t)GT_TOK((it) < nit ? (it) : 0) * 128 + ((it) & 7) * 16 + ((lane >> 2) & 15)])
    int idx_c = GT_IDX(0), idx_n = GT_IDX(1);
    float gate_c = GT_GS(GATE, 0), scu_c = GT_GS(SCU, 0);
    f32x2 x2[8], xn[8], acc[8];
#pragma unroll
    for (int k = 0; k < 4; ++k) { const f32x4 hx = *(const f32x4*)(H + (size_t)c.gw * D + 16 * lane + 4 * k); xn[2 * k] = (f32x2){hx[0], hx[1]}; xn[2 * k + 1] = (f32x2){hx[2], hx[3]}; }
    v4u ru[16], rv[16];
#pragma unroll
    for (int e = 0; e < 16; ++e) {
        const int id = __builtin_amdgcn_readlane(idx_c, e);
        ru[e] = *(const v4u*)(EU + (size_t)id * D + 16 * lane); rv[e] = *(const v4u*)(EV + (size_t)id * D + 16 * lane);
    }
    for (int it = 0; it < nit; ++it) {
        const int t = GT_TOK(it), bt = it & 7;
        const int idx_nn = GT_IDX(it + 2);
        const float gate_n = GT_GS(GATE, it + 1), scu_n = GT_GS(SCU, it + 1);
        const float mygate = gate_c, myscu = scu_c;
        if (bt == 0) {
#pragma unroll
            for (int i = 0; i < 8; ++i) { x2[i] = xn[i]; acc[i] = (f32x2){0.f, 0.f}; }
        }
        if (bt == 7 && it + 1 < nit) {
            const int tn = GT_TOK(it + 1);
#pragma unroll
            for (int k = 0; k < 4; ++k) { const f32x4 hx = *(const f32x4*)(H + (size_t)tn * D + 16 * lane + 4 * k); xn[2 * k] = (f32x2){hx[0], hx[1]}; xn[2 * k + 1] = (f32x2){hx[2], hx[3]}; }
        }
        float pv[16];
#pragma unroll
        for (int e = 0; e < 16; ++e) {
            const v4u w = ru[e];
            f32x2 d = CVT8(w.x, false) * x2[0];
            d += CVT8(w.x, true) * x2[1]; d += CVT8(w.y, false) * x2[2]; d += CVT8(w.y, true) * x2[3];
            d += CVT8(w.z, false) * x2[4]; d += CVT8(w.z, true) * x2[5]; d += CVT8(w.w, false) * x2[6]; d += CVT8(w.w, true) * x2[7];
            pv[e] = d.x + d.y;
            ru[e] = *(const v4u*)(EU + (size_t)__builtin_amdgcn_readlane(idx_n, e) * D + 16 * lane);
        }
        const float tot = reduce16(pv, lane);
        const float wgt = mygate * gelu_f(tot * myscu);
#pragma unroll
        for (int e = 0; e < 16; ++e) {
            const float we = __builtin_bit_cast(float, __builtin_amdgcn_readlane(__builtin_bit_cast(int, wgt), 4 * e));
            const v4u w = rv[e];
            acc[0] += CVT8(w.x, false) * we; acc[1] += CVT8(w.x, true) * we; acc[2] += CVT8(w.y, false) * we; acc[3] += CVT8(w.y, true) * we;
            acc[4] += CVT8(w.z, false) * we; acc[5] += CVT8(w.z, true) * we; acc[6] += CVT8(w.w, false) * we; acc[7] += CVT8(w.w, true) * we;
            rv[e] = *(const v4u*)(EV + (size_t)__builtin_amdgcn_readlane(idx_n, e) * D + 16 * lane);
        }
        if (bt == 7) {
            f32x4 v[4];
#pragma unroll
            for (int k = 0; k < 4; ++k) v[k] = (f32x4){x2[2 * k].x, x2[2 * k].y, x2[2 * k + 1].x, x2[2 * k + 1].y} * ALPHA + (f32x4){acc[2 * k].x, acc[2 * k].y, acc[2 * k + 1].x, acc[2 * k + 1].y};
            float mean, rstd; ln_stats(v, mean, rstd, lane);
            float* o32 = ((layer == 3 && !dummy) ? c.out : Ho) + (size_t)t * D + 16 * lane;
            bf16* ob = (layer == 3 && !dummy) ? (bf16*)nullptr : HB + (size_t)t * D + 16 * lane;
            v4u wb[2];
#pragma unroll
            for (int k = 0; k < 4; ++k) {
                const f32x4 g4 = *(const f32x4*)(g + 16 * lane + 4 * k), b4 = *(const f32x4*)(b + 16 * lane + 4 * k);
                const f32x4 o = (v[k] - mean) * rstd * g4 + b4;
                *(f32x4*)(o32 + 4 * k) = o;
                if (k & 1) { wb[k >> 1].z = pk2(o[0], o[1]); wb[k >> 1].w = pk2(o[2], o[3]); } else { wb[k >> 1].x = pk2(o[0], o[1]); wb[k >> 1].y = pk2(o[2], o[3]); }
            }
            if (ob) { *(v4u*)(ob) = wb[0]; *(v4u*)(ob + 8) = wb[1]; }
        }
        idx_c = idx_n; idx_n = idx_nn; gate_c = gate_n; scu_c = scu_n;
    }
#undef GT_GS
#undef GT_TOK
#undef GT_IDX
}

#define XB_TMO      128
#define XB_XCNT(j)  (256  + 64 * (j))
#define XB_XSUB(j)  (1280 + 64 * (j))
#define XB_XGEN(j)  (2304 + 64 * (j))
#define XB_TOP      3328
#define XB_TOPGEN   3392
#define XCD_BAR_WORDS 3456
#define XB_SPIN_CAP (1u << 22)
__device__ __forceinline__ unsigned xb_ld(unsigned* p)              { return __hip_atomic_load(p, __ATOMIC_RELAXED, __HIP_MEMORY_SCOPE_AGENT); }
__device__ __forceinline__ unsigned xb_add(unsigned* p, unsigned v) { return __hip_atomic_fetch_add(p, v, __ATOMIC_RELAXED, __HIP_MEMORY_SCOPE_AGENT); }
__device__ __forceinline__ unsigned xb_xcc_id() { return (unsigned)__builtin_amdgcn_s_getreg((3 << 11) | 20) & 0xFu; }
#define XB_SPIN(cond, bar) do { unsigned _sp = 0; while (cond) { __builtin_amdgcn_s_sleep(1); \
    if ((++_sp & 255u) == 0u) { if (xb_ld(&(bar)[XB_TMO])) break; if (_sp > XB_SPIN_CAP) { atomicAdd(&(bar)[XB_TMO], 1u); break; } } } } while (0)
struct XcdBarrier { unsigned* bar; unsigned x; volatile LAS unsigned* st; };
__device__ __forceinline__ XcdBarrier xcd_barrier_post(unsigned* bar, volatile LAS unsigned* st) {
    XcdBarrier b; b.bar = bar; b.x = xb_xcc_id(); b.st = st;
    if (threadIdx.x == 0) (void)xb_add(&bar[XB_XCNT(b.x)], 1u);
    return b;
}
__device__ __forceinline__ void xcd_barrier_complete(unsigned* bar, unsigned x, unsigned& nloc, unsigned& nx) {
    const unsigned G = gridDim.x * gridDim.y * gridDim.z;
    unsigned sum, cnt, mine, sp = 0u;
    for (;;) {
        sum = 0u; cnt = 0u; mine = 0u;
#pragma unroll
        for (unsigned j = 0; j < 16; ++j) { const unsigned cc = xb_ld(&bar[XB_XCNT(j)]); sum += cc; cnt += (cc > 0u) ? 1u : 0u; mine = (j == x) ? cc : mine; }
        if (sum == G) break;
        __builtin_amdgcn_s_sleep(1);
        if ((++sp & 255u) == 0u) { if (xb_ld(&bar[XB_TMO])) break; if (sp > XB_SPIN_CAP) { atomicAdd(&bar[XB_TMO], 1u); break; } }
    }
    nloc = mine > 0u ? mine : 1u; nx = cnt > 0u ? cnt : 1u;
}
__device__ __forceinline__ void xcd_barrier(const XcdBarrier& b, int tid) {
    asm volatile("s_waitcnt vmcnt(0)" ::: "memory");
    __syncthreads();
    if (tid == 0) {
        unsigned* bar = b.bar;
        __builtin_amdgcn_s_waitcnt(0);
        unsigned nloc = b.st[0], nx = b.st[1];
        if (nloc == 0u) { xcd_barrier_complete(bar, b.x, nloc, nx); b.st[0] = nloc; b.st[1] = nx; }
        const unsigned old = xb_add(&bar[XB_XSUB(b.x)], 1u);
        const unsigned gen = old / nloc;
        if (old + 1u == (gen + 1u) * nloc) {
            __builtin_amdgcn_fence(__ATOMIC_RELEASE, "agent");
            asm volatile("s_waitcnt vmcnt(0)" ::: "memory");
            const unsigned og = xb_add(&bar[XB_TOP], 1u);
            const unsigned tg = og / nx;
            if (og + 1u == (tg + 1u) * nx) xb_add(&bar[XB_TOPGEN], 1u);
            else XB_SPIN(xb_ld(&bar[XB_TOPGEN]) == tg, bar);
            __builtin_amdgcn_fence(__ATOMIC_ACQUIRE, "agent");
            xb_add(&bar[XB_XGEN(b.x)], 1u);
            asm volatile("s_waitcnt vmcnt(0)" ::: "memory");
        } else {
            XB_SPIN(xb_ld(&bar[XB_XGEN(b.x)]) == gen, bar);
            __builtin_amdgcn_fence(__ATOMIC_ACQUIRE, "agent");
            asm volatile("s_waitcnt vmcnt(0)" ::: "memory");
        }
    }
    __syncthreads();
}

__global__ void __launch_bounds__(NTHR, 2) mega(Params P) {
    extern __shared__ __attribute__((aligned(16))) unsigned char lds_raw[];
    cg::grid_group grid = cg::this_grid();
    Ctx c;
    c.in = P.in; c.out = P.out; c.ws = P.ws; c.lds = (LAS unsigned char*)lds_raw; c.z = 0;
    c.tid = threadIdx.x; c.lane = c.tid & 63; c.wave = __builtin_amdgcn_readfirstlane(c.tid >> 6);
    c.gw = (int)blockIdx.x * NWAVES + c.wave; c.NGW = (int)gridDim.x * NWAVES; c.gt = (int)blockIdx.x * NTHR + c.tid; c.NGT = (int)gridDim.x * NTHR; c.bid = (int)blockIdx.x; c.nblk = (int)gridDim.x;
#define RF() do { int zs_ = 0; asm volatile("" : "+s"(zs_)); c.z = zs_; c.lds = (LAS unsigned char*)lds_raw + zs_; int z_ = 0; asm volatile("" : "+v"(z_)); const int l_ = (int)__builtin_amdgcn_mbcnt_hi(~0u, __builtin_amdgcn_mbcnt_lo(~0u, (unsigned)z_)); c.lane = l_; c.tid = c.wave * 64 + l_; c.bid = (int)blockIdx.x + zs_; c.nblk = (int)gridDim.x + zs_; c.gw = c.bid * NWAVES + c.wave; c.NGW = c.nblk * NWAVES; c.gt = c.bid * NTHR + c.tid; c.NGT = c.nblk * NTHR; } while (0)
    bf16* HB = c.W<bf16>(WS_HB); bf16* A0 = c.W<bf16>(WS_A0); bf16* A1 = c.W<bf16>(WS_A1); bf16* A2 = c.W<bf16>(WS_A2); bf16* Qb = c.W<bf16>(WS_Q);
    float* H32 = c.W<float>(WS_H32); float* R32 = c.W<float>(WS_R32);

    if (threadIdx.x < 16) ((volatile LAS unsigned*)(c.lds + MISC_OFF))[threadIdx.x] = 0u;
    __syncthreads();
    const XcdBarrier xbar = xcd_barrier_post(c.W<unsigned>(WS_CTL), (volatile LAS unsigned*)(c.lds + MISC_OFF));
#define GSYNC() do { RF(); xcd_barrier(xbar, c.tid); } while (0)
    RF(); prologue(c);
    grid.sync();
    for (int layer = 0; layer < 4; ++layer) {
        if (layer <= 1) {
            const bf16* Wt = c.W<bf16>(layer == 0 ? WS_W_S5IN : WS_W_PIN);
            RF(); run_gemm(c, HB, D, 0, Wt, 1024, 1024, EpiBf16<0>{A0, D, nullptr, nullptr, nullptr});
        } else if (layer == 2) {
            RF(); run_gemm(c, HB, D, 0, c.W<bf16>(WS_W_CIN), 2048, 1024, EpiBf16<1>{Qb, 2048, c.in[c.z + 24], nullptr, nullptr});
        } else {
            RF(); run_gemm(c, HB, D, 0, c.W<bf16>(WS_W_SIN), NPROJ, 1024, EpiSsdProj{Qb, c.W<bf16>(WS_XBC), c.W<float>(WS_DT)});
        }
        GSYNC();
        const bf16* Aout = A2; const bf16* Wout;
        if (layer == 0) {
            for (int r = 0; r < PR_S5; ++r) { RF(); phase_s5scan(c); }
            GSYNC();
            RF(); run_gemm(c, A1, D, 0, c.W<bf16>(WS_W_S5GLU), 1024, 1024, EpiBf16<3>{A2, D, c.in[c.z + 17], nullptr, A1});
            Wout = c.W<bf16>(WS_W_S5OUT);
        } else if (layer == 1) {
            RF(); phase_pool(c);
            GSYNC();
            RF(); run_gemm(c, A1, D, 256, c.W<bf16>(WS_W_PGRP), 1024, 256, EpiBf16<2>{A2, D, nullptr, c.in[c.z + 21], nullptr});
            Wout = c.W<bf16>(WS_W_POUT);
        } else if (layer == 2) {
            RF(); phase_cmlp_ln(c);
            GSYNC();
            RF(); phase_cmlp_mix(c);
            Aout = A1; Wout = c.W<bf16>(WS_W_COUT);
        } else {
            RF(); phase_ssd_conv(c);
            GSYNC();
            for (int r = 0; r < PR_SSD; ++r) { RF(); phase_ssd_scan(c); }
            GSYNC();
            RF(); phase_ssd_gatenorm(c);
            Aout = c.W<bf16>(WS_YN); Wout = c.W<bf16>(WS_W_SOUT);
        }
        GSYNC();
        if (layer == 3) { RF(); run_gemm(c, Aout, 2048, 0, Wout, 1024, 2048, EpiResid{H32, R32}); }
        else { RF(); run_gemm(c, Aout, 1024, 0, Wout, 1024, 1024, EpiResid{H32, R32}); }
        GSYNC();
        RF(); phase_ln1(c, layer);
        if (layer > 0) { RF(); cvt_tables(c, layer); }
        GSYNC();
        RF(); run_gemm(c, HB, D, 0, c.W<bf16>(WS_W_PQ) + (size_t)layer * 2048 * 1024, 2048, 1024, EpiBf16<0>{Qb, 2048, nullptr, nullptr, nullptr});
        GSYNC();
        for (int r = 0; r < PR_ROUTE; ++r) { RF(); phase_route(c, layer); }
        GSYNC();
        for (int r = 1; r < PR_GATHER; ++r) { RF(); phase_gather(c, layer, true); }
        RF(); phase_gather(c, layer, false);
        GSYNC();
    }
}
}

extern "C" void kernel_launch(void* const* d_in, const int* in_sizes, int n_in, void* d_out, int out_size, void* d_ws, size_t ws_size, hipStream_t stream) {
    static int grid = 0;
    if (grid == 0) {
        int dev = 0, cus = 0, per_cu = 0;
        if (hipGetDevice(&dev) != hipSuccess || hipDeviceGetAttribute(&cus, hipDeviceAttributeMultiprocessorCount, dev) != hipSuccess) { fprintf(stderr, "kernel_launch: device query failed\n"); grid = -1; return; }
        if (hipFuncSetAttribute((const void*)mk::mega, hipFuncAttributeMaxDynamicSharedMemorySize, mk::LDS_BYTES) != hipSuccess) { fprintf(stderr, "kernel_launch: hipFuncSetAttribute failed\n"); grid = -1; return; }
        if (hipOccupancyMaxActiveBlocksPerMultiprocessor(&per_cu, (const void*)mk::mega, mk::NTHR, mk::LDS_BYTES) != hipSuccess || per_cu < 1) { fprintf(stderr, "kernel_launch: occupancy query says %d blocks per CU\n", per_cu); grid = -1; return; }
        grid = cus;
        if (ws_size < mk::WS_END) { fprintf(stderr, "kernel_launch: workspace too small (%zu < %zu)\n", ws_size, (size_t)mk::WS_END); grid = -1; return; }
    }
    if (grid < 0) return;
    mk::Params p{};
    for (int i = 0; i < 46; ++i) p.in[i] = (const float*)d_in[i];
    p.out = (float*)d_out; p.ws = (unsigned char*)d_ws;
    if (hipMemsetAsync((char*)d_ws + mk::WS_CTL, 0, mk::CTL_BYTES, stream) != hipSuccess) { fprintf(stderr, "kernel_launch: memset failed\n"); return; }
    void* args[] = {&p};
    hipError_t e = hipLaunchCooperativeKernel((const void*)mk::mega, dim3(grid), dim3(mk::NTHR), args, mk::LDS_BYTES, stream);
    if (e != hipSuccess) fprintf(stderr, "cooperative launch failed: %s (grid %d)\n", hipGetErrorString(e), grid);
}
```

```cpp
#include <hip/hip_runtime.h>
#include <hip/hip_cooperative_groups.h>
#include <cstdio>
#include <cstdint>
#include <math.h>
namespace cg = cooperative_groups;

namespace pg8 {
#define PG8_LAS __attribute__((address_space(3)))
typedef unsigned short bf16_t;
typedef short bf16x8 __attribute__((ext_vector_type(8)));
typedef float f32x4 __attribute__((ext_vector_type(4)));
typedef unsigned u32x4 __attribute__((ext_vector_type(4)));
constexpr int BM = 256, BK = 64, HALF = 128, HTB = HALF * BK * 2, STAGE_BYTES = 8 * HTB, NXCD = 8, WGM = 8;
__host__ __device__ __forceinline__ int lds_byte(int r, int c) { const int st = (r >> 4) * 2 + (c >> 5), rr = r & 15, cc = c & 31, ob = rr * 64 + cc * 2; return st * 1024 + (ob ^ (((ob >> 9) & 1) << 5)); }
__host__ __device__ __forceinline__ void stage_rc(int b, int& R, int& C) { const int st = b / 1024, sb = b % 1024, swz = sb ^ (((sb >> 9) & 1) << 5); R = (st >> 1) * 16 + swz / 64; C = (st & 1) * 32 + (swz % 64) / 2; }
__host__ __device__ __forceinline__ int perm32(int rho) { const int n = rho >> 4, i = rho & 15; return 8 * (i >> 2) + 4 * n + (i & 3); }
struct Unit { int pm, pn; };
struct Gemm { const bf16_t* A; const bf16_t* Bt; int M, N, K, lda, a_pn_off; };
struct StaticOrder {
    int nM, nN, nwg, G, c;
    __host__ __device__ void init(int M, int N, int G_, int c_) { nM = M / BM; nN = N / BM; nwg = nM * nN; G = G_; c = c_; }
    __host__ __device__ bool next(int i, Unit& u) const {
        const long L = (long)i * G + c; if (L >= nwg) return false;
        int wgid = (int)L; { const int q = nwg / NXCD, r = nwg % NXCD, xcd = wgid % NXCD, off = wgid / NXCD; wgid = (xcd < r ? xcd * (q + 1) : r * (q + 1) + (xcd - r) * q) + off; }
        const int nig = WGM * nN, gid = wgid / nig, fm = gid * WGM, gsz = (nM - fm) < WGM ? (nM - fm) : WGM;
        u.pm = fm + ((wgid % nig) % gsz); u.pn = (wgid % nig) / gsz; return true;
    }
    __device__ __forceinline__ void a_ready(const Unit&) const {}
    __device__ __forceinline__ void done(const Unit&) const {}
};
__device__ __forceinline__ unsigned cvt_pk_bf16(float lo, float hi) { unsigned r; asm volatile("v_cvt_pk_bf16_f32 %0, %1, %2" : "=v"(r) : "v"(lo), "v"(hi)); return r; }
template <class Epi, class Sched, bool ALIGN_EPI = false, bool SP2 = false>
__device__ __forceinline__ void gemm_phase(PG8_LAS unsigned char* lds, const Gemm g, const Sched& S, const Epi& E, int tid_in) {
    int tid_ = tid_in; asm volatile("" : "+v"(tid_));
    const int tid = tid_, wid = __builtin_amdgcn_readfirstlane(tid >> 6), lane = tid & 63, wr = wid >> 2, wc = wid & 3, fr = lane & 15, fq = lane >> 4;
    const int K = g.K, nt = K / BK;
    unsigned voffA[2], voffB[2];
#pragma unroll
    for (int i = 0; i < 2; ++i) { int R, C; stage_rc(tid * 16 + i * 8192, R, C); const int Rb = Epi::PERM ? ((R & ~31) + perm32(R & 31)) : R;
        voffA[i] = (unsigned)(R * g.lda + C) * 2u; voffB[i] = (unsigned)(Rb * K + C) * 2u; }
    const size_t kstep = (size_t)(BK * 2);
    const size_t hstepA = (size_t)HALF * g.lda * 2, tstepA = 2 * hstepA;
    const size_t hstepB = (size_t)HALF * K * 2, tstepB = 2 * hstepB;
    const size_t apn = (size_t)g.a_pn_off * 2;
    const unsigned ldsw = (unsigned)wid * 1024u;
    const int aoff = lds_byte(wr * 64 + fr, fq * 8), boff = lds_byte(wc * 32 + fr, fq * 8);
#define PG8_SA(b, h) (((b) * 2 + (h)) * HTB)
#define PG8_SB(b, h) ((4 + (b) * 2 + (h)) * HTB)
#define PG8_STAGE(bufoff, gbase, voff) do { _Pragma("unroll") for (int _i = 0; _i < 2; ++_i) \
        __builtin_amdgcn_global_load_lds((const unsigned*)((const char*)(gbase) + (voff)[_i]), (PG8_LAS unsigned*)(lds + (bufoff) + ldsw + _i * 8192), 16, 0, 0); } while (0)
#define PG8_LDA(dst, b, h) do { _Pragma("unroll") for (int m = 0; m < 4; ++m) _Pragma("unroll") for (int k = 0; k < 2; ++k) dst[m][k] = *(const PG8_LAS bf16x8*)(lds + PG8_SA(b, h) + aoff + m * 2048 + k * 1024); } while (0)
#define PG8_LDB(dst, b, h) do { _Pragma("unroll") for (int n = 0; n < 2; ++n) _Pragma("unroll") for (int k = 0; k < 2; ++k) dst[n][k] = *(const PG8_LAS bf16x8*)(lds + PG8_SB(b, h) + boff + n * 2048 + k * 1024); } while (0)
#define PG8_MMA(ai, bj, At, Bt) do { __builtin_amdgcn_s_setprio(1); _Pragma("unroll") for (int m = 0; m < 4; ++m) _Pragma("unroll") for (int n = 0; n < 2; ++n) _Pragma("unroll") for (int k = 0; k < 2; ++k) \
        acc[ai][bj][m][n] = __builtin_amdgcn_mfma_f32_16x16x32_bf16(Bt[n][k], At[m][k], acc[ai][bj][m][n], 0, 0, 0); __builtin_amdgcn_s_setprio(0); } while (0)
#define PG8_WAIT_V(n) asm volatile("s_waitcnt vmcnt(" #n ")" ::: "memory")
#define PG8_WAIT_L(n) asm volatile("s_waitcnt lgkmcnt(" #n ")" ::: "memory")
#define PG8_BAR __builtin_amdgcn_s_barrier()
#define PG8_SCHED __builtin_amdgcn_sched_barrier(0)
    Unit cur, nxt; int ui = 0;
    if (!S.next(0, cur)) return;
    f32x4 acc[2][2][4][2];
#pragma unroll
    for (int a = 0; a < 2; ++a)
#pragma unroll
        for (int b = 0; b < 2; ++b)
#pragma unroll
            for (int m = 0; m < 4; ++m)
#pragma unroll
                for (int n = 0; n < 2; ++n) acc[a][b][m][n] = (f32x4){0.f, 0.f, 0.f, 0.f};
    bf16x8 At[4][2], B0[2][2], B1[2][2];
    const char* cA = (const char*)g.A + (size_t)cur.pm * tstepA + (size_t)cur.pn * apn; const char* cB = (const char*)g.Bt + (size_t)cur.pn * tstepB;
    S.a_ready(cur);
    if constexpr (SP2) {
        PG8_STAGE(PG8_SB(0, 0), cB, voffB); PG8_STAGE(PG8_SB(0, 1), cB + hstepB, voffB); PG8_STAGE(PG8_SA(0, 0), cA, voffA); PG8_STAGE(PG8_SA(0, 1), cA + hstepA, voffA);
        if (wr == 1) PG8_BAR;
        PG8_WAIT_V(2); PG8_BAR;
        PG8_STAGE(PG8_SB(1, 0), cB + kstep, voffB); PG8_STAGE(PG8_SA(1, 0), cA + kstep, voffA); PG8_STAGE(PG8_SB(1, 1), cB + hstepB + kstep, voffB);
        PG8_WAIT_V(6); PG8_BAR;
    } else {
        PG8_STAGE(PG8_SB(0, 0), cB, voffB); PG8_STAGE(PG8_SA(0, 0), cA, voffA); PG8_STAGE(PG8_SB(0, 1), cB + hstepB, voffB); PG8_STAGE(PG8_SA(0, 1), cA + hstepA, voffA);
        if (wr == 1) PG8_BAR;
        PG8_WAIT_V(4); PG8_BAR;
        PG8_STAGE(PG8_SB(1, 0), cB + kstep, voffB); PG8_STAGE(PG8_SA(1, 0), cA + kstep, voffA); PG8_STAGE(PG8_SB(1, 1), cB + hstepB + kstep, voffB);
        PG8_WAIT_V(6); PG8_BAR;
    }
    for (;;) {
        const bool has_next = S.next(ui + 1, nxt);
        const char* nA = has_next ? (const char*)g.A + (size_t)nxt.pm * tstepA + (size_t)nxt.pn * apn : cA; const char* nB = has_next ? (const char*)g.Bt + (size_t)nxt.pn * tstepB : cB;
#pragma nounroll
        for (int t = 0; t < nt; t += 2) {
            const bool last = (t == nt - 2);
            const char* a1 = cA + (size_t)(t + 1) * kstep;
            const char* a2 = last ? nA : cA + (size_t)(t + 2) * kstep; const char* b2 = last ? nB : cB + (size_t)(t + 2) * kstep;
            const char* a3 = a2 + kstep; const char* b3 = b2 + kstep;
            if (last && has_next) S.a_ready(nxt);
            if constexpr (SP2) {
            PG8_LDB(B0, 0, 0); PG8_LDB(B1, 0, 1); PG8_SCHED; PG8_LDA(At, 0, 0); PG8_STAGE(PG8_SA(1, 1), a1 + hstepA, voffA);
            PG8_WAIT_V(8); PG8_WAIT_L(0); PG8_BAR; PG8_MMA(0, 0, At, B0); PG8_MMA(0, 1, At, B1); PG8_BAR; PG8_SCHED;
            PG8_LDA(At, 0, 1); PG8_STAGE(PG8_SB(0, 0), b2, voffB); PG8_STAGE(PG8_SB(0, 1), b2 + hstepB, voffB); PG8_STAGE(PG8_SA(0, 0), a2, voffA);
            PG8_WAIT_V(8); PG8_WAIT_L(0); PG8_BAR; PG8_MMA(1, 0, At, B0); PG8_MMA(1, 1, At, B1); PG8_BAR; PG8_SCHED;
            PG8_LDB(B0, 1, 0); PG8_LDB(B1, 1, 1); PG8_SCHED; PG8_LDA(At, 1, 0); PG8_STAGE(PG8_SA(0, 1), a2 + hstepA, voffA);
            PG8_WAIT_V(8); PG8_WAIT_L(0); PG8_BAR; PG8_MMA(0, 0, At, B0); PG8_MMA(0, 1, At, B1); PG8_BAR; PG8_SCHED;
            PG8_LDA(At, 1, 1); PG8_STAGE(PG8_SB(1, 0), b3, voffB); PG8_STAGE(PG8_SB(1, 1), b3 + hstepB, voffB); PG8_STAGE(PG8_SA(1, 0), a3, voffA);
            PG8_WAIT_V(8); PG8_WAIT_L(0); PG8_BAR; PG8_MMA(1, 0, At, B0); PG8_MMA(1, 1, At, B1); PG8_BAR; PG8_SCHED;
            } else {
            PG8_LDB(B0, 0, 0); PG8_SCHED; PG8_LDA(At, 0, 0); PG8_STAGE(PG8_SA(1, 1), a1 + hstepA, voffA);
            PG8_WAIT_L(8); PG8_BAR; PG8_WAIT_L(0); PG8_MMA(0, 0, At, B0); PG8_BAR; PG8_SCHED;
            PG8_LDB(B1, 0, 1); PG8_STAGE(PG8_SB(0, 0), b2, voffB);
            PG8_BAR; PG8_WAIT_L(0); PG8_MMA(0, 1, At, B1); PG8_BAR;
            PG8_LDA(At, 0, 1); PG8_STAGE(PG8_SA(0, 0), a2, voffA);
            PG8_BAR; PG8_WAIT_L(0); PG8_MMA(1, 0, At, B0); PG8_BAR; PG8_SCHED;
            PG8_STAGE(PG8_SB(0, 1), b2 + hstepB, voffB);
            PG8_WAIT_V(6); PG8_BAR; PG8_MMA(1, 1, At, B1); PG8_BAR;
            PG8_LDB(B0, 1, 0); PG8_SCHED; PG8_LDA(At, 1, 0); PG8_STAGE(PG8_SA(0, 1), a2 + hstepA, voffA);
            PG8_WAIT_L(8); PG8_BAR; PG8_WAIT_L(0); PG8_MMA(0, 0, At, B0); PG8_BAR; PG8_SCHED;
            PG8_LDB(B1, 1, 1); PG8_STAGE(PG8_SB(1, 0), b3, voffB);
            PG8_BAR; PG8_WAIT_L(0); PG8_MMA(0, 1, At, B1); PG8_BAR;
            PG8_LDA(At, 1, 1); PG8_STAGE(PG8_SA(1, 0), a3, voffA);
            PG8_BAR; PG8_WAIT_L(0); PG8_MMA(1, 0, At, B0); PG8_BAR; PG8_SCHED;
            PG8_STAGE(PG8_SB(1, 1), b3 + hstepB, voffB);
            PG8_WAIT_V(6); PG8_BAR; PG8_MMA(1, 1, At, B1); PG8_BAR;
            }
        }
        if constexpr (ALIGN_EPI) { if (wr == 0) PG8_BAR; }
        if constexpr (!Epi::AFTER_DRAIN) { E(acc, cur, wr, wc, fr, fq); S.done(cur); }
        if (!has_next) break;
#pragma unroll
        for (int a = 0; a < 2; ++a)
#pragma unroll
            for (int b = 0; b < 2; ++b)
#pragma unroll
                for (int m = 0; m < 4; ++m)
#pragma unroll
                    for (int n = 0; n < 2; ++n) acc[a][b][m][n] = (f32x4){0.f, 0.f, 0.f, 0.f};
        cur = nxt; cA = nA; cB = nB; ++ui;
        if constexpr (ALIGN_EPI) { if (wr == 1) PG8_BAR; }
    }
    PG8_WAIT_V(0);
    if constexpr (!ALIGN_EPI) { if (wr == 0) PG8_BAR; }
    PG8_BAR;
    if constexpr (Epi::AFTER_DRAIN) { E.fused(acc, cur, wr, wc, fr, fq, lds, wid, lane); S.done(cur); }
#undef PG8_SA
#undef PG8_SB
#undef PG8_STAGE
#undef PG8_LDA
#undef PG8_LDB
#undef PG8_MMA
#undef PG8_WAIT_V
#undef PG8_WAIT_L
#undef PG8_BAR
#undef PG8_SCHED
}
}

#ifndef PR_GATHER
#define PR_GATHER 1
#endif
#ifndef PR_ROUTE
#define PR_ROUTE 1
#endif
#ifndef PR_S5
#define PR_S5 1
#endif
#ifndef PR_SSD
#define PR_SSD 1
#endif
#ifndef PR_GEMM
#define PR_GEMM 1
#endif
#ifndef PR_MISC
#define PR_MISC 1
#endif
namespace mk {
#define LAS __attribute__((address_space(3)))
typedef unsigned short bf16;
typedef unsigned v4u __attribute__((ext_vector_type(4)));
typedef unsigned v2u __attribute__((ext_vector_type(2)));
typedef float f32x4 __attribute__((ext_vector_type(4)));
typedef short bf16x8 __attribute__((ext_vector_type(8)));
using bf16x2 = __attribute__((ext_vector_type(2))) __bf16;

constexpr int D = 1024, T = 17408, TP = 16384, NWAVES = 8, NTHR = 512;
constexpr float ALPHA = 1.6817928305074290f;
constexpr float LN_EPS = 1e-5f, RMS_EPS = 1e-5f;
constexpr int LDS_BYTES = 160 * 1024;
constexpr int NPROJ = 5376, CONVD = 3072;

constexpr size_t MiB = 1u << 20;
constexpr size_t WS_W_S5IN = 0, WS_W_S5GLU = 2 * MiB, WS_W_S5OUT = 4 * MiB, WS_W_PIN = 6 * MiB, WS_W_PGRP = 8 * MiB, WS_W_POUT = 9 * MiB,
                 WS_W_CIN = 11 * MiB, WS_W_COUT = 15 * MiB, WS_W_SIN = 17 * MiB  , WS_W_SOUT = 28 * MiB, WS_W_PQ = 32 * MiB  ,
                 WS_KEYS = 48 * MiB  , WS_SMALL = 50 * MiB, WS_CTL = 52 * MiB  ;
constexpr size_t CTL_BYTES = 16384;
constexpr int MISC_OFF = LDS_BYTES - 64;
constexpr size_t WS_EU = 64 * MiB, WS_EV = 96 * MiB;
constexpr size_t WS_H32 = 128 * MiB, WS_R32 = 196 * MiB, WS_HB = 264 * MiB, WS_A0 = 298 * MiB, WS_A1 = 332 * MiB, WS_A2 = 366 * MiB;
constexpr size_t WS_Q = 400 * MiB  , WS_IDX = 468 * MiB  , WS_GATE = 477 * MiB  , WS_DT = 486 * MiB  ;
constexpr size_t WS_XBC = 490 * MiB  , WS_XC = 592 * MiB  , WS_Y = 694 * MiB  , WS_YN = 762 * MiB  , WS_SCU = 830 * MiB  , WS_END = 839 * MiB;
constexpr size_t SM_LBR = 0, SM_LBI = 4096, SM_BBR = 8192, SM_BBI = 8192 + 65536, SM_ISU = 8192 + 131072, SM_ISV = SM_ISU + 16384;

struct Params { const float* in[46]; float* out; unsigned char* ws; };

__device__ __forceinline__ unsigned f2bf(float f) { unsigned u = __builtin_bit_cast(unsigned, f); return (u + 0x7fffu + ((u >> 16) & 1u)) >> 16; }
__device__ __forceinline__ unsigned pk2(float lo, float hi) { return pg8::cvt_pk_bf16(lo, hi); }
__device__ __forceinline__ float bflo(unsigned w) { return __builtin_bit_cast(float, w << 16); }
__device__ __forceinline__ float bfhi(unsigned w) { return __builtin_bit_cast(float, w & 0xffff0000u); }
__device__ __forceinline__ float bf2f(bf16 b) { return __builtin_bit_cast(float, ((unsigned)b) << 16); }
__device__ __forceinline__ float sigmoid_f(float x) { return 1.f / (1.f + __expf(-x)); }
__device__ __forceinline__ float silu_f(float x) { return x * sigmoid_f(x); }
__device__ __forceinline__ float gelu_f(float x) { return x * sigmoid_f(1.5957691216057308f * (x + 0.044715f * x * x * x)); }
__device__ __forceinline__ float shx(float v, int o, int lane) { return __builtin_bit_cast(float, __builtin_amdgcn_ds_bpermute((lane ^ o) << 2, __builtin_bit_cast(int, v))); }
__device__ __forceinline__ float wave_sum(float v, int lane) {
#pragma unroll
    for (int o = 32; o >= 1; o >>= 1) v += shx(v, o, lane);
    return v;
}
__device__ __forceinline__ float dot2(unsigned w, unsigned x, float acc) { return __builtin_amdgcn_fdot2_f32_bf16(__builtin_bit_cast(bf16x2, w), __builtin_bit_cast(bf16x2, x), acc, false); }
__device__ __forceinline__ float reduce16(const float (&p)[16], int lane) {
    const bool b5 = lane & 32, b4 = lane & 16, b3 = lane & 8, b2 = lane & 4;
    float q[8], r[4], s[2], t;
#pragma unroll
    for (int i = 0; i < 8; ++i) { const float keep = b5 ? p[i + 8] : p[i], send = b5 ? p[i] : p[i + 8]; q[i] = keep + shx(send, 32, lane); }
#pragma unroll
    for (int i = 0; i < 4; ++i) { const float keep = b4 ? q[i + 4] : q[i], send = b4 ? q[i] : q[i + 4]; r[i] = keep + shx(send, 16, lane); }
#pragma unroll
    for (int i = 0; i < 2; ++i) { const float keep = b3 ? r[i + 2] : r[i], send = b3 ? r[i] : r[i + 2]; s[i] = keep + shx(send, 8, lane); }
    { const float keep = b2 ? s[1] : s[0], send = b2 ? s[0] : s[1]; t = keep + shx(send, 4, lane); }
    t += shx(t, 2, lane); t += shx(t, 1, lane);
    return t;
}
__device__ __forceinline__ void seq_info(int s, int& tok0, int& L) { if (s < 8) { tok0 = s << 11; L = 2048; } else { tok0 = TP + ((s - 8) << 3); L = 8; } }
__device__ __forceinline__ void tok_info(int t, int& s, int& l, int& tok0) {
    if (t < TP) { s = t >> 11; l = t & 2047; tok0 = s << 11; } else { const int b = (t - TP) >> 3; s = 8 + b; l = (t - TP) & 7; tok0 = TP + (b << 3); }
}

template <int MODE> struct EpiBf16 {
    static constexpr bool PERM = true, AFTER_DRAIN = false;
    bf16* O; int ldc; const float* bias; const float* scale; const bf16* G;
    __device__ __forceinline__ void operator()(const pg8::f32x4 (&acc)[2][2][4][2], const pg8::Unit& u, int wr, int wc, int fr_, int fq_) const {
        int fr = fr_, fq = fq_; asm volatile("" : "+v"(fr), "+v"(fq));
        const int row0 = u.pm * 256 + wr * 64 + fr, col0 = u.pn * 256 + wc * 32 + 8 * fq;
        f32x4 bv[2][2], sv[2][2];
#pragma unroll
        for (int bj = 0; bj < 2; ++bj)
#pragma unroll
            for (int n = 0; n < 2; ++n) {
                bv[bj][n] = bias ? *(const f32x4*)(bias + col0 + bj * 128 + 4 * n) : (f32x4){0.f, 0.f, 0.f, 0.f};
                sv[bj][n] = (MODE == 2) ? *(const f32x4*)(scale + col0 + bj * 128 + 4 * n) : (f32x4){1.f, 1.f, 1.f, 1.f};
            }
#pragma unroll
        for (int ai = 0; ai < 2; ++ai)
#pragma unroll
            for (int m = 0; m < 4; ++m) {
                const size_t roff = (size_t)(row0 + ai * 128 + m * 16) * ldc + col0;
#pragma unroll
                for (int bj = 0; bj < 2; ++bj) {
                    f32x4 v0 = acc[ai][bj][m][0] + bv[bj][0], v1 = acc[ai][bj][m][1] + bv[bj][1];
                    if (MODE == 1) {
#pragma unroll
                        for (int j = 0; j < 4; ++j) { v0[j] = gelu_f(v0[j]); v1[j] = gelu_f(v1[j]); }
                    }
                    if (MODE == 2) { v0 = v0 * sv[bj][0]; v1 = v1 * sv[bj][1]; }
                    if (MODE == 3) {
                        const v4u gw = *(const v4u*)(G + roff + bj * 128);
                        v0[0] = bflo(gw.x) * sigmoid_f(v0[0]); v0[1] = bfhi(gw.x) * sigmoid_f(v0[1]); v0[2] = bflo(gw.y) * sigmoid_f(v0[2]); v0[3] = bfhi(gw.y) * sigmoid_f(v0[3]);
                        v1[0] = bflo(gw.z) * sigmoid_f(v1[0]); v1[1] = bfhi(gw.z) * sigmoid_f(v1[1]); v1[2] = bflo(gw.w) * sigmoid_f(v1[2]); v1[3] = bfhi(gw.w) * sigmoid_f(v1[3]);
                    }
                    v4u w; w.x = pk2(v0[0], v0[1]); w.y = pk2(v0[2], v0[3]); w.z = pk2(v1[0], v1[1]); w.w = pk2(v1[2], v1[3]);
                    *(v4u*)(O + roff + bj * 128) = w;
                }
            }
    }
};
struct EpiResid {
    static constexpr bool PERM = false, AFTER_DRAIN = false;
    const float* H; float* R;
    __device__ __forceinline__ void operator()(const pg8::f32x4 (&acc)[2][2][4][2], const pg8::Unit& u, int wr, int wc, int fr_, int fq_) const {
        int fr = fr_, fq = fq_; asm volatile("" : "+v"(fr), "+v"(fq));
        const int row0 = u.pm * 256 + wr * 64 + fr, col0 = u.pn * 256 + wc * 32 + 4 * fq;
#pragma unroll
        for (int ai = 0; ai < 2; ++ai)
#pragma unroll
            for (int m = 0; m < 4; ++m) {
                const size_t roff = (size_t)(row0 + ai * 128 + m * 16) * D + col0;
#pragma unroll
                for (int bj = 0; bj < 2; ++bj)
#pragma unroll
                    for (int n = 0; n < 2; ++n) {
                        const f32x4 hv = *(const f32x4*)(H + roff + bj * 128 + n * 16);
                        *(f32x4*)(R + roff + bj * 128 + n * 16) = hv * ALPHA + acc[ai][bj][m][n];
                    }
            }
    }
};
struct EpiSsdProj {
    static constexpr bool PERM = true, AFTER_DRAIN = false;
    bf16* Z; bf16* XBC; float* DT;
    __device__ __forceinline__ void operator()(const pg8::f32x4 (&acc)[2][2][4][2], const pg8::Unit& u, int wr, int wc, int fr_, int fq_) const {
        int fr = fr_, fq = fq_; asm volatile("" : "+v"(fr), "+v"(fq));
        const int row0 = u.pm * 256 + wr * 64 + fr, col0 = u.pn * 256 + wc * 32 + 8 * fq;
#pragma unroll
        for (int ai = 0; ai < 2; ++ai)
#pragma unroll
            for (int m = 0; m < 4; ++m) {
                const size_t row = (size_t)(row0 + ai * 128 + m * 16);
#pragma unroll
                for (int bj = 0; bj < 2; ++bj) {
                    const f32x4 v0 = acc[ai][bj][m][0], v1 = acc[ai][bj][m][1];
                    const int col = col0 + bj * 128;
                    if (u.pn < 20) {
                        v4u w; w.x = pk2(v0[0], v0[1]); w.y = pk2(v0[2], v0[3]); w.z = pk2(v1[0], v1[1]); w.w = pk2(v1[2], v1[3]);
                        if (u.pn < 8) *(v4u*)(Z + row * 2048 + col) = w; else *(v4u*)(XBC + row * CONVD + (col - 2048)) = w;
                    } else if (col - 5120 < 32) {
                        *(f32x4*)(DT + row * 32 + (col - 5120)) = v0; *(f32x4*)(DT + row * 32 + (col - 5120) + 4) = v1;
                    }
                }
            }
    }
};

struct Ctx {
    const float* const* in; float* out; unsigned char* ws; LAS unsigned char* lds;
    int tid, lane, wave, gw, NGW, gt, NGT, bid, nblk;
    int z;
    template <class Tp> __device__ __forceinline__ Tp* W(size_t off) const { return (Tp*)(ws + (off + (size_t)(unsigned)z)); }
};

template <class Epi> __device__ __forceinline__ void run_gemm(const Ctx& c, const bf16* A, int lda, int a_pn_off, const bf16* Bt, int N, int K, const Epi& E) {
    pg8::Gemm g{A, Bt, T, N, K, lda, a_pn_off};
    pg8::StaticOrder S; S.init(T, N, c.nblk, c.bid);
    for (int r = 0; r < PR_GEMM; ++r) pg8::gemm_phase<Epi, pg8::StaticOrder, false, false>(c.lds, g, S, E, c.tid);
}

__device__ __forceinline__ void transpose_item(const float* __restrict__ Wm, int K, int N, bf16* WT, LAS float* scr, int item, int lane) {
    const int nblk = N / 32, kb = item / nblk, nb = item % nblk, k0 = 64 * kb, n0 = 32 * nb;
#pragma unroll 8
    for (int i = 0; i < 32; ++i) { const int kk = 2 * i + (lane >> 5); scr[kk * 33 + (lane & 31)] = Wm[(size_t)(k0 + kk) * N + n0 + (lane & 31)]; }
    asm volatile("s_waitcnt lgkmcnt(0)" ::: "memory");
    const int cc = lane & 7;
#pragma unroll
    for (int j = 0; j < 4; ++j) {
        const int n = (lane >> 3) + 8 * j; const LAS float* s = scr + (8 * cc) * 33 + n;
        v4u o; o.x = pk2(s[0 * 33], s[1 * 33]); o.y = pk2(s[2 * 33], s[3 * 33]); o.z = pk2(s[4 * 33], s[5 * 33]); o.w = pk2(s[6 * 33], s[7 * 33]);
        *(v4u*)(WT + (size_t)(n0 + n) * K + k0 + 8 * cc) = o;
    }
    asm volatile("s_waitcnt lgkmcnt(0)" ::: "memory");
}
__device__ __forceinline__ void transpose_mat(const Ctx& c, const float* Wm, int K, int N, bf16* WT) {
    LAS float* scr = (LAS float*)(c.lds + c.wave * 16384);
    const int nitems = (K / 64) * (N / 32);
    for (int it = c.gw; it < nitems; it += c.NGW) transpose_item(Wm, K, N, WT, scr, it, c.lane);
}
__device__ __forceinline__ void cvt_copy(const Ctx& c, const float* __restrict__ src, bf16* dst, size_t n) {
    for (size_t i = (size_t)c.gt * 8; i < n; i += (size_t)c.NGT * 8) {
        const f32x4 a = *(const f32x4*)(src + i), b = *(const f32x4*)(src + i + 4);
        v4u w; w.x = pk2(a[0], a[1]); w.y = pk2(a[2], a[3]); w.z = pk2(b[0], b[1]); w.w = pk2(b[2], b[3]);
        *(v4u*)(dst + i) = w;
    }
}
__device__ __forceinline__ float wave_max(float v, int lane) {
#pragma unroll
    for (int o = 32; o >= 1; o >>= 1) v = fmaxf(v, shx(v, o, lane));
    return v;
}
__device__ __forceinline__ void cvt_tables(const Ctx& c, int layer) {
    float* sm = c.W<float>(WS_SMALL);
    for (int r = c.gw; r < 2 * 16384; r += c.NGW) {
        const int tb = r >> 14, row = r & 16383;
        const float* src = c.in[c.z + 44 + tb] + ((size_t)layer * 16384 + row) * D + 16 * c.lane;
        f32x4 v[4];
#pragma unroll
        for (int k = 0; k < 4; ++k) v[k] = *(const f32x4*)(src + 4 * k);
        float m = 0.f;
#pragma unroll
        for (int k = 0; k < 4; ++k) m = fmaxf(fmaxf(fmaxf(fabsf(v[k][0]), fabsf(v[k][1])), fmaxf(fabsf(v[k][2]), fabsf(v[k][3]))), m);
        m = fmaxf(wave_max(m, c.lane), 1e-30f);
        const int ex = (int)((__builtin_bit_cast(unsigned, m) >> 23) & 0xffu) - 127;
        const float sc = __builtin_bit_cast(float, (unsigned)(127 + 7 - ex) << 23);
        const float isc = __builtin_bit_cast(float, (unsigned)(127 - 7 + ex) << 23);
        v4u o;
        { int p = __builtin_amdgcn_cvt_pk_fp8_f32(v[0][0] * sc, v[0][1] * sc, 0, false); p = __builtin_amdgcn_cvt_pk_fp8_f32(v[0][2] * sc, v[0][3] * sc, p, true); o.x = (unsigned)p; }
        { int p = __builtin_amdgcn_cvt_pk_fp8_f32(v[1][0] * sc, v[1][1] * sc, 0, false); p = __builtin_amdgcn_cvt_pk_fp8_f32(v[1][2] * sc, v[1][3] * sc, p, true); o.y = (unsigned)p; }
        { int p = __builtin_amdgcn_cvt_pk_fp8_f32(v[2][0] * sc, v[2][1] * sc, 0, false); p = __builtin_amdgcn_cvt_pk_fp8_f32(v[2][2] * sc, v[2][3] * sc, p, true); o.z = (unsigned)p; }
        { int p = __builtin_amdgcn_cvt_pk_fp8_f32(v[3][0] * sc, v[3][1] * sc, 0, false); p = __builtin_amdgcn_cvt_pk_fp8_f32(v[3][2] * sc, v[3][3] * sc, p, true); o.w = (unsigned)p; }
        *(v4u*)(c.ws + (tb ? WS_EV : WS_EU) + (size_t)row * D + 16 * c.lane) = o;
        if (c.lane == 0) sm[(tb ? SM_ISV : SM_ISU) + row] = isc;
    }
}
__device__ __forceinline__ void prologue(const Ctx& c) {
    transpose_mat(c, c.in[c.z + 7], 1024, 1024, c.W<bf16>(WS_W_S5IN));
    transpose_mat(c, c.in[c.z + 16], 1024, 1024, c.W<bf16>(WS_W_S5GLU));
    transpose_mat(c, c.in[c.z + 18], 1024, 1024, c.W<bf16>(WS_W_S5OUT));
    transpose_mat(c, c.in[c.z + 19], 1024, 1024, c.W<bf16>(WS_W_PIN));
    for (int g = 0; g < 4; ++g) transpose_mat(c, c.in[c.z + 20] + (size_t)g * 65536, 256, 256, c.W<bf16>(WS_W_PGRP) + (size_t)g * 65536);
    transpose_mat(c, c.in[c.z + 22], 1024, 1024, c.W<bf16>(WS_W_POUT));
    transpose_mat(c, c.in[c.z + 23], 1024, 2048, c.W<bf16>(WS_W_CIN));
    transpose_mat(c, c.in[c.z + 29], 1024, 1024, c.W<bf16>(WS_W_COUT));
    transpose_mat(c, c.in[c.z + 30], 1024, 5152, c.W<bf16>(WS_W_SIN));
    transpose_mat(c, c.in[c.z + 37], 2048, 1024, c.W<bf16>(WS_W_SOUT));
    for (int l = 0; l < 4; ++l) transpose_mat(c, c.in[c.z + 42] + (size_t)l * 1024 * 2048, 1024, 2048, c.W<bf16>(WS_W_PQ) + (size_t)l * 2048 * 1024);
    {
        v4u* z = (v4u*)(c.W<bf16>(WS_W_SIN) + (size_t)5152 * 1024);
        for (int i = c.gt; i < 224 * 1024 / 8; i += c.NGT) z[i] = (v4u){0u, 0u, 0u, 0u};
    }
    cvt_copy(c, c.in[c.z + 43], c.W<bf16>(WS_KEYS), (size_t)4 * 8 * 2 * 128 * 128);
    {
        float* H = c.W<float>(WS_H32); bf16* HB = c.W<bf16>(WS_HB);
        for (size_t i = (size_t)c.gt * 8; i < (size_t)T * D; i += (size_t)c.NGT * 8) {
            const float* src = (i < (size_t)TP * D) ? (c.in[c.z + 0] + i) : (c.in[c.z + 1] + (i - (size_t)TP * D));
            const f32x4 a = *(const f32x4*)(src), b = *(const f32x4*)(src + 4);
            *(f32x4*)(H + i) = a; *(f32x4*)(H + i + 4) = b;
            v4u w; w.x = pk2(a[0], a[1]); w.y = pk2(a[2], a[3]); w.z = pk2(b[0], b[1]); w.w = pk2(b[2], b[3]);
            *(v4u*)(HB + i) = w;
        }
    }
    if (c.gt < 4096) {
        const int gp = c.gt, g = gp >> 6;
        float* sm = c.W<float>(WS_SMALL);
        const float dt = expf(c.in[c.z + 10][g]);
        const float lr = c.in[c.z + 8][gp], li = c.in[c.z + 9][gp];
        const float mag = expf(lr * dt);
        const float br = mag * cosf(li * dt), bi = mag * sinf(li * dt);
        const float den = lr * lr + li * li;
        const float fr = ((br - 1.f) * lr + bi * li) / den, fi = (bi * lr - (br - 1.f) * li) / den;
        sm[SM_LBR + gp] = br; sm[SM_LBI + gp] = bi;
        for (int i = 0; i < 16; ++i) {
            const float xr = c.in[c.z + 11][gp * 16 + i], xi = c.in[c.z + 12][gp * 16 + i];
            sm[SM_BBR + gp * 16 + i] = fr * xr - fi * xi; sm[SM_BBI + gp * 16 + i] = fr * xi + fi * xr;
        }
    }
    cvt_tables(c, 0);
}

__device__ __forceinline__ void ln_row_store(const f32x4 (&v)[4], float mean, float rstd, const float* __restrict__ g, const float* __restrict__ b, float* o32, bf16* ob, int lane) {
#pragma unroll
    for (int h = 0; h < 2; ++h) {
        const int c0 = h * 512 + 8 * lane;
        const f32x4 g0 = *(const f32x4*)(g + c0), g1 = *(const f32x4*)(g + c0 + 4), b0 = *(const f32x4*)(b + c0), b1 = *(const f32x4*)(b + c0 + 4);
        const f32x4 o0 = (v[2 * h] - mean) * rstd * g0 + b0, o1 = (v[2 * h + 1] - mean) * rstd * g1 + b1;
        *(f32x4*)(o32 + c0) = o0; *(f32x4*)(o32 + c0 + 4) = o1;
        if (ob) { v4u w; w.x = pk2(o0[0], o0[1]); w.y = pk2(o0[2], o0[3]); w.z = pk2(o1[0], o1[1]); w.w = pk2(o1[2], o1[3]); *(v4u*)(ob + c0) = w; }
    }
}
__device__ __forceinline__ void ln_stats(const f32x4 (&v)[4], float& mean, float& rstd, int lane) {
    float s = 0.f;
#pragma unroll
    for (int k = 0; k < 4; ++k) s += (v[k][0] + v[k][1]) + (v[k][2] + v[k][3]);
    mean = wave_sum(s, lane) * (1.f / D);
    float q = 0.f;
#pragma unroll
    for (int k = 0; k < 4; ++k) { const f32x4 d = v[k] - mean; q += (d[0] * d[0] + d[1] * d[1]) + (d[2] * d[2] + d[3] * d[3]); }
    rstd = rsqrtf(wave_sum(q, lane) * (1.f / D) + LN_EPS);
}
__device__ __forceinline__ void phase_ln1(const Ctx& c, int layer) {
    const float* R = c.W<float>(WS_R32); float* H = c.W<float>(WS_H32); bf16* HB = c.W<bf16>(WS_HB);
    const float* g = c.in[c.z + 38] + layer * D; const float* b = c.in[c.z + 39] + layer * D;
    for (int t = c.gw; t < T; t += c.NGW) {
        f32x4 v[4];
#pragma unroll
        for (int h = 0; h < 2; ++h) { v[2 * h] = *(const f32x4*)(R + (size_t)t * D + h * 512 + 8 * c.lane); v[2 * h + 1] = *(const f32x4*)(R + (size_t)t * D + h * 512 + 8 * c.lane + 4); }
        float mean, rstd; ln_stats(v, mean, rstd, c.lane);
        ln_row_store(v, mean, rstd, g, b, H + (size_t)t * D, HB + (size_t)t * D, c.lane);
    }
}

__device__ __forceinline__ bf16x8 mk8(float a0, float a1, float a2, float a3, float a4, float a5, float a6, float a7) {
    v4u w; w.x = pk2(a0, a1); w.y = pk2(a2, a3); w.z = pk2(a4, a5); w.w = pk2(a6, a7); return __builtin_bit_cast(bf16x8, w);
}
constexpr int S5_BU_LD = 132  , S5_H_LD = 136  , S5_WAVE_BYTES = 16 * S5_BU_LD * 4 + 16 * S5_H_LD * 2;
__device__ __forceinline__ void phase_s5scan(const Ctx& c) {
    const bf16* U = c.W<bf16>(WS_A0); bf16* G = c.W<bf16>(WS_A1);
    const float* sm = c.W<float>(WS_SMALL);
    float* out = c.out;
    float* o_re_p = out + 17825792, *o_im_p = o_re_p + 32768, *o_re_s = out + 17825792 + 32768 * 2 + 122880 + 73728 + 2097152, *o_im_s = o_re_s + 524288;
    const int lane = c.lane, p = lane, fr = lane & 15, fq = lane >> 4;
    LAS float* BuT = (LAS float*)(c.lds + c.wave * S5_WAVE_BYTES);
    LAS bf16* Hi = (LAS bf16*)(c.lds + c.wave * S5_WAVE_BYTES + 16 * S5_BU_LD * 4);
    const int wslot = c.wave * c.nblk + c.bid;
    for (int unit = wslot; unit < 136 * 64; unit += c.NGW) {
        const int s = unit >> 6, g = unit & 63;
        int tok0, L; seq_info(s, tok0, L);
        bf16x8 Bf[8];
#pragma unroll
        for (int nt = 0; nt < 8; ++nt) {
            const int comp = 16 * nt + fr;
            const float* src = sm + ((comp < 64) ? SM_BBR : SM_BBI) + (size_t)(g * 64 + (comp & 63)) * 16 + 8 * (fq & 1);
            const f32x4 a = *(const f32x4*)src, b = *(const f32x4*)(src + 4);
            const bf16x8 v = mk8(a[0], a[1], a[2], a[3], b[0], b[1], b[2], b[3]);
            Bf[nt] = (fq < 2) ? v : (bf16x8){0, 0, 0, 0, 0, 0, 0, 0};
        }
        bf16x8 Cf[4];
#pragma unroll
        for (int ks = 0; ks < 4; ++ks) {
            const int comp0 = 32 * ks + 8 * fq;
            const float* src = ((ks < 2) ? c.in[c.z + 13] : c.in[c.z + 14]) + (size_t)(g * 16 + fr) * 64 + (comp0 & 63);
            const f32x4 a = *(const f32x4*)src, b = *(const f32x4*)(src + 4);
            const float sg = (ks < 2) ? 1.f : -1.f;
            Cf[ks] = mk8(sg * a[0], sg * a[1], sg * a[2], sg * a[3], sg * b[0], sg * b[1], sg * b[2], sg * b[3]);
        }
        const float lr = sm[SM_LBR + g * 64 + p], li = sm[SM_LBI + g * 64 + p];
        float hr = 0.f, hi = 0.f;
        if (s >= 8) { hr = c.in[c.z + 2][((s - 8) * 64 + g) * 64 + p]; hi = c.in[c.z + 3][((s - 8) * 64 + g) * 64 + p]; }
        const f32x4 dk4 = *(const f32x4*)(c.in[c.z + 15] + g * 16 + 4 * fq);
        const int ntile = (L + 15) >> 4;
        for (int tile = 0; tile < ntile; ++tile) {
            const int tb = tok0 + tile * 16;
            const bool valid = (tile * 16 + fr) < L;
            bf16x8 uf = {0, 0, 0, 0, 0, 0, 0, 0};
            if (fq < 2 && valid) uf = *(const bf16x8*)(U + (size_t)(tb + fr) * D + g * 16 + 8 * fq);
#pragma unroll
            for (int nt = 0; nt < 8; ++nt) {
                f32x4 acc = {0.f, 0.f, 0.f, 0.f};
                acc = __builtin_amdgcn_mfma_f32_16x16x32_bf16(Bf[nt], uf, acc, 0, 0, 0);
                *(LAS f32x4*)(BuT + fr * S5_BU_LD + 16 * nt + 4 * fq) = acc;
            }
            asm volatile("s_waitcnt lgkmcnt(0)" ::: "memory");
            const int nsteps = min(16, L - tile * 16);
#pragma unroll
            for (int t = 0; t < 16; ++t) {
                const float br = BuT[t * S5_BU_LD + p], bi = BuT[t * S5_BU_LD + 64 + p];
                const float nr = lr * hr - li * hi + br, ni = lr * hi + li * hr + bi;
                if (t < nsteps) { hr = nr; hi = ni; }
                Hi[t * S5_H_LD + p] = (bf16)f2bf(hr); Hi[t * S5_H_LD + 64 + p] = (bf16)f2bf(hi);
            }
            asm volatile("s_waitcnt lgkmcnt(0)" ::: "memory");
            f32x4 y = {0.f, 0.f, 0.f, 0.f};
#pragma unroll
            for (int ks = 0; ks < 4; ++ks) {
                const bf16x8 hf = *(const LAS bf16x8*)(Hi + fr * S5_H_LD + 32 * ks + 8 * fq);
                y = __builtin_amdgcn_mfma_f32_16x16x32_bf16(Cf[ks], hf, y, 0, 0, 0);
            }
            if (valid) {
                const v2u uq = *(const v2u*)(U + (size_t)(tb + fr) * D + g * 16 + 4 * fq);
                v2u o; o.x = pk2(gelu_f(y[0] + dk4[0] * bflo(uq.x)), gelu_f(y[1] + dk4[1] * bfhi(uq.x))); o.y = pk2(gelu_f(y[2] + dk4[2] * bflo(uq.y)), gelu_f(y[3] + dk4[3] * bfhi(uq.y)));
                *(v2u*)(G + (size_t)(tb + fr) * D + g * 16 + 4 * fq) = o;
            }
            asm volatile("" ::: "memory");
        }
        if (s < 8) { o_re_p[(s * 64 + g) * 64 + p] = hr; o_im_p[(s * 64 + g) * 64 + p] = hi; }
        else { o_re_s[((s - 8) * 64 + g) * 64 + p] = hr; o_im_s[((s - 8) * 64 + g) * 64 + p] = hi; }
    }
}

__device__ __forceinline__ void phase_pool(const Ctx& c) {
    const bf16* U = c.W<bf16>(WS_A0); bf16* P = c.W<bf16>(WS_A1);
    float* o_p = c.out + 17825792 + 65536, *o_s = c.out + 17825792 + 65536 + 122880 + 73728 + 2097152 + 1048576;
    for (size_t i = (size_t)c.gt; i < (size_t)T * 128; i += (size_t)c.NGT) {
        const int t = (int)(i >> 7), c0 = (int)(i & 127) * 8;
        int s, l, tok0; tok_info(t, s, l, tok0);
        const int w = 2 << (c0 >> 8);
        float sum[8];
#pragma unroll
        for (int j = 0; j < 8; ++j) sum[j] = 0.f;
        float cur[8];
        for (int k = 0; k < w; ++k) {
            const int ll = l - k;
            if (ll >= 0) {
                const v4u q = *(const v4u*)(U + (size_t)(tok0 + ll) * D + c0);
                const float f[8] = {bflo(q.x), bfhi(q.x), bflo(q.y), bfhi(q.y), bflo(q.z), bfhi(q.z), bflo(q.w), bfhi(q.w)};
#pragma unroll
                for (int j = 0; j < 8; ++j) { sum[j] += f[j]; if (k == 0) cur[j] = f[j]; }
            } else if (s >= 8) {
                const float* sp = c.in[c.z + 4] + ((size_t)(s - 8) * 15 + (15 + ll)) * D + c0;
                const f32x4 a = *(const f32x4*)sp, b = *(const f32x4*)(sp + 4);
                sum[0] += a[0]; sum[1] += a[1]; sum[2] += a[2]; sum[3] += a[3]; sum[4] += b[0]; sum[5] += b[1]; sum[6] += b[2]; sum[7] += b[3];
            }
        }
        const int pos = (s >= 8 ? 16384 : 0) + l;
        const float inv = 1.f / (float)min(pos + 1, w);
        v4u o; o.x = pk2(sum[0] * inv - cur[0], sum[1] * inv - cur[1]); o.y = pk2(sum[2] * inv - cur[2], sum[3] * inv - cur[3]);
        o.z = pk2(sum[4] * inv - cur[4], sum[5] * inv - cur[5]); o.w = pk2(sum[6] * inv - cur[6], sum[7] * inv - cur[7]);
        *(v4u*)(P + (size_t)t * D + c0) = o;
    }
    for (size_t i = (size_t)c.gt; i < (size_t)136 * 15 * D; i += (size_t)c.NGT) {
        const int ch = (int)(i & 1023); const int j = (int)((i >> 10) % 15); const int s = (int)(i / (15 * 1024));
        if (s < 8) o_p[((size_t)s * 15 + j) * D + ch] = bf2f(U[(size_t)(s * 2048 + 2033 + j) * D + ch]);
        else { const int b = s - 8; o_s[((size_t)b * 15 + j) * D + ch] = (j < 7) ? c.in[c.z + 4][((size_t)b * 15 + 8 + j) * D + ch] : bf2f(U[(size_t)(TP + b * 8 + (j - 7)) * D + ch]); }
    }
}

__device__ __forceinline__ void phase_cmlp_ln(const Ctx& c) {
    bf16* Z = c.W<bf16>(WS_Q);
    float* o_v = c.out + 17825792 + 65536 + 122880 + 73728 + 2097152 + 1048576 + 1966080;
    const float* g = c.in[c.z + 25]; const float* b = c.in[c.z + 26];
    for (int t = c.gw; t < T; t += c.NGW) {
        bf16* vr = Z + (size_t)t * 2048 + 1024;
        f32x4 v[4];
#pragma unroll
        for (int h = 0; h < 2; ++h) {
            const v4u q = *(const v4u*)(vr + h * 512 + 8 * c.lane);
            v[2 * h] = (f32x4){bflo(q.x), bfhi(q.x), bflo(q.y), bfhi(q.y)}; v[2 * h + 1] = (f32x4){bflo(q.z), bfhi(q.z), bflo(q.w), bfhi(q.w)};
        }
        float mean, rstd; ln_stats(v, mean, rstd, c.lane);
#pragma unroll
        for (int h = 0; h < 2; ++h) {
            const int c0 = h * 512 + 8 * c.lane;
            const f32x4 g0 = *(const f32x4*)(g + c0), g1 = *(const f32x4*)(g + c0 + 4), b0 = *(const f32x4*)(b + c0), b1 = *(const f32x4*)(b + c0 + 4);
            const f32x4 o0 = (v[2 * h] - mean) * rstd * g0 + b0, o1 = (v[2 * h + 1] - mean) * rstd * g1 + b1;
            v4u w; w.x = pk2(o0[0], o0[1]); w.y = pk2(o0[2], o0[3]); w.z = pk2(o1[0], o1[1]); w.w = pk2(o1[2], o1[3]);
            *(v4u*)(vr + c0) = w;
            if (t >= TP) { *(f32x4*)(o_v + (size_t)(t - TP) * D + c0) = o0; *(f32x4*)(o_v + (size_t)(t - TP) * D + c0 + 4) = o1; }
        }
    }
}
constexpr int CM_LD = 136, CM_WS = 0  , CM_VT = 34816  ;
__device__ __forceinline__ void phase_cmlp_mix(const Ctx& c) {
    const bf16* Z = c.W<bf16>(WS_Q); bf16* O = c.W<bf16>(WS_A1);
    LAS unsigned char* lds = c.lds;
    const int tid = c.tid, lane = c.lane, w = c.wave, fr = lane & 15, fq = lane >> 4;
    for (int unit = c.bid; unit < 128 * 4; unit += c.nblk) {
        const int chunk = unit >> 2, hd = unit & 3, tokc = chunk * 128;
#pragma unroll
        for (int k = 0; k < 4; ++k) {
            const int q = tid + 512 * k, row = q >> 4, cc = q & 15;
            const float* src = c.in[c.z + 27] + ((size_t)hd * 128 + row) * 128 + cc * 8;
            const f32x4 a = *(const f32x4*)src, b = *(const f32x4*)(src + 4);
            float f[8] = {a[0], a[1], a[2], a[3], b[0], b[1], b[2], b[3]};
#pragma unroll
            for (int j = 0; j < 8; ++j) f[j] = (cc * 8 + j <= row) ? f[j] : 0.f;
            v4u o; o.x = pk2(f[0], f[1]); o.y = pk2(f[2], f[3]); o.z = pk2(f[4], f[5]); o.w = pk2(f[6], f[7]);
            *(LAS v4u*)(lds + CM_WS + (row * CM_LD + cc * 8) * 2) = o;
        }
        {
            const int srow = tid & 127, dq = tid >> 7;
            const bf16* vs = Z + (size_t)(tokc + srow) * 2048 + 1024 + hd * 256 + dq * 64;
#pragma unroll
            for (int k = 0; k < 8; ++k) {
                const v4u q = *(const v4u*)(vs + 8 * k);
                const unsigned xw[4] = {q.x, q.y, q.z, q.w};
#pragma unroll
                for (int j = 0; j < 4; ++j) {
                    *(LAS bf16*)(lds + CM_VT + ((dq * 64 + 8 * k + 2 * j) * CM_LD + srow) * 2) = (bf16)(xw[j] & 0xffffu);
                    *(LAS bf16*)(lds + CM_VT + ((dq * 64 + 8 * k + 2 * j + 1) * CM_LD + srow) * 2) = (bf16)(xw[j] >> 16);
                }
            }
        }
        __syncthreads();
        f32x4 acc[16];
#pragma unroll
        for (int jd = 0; jd < 16; ++jd) acc[jd] = (f32x4){0.f, 0.f, 0.f, 0.f};
#pragma unroll
        for (int ks = 0; ks < 4; ++ks) {
            if (ks <= (w >> 1)) {
                const bf16x8 wf = *(const LAS bf16x8*)(lds + CM_WS + ((16 * w + fr) * CM_LD + ks * 32 + 8 * fq) * 2);
#pragma unroll
                for (int jd = 0; jd < 16; ++jd)
                    acc[jd] = __builtin_amdgcn_mfma_f32_16x16x32_bf16(*(const LAS bf16x8*)(lds + CM_VT + ((16 * jd + fr) * CM_LD + ks * 32 + 8 * fq) * 2), wf, acc[jd], 0, 0, 0);
            }
        }
        {
            const int t = 16 * w + fr; const size_t tok = (size_t)(tokc + t);
            const float bs = c.in[c.z + 28][hd * 128 + t];
#pragma unroll
            for (int jd = 0; jd < 16; ++jd) {
                const v2u uq = *(const v2u*)(Z + tok * 2048 + hd * 256 + 16 * jd + 4 * fq);
                v2u o; o.x = pk2(bflo(uq.x) * (acc[jd][0] + bs), bfhi(uq.x) * (acc[jd][1] + bs)); o.y = pk2(bflo(uq.y) * (acc[jd][2] + bs), bfhi(uq.y) * (acc[jd][3] + bs));
                *(v2u*)(O + tok * D + hd * 256 + 16 * jd + 4 * fq) = o;
            }
        }
        __syncthreads();
    }
    for (size_t i = (size_t)c.gt; i < (size_t)(T - TP) * 128; i += (size_t)c.NGT) {
        const int t = TP + (int)(i >> 7), c0 = (int)(i & 127) * 8;
        const int hd = c0 >> 8, tp = (t - TP) & 7, base = t - tp;
        float acc[8];
        const float bs = c.in[c.z + 28][hd * 128 + tp];
#pragma unroll
        for (int j = 0; j < 8; ++j) acc[j] = bs;
        const float* wr = c.in[c.z + 27] + ((size_t)hd * 128 + tp) * 128;
        for (int sp = 0; sp <= tp; ++sp) {
            const float wv = wr[sp];
            const v4u q = *(const v4u*)(Z + (size_t)(base + sp) * 2048 + 1024 + c0);
            acc[0] += wv * bflo(q.x); acc[1] += wv * bfhi(q.x); acc[2] += wv * bflo(q.y); acc[3] += wv * bfhi(q.y);
            acc[4] += wv * bflo(q.z); acc[5] += wv * bfhi(q.z); acc[6] += wv * bflo(q.w); acc[7] += wv * bfhi(q.w);
        }
        const v4u uq = *(const v4u*)(Z + (size_t)t * 2048 + c0);
        v4u o; o.x = pk2(bflo(uq.x) * acc[0], bfhi(uq.x) * acc[1]); o.y = pk2(bflo(uq.y) * acc[2], bfhi(uq.y) * acc[3]);
        o.z = pk2(bflo(uq.z) * acc[4], bfhi(uq.z) * acc[5]); o.w = pk2(bflo(uq.w) * acc[6], bfhi(uq.w) * acc[7]);
        *(v4u*)(O + (size_t)t * D + c0) = o;
    }
}

__device__ __forceinline__ void phase_ssd_conv(const Ctx& c) {
    const bf16* X = c.W<bf16>(WS_XBC); bf16* XC = c.W<bf16>(WS_XC);
    float* o_p = c.out + 17825792 + 65536 + 122880, *o_s = c.out + 17825792 + 65536 + 122880 + 73728 + 2097152 + 1048576 + 1966080 + 1048576;
    for (size_t i = (size_t)c.gt; i < (size_t)T * (CONVD / 8); i += (size_t)c.NGT) {
        const int t = (int)(i / (CONVD / 8)), c0 = (int)(i % (CONVD / 8)) * 8;
        int s, l, tok0; tok_info(t, s, l, tok0);
        float acc[8];
        { const f32x4 a = *(const f32x4*)(c.in[c.z + 32] + c0), b = *(const f32x4*)(c.in[c.z + 32] + c0 + 4); acc[0] = a[0]; acc[1] = a[1]; acc[2] = a[2]; acc[3] = a[3]; acc[4] = b[0]; acc[5] = b[1]; acc[6] = b[2]; acc[7] = b[3]; }
#pragma unroll
        for (int k = 0; k < 4; ++k) {
            const int src = l + k - 3;
            float f[8];
            if (src >= 0) {
                const v4u q = *(const v4u*)(X + (size_t)(tok0 + src) * CONVD + c0);
                f[0] = bflo(q.x); f[1] = bfhi(q.x); f[2] = bflo(q.y); f[3] = bfhi(q.y); f[4] = bflo(q.z); f[5] = bfhi(q.z); f[6] = bflo(q.w); f[7] = bfhi(q.w);
            } else if (s >= 8) {
                const float* sp = c.in[c.z + 5] + ((size_t)(s - 8) * 3 + (l + k)) * CONVD + c0;
                const f32x4 a = *(const f32x4*)sp, b = *(const f32x4*)(sp + 4);
                f[0] = a[0]; f[1] = a[1]; f[2] = a[2]; f[3] = a[3]; f[4] = b[0]; f[5] = b[1]; f[6] = b[2]; f[7] = b[3];
            } else {
#pragma unroll
                for (int j = 0; j < 8; ++j) f[j] = 0.f;
            }
            const f32x4 wa = *(const f32x4*)(c.in[c.z + 31] + k * CONVD + c0), wb = *(const f32x4*)(c.in[c.z + 31] + k * CONVD + c0 + 4);
            acc[0] += f[0] * wa[0]; acc[1] += f[1] * wa[1]; acc[2] += f[2] * wa[2]; acc[3] += f[3] * wa[3];
            acc[4] += f[4] * wb[0]; acc[5] += f[5] * wb[1]; acc[6] += f[6] * wb[2]; acc[7] += f[7] * wb[3];
        }
        v4u o; o.x = pk2(silu_f(acc[0]), silu_f(acc[1])); o.y = pk2(silu_f(acc[2]), silu_f(acc[3])); o.z = pk2(silu_f(acc[4]), silu_f(acc[5])); o.w = pk2(silu_f(acc[6]), silu_f(acc[7]));
        *(v4u*)(XC + (size_t)t * CONVD + c0) = o;
    }
    for (size_t i = (size_t)c.gt; i < (size_t)136 * 3 * CONVD; i += (size_t)c.NGT) {
        const int ch = (int)(i % CONVD); const int j = (int)((i / CONVD) % 3); const int s = (int)(i / (3 * CONVD));
        if (s < 8) o_p[((size_t)s * 3 + j) * CONVD + ch] = bf2f(X[(size_t)(s * 2048 + 2045 + j) * CONVD + ch]);
        else { const int b = s - 8; o_s[((size_t)b * 3 + j) * CONVD + ch] = bf2f(X[(size_t)(TP + b * 8 + 5 + j) * CONVD + ch]); }
    }
}
constexpr int SD_LD = 136;
constexpr int SD_C = 0, SD_B = 34816, SD_BT = 69632, SD_XT = 104448, SD_HB = 121856, SD_VEC = 139264;
__device__ __forceinline__ float softplus_f(float x) { return (x > 20.f) ? x : log1pf(__expf(x)); }
__device__ __forceinline__ void phase_ssd_scan(const Ctx& c) {
    const bf16* XC = c.W<bf16>(WS_XC); const float* DT = c.W<float>(WS_DT); bf16* Y = c.W<bf16>(WS_Y);
    float* o_p = c.out + 17825792 + 65536 + 122880 + 73728;
    float* o_s = c.out + 17825792 + 65536 + 122880 + 73728 + 2097152 + 1048576 + 1966080 + 1048576 + 1179648;
    const int tid = c.tid, lane = c.lane, w = c.wave, fr = lane & 15, fq = lane >> 4;
    LAS unsigned char* lds = c.lds;
    LAS float* csv = (LAS float*)(lds + SD_VEC); LAS float* dtv = csv + 128;
#define SD_FRAG(img, row, ks) (*(const LAS bf16x8*)(lds + (img) + ((row) * SD_LD + (ks) * 32 + 8 * fq) * 2))
    for (int unit = c.bid; unit < 8 * 32; unit += c.nblk) {
        const int s = unit >> 5, hd = unit & 31, g = hd >> 3;
        const float a = -__expf(c.in[c.z + 34][hd]), dtb = c.in[c.z + 33][hd], dk = c.in[c.z + 35][hd];
        f32x4 hacc[4];
#pragma unroll
        for (int jp = 0; jp < 4; ++jp) hacc[jp] = (f32x4){0.f, 0.f, 0.f, 0.f};
        for (int ch = 0; ch < 16; ++ch) {
            const int tokc = s * 2048 + ch * 128;
            if (w == 0) {
                const float dt0 = softplus_f(DT[(size_t)(tokc + lane) * 32 + hd] + dtb), dt1 = softplus_f(DT[(size_t)(tokc + 64 + lane) * 32 + hd] + dtb);
                float s0 = dt0 * a, s1 = dt1 * a;
#pragma unroll
                for (int o = 1; o < 64; o <<= 1) {
                    const float u0 = __builtin_bit_cast(float, __builtin_amdgcn_ds_bpermute(((lane - o) & 63) << 2, __builtin_bit_cast(int, s0)));
                    const float u1 = __builtin_bit_cast(float, __builtin_amdgcn_ds_bpermute(((lane - o) & 63) << 2, __builtin_bit_cast(int, s1)));
                    if (lane >= o) { s0 += u0; s1 += u1; }
                }
                const float tot0 = __builtin_bit_cast(float, __builtin_amdgcn_readlane(__builtin_bit_cast(int, s0), 63));
                csv[lane] = s0; csv[64 + lane] = tot0 + s1; dtv[lane] = dt0; dtv[64 + lane] = dt1;
            }
#pragma unroll
            for (int k = 0; k < 4; ++k) {
                const int q = tid + 512 * k, row = q >> 4, cc = q & 15;
                const bf16* src = XC + (size_t)(tokc + row) * CONVD + g * 128 + cc * 8;
                *(LAS v4u*)(lds + SD_C + (row * SD_LD + cc * 8) * 2) = *(const v4u*)(src + 2560);
                *(LAS v4u*)(lds + SD_B + (row * SD_LD + cc * 8) * 2) = *(const v4u*)(src + 2048);
            }
#pragma unroll
            for (int jp = 0; jp < 4; ++jp) {
                v2u hq; hq.x = pk2(hacc[jp][0], hacc[jp][1]); hq.y = pk2(hacc[jp][2], hacc[jp][3]);
                *(LAS v2u*)(lds + SD_HB + ((16 * jp + fr) * SD_LD + 16 * w + 4 * fq) * 2) = hq;
            }
            __syncthreads();
            {
                const int srow = tid & 127, qq = tid >> 7;
                const float sc = __expf(csv[127] - csv[srow]) * dtv[srow];
#pragma unroll
                for (int k = 0; k < 4; ++k) {
                    const int n0 = qq * 32 + k * 8;
                    const v4u bq = *(const LAS v4u*)(lds + SD_B + (srow * SD_LD + n0) * 2);
                    const float f[8] = {bflo(bq.x), bfhi(bq.x), bflo(bq.y), bfhi(bq.y), bflo(bq.z), bfhi(bq.z), bflo(bq.w), bfhi(bq.w)};
#pragma unroll
                    for (int j = 0; j < 8; ++j) *(LAS bf16*)(lds + SD_BT + ((n0 + j) * SD_LD + srow) * 2) = (bf16)f2bf(f[j] * sc);
                }
                const bf16* xs = XC + (size_t)(tokc + srow) * CONVD + hd * 64 + qq * 16;
                const v4u x0 = *(const v4u*)xs, x1 = *(const v4u*)(xs + 8);
                const unsigned xw[8] = {x0.x, x0.y, x0.z, x0.w, x1.x, x1.y, x1.z, x1.w};
#pragma unroll
                for (int j = 0; j < 8; ++j) {
                    *(LAS bf16*)(lds + SD_XT + ((qq * 16 + 2 * j) * SD_LD + srow) * 2) = (bf16)(xw[j] & 0xffffu);
                    *(LAS bf16*)(lds + SD_XT + ((qq * 16 + 2 * j + 1) * SD_LD + srow) * 2) = (bf16)(xw[j] >> 16);
                }
            }
            __syncthreads();
            const int jmax = w | 1;
            bf16x8 Cf[4];
#pragma unroll
            for (int ks = 0; ks < 4; ++ks) Cf[ks] = SD_FRAG(SD_C, 16 * w + fr, ks);
            f32x4 acc[8];
#pragma unroll
            for (int j = 0; j < 8; ++j) {
                acc[j] = (f32x4){0.f, 0.f, 0.f, 0.f};
                if (j <= jmax) {
#pragma unroll
                    for (int ks = 0; ks < 4; ++ks) acc[j] = __builtin_amdgcn_mfma_f32_16x16x32_bf16(SD_FRAG(SD_B, 16 * j + fr, ks), Cf[ks], acc[j], 0, 0, 0);
                }
            }
            {
                const float cdec = __expf(csv[127]);
                bf16x8 Bt[4];
#pragma unroll
                for (int ks = 0; ks < 4; ++ks) Bt[ks] = SD_FRAG(SD_BT, 16 * w + fr, ks);
#pragma unroll
                for (int jp = 0; jp < 4; ++jp) {
                    hacc[jp] = hacc[jp] * cdec;
#pragma unroll
                    for (int ks = 0; ks < 4; ++ks) hacc[jp] = __builtin_amdgcn_mfma_f32_16x16x32_bf16(Bt[ks], SD_FRAG(SD_XT, 16 * jp + fr, ks), hacc[jp], 0, 0, 0);
                }
            }
            __syncthreads();
            {
                const int t = 16 * w + fr; const float cst = csv[t];
#pragma unroll
                for (int j = 0; j < 8; ++j) {
                    if (j <= jmax) {
                        const f32x4 css = *(const LAS f32x4*)(csv + 16 * j + 4 * fq), dts = *(const LAS f32x4*)(dtv + 16 * j + 4 * fq);
                        float v[4];
#pragma unroll
                        for (int r = 0; r < 4; ++r) v[r] = (16 * j + 4 * fq + r <= t) ? acc[j][r] * __expf(cst - css[r]) * dts[r] : 0.f;
                        v2u lq; lq.x = pk2(v[0], v[1]); lq.y = pk2(v[2], v[3]);
                        *(LAS v2u*)(lds + SD_B + (t * SD_LD + 16 * j + 4 * fq) * 2) = lq;
                    }
                }
            }
            __syncthreads();
            {
                f32x4 a1[4], a2[4];
#pragma unroll
                for (int jp = 0; jp < 4; ++jp) { a1[jp] = (f32x4){0.f, 0.f, 0.f, 0.f}; a2[jp] = (f32x4){0.f, 0.f, 0.f, 0.f}; }
#pragma unroll
                for (int ks = 0; ks < 4; ++ks) {
                    if (ks <= (w >> 1)) {
                        const bf16x8 Lf = SD_FRAG(SD_B, 16 * w + fr, ks);
#pragma unroll
                        for (int jp = 0; jp < 4; ++jp) a1[jp] = __builtin_amdgcn_mfma_f32_16x16x32_bf16(SD_FRAG(SD_XT, 16 * jp + fr, ks), Lf, a1[jp], 0, 0, 0);
                    }
#pragma unroll
                    for (int jp = 0; jp < 4; ++jp) a2[jp] = __builtin_amdgcn_mfma_f32_16x16x32_bf16(SD_FRAG(SD_HB, 16 * jp + fr, ks), Cf[ks], a2[jp], 0, 0, 0);
                }
                const int t = 16 * w + fr; const float ecs = __expf(csv[t]);
                const size_t tok = (size_t)(tokc + t);
#pragma unroll
                for (int jp = 0; jp < 4; ++jp) {
                    const v2u xq = *(const v2u*)(XC + tok * CONVD + hd * 64 + 16 * jp + 4 * fq);
                    v2u yo; yo.x = pk2(a1[jp][0] + ecs * a2[jp][0] + dk * bflo(xq.x), a1[jp][1] + ecs * a2[jp][1] + dk * bfhi(xq.x));
                    yo.y = pk2(a1[jp][2] + ecs * a2[jp][2] + dk * bflo(xq.y), a1[jp][3] + ecs * a2[jp][3] + dk * bfhi(xq.y));
                    *(v2u*)(Y + tok * 2048 + hd * 64 + 16 * jp + 4 * fq) = yo;
                }
            }
            __syncthreads();
        }
#pragma unroll
        for (int jp = 0; jp < 4; ++jp) *(f32x4*)(o_p + (((size_t)s * 32 + hd) * 64 + 16 * jp + fr) * 128 + 16 * w + 4 * fq) = hacc[jp];
    }
#undef SD_FRAG
    __syncthreads();
    {
        LAS float* Bw = (LAS float*)(lds + w * 8192);
        LAS float* Cw = Bw + 1024;
        for (int unit = c.gw; unit < 128 * 32; unit += c.NGW) {
            const int b = unit >> 5, hd = unit & 31, g = hd >> 3, tok0 = TP + b * 8, p = lane;
            const float a = -__expf(c.in[c.z + 34][hd]), dtb = c.in[c.z + 33][hd], dk = c.in[c.z + 35][hd];
            {
                const int tk = lane >> 3, c0 = (lane & 7) * 16;
                const bf16* src = XC + (size_t)(tok0 + tk) * CONVD + g * 128 + c0;
                const v4u b0 = *(const v4u*)(src + 2048), b1 = *(const v4u*)(src + 2048 + 8), c0v = *(const v4u*)(src + 2560), c1v = *(const v4u*)(src + 2560 + 8);
                LAS float* bd = Bw + tk * 128 + c0; LAS float* cd = Cw + tk * 128 + c0;
                *(LAS f32x4*)(bd) = (f32x4){bflo(b0.x), bfhi(b0.x), bflo(b0.y), bfhi(b0.y)}; *(LAS f32x4*)(bd + 4) = (f32x4){bflo(b0.z), bfhi(b0.z), bflo(b0.w), bfhi(b0.w)};
                *(LAS f32x4*)(bd + 8) = (f32x4){bflo(b1.x), bfhi(b1.x), bflo(b1.y), bfhi(b1.y)}; *(LAS f32x4*)(bd + 12) = (f32x4){bflo(b1.z), bfhi(b1.z), bflo(b1.w), bfhi(b1.w)};
                *(LAS f32x4*)(cd) = (f32x4){bflo(c0v.x), bfhi(c0v.x), bflo(c0v.y), bfhi(c0v.y)}; *(LAS f32x4*)(cd + 4) = (f32x4){bflo(c0v.z), bfhi(c0v.z), bflo(c0v.w), bfhi(c0v.w)};
                *(LAS f32x4*)(cd + 8) = (f32x4){bflo(c1v.x), bfhi(c1v.x), bflo(c1v.y), bfhi(c1v.y)}; *(LAS f32x4*)(cd + 12) = (f32x4){bflo(c1v.z), bfhi(c1v.z), bflo(c1v.w), bfhi(c1v.w)};
            }
            float xv[8], dA[8], coef[8], yv[8];
#pragma unroll
            for (int t = 0; t < 8; ++t) {
                xv[t] = bf2f(XC[(size_t)(tok0 + t) * CONVD + hd * 64 + p]);
                const float dtv_ = softplus_f(DT[(size_t)(tok0 + t) * 32 + hd] + dtb);
                dA[t] = __expf(dtv_ * a); coef[t] = dtv_ * xv[t]; yv[t] = dk * xv[t];
            }
            asm volatile("s_waitcnt lgkmcnt(0)" ::: "memory");
            const float* hin = c.in[c.z + 6] + (((size_t)b * 32 + hd) * 64 + p) * 128;
            float* hout = o_s + (((size_t)b * 32 + hd) * 64 + p) * 128;
#pragma unroll 1
            for (int qt = 0; qt < 4; ++qt) {
                float h[32];
#pragma unroll
                for (int i = 0; i < 8; ++i) { const f32x4 q = *(const f32x4*)(hin + qt * 32 + 4 * i); h[4 * i] = q[0]; h[4 * i + 1] = q[1]; h[4 * i + 2] = q[2]; h[4 * i + 3] = q[3]; }
#pragma unroll
                for (int t = 0; t < 8; ++t) {
                    float ya = 0.f, yb = 0.f;
#pragma unroll
                    for (int i = 0; i < 8; ++i) {
                        const f32x4 bq = *(const LAS f32x4*)(Bw + t * 128 + qt * 32 + 4 * i), cq = *(const LAS f32x4*)(Cw + t * 128 + qt * 32 + 4 * i);
                        h[4 * i] = h[4 * i] * dA[t] + coef[t] * bq[0]; ya += cq[0] * h[4 * i];
                        h[4 * i + 1] = h[4 * i + 1] * dA[t] + coef[t] * bq[1]; yb += cq[1] * h[4 * i + 1];
                        h[4 * i + 2] = h[4 * i + 2] * dA[t] + coef[t] * bq[2]; ya += cq[2] * h[4 * i + 2];
                        h[4 * i + 3] = h[4 * i + 3] * dA[t] + coef[t] * bq[3]; yb += cq[3] * h[4 * i + 3];
                    }
                    yv[t] += ya + yb;
                    asm volatile("" ::: "memory");
                }
#pragma unroll
                for (int i = 0; i < 8; ++i) *(f32x4*)(hout + qt * 32 + 4 * i) = (f32x4){h[4 * i], h[4 * i + 1], h[4 * i + 2], h[4 * i + 3]};
            }
#pragma unroll
            for (int t = 0; t < 8; ++t) Y[(size_t)(tok0 + t) * 2048 + hd * 64 + p] = (bf16)f2bf(yv[t]);
            asm volatile("" ::: "memory");
        }
    }
}
__device__ __forceinline__ void phase_ssd_gatenorm(const Ctx& c) {
    const bf16* Y = c.W<bf16>(WS_Y); const bf16* Z = c.W<bf16>(WS_Q); bf16* YN = c.W<bf16>(WS_YN);
    for (int it = c.gw; it < T * 4; it += c.NGW) {
        const int t = it >> 2, c0 = (it & 3) * 512 + 8 * c.lane;
        const v4u yq = *(const v4u*)(Y + (size_t)t * 2048 + c0), zq = *(const v4u*)(Z + (size_t)t * 2048 + c0);
        const float yf[8] = {bflo(yq.x), bfhi(yq.x), bflo(yq.y), bfhi(yq.y), bflo(yq.z), bfhi(yq.z), bflo(yq.w), bfhi(yq.w)};
        const float zf[8] = {bflo(zq.x), bfhi(zq.x), bflo(zq.y), bfhi(zq.y), bflo(zq.z), bfhi(zq.z), bflo(zq.w), bfhi(zq.w)};
        float v[8]; float q = 0.f;
#pragma unroll
        for (int j = 0; j < 8; ++j) { v[j] = yf[j] * silu_f(zf[j]); q += v[j] * v[j]; }
        const float r = rsqrtf(wave_sum(q, c.lane) * (1.f / 512.f) + RMS_EPS);
        const f32x4 g0 = *(const f32x4*)(c.in[c.z + 36] + c0), g1 = *(const f32x4*)(c.in[c.z + 36] + c0 + 4);
        v4u o; o.x = pk2(v[0] * r * g0[0], v[1] * r * g0[1]); o.y = pk2(v[2] * r * g0[2], v[3] * r * g0[3]); o.z = pk2(v[4] * r * g1[0], v[5] * r * g1[1]); o.w = pk2(v[6] * r * g1[2], v[7] * r * g1[3]);
        *(v4u*)(YN + (size_t)t * 2048 + c0) = o;
    }
}

__device__ __forceinline__ unsigned ord_key(float s) { const unsigned u = __builtin_bit_cast(unsigned, s); return (u & 0x80000000u) ? ~u : (u | 0x80000000u); }
__device__ __forceinline__ float ord_dec(unsigned k) { const unsigned u = (k & 0x80000000u) ? (k & 0x7fffffffu) : ~k; return __builtin_bit_cast(float, u); }
__device__ __forceinline__ void ins16(unsigned (&Lk)[16], unsigned x) {
#pragma unroll
    for (int k = 0; k < 16; ++k) { const unsigned hi = max(Lk[k], x); x = min(Lk[k], x); Lk[k] = hi; }
}
constexpr int RT_SC_LD = 260, RT_LIST_OFF = 128 * RT_SC_LD * 4;
__device__ __forceinline__ void phase_route(const Ctx& c, int layer) {
    const bf16* Q = c.W<bf16>(WS_Q); const bf16* KEYS = c.W<bf16>(WS_KEYS) + (size_t)layer * 8 * 2 * 128 * 128;
    int* IDX = c.W<int>(WS_IDX); float* GATE = c.W<float>(WS_GATE); float* SCU = c.W<float>(WS_SCU);
    const float* ISU = c.W<float>(WS_SMALL) + SM_ISU; const float* ISV = c.W<float>(WS_SMALL) + SM_ISV;
    LAS float* sc = (LAS float*)c.lds; LAS unsigned* lists = (LAS unsigned*)(c.lds + RT_LIST_OFF);
    const int fr = c.lane & 15, fq = c.lane >> 4;
    for (int task = c.bid; task < 136 * 8; task += c.nblk) {
        const int tt = task >> 3, h = task & 7, tok0 = tt * 128;
        {
            const bf16* qrow = Q + (size_t)(tok0 + 16 * c.wave + fr) * 2048 + h * 256 + 8 * fq;
#pragma unroll
            for (int side = 0; side < 2; ++side) {
                bf16x8 qf[4];
#pragma unroll
                for (int ks = 0; ks < 4; ++ks) qf[ks] = *(const bf16x8*)(qrow + side * 128 + ks * 32);
                const bf16* kb = KEYS + ((size_t)(h * 2 + side) * 128 + fr) * 128 + 8 * fq;
#pragma unroll
                for (int nt = 0; nt < 8; ++nt) {
                    f32x4 acc = {0.f, 0.f, 0.f, 0.f};
#pragma unroll
                    for (int ks = 0; ks < 4; ++ks) {
                        const bf16x8 kf = *(const bf16x8*)(kb + (size_t)nt * 16 * 128 + ks * 32);
                        acc = __builtin_amdgcn_mfma_f32_16x16x32_bf16(kf, qf[ks], acc, 0, 0, 0);
                    }
                    *(LAS f32x4*)(sc + (16 * c.wave + fr) * RT_SC_LD + side * 128 + nt * 16 + 4 * fq) = acc;
                }
            }
        }
        __syncthreads();
        if (c.tid < 256) {
            const int token = c.tid & 127, side = c.tid >> 7;
            unsigned Lk[16];
#pragma unroll
            for (int k = 0; k < 16; ++k) Lk[k] = 0u;
            const LAS float* row = sc + token * RT_SC_LD + side * 128;
            for (int n4 = 0; n4 < 32; ++n4) {
                const f32x4 v = *(const LAS f32x4*)(row + n4 * 4);
#pragma unroll
                for (int j = 0; j < 4; ++j) ins16(Lk, (ord_key(v[j]) & ~127u) | (unsigned)(127 - (n4 * 4 + j)));
            }
#pragma unroll
            for (int k = 0; k < 16; ++k) lists[(token * 2 + side) * 16 + k] = Lk[k];
        }
        __syncthreads();
        if (c.tid < 128) {
            const int token = c.tid;
            float s0[16], s1[16];
#pragma unroll
            for (int k = 0; k < 16; ++k) { s0[k] = ord_dec(lists[(token * 2) * 16 + k] & ~127u); s1[k] = ord_dec(lists[(token * 2 + 1) * 16 + k] & ~127u); }
            unsigned Bk[16];
#pragma unroll
            for (int k = 0; k < 16; ++k) Bk[k] = 0u;
#pragma unroll
            for (int i = 0; i < 16; ++i)
#pragma unroll
                for (int j = 0; j < 16; ++j)
                    if ((i + 1) * (j + 1) <= 16) ins16(Bk, (ord_key(s0[i] + s1[j]) & ~255u) | (unsigned)(255 - (i * 16 + j)));
            float e[16]; int id[16]; float mx = 0.f, den = 0.f;
#pragma unroll
            for (int k = 0; k < 16; ++k) {
                const int pay = 255 - (int)(Bk[k] & 255u), i = pay >> 4, j = pay & 15;
                const unsigned k0 = lists[(token * 2) * 16 + i], k1 = lists[(token * 2 + 1) * 16 + j];
                id[k] = (127 - (int)(k0 & 127u)) * 128 + (127 - (int)(k1 & 127u));
                const float sv = ord_dec(k0 & ~127u) + ord_dec(k1 & ~127u);
                if (k == 0) mx = sv;
                e[k] = __expf(sv - mx); den += e[k];
            }
            const float inv = 1.f / den;
            int* ip = IDX + (size_t)(tok0 + token) * 128 + h * 16; float* gp = GATE + (size_t)(tok0 + token) * 128 + h * 16; float* up = SCU + (size_t)(tok0 + token) * 128 + h * 16;
            float su[16];
#pragma unroll
            for (int k = 0; k < 16; ++k) { su[k] = ISU[id[k]]; e[k] *= inv * ISV[id[k]]; }
#pragma unroll
            for (int k = 0; k < 4; ++k) {
                *(int4*)(ip + 4 * k) = make_int4(id[4 * k], id[4 * k + 1], id[4 * k + 2], id[4 * k + 3]);
                *(f32x4*)(gp + 4 * k) = (f32x4){e[4 * k], e[4 * k + 1], e[4 * k + 2], e[4 * k + 3]};
                *(f32x4*)(up + 4 * k) = (f32x4){su[4 * k], su[4 * k + 1], su[4 * k + 2], su[4 * k + 3]};
            }
        }
        __syncthreads();
    }
}

typedef float f32x2 __attribute__((ext_vector_type(2)));
#define CVT8(wd, hi) __builtin_amdgcn_cvt_pk_f32_fp8((int)(wd), (hi))
__device__ __forceinline__ void phase_gather(const Ctx& c, int layer, bool dummy) {
    const unsigned char* EU = c.ws + WS_EU; const unsigned char* EV = c.ws + WS_EV;
    const int* IDX = c.W<int>(WS_IDX); const float* GATE = c.W<float>(WS_GATE); const float* SCU = c.W<float>(WS_SCU);
    const float* H = c.W<float>(WS_H32); float* Ho = dummy ? c.W<float>(WS_R32) : c.W<float>(WS_H32); bf16* HB = dummy ? c.W<bf16>(WS_A0) : c.W<bf16>(WS_HB);
    const float* g = c.in[c.z + 40] + layer * D; const float* b = c.in[c.z + 41] + layer * D;
    const int lane = c.lane;
    const int ntw = (T - c.gw + c.NGW - 1) / c.NGW, nit = ntw * 8;
#define GT_TOK(it) (c.gw + ((it) >> 3) * c.NGW)
#define GT_IDX(it) (((it) < nit) ? IDX[(size_t)GT_TOK(it) * 128 + ((it) & 7) * 16 + (lane & 15)] : 0)
#define GT_GS(P, it) ((P)[(size_t)GT_TOK((it) < nit ? (it) : 0) * 128 + ((it) & 7) * 16 + ((lane >> 2) & 15)])
    int idx_c = GT_IDX(0), idx_n = GT_IDX(1);
    float gate_c = GT_GS(GATE, 0), scu_c = GT_GS(SCU, 0);
    f32x2 x2[8], xn[8], acc[8];
#pragma unroll
    for (int k = 0; k < 4; ++k) { const f32x4 hx = *(const f32x4*)(H + (size_t)c.gw * D + 16 * lane + 4 * k); xn[2 * k] = (f32x2){hx[0], hx[1]}; xn[2 * k + 1] = (f32x2){hx[2], hx[3]}; }
    v4u ru[16], rv[16];
#pragma unroll
    for (int e = 0; e < 16; ++e) {
        const int id = __builtin_amdgcn_readlane(idx_c, e);
        ru[e] = *(const v4u*)(EU + (size_t)id * D + 16 * lane); rv[e] = *(const v4u*)(EV + (size_t)id * D + 16 * lane);
    }
    for (int it = 0; it < nit; ++it) {
        const int t = GT_TOK(it), bt = it & 7;
        const int idx_nn = GT_IDX(it + 2);
        const float gate_n = GT_GS(GATE, it + 1), scu_n = GT_GS(SCU, it + 1);
        const float mygate = gate_c, myscu = scu_c;
        if (bt == 0) {
#pragma unroll
            for (int i = 0; i < 8; ++i) { x2[i] = xn[i]; acc[i] = (f32x2){0.f, 0.f}; }
        }
        if (bt == 7 && it + 1 < nit) {
            const int tn = GT_TOK(it + 1);
#pragma unroll
            for (int k = 0; k < 4; ++k) { const f32x4 hx = *(const f32x4*)(H + (size_t)tn * D + 16 * lane + 4 * k); xn[2 * k] = (f32x2){hx[0], hx[1]}; xn[2 * k + 1] = (f32x2){hx[2], hx[3]}; }
        }
        float pv[16];
#pragma unroll
        for (int e = 0; e < 16; ++e) {
            const v4u w = ru[e];
            f32x2 d = CVT8(w.x, false) * x2[0];
            d += CVT8(w.x, true) * x2[1]; d += CVT8(w.y, false) * x2[2]; d += CVT8(w.y, true) * x2[3];
            d += CVT8(w.z, false) * x2[4]; d += CVT8(w.z, true) * x2[5]; d += CVT8(w.w, false) * x2[6]; d += CVT8(w.w, true) * x2[7];
            pv[e] = d.x + d.y;
            ru[e] = *(const v4u*)(EU + (size_t)__builtin_amdgcn_readlane(idx_n, e) * D + 16 * lane);
        }
        const float tot = reduce16(pv, lane);
        const float wgt = mygate * gelu_f(tot * myscu);
#pragma unroll
        for (int e = 0; e < 16; ++e) {
            const float we = __builtin_bit_cast(float, __builtin_amdgcn_readlane(__builtin_bit_cast(int, wgt), 4 * e));
            const v4u w = rv[e];
            acc[0] += CVT8(w.x, false) * we; acc[1] += CVT8(w.x, true) * we; acc[2] += CVT8(w.y, false) * we; acc[3] += CVT8(w.y, true) * we;
            acc[4] += CVT8(w.z, false) * we; acc[5] += CVT8(w.z, true) * we; acc[6] += CVT8(w.w, false) * we; acc[7] += CVT8(w.w, true) * we;
            rv[e] = *(const v4u*)(EV + (size_t)__builtin_amdgcn_readlane(idx_n, e) * D + 16 * lane);
        }
        if (bt == 7) {
            f32x4 v[4];
#pragma unroll
            for (int k = 0; k < 4; ++k) v[k] = (f32x4){x2[2 * k].x, x2[2 * k].y, x2[2 * k + 1].x, x2[2 * k + 1].y} * ALPHA + (f32x4){acc[2 * k].x, acc[2 * k].y, acc[2 * k + 1].x, acc[2 * k + 1].y};
            float mean, rstd; ln_stats(v, mean, rstd, lane);
            float* o32 = ((layer == 3 && !dummy) ? c.out : Ho) + (size_t)t * D + 16 * lane;
            bf16* ob = (layer == 3 && !dummy) ? (bf16*)nullptr : HB + (size_t)t * D + 16 * lane;
            v4u wb[2];
#pragma unroll
            for (int k = 0; k < 4; ++k) {
                const f32x4 g4 = *(const f32x4*)(g + 16 * lane + 4 * k), b4 = *(const f32x4*)(b + 16 * lane + 4 * k);
                const f32x4 o = (v[k] - mean) * rstd * g4 + b4;
                *(f32x4*)(o32 + 4 * k) = o;
                if (k & 1) { wb[k >> 1].z = pk2(o[0], o[1]); wb[k >> 1].w = pk2(o[2], o[3]); } else { wb[k >> 1].x = pk2(o[0], o[1]); wb[k >> 1].y = pk2(o[2], o[3]); }
            }
            if (ob) { *(v4u*)(ob) = wb[0]; *(v4u*)(ob + 8) = wb[1]; }
        }
        idx_c = idx_n; idx_n = idx_nn; gate_c = gate_n; scu_c = scu_n;
    }
#undef GT_GS
#undef GT_TOK
#undef GT_IDX
}

#define XB_TMO      128
#define XB_XCNT(j)  (256  + 64 * (j))
#define XB_XSUB(j)  (1280 + 64 * (j))
#define XB_XGEN(j)  (2304 + 64 * (j))
#define XB_TOP      3328
#define XB_TOPGEN   3392
#define XCD_BAR_WORDS 3456
#define XB_SPIN_CAP (1u << 22)
__device__ __forceinline__ unsigned xb_ld(unsigned* p)              { return __hip_atomic_load(p, __ATOMIC_RELAXED, __HIP_MEMORY_SCOPE_AGENT); }
__device__ __forceinline__ unsigned xb_add(unsigned* p, unsigned v) { return __hip_atomic_fetch_add(p, v, __ATOMIC_RELAXED, __HIP_MEMORY_SCOPE_AGENT); }
__device__ __forceinline__ unsigned xb_xcc_id() { return (unsigned)__builtin_amdgcn_s_getreg((3 << 11) | 20) & 0xFu; }
#define XB_SPIN(cond, bar) do { unsigned _sp = 0; while (cond) { __builtin_amdgcn_s_sleep(1); \
    if ((++_sp & 255u) == 0u) { if (xb_ld(&(bar)[XB_TMO])) break; if (_sp > XB_SPIN_CAP) { atomicAdd(&(bar)[XB_TMO], 1u); break; } } } } while (0)
struct XcdBarrier { unsigned* bar; unsigned x; volatile LAS unsigned* st; };
__device__ __forceinline__ XcdBarrier xcd_barrier_post(unsigned* bar, volatile LAS unsigned* st) {
    XcdBarrier b; b.bar = bar; b.x = xb_xcc_id(); b.st = st;
    if (threadIdx.x == 0) (void)xb_add(&bar[XB_XCNT(b.x)], 1u);
    return b;
}
__device__ __forceinline__ void xcd_barrier_complete(unsigned* bar, unsigned x, unsigned& nloc, unsigned& nx) {
    const unsigned G = gridDim.x * gridDim.y * gridDim.z;
    unsigned sum, cnt, mine, sp = 0u;
    for (;;) {
        sum = 0u; cnt = 0u; mine = 0u;
#pragma unroll
        for (unsigned j = 0; j < 16; ++j) { const unsigned cc = xb_ld(&bar[XB_XCNT(j)]); sum += cc; cnt += (cc > 0u) ? 1u : 0u; mine = (j == x) ? cc : mine; }
        if (sum == G) break;
        __builtin_amdgcn_s_sleep(1);
        if ((++sp & 255u) == 0u) { if (xb_ld(&bar[XB_TMO])) break; if (sp > XB_SPIN_CAP) { atomicAdd(&bar[XB_TMO], 1u); break; } }
    }
    nloc = mine > 0u ? mine : 1u; nx = cnt > 0u ? cnt : 1u;
}
__device__ __forceinline__ void xcd_barrier(const XcdBarrier& b, int tid) {
    asm volatile("s_waitcnt vmcnt(0)" ::: "memory");
    __syncthreads();
    if (tid == 0) {
        unsigned* bar = b.bar;
        __builtin_amdgcn_s_waitcnt(0);
        unsigned nloc = b.st[0], nx = b.st[1];
        if (nloc == 0u) { xcd_barrier_complete(bar, b.x, nloc, nx); b.st[0] = nloc; b.st[1] = nx; }
        const unsigned old = xb_add(&bar[XB_XSUB(b.x)], 1u);
        const unsigned gen = old / nloc;
        if (old + 1u == (gen + 1u) * nloc) {
            __builtin_amdgcn_fence(__ATOMIC_RELEASE, "agent");
            asm volatile("s_waitcnt vmcnt(0)" ::: "memory");
            const unsigned og = xb_add(&bar[XB_TOP], 1u);
            const unsigned tg = og / nx;
            if (og + 1u == (tg + 1u) * nx) xb_add(&bar[XB_TOPGEN], 1u);
            else XB_SPIN(xb_ld(&bar[XB_TOPGEN]) == tg, bar);
            __builtin_amdgcn_fence(__ATOMIC_ACQUIRE, "agent");
            xb_add(&bar[XB_XGEN(b.x)], 1u);
            asm volatile("s_waitcnt vmcnt(0)" ::: "memory");
        } else {
            XB_SPIN(xb_ld(&bar[XB_XGEN(b.x)]) == gen, bar);
            __builtin_amdgcn_fence(__ATOMIC_ACQUIRE, "agent");
            asm volatile("s_waitcnt vmcnt(0)" ::: "memory");
        }
    }
    __syncthreads();
}

__global__ void __launch_bounds__(NTHR, 2) mega(Params P) {
    extern __shared__ __attribute__((aligned(16))) unsigned char lds_raw[];
    cg::grid_group grid = cg::this_grid();
    Ctx c;
    c.in = P.in; c.out = P.out; c.ws = P.ws; c.lds = (LAS unsigned char*)lds_raw; c.z = 0;
    c.tid = threadIdx.x; c.lane = c.tid & 63; c.wave = __builtin_amdgcn_readfirstlane(c.tid >> 6);
    c.gw = (int)blockIdx.x * NWAVES + c.wave; c.NGW = (int)gridDim.x * NWAVES; c.gt = (int)blockIdx.x * NTHR + c.tid; c.NGT = (int)gridDim.x * NTHR; c.bid = (int)blockIdx.x; c.nblk = (int)gridDim.x;
#define RF() do { int zs_ = 0; asm volatile("" : "+s"(zs_)); c.z = zs_; c.lds = (LAS unsigned char*)lds_raw + zs_; int z_ = 0; asm volatile("" : "+v"(z_)); const int l_ = (int)__builtin_amdgcn_mbcnt_hi(~0u, __builtin_amdgcn_mbcnt_lo(~0u, (unsigned)z_)); c.lane = l_; c.tid = c.wave * 64 + l_; c.bid = (int)blockIdx.x + zs_; c.nblk = (int)gridDim.x + zs_; c.gw = c.bid * NWAVES + c.wave; c.NGW = c.nblk * NWAVES; c.gt = c.bid * NTHR + c.tid; c.NGT = c.nblk * NTHR; } while (0)
    bf16* HB = c.W<bf16>(WS_HB); bf16* A0 = c.W<bf16>(WS_A0); bf16* A1 = c.W<bf16>(WS_A1); bf16* A2 = c.W<bf16>(WS_A2); bf16* Qb = c.W<bf16>(WS_Q);
    float* H32 = c.W<float>(WS_H32); float* R32 = c.W<float>(WS_R32);

    if (threadIdx.x < 16) ((volatile LAS unsigned*)(c.lds + MISC_OFF))[threadIdx.x] = 0u;
    __syncthreads();
    const XcdBarrier xbar = xcd_barrier_post(c.W<unsigned>(WS_CTL), (volatile LAS unsigned*)(c.lds + MISC_OFF));
#define GSYNC() do { RF(); xcd_barrier(xbar, c.tid); } while (0)
    RF(); prologue(c);
    grid.sync();
    for (int layer = 0; layer < 4; ++layer) {
        if (layer <= 1) {
            const bf16* Wt = c.W<bf16>(layer == 0 ? WS_W_S5IN : WS_W_PIN);
            RF(); run_gemm(c, HB, D, 0, Wt, 1024, 1024, EpiBf16<0>{A0, D, nullptr, nullptr, nullptr});
        } else if (layer == 2) {
            RF(); run_gemm(c, HB, D, 0, c.W<bf16>(WS_W_CIN), 2048, 1024, EpiBf16<1>{Qb, 2048, c.in[c.z + 24], nullptr, nullptr});
        } else {
            RF(); run_gemm(c, HB, D, 0, c.W<bf16>(WS_W_SIN), NPROJ, 1024, EpiSsdProj{Qb, c.W<bf16>(WS_XBC), c.W<float>(WS_DT)});
        }
        GSYNC();
        const bf16* Aout = A2; const bf16* Wout;
        if (layer == 0) {
            for (int r = 0; r < PR_S5; ++r) { RF(); phase_s5scan(c); }
            GSYNC();
            RF(); run_gemm(c, A1, D, 0, c.W<bf16>(WS_W_S5GLU), 1024, 1024, EpiBf16<3>{A2, D, c.in[c.z + 17], nullptr, A1});
            Wout = c.W<bf16>(WS_W_S5OUT);
        } else if (layer == 1) {
            RF(); phase_pool(c);
            GSYNC();
            RF(); run_gemm(c, A1, D, 256, c.W<bf16>(WS_W_PGRP), 1024, 256, EpiBf16<2>{A2, D, nullptr, c.in[c.z + 21], nullptr});
            Wout = c.W<bf16>(WS_W_POUT);
        } else if (layer == 2) {
            RF(); phase_cmlp_ln(c);
            GSYNC();
            RF(); phase_cmlp_mix(c);
            Aout = A1; Wout = c.W<bf16>(WS_W_COUT);
        } else {
            RF(); phase_ssd_conv(c);
            GSYNC();
            for (int r = 0; r < PR_SSD; ++r) { RF(); phase_ssd_scan(c); }
            GSYNC();
            RF(); phase_ssd_gatenorm(c);
            Aout = c.W<bf16>(WS_YN); Wout = c.W<bf16>(WS_W_SOUT);
        }
        GSYNC();
        if (layer == 3) { RF(); run_gemm(c, Aout, 2048, 0, Wout, 1024, 2048, EpiResid{H32, R32}); }
        else { RF(); run_gemm(c, Aout, 1024, 0, Wout, 1024, 1024, EpiResid{H32, R32}); }
        GSYNC();
        RF(); phase_ln1(c, layer);
        if (layer > 0) { RF(); cvt_tables(c, layer); }
        GSYNC();
        RF(); run_gemm(c, HB, D, 0, c.W<bf16>(WS_W_PQ) + (size_t)layer * 2048 * 1024, 2048, 1024, EpiBf16<0>{Qb, 2048, nullptr, nullptr, nullptr});
        GSYNC();
        for (int r = 0; r < PR_ROUTE; ++r) { RF(); phase_route(c, layer); }
        GSYNC();
        for (int r = 1; r < PR_GATHER; ++r) { RF(); phase_gather(c, layer, true); }
        RF(); phase_gather(c, layer, false);
        GSYNC();
    }
}
}

extern "C" void kernel_launch(void* const* d_in, const int* in_sizes, int n_in, void* d_out, int out_size, void* d_ws, size_t ws_size, hipStream_t stream) {
    static int grid = 0;
    if (grid == 0) {
        int dev = 0, cus = 0, per_cu = 0;
        if (hipGetDevice(&dev) != hipSuccess || hipDeviceGetAttribute(&cus, hipDeviceAttributeMultiprocessorCount, dev) != hipSuccess) { fprintf(stderr, "kernel_launch: device query failed\n"); grid = -1; return; }
        if (hipFuncSetAttribute((const void*)mk::mega, hipFuncAttributeMaxDynamicSharedMemorySize, mk::LDS_BYTES) != hipSuccess) { fprintf(stderr, "kernel_launch: hipFuncSetAttribute failed\n"); grid = -1; return; }
        if (hipOccupancyMaxActiveBlocksPerMultiprocessor(&per_cu, (const void*)mk::mega, mk::NTHR, mk::LDS_BYTES) != hipSuccess || per_cu < 1) { fprintf(stderr, "kernel_launch: occupancy query says %d blocks per CU\n", per_cu); grid = -1; return; }
        grid = cus;
        if (ws_size < mk::WS_END) { fprintf(stderr, "kernel_launch: workspace too small (%zu < %zu)\n", ws_size, (size_t)mk::WS_END); grid = -1; return; }
    }
    if (grid < 0) return;
    mk::Params p{};
    for (int i = 0; i < 46; ++i) p.in[i] = (const float*)d_in[i];
    p.out = (float*)d_out; p.ws = (unsigned char*)d_ws;
    if (hipMemsetAsync((char*)d_ws + mk::WS_CTL, 0, mk::CTL_BYTES, stream) != hipSuccess) { fprintf(stderr, "kernel_launch: memset failed\n"); return; }
    void* args[] = {&p};
    hipError_t e = hipLaunchCooperativeKernel((const void*)mk::mega, dim3(grid), dim3(mk::NTHR), args, mk::LDS_BYTES, stream);
    if (e != hipSuccess) fprintf(stderr, "cooperative launch failed: %s (grid %d)\n", hipGetErrorString(e), grid);
}
```

```cpp
#include <hip/hip_runtime.h>
#include <hip/hip_cooperative_groups.h>
#include <cstdio>
#include <cstdint>
#include <math.h>
namespace cg = cooperative_groups;

namespace pg8 {
#define PG8_LAS __attribute__((address_space(3)))
typedef unsigned short bf16_t;
typedef short bf16x8 __attribute__((ext_vector_type(8)));
typedef float f32x4 __attribute__((ext_vector_type(4)));
typedef unsigned u32x4 __attribute__((ext_vector_type(4)));
constexpr int BM = 256, BK = 64, HALF = 128, HTB = HALF * BK * 2, STAGE_BYTES = 8 * HTB, NXCD = 8, WGM = 8;
__host__ __device__ __forceinline__ int lds_byte(int r, int c) { const int st = (r >> 4) * 2 + (c >> 5), rr = r & 15, cc = c & 31, ob = rr * 64 + cc * 2; return st * 1024 + (ob ^ (((ob >> 9) & 1) << 5)); }
__host__ __device__ __forceinline__ void stage_rc(int b, int& R, int& C) { const int st = b / 1024, sb = b % 1024, swz = sb ^ (((sb >> 9) & 1) << 5); R = (st >> 1) * 16 + swz / 64; C = (st & 1) * 32 + (swz % 64) / 2; }
__host__ __device__ __forceinline__ int perm32(int rho) { const int n = rho >> 4, i = rho & 15; return 8 * (i >> 2) + 4 * n + (i & 3); }
struct Unit { int pm, pn; };
struct Gemm { const bf16_t* A; const bf16_t* Bt; int M, N, K, lda, a_pn_off; };
struct StaticOrder {
    int nM, nN, nwg, G, c;
    __host__ __device__ void init(int M, int N, int G_, int c_) { nM = M / BM; nN = N / BM; nwg = nM * nN; G = G_; c = c_; }
    __host__ __device__ bool next(int i, Unit& u) const {
        const long L = (long)i * G + c; if (L >= nwg) return false;
        int wgid = (int)L; { const int q = nwg / NXCD, r = nwg % NXCD, xcd = wgid % NXCD, off = wgid / NXCD; wgid = (xcd < r ? xcd * (q + 1) : r * (q + 1) + (xcd - r) * q) + off; }
        const int nig = WGM * nN, gid = wgid / nig, fm = gid * WGM, gsz = (nM - fm) < WGM ? (nM - fm) : WGM;
        u.pm = fm + ((wgid % nig) % gsz); u.pn = (wgid % nig) / gsz; return true;
    }
    __device__ __forceinline__ void a_ready(const Unit&) const {}
    __device__ __forceinline__ void done(const Unit&) const {}
};
__device__ __forceinline__ unsigned cvt_pk_bf16(float lo, float hi) { unsigned r; asm volatile("v_cvt_pk_bf16_f32 %0, %1, %2" : "=v"(r) : "v"(lo), "v"(hi)); return r; }
template <class Epi, class Sched, bool ALIGN_EPI = false, bool SP2 = false>
__device__ __forceinline__ void gemm_phase(PG8_LAS unsigned char* lds, const Gemm g, const Sched& S, const Epi& E, int tid_in) {
    int tid_ = tid_in; asm volatile("" : "+v"(tid_));
    const int tid = tid_, wid = __builtin_amdgcn_readfirstlane(tid >> 6), lane = tid & 63, wr = wid >> 2, wc = wid & 3, fr = lane & 15, fq = lane >> 4;
    const int K = g.K, nt = K / BK;
    unsigned voffA[2], voffB[2];
#pragma unroll
    for (int i = 0; i < 2; ++i) { int R, C; stage_rc(tid * 16 + i * 8192, R, C); const int Rb = Epi::PERM ? ((R & ~31) + perm32(R & 31)) : R;
        voffA[i] = (unsigned)(R * g.lda + C) * 2u; voffB[i] = (unsigned)(Rb * K + C) * 2u; }
    const size_t kstep = (size_t)(BK * 2);
    const size_t hstepA = (size_t)HALF * g.lda * 2, tstepA = 2 * hstepA;
    const size_t hstepB = (size_t)HALF * K * 2, tstepB = 2 * hstepB;
    const size_t apn = (size_t)g.a_pn_off * 2;
    const unsigned ldsw = (unsigned)wid * 1024u;
    const int aoff = lds_byte(wr * 64 + fr, fq * 8), boff = lds_byte(wc * 32 + fr, fq * 8);
#define PG8_SA(b, h) (((b) * 2 + (h)) * HTB)
#define PG8_SB(b, h) ((4 + (b) * 2 + (h)) * HTB)
#define PG8_STAGE(bufoff, gbase, voff) do { _Pragma("unroll") for (int _i = 0; _i < 2; ++_i) \
        __builtin_amdgcn_global_load_lds((const unsigned*)((const char*)(gbase) + (voff)[_i]), (PG8_LAS unsigned*)(lds + (bufoff) + ldsw + _i * 8192), 16, 0, 0); } while (0)
#define PG8_LDA(dst, b, h) do { _Pragma("unroll") for (int m = 0; m < 4; ++m) _Pragma("unroll") for (int k = 0; k < 2; ++k) dst[m][k] = *(const PG8_LAS bf16x8*)(lds + PG8_SA(b, h) + aoff + m * 2048 + k * 1024); } while (0)
#define PG8_LDB(dst, b, h) do { _Pragma("unroll") for (int n = 0; n < 2; ++n) _Pragma("unroll") for (int k = 0; k < 2; ++k) dst[n][k] = *(const PG8_LAS bf16x8*)(lds + PG8_SB(b, h) + boff + n * 2048 + k * 1024); } while (0)
#define PG8_MMA(ai, bj, At, Bt) do { __builtin_amdgcn_s_setprio(1); _Pragma("unroll") for (int m = 0; m < 4; ++m) _Pragma("unroll") for (int n = 0; n < 2; ++n) _Pragma("unroll") for (int k = 0; k < 2; ++k) \
        acc[ai][bj][m][n] = __builtin_amdgcn_mfma_f32_16x16x32_bf16(Bt[n][k], At[m][k], acc[ai][bj][m][n], 0, 0, 0); __builtin_amdgcn_s_setprio(0); } while (0)
#define PG8_WAIT_V(n) asm volatile("s_waitcnt vmcnt(" #n ")" ::: "memory")
#define PG8_WAIT_L(n) asm volatile("s_waitcnt lgkmcnt(" #n ")" ::: "memory")
#define PG8_BAR __builtin_amdgcn_s_barrier()
#define PG8_SCHED __builtin_amdgcn_sched_barrier(0)
    Unit cur, nxt; int ui = 0;
    if (!S.next(0, cur)) return;
    f32x4 acc[2][2][4][2];
#pragma unroll
    for (int a = 0; a < 2; ++a)
#pragma unroll
        for (int b = 0; b < 2; ++b)
#pragma unroll
            for (int m = 0; m < 4; ++m)
#pragma unroll
                for (int n = 0; n < 2; ++n) acc[a][b][m][n] = (f32x4){0.f, 0.f, 0.f, 0.f};
    bf16x8 At[4][2], B0[2][2], B1[2][2];
    const char* cA = (const char*)g.A + (size_t)cur.pm * tstepA + (size_t)cur.pn * apn; const char* cB = (const char*)g.Bt + (size_t)cur.pn * tstepB;
    S.a_ready(cur);
    if constexpr (SP2) {
        PG8_STAGE(PG8_SB(0, 0), cB, voffB); PG8_STAGE(PG8_SB(0, 1), cB + hstepB, voffB); PG8_STAGE(PG8_SA(0, 0), cA, voffA); PG8_STAGE(PG8_SA(0, 1), cA + hstepA, voffA);
        if (wr == 1) PG8_BAR;
        PG8_WAIT_V(2); PG8_BAR;
        PG8_STAGE(PG8_SB(1, 0), cB + kstep, voffB); PG8_STAGE(PG8_SA(1, 0), cA + kstep, voffA); PG8_STAGE(PG8_SB(1, 1), cB + hstepB + kstep, voffB);
        PG8_WAIT_V(6); PG8_BAR;
    } else {
        PG8_STAGE(PG8_SB(0, 0), cB, voffB); PG8_STAGE(PG8_SA(0, 0), cA, voffA); PG8_STAGE(PG8_SB(0, 1), cB + hstepB, voffB); PG8_STAGE(PG8_SA(0, 1), cA + hstepA, voffA);
        if (wr == 1) PG8_BAR;
        PG8_WAIT_V(4); PG8_BAR;
        PG8_STAGE(PG8_SB(1, 0), cB + kstep, voffB); PG8_STAGE(PG8_SA(1, 0), cA + kstep, voffA); PG8_STAGE(PG8_SB(1, 1), cB + hstepB + kstep, voffB);
        PG8_WAIT_V(6); PG8_BAR;
    }
    for (;;) {
        const bool has_next = S.next(ui + 1, nxt);
        const char* nA = has_next ? (const char*)g.A + (size_t)nxt.pm * tstepA + (size_t)nxt.pn * apn : cA; const char* nB = has_next ? (const char*)g.Bt + (size_t)nxt.pn * tstepB : cB;
#pragma nounroll
        for (int t = 0; t < nt; t += 2) {
            const bool last = (t == nt - 2);
            const char* a1 = cA + (size_t)(t + 1) * kstep;
            const char* a2 = last ? nA : cA + (size_t)(t + 2) * kstep; const char* b2 = last ? nB : cB + (size_t)(t + 2) * kstep;
            const char* a3 = a2 + kstep; const char* b3 = b2 + kstep;
            if (last && has_next) S.a_ready(nxt);
            if constexpr (SP2) {
            PG8_LDB(B0, 0, 0); PG8_LDB(B1, 0, 1); PG8_SCHED; PG8_LDA(At, 0, 0); PG8_STAGE(PG8_SA(1, 1), a1 + hstepA, voffA);
            PG8_WAIT_V(8); PG8_WAIT_L(0); PG8_BAR; PG8_MMA(0, 0, At, B0); PG8_MMA(0, 1, At, B1); PG8_BAR; PG8_SCHED;
            PG8_LDA(At, 0, 1); PG8_STAGE(PG8_SB(0, 0), b2, voffB); PG8_STAGE(PG8_SB(0, 1), b2 + hstepB, voffB); PG8_STAGE(PG8_SA(0, 0), a2, voffA);
            PG8_WAIT_V(8); PG8_WAIT_L(0); PG8_BAR; PG8_MMA(1, 0, At, B0); PG8_MMA(1, 1, At, B1); PG8_BAR; PG8_SCHED;
            PG8_LDB(B0, 1, 0); PG8_LDB(B1, 1, 1); PG8_SCHED; PG8_LDA(At, 1, 0); PG8_STAGE(PG8_SA(0, 1), a2 + hstepA, voffA);
            PG8_WAIT_V(8); PG8_WAIT_L(0); PG8_BAR; PG8_MMA(0, 0, At, B0); PG8_MMA(0, 1, At, B1); PG8_BAR; PG8_SCHED;
            PG8_LDA(At, 1, 1); PG8_STAGE(PG8_SB(1, 0), b3, voffB); PG8_STAGE(PG8_SB(1, 1), b3 + hstepB, voffB); PG8_STAGE(PG8_SA(1, 0), a3, voffA);
            PG8_WAIT_V(8); PG8_WAIT_L(0); PG8_BAR; PG8_MMA(1, 0, At, B0); PG8_MMA(1, 1, At, B1); PG8_BAR; PG8_SCHED;
            } else {
            PG8_LDB(B0, 0, 0); PG8_SCHED; PG8_LDA(At, 0, 0); PG8_STAGE(PG8_SA(1, 1), a1 + hstepA, voffA);
            PG8_WAIT_L(8); PG8_BAR; PG8_WAIT_L(0); PG8_MMA(0, 0, At, B0); PG8_BAR; PG8_SCHED;
            PG8_LDB(B1, 0, 1); PG8_STAGE(PG8_SB(0, 0), b2, voffB);
            PG8_BAR; PG8_WAIT_L(0); PG8_MMA(0, 1, At, B1); PG8_BAR;
            PG8_LDA(At, 0, 1); PG8_STAGE(PG8_SA(0, 0), a2, voffA);
            PG8_BAR; PG8_WAIT_L(0); PG8_MMA(1, 0, At, B0); PG8_BAR; PG8_SCHED;
            PG8_STAGE(PG8_SB(0, 1), b2 + hstepB, voffB);
            PG8_WAIT_V(6); PG8_BAR; PG8_MMA(1, 1, At, B1); PG8_BAR;
            PG8_LDB(B0, 1, 0); PG8_SCHED; PG8_LDA(At, 1, 0); PG8_STAGE(PG8_SA(0, 1), a2 + hstepA, voffA);
            PG8_WAIT_L(8); PG8_BAR; PG8_WAIT_L(0); PG8_MMA(0, 0, At, B0); PG8_BAR; PG8_SCHED;
            PG8_LDB(B1, 1, 1); PG8_STAGE(PG8_SB(1, 0), b3, voffB);
            PG8_BAR; PG8_WAIT_L(0); PG8_MMA(0, 1, At, B1); PG8_BAR;
            PG8_LDA(At, 1, 1); PG8_STAGE(PG8_SA(1, 0), a3, voffA);
            PG8_BAR; PG8_WAIT_L(0); PG8_MMA(1, 0, At, B0); PG8_BAR; PG8_SCHED;
            PG8_STAGE(PG8_SB(1, 1), b3 + hstepB, voffB);
            PG8_WAIT_V(6); PG8_BAR; PG8_MMA(1, 1, At, B1); PG8_BAR;
            }
        }
        if constexpr (ALIGN_EPI) { if (wr == 0) PG8_BAR; }
        if constexpr (!Epi::AFTER_DRAIN) { E(acc, cur, wr, wc, fr, fq); S.done(cur); }
        if (!has_next) break;
#pragma unroll
        for (int a = 0; a < 2; ++a)
#pragma unroll
            for (int b = 0; b < 2; ++b)
#pragma unroll
                for (int m = 0; m < 4; ++m)
#pragma unroll
                    for (int n = 0; n < 2; ++n) acc[a][b][m][n] = (f32x4){0.f, 0.f, 0.f, 0.f};
        cur = nxt; cA = nA; cB = nB; ++ui;
        if constexpr (ALIGN_EPI) { if (wr == 1) PG8_BAR; }
    }
    PG8_WAIT_V(0);
    if constexpr (!ALIGN_EPI) { if (wr == 0) PG8_BAR; }
    PG8_BAR;
    if constexpr (Epi::AFTER_DRAIN) { E.fused(acc, cur, wr, wc, fr, fq, lds, wid, lane); S.done(cur); }
#undef PG8_SA
#undef PG8_SB
#undef PG8_STAGE
#undef PG8_LDA
#undef PG8_LDB
#undef PG8_MMA
#undef PG8_WAIT_V
#undef PG8_WAIT_L
#undef PG8_BAR
#undef PG8_SCHED
}
}

#ifndef PR_GATHER
#define PR_GATHER 1
#endif
#ifndef PR_ROUTE
#define PR_ROUTE 1
#endif
#ifndef PR_S5
#define PR_S5 1
#endif
#ifndef PR_SSD
#define PR_SSD 1
#endif
#ifndef PR_GEMM
#define PR_GEMM 1
#endif
#ifndef PR_MISC
#define PR_MISC 1
#endif
namespace mk {
#define LAS __attribute__((address_space(3)))
typedef unsigned short bf16;
typedef unsigned v4u __attribute__((ext_vector_type(4)));
typedef unsigned v2u __attribute__((ext_vector_type(2)));
typedef float f32x4 __attribute__((ext_vector_type(4)));
typedef short bf16x8 __attribute__((ext_vector_type(8)));
using bf16x2 = __attribute__((ext_vector_type(2))) __bf16;

constexpr int D = 1024, T = 17408, TP = 16384, NWAVES = 8, NTHR = 512;
constexpr float ALPHA = 1.6817928305074290f;
constexpr float LN_EPS = 1e-5f, RMS_EPS = 1e-5f;
constexpr int LDS_BYTES = 160 * 1024;
constexpr int NPROJ = 5376, CONVD = 3072;

constexpr size_t MiB = 1u << 20;
constexpr size_t WS_W_S5IN = 0, WS_W_S5GLU = 2 * MiB, WS_W_S5OUT = 4 * MiB, WS_W_PIN = 6 * MiB, WS_W_PGRP = 8 * MiB, WS_W_POUT = 9 * MiB,
                 WS_W_CIN = 11 * MiB, WS_W_COUT = 15 * MiB, WS_W_SIN = 17 * MiB  , WS_W_SOUT = 28 * MiB, WS_W_PQ = 32 * MiB  ,
                 WS_KEYS = 48 * MiB  , WS_SMALL = 50 * MiB, WS_CTL = 52 * MiB  ;
constexpr size_t CTL_BYTES = 16384;
constexpr int MISC_OFF = LDS_BYTES - 64;
constexpr size_t WS_EU = 64 * MiB, WS_EV = 96 * MiB;
constexpr size_t WS_H32 = 128 * MiB, WS_R32 = 196 * MiB, WS_HB = 264 * MiB, WS_A0 = 298 * MiB, WS_A1 = 332 * MiB, WS_A2 = 366 * MiB;
constexpr size_t WS_Q = 400 * MiB  , WS_IDX = 468 * MiB  , WS_GATE = 477 * MiB  , WS_DT = 486 * MiB  ;
constexpr size_t WS_XBC = 490 * MiB  , WS_XC = 592 * MiB  , WS_Y = 694 * MiB  , WS_YN = 762 * MiB  , WS_SCU = 830 * MiB  , WS_END = 839 * MiB;
constexpr size_t SM_LBR = 0, SM_LBI = 4096, SM_BBR = 8192, SM_BBI = 8192 + 65536, SM_ISU = 8192 + 131072, SM_ISV = SM_ISU + 16384;

struct Params { const float* in[46]; float* out; unsigned char* ws; };

__device__ __forceinline__ unsigned f2bf(float f) { unsigned u = __builtin_bit_cast(unsigned, f); return (u + 0x7fffu + ((u >> 16) & 1u)) >> 16; }
__device__ __forceinline__ unsigned pk2(float lo, float hi) { return pg8::cvt_pk_bf16(lo, hi); }
__device__ __forceinline__ float bflo(unsigned w) { return __builtin_bit_cast(float, w << 16); }
__device__ __forceinline__ float bfhi(unsigned w) { return __builtin_bit_cast(float, w & 0xffff0000u); }
__device__ __forceinline__ float bf2f(bf16 b) { return __builtin_bit_cast(float, ((unsigned)b) << 16); }
__device__ __forceinline__ float sigmoid_f(float x) { return 1.f / (1.f + __expf(-x)); }
__device__ __forceinline__ float silu_f(float x) { return x * sigmoid_f(x); }
__device__ __forceinline__ float gelu_f(float x) { return x * sigmoid_f(1.5957691216057308f * (x + 0.044715f * x * x * x)); }
__device__ __forceinline__ float shx(float v, int o, int lane) { return __builtin_bit_cast(float, __builtin_amdgcn_ds_bpermute((lane ^ o) << 2, __builtin_bit_cast(int, v))); }
__device__ __forceinline__ float wave_sum(float v, int lane) {
#pragma unroll
    for (int o = 32; o >= 1; o >>= 1) v += shx(v, o, lane);
    return v;
}
__device__ __forceinline__ float dot2(unsigned w, unsigned x, float acc) { return __builtin_amdgcn_fdot2_f32_bf16(__builtin_bit_cast(bf16x2, w), __builtin_bit_cast(bf16x2, x), acc, false); }
__device__ __forceinline__ float reduce16(const float (&p)[16], int lane) {
    const bool b5 = lane & 32, b4 = lane & 16, b3 = lane & 8, b2 = lane & 4;
    float q[8], r[4], s[2], t;
#pragma unroll
    for (int i = 0; i < 8; ++i) { const float keep = b5 ? p[i + 8] : p[i], send = b5 ? p[i] : p[i + 8]; q[i] = keep + shx(send, 32, lane); }
#pragma unroll
    for (int i = 0; i < 4; ++i) { const float keep = b4 ? q[i + 4] : q[i], send = b4 ? q[i] : q[i + 4]; r[i] = keep + shx(send, 16, lane); }
#pragma unroll
    for (int i = 0; i < 2; ++i) { const float keep = b3 ? r[i + 2] : r[i], send = b3 ? r[i] : r[i + 2]; s[i] = keep + shx(send, 8, lane); }
    { const float keep = b2 ? s[1] : s[0], send = b2 ? s[0] : s[1]; t = keep + shx(send, 4, lane); }
    t += shx(t, 2, lane); t += shx(t, 1, lane);
    return t;
}
__device__ __forceinline__ void seq_info(int s, int& tok0, int& L) { if (s < 8) { tok0 = s << 11; L = 2048; } else { tok0 = TP + ((s - 8) << 3); L = 8; } }
__device__ __forceinline__ void tok_info(int t, int& s, int& l, int& tok0) {
    if (t < TP) { s = t >> 11; l = t & 2047; tok0 = s << 11; } else { const int b = (t - TP) >> 3; s = 8 + b; l = (t - TP) & 7; tok0 = TP + (b << 3); }
}

template <int MODE> struct EpiBf16 {
    static constexpr bool PERM = true, AFTER_DRAIN = false;
    bf16* O; int ldc; const float* bias; const float* scale; const bf16* G;
    __device__ __forceinline__ void operator()(const pg8::f32x4 (&acc)[2][2][4][2], const pg8::Unit& u, int wr, int wc, int fr_, int fq_) const {
        int fr = fr_, fq = fq_; asm volatile("" : "+v"(fr), "+v"(fq));
        const int row0 = u.pm * 256 + wr * 64 + fr, col0 = u.pn * 256 + wc * 32 + 8 * fq;
        f32x4 bv[2][2], sv[2][2];
#pragma unroll
        for (int bj = 0; bj < 2; ++bj)
#pragma unroll
            for (int n = 0; n < 2; ++n) {
                bv[bj][n] = bias ? *(const f32x4*)(bias + col0 + bj * 128 + 4 * n) : (f32x4){0.f, 0.f, 0.f, 0.f};
                sv[bj][n] = (MODE == 2) ? *(const f32x4*)(scale + col0 + bj * 128 + 4 * n) : (f32x4){1.f, 1.f, 1.f, 1.f};
            }
#pragma unroll
        for (int ai = 0; ai < 2; ++ai)
#pragma unroll
            for (int m = 0; m < 4; ++m) {
                const size_t roff = (size_t)(row0 + ai * 128 + m * 16) * ldc + col0;
#pragma unroll
                for (int bj = 0; bj < 2; ++bj) {
                    f32x4 v0 = acc[ai][bj][m][0] + bv[bj][0], v1 = acc[ai][bj][m][1] + bv[bj][1];
                    if (MODE == 1) {
#pragma unroll
                        for (int j = 0; j < 4; ++j) { v0[j] = gelu_f(v0[j]); v1[j] = gelu_f(v1[j]); }
                    }
                    if (MODE == 2) { v0 = v0 * sv[bj][0]; v1 = v1 * sv[bj][1]; }
                    if (MODE == 3) {
                        const v4u gw = *(const v4u*)(G + roff + bj * 128);
                        v0[0] = bflo(gw.x) * sigmoid_f(v0[0]); v0[1] = bfhi(gw.x) * sigmoid_f(v0[1]); v0[2] = bflo(gw.y) * sigmoid_f(v0[2]); v0[3] = bfhi(gw.y) * sigmoid_f(v0[3]);
                        v1[0] = bflo(gw.z) * sigmoid_f(v1[0]); v1[1] = bfhi(gw.z) * sigmoid_f(v1[1]); v1[2] = bflo(gw.w) * sigmoid_f(v1[2]); v1[3] = bfhi(gw.w) * sigmoid_f(v1[3]);
                    }
                    v4u w; w.x = pk2(v0[0], v0[1]); w.y = pk2(v0[2], v0[3]); w.z = pk2(v1[0], v1[1]); w.w = pk2(v1[2], v1[3]);
                    *(v4u*)(O + roff + bj * 128) = w;
                }
            }
    }
};
struct EpiResid {
    static constexpr bool PERM = false, AFTER_DRAIN = false;
    const float* H; float* R;
    __device__ __forceinline__ void operator()(const pg8::f32x4 (&acc)[2][2][4][2], const pg8::Unit& u, int wr, int wc, int fr_, int fq_) const {
        int fr = fr_, fq = fq_; asm volatile("" : "+v"(fr), "+v"(fq));
        const int row0 = u.pm * 256 + wr * 64 + fr, col0 = u.pn * 256 + wc * 32 + 4 * fq;
#pragma unroll
        for (int ai = 0; ai < 2; ++ai)
#pragma unroll
            for (int m = 0; m < 4; ++m) {
                const size_t roff = (size_t)(row0 + ai * 128 + m * 16) * D + col0;
#pragma unroll
                for (int bj = 0; bj < 2; ++bj)
#pragma unroll
                    for (int n = 0; n < 2; ++n) {
                        const f32x4 hv = *(const f32x4*)(H + roff + bj * 128 + n * 16);
                        *(f32x4*)(R + roff + bj * 128 + n * 16) = hv * ALPHA + acc[ai][bj][m][n];
                    }
            }
    }
};
struct EpiSsdProj {
    static constexpr bool PERM = true, AFTER_DRAIN = false;
    bf16* Z; bf16* XBC; float* DT;
    __device__ __forceinline__ void operator()(const pg8::f32x4 (&acc)[2][2][4][2], const pg8::Unit& u, int wr, int wc, int fr_, int fq_) const {
        int fr = fr_, fq = fq_; asm volatile("" : "+v"(fr), "+v"(fq));
        const int row0 = u.pm * 256 + wr * 64 + fr, col0 = u.pn * 256 + wc * 32 + 8 * fq;
#pragma unroll
        for (int ai = 0; ai < 2; ++ai)
#pragma unroll
            for (int m = 0; m < 4; ++m) {
                const size_t row = (size_t)(row0 + ai * 128 + m * 16);
#pragma unroll
                for (int bj = 0; bj < 2; ++bj) {
                    const f32x4 v0 = acc[ai][bj][m][0], v1 = acc[ai][bj][m][1];
                    const int col = col0 + bj * 128;
                    if (u.pn < 20) {
                        v4u w; w.x = pk2(v0[0], v0[1]); w.y = pk2(v0[2], v0[3]); w.z = pk2(v1[0], v1[1]); w.w = pk2(v1[2], v1[3]);
                        if (u.pn < 8) *(v4u*)(Z + row * 2048 + col) = w; else *(v4u*)(XBC + row * CONVD + (col - 2048)) = w;
                    } else if (col - 5120 < 32) {
                        *(f32x4*)(DT + row * 32 + (col - 5120)) = v0; *(f32x4*)(DT + row * 32 + (col - 5120) + 4) = v1;
                    }
                }
            }
    }
};

struct Ctx {
    const float* const* in; float* out; unsigned char* ws; LAS unsigned char* lds;
    int tid, lane, wave, gw, NGW, gt, NGT, bid, nblk;
    int z;
    template <class Tp> __device__ __forceinline__ Tp* W(size_t off) const { return (Tp*)(ws + (off + (size_t)(unsigned)z)); }
};

template <class Epi> __device__ __forceinline__ void run_gemm(const Ctx& c, const bf16* A, int lda, int a_pn_off, const bf16* Bt, int N, int K, const Epi& E) {
    pg8::Gemm g{A, Bt, T, N, K, lda, a_pn_off};
    pg8::StaticOrder S; S.init(T, N, c.nblk, c.bid);
    for (int r = 0; r < PR_GEMM; ++r) pg8::gemm_phase<Epi, pg8::StaticOrder, true, true>(c.lds, g, S, E, c.tid);
}

__device__ __forceinline__ void transpose_item(const float* __restrict__ Wm, int K, int N, bf16* WT, LAS float* scr, int item, int lane) {
    const int nblk = N / 32, kb = item / nblk, nb = item % nblk, k0 = 64 * kb, n0 = 32 * nb;
#pragma unroll 8
    for (int i = 0; i < 32; ++i) { const int kk = 2 * i + (lane >> 5); scr[kk * 33 + (lane & 31)] = Wm[(size_t)(k0 + kk) * N + n0 + (lane & 31)]; }
    asm volatile("s_waitcnt lgkmcnt(0)" ::: "memory");
    const int cc = lane & 7;
#pragma unroll
    for (int j = 0; j < 4; ++j) {
        const int n = (lane >> 3) + 8 * j; const LAS float* s = scr + (8 * cc) * 33 + n;
        v4u o; o.x = pk2(s[0 * 33], s[1 * 33]); o.y = pk2(s[2 * 33], s[3 * 33]); o.z = pk2(s[4 * 33], s[5 * 33]); o.w = pk2(s[6 * 33], s[7 * 33]);
        *(v4u*)(WT + (size_t)(n0 + n) * K + k0 + 8 * cc) = o;
    }
    asm volatile("s_waitcnt lgkmcnt(0)" ::: "memory");
}
__device__ __forceinline__ void transpose_mat(const Ctx& c, const float* Wm, int K, int N, bf16* WT) {
    LAS float* scr = (LAS float*)(c.lds + c.wave * 16384);
    const int nitems = (K / 64) * (N / 32);
    for (int it = c.gw; it < nitems; it += c.NGW) transpose_item(Wm, K, N, WT, scr, it, c.lane);
}
__device__ __forceinline__ void cvt_copy(const Ctx& c, const float* __restrict__ src, bf16* dst, size_t n) {
    for (size_t i = (size_t)c.gt * 8; i < n; i += (size_t)c.NGT * 8) {
        const f32x4 a = *(const f32x4*)(src + i), b = *(const f32x4*)(src + i + 4);
        v4u w; w.x = pk2(a[0], a[1]); w.y = pk2(a[2], a[3]); w.z = pk2(b[0], b[1]); w.w = pk2(b[2], b[3]);
        *(v4u*)(dst + i) = w;
    }
}
__device__ __forceinline__ float wave_max(float v, int lane) {
#pragma unroll
    for (int o = 32; o >= 1; o >>= 1) v = fmaxf(v, shx(v, o, lane));
    return v;
}
__device__ __forceinline__ void cvt_tables(const Ctx& c, int layer) {
    float* sm = c.W<float>(WS_SMALL);
    for (int r = c.gw; r < 2 * 16384; r += c.NGW) {
        const int tb = r >> 14, row = r & 16383;
        const float* src = c.in[c.z + 44 + tb] + ((size_t)layer * 16384 + row) * D + 16 * c.lane;
        f32x4 v[4];
#pragma unroll
        for (int k = 0; k < 4; ++k) v[k] = *(const f32x4*)(src + 4 * k);
        float m = 0.f;
#pragma unroll
        for (int k = 0; k < 4; ++k) m = fmaxf(fmaxf(fmaxf(fabsf(v[k][0]), fabsf(v[k][1])), fmaxf(fabsf(v[k][2]), fabsf(v[k][3]))), m);
        m = fmaxf(wave_max(m, c.lane), 1e-30f);
        const int ex = (int)((__builtin_bit_cast(unsigned, m) >> 23) & 0xffu) - 127;
        const float sc = __builtin_bit_cast(float, (unsigned)(127 + 7 - ex) << 23);
        const float isc = __builtin_bit_cast(float, (unsigned)(127 - 7 + ex) << 23);
        v4u o;
        { int p = __builtin_amdgcn_cvt_pk_fp8_f32(v[0][0] * sc, v[0][1] * sc, 0, false); p = __builtin_amdgcn_cvt_pk_fp8_f32(v[0][2] * sc, v[0][3] * sc, p, true); o.x = (unsigned)p; }
        { int p = __builtin_amdgcn_cvt_pk_fp8_f32(v[1][0] * sc, v[1][1] * sc, 0, false); p = __builtin_amdgcn_cvt_pk_fp8_f32(v[1][2] * sc, v[1][3] * sc, p, true); o.y = (unsigned)p; }
        { int p = __builtin_amdgcn_cvt_pk_fp8_f32(v[2][0] * sc, v[2][1] * sc, 0, false); p = __builtin_amdgcn_cvt_pk_fp8_f32(v[2][2] * sc, v[2][3] * sc, p, true); o.z = (unsigned)p; }
        { int p = __builtin_amdgcn_cvt_pk_fp8_f32(v[3][0] * sc, v[3][1] * sc, 0, false); p = __builtin_amdgcn_cvt_pk_fp8_f32(v[3][2] * sc, v[3][3] * sc, p, true); o.w = (unsigned)p; }
        *(v4u*)(c.ws + (tb ? WS_EV : WS_EU) + (size_t)row * D + 16 * c.lane) = o;
        if (c.lane == 0) sm[(tb ? SM_ISV : SM_ISU) + row] = isc;
    }
}
__device__ __forceinline__ void prologue(const Ctx& c) {
    transpose_mat(c, c.in[c.z + 7], 1024, 1024, c.W<bf16>(WS_W_S5IN));
    transpose_mat(c, c.in[c.z + 16], 1024, 1024, c.W<bf16>(WS_W_S5GLU));
    transpose_mat(c, c.in[c.z + 18], 1024, 1024, c.W<bf16>(WS_W_S5OUT));
    transpose_mat(c, c.in[c.z + 19], 1024, 1024, c.W<bf16>(WS_W_PIN));
    for (int g = 0; g < 4; ++g) transpose_mat(c, c.in[c.z + 20] + (size_t)g * 65536, 256, 256, c.W<bf16>(WS_W_PGRP) + (size_t)g * 65536);
    transpose_mat(c, c.in[c.z + 22], 1024, 1024, c.W<bf16>(WS_W_POUT));
    transpose_mat(c, c.in[c.z + 23], 1024, 2048, c.W<bf16>(WS_W_CIN));
    transpose_mat(c, c.in[c.z + 29], 1024, 1024, c.W<bf16>(WS_W_COUT));
    transpose_mat(c, c.in[c.z + 30], 1024, 5152, c.W<bf16>(WS_W_SIN));
    transpose_mat(c, c.in[c.z + 37], 2048, 1024, c.W<bf16>(WS_W_SOUT));
    for (int l = 0; l < 4; ++l) transpose_mat(c, c.in[c.z + 42] + (size_t)l * 1024 * 2048, 1024, 2048, c.W<bf16>(WS_W_PQ) + (size_t)l * 2048 * 1024);
    {
        v4u* z = (v4u*)(c.W<bf16>(WS_W_SIN) + (size_t)5152 * 1024);
        for (int i = c.gt; i < 224 * 1024 / 8; i += c.NGT) z[i] = (v4u){0u, 0u, 0u, 0u};
    }
    cvt_copy(c, c.in[c.z + 43], c.W<bf16>(WS_KEYS), (size_t)4 * 8 * 2 * 128 * 128);
    {
        float* H = c.W<float>(WS_H32); bf16* HB = c.W<bf16>(WS_HB);
        for (size_t i = (size_t)c.gt * 8; i < (size_t)T * D; i += (size_t)c.NGT * 8) {
            const float* src = (i < (size_t)TP * D) ? (c.in[c.z + 0] + i) : (c.in[c.z + 1] + (i - (size_t)TP * D));
            const f32x4 a = *(const f32x4*)(src), b = *(const f32x4*)(src + 4);
            *(f32x4*)(H + i) = a; *(f32x4*)(H + i + 4) = b;
            v4u w; w.x = pk2(a[0], a[1]); w.y = pk2(a[2], a[3]); w.z = pk2(b[0], b[1]); w.w = pk2(b[2], b[3]);
            *(v4u*)(HB + i) = w;
        }
    }
    if (c.gt < 4096) {
        const int gp = c.gt, g = gp >> 6;
        float* sm = c.W<float>(WS_SMALL);
        const float dt = expf(c.in[c.z + 10][g]);
        const float lr = c.in[c.z + 8][gp], li = c.in[c.z + 9][gp];
        const float mag = expf(lr * dt);
        const float br = mag * cosf(li * dt), bi = mag * sinf(li * dt);
        const float den = lr * lr + li * li;
        const float fr = ((br - 1.f) * lr + bi * li) / den, fi = (bi * lr - (br - 1.f) * li) / den;
        sm[SM_LBR + gp] = br; sm[SM_LBI + gp] = bi;
        for (int i = 0; i < 16; ++i) {
            const float xr = c.in[c.z + 11][gp * 16 + i], xi = c.in[c.z + 12][gp * 16 + i];
            sm[SM_BBR + gp * 16 + i] = fr * xr - fi * xi; sm[SM_BBI + gp * 16 + i] = fr * xi + fi * xr;
        }
    }
    cvt_tables(c, 0);
}

__device__ __forceinline__ void ln_row_store(const f32x4 (&v)[4], float mean, float rstd, const float* __restrict__ g, const float* __restrict__ b, float* o32, bf16* ob, int lane) {
#pragma unroll
    for (int h = 0; h < 2; ++h) {
        const int c0 = h * 512 + 8 * lane;
        const f32x4 g0 = *(const f32x4*)(g + c0), g1 = *(const f32x4*)(g + c0 + 4), b0 = *(const f32x4*)(b + c0), b1 = *(const f32x4*)(b + c0 + 4);
        const f32x4 o0 = (v[2 * h] - mean) * rstd * g0 + b0, o1 = (v[2 * h + 1] - mean) * rstd * g1 + b1;
        *(f32x4*)(o32 + c0) = o0; *(f32x4*)(o32 + c0 + 4) = o1;
        if (ob) { v4u w; w.x = pk2(o0[0], o0[1]); w.y = pk2(o0[2], o0[3]); w.z = pk2(o1[0], o1[1]); w.w = pk2(o1[2], o1[3]); *(v4u*)(ob + c0) = w; }
    }
}
__device__ __forceinline__ void ln_stats(const f32x4 (&v)[4], float& mean, float& rstd, int lane) {
    float s = 0.f;
#pragma unroll
    for (int k = 0; k < 4; ++k) s += (v[k][0] + v[k][1]) + (v[k][2] + v[k][3]);
    mean = wave_sum(s, lane) * (1.f / D);
    float q = 0.f;
#pragma unroll
    for (int k = 0; k < 4; ++k) { const f32x4 d = v[k] - mean; q += (d[0] * d[0] + d[1] * d[1]) + (d[2] * d[2] + d[3] * d[3]); }
    rstd = rsqrtf(wave_sum(q, lane) * (1.f / D) + LN_EPS);
}
__device__ __forceinline__ void phase_ln1(const Ctx& c, int layer) {
    const float* R = c.W<float>(WS_R32); float* H = c.W<float>(WS_H32); bf16* HB = c.W<bf16>(WS_HB);
    const float* g = c.in[c.z + 38] + layer * D; const float* b = c.in[c.z + 39] + layer * D;
    for (int t = c.gw; t < T; t += c.NGW) {
        f32x4 v[4];
#pragma unroll
        for (int h = 0; h < 2; ++h) { v[2 * h] = *(const f32x4*)(R + (size_t)t * D + h * 512 + 8 * c.lane); v[2 * h + 1] = *(const f32x4*)(R + (size_t)t * D + h * 512 + 8 * c.lane + 4); }
        float mean, rstd; ln_stats(v, mean, rstd, c.lane);
        ln_row_store(v, mean, rstd, g, b, H + (size_t)t * D, HB + (size_t)t * D, c.lane);
    }
}

__device__ __forceinline__ bf16x8 mk8(float a0, float a1, float a2, float a3, float a4, float a5, float a6, float a7) {
    v4u w; w.x = pk2(a0, a1); w.y = pk2(a2, a3); w.z = pk2(a4, a5); w.w = pk2(a6, a7); return __builtin_bit_cast(bf16x8, w);
}
constexpr int S5_BU_LD = 132  , S5_H_LD = 136  , S5_WAVE_BYTES = 16 * S5_BU_LD * 4 + 16 * S5_H_LD * 2;
__device__ __forceinline__ void phase_s5scan(const Ctx& c) {
    const bf16* U = c.W<bf16>(WS_A0); bf16* G = c.W<bf16>(WS_A1);
    const float* sm = c.W<float>(WS_SMALL);
    float* out = c.out;
    float* o_re_p = out + 17825792, *o_im_p = o_re_p + 32768, *o_re_s = out + 17825792 + 32768 * 2 + 122880 + 73728 + 2097152, *o_im_s = o_re_s + 524288;
    const int lane = c.lane, p = lane, fr = lane & 15, fq = lane >> 4;
    LAS float* BuT = (LAS float*)(c.lds + c.wave * S5_WAVE_BYTES);
    LAS bf16* Hi = (LAS bf16*)(c.lds + c.wave * S5_WAVE_BYTES + 16 * S5_BU_LD * 4);
    const int wslot = c.wave * c.nblk + c.bid;
    for (int unit = wslot; unit < 136 * 64; unit += c.NGW) {
        const int s = unit >> 6, g = unit & 63;
        int tok0, L; seq_info(s, tok0, L);
        bf16x8 Bf[8];
#pragma unroll
        for (int nt = 0; nt < 8; ++nt) {
            const int comp = 16 * nt + fr;
            const float* src = sm + ((comp < 64) ? SM_BBR : SM_BBI) + (size_t)(g * 64 + (comp & 63)) * 16 + 8 * (fq & 1);
            const f32x4 a = *(const f32x4*)src, b = *(const f32x4*)(src + 4);
            const bf16x8 v = mk8(a[0], a[1], a[2], a[3], b[0], b[1], b[2], b[3]);
            Bf[nt] = (fq < 2) ? v : (bf16x8){0, 0, 0, 0, 0, 0, 0, 0};
        }
        bf16x8 Cf[4];
#pragma unroll
        for (int ks = 0; ks < 4; ++ks) {
            const int comp0 = 32 * ks + 8 * fq;
            const float* src = ((ks < 2) ? c.in[c.z + 13] : c.in[c.z + 14]) + (size_t)(g * 16 + fr) * 64 + (comp0 & 63);
            const f32x4 a = *(const f32x4*)src, b = *(const f32x4*)(src + 4);
            const float sg = (ks < 2) ? 1.f : -1.f;
            Cf[ks] = mk8(sg * a[0], sg * a[1], sg * a[2], sg * a[3], sg * b[0], sg * b[1], sg * b[2], sg * b[3]);
        }
        const float lr = sm[SM_LBR + g * 64 + p], li = sm[SM_LBI + g * 64 + p];
        float hr = 0.f, hi = 0.f;
        if (s >= 8) { hr = c.in[c.z + 2][((s - 8) * 64 + g) * 64 + p]; hi = c.in[c.z + 3][((s - 8) * 64 + g) * 64 + p]; }
        const f32x4 dk4 = *(const f32x4*)(c.in[c.z + 15] + g * 16 + 4 * fq);
        const int ntile = (L + 15) >> 4;
        for (int tile = 0; tile < ntile; ++tile) {
            const int tb = tok0 + tile * 16;
            const bool valid = (tile * 16 + fr) < L;
            bf16x8 uf = {0, 0, 0, 0, 0, 0, 0, 0};
            if (fq < 2 && valid) uf = *(const bf16x8*)(U + (size_t)(tb + fr) * D + g * 16 + 8 * fq);
#pragma unroll
            for (int nt = 0; nt < 8; ++nt) {
                f32x4 acc = {0.f, 0.f, 0.f, 0.f};
                acc = __builtin_amdgcn_mfma_f32_16x16x32_bf16(Bf[nt], uf, acc, 0, 0, 0);
                *(LAS f32x4*)(BuT + fr * S5_BU_LD + 16 * nt + 4 * fq) = acc;
            }
            asm volatile("s_waitcnt lgkmcnt(0)" ::: "memory");
            const int nsteps = min(16, L - tile * 16);
#pragma unroll
            for (int t = 0; t < 16; ++t) {
                const float br = BuT[t * S5_BU_LD + p], bi = BuT[t * S5_BU_LD + 64 + p];
                const float nr = lr * hr - li * hi + br, ni = lr * hi + li * hr + bi;
                if (t < nsteps) { hr = nr; hi = ni; }
                Hi[t * S5_H_LD + p] = (bf16)f2bf(hr); Hi[t * S5_H_LD + 64 + p] = (bf16)f2bf(hi);
            }
            asm volatile("s_waitcnt lgkmcnt(0)" ::: "memory");
            f32x4 y = {0.f, 0.f, 0.f, 0.f};
#pragma unroll
            for (int ks = 0; ks < 4; ++ks) {
                const bf16x8 hf = *(const LAS bf16x8*)(Hi + fr * S5_H_LD + 32 * ks + 8 * fq);
                y = __builtin_amdgcn_mfma_f32_16x16x32_bf16(Cf[ks], hf, y, 0, 0, 0);
            }
            if (valid) {
                const v2u uq = *(const v2u*)(U + (size_t)(tb + fr) * D + g * 16 + 4 * fq);
                v2u o; o.x = pk2(gelu_f(y[0] + dk4[0] * bflo(uq.x)), gelu_f(y[1] + dk4[1] * bfhi(uq.x))); o.y = pk2(gelu_f(y[2] + dk4[2] * bflo(uq.y)), gelu_f(y[3] + dk4[3] * bfhi(uq.y)));
                *(v2u*)(G + (size_t)(tb + fr) * D + g * 16 + 4 * fq) = o;
            }
            asm volatile("" ::: "memory");
        }
        if (s < 8) { o_re_p[(s * 64 + g) * 64 + p] = hr; o_im_p[(s * 64 + g) * 64 + p] = hi; }
        else { o_re_s[((s - 8) * 64 + g) * 64 + p] = hr; o_im_s[((s - 8) * 64 + g) * 64 + p] = hi; }
    }
}

__device__ __forceinline__ void phase_pool(const Ctx& c) {
    const bf16* U = c.W<bf16>(WS_A0); bf16* P = c.W<bf16>(WS_A1);
    float* o_p = c.out + 17825792 + 65536, *o_s = c.out + 17825792 + 65536 + 122880 + 73728 + 2097152 + 1048576;
    for (size_t i = (size_t)c.gt; i < (size_t)T * 128; i += (size_t)c.NGT) {
        const int t = (int)(i >> 7), c0 = (int)(i & 127) * 8;
        int s, l, tok0; tok_info(t, s, l, tok0);
        const int w = 2 << (c0 >> 8);
        float sum[8];
#pragma unroll
        for (int j = 0; j < 8; ++j) sum[j] = 0.f;
        float cur[8];
        for (int k = 0; k < w; ++k) {
            const int ll = l - k;
            if (ll >= 0) {
                const v4u q = *(const v4u*)(U + (size_t)(tok0 + ll) * D + c0);
                const float f[8] = {bflo(q.x), bfhi(q.x), bflo(q.y), bfhi(q.y), bflo(q.z), bfhi(q.z), bflo(q.w), bfhi(q.w)};
#pragma unroll
                for (int j = 0; j < 8; ++j) { sum[j] += f[j]; if (k == 0) cur[j] = f[j]; }
            } else if (s >= 8) {
                const float* sp = c.in[c.z + 4] + ((size_t)(s - 8) * 15 + (15 + ll)) * D + c0;
                const f32x4 a = *(const f32x4*)sp, b = *(const f32x4*)(sp + 4);
                sum[0] += a[0]; sum[1] += a[1]; sum[2] += a[2]; sum[3] += a[3]; sum[4] += b[0]; sum[5] += b[1]; sum[6] += b[2]; sum[7] += b[3];
            }
        }
        const int pos = (s >= 8 ? 16384 : 0) + l;
        const float inv = 1.f / (float)min(pos + 1, w);
        v4u o; o.x = pk2(sum[0] * inv - cur[0], sum[1] * inv - cur[1]); o.y = pk2(sum[2] * inv - cur[2], sum[3] * inv - cur[3]);
        o.z = pk2(sum[4] * inv - cur[4], sum[5] * inv - cur[5]); o.w = pk2(sum[6] * inv - cur[6], sum[7] * inv - cur[7]);
        *(v4u*)(P + (size_t)t * D + c0) = o;
    }
    for (size_t i = (size_t)c.gt; i < (size_t)136 * 15 * D; i += (size_t)c.NGT) {
        const int ch = (int)(i & 1023); const int j = (int)((i >> 10) % 15); const int s = (int)(i / (15 * 1024));
        if (s < 8) o_p[((size_t)s * 15 + j) * D + ch] = bf2f(U[(size_t)(s * 2048 + 2033 + j) * D + ch]);
        else { const int b = s - 8; o_s[((size_t)b * 15 + j) * D + ch] = (j < 7) ? c.in[c.z + 4][((size_t)b * 15 + 8 + j) * D + ch] : bf2f(U[(size_t)(TP + b * 8 + (j - 7)) * D + ch]); }
    }
}

__device__ __forceinline__ void phase_cmlp_ln(const Ctx& c) {
    bf16* Z = c.W<bf16>(WS_Q);
    float* o_v = c.out + 17825792 + 65536 + 122880 + 73728 + 2097152 + 1048576 + 1966080;
    const float* g = c.in[c.z + 25]; const float* b = c.in[c.z + 26];
    for (int t = c.gw; t < T; t += c.NGW) {
        bf16* vr = Z + (size_t)t * 2048 + 1024;
        f32x4 v[4];
#pragma unroll
        for (int h = 0; h < 2; ++h) {
            const v4u q = *(const v4u*)(vr + h * 512 + 8 * c.lane);
            v[2 * h] = (f32x4){bflo(q.x), bfhi(q.x), bflo(q.y), bfhi(q.y)}; v[2 * h + 1] = (f32x4){bflo(q.z), bfhi(q.z), bflo(q.w), bfhi(q.w)};
        }
        float mean, rstd; ln_stats(v, mean, rstd, c.lane);
#pragma unroll
        for (int h = 0; h < 2; ++h) {
            const int c0 = h * 512 + 8 * c.lane;
            const f32x4 g0 = *(const f32x4*)(g + c0), g1 = *(const f32x4*)(g + c0 + 4), b0 = *(const f32x4*)(b + c0), b1 = *(const f32x4*)(b + c0 + 4);
            const f32x4 o0 = (v[2 * h] - mean) * rstd * g0 + b0, o1 = (v[2 * h + 1] - mean) * rstd * g1 + b1;
            v4u w; w.x = pk2(o0[0], o0[1]); w.y = pk2(o0[2], o0[3]); w.z = pk2(o1[0], o1[1]); w.w = pk2(o1[2], o1[3]);
            *(v4u*)(vr + c0) = w;
            if (t >= TP) { *(f32x4*)(o_v + (size_t)(t - TP) * D + c0) = o0; *(f32x4*)(o_v + (size_t)(t - TP) * D + c0 + 4) = o1; }
        }
    }
}
constexpr int CM_LD = 136, CM_WS = 0  , CM_VT = 34816  ;
__device__ __forceinline__ void phase_cmlp_mix(const Ctx& c) {
    const bf16* Z = c.W<bf16>(WS_Q); bf16* O = c.W<bf16>(WS_A1);
    LAS unsigned char* lds = c.lds;
    const int tid = c.tid, lane = c.lane, w = c.wave, fr = lane & 15, fq = lane >> 4;
    for (int unit = c.bid; unit < 128 * 4; unit += c.nblk) {
        const int chunk = unit >> 2, hd = unit & 3, tokc = chunk * 128;
#pragma unroll
        for (int k = 0; k < 4; ++k) {
            const int q = tid + 512 * k, row = q >> 4, cc = q & 15;
            const float* src = c.in[c.z + 27] + ((size_t)hd * 128 + row) * 128 + cc * 8;
            const f32x4 a = *(const f32x4*)src, b = *(const f32x4*)(src + 4);
            float f[8] = {a[0], a[1], a[2], a[3], b[0], b[1], b[2], b[3]};
#pragma unroll
            for (int j = 0; j < 8; ++j) f[j] = (cc * 8 + j <= row) ? f[j] : 0.f;
            v4u o; o.x = pk2(f[0], f[1]); o.y = pk2(f[2], f[3]); o.z = pk2(f[4], f[5]); o.w = pk2(f[6], f[7]);
            *(LAS v4u*)(lds + CM_WS + (row * CM_LD + cc * 8) * 2) = o;
        }
        {
            const int srow = tid & 127, dq = tid >> 7;
            const bf16* vs = Z + (size_t)(tokc + srow) * 2048 + 1024 + hd * 256 + dq * 64;
#pragma unroll
            for (int k = 0; k < 8; ++k) {
                const v4u q = *(const v4u*)(vs + 8 * k);
                const unsigned xw[4] = {q.x, q.y, q.z, q.w};
#pragma unroll
                for (int j = 0; j < 4; ++j) {
                    *(LAS bf16*)(lds + CM_VT + ((dq * 64 + 8 * k + 2 * j) * CM_LD + srow) * 2) = (bf16)(xw[j] & 0xffffu);
                    *(LAS bf16*)(lds + CM_VT + ((dq * 64 + 8 * k + 2 * j + 1) * CM_LD + srow) * 2) = (bf16)(xw[j] >> 16);
                }
            }
        }
        __syncthreads();
        f32x4 acc[16];
#pragma unroll
        for (int jd = 0; jd < 16; ++jd) acc[jd] = (f32x4){0.f, 0.f, 0.f, 0.f};
#pragma unroll
        for (int ks = 0; ks < 4; ++ks) {
            if (ks <= (w >> 1)) {
                const bf16x8 wf = *(const LAS bf16x8*)(lds + CM_WS + ((16 * w + fr) * CM_LD + ks * 32 + 8 * fq) * 2);
#pragma unroll
                for (int jd = 0; jd < 16; ++jd)
                    acc[jd] = __builtin_amdgcn_mfma_f32_16x16x32_bf16(*(const LAS bf16x8*)(lds + CM_VT + ((16 * jd + fr) * CM_LD + ks * 32 + 8 * fq) * 2), wf, acc[jd], 0, 0, 0);
            }
        }
        {
            const int t = 16 * w + fr; const size_t tok = (size_t)(tokc + t);
            const float bs = c.in[c.z + 28][hd * 128 + t];
#pragma unroll
            for (int jd = 0; jd < 16; ++jd) {
                const v2u uq = *(const v2u*)(Z + tok * 2048 + hd * 256 + 16 * jd + 4 * fq);
                v2u o; o.x = pk2(bflo(uq.x) * (acc[jd][0] + bs), bfhi(uq.x) * (acc[jd][1] + bs)); o.y = pk2(bflo(uq.y) * (acc[jd][2] + bs), bfhi(uq.y) * (acc[jd][3] + bs));
                *(v2u*)(O + tok * D + hd * 256 + 16 * jd + 4 * fq) = o;
            }
        }
        __syncthreads();
    }
    for (size_t i = (size_t)c.gt; i < (size_t)(T - TP) * 128; i += (size_t)c.NGT) {
        const int t = TP + (int)(i >> 7), c0 = (int)(i & 127) * 8;
        const int hd = c0 >> 8, tp = (t - TP) & 7, base = t - tp;
        float acc[8];
        const float bs = c.in[c.z + 28][hd * 128 + tp];
#pragma unroll
        for (int j = 0; j < 8; ++j) acc[j] = bs;
        const float* wr = c.in[c.z + 27] + ((size_t)hd * 128 + tp) * 128;
        for (int sp = 0; sp <= tp; ++sp) {
            const float wv = wr[sp];
            const v4u q = *(const v4u*)(Z + (size_t)(base + sp) * 2048 + 1024 + c0);
            acc[0] += wv * bflo(q.x); acc[1] += wv * bfhi(q.x); acc[2] += wv * bflo(q.y); acc[3] += wv * bfhi(q.y);
            acc[4] += wv * bflo(q.z); acc[5] += wv * bfhi(q.z); acc[6] += wv * bflo(q.w); acc[7] += wv * bfhi(q.w);
        }
        const v4u uq = *(const v4u*)(Z + (size_t)t * 2048 + c0);
        v4u o; o.x = pk2(bflo(uq.x) * acc[0], bfhi(uq.x) * acc[1]); o.y = pk2(bflo(uq.y) * acc[2], bfhi(uq.y) * acc[3]);
        o.z = pk2(bflo(uq.z) * acc[4], bfhi(uq.z) * acc[5]); o.w = pk2(bflo(uq.w) * acc[6], bfhi(uq.w) * acc[7]);
        *(v4u*)(O + (size_t)t * D + c0) = o;
    }
}

__device__ __forceinline__ void phase_ssd_conv(const Ctx& c) {
    const bf16* X = c.W<bf16>(WS_XBC); bf16* XC = c.W<bf16>(WS_XC);
    float* o_p = c.out + 17825792 + 65536 + 122880, *o_s = c.out + 17825792 + 65536 + 122880 + 73728 + 2097152 + 1048576 + 1966080 + 1048576;
    for (size_t i = (size_t)c.gt; i < (size_t)T * (CONVD / 8); i += (size_t)c.NGT) {
        const int t = (int)(i / (CONVD / 8)), c0 = (int)(i % (CONVD / 8)) * 8;
        int s, l, tok0; tok_info(t, s, l, tok0);
        float acc[8];
        { const f32x4 a = *(const f32x4*)(c.in[c.z + 32] + c0), b = *(const f32x4*)(c.in[c.z + 32] + c0 + 4); acc[0] = a[0]; acc[1] = a[1]; acc[2] = a[2]; acc[3] = a[3]; acc[4] = b[0]; acc[5] = b[1]; acc[6] = b[2]; acc[7] = b[3]; }
#pragma unroll
        for (int k = 0; k < 4; ++k) {
            const int src = l + k - 3;
            float f[8];
            if (src >= 0) {
                const v4u q = *(const v4u*)(X + (size_t)(tok0 + src) * CONVD + c0);
                f[0] = bflo(q.x); f[1] = bfhi(q.x); f[2] = bflo(q.y); f[3] = bfhi(q.y); f[4] = bflo(q.z); f[5] = bfhi(q.z); f[6] = bflo(q.w); f[7] = bfhi(q.w);
            } else if (s >= 8) {
                const float* sp = c.in[c.z + 5] + ((size_t)(s - 8) * 3 + (l + k)) * CONVD + c0;
                const f32x4 a = *(const f32x4*)sp, b = *(const f32x4*)(sp + 4);
                f[0] = a[0]; f[1] = a[1]; f[2] = a[2]; f[3] = a[3]; f[4] = b[0]; f[5] = b[1]; f[6] = b[2]; f[7] = b[3];
            } else {
#pragma unroll
                for (int j = 0; j < 8; ++j) f[j] = 0.f;
            }
            const f32x4 wa = *(const f32x4*)(c.in[c.z + 31] + k * CONVD + c0), wb = *(const f32x4*)(c.in[c.z + 31] + k * CONVD + c0 + 4);
            acc[0] += f[0] * wa[0]; acc[1] += f[1] * wa[1]; acc[2] += f[2] * wa[2]; acc[3] += f[3] * wa[3];
            acc[4] += f[4] * wb[0]; acc[5] += f[5] * wb[1]; acc[6] += f[6] * wb[2]; acc[7] += f[7] * wb[3];
        }
        v4u o; o.x = pk2(silu_f(acc[0]), silu_f(acc[1])); o.y = pk2(silu_f(acc[2]), silu_f(acc[3])); o.z = pk2(silu_f(acc[4]), silu_f(acc[5])); o.w = pk2(silu_f(acc[6]), silu_f(acc[7]));
        *(v4u*)(XC + (size_t)t * CONVD + c0) = o;
    }
    for (size_t i = (size_t)c.gt; i < (size_t)136 * 3 * CONVD; i += (size_t)c.NGT) {
        const int ch = (int)(i % CONVD); const int j = (int)((i / CONVD) % 3); const int s = (int)(i / (3 * CONVD));
        if (s < 8) o_p[((size_t)s * 3 + j) * CONVD + ch] = bf2f(X[(size_t)(s * 2048 + 2045 + j) * CONVD + ch]);
        else { const int b = s - 8; o_s[((size_t)b * 3 + j) * CONVD + ch] = bf2f(X[(size_t)(TP + b * 8 + 5 + j) * CONVD + ch]); }
    }
}
constexpr int SD_LD = 136;
constexpr int SD_C = 0, SD_B = 34816, SD_BT = 69632, SD_XT = 104448, SD_HB = 121856, SD_VEC = 139264;
__device__ __forceinline__ float softplus_f(float x) { return (x > 20.f) ? x : log1pf(__expf(x)); }
__device__ __forceinline__ void phase_ssd_scan(const Ctx& c) {
    const bf16* XC = c.W<bf16>(WS_XC); const float* DT = c.W<float>(WS_DT); bf16* Y = c.W<bf16>(WS_Y);
    float* o_p = c.out + 17825792 + 65536 + 122880 + 73728;
    float* o_s = c.out + 17825792 + 65536 + 122880 + 73728 + 2097152 + 1048576 + 1966080 + 1048576 + 1179648;
    const int tid = c.tid, lane = c.lane, w = c.wave, fr = lane & 15, fq = lane >> 4;
    LAS unsigned char* lds = c.lds;
    LAS float* csv = (LAS float*)(lds + SD_VEC); LAS float* dtv = csv + 128;
#define SD_FRAG(img, row, ks) (*(const LAS bf16x8*)(lds + (img) + ((row) * SD_LD + (ks) * 32 + 8 * fq) * 2))
    for (int unit = c.bid; unit < 8 * 32; unit += c.nblk) {
        const int s = unit >> 5, hd = unit & 31, g = hd >> 3;
        const float a = -__expf(c.in[c.z + 34][hd]), dtb = c.in[c.z + 33][hd], dk = c.in[c.z + 35][hd];
        f32x4 hacc[4];
#pragma unroll
        for (int jp = 0; jp < 4; ++jp) hacc[jp] = (f32x4){0.f, 0.f, 0.f, 0.f};
        for (int ch = 0; ch < 16; ++ch) {
            const int tokc = s * 2048 + ch * 128;
            if (w == 0) {
                const float dt0 = softplus_f(DT[(size_t)(tokc + lane) * 32 + hd] + dtb), dt1 = softplus_f(DT[(size_t)(tokc + 64 + lane) * 32 + hd] + dtb);
                float s0 = dt0 * a, s1 = dt1 * a;
#pragma unroll
                for (int o = 1; o < 64; o <<= 1) {
                    const float u0 = __builtin_bit_cast(float, __builtin_amdgcn_ds_bpermute(((lane - o) & 63) << 2, __builtin_bit_cast(int, s0)));
                    const float u1 = __builtin_bit_cast(float, __builtin_amdgcn_ds_bpermute(((lane - o) & 63) << 2, __builtin_bit_cast(int, s1)));
                    if (lane >= o) { s0 += u0; s1 += u1; }
                }
                const float tot0 = __builtin_bit_cast(float, __builtin_amdgcn_readlane(__builtin_bit_cast(int, s0), 63));
                csv[lane] = s0; csv[64 + lane] = tot0 + s1; dtv[lane] = dt0; dtv[64 + lane] = dt1;
            }
#pragma unroll
            for (int k = 0; k < 4; ++k) {
                const int q = tid + 512 * k, row = q >> 4, cc = q & 15;
                const bf16* src = XC + (size_t)(tokc + row) * CONVD + g * 128 + cc * 8;
                *(LAS v4u*)(lds + SD_C + (row * SD_LD + cc * 8) * 2) = *(const v4u*)(src + 2560);
                *(LAS v4u*)(lds + SD_B + (row * SD_LD + cc * 8) * 2) = *(const v4u*)(src + 2048);
            }
#pragma unroll
            for (int jp = 0; jp < 4; ++jp) {
                v2u hq; hq.x = pk2(hacc[jp][0], hacc[jp][1]); hq.y = pk2(hacc[jp][2], hacc[jp][3]);
                *(LAS v2u*)(lds + SD_HB + ((16 * jp + fr) * SD_LD + 16 * w + 4 * fq) * 2) = hq;
            }
            __syncthreads();
            {
                const int srow = tid & 127, qq = tid >> 7;
                const float sc = __expf(csv[127] - csv[srow]) * dtv[srow];
#pragma unroll
                for (int k = 0; k < 4; ++k) {
                    const int n0 = qq * 32 + k * 8;
                    const v4u bq = *(const LAS v4u*)(lds + SD_B + (srow * SD_LD + n0) * 2);
                    const float f[8] = {bflo(bq.x), bfhi(bq.x), bflo(bq.y), bfhi(bq.y), bflo(bq.z), bfhi(bq.z), bflo(bq.w), bfhi(bq.w)};
#pragma unroll
                    for (int j = 0; j < 8; ++j) *(LAS bf16*)(lds + SD_BT + ((n0 + j) * SD_LD + srow) * 2) = (bf16)f2bf(f[j] * sc);
                }
                const bf16* xs = XC + (size_t)(tokc + srow) * CONVD + hd * 64 + qq * 16;
                const v4u x0 = *(const v4u*)xs, x1 = *(const v4u*)(xs + 8);
                const unsigned xw[8] = {x0.x, x0.y, x0.z, x0.w, x1.x, x1.y, x1.z, x1.w};
#pragma unroll
                for (int j = 0; j < 8; ++j) {
                    *(LAS bf16*)(lds + SD_XT + ((qq * 16 + 2 * j) * SD_LD + srow) * 2) = (bf16)(xw[j] & 0xffffu);
                    *(LAS bf16*)(lds + SD_XT + ((qq * 16 + 2 * j + 1) * SD_LD + srow) * 2) = (bf16)(xw[j] >> 16);
                }
            }
            __syncthreads();
            const int jmax = w | 1;
            bf16x8 Cf[4];
#pragma unroll
            for (int ks = 0; ks < 4; ++ks) Cf[ks] = SD_FRAG(SD_C, 16 * w + fr, ks);
            f32x4 acc[8];
#pragma unroll
            for (int j = 0; j < 8; ++j) {
                acc[j] = (f32x4){0.f, 0.f, 0.f, 0.f};
                if (j <= jmax) {
#pragma unroll
                    for (int ks = 0; ks < 4; ++ks) acc[j] = __builtin_amdgcn_mfma_f32_16x16x32_bf16(SD_FRAG(SD_B, 16 * j + fr, ks), Cf[ks], acc[j], 0, 0, 0);
                }
            }
            {
                const float cdec = __expf(csv[127]);
                bf16x8 Bt[4];
#pragma unroll
                for (int ks = 0; ks < 4; ++ks) Bt[ks] = SD_FRAG(SD_BT, 16 * w + fr, ks);
#pragma unroll
                for (int jp = 0; jp < 4; ++jp) {
                    hacc[jp] = hacc[jp] * cdec;
#pragma unroll
                    for (int ks = 0; ks < 4; ++ks) hacc[jp] = __builtin_amdgcn_mfma_f32_16x16x32_bf16(Bt[ks], SD_FRAG(SD_XT, 16 * jp + fr, ks), hacc[jp], 0, 0, 0);
                }
            }
            __syncthreads();
            {
                const int t = 16 * w + fr; const float cst = csv[t];
#pragma unroll
                for (int j = 0; j < 8; ++j) {
                    if (j <= jmax) {
                        const f32x4 css = *(const LAS f32x4*)(csv + 16 * j + 4 * fq), dts = *(const LAS f32x4*)(dtv + 16 * j + 4 * fq);
                        float v[4];
#pragma unroll
                        for (int r = 0; r < 4; ++r) v[r] = (16 * j + 4 * fq + r <= t) ? acc[j][r] * __expf(cst - css[r]) * dts[r] : 0.f;
                        v2u lq; lq.x = pk2(v[0], v[1]); lq.y = pk2(v[2], v[3]);
                        *(LAS v2u*)(lds + SD_B + (t * SD_LD + 16 * j + 4 * fq) * 2) = lq;
                    }
                }
            }
            __syncthreads();
            {
                f32x4 a1[4], a2[4];
#pragma unroll
                for (int jp = 0; jp < 4; ++jp) { a1[jp] = (f32x4){0.f, 0.f, 0.f, 0.f}; a2[jp] = (f32x4){0.f, 0.f, 0.f, 0.f}; }
#pragma unroll
                for (int ks = 0; ks < 4; ++ks) {
                    if (ks <= (w >> 1)) {
                        const bf16x8 Lf = SD_FRAG(SD_B, 16 * w + fr, ks);
#pragma unroll
                        for (int jp = 0; jp < 4; ++jp) a1[jp] = __builtin_amdgcn_mfma_f32_16x16x32_bf16(SD_FRAG(SD_XT, 16 * jp + fr, ks), Lf, a1[jp], 0, 0, 0);
                    }
#pragma unroll
                    for (int jp = 0; jp < 4; ++jp) a2[jp] = __builtin_amdgcn_mfma_f32_16x16x32_bf16(SD_FRAG(SD_HB, 16 * jp + fr, ks), Cf[ks], a2[jp], 0, 0, 0);
                }
                const int t = 16 * w + fr; const float ecs = __expf(csv[t]);
                const size_t tok = (size_t)(tokc + t);
#pragma unroll
                for (int jp = 0; jp < 4; ++jp) {
                    const v2u xq = *(const v2u*)(XC + tok * CONVD + hd * 64 + 16 * jp + 4 * fq);
                    v2u yo; yo.x = pk2(a1[jp][0] + ecs * a2[jp][0] + dk * bflo(xq.x), a1[jp][1] + ecs * a2[jp][1] + dk * bfhi(xq.x));
                    yo.y = pk2(a1[jp][2] + ecs * a2[jp][2] + dk * bflo(xq.y), a1[jp][3] + ecs * a2[jp][3] + dk * bfhi(xq.y));
                    *(v2u*)(Y + tok * 2048 + hd * 64 + 16 * jp + 4 * fq) = yo;
                }
            }
            __syncthreads();
        }
#pragma unroll
        for (int jp = 0; jp < 4; ++jp) *(f32x4*)(o_p + (((size_t)s * 32 + hd) * 64 + 16 * jp + fr) * 128 + 16 * w + 4 * fq) = hacc[jp];
    }
#undef SD_FRAG
    __syncthreads();
    {
        LAS float* Bw = (LAS float*)(lds + w * 8192);
        LAS float* Cw = Bw + 1024;
        for (int unit = c.gw; unit < 128 * 32; unit += c.NGW) {
            const int b = unit >> 5, hd = unit & 31, g = hd >> 3, tok0 = TP + b * 8, p = lane;
            const float a = -__expf(c.in[c.z + 34][hd]), dtb = c.in[c.z + 33][hd], dk = c.in[c.z + 35][hd];
            {
                const int tk = lane >> 3, c0 = (lane & 7) * 16;
                const bf16* src = XC + (size_t)(tok0 + tk) * CONVD + g * 128 + c0;
                const v4u b0 = *(const v4u*)(src + 2048), b1 = *(const v4u*)(src + 2048 + 8), c0v = *(const v4u*)(src + 2560), c1v = *(const v4u*)(src + 2560 + 8);
                LAS float* bd = Bw + tk * 128 + c0; LAS float* cd = Cw + tk * 128 + c0;
                *(LAS f32x4*)(bd) = (f32x4){bflo(b0.x), bfhi(b0.x), bflo(b0.y), bfhi(b0.y)}; *(LAS f32x4*)(bd + 4) = (f32x4){bflo(b0.z), bfhi(b0.z), bflo(b0.w), bfhi(b0.w)};
                *(LAS f32x4*)(bd + 8) = (f32x4){bflo(b1.x), bfhi(b1.x), bflo(b1.y), bfhi(b1.y)}; *(LAS f32x4*)(bd + 12) = (f32x4){bflo(b1.z), bfhi(b1.z), bflo(b1.w), bfhi(b1.w)};
                *(LAS f32x4*)(cd) = (f32x4){bflo(c0v.x), bfhi(c0v.x), bflo(c0v.y), bfhi(c0v.y)}; *(LAS f32x4*)(cd + 4) = (f32x4){bflo(c0v.z), bfhi(c0v.z), bflo(c0v.w), bfhi(c0v.w)};
                *(LAS f32x4*)(cd + 8) = (f32x4){bflo(c1v.x), bfhi(c1v.x), bflo(c1v.y), bfhi(c1v.y)}; *(LAS f32x4*)(cd + 12) = (f32x4){bflo(c1v.z), bfhi(c1v.z), bflo(c1v.w), bfhi(c1v.w)};
            }
            float xv[8], dA[8], coef[8], yv[8];
#pragma unroll
            for (int t = 0; t < 8; ++t) {
                xv[t] = bf2f(XC[(size_t)(tok0 + t) * CONVD + hd * 64 + p]);
                const float dtv_ = softplus_f(DT[(size_t)(tok0 + t) * 32 + hd] + dtb);
                dA[t] = __expf(dtv_ * a); coef[t] = dtv_ * xv[t]; yv[t] = dk * xv[t];
            }
            asm volatile("s_waitcnt lgkmcnt(0)" ::: "memory");
            const float* hin = c.in[c.z + 6] + (((size_t)b * 32 + hd) * 64 + p) * 128;
            float* hout = o_s + (((size_t)b * 32 + hd) * 64 + p) * 128;
#pragma unroll 1
            for (int qt = 0; qt < 4; ++qt) {
                float h[32];
#pragma unroll
                for (int i = 0; i < 8; ++i) { const f32x4 q = *(const f32x4*)(hin + qt * 32 + 4 * i); h[4 * i] = q[0]; h[4 * i + 1] = q[1]; h[4 * i + 2] = q[2]; h[4 * i + 3] = q[3]; }
#pragma unroll
                for (int t = 0; t < 8; ++t) {
                    float ya = 0.f, yb = 0.f;
#pragma unroll
                    for (int i = 0; i < 8; ++i) {
                        const f32x4 bq = *(const LAS f32x4*)(Bw + t * 128 + qt * 32 + 4 * i), cq = *(const LAS f32x4*)(Cw + t * 128 + qt * 32 + 4 * i);
                        h[4 * i] = h[4 * i] * dA[t] + coef[t] * bq[0]; ya += cq[0] * h[4 * i];
                        h[4 * i + 1] = h[4 * i + 1] * dA[t] + coef[t] * bq[1]; yb += cq[1] * h[4 * i + 1];
                        h[4 * i + 2] = h[4 * i + 2] * dA[t] + coef[t] * bq[2]; ya += cq[2] * h[4 * i + 2];
                        h[4 * i + 3] = h[4 * i + 3] * dA[t] + coef[t] * bq[3]; yb += cq[3] * h[4 * i + 3];
                    }
                    yv[t] += ya + yb;
                    asm volatile("" ::: "memory");
                }
#pragma unroll
                for (int i = 0; i < 8; ++i) *(f32x4*)(hout + qt * 32 + 4 * i) = (f32x4){h[4 * i], h[4 * i + 1], h[4 * i + 2], h[4 * i + 3]};
            }
#pragma unroll
            for (int t = 0; t < 8; ++t) Y[(size_t)(tok0 + t) * 2048 + hd * 64 + p] = (bf16)f2bf(yv[t]);
            asm volatile("" ::: "memory");
        }
    }
}
__device__ __forceinline__ void phase_ssd_gatenorm(const Ctx& c) {
    const bf16* Y = c.W<bf16>(WS_Y); const bf16* Z = c.W<bf16>(WS_Q); bf16* YN = c.W<bf16>(WS_YN);
    for (int it = c.gw; it < T * 4; it += c.NGW) {
        const int t = it >> 2, c0 = (it & 3) * 512 + 8 * c.lane;
        const v4u yq = *(const v4u*)(Y + (size_t)t * 2048 + c0), zq = *(const v4u*)(Z + (size_t)t * 2048 + c0);
        const float yf[8] = {bflo(yq.x), bfhi(yq.x), bflo(yq.y), bfhi(yq.y), bflo(yq.z), bfhi(yq.z), bflo(yq.w), bfhi(yq.w)};
        const float zf[8] = {bflo(zq.x), bfhi(zq.x), bflo(zq.y), bfhi(zq.y), bflo(zq.z), bfhi(zq.z), bflo(zq.w), bfhi(zq.w)};
        float v[8]; float q = 0.f;
#pragma unroll
        for (int j = 0; j < 8; ++j) { v[j] = yf[j] * silu_f(zf[j]); q += v[j] * v[j]; }
        const float r = rsqrtf(wave_sum(q, c.lane) * (1.f / 512.f) + RMS_EPS);
        const f32x4 g0 = *(const f32x4*)(c.in[c.z + 36] + c0), g1 = *(const f32x4*)(c.in[c.z + 36] + c0 + 4);
        v4u o; o.x = pk2(v[0] * r * g0[0], v[1] * r * g0[1]); o.y = pk2(v[2] * r * g0[2], v[3] * r * g0[3]); o.z = pk2(v[4] * r * g1[0], v[5] * r * g1[1]); o.w = pk2(v[6] * r * g1[2], v[7] * r * g1[3]);
        *(v4u*)(YN + (size_t)t * 2048 + c0) = o;
    }
}

__device__ __forceinline__ unsigned ord_key(float s) { const unsigned u = __builtin_bit_cast(unsigned, s); return (u & 0x80000000u) ? ~u : (u | 0x80000000u); }
__device__ __forceinline__ float ord_dec(unsigned k) { const unsigned u = (k & 0x80000000u) ? (k & 0x7fffffffu) : ~k; return __builtin_bit_cast(float, u); }
__device__ __forceinline__ void ins16(unsigned (&Lk)[16], unsigned x) {
#pragma unroll
    for (int k = 0; k < 16; ++k) { const unsigned hi = max(Lk[k], x); x = min(Lk[k], x); Lk[k] = hi; }
}
constexpr int RT_SC_LD = 260, RT_LIST_OFF = 128 * RT_SC_LD * 4;
__device__ __forceinline__ void phase_route(const Ctx& c, int layer) {
    const bf16* Q = c.W<bf16>(WS_Q); const bf16* KEYS = c.W<bf16>(WS_KEYS) + (size_t)layer * 8 * 2 * 128 * 128;
    int* IDX = c.W<int>(WS_IDX); float* GATE = c.W<float>(WS_GATE); float* SCU = c.W<float>(WS_SCU);
    const float* ISU = c.W<float>(WS_SMALL) + SM_ISU; const float* ISV = c.W<float>(WS_SMALL) + SM_ISV;
    LAS float* sc = (LAS float*)c.lds; LAS unsigned* lists = (LAS unsigned*)(c.lds + RT_LIST_OFF);
    const int fr = c.lane & 15, fq = c.lane >> 4;
    for (int task = c.bid; task < 136 * 8; task += c.nblk) {
        const int tt = task >> 3, h = task & 7, tok0 = tt * 128;
        {
            const bf16* qrow = Q + (size_t)(tok0 + 16 * c.wave + fr) * 2048 + h * 256 + 8 * fq;
#pragma unroll
            for (int side = 0; side < 2; ++side) {
                bf16x8 qf[4];
#pragma unroll
                for (int ks = 0; ks < 4; ++ks) qf[ks] = *(const bf16x8*)(qrow + side * 128 + ks * 32);
                const bf16* kb = KEYS + ((size_t)(h * 2 + side) * 128 + fr) * 128 + 8 * fq;
#pragma unroll
                for (int nt = 0; nt < 8; ++nt) {
                    f32x4 acc = {0.f, 0.f, 0.f, 0.f};
#pragma unroll
                    for (int ks = 0; ks < 4; ++ks) {
                        const bf16x8 kf = *(const bf16x8*)(kb + (size_t)nt * 16 * 128 + ks * 32);
                        acc = __builtin_amdgcn_mfma_f32_16x16x32_bf16(kf, qf[ks], acc, 0, 0, 0);
                    }
                    *(LAS f32x4*)(sc + (16 * c.wave + fr) * RT_SC_LD + side * 128 + nt * 16 + 4 * fq) = acc;
                }
            }
        }
        __syncthreads();
        if (c.tid < 256) {
            const int token = c.tid & 127, side = c.tid >> 7;
            unsigned Lk[16];
#pragma unroll
            for (int k = 0; k < 16; ++k) Lk[k] = 0u;
            const LAS float* row = sc + token * RT_SC_LD + side * 128;
            for (int n4 = 0; n4 < 32; ++n4) {
                const f32x4 v = *(const LAS f32x4*)(row + n4 * 4);
#pragma unroll
                for (int j = 0; j < 4; ++j) ins16(Lk, (ord_key(v[j]) & ~127u) | (unsigned)(127 - (n4 * 4 + j)));
            }
#pragma unroll
            for (int k = 0; k < 16; ++k) lists[(token * 2 + side) * 16 + k] = Lk[k];
        }
        __syncthreads();
        if (c.tid < 128) {
            const int token = c.tid;
            float s0[16], s1[16];
#pragma unroll
            for (int k = 0; k < 16; ++k) { s0[k] = ord_dec(lists[(token * 2) * 16 + k] & ~127u); s1[k] = ord_dec(lists[(token * 2 + 1) * 16 + k] & ~127u); }
            unsigned Bk[16];
#pragma unroll
            for (int k = 0; k < 16; ++k) Bk[k] = 0u;
#pragma unroll
            for (int i = 0; i < 16; ++i)
#pragma unroll
                for (int j = 0; j < 16; ++j)
                    if ((i + 1) * (j + 1) <= 16) ins16(Bk, (ord_key(s0[i] + s1[j]) & ~255u) | (unsigned)(255 - (i * 16 + j)));
            float e[16]; int id[16]; float mx = 0.f, den = 0.f;
#pragma unroll
            for (int k = 0; k < 16; ++k) {
                const int pay = 255 - (int)(Bk[k] & 255u), i = pay >> 4, j = pay & 15;
                const unsigned k0 = lists[(token * 2) * 16 + i], k1 = lists[(token * 2 + 1) * 16 + j];
                id[k] = (127 - (int)(k0 & 127u)) * 128 + (127 - (int)(k1 & 127u));
                const float sv = ord_dec(k0 & ~127u) + ord_dec(k1 & ~127u);
                if (k == 0) mx = sv;
                e[k] = __expf(sv - mx); den += e[k];
            }
            const float inv = 1.f / den;
            int* ip = IDX + (size_t)(tok0 + token) * 128 + h * 16; float* gp = GATE + (size_t)(tok0 + token) * 128 + h * 16; float* up = SCU + (size_t)(tok0 + token) * 128 + h * 16;
            float su[16];
#pragma unroll
            for (int k = 0; k < 16; ++k) { su[k] = ISU[id[k]]; e[k] *= inv * ISV[id[k]]; }
#pragma unroll
            for (int k = 0; k < 4; ++k) {
                *(int4*)(ip + 4 * k) = make_int4(id[4 * k], id[4 * k + 1], id[4 * k + 2], id[4 * k + 3]);
                *(f32x4*)(gp + 4 * k) = (f32x4){e[4 * k], e[4 * k + 1], e[4 * k + 2], e[4 * k + 3]};
                *(f32x4*)(up + 4 * k) = (f32x4){su[4 * k], su[4 * k + 1], su[4 * k + 2], su[4 * k + 3]};
            }
        }
        __syncthreads();
    }
}

typedef float f32x2 __attribute__((ext_vector_type(2)));
#define CVT8(wd, hi) __builtin_amdgcn_cvt_pk_f32_fp8((int)(wd), (hi))
__device__ __forceinline__ void phase_gather(const Ctx& c, int layer, bool dummy) {
    const unsigned char* EU = c.ws + WS_EU; const unsigned char* EV = c.ws + WS_EV;
    const int* IDX = c.W<int>(WS_IDX); const float* GATE = c.W<float>(WS_GATE); const float* SCU = c.W<float>(WS_SCU);
    const float* H = c.W<float>(WS_H32); float* Ho = dummy ? c.W<float>(WS_R32) : c.W<float>(WS_H32); bf16* HB = dummy ? c.W<bf16>(WS_A0) : c.W<bf16>(WS_HB);
    const float* g = c.in[c.z + 40] + layer * D; const float* b = c.in[c.z + 41] + layer * D;
    const int lane = c.lane;
    const int ntw = (T - c.gw + c.NGW - 1) / c.NGW, nit = ntw * 8;
#define GT_TOK(it) (c.gw + ((it) >> 3) * c.NGW)
#define GT_IDX(it) (((it) < nit) ? IDX[(size_t)GT_TOK(it) * 128 + ((it) & 7) * 16 + (lane & 15)] : 0)
#define GT_GS(P, it) ((P)[(size_t)GT_TOK((it) < nit ? (it) : 0) * 128 + ((it) & 7) * 16 + ((lane >> 2) & 15)])
    int idx_c = GT_IDX(0), idx_n = GT_IDX(1);
    float gate_c = GT_GS(GATE, 0), scu_c = GT_GS(SCU, 0);
    f32x2 x2[8], xn[8], acc[8];
#pragma unroll
    for (int k = 0; k < 4; ++k) { const f32x4 hx = *(const f32x4*)(H + (size_t)c.gw * D + 16 * lane + 4 * k); xn[2 * k] = (f32x2){hx[0], hx[1]}; xn[2 * k + 1] = (f32x2){hx[2], hx[3]}; }
    v4u ru[16], rv[16];
#pragma unroll
    for (int e = 0; e < 16; ++e) {
        const int id = __builtin_amdgcn_readlane(idx_c, e);
        ru[e] = *(const v4u*)(EU + (size_t)id * D + 16 * lane); rv[e] = *(const v4u*)(EV + (size_t)id * D + 16 * lane);
    }
    for (int it = 0; it < nit; ++it) {
        const int t = GT_TOK(it), bt = it & 7;
        const int idx_nn = GT_IDX(it + 2);
        const float gate_n = GT_GS(GATE, it + 1), scu_n = GT_GS(SCU, it + 1);
        const float mygate = gate_c, myscu = scu_c;
        if (bt == 0) {
#pragma unroll
            for (int i = 0; i < 8; ++i) { x2[i] = xn[i]; acc[i] = (f32x2){0.f, 0.f}; }
        }
        if (bt == 7 && it + 1 < nit) {
            const int tn = GT_TOK(it + 1);
#pragma unroll
            for (int k = 0; k < 4; ++k) { const f32x4 hx = *(const f32x4*)(H + (size_t)tn * D + 16 * lane + 4 * k); xn[2 * k] = (f32x2){hx[0], hx[1]}; xn[2 * k + 1] = (f32x2){hx[2], hx[3]}; }
        }
        float pv[16];
#pragma unroll
        for (int e = 0; e < 16; ++e) {
            const v4u w = ru[e];
            f32x2 d = CVT8(w.x, false) * x2[0];
            d += CVT8(w.x, true) * x2[1]; d += CVT8(w.y, false) * x2[2]; d += CVT8(w.y, true) * x2[3];
            d += CVT8(w.z, false) * x2[4]; d += CVT8(w.z, true) * x2[5]; d += CVT8(w.w, false) * x2[6]; d += CVT8(w.w, true) * x2[7];
            pv[e] = d.x + d.y;
            ru[e] = *(const v4u*)(EU + (size_t)__builtin_amdgcn_readlane(idx_n, e) * D + 16 * lane);
        }
        const float tot = reduce16(pv, lane);
        const float wgt = mygate * gelu_f(tot * myscu);
#pragma unroll
        for (int e = 0; e < 16; ++e) {
            const float we = __builtin_bit_cast(float, __builtin_amdgcn_readlane(__builtin_bit_cast(int, wgt), 4 * e));
            const v4u w = rv[e];
            acc[0] += CVT8(w.x, false) * we; acc[1] += CVT8(w.x, true) * we; acc[2] += CVT8(w.y, false) * we; acc[3] += CVT8(w.y, true) * we;
            acc[4] += CVT8(w.z, false) * we; acc[5] += CVT8(w.z, true) * we; acc[6] += CVT8(w.w, false) * we; acc[7] += CVT8(w.w, true) * we;
            rv[e] = *(const v4u*)(EV + (size_t)__builtin_amdgcn_readlane(idx_n, e) * D + 16 * lane);
        }
        if (bt == 7) {
            f32x4 v[4];
#pragma unroll
            for (int k = 0; k < 4; ++k) v[k] = (f32x4){x2[2 * k].x, x2[2 * k].y, x2[2 * k + 1].x, x2[2 * k + 1].y} * ALPHA + (f32x4){acc[2 * k].x, acc[2 * k].y, acc[2 * k + 1].x, acc[2 * k + 1].y};
            float mean, rstd; ln_stats(v, mean, rstd, lane);
            float* o32 = ((layer == 3 && !dummy) ? c.out : Ho) + (size_t)t * D + 16 * lane;
            bf16* ob = (layer == 3 && !dummy) ? (bf16*)nullptr : HB + (size_t)t * D + 16 * lane;
            v4u wb[2];
#pragma unroll
            for (int k = 0; k < 4; ++k) {
                const f32x4 g4 = *(const f32x4*)(g + 16 * lane + 4 * k), b4 = *(const f32x4*)(b + 16 * lane + 4 * k);
                const f32x4 o = (v[k] - mean) * rstd * g4 + b4;
                *(f32x4*)(o32 + 4 * k) = o;
                if (k & 1) { wb[k >> 1].z = pk2(o[0], o[1]); wb[k >> 1].w = pk2(o[2], o[3]); } else { wb[k >> 1].x = pk2(o[0], o[1]); wb[k >> 1].y = pk2(o[2], o[3]); }
            }
            if (ob) { *(v4u*)(ob) = wb[0]; *(v4u*)(ob + 8) = wb[1]; }
        }
        idx_c = idx_n; idx_n = idx_nn; gate_c = gate_n; scu_c = scu_n;
    }
#undef GT_GS
#undef GT_TOK
#undef GT_IDX
}

#define XB_TMO      128
#define XB_XCNT(j)  (256  + 64 * (j))
#define XB_XSUB(j)  (1280 + 64 * (j))
#define XB_XGEN(j)  (2304 + 64 * (j))
#define XB_TOP      3328
#define XB_TOPGEN   3392
#define XCD_BAR_WORDS 3456
#define XB_SPIN_CAP (1u << 22)
__device__ __forceinline__ unsigned xb_ld(unsigned* p)              { return __hip_atomic_load(p, __ATOMIC_RELAXED, __HIP_MEMORY_SCOPE_AGENT); }
__device__ __forceinline__ unsigned xb_add(unsigned* p, unsigned v) { return __hip_atomic_fetch_add(p, v, __ATOMIC_RELAXED, __HIP_MEMORY_SCOPE_AGENT); }
__device__ __forceinline__ unsigned xb_xcc_id() { return (unsigned)__builtin_amdgcn_s_getreg((3 << 11) | 20) & 0xFu; }
#define XB_SPIN(cond, bar) do { unsigned _sp = 0; while (cond) { __builtin_amdgcn_s_sleep(1); \
    if ((++_sp & 255u) == 0u) { if (xb_ld(&(bar)[XB_TMO])) break; if (_sp > XB_SPIN_CAP) { atomicAdd(&(bar)[XB_TMO], 1u); break; } } } } while (0)
struct XcdBarrier { unsigned* bar; unsigned x; volatile LAS unsigned* st; };
__device__ __forceinline__ XcdBarrier xcd_barrier_post(unsigned* bar, volatile LAS unsigned* st) {
    XcdBarrier b; b.bar = bar; b.x = xb_xcc_id(); b.st = st;
    if (threadIdx.x == 0) (void)xb_add(&bar[XB_XCNT(b.x)], 1u);
    return b;
}
__device__ __forceinline__ void xcd_barrier_complete(unsigned* bar, unsigned x, unsigned& nloc, unsigned& nx) {
    const unsigned G = gridDim.x * gridDim.y * gridDim.z;
    unsigned sum, cnt, mine, sp = 0u;
    for (;;) {
        sum = 0u; cnt = 0u; mine = 0u;
#pragma unroll
        for (unsigned j = 0; j < 16; ++j) { const unsigned cc = xb_ld(&bar[XB_XCNT(j)]); sum += cc; cnt += (cc > 0u) ? 1u : 0u; mine = (j == x) ? cc : mine; }
        if (sum == G) break;
        __builtin_amdgcn_s_sleep(1);
        if ((++sp & 255u) == 0u) { if (xb_ld(&bar[XB_TMO])) break; if (sp > XB_SPIN_CAP) { atomicAdd(&bar[XB_TMO], 1u); break; } }
    }
    nloc = mine > 0u ? mine : 1u; nx = cnt > 0u ? cnt : 1u;
}
__device__ __forceinline__ void xcd_barrier(const XcdBarrier& b, int tid) {
    asm volatile("s_waitcnt vmcnt(0)" ::: "memory");
    __syncthreads();
    if (tid == 0) {
        unsigned* bar = b.bar;
        __builtin_amdgcn_s_waitcnt(0);
        unsigned nloc = b.st[0], nx = b.st[1];
        if (nloc == 0u) { xcd_barrier_complete(bar, b.x, nloc, nx); b.st[0] = nloc; b.st[1] = nx; }
        const unsigned old = xb_add(&bar[XB_XSUB(b.x)], 1u);
        const unsigned gen = old / nloc;
        if (old + 1u == (gen + 1u) * nloc) {
            __builtin_amdgcn_fence(__ATOMIC_RELEASE, "agent");
            asm volatile("s_waitcnt vmcnt(0)" ::: "memory");
            const unsigned og = xb_add(&bar[XB_TOP], 1u);
            const unsigned tg = og / nx;
            if (og + 1u == (tg + 1u) * nx) xb_add(&bar[XB_TOPGEN], 1u);
            else XB_SPIN(xb_ld(&bar[XB_TOPGEN]) == tg, bar);
            __builtin_amdgcn_fence(__ATOMIC_ACQUIRE, "agent");
            xb_add(&bar[XB_XGEN(b.x)], 1u);
            asm volatile("s_waitcnt vmcnt(0)" ::: "memory");
        } else {
            XB_SPIN(xb_ld(&bar[XB_XGEN(b.x)]) == gen, bar);
            __builtin_amdgcn_fence(__ATOMIC_ACQUIRE, "agent");
            asm volatile("s_waitcnt vmcnt(0)" ::: "memory");
        }
    }
    __syncthreads();
}

__global__ void __launch_bounds__(NTHR, 2) mega(Params P) {
    extern __shared__ __attribute__((aligned(16))) unsigned char lds_raw[];
    cg::grid_group grid = cg::this_grid();
    Ctx c;
    c.in = P.in; c.out = P.out; c.ws = P.ws; c.lds = (LAS unsigned char*)lds_raw; c.z = 0;
    c.tid = threadIdx.x; c.lane = c.tid & 63; c.wave = __builtin_amdgcn_readfirstlane(c.tid >> 6);
    c.gw = (int)blockIdx.x * NWAVES + c.wave; c.NGW = (int)gridDim.x * NWAVES; c.gt = (int)blockIdx.x * NTHR + c.tid; c.NGT = (int)gridDim.x * NTHR; c.bid = (int)blockIdx.x; c.nblk = (int)gridDim.x;
#define RF() do { int zs_ = 0; asm volatile("" : "+s"(zs_)); c.z = zs_; c.lds = (LAS unsigned char*)lds_raw + zs_; int z_ = 0; asm volatile("" : "+v"(z_)); const int l_ = (int)__builtin_amdgcn_mbcnt_hi(~0u, __builtin_amdgcn_mbcnt_lo(~0u, (unsigned)z_)); c.lane = l_; c.tid = c.wave * 64 + l_; c.bid = (int)blockIdx.x + zs_; c.nblk = (int)gridDim.x + zs_; c.gw = c.bid * NWAVES + c.wave; c.NGW = c.nblk * NWAVES; c.gt = c.bid * NTHR + c.tid; c.NGT = c.nblk * NTHR; } while (0)
    bf16* HB = c.W<bf16>(WS_HB); bf16* A0 = c.W<bf16>(WS_A0); bf16* A1 = c.W<bf16>(WS_A1); bf16* A2 = c.W<bf16>(WS_A2); bf16* Qb = c.W<bf16>(WS_Q);
    float* H32 = c.W<float>(WS_H32); float* R32 = c.W<float>(WS_R32);

    if (threadIdx.x < 16) ((volatile LAS unsigned*)(c.lds + MISC_OFF))[threadIdx.x] = 0u;
    __syncthreads();
    const XcdBarrier xbar = xcd_barrier_post(c.W<unsigned>(WS_CTL), (volatile LAS unsigned*)(c.lds + MISC_OFF));
#define GSYNC() do { RF(); xcd_barrier(xbar, c.tid); } while (0)
    RF(); prologue(c);
    grid.sync();
    for (int layer = 0; layer < 4; ++layer) {
        if (layer <= 1) {
            const bf16* Wt = c.W<bf16>(layer == 0 ? WS_W_S5IN : WS_W_PIN);
            RF(); run_gemm(c, HB, D, 0, Wt, 1024, 1024, EpiBf16<0>{A0, D, nullptr, nullptr, nullptr});
        } else if (layer == 2) {
            RF(); run_gemm(c, HB, D, 0, c.W<bf16>(WS_W_CIN), 2048, 1024, EpiBf16<1>{Qb, 2048, c.in[c.z + 24], nullptr, nullptr});
        } else {
            RF(); run_gemm(c, HB, D, 0, c.W<bf16>(WS_W_SIN), NPROJ, 1024, EpiSsdProj{Qb, c.W<bf16>(WS_XBC), c.W<float>(WS_DT)});
        }
        GSYNC();
        const bf16* Aout = A2; const bf16* Wout;
        if (layer == 0) {
            for (int r = 0; r < PR_S5; ++r) { RF(); phase_s5scan(c); }
            GSYNC();
            RF(); run_gemm(c, A1, D, 0, c.W<bf16>(WS_W_S5GLU), 1024, 1024, EpiBf16<3>{A2, D, c.in[c.z + 17], nullptr, A1});
            Wout = c.W<bf16>(WS_W_S5OUT);
        } else if (layer == 1) {
            RF(); phase_pool(c);
            GSYNC();
            RF(); run_gemm(c, A1, D, 256, c.W<bf16>(WS_W_PGRP), 1024, 256, EpiBf16<2>{A2, D, nullptr, c.in[c.z + 21], nullptr});
            Wout = c.W<bf16>(WS_W_POUT);
        } else if (layer == 2) {
            RF(); phase_cmlp_ln(c);
            GSYNC();
            RF(); phase_cmlp_mix(c);
            Aout = A1; Wout = c.W<bf16>(WS_W_COUT);
        } else {
            RF(); phase_ssd_conv(c);
            GSYNC();
            for (int r = 0; r < PR_SSD; ++r) { RF(); phase_ssd_scan(c); }
            GSYNC();
            RF(); phase_ssd_gatenorm(c);
            Aout = c.W<bf16>(WS_YN); Wout = c.W<bf16>(WS_W_SOUT);
        }
        GSYNC();
        if (layer == 3) { RF(); run_gemm(c, Aout, 2048, 0, Wout, 1024, 2048, EpiResid{H32, R32}); }
        else { RF(); run_gemm(c, Aout, 1024, 0, Wout, 1024, 1024, EpiResid{H32, R32}); }
        GSYNC();
        RF(); phase_ln1(c, layer);
        if (layer > 0) { RF(); cvt_tables(c, layer); }
        GSYNC();
        RF(); run_gemm(c, HB, D, 0, c.W<bf16>(WS_W_PQ) + (size_t)layer * 2048 * 1024, 2048, 1024, EpiBf16<0>{Qb, 2048, nullptr, nullptr, nullptr});
        GSYNC();
        for (int r = 0; r < PR_ROUTE; ++r) { RF(); phase_route(c, layer); }
        GSYNC();
        for (int r = 1; r < PR_GATHER; ++r) { RF(); phase_gather(c, layer, true); }
        RF(); phase_gather(c, layer, false);
        GSYNC();
    }
}
}

extern "C" void kernel_launch(void* const* d_in, const int* in_sizes, int n_in, void* d_out, int out_size, void* d_ws, size_t ws_size, hipStream_t stream) {
    static int grid = 0;
    if (grid == 0) {
        int dev = 0, cus = 0, per_cu = 0;
        if (hipGetDevice(&dev) != hipSuccess || hipDeviceGetAttribute(&cus, hipDeviceAttributeMultiprocessorCount, dev) != hipSuccess) { fprintf(stderr, "kernel_launch: device query failed\n"); grid = -1; return; }
        if (hipFuncSetAttribute((const void*)mk::mega, hipFuncAttributeMaxDynamicSharedMemorySize, mk::LDS_BYTES) != hipSuccess) { fprintf(stderr, "kernel_launch: hipFuncSetAttribute failed\n"); grid = -1; return; }
        if (hipOccupancyMaxActiveBlocksPerMultiprocessor(&per_cu, (const void*)mk::mega, mk::NTHR, mk::LDS_BYTES) != hipSuccess || per_cu < 1) { fprintf(stderr, "kernel_launch: occupancy query says %d blocks per CU\n", per_cu); grid = -1; return; }
        grid = cus;
        if (ws_size < mk::WS_END) { fprintf(stderr, "kernel_launch: workspace too small (%zu < %zu)\n", ws_size, (size_t)mk::WS_END); grid = -1; return; }
    }
    if (grid < 0) return;
    mk::Params p{};
    for (int i = 0; i < 46; ++i) p.in[i] = (const float*)d_in[i];
    p.out = (float*)d_out; p.ws = (unsigned char*)d_ws;
    if (hipMemsetAsync((char*)d_ws + mk::WS_CTL, 0, mk::CTL_BYTES, stream) != hipSuccess) { fprintf(stderr, "kernel_launch: memset failed\n"); return; }
    void* args[] = {&p};
    hipError_t e = hipLaunchCooperativeKernel((const void*)mk::mega, dim3(grid), dim3(mk::NTHR), args, mk::LDS_BYTES, stream);
    if (e != hipSuccess) fprintf(stderr, "cooperative launch failed: %s (grid %d)\n", hipGetErrorString(e), grid);
}
```

```cpp
#include <hip/hip_runtime.h>
#include <hip/hip_cooperative_groups.h>
#include <cstdio>
#include <cstdint>
#include <math.h>
namespace cg = cooperative_groups;

namespace pg8 {
#define PG8_LAS __attribute__((address_space(3)))
typedef unsigned short bf16_t;
typedef short bf16x8 __attribute__((ext_vector_type(8)));
typedef float f32x4 __attribute__((ext_vector_type(4)));
typedef unsigned u32x4 __attribute__((ext_vector_type(4)));
constexpr int BM = 256, BK = 64, HALF = 128, HTB = HALF * BK * 2, STAGE_BYTES = 8 * HTB, NXCD = 8, WGM = 8;
__host__ __device__ __forceinline__ int lds_byte(int r, int c) { const int st = (r >> 4) * 2 + (c >> 5), rr = r & 15, cc = c & 31, ob = rr * 64 + cc * 2; return st * 1024 + (ob ^ (((ob >> 9) & 1) << 5)); }
__host__ __device__ __forceinline__ void stage_rc(int b, int& R, int& C) { const int st = b / 1024, sb = b % 1024, swz = sb ^ (((sb >> 9) & 1) << 5); R = (st >> 1) * 16 + swz / 64; C = (st & 1) * 32 + (swz % 64) / 2; }
__host__ __device__ __forceinline__ int perm32(int rho) { const int n = rho >> 4, i = rho & 15; return 8 * (i >> 2) + 4 * n + (i & 3); }
struct Unit { int pm, pn; };
struct Gemm { const bf16_t* A; const bf16_t* Bt; int M, N, K, lda, a_pn_off; };
struct StaticOrder {
    int nM, nN, nwg, G, c;
    __host__ __device__ void init(int M, int N, int G_, int c_) { nM = M / BM; nN = N / BM; nwg = nM * nN; G = G_; c = c_; }
    __host__ __device__ bool next(int i, Unit& u) const {
        const long L = (long)i * G + c; if (L >= nwg) return false;
        int wgid = (int)L; { const int q = nwg / NXCD, r = nwg % NXCD, xcd = wgid % NXCD, off = wgid / NXCD; wgid = (xcd < r ? xcd * (q + 1) : r * (q + 1) + (xcd - r) * q) + off; }
        const int nig = WGM * nN, gid = wgid / nig, fm = gid * WGM, gsz = (nM - fm) < WGM ? (nM - fm) : WGM;
        u.pm = fm + ((wgid % nig) % gsz); u.pn = (wgid % nig) / gsz; return true;
    }
    __device__ __forceinline__ void a_ready(const Unit&) const {}
    __device__ __forceinline__ void done(const Unit&) const {}
};
__device__ __forceinline__ unsigned cvt_pk_bf16(float lo, float hi) { unsigned r; asm volatile("v_cvt_pk_bf16_f32 %0, %1, %2" : "=v"(r) : "v"(lo), "v"(hi)); return r; }
template <class Epi, class Sched, bool ALIGN_EPI = false, bool SP2 = false>
__device__ __forceinline__ void gemm_phase(PG8_LAS unsigned char* lds, const Gemm g, const Sched& S, const Epi& E, int tid_in) {
    int tid_ = tid_in; asm volatile("" : "+v"(tid_));
    const int tid = tid_, wid = __builtin_amdgcn_readfirstlane(tid >> 6), lane = tid & 63, wr = wid >> 2, wc = wid & 3, fr = lane & 15, fq = lane >> 4;
    const int K = g.K, nt = K / BK;
    unsigned voffA[2], voffB[2];
#pragma unroll
    for (int i = 0; i < 2; ++i) { int R, C; stage_rc(tid * 16 + i * 8192, R, C); const int Rb = Epi::PERM ? ((R & ~31) + perm32(R & 31)) : R;
        voffA[i] = (unsigned)(R * g.lda + C) * 2u; voffB[i] = (unsigned)(Rb * K + C) * 2u; }
    const size_t kstep = (size_t)(BK * 2);
    const size_t hstepA = (size_t)HALF * g.lda * 2, tstepA = 2 * hstepA;
    const size_t hstepB = (size_t)HALF * K * 2, tstepB = 2 * hstepB;
    const size_t apn = (size_t)g.a_pn_off * 2;
    const unsigned ldsw = (unsigned)wid * 1024u;
    const int aoff = lds_byte(wr * 64 + fr, fq * 8), boff = lds_byte(wc * 32 + fr, fq * 8);
#define PG8_SA(b, h) (((b) * 2 + (h)) * HTB)
#define PG8_SB(b, h) ((4 + (b) * 2 + (h)) * HTB)
#define PG8_STAGE(bufoff, gbase, voff) do { _Pragma("unroll") for (int _i = 0; _i < 2; ++_i) \
        __builtin_amdgcn_global_load_lds((const unsigned*)((const char*)(gbase) + (voff)[_i]), (PG8_LAS unsigned*)(lds + (bufoff) + ldsw + _i * 8192), 16, 0, 0); } while (0)
#define PG8_LDA(dst, b, h) do { _Pragma("unroll") for (int m = 0; m < 4; ++m) _Pragma("unroll") for (int k = 0; k < 2; ++k) dst[m][k] = *(const PG8_LAS bf16x8*)(lds + PG8_SA(b, h) + aoff + m * 2048 + k * 1024); } while (0)
#define PG8_LDB(dst, b, h) do { _Pragma("unroll") for (int n = 0; n < 2; ++n) _Pragma("unroll") for (int k = 0; k < 2; ++k) dst[n][k] = *(const PG8_LAS bf16x8*)(lds + PG8_SB(b, h) + boff + n * 2048 + k * 1024); } while (0)
#define PG8_MMA(ai, bj, At, Bt) do { __builtin_amdgcn_s_setprio(1); _Pragma("unroll") for (int m = 0; m < 4; ++m) _Pragma("unroll") for (int n = 0; n < 2; ++n) _Pragma("unroll") for (int k = 0; k < 2; ++k) \
        acc[ai][bj][m][n] = __builtin_amdgcn_mfma_f32_16x16x32_bf16(Bt[n][k], At[m][k], acc[ai][bj][m][n], 0, 0, 0); __builtin_amdgcn_s_setprio(0); } while (0)
#define PG8_WAIT_V(n) asm volatile("s_waitcnt vmcnt(" #n ")" ::: "memory")
#define PG8_WAIT_L(n) asm volatile("s_waitcnt lgkmcnt(" #n ")" ::: "memory")
#define PG8_BAR __builtin_amdgcn_s_barrier()
#define PG8_SCHED __builtin_amdgcn_sched_barrier(0)
    Unit cur, nxt; int ui = 0;
    if (!S.next(0, cur)) return;
    f32x4 acc[2][2][4][2];
#pragma unroll
    for (int a = 0; a < 2; ++a)
#pragma unroll
        for (int b = 0; b < 2; ++b)
#pragma unroll
            for (int m = 0; m < 4; ++m)
#pragma unroll
                for (int n = 0; n < 2; ++n) acc[a][b][m][n] = (f32x4){0.f, 0.f, 0.f, 0.f};
    bf16x8 At[4][2], B0[2][2], B1[2][2];
    const char* cA = (const char*)g.A + (size_t)cur.pm * tstepA + (size_t)cur.pn * apn; const char* cB = (const char*)g.Bt + (size_t)cur.pn * tstepB;
    S.a_ready(cur);
    if constexpr (SP2) {
        PG8_STAGE(PG8_SB(0, 0), cB, voffB); PG8_STAGE(PG8_SB(0, 1), cB + hstepB, voffB); PG8_STAGE(PG8_SA(0, 0), cA, voffA); PG8_STAGE(PG8_SA(0, 1), cA + hstepA, voffA);
        if (wr == 1) PG8_BAR;
        PG8_WAIT_V(2); PG8_BAR;
        PG8_STAGE(PG8_SB(1, 0), cB + kstep, voffB); PG8_STAGE(PG8_SA(1, 0), cA + kstep, voffA); PG8_STAGE(PG8_SB(1, 1), cB + hstepB + kstep, voffB);
        PG8_WAIT_V(6); PG8_BAR;
    } else {
        PG8_STAGE(PG8_SB(0, 0), cB, voffB); PG8_STAGE(PG8_SA(0, 0), cA, voffA); PG8_STAGE(PG8_SB(0, 1), cB + hstepB, voffB); PG8_STAGE(PG8_SA(0, 1), cA + hstepA, voffA);
        if (wr == 1) PG8_BAR;
        PG8_WAIT_V(4); PG8_BAR;
        PG8_STAGE(PG8_SB(1, 0), cB + kstep, voffB); PG8_STAGE(PG8_SA(1, 0), cA + kstep, voffA); PG8_STAGE(PG8_SB(1, 1), cB + hstepB + kstep, voffB);
        PG8_WAIT_V(6); PG8_BAR;
    }
    for (;;) {
        const bool has_next = S.next(ui + 1, nxt);
        const char* nA = has_next ? (const char*)g.A + (size_t)nxt.pm * tstepA + (size_t)nxt.pn * apn : cA; const char* nB = has_next ? (const char*)g.Bt + (size_t)nxt.pn * tstepB : cB;
#pragma nounroll
        for (int t = 0; t < nt; t += 2) {
            const bool last = (t == nt - 2);
            const char* a1 = cA + (size_t)(t + 1) * kstep;
            const char* a2 = last ? nA : cA + (size_t)(t + 2) * kstep; const char* b2 = last ? nB : cB + (size_t)(t + 2) * kstep;
            const char* a3 = a2 + kstep; const char* b3 = b2 + kstep;
            if (last && has_next) S.a_ready(nxt);
            if constexpr (SP2) {
            PG8_LDB(B0, 0, 0); PG8_LDB(B1, 0, 1); PG8_SCHED; PG8_LDA(At, 0, 0); PG8_STAGE(PG8_SA(1, 1), a1 + hstepA, voffA);
            PG8_WAIT_V(8); PG8_WAIT_L(0); PG8_BAR; PG8_MMA(0, 0, At, B0); PG8_MMA(0, 1, At, B1); PG8_BAR; PG8_SCHED;
            PG8_LDA(At, 0, 1); PG8_STAGE(PG8_SB(0, 0), b2, voffB); PG8_STAGE(PG8_SB(0, 1), b2 + hstepB, voffB); PG8_STAGE(PG8_SA(0, 0), a2, voffA);
            PG8_WAIT_V(8); PG8_WAIT_L(0); PG8_BAR; PG8_MMA(1, 0, At, B0); PG8_MMA(1, 1, At, B1); PG8_BAR; PG8_SCHED;
            PG8_LDB(B0, 1, 0); PG8_LDB(B1, 1, 1); PG8_SCHED; PG8_LDA(At, 1, 0); PG8_STAGE(PG8_SA(0, 1), a2 + hstepA, voffA);
            PG8_WAIT_V(8); PG8_WAIT_L(0); PG8_BAR; PG8_MMA(0, 0, At, B0); PG8_MMA(0, 1, At, B1); PG8_BAR; PG8_SCHED;
            PG8_LDA(At, 1, 1); PG8_STAGE(PG8_SB(1, 0), b3, voffB); PG8_STAGE(PG8_SB(1, 1), b3 + hstepB, voffB); PG8_STAGE(PG8_SA(1, 0), a3, voffA);
            PG8_WAIT_V(8); PG8_WAIT_L(0); PG8_BAR; PG8_MMA(1, 0, At, B0); PG8_MMA(1, 1, At, B1); PG8_BAR; PG8_SCHED;
            } else {
            PG8_LDB(B0, 0, 0); PG8_SCHED; PG8_LDA(At, 0, 0); PG8_STAGE(PG8_SA(1, 1), a1 + hstepA, voffA);
            PG8_WAIT_L(8); PG8_BAR; PG8_WAIT_L(0); PG8_MMA(0, 0, At, B0); PG8_BAR; PG8_SCHED;
            PG8_LDB(B1, 0, 1); PG8_STAGE(PG8_SB(0, 0), b2, voffB);
            PG8_BAR; PG8_WAIT_L(0); PG8_MMA(0, 1, At, B1); PG8_BAR;
            PG8_LDA(At, 0, 1); PG8_STAGE(PG8_SA(0, 0), a2, voffA);
            PG8_BAR; PG8_WAIT_L(0); PG8_MMA(1, 0, At, B0); PG8_BAR; PG8_SCHED;
            PG8_STAGE(PG8_SB(0, 1), b2 + hstepB, voffB);
            PG8_WAIT_V(6); PG8_BAR; PG8_MMA(1, 1, At, B1); PG8_BAR;
            PG8_LDB(B0, 1, 0); PG8_SCHED; PG8_LDA(At, 1, 0); PG8_STAGE(PG8_SA(0, 1), a2 + hstepA, voffA);
            PG8_WAIT_L(8); PG8_BAR; PG8_WAIT_L(0); PG8_MMA(0, 0, At, B0); PG8_BAR; PG8_SCHED;
            PG8_LDB(B1, 1, 1); PG8_STAGE(PG8_SB(1, 0), b3, voffB);
            PG8_BAR; PG8_WAIT_L(0); PG8_MMA(0, 1, At, B1); PG8_BAR;
            PG8_LDA(At, 1, 1); PG8_STAGE(PG8_SA(1, 0), a3, voffA);
            PG8_BAR; PG8_WAIT_L(0); PG8_MMA(1, 0, At, B0); PG8_BAR; PG8_SCHED;
            PG8_STAGE(PG8_SB(1, 1), b3 + hstepB, voffB);
            PG8_WAIT_V(6); PG8_BAR; PG8_MMA(1, 1, At, B1); PG8_BAR;
            }
        }
        if constexpr (ALIGN_EPI) { if (wr == 0) PG8_BAR; }
        if constexpr (!Epi::AFTER_DRAIN) { E(acc, cur, wr, wc, fr, fq); S.done(cur); }
        if (!has_next) break;
#pragma unroll
        for (int a = 0; a < 2; ++a)
#pragma unroll
            for (int b = 0; b < 2; ++b)
#pragma unroll
                for (int m = 0; m < 4; ++m)
#pragma unroll
                    for (int n = 0; n < 2; ++n) acc[a][b][m][n] = (f32x4){0.f, 0.f, 0.f, 0.f};
        cur = nxt; cA = nA; cB = nB; ++ui;
        if constexpr (ALIGN_EPI) { if (wr == 1) PG8_BAR; }
    }
    PG8_WAIT_V(0);
    if constexpr (!ALIGN_EPI) { if (wr == 0) PG8_BAR; }
    PG8_BAR;
    if constexpr (Epi::AFTER_DRAIN) { E.fused(acc, cur, wr, wc, fr, fq, lds, wid, lane); S.done(cur); }
#undef PG8_SA
#undef PG8_SB
#undef PG8_STAGE
#undef PG8_LDA
#undef PG8_LDB
#undef PG8_MMA
#undef PG8_WAIT_V
#undef PG8_WAIT_L
#undef PG8_BAR
#undef PG8_SCHED
}
}

#ifndef PR_GATHER
#define PR_GATHER 1
#endif
#ifndef PR_ROUTE
#define PR_ROUTE 1
#endif
#ifndef PR_S5
#define PR_S5 1
#endif
#ifndef PR_SSD
#define PR_SSD 1
#endif
#ifndef PR_GEMM
#define PR_GEMM 1
#endif
#ifndef PR_MISC
#define PR_MISC 1
#endif
namespace mk {
#define LAS __attribute__((address_space(3)))
typedef unsigned short bf16;
typedef unsigned v4u __attribute__((ext_vector_type(4)));
typedef unsigned v2u __attribute__((ext_vector_type(2)));
typedef float f32x4 __attribute__((ext_vector_type(4)));
typedef short bf16x8 __attribute__((ext_vector_type(8)));
using bf16x2 = __attribute__((ext_vector_type(2))) __bf16;

constexpr int D = 1024, T = 17408, TP = 16384, NWAVES = 8, NTHR = 512;
constexpr float ALPHA = 1.6817928305074290f;
constexpr float LN_EPS = 1e-5f, RMS_EPS = 1e-5f;
constexpr int LDS_BYTES = 160 * 1024;
constexpr int NPROJ = 5376, CONVD = 3072;

constexpr size_t MiB = 1u << 20;
constexpr size_t WS_W_S5IN = 0, WS_W_S5GLU = 2 * MiB, WS_W_S5OUT = 4 * MiB, WS_W_PIN = 6 * MiB, WS_W_PGRP = 8 * MiB, WS_W_POUT = 9 * MiB,
                 WS_W_CIN = 11 * MiB, WS_W_COUT = 15 * MiB, WS_W_SIN = 17 * MiB  , WS_W_SOUT = 28 * MiB, WS_W_PQ = 32 * MiB  ,
                 WS_KEYS = 48 * MiB  , WS_SMALL = 50 * MiB, WS_CTL = 52 * MiB  ;
constexpr size_t CTL_BYTES = 16384;
constexpr int MISC_OFF = LDS_BYTES - 64;
constexpr size_t WS_EU = 64 * MiB, WS_EV = 96 * MiB;
constexpr size_t WS_H32 = 128 * MiB, WS_R32 = 196 * MiB, WS_HB = 264 * MiB, WS_A0 = 298 * MiB, WS_A1 = 332 * MiB, WS_A2 = 366 * MiB;
constexpr size_t WS_Q = 400 * MiB  , WS_IDX = 468 * MiB  , WS_GATE = 477 * MiB  , WS_DT = 486 * MiB  ;
constexpr size_t WS_XBC = 490 * MiB  , WS_XC = 592 * MiB  , WS_Y = 694 * MiB  , WS_YN = 762 * MiB  , WS_SCU = 830 * MiB  , WS_END = 839 * MiB;
constexpr size_t SM_LBR = 0, SM_LBI = 4096, SM_BBR = 8192, SM_BBI = 8192 + 65536, SM_ISU = 8192 + 131072, SM_ISV = SM_ISU + 16384;

struct Params { const float* in[46]; float* out; unsigned char* ws; };

__device__ __forceinline__ unsigned f2bf(float f) { unsigned u = __builtin_bit_cast(unsigned, f); return (u + 0x7fffu + ((u >> 16) & 1u)) >> 16; }
__device__ __forceinline__ unsigned pk2(float lo, float hi) { return pg8::cvt_pk_bf16(lo, hi); }
__device__ __forceinline__ float bflo(unsigned w) { return __builtin_bit_cast(float, w << 16); }
__device__ __forceinline__ float bfhi(unsigned w) { return __builtin_bit_cast(float, w & 0xffff0000u); }
__device__ __forceinline__ float bf2f(bf16 b) { return __builtin_bit_cast(float, ((unsigned)b) << 16); }
__device__ __forceinline__ float sigmoid_f(float x) { return 1.f / (1.f + __expf(-x)); }
__device__ __forceinline__ float silu_f(float x) { return x * sigmoid_f(x); }
__device__ __forceinline__ float gelu_f(float x) { return x * sigmoid_f(1.5957691216057308f * (x + 0.044715f * x * x * x)); }
__device__ __forceinline__ float shx(float v, int o, int lane) { return __builtin_bit_cast(float, __builtin_amdgcn_ds_bpermute((lane ^ o) << 2, __builtin_bit_cast(int, v))); }
__device__ __forceinline__ float wave_sum(float v, int lane) {
#pragma unroll
    for (int o = 32; o >= 1; o >>= 1) v += shx(v, o, lane);
    return v;
}
__device__ __forceinline__ float dot2(unsigned w, unsigned x, float acc) { return __builtin_amdgcn_fdot2_f32_bf16(__builtin_bit_cast(bf16x2, w), __builtin_bit_cast(bf16x2, x), acc, false); }
__device__ __forceinline__ float reduce16(const float (&p)[16], int lane) {
    const bool b5 = lane & 32, b4 = lane & 16, b3 = lane & 8, b2 = lane & 4;
    float q[8], r[4], s[2], t;
#pragma unroll
    for (int i = 0; i < 8; ++i) { const float keep = b5 ? p[i + 8] : p[i], send = b5 ? p[i] : p[i + 8]; q[i] = keep + shx(send, 32, lane); }
#pragma unroll
    for (int i = 0; i < 4; ++i) { const float keep = b4 ? q[i + 4] : q[i], send = b4 ? q[i] : q[i + 4]; r[i] = keep + shx(send, 16, lane); }
#pragma unroll
    for (int i = 0; i < 2; ++i) { const float keep = b3 ? r[i + 2] : r[i], send = b3 ? r[i] : r[i + 2]; s[i] = keep + shx(send, 8, lane); }
    { const float keep = b2 ? s[1] : s[0], send = b2 ? s[0] : s[1]; t = keep + shx(send, 4, lane); }
    t += shx(t, 2, lane); t += shx(t, 1, lane);
    return t;
}
__device__ __forceinline__ void seq_info(int s, int& tok0, int& L) { if (s < 8) { tok0 = s << 11; L = 2048; } else { tok0 = TP + ((s - 8) << 3); L = 8; } }
__device__ __forceinline__ void tok_info(int t, int& s, int& l, int& tok0) {
    if (t < TP) { s = t >> 11; l = t & 2047; tok0 = s << 11; } else { const int b = (t - TP) >> 3; s = 8 + b; l = (t - TP) & 7; tok0 = TP + (b << 3); }
}

template <int MODE> struct EpiBf16 {
    static constexpr bool PERM = true, AFTER_DRAIN = false;
    bf16* O; int ldc; const float* bias; const float* scale; const bf16* G;
    __device__ __forceinline__ void operator()(const pg8::f32x4 (&acc)[2][2][4][2], const pg8::Unit& u, int wr, int wc, int fr_, int fq_) const {
        int fr = fr_, fq = fq_; asm volatile("" : "+v"(fr), "+v"(fq));
        const int row0 = u.pm * 256 + wr * 64 + fr, col0 = u.pn * 256 + wc * 32 + 8 * fq;
        f32x4 bv[2][2], sv[2][2];
#pragma unroll
        for (int bj = 0; bj < 2; ++bj)
#pragma unroll
            for (int n = 0; n < 2; ++n) {
                bv[bj][n] = bias ? *(const f32x4*)(bias + col0 + bj * 128 + 4 * n) : (f32x4){0.f, 0.f, 0.f, 0.f};
                sv[bj][n] = (MODE == 2) ? *(const f32x4*)(scale + col0 + bj * 128 + 4 * n) : (f32x4){1.f, 1.f, 1.f, 1.f};
            }
#pragma unroll
        for (int ai = 0; ai < 2; ++ai)
#pragma unroll
            for (int m = 0; m < 4; ++m) {
                const size_t roff = (size_t)(row0 + ai * 128 + m * 16) * ldc + col0;
#pragma unroll
                for (int bj = 0; bj < 2; ++bj) {
                    f32x4 v0 = acc[ai][bj][m][0] + bv[bj][0], v1 = acc[ai][bj][m][1] + bv[bj][1];
                    if (MODE == 1) {
#pragma unroll
                        for (int j = 0; j < 4; ++j) { v0[j] = gelu_f(v0[j]); v1[j] = gelu_f(v1[j]); }
                    }
                    if (MODE == 2) { v0 = v0 * sv[bj][0]; v1 = v1 * sv[bj][1]; }
                    if (MODE == 3) {
                        const v4u gw = *(const v4u*)(G + roff + bj * 128);
                        v0[0] = bflo(gw.x) * sigmoid_f(v0[0]); v0[1] = bfhi(gw.x) * sigmoid_f(v0[1]); v0[2] = bflo(gw.y) * sigmoid_f(v0[2]); v0[3] = bfhi(gw.y) * sigmoid_f(v0[3]);
                        v1[0] = bflo(gw.z) * sigmoid_f(v1[0]); v1[1] = bfhi(gw.z) * sigmoid_f(v1[1]); v1[2] = bflo(gw.w) * sigmoid_f(v1[2]); v1[3] = bfhi(gw.w) * sigmoid_f(v1[3]);
                    }
                    v4u w; w.x = pk2(v0[0], v0[1]); w.y = pk2(v0[2], v0[3]); w.z = pk2(v1[0], v1[1]); w.w = pk2(v1[2], v1[3]);
                    *(v4u*)(O + roff + bj * 128) = w;
                }
            }
    }
};
struct EpiResid {
    static constexpr bool PERM = false, AFTER_DRAIN = false;
    const float* H; float* R;
    __device__ __forceinline__ void operator()(const pg8::f32x4 (&acc)[2][2][4][2], const pg8::Unit& u, int wr, int wc, int fr_, int fq_) const {
        int fr = fr_, fq = fq_; asm volatile("" : "+v"(fr), "+v"(fq));
        const int row0 = u.pm * 256 + wr * 64 + fr, col0 = u.pn * 256 + wc * 32 + 4 * fq;
#pragma unroll
        for (int ai = 0; ai < 2; ++ai)
#pragma unroll
            for (int m = 0; m < 4; ++m) {
                const size_t roff = (size_t)(row0 + ai * 128 + m * 16) * D + col0;
#pragma unroll
                for (int bj = 0; bj < 2; ++bj)
#pragma unroll
                    for (int n = 0; n < 2; ++n) {
                        const f32x4 hv = *(const f32x4*)(H + roff + bj * 128 + n * 16);
                        *(f32x4*)(R + roff + bj * 128 + n * 16) = hv * ALPHA + acc[ai][bj][m][n];
                    }
            }
    }
};
struct EpiSsdProj {
    static constexpr bool PERM = true, AFTER_DRAIN = false;
    bf16* Z; bf16* XBC; float* DT;
    __device__ __forceinline__ void operator()(const pg8::f32x4 (&acc)[2][2][4][2], const pg8::Unit& u, int wr, int wc, int fr_, int fq_) const {
        int fr = fr_, fq = fq_; asm volatile("" : "+v"(fr), "+v"(fq));
        const int row0 = u.pm * 256 + wr * 64 + fr, col0 = u.pn * 256 + wc * 32 + 8 * fq;
#pragma unroll
        for (int ai = 0; ai < 2; ++ai)
#pragma unroll
            for (int m = 0; m < 4; ++m) {
                const size_t row = (size_t)(row0 + ai * 128 + m * 16);
#pragma unroll
                for (int bj = 0; bj < 2; ++bj) {
                    const f32x4 v0 = acc[ai][bj][m][0], v1 = acc[ai][bj][m][1];
                    const int col = col0 + bj * 128;
                    if (u.pn < 20) {
                        v4u w; w.x = pk2(v0[0], v0[1]); w.y = pk2(v0[2], v0[3]); w.z = pk2(v1[0], v1[1]); w.w = pk2(v1[2], v1[3]);
                        if (u.pn < 8) *(v4u*)(Z + row * 2048 + col) = w; else *(v4u*)(XBC + row * CONVD + (col - 2048)) = w;
                    } else if (col - 5120 < 32) {
                        *(f32x4*)(DT + row * 32 + (col - 5120)) = v0; *(f32x4*)(DT + row * 32 + (col - 5120) + 4) = v1;
                    }
                }
            }
    }
};

struct Ctx {
    const float* const* in; float* out; unsigned char* ws; LAS unsigned char* lds;
    int tid, lane, wave, gw, NGW, gt, NGT, bid, nblk;
    int z;
    template <class Tp> __device__ __forceinline__ Tp* W(size_t off) const { return (Tp*)(ws + (off + (size_t)(unsigned)z)); }
};

template <class Epi> __device__ __forceinline__ void run_gemm(const Ctx& c, const bf16* A, int lda, int a_pn_off, const bf16* Bt, int N, int K, const Epi& E) {
    pg8::Gemm g{A, Bt, T, N, K, lda, a_pn_off};
    pg8::StaticOrder S; S.init(T, N, c.nblk, c.bid);
    for (int r = 0; r < PR_GEMM; ++r) pg8::gemm_phase<Epi, pg8::StaticOrder, true, true>(c.lds, g, S, E, c.tid);
}

__device__ __forceinline__ void transpose_item(const float* __restrict__ Wm, int K, int N, bf16* WT, LAS float* scr, int item, int lane) {
    const int nblk = N / 32, kb = item / nblk, nb = item % nblk, k0 = 64 * kb, n0 = 32 * nb;
#pragma unroll 8
    for (int i = 0; i < 32; ++i) { const int kk = 2 * i + (lane >> 5); scr[kk * 33 + (lane & 31)] = Wm[(size_t)(k0 + kk) * N + n0 + (lane & 31)]; }
    asm volatile("s_waitcnt lgkmcnt(0)" ::: "memory");
    const int cc = lane & 7;
#pragma unroll
    for (int j = 0; j < 4; ++j) {
        const int n = (lane >> 3) + 8 * j; const LAS float* s = scr + (8 * cc) * 33 + n;
        v4u o; o.x = pk2(s[0 * 33], s[1 * 33]); o.y = pk2(s[2 * 33], s[3 * 33]); o.z = pk2(s[4 * 33], s[5 * 33]); o.w = pk2(s[6 * 33], s[7 * 33]);
        *(v4u*)(WT + (size_t)(n0 + n) * K + k0 + 8 * cc) = o;
    }
    asm volatile("s_waitcnt lgkmcnt(0)" ::: "memory");
}
__device__ __forceinline__ void transpose_mat(const Ctx& c, const float* Wm, int K, int N, bf16* WT) {
    LAS float* scr = (LAS float*)(c.lds + c.wave * 16384);
    const int nitems = (K / 64) * (N / 32);
    for (int it = c.gw; it < nitems; it += c.NGW) transpose_item(Wm, K, N, WT, scr, it, c.lane);
}
__device__ __forceinline__ void cvt_copy(const Ctx& c, const float* __restrict__ src, bf16* dst, size_t n) {
    for (size_t i = (size_t)c.gt * 8; i < n; i += (size_t)c.NGT * 8) {
        const f32x4 a = *(const f32x4*)(src + i), b = *(const f32x4*)(src + i + 4);
        v4u w; w.x = pk2(a[0], a[1]); w.y = pk2(a[2], a[3]); w.z = pk2(b[0], b[1]); w.w = pk2(b[2], b[3]);
        *(v4u*)(dst + i) = w;
    }
}
__device__ __forceinline__ float wave_max(float v, int lane) {
#pragma unroll
    for (int o = 32; o >= 1; o >>= 1) v = fmaxf(v, shx(v, o, lane));
    return v;
}
__device__ __forceinline__ void cvt_tables(const Ctx& c, int layer) {
    float* sm = c.W<float>(WS_SMALL);
    for (int r = c.gw; r < 2 * 16384; r += c.NGW) {
        const int tb = r >> 14, row = r & 16383;
        const float* src = c.in[c.z + 44 + tb] + ((size_t)layer * 16384 + row) * D + 16 * c.lane;
        f32x4 v[4];
#pragma unroll
        for (int k = 0; k < 4; ++k) v[k] = *(const f32x4*)(src + 4 * k);
        float m = 0.f;
#pragma unroll
        for (int k = 0; k < 4; ++k) m = fmaxf(fmaxf(fmaxf(fabsf(v[k][0]), fabsf(v[k][1])), fmaxf(fabsf(v[k][2]), fabsf(v[k][3]))), m);
        m = fmaxf(wave_max(m, c.lane), 1e-30f);
        const int ex = (int)((__builtin_bit_cast(unsigned, m) >> 23) & 0xffu) - 127;
        const float sc = __builtin_bit_cast(float, (unsigned)(127 + 7 - ex) << 23);
        const float isc = __builtin_bit_cast(float, (unsigned)(127 - 7 + ex) << 23);
        v4u o;
        { int p = __builtin_amdgcn_cvt_pk_fp8_f32(v[0][0] * sc, v[0][1] * sc, 0, false); p = __builtin_amdgcn_cvt_pk_fp8_f32(v[0][2] * sc, v[0][3] * sc, p, true); o.x = (unsigned)p; }
        { int p = __builtin_amdgcn_cvt_pk_fp8_f32(v[1][0] * sc, v[1][1] * sc, 0, false); p = __builtin_amdgcn_cvt_pk_fp8_f32(v[1][2] * sc, v[1][3] * sc, p, true); o.y = (unsigned)p; }
        { int p = __builtin_amdgcn_cvt_pk_fp8_f32(v[2][0] * sc, v[2][1] * sc, 0, false); p = __builtin_amdgcn_cvt_pk_fp8_f32(v[2][2] * sc, v[2][3] * sc, p, true); o.z = (unsigned)p; }
        { int p = __builtin_amdgcn_cvt_pk_fp8_f32(v[3][0] * sc, v[3][1] * sc, 0, false); p = __builtin_amdgcn_cvt_pk_fp8_f32(v[3][2] * sc, v[3][3] * sc, p, true); o.w = (unsigned)p; }
        *(v4u*)(c.ws + (tb ? WS_EV : WS_EU) + (size_t)row * D + 16 * c.lane) = o;
        if (c.lane == 0) sm[(tb ? SM_ISV : SM_ISU) + row] = isc;
    }
}
__device__ __forceinline__ void prologue(const Ctx& c) {
    transpose_mat(c, c.in[c.z + 7], 1024, 1024, c.W<bf16>(WS_W_S5IN));
    transpose_mat(c, c.in[c.z + 16], 1024, 1024, c.W<bf16>(WS_W_S5GLU));
    transpose_mat(c, c.in[c.z + 18], 1024, 1024, c.W<bf16>(WS_W_S5OUT));
    transpose_mat(c, c.in[c.z + 19], 1024, 1024, c.W<bf16>(WS_W_PIN));
    for (int g = 0; g < 4; ++g) transpose_mat(c, c.in[c.z + 20] + (size_t)g * 65536, 256, 256, c.W<bf16>(WS_W_PGRP) + (size_t)g * 65536);
    transpose_mat(c, c.in[c.z + 22], 1024, 1024, c.W<bf16>(WS_W_POUT));
    transpose_mat(c, c.in[c.z + 23], 1024, 2048, c.W<bf16>(WS_W_CIN));
    transpose_mat(c, c.in[c.z + 29], 1024, 1024, c.W<bf16>(WS_W_COUT));
    transpose_mat(c, c.in[c.z + 30], 1024, 5152, c.W<bf16>(WS_W_SIN));
    transpose_mat(c, c.in[c.z + 37], 2048, 1024, c.W<bf16>(WS_W_SOUT));
    for (int l = 0; l < 4; ++l) transpose_mat(c, c.in[c.z + 42] + (size_t)l * 1024 * 2048, 1024, 2048, c.W<bf16>(WS_W_PQ) + (size_t)l * 2048 * 1024);
    {
        v4u* z = (v4u*)(c.W<bf16>(WS_W_SIN) + (size_t)5152 * 1024);
        for (int i = c.gt; i < 224 * 1024 / 8; i += c.NGT) z[i] = (v4u){0u, 0u, 0u, 0u};
    }
    cvt_copy(c, c.in[c.z + 43], c.W<bf16>(WS_KEYS), (size_t)4 * 8 * 2 * 128 * 128);
    {
        float* H = c.W<float>(WS_H32); bf16* HB = c.W<bf16>(WS_HB);
        for (size_t i = (size_t)c.gt * 8; i < (size_t)T * D; i += (size_t)c.NGT * 8) {
            const float* src = (i < (size_t)TP * D) ? (c.in[c.z + 0] + i) : (c.in[c.z + 1] + (i - (size_t)TP * D));
            const f32x4 a = *(const f32x4*)(src), b = *(const f32x4*)(src + 4);
            *(f32x4*)(H + i) = a; *(f32x4*)(H + i + 4) = b;
            v4u w; w.x = pk2(a[0], a[1]); w.y = pk2(a[2], a[3]); w.z = pk2(b[0], b[1]); w.w = pk2(b[2], b[3]);
            *(v4u*)(HB + i) = w;
        }
    }
    if (c.gt < 4096) {
        const int gp = c.gt, g = gp >> 6;
        float* sm = c.W<float>(WS_SMALL);
        const float dt = expf(c.in[c.z + 10][g]);
        const float lr = c.in[c.z + 8][gp], li = c.in[c.z + 9][gp];
        const float mag = expf(lr * dt);
        const float br = mag * cosf(li * dt), bi = mag * sinf(li * dt);
        const float den = lr * lr + li * li;
        const float fr = ((br - 1.f) * lr + bi * li) / den, fi = (bi * lr - (br - 1.f) * li) / den;
        sm[SM_LBR + gp] = br; sm[SM_LBI + gp] = bi;
        for (int i = 0; i < 16; ++i) {
            const float xr = c.in[c.z + 11][gp * 16 + i], xi = c.in[c.z + 12][gp * 16 + i];
            sm[SM_BBR + gp * 16 + i] = fr * xr - fi * xi; sm[SM_BBI + gp * 16 + i] = fr * xi + fi * xr;
        }
    }
    cvt_tables(c, 0);
}

__device__ __forceinline__ void ln_row_store(const f32x4 (&v)[4], float mean, float rstd, const float* __restrict__ g, const float* __restrict__ b, float* o32, bf16* ob, int lane) {
#pragma unroll
    for (int h = 0; h < 2; ++h) {
        const int c0 = h * 512 + 8 * lane;
        const f32x4 g0 = *(const f32x4*)(g + c0), g1 = *(const f32x4*)(g + c0 + 4), b0 = *(const f32x4*)(b + c0), b1 = *(const f32x4*)(b + c0 + 4);
        const f32x4 o0 = (v[2 * h] - mean) * rstd * g0 + b0, o1 = (v[2 * h + 1] - mean) * rstd * g1 + b1;
        *(f32x4*)(o32 + c0) = o0; *(f32x4*)(o32 + c0 + 4) = o1;
        if (ob) { v4u w; w.x = pk2(o0[0], o0[1]); w.y = pk2(o0[2], o0[3]); w.z = pk2(o1[0], o1[1]); w.w = pk2(o1[2], o1[3]); *(v4u*)(ob + c0) = w; }
    }
}
__device__ __forceinline__ void ln_stats(const f32x4 (&v)[4], float& mean, float& rstd, int lane) {
    float s = 0.f;
#pragma unroll
    for (int k = 0; k < 4; ++k) s += (v[k][0] + v[k][1]) + (v[k][2] + v[k][3]);
    mean = wave_sum(s, lane) * (1.f / D);
    float q = 0.f;
#pragma unroll
    for (int k = 0; k < 4; ++k) { const f32x4 d = v[k] - mean; q += (d[0] * d[0] + d[1] * d[1]) + (d[2] * d[2] + d[3] * d[3]); }
    rstd = rsqrtf(wave_sum(q, lane) * (1.f / D) + LN_EPS);
}
__device__ __forceinline__ void phase_ln1(const Ctx& c, int layer) {
    const float* R = c.W<float>(WS_R32); float* H = c.W<float>(WS_H32); bf16* HB = c.W<bf16>(WS_HB);
    const float* g = c.in[c.z + 38] + layer * D; const float* b = c.in[c.z + 39] + layer * D;
    for (int t = c.gw; t < T; t += c.NGW) {
        f32x4 v[4];
#pragma unroll
        for (int h = 0; h < 2; ++h) { v[2 * h] = *(const f32x4*)(R + (size_t)t * D + h * 512 + 8 * c.lane); v[2 * h + 1] = *(const f32x4*)(R + (size_t)t * D + h * 512 + 8 * c.lane + 4); }
        float mean, rstd; ln_stats(v, mean, rstd, c.lane);
        ln_row_store(v, mean, rstd, g, b, H + (size_t)t * D, HB + (size_t)t * D, c.lane);
    }
}

__device__ __forceinline__ bf16x8 mk8(float a0, float a1, float a2, float a3, float a4, float a5, float a6, float a7) {
    v4u w; w.x = pk2(a0, a1); w.y = pk2(a2, a3); w.z = pk2(a4, a5); w.w = pk2(a6, a7); return __builtin_bit_cast(bf16x8, w);
}
constexpr int S5_BU_LD = 132  , S5_H_LD = 136  , S5_WAVE_BYTES = 16 * S5_BU_LD * 4 + 16 * S5_H_LD * 2;
__device__ __forceinline__ void phase_s5scan(const Ctx& c) {
    const bf16* U = c.W<bf16>(WS_A0); bf16* G = c.W<bf16>(WS_A1);
    const float* sm = c.W<float>(WS_SMALL);
    float* out = c.out;
    float* o_re_p = out + 17825792, *o_im_p = o_re_p + 32768, *o_re_s = out + 17825792 + 32768 * 2 + 122880 + 73728 + 2097152, *o_im_s = o_re_s + 524288;
    const int lane = c.lane, p = lane, fr = lane & 15, fq = lane >> 4;
    LAS float* BuT = (LAS float*)(c.lds + c.wave * S5_WAVE_BYTES);
    LAS bf16* Hi = (LAS bf16*)(c.lds + c.wave * S5_WAVE_BYTES + 16 * S5_BU_LD * 4);
    const int wslot = c.wave * c.nblk + c.bid;
    for (int unit = wslot; unit < 136 * 64; unit += c.NGW) {
        const int s = unit >> 6, g = unit & 63;
        int tok0, L; seq_info(s, tok0, L);
        bf16x8 Bf[8];
#pragma unroll
        for (int nt = 0; nt < 8; ++nt) {
            const int comp = 16 * nt + fr;
            const float* src = sm + ((comp < 64) ? SM_BBR : SM_BBI) + (size_t)(g * 64 + (comp & 63)) * 16 + 8 * (fq & 1);
            const f32x4 a = *(const f32x4*)src, b = *(const f32x4*)(src + 4);
            const bf16x8 v = mk8(a[0], a[1], a[2], a[3], b[0], b[1], b[2], b[3]);
            Bf[nt] = (fq < 2) ? v : (bf16x8){0, 0, 0, 0, 0, 0, 0, 0};
        }
        bf16x8 Cf[4];
#pragma unroll
        for (int ks = 0; ks < 4; ++ks) {
            const int comp0 = 32 * ks + 8 * fq;
            const float* src = ((ks < 2) ? c.in[c.z + 13] : c.in[c.z + 14]) + (size_t)(g * 16 + fr) * 64 + (comp0 & 63);
            const f32x4 a = *(const f32x4*)src, b = *(const f32x4*)(src + 4);
            const float sg = (ks < 2) ? 1.f : -1.f;
            Cf[ks] = mk8(sg * a[0], sg * a[1], sg * a[2], sg * a[3], sg * b[0], sg * b[1], sg * b[2], sg * b[3]);
        }
        const float lr = sm[SM_LBR + g * 64 + p], li = sm[SM_LBI + g * 64 + p];
        float hr = 0.f, hi = 0.f;
        if (s >= 8) { hr = c.in[c.z + 2][((s - 8) * 64 + g) * 64 + p]; hi = c.in[c.z + 3][((s - 8) * 64 + g) * 64 + p]; }
        const f32x4 dk4 = *(const f32x4*)(c.in[c.z + 15] + g * 16 + 4 * fq);
        const int ntile = (L + 15) >> 4;
        for (int tile = 0; tile < ntile; ++tile) {
            const int tb = tok0 + tile * 16;
            const bool valid = (tile * 16 + fr) < L;
            bf16x8 uf = {0, 0, 0, 0, 0, 0, 0, 0};
            if (fq < 2 && valid) uf = *(const bf16x8*)(U + (size_t)(tb + fr) * D + g * 16 + 8 * fq);
#pragma unroll
            for (int nt = 0; nt < 8; ++nt) {
                f32x4 acc = {0.f, 0.f, 0.f, 0.f};
                acc = __builtin_amdgcn_mfma_f32_16x16x32_bf16(Bf[nt], uf, acc, 0, 0, 0);
                *(LAS f32x4*)(BuT + fr * S5_BU_LD + 16 * nt + 4 * fq) = acc;
            }
            asm volatile("s_waitcnt lgkmcnt(0)" ::: "memory");
            const int nsteps = min(16, L - tile * 16);
#pragma unroll
            for (int t = 0; t < 16; ++t) {
                const float br = BuT[t * S5_BU_LD + p], bi = BuT[t * S5_BU_LD + 64 + p];
                const float nr = lr * hr - li * hi + br, ni = lr * hi + li * hr + bi;
                if (t < nsteps) { hr = nr; hi = ni; }
                Hi[t * S5_H_LD + p] = (bf16)f2bf(hr); Hi[t * S5_H_LD + 64 + p] = (bf16)f2bf(hi);
            }
            asm volatile("s_waitcnt lgkmcnt(0)" ::: "memory");
            f32x4 y = {0.f, 0.f, 0.f, 0.f};
#pragma unroll
            for (int ks = 0; ks < 4; ++ks) {
                const bf16x8 hf = *(const LAS bf16x8*)(Hi + fr * S5_H_LD + 32 * ks + 8 * fq);
                y = __builtin_amdgcn_mfma_f32_16x16x32_bf16(Cf[ks], hf, y, 0, 0, 0);
            }
            if (valid) {
                const v2u uq = *(const v2u*)(U + (size_t)(tb + fr) * D + g * 16 + 4 * fq);
                v2u o; o.x = pk2(gelu_f(y[0] + dk4[0] * bflo(uq.x)), gelu_f(y[1] + dk4[1] * bfhi(uq.x))); o.y = pk2(gelu_f(y[2] + dk4[2] * bflo(uq.y)), gelu_f(y[3] + dk4[3] * bfhi(uq.y)));
                *(v2u*)(G + (size_t)(tb + fr) * D + g * 16 + 4 * fq) = o;
            }
            asm volatile("" ::: "memory");
        }
        if (s < 8) { o_re_p[(s * 64 + g) * 64 + p] = hr; o_im_p[(s * 64 + g) * 64 + p] = hi; }
        else { o_re_s[((s - 8) * 64 + g) * 64 + p] = hr; o_im_s[((s - 8) * 64 + g) * 64 + p] = hi; }
    }
}

__device__ __forceinline__ void phase_pool(const Ctx& c) {
    const bf16* U = c.W<bf16>(WS_A0); bf16* P = c.W<bf16>(WS_A1);
    float* o_p = c.out + 17825792 + 65536, *o_s = c.out + 17825792 + 65536 + 122880 + 73728 + 2097152 + 1048576;
    for (size_t i = (size_t)c.gt; i < (size_t)T * 128; i += (size_t)c.NGT) {
        const int t = (int)(i >> 7), c0 = (int)(i & 127) * 8;
        int s, l, tok0; tok_info(t, s, l, tok0);
        const int w = 2 << (c0 >> 8);
        float sum[8];
#pragma unroll
        for (int j = 0; j < 8; ++j) sum[j] = 0.f;
        float cur[8];
        for (int k = 0; k < w; ++k) {
            const int ll = l - k;
            if (ll >= 0) {
                const v4u q = *(const v4u*)(U + (size_t)(tok0 + ll) * D + c0);
                const float f[8] = {bflo(q.x), bfhi(q.x), bflo(q.y), bfhi(q.y), bflo(q.z), bfhi(q.z), bflo(q.w), bfhi(q.w)};
#pragma unroll
                for (int j = 0; j < 8; ++j) { sum[j] += f[j]; if (k == 0) cur[j] = f[j]; }
            } else if (s >= 8) {
                const float* sp = c.in[c.z + 4] + ((size_t)(s - 8) * 15 + (15 + ll)) * D + c0;
                const f32x4 a = *(const f32x4*)sp, b = *(const f32x4*)(sp + 4);
                sum[0] += a[0]; sum[1] += a[1]; sum[2] += a[2]; sum[3] += a[3]; sum[4] += b[0]; sum[5] += b[1]; sum[6] += b[2]; sum[7] += b[3];
            }
        }
        const int pos = (s >= 8 ? 16384 : 0) + l;
        const float inv = 1.f / (float)min(pos + 1, w);
        v4u o; o.x = pk2(sum[0] * inv - cur[0], sum[1] * inv - cur[1]); o.y = pk2(sum[2] * inv - cur[2], sum[3] * inv - cur[3]);
        o.z = pk2(sum[4] * inv - cur[4], sum[5] * inv - cur[5]); o.w = pk2(sum[6] * inv - cur[6], sum[7] * inv - cur[7]);
        *(v4u*)(P + (size_t)t * D + c0) = o;
    }
    for (size_t i = (size_t)c.gt; i < (size_t)136 * 15 * D; i += (size_t)c.NGT) {
        const int ch = (int)(i & 1023); const int j = (int)((i >> 10) % 15); const int s = (int)(i / (15 * 1024));
        if (s < 8) o_p[((size_t)s * 15 + j) * D + ch] = bf2f(U[(size_t)(s * 2048 + 2033 + j) * D + ch]);
        else { const int b = s - 8; o_s[((size_t)b * 15 + j) * D + ch] = (j < 7) ? c.in[c.z + 4][((size_t)b * 15 + 8 + j) * D + ch] : bf2f(U[(size_t)(TP + b * 8 + (j - 7)) * D + ch]); }
    }
}

__device__ __forceinline__ void phase_cmlp_ln(const Ctx& c) {
    bf16* Z = c.W<bf16>(WS_Q);
    float* o_v = c.out + 17825792 + 65536 + 122880 + 73728 + 2097152 + 1048576 + 1966080;
    const float* g = c.in[c.z + 25]; const float* b = c.in[c.z + 26];
    for (int t = c.gw; t < T; t += c.NGW) {
        bf16* vr = Z + (size_t)t * 2048 + 1024;
        f32x4 v[4];
#pragma unroll
        for (int h = 0; h < 2; ++h) {
            const v4u q = *(const v4u*)(vr + h * 512 + 8 * c.lane);
            v[2 * h] = (f32x4){bflo(q.x), bfhi(q.x), bflo(q.y), bfhi(q.y)}; v[2 * h + 1] = (f32x4){bflo(q.z), bfhi(q.z), bflo(q.w), bfhi(q.w)};
        }
        float mean, rstd; ln_stats(v, mean, rstd, c.lane);
#pragma unroll
        for (int h = 0; h < 2; ++h) {
            const int c0 = h * 512 + 8 * c.lane;
            const f32x4 g0 = *(const f32x4*)(g + c0), g1 = *(const f32x4*)(g + c0 + 4), b0 = *(const f32x4*)(b + c0), b1 = *(const f32x4*)(b + c0 + 4);
            const f32x4 o0 = (v[2 * h] - mean) * rstd * g0 + b0, o1 = (v[2 * h + 1] - mean) * rstd * g1 + b1;
            v4u w; w.x = pk2(o0[0], o0[1]); w.y = pk2(o0[2], o0[3]); w.z = pk2(o1[0], o1[1]); w.w = pk2(o1[2], o1[3]);
            *(v4u*)(vr + c0) = w;
            if (t >= TP) { *(f32x4*)(o_v + (size_t)(t - TP) * D + c0) = o0; *(f32x4*)(o_v + (size_t)(t - TP) * D + c0 + 4) = o1; }
        }
    }
}
constexpr int CM_LD = 136, CM_WS = 0  , CM_VT = 34816  ;
__device__ __forceinline__ void phase_cmlp_mix(const Ctx& c) {
    const bf16* Z = c.W<bf16>(WS_Q); bf16* O = c.W<bf16>(WS_A1);
    LAS unsigned char* lds = c.lds;
    const int tid = c.tid, lane = c.lane, w = c.wave, fr = lane & 15, fq = lane >> 4;
    for (int unit = c.bid; unit < 128 * 4; unit += c.nblk) {
        const int chunk = unit >> 2, hd = unit & 3, tokc = chunk * 128;
#pragma unroll
        for (int k = 0; k < 4; ++k) {
            const int q = tid + 512 * k, row = q >> 4, cc = q & 15;
            const float* src = c.in[c.z + 27] + ((size_t)hd * 128 + row) * 128 + cc * 8;
            const f32x4 a = *(const f32x4*)src, b = *(const f32x4*)(src + 4);
            float f[8] = {a[0], a[1], a[2], a[3], b[0], b[1], b[2], b[3]};
#pragma unroll
            for (int j = 0; j < 8; ++j) f[j] = (cc * 8 + j <= row) ? f[j] : 0.f;
            v4u o; o.x = pk2(f[0], f[1]); o.y = pk2(f[2], f[3]); o.z = pk2(f[4], f[5]); o.w = pk2(f[6], f[7]);
            *(LAS v4u*)(lds + CM_WS + (row * CM_LD + cc * 8) * 2) = o;
        }
        {
            const int srow = tid & 127, dq = tid >> 7;
            const bf16* vs = Z + (size_t)(tokc + srow) * 2048 + 1024 + hd * 256 + dq * 64;
#pragma unroll
            for (int k = 0; k < 8; ++k) {
                const v4u q = *(const v4u*)(vs + 8 * k);
                const unsigned xw[4] = {q.x, q.y, q.z, q.w};
#pragma unroll
                for (int j = 0; j < 4; ++j) {
                    *(LAS bf16*)(lds + CM_VT + ((dq * 64 + 8 * k + 2 * j) * CM_LD + srow) * 2) = (bf16)(xw[j] & 0xffffu);
                    *(LAS bf16*)(lds + CM_VT + ((dq * 64 + 8 * k + 2 * j + 1) * CM_LD + srow) * 2) = (bf16)(xw[j] >> 16);
                }
            }
        }
        __syncthreads();
        f32x4 acc[16];
#pragma unroll
        for (int jd = 0; jd < 16; ++jd) acc[jd] = (f32x4){0.f, 0.f, 0.f, 0.f};
#pragma unroll
        for (int ks = 0; ks < 4; ++ks) {
            if (ks <= (w >> 1)) {
                const bf16x8 wf = *(const LAS bf16x8*)(lds + CM_WS + ((16 * w + fr) * CM_LD + ks * 32 + 8 * fq) * 2);
#pragma unroll
                for (int jd = 0; jd < 16; ++jd)
                    acc[jd] = __builtin_amdgcn_mfma_f32_16x16x32_bf16(*(const LAS bf16x8*)(lds + CM_VT + ((16 * jd + fr) * CM_LD + ks * 32 + 8 * fq) * 2), wf, acc[jd], 0, 0, 0);
            }
        }
        {
            const int t = 16 * w + fr; const size_t tok = (size_t)(tokc + t);
            const float bs = c.in[c.z + 28][hd * 128 + t];
#pragma unroll
            for (int jd = 0; jd < 16; ++jd) {
                const v2u uq = *(const v2u*)(Z + tok * 2048 + hd * 256 + 16 * jd + 4 * fq);
                v2u o; o.x = pk2(bflo(uq.x) * (acc[jd][0] + bs), bfhi(uq.x) * (acc[jd][1] + bs)); o.y = pk2(bflo(uq.y) * (acc[jd][2] + bs), bfhi(uq.y) * (acc[jd][3] + bs));
                *(v2u*)(O + tok * D + hd * 256 + 16 * jd + 4 * fq) = o;
            }
        }
        __syncthreads();
    }
    for (size_t i = (size_t)c.gt; i < (size_t)(T - TP) * 128; i += (size_t)c.NGT) {
        const int t = TP + (int)(i >> 7), c0 = (int)(i & 127) * 8;
        const int hd = c0 >> 8, tp = (t - TP) & 7, base = t - tp;
        float acc[8];
        const float bs = c.in[c.z + 28][hd * 128 + tp];
#pragma unroll
        for (int j = 0; j < 8; ++j) acc[j] = bs;
        const float* wr = c.in[c.z + 27] + ((size_t)hd * 128 + tp) * 128;
        for (int sp = 0; sp <= tp; ++sp) {
            const float wv = wr[sp];
            const v4u q = *(const v4u*)(Z + (size_t)(base + sp) * 2048 + 1024 + c0);
            acc[0] += wv * bflo(q.x); acc[1] += wv * bfhi(q.x); acc[2] += wv * bflo(q.y); acc[3] += wv * bfhi(q.y);
            acc[4] += wv * bflo(q.z); acc[5] += wv * bfhi(q.z); acc[6] += wv * bflo(q.w); acc[7] += wv * bfhi(q.w);
        }
        const v4u uq = *(const v4u*)(Z + (size_t)t * 2048 + c0);
        v4u o; o.x = pk2(bflo(uq.x) * acc[0], bfhi(uq.x) * acc[1]); o.y = pk2(bflo(uq.y) * acc[2], bfhi(uq.y) * acc[3]);
        o.z = pk2(bflo(uq.z) * acc[4], bfhi(uq.z) * acc[5]); o.w = pk2(bflo(uq.w) * acc[6], bfhi(uq.w) * acc[7]);
        *(v4u*)(O + (size_t)t * D + c0) = o;
    }
}

__device__ __forceinline__ void phase_ssd_conv(const Ctx& c) {
    const bf16* X = c.W<bf16>(WS_XBC); bf16* XC = c.W<bf16>(WS_XC);
    float* o_p = c.out + 17825792 + 65536 + 122880, *o_s = c.out + 17825792 + 65536 + 122880 + 73728 + 2097152 + 1048576 + 1966080 + 1048576;
    for (size_t i = (size_t)c.gt; i < (size_t)T * (CONVD / 8); i += (size_t)c.NGT) {
        const int t = (int)(i / (CONVD / 8)), c0 = (int)(i % (CONVD / 8)) * 8;
        int s, l, tok0; tok_info(t, s, l, tok0);
        float acc[8];
        { const f32x4 a = *(const f32x4*)(c.in[c.z + 32] + c0), b = *(const f32x4*)(c.in[c.z + 32] + c0 + 4); acc[0] = a[0]; acc[1] = a[1]; acc[2] = a[2]; acc[3] = a[3]; acc[4] = b[0]; acc[5] = b[1]; acc[6] = b[2]; acc[7] = b[3]; }
#pragma unroll
        for (int k = 0; k < 4; ++k) {
            const int src = l + k - 3;
            float f[8];
            if (src >= 0) {
                const v4u q = *(const v4u*)(X + (size_t)(tok0 + src) * CONVD + c0);
                f[0] = bflo(q.x); f[1] = bfhi(q.x); f[2] = bflo(q.y); f[3] = bfhi(q.y); f[4] = bflo(q.z); f[5] = bfhi(q.z); f[6] = bflo(q.w); f[7] = bfhi(q.w);
            } else if (s >= 8) {
                const float* sp = c.in[c.z + 5] + ((size_t)(s - 8) * 3 + (l + k)) * CONVD + c0;
                const f32x4 a = *(const f32x4*)sp, b = *(const f32x4*)(sp + 4);
                f[0] = a[0]; f[1] = a[1]; f[2] = a[2]; f[3] = a[3]; f[4] = b[0]; f[5] = b[1]; f[6] = b[2]; f[7] = b[3];
            } else {
#pragma unroll
                for (int j = 0; j < 8; ++j) f[j] = 0.f;
            }
            const f32x4 wa = *(const f32x4*)(c.in[c.z + 31] + k * CONVD + c0), wb = *(const f32x4*)(c.in[c.z + 31] + k * CONVD + c0 + 4);
            acc[0] += f[0] * wa[0]; acc[1] += f[1] * wa[1]; acc[2] += f[2] * wa[2]; acc[3] += f[3] * wa[3];
            acc[4] += f[4] * wb[0]; acc[5] += f[5] * wb[1]; acc[6] += f[6] * wb[2]; acc[7] += f[7] * wb[3];
        }
        v4u o; o.x = pk2(silu_f(acc[0]), silu_f(acc[1])); o.y = pk2(silu_f(acc[2]), silu_f(acc[3])); o.z = pk2(silu_f(acc[4]), silu_f(acc[5])); o.w = pk2(silu_f(acc[6]), silu_f(acc[7]));
        *(v4u*)(XC + (size_t)t * CONVD + c0) = o;
    }
    for (size_t i = (size_t)c.gt; i < (size_t)136 * 3 * CONVD; i += (size_t)c.NGT) {
        const int ch = (int)(i % CONVD); const int j = (int)((i / CONVD) % 3); const int s = (int)(i / (3 * CONVD));
        if (s < 8) o_p[((size_t)s * 3 + j) * CONVD + ch] = bf2f(X[(size_t)(s * 2048 + 2045 + j) * CONVD + ch]);
        else { const int b = s - 8; o_s[((size_t)b * 3 + j) * CONVD + ch] = bf2f(X[(size_t)(TP + b * 8 + 5 + j) * CONVD + ch]); }
    }
}
constexpr int SD_LD = 136;
constexpr int SD_C = 0, SD_B = 34816, SD_BT = 69632, SD_XT = 104448, SD_HB = 121856, SD_VEC = 139264;
__device__ __forceinline__ float softplus_f(float x) { return (x > 20.f) ? x : log1pf(__expf(x)); }
__device__ __forceinline__ void phase_ssd_scan(const Ctx& c) {
    const bf16* XC = c.W<bf16>(WS_XC); const float* DT = c.W<float>(WS_DT); bf16* Y = c.W<bf16>(WS_Y);
    float* o_p = c.out + 17825792 + 65536 + 122880 + 73728;
    float* o_s = c.out + 17825792 + 65536 + 122880 + 73728 + 2097152 + 1048576 + 1966080 + 1048576 + 1179648;
    const int tid = c.tid, lane = c.lane, w = c.wave, fr = lane & 15, fq = lane >> 4;
    LAS unsigned char* lds = c.lds;
    LAS float* csv = (LAS float*)(lds + SD_VEC); LAS float* dtv = csv + 128;
#define SD_FRAG(img, row, ks) (*(const LAS bf16x8*)(lds + (img) + ((row) * SD_LD + (ks) * 32 + 8 * fq) * 2))
    for (int unit = c.bid; unit < 8 * 32; unit += c.nblk) {
        const int s = unit >> 5, hd = unit & 31, g = hd >> 3;
        const float a = -__expf(c.in[c.z + 34][hd]), dtb = c.in[c.z + 33][hd], dk = c.in[c.z + 35][hd];
        f32x4 hacc[4];
#pragma unroll
        for (int jp = 0; jp < 4; ++jp) hacc[jp] = (f32x4){0.f, 0.f, 0.f, 0.f};
        for (int ch = 0; ch < 16; ++ch) {
            const int tokc = s * 2048 + ch * 128;
            if (w == 0) {
                const float dt0 = softplus_f(DT[(size_t)(tokc + lane) * 32 + hd] + dtb), dt1 = softplus_f(DT[(size_t)(tokc + 64 + lane) * 32 + hd] + dtb);
                float s0 = dt0 * a, s1 = dt1 * a;
#pragma unroll
                for (int o = 1; o < 64; o <<= 1) {
                    const float u0 = __builtin_bit_cast(float, __builtin_amdgcn_ds_bpermute(((lane - o) & 63) << 2, __builtin_bit_cast(int, s0)));
                    const float u1 = __builtin_bit_cast(float, __builtin_amdgcn_ds_bpermute(((lane - o) & 63) << 2, __builtin_bit_cast(int, s1)));
                    if (lane >= o) { s0 += u0; s1 += u1; }
                }
                const float tot0 = __builtin_bit_cast(float, __builtin_amdgcn_readlane(__builtin_bit_cast(int, s0), 63));
                csv[lane] = s0; csv[64 + lane] = tot0 + s1; dtv[lane] = dt0; dtv[64 + lane] = dt1;
            }
#pragma unroll
            for (int k = 0; k < 4; ++k) {
                const int q = tid + 512 * k, row = q >> 4, cc = q & 15;
                const bf16* src = XC + (size_t)(tokc + row) * CONVD + g * 128 + cc * 8;
                *(LAS v4u*)(lds + SD_C + (row * SD_LD + cc * 8) * 2) = *(const v4u*)(src + 2560);
                *(LAS v4u*)(lds + SD_B + (row * SD_LD + cc * 8) * 2) = *(const v4u*)(src + 2048);
            }
#pragma unroll
            for (int jp = 0; jp < 4; ++jp) {
                v2u hq; hq.x = pk2(hacc[jp][0], hacc[jp][1]); hq.y = pk2(hacc[jp][2], hacc[jp][3]);
                *(LAS v2u*)(lds + SD_HB + ((16 * jp + fr) * SD_LD + 16 * w + 4 * fq) * 2) = hq;
            }
            __syncthreads();
            {
                const int srow = tid & 127, qq = tid >> 7;
                const float sc = __expf(csv[127] - csv[srow]) * dtv[srow];
#pragma unroll
                for (int k = 0; k < 4; ++k) {
                    const int n0 = qq * 32 + k * 8;
                    const v4u bq = *(const LAS v4u*)(lds + SD_B + (srow * SD_LD + n0) * 2);
                    const float f[8] = {bflo(bq.x), bfhi(bq.x), bflo(bq.y), bfhi(bq.y), bflo(bq.z), bfhi(bq.z), bflo(bq.w), bfhi(bq.w)};
#pragma unroll
                    for (int j = 0; j < 8; ++j) *(LAS bf16*)(lds + SD_BT + ((n0 + j) * SD_LD + srow) * 2) = (bf16)f2bf(f[j] * sc);
                }
                const bf16* xs = XC + (size_t)(tokc + srow) * CONVD + hd * 64 + qq * 16;
                const v4u x0 = *(const v4u*)xs, x1 = *(const v4u*)(xs + 8);
                const unsigned xw[8] = {x0.x, x0.y, x0.z, x0.w, x1.x, x1.y, x1.z, x1.w};
#pragma unroll
                for (int j = 0; j < 8; ++j) {
                    *(LAS bf16*)(lds + SD_XT + ((qq * 16 + 2 * j) * SD_LD + srow) * 2) = (bf16)(xw[j] & 0xffffu);
                    *(LAS bf16*)(lds + SD_XT + ((qq * 16 + 2 * j + 1) * SD_LD + srow) * 2) = (bf16)(xw[j] >> 16);
                }
            }
            __syncthreads();
            const int jmax = w | 1;
            bf16x8 Cf[4];
#pragma unroll
            for (int ks = 0; ks < 4; ++ks) Cf[ks] = SD_FRAG(SD_C, 16 * w + fr, ks);
            f32x4 acc[8];
#pragma unroll
            for (int j = 0; j < 8; ++j) {
                acc[j] = (f32x4){0.f, 0.f, 0.f, 0.f};
                if (j <= jmax) {
#pragma unroll
                    for (int ks = 0; ks < 4; ++ks) acc[j] = __builtin_amdgcn_mfma_f32_16x16x32_bf16(SD_FRAG(SD_B, 16 * j + fr, ks), Cf[ks], acc[j], 0, 0, 0);
                }
            }
            {
                const float cdec = __expf(csv[127]);
                bf16x8 Bt[4];
#pragma unroll
                for (int ks = 0; ks < 4; ++ks) Bt[ks] = SD_FRAG(SD_BT, 16 * w + fr, ks);
#pragma unroll
                for (int jp = 0; jp < 4; ++jp) {
                    hacc[jp] = hacc[jp] * cdec;
#pragma unroll
                    for (int ks = 0; ks < 4; ++ks) hacc[jp] = __builtin_amdgcn_mfma_f32_16x16x32_bf16(Bt[ks], SD_FRAG(SD_XT, 16 * jp + fr, ks), hacc[jp], 0, 0, 0);
                }
            }
            __syncthreads();
            {
                const int t = 16 * w + fr; const float cst = csv[t];
#pragma unroll
                for (int j = 0; j < 8; ++j) {
                    if (j <= jmax) {
                        const f32x4 css = *(const LAS f32x4*)(csv + 16 * j + 4 * fq), dts = *(const LAS f32x4*)(dtv + 16 * j + 4 * fq);
                        float v[4];
#pragma unroll
                        for (int r = 0; r < 4; ++r) v[r] = (16 * j + 4 * fq + r <= t) ? acc[j][r] * __expf(cst - css[r]) * dts[r] : 0.f;
                        v2u lq; lq.x = pk2(v[0], v[1]); lq.y = pk2(v[2], v[3]);
                        *(LAS v2u*)(lds + SD_B + (t * SD_LD + 16 * j + 4 * fq) * 2) = lq;
                    }
                }
            }
            __syncthreads();
            {
                f32x4 a1[4], a2[4];
#pragma unroll
                for (int jp = 0; jp < 4; ++jp) { a1[jp] = (f32x4){0.f, 0.f, 0.f, 0.f}; a2[jp] = (f32x4){0.f, 0.f, 0.f, 0.f}; }
#pragma unroll
                for (int ks = 0; ks < 4; ++ks) {
                    if (ks <= (w >> 1)) {
                        const bf16x8 Lf = SD_FRAG(SD_B, 16 * w + fr, ks);
#pragma unroll
                        for (int jp = 0; jp < 4; ++jp) a1[jp] = __builtin_amdgcn_mfma_f32_16x16x32_bf16(SD_FRAG(SD_XT, 16 * jp + fr, ks), Lf, a1[jp], 0, 0, 0);
                    }
#pragma unroll
                    for (int jp = 0; jp < 4; ++jp) a2[jp] = __builtin_amdgcn_mfma_f32_16x16x32_bf16(SD_FRAG(SD_HB, 16 * jp + fr, ks), Cf[ks], a2[jp], 0, 0, 0);
                }
                const int t = 16 * w + fr; const float ecs = __expf(csv[t]);
                const size_t tok = (size_t)(tokc + t);
#pragma unroll
                for (int jp = 0; jp < 4; ++jp) {
                    const v2u xq = *(const v2u*)(XC + tok * CONVD + hd * 64 + 16 * jp + 4 * fq);
                    v2u yo; yo.x = pk2(a1[jp][0] + ecs * a2[jp][0] + dk * bflo(xq.x), a1[jp][1] + ecs * a2[jp][1] + dk * bfhi(xq.x));
                    yo.y = pk2(a1[jp][2] + ecs * a2[jp][2] + dk * bflo(xq.y), a1[jp][3] + ecs * a2[jp][3] + dk * bfhi(xq.y));
                    *(v2u*)(Y + tok * 2048 + hd * 64 + 16 * jp + 4 * fq) = yo;
                }
            }
            __syncthreads();
        }
#pragma unroll
        for (int jp = 0; jp < 4; ++jp) *(f32x4*)(o_p + (((size_t)s * 32 + hd) * 64 + 16 * jp + fr) * 128 + 16 * w + 4 * fq) = hacc[jp];
    }
#undef SD_FRAG
    __syncthreads();
    {
        LAS float* Bw = (LAS float*)(lds + w * 8192);
        LAS float* Cw = Bw + 1024;
        for (int unit = c.gw; unit < 128 * 32; unit += c.NGW) {
            const int b = unit >> 5, hd = unit & 31, g = hd >> 3, tok0 = TP + b * 8, p = lane;
            const float a = -__expf(c.in[c.z + 34][hd]), dtb = c.in[c.z + 33][hd], dk = c.in[c.z + 35][hd];
            {
                const int tk = lane >> 3, c0 = (lane & 7) * 16;
                const bf16* src = XC + (size_t)(tok0 + tk) * CONVD + g * 128 + c0;
                const v4u b0 = *(const v4u*)(src + 2048), b1 = *(const v4u*)(src + 2048 + 8), c0v = *(const v4u*)(src + 2560), c1v = *(const v4u*)(src + 2560 + 8);
                LAS float* bd = Bw + tk * 128 + c0; LAS float* cd = Cw + tk * 128 + c0;
                *(LAS f32x4*)(bd) = (f32x4){bflo(b0.x), bfhi(b0.x), bflo(b0.y), bfhi(b0.y)}; *(LAS f32x4*)(bd + 4) = (f32x4){bflo(b0.z), bfhi(b0.z), bflo(b0.w), bfhi(b0.w)};
                *(LAS f32x4*)(bd + 8) = (f32x4){bflo(b1.x), bfhi(b1.x), bflo(b1.y), bfhi(b1.y)}; *(LAS f32x4*)(bd + 12) = (f32x4){bflo(b1.z), bfhi(b1.z), bflo(b1.w), bfhi(b1.w)};
                *(LAS f32x4*)(cd) = (f32x4){bflo(c0v.x), bfhi(c0v.x), bflo(c0v.y), bfhi(c0v.y)}; *(LAS f32x4*)(cd + 4) = (f32x4){bflo(c0v.z), bfhi(c0v.z), bflo(c0v.w), bfhi(c0v.w)};
                *(LAS f32x4*)(cd + 8) = (f32x4){bflo(c1v.x), bfhi(c1v.x), bflo(c1v.y), bfhi(c1v.y)}; *(LAS f32x4*)(cd + 12) = (f32x4){bflo(c1v.z), bfhi(c1v.z), bflo(c1v.w), bfhi(c1v.w)};
            }
            float xv[8], dA[8], coef[8], yv[8];
#pragma unroll
            for (int t = 0; t < 8; ++t) {
                xv[t] = bf2f(XC[(size_t)(tok0 + t) * CONVD + hd * 64 + p]);
                const float dtv_ = softplus_f(DT[(size_t)(tok0 + t) * 32 + hd] + dtb);
                dA[t] = __expf(dtv_ * a); coef[t] = dtv_ * xv[t]; yv[t] = dk * xv[t];
            }
            asm volatile("s_waitcnt lgkmcnt(0)" ::: "memory");
            const float* hin = c.in[c.z + 6] + (((size_t)b * 32 + hd) * 64 + p) * 128;
            float* hout = o_s + (((size_t)b * 32 + hd) * 64 + p) * 128;
#pragma unroll 1
            for (int qt = 0; qt < 4; ++qt) {
                float h[32];
#pragma unroll
                for (int i = 0; i < 8; ++i) { const f32x4 q = *(const f32x4*)(hin + qt * 32 + 4 * i); h[4 * i] = q[0]; h[4 * i + 1] = q[1]; h[4 * i + 2] = q[2]; h[4 * i + 3] = q[3]; }
#pragma unroll
                for (int t = 0; t < 8; ++t) {
                    float ya = 0.f, yb = 0.f;
#pragma unroll
                    for (int i = 0; i < 8; ++i) {
                        const f32x4 bq = *(const LAS f32x4*)(Bw + t * 128 + qt * 32 + 4 * i), cq = *(const LAS f32x4*)(Cw + t * 128 + qt * 32 + 4 * i);
                        h[4 * i] = h[4 * i] * dA[t] + coef[t] * bq[0]; ya += cq[0] * h[4 * i];
                        h[4 * i + 1] = h[4 * i + 1] * dA[t] + coef[t] * bq[1]; yb += cq[1] * h[4 * i + 1];
                        h[4 * i + 2] = h[4 * i + 2] * dA[t] + coef[t] * bq[2]; ya += cq[2] * h[4 * i + 2];
                        h[4 * i + 3] = h[4 * i + 3] * dA[t] + coef[t] * bq[3]; yb += cq[3] * h[4 * i + 3];
                    }
                    yv[t] += ya + yb;
                    asm volatile("" ::: "memory");
                }
#pragma unroll
                for (int i = 0; i < 8; ++i) *(f32x4*)(hout + qt * 32 + 4 * i) = (f32x4){h[4 * i], h[4 * i + 1], h[4 * i + 2], h[4 * i + 3]};
            }
#pragma unroll
            for (int t = 0; t < 8; ++t) Y[(size_t)(tok0 + t) * 2048 + hd * 64 + p] = (bf16)f2bf(yv[t]);
            asm volatile("" ::: "memory");
        }
    }
}
__device__ __forceinline__ void phase_ssd_gatenorm(const Ctx& c) {
    const bf16* Y = c.W<bf16>(WS_Y); const bf16* Z = c.W<bf16>(WS_Q); bf16* YN = c.W<bf16>(WS_YN);
    for (int it = c.gw; it < T * 4; it += c.NGW) {
        const int t = it >> 2, c0 = (it & 3) * 512 + 8 * c.lane;
        const v4u yq = *(const v4u*)(Y + (size_t)t * 2048 + c0), zq = *(const v4u*)(Z + (size_t)t * 2048 + c0);
        const float yf[8] = {bflo(yq.x), bfhi(yq.x), bflo(yq.y), bfhi(yq.y), bflo(yq.z), bfhi(yq.z), bflo(yq.w), bfhi(yq.w)};
        const float zf[8] = {bflo(zq.x), bfhi(zq.x), bflo(zq.y), bfhi(zq.y), bflo(zq.z), bfhi(zq.z), bflo(zq.w), bfhi(zq.w)};
        float v[8]; float q = 0.f;
#pragma unroll
        for (int j = 0; j < 8; ++j) { v[j] = yf[j] * silu_f(zf[j]); q += v[j] * v[j]; }
        const float r = rsqrtf(wave_sum(q, c.lane) * (1.f / 512.f) + RMS_EPS);
        const f32x4 g0 = *(const f32x4*)(c.in[c.z + 36] + c0), g1 = *(const f32x4*)(c.in[c.z + 36] + c0 + 4);
        v4u o; o.x = pk2(v[0] * r * g0[0], v[1] * r * g0[1]); o.y = pk2(v[2] * r * g0[2], v[3] * r * g0[3]); o.z = pk2(v[4] * r * g1[0], v[5] * r * g1[1]); o.w = pk2(v[6] * r * g1[2], v[7] * r * g1[3]);
        *(v4u*)(YN + (size_t)t * 2048 + c0) = o;
    }
}

__device__ __forceinline__ unsigned ord_key(float s) { const unsigned u = __builtin_bit_cast(unsigned, s); return (u & 0x80000000u) ? ~u : (u | 0x80000000u); }
__device__ __forceinline__ float ord_dec(unsigned k) { const unsigned u = (k & 0x80000000u) ? (k & 0x7fffffffu) : ~k; return __builtin_bit_cast(float, u); }
__device__ __forceinline__ void ins16(unsigned (&Lk)[16], unsigned x) {
#pragma unroll
    for (int k = 0; k < 16; ++k) { const unsigned hi = max(Lk[k], x); x = min(Lk[k], x); Lk[k] = hi; }
}
__device__ __forceinline__ void ce_desc(unsigned& a, unsigned& b) { const unsigned hi = max(a, b), lo = min(a, b); a = hi; b = lo; }
__device__ __forceinline__ void ce_asc(unsigned& a, unsigned& b) { const unsigned hi = max(a, b), lo = min(a, b); a = lo; b = hi; }
__device__ __forceinline__ void sort16_desc(unsigned (&a)[16]) {
#pragma unroll
    for (int k = 2; k <= 16; k <<= 1)
#pragma unroll
        for (int j = k >> 1; j > 0; j >>= 1)
#pragma unroll
            for (int i = 0; i < 16; ++i) { const int l = i ^ j; if (l > i) { if ((i & k) == 0) ce_desc(a[i], a[l]); else ce_asc(a[i], a[l]); } }
}
__device__ __forceinline__ void bmerge16_desc(unsigned (&a)[16]) {
#pragma unroll
    for (int j = 8; j > 0; j >>= 1)
#pragma unroll
        for (int i = 0; i < 16; ++i) { const int l = i ^ j; if (l > i) ce_desc(a[i], a[l]); }
}
__device__ __forceinline__ void xmerge16(unsigned (&a)[16], int o, int lane) {
    unsigned pq[16];
#pragma unroll
    for (int k = 0; k < 16; ++k) pq[k] = (unsigned)__builtin_amdgcn_ds_bpermute((lane ^ o) << 2, (int)a[k]);
#pragma unroll
    for (int k = 0; k < 16; ++k) a[k] = max(a[k], pq[15 - k]);
    bmerge16_desc(a);
}
struct CandTab { unsigned char v[52]; };
constexpr CandTab make_cands() { CandTab t{}; int n = 0; for (int i = 0; i < 16; ++i) for (int j = 0; j < 16; ++j) if ((i + 1) * (j + 1) <= 16) t.v[n++] = (unsigned char)(i * 16 + j); return t; }
__device__ __forceinline__ void phase_route(const Ctx& c, int layer) {
    constexpr CandTab CT = make_cands();
    const bf16* Q = c.W<bf16>(WS_Q); const bf16* KEYS = c.W<bf16>(WS_KEYS) + (size_t)layer * 8 * 2 * 128 * 128;
    int* IDX = c.W<int>(WS_IDX); float* GATE = c.W<float>(WS_GATE); float* SCU = c.W<float>(WS_SCU);
    const float* ISU = c.W<float>(WS_SMALL) + SM_ISU; const float* ISV = c.W<float>(WS_SMALL) + SM_ISV;
    const int lane = c.lane, fr = lane & 15, fq = lane >> 4;
    constexpr int RK_LD = 136, RK_BYTES = 2 * 128 * RK_LD * 2;
    LAS unsigned* lists = (LAS unsigned*)(c.lds + RK_BYTES + c.wave * 2048);
    const int h = c.bid & 7;
    {
        const bf16* kg = KEYS + (size_t)h * 2 * 128 * 128;
        for (int q = c.tid; q < 2 * 128 * 16; q += NTHR) { const int row = q >> 4, cc = q & 15; *(LAS v4u*)(c.lds + (row * RK_LD + cc * 8) * 2) = *(const v4u*)(kg + (size_t)row * 128 + cc * 8); }
    }
    __syncthreads();
    const int nb8 = c.nblk >> 3;
    for (int tg = (c.bid >> 3) + nb8 * c.wave; tg < 1088; tg += nb8 * NWAVES) {
        const int tok0 = tg * 16;
        const bf16* qrow = Q + (size_t)(tok0 + fr) * 2048 + h * 256 + 8 * fq;
#pragma unroll
        for (int side = 0; side < 2; ++side) {
            bf16x8 qf[4];
#pragma unroll
            for (int ks = 0; ks < 4; ++ks) qf[ks] = *(const bf16x8*)(qrow + side * 128 + ks * 32);
            const LAS unsigned char* kb = c.lds + ((side * 128 + fr) * RK_LD + 8 * fq) * 2;
            unsigned A[16], B[16];
#pragma unroll
            for (int nt = 0; nt < 8; ++nt) {
                f32x4 acc = {0.f, 0.f, 0.f, 0.f};
#pragma unroll
                for (int ks = 0; ks < 4; ++ks) acc = __builtin_amdgcn_mfma_f32_16x16x32_bf16(*(const LAS bf16x8*)(kb + (nt * 16 * RK_LD + ks * 32) * 2), qf[ks], acc, 0, 0, 0);
#pragma unroll
                for (int r = 0; r < 4; ++r) {
                    const unsigned key = (ord_key(acc[r]) & ~127u) | (unsigned)(127 - (16 * nt + 4 * fq + r));
                    if (nt < 4) A[nt * 4 + r] = key; else B[(nt - 4) * 4 + r] = key;
                }
            }
            sort16_desc(A); sort16_desc(B);
#pragma unroll
            for (int k = 0; k < 16; ++k) A[k] = max(A[k], B[15 - k]);
            bmerge16_desc(A);
            xmerge16(A, 16, lane); xmerge16(A, 32, lane);
            if (fq == 0) {
#pragma unroll
                for (int k = 0; k < 4; ++k) *(LAS v4u*)(lists + (fr * 2 + side) * 16 + 4 * k) = (v4u){A[4 * k], A[4 * k + 1], A[4 * k + 2], A[4 * k + 3]};
            }
        }
        asm volatile("s_waitcnt lgkmcnt(0)" ::: "memory");
        int fq2 = fq, fr2 = fr; asm volatile("" : "+v"(fq2), "+v"(fr2));
        unsigned Cd[16];
#pragma unroll
        for (int k = 0; k < 13; ++k) {
            const int ij = (fq2 == 0) ? CT.v[k] : (fq2 == 1) ? CT.v[13 + k] : (fq2 == 2) ? CT.v[26 + k] : ((39 + k < 50) ? CT.v[(39 + k < 50) ? 39 + k : 0] : 0);
            const bool ok = (fq2 < 3) || (39 + k < 50);
            const unsigned k0 = lists[(fr2 * 2) * 16 + (ij >> 4)], k1 = lists[(fr2 * 2 + 1) * 16 + (ij & 15)];
            const unsigned x = (ord_key(ord_dec(k0 & ~127u) + ord_dec(k1 & ~127u)) & ~255u) | (unsigned)(255 - ij);
            Cd[k] = ok ? x : 0u;
        }
        Cd[13] = 0u; Cd[14] = 0u; Cd[15] = 0u;
        sort16_desc(Cd);
        xmerge16(Cd, 16, lane); xmerge16(Cd, 32, lane);
        float e[16], su[16]; int id[16]; float mx = 0.f, den = 0.f;
#pragma unroll
        for (int k = 0; k < 16; ++k) {
            const int pay = 255 - (int)(Cd[k] & 255u), i = pay >> 4, j = pay & 15;
            const unsigned k0 = lists[(fr2 * 2) * 16 + i], k1 = lists[(fr2 * 2 + 1) * 16 + j];
            id[k] = (127 - (int)(k0 & 127u)) * 128 + (127 - (int)(k1 & 127u));
            const float sv = ord_dec(k0 & ~127u) + ord_dec(k1 & ~127u);
            if (k == 0) mx = sv;
            e[k] = __expf(sv - mx); den += e[k];
        }
        const float inv = 1.f / den;
        int oi[4]; float og[4], ou[4];
#pragma unroll
        for (int r = 0; r < 4; ++r) {
            oi[r] = (fq2 == 0) ? id[r] : (fq2 == 1) ? id[4 + r] : (fq2 == 2) ? id[8 + r] : id[12 + r];
            og[r] = (fq2 == 0) ? e[r] : (fq2 == 1) ? e[4 + r] : (fq2 == 2) ? e[8 + r] : e[12 + r];
        }
#pragma unroll
        for (int r = 0; r < 4; ++r) { ou[r] = ISU[oi[r]]; og[r] *= inv * ISV[oi[r]]; }
        const size_t ob = (size_t)(tok0 + fr2) * 128 + h * 16 + 4 * fq2;
        *(int4*)(IDX + ob) = make_int4(oi[0], oi[1], oi[2], oi[3]);
        *(f32x4*)(GATE + ob) = (f32x4){og[0], og[1], og[2], og[3]};
        *(f32x4*)(SCU + ob) = (f32x4){ou[0], ou[1], ou[2], ou[3]};
        asm volatile("" ::: "memory");
        (void)su;
    }
}

typedef float f32x2 __attribute__((ext_vector_type(2)));
#define CVT8(wd, hi) __builtin_amdgcn_cvt_pk_f32_fp8((int)(wd), (hi))
__device__ __forceinline__ void phase_gather(const Ctx& c, int layer, bool dummy) {
    const unsigned char* EU = c.ws + WS_EU; const unsigned char* EV = c.ws + WS_EV;
    const int* IDX = c.W<int>(WS_IDX); const float* GATE = c.W<float>(WS_GATE); const float* SCU = c.W<float>(WS_SCU);
    const float* H = c.W<float>(WS_H32); float* Ho = dummy ? c.W<float>(WS_R32) : c.W<float>(WS_H32); bf16* HB = dummy ? c.W<bf16>(WS_A0) : c.W<bf16>(WS_HB);
    const float* g = c.in[c.z + 40] + layer * D; const float* b = c.in[c.z + 41] + layer * D;
    const int lane = c.lane;
    const int ntw = (T - c.gw + c.NGW - 1) / c.NGW, nit = ntw * 8;
#define GT_TOK(it) (c.gw + ((it) >> 3) * c.NGW)
#define GT_IDX(it) (((it) < nit) ? IDX[(size_t)GT_TOK(it) * 128 + ((it) & 7) * 16 + (lane & 15)] : 0)
#define GT_GS(P, it) ((P)[(size_t)GT_TOK((it) < nit ? (it) : 0) * 128 + ((it) & 7) * 16 + ((lane >> 2) & 15)])
    int idx_c = GT_IDX(0), idx_n = GT_IDX(1);
    float gate_c = GT_GS(GATE, 0), scu_c = GT_GS(SCU, 0);
    f32x2 x2[8], xn[8], acc[8];
#pragma unroll
    for (int k = 0; k < 4; ++k) { const f32x4 hx = *(const f32x4*)(H + (size_t)c.gw * D + 16 * lane + 4 * k); xn[2 * k] = (f32x2){hx[0], hx[1]}; xn[2 * k + 1] = (f32x2){hx[2], hx[3]}; }
    v4u ru[16], rv[16];
#pragma unroll
    for (int e = 0; e < 16; ++e) {
        const int id = __builtin_amdgcn_readlane(idx_c, e);
        ru[e] = *(const v4u*)(EU + (size_t)id * D + 16 * lane); rv[e] = *(const v4u*)(EV + (size_t)id * D + 16 * lane);
    }
    for (int it = 0; it < nit; ++it) {
        const int t = GT_TOK(it), bt = it & 7;
        const int idx_nn = GT_IDX(it + 2);
        const float gate_n = GT_GS(GATE, it + 1), scu_n = GT_GS(SCU, it + 1);
        const float mygate = gate_c, myscu = scu_c;
        if (bt == 0) {
#pragma unroll
            for (int i = 0; i < 8; ++i) { x2[i] = xn[i]; acc[i] = (f32x2){0.f, 0.f}; }
        }
        if (bt == 7 && it + 1 < nit) {
            const int tn = GT_TOK(it + 1);
#pragma unroll
            for (int k = 0; k < 4; ++k) { const f32x4 hx = *(const f32x4*)(H + (size_t)tn * D + 16 * lane + 4 * k); xn[2 * k] = (f32x2){hx[0], hx[1]}; xn[2 * k + 1] = (f32x2){hx[2], hx[3]}; }
        }
        float pv[16];
#pragma unroll
        for (int e = 0; e < 16; ++e) {
            const v4u w = ru[e];
            f32x2 d = CVT8(w.x, false) * x2[0];
            d += CVT8(w.x, true) * x2[1]; d += CVT8(w.y, false) * x2[2]; d += CVT8(w.y, true) * x2[3];
            d += CVT8(w.z, false) * x2[4]; d += CVT8(w.z, true) * x2[5]; d += CVT8(w.w, false) * x2[6]; d += CVT8(w.w, true) * x2[7];
            pv[e] = d.x + d.y;
            ru[e] = *(const v4u*)(EU + (size_t)__builtin_amdgcn_readlane(idx_n, e) * D + 16 * lane);
        }
        const float tot = reduce16(pv, lane);
        const float wgt = mygate * gelu_f(tot * myscu);
#pragma unroll
        for (int e = 0; e < 16; ++e) {
            const float we = __builtin_bit_cast(float, __builtin_amdgcn_readlane(__builtin_bit_cast(int, wgt), 4 * e));
            const v4u w = rv[e];
            acc[0] += CVT8(w.x, false) * we; acc[1] += CVT8(w.x, true) * we; acc[2] += CVT8(w.y, false) * we; acc[3] += CVT8(w.y, true) * we;
            acc[4] += CVT8(w.z, false) * we; acc[5] += CVT8(w.z, true) * we; acc[6] += CVT8(w.w, false) * we; acc[7] += CVT8(w.w, true) * we;
            rv[e] = *(const v4u*)(EV + (size_t)__builtin_amdgcn_readlane(idx_n, e) * D + 16 * lane);
        }
        if (bt == 7) {
            f32x4 v[4];
#pragma unroll
            for (int k = 0; k < 4; ++k) v[k] = (f32x4){x2[2 * k].x, x2[2 * k].y, x2[2 * k + 1].x, x2[2 * k + 1].y} * ALPHA + (f32x4){acc[2 * k].x, acc[2 * k].y, acc[2 * k + 1].x, acc[2 * k + 1].y};
            float mean, rstd; ln_stats(v, mean, rstd, lane);
            float* o32 = ((layer == 3 && !dummy) ? c.out : Ho) + (size_t)t * D + 16 * lane;
            bf16* ob = (layer == 3 && !dummy) ? (bf16*)nullptr : HB + (size_t)t * D + 16 * lane;
            v4u wb[2];
#pragma unroll
            for (int k = 0; k < 4; ++k) {
                const f32x4 g4 = *(const f32x4*)(g + 16 * lane + 4 * k), b4 = *(const f32x4*)(b + 16 * lane + 4 * k);
                const f32x4 o = (v[k] - mean) * rstd * g4 + b4;
                *(f32x4*)(o32 + 4 * k) = o;
                if (k & 1) { wb[k >> 1].z = pk2(o[0], o[1]); wb[k >> 1].w = pk2(o[2], o[3]); } else { wb[k >> 1].x = pk2(o[0], o[1]); wb[k >> 1].y = pk2(o[2], o[3]); }
            }
            if (ob) { *(v4u*)(ob) = wb[0]; *(v4u*)(ob + 8) = wb[1]; }
        }
        idx_c = idx_n; idx_n = idx_nn; gate_c = gate_n; scu_c = scu_n;
    }
#undef GT_GS
#undef GT_TOK
#undef GT_IDX
}

#define XB_TMO      128
#define XB_XCNT(j)  (256  + 64 * (j))
#define XB_XSUB(j)  (1280 + 64 * (j))
#define XB_XGEN(j)  (2304 + 64 * (j))
#define XB_TOP      3328
#define XB_TOPGEN   3392
#define XCD_BAR_WORDS 3456
#define XB_SPIN_CAP (1u << 22)
__device__ __forceinline__ unsigned xb_ld(unsigned* p)              { return __hip_atomic_load(p, __ATOMIC_RELAXED, __HIP_MEMORY_SCOPE_AGENT); }
__device__ __forceinline__ unsigned xb_add(unsigned* p, unsigned v) { return __hip_atomic_fetch_add(p, v, __ATOMIC_RELAXED, __HIP_MEMORY_SCOPE_AGENT); }
__device__ __forceinline__ unsigned xb_xcc_id() { return (unsigned)__builtin_amdgcn_s_getreg((3 << 11) | 20) & 0xFu; }
#define XB_SPIN(cond, bar) do { unsigned _sp = 0; while (cond) { __builtin_amdgcn_s_sleep(1); \
    if ((++_sp & 255u) == 0u) { if (xb_ld(&(bar)[XB_TMO])) break; if (_sp > XB_SPIN_CAP) { atomicAdd(&(bar)[XB_TMO], 1u); break; } } } } while (0)
struct XcdBarrier { unsigned* bar; unsigned x; volatile LAS unsigned* st; };
__device__ __forceinline__ XcdBarrier xcd_barrier_post(unsigned* bar, volatile LAS unsigned* st) {
    XcdBarrier b; b.bar = bar; b.x = xb_xcc_id(); b.st = st;
    if (threadIdx.x == 0) (void)xb_add(&bar[XB_XCNT(b.x)], 1u);
    return b;
}
__device__ __forceinline__ void xcd_barrier_complete(unsigned* bar, unsigned x, unsigned& nloc, unsigned& nx) {
    const unsigned G = gridDim.x * gridDim.y * gridDim.z;
    unsigned sum, cnt, mine, sp = 0u;
    for (;;) {
        sum = 0u; cnt = 0u; mine = 0u;
#pragma unroll
        for (unsigned j = 0; j < 16; ++j) { const unsigned cc = xb_ld(&bar[XB_XCNT(j)]); sum += cc; cnt += (cc > 0u) ? 1u : 0u; mine = (j == x) ? cc : mine; }
        if (sum == G) break;
        __builtin_amdgcn_s_sleep(1);
        if ((++sp & 255u) == 0u) { if (xb_ld(&bar[XB_TMO])) break; if (sp > XB_SPIN_CAP) { atomicAdd(&bar[XB_TMO], 1u); break; } }
    }
    nloc = mine > 0u ? mine : 1u; nx = cnt > 0u ? cnt : 1u;
}
__device__ __forceinline__ void xcd_barrier(const XcdBarrier& b, int tid) {
    asm volatile("s_waitcnt vmcnt(0)" ::: "memory");
    __syncthreads();
    if (tid == 0) {
        unsigned* bar = b.bar;
        __builtin_amdgcn_s_waitcnt(0);
        unsigned nloc = b.st[0], nx = b.st[1];
        if (nloc == 0u) { xcd_barrier_complete(bar, b.x, nloc, nx); b.st[0] = nloc; b.st[1] = nx; }
        const unsigned old = xb_add(&bar[XB_XSUB(b.x)], 1u);
        const unsigned gen = old / nloc;
        if (old + 1u == (gen + 1u) * nloc) {
            __builtin_amdgcn_fence(__ATOMIC_RELEASE, "agent");
            asm volatile("s_waitcnt vmcnt(0)" ::: "memory");
            const unsigned og = xb_add(&bar[XB_TOP], 1u);
            const unsigned tg = og / nx;
            if (og + 1u == (tg + 1u) * nx) xb_add(&bar[XB_TOPGEN], 1u);
            else XB_SPIN(xb_ld(&bar[XB_TOPGEN]) == tg, bar);
            __builtin_amdgcn_fence(__ATOMIC_ACQUIRE, "agent");
            xb_add(&bar[XB_XGEN(b.x)], 1u);
            asm volatile("s_waitcnt vmcnt(0)" ::: "memory");
        } else {
            XB_SPIN(xb_ld(&bar[XB_XGEN(b.x)]) == gen, bar);
            __builtin_amdgcn_fence(__ATOMIC_ACQUIRE, "agent");
            asm volatile("s_waitcnt vmcnt(0)" ::: "memory");
        }
    }
    __syncthreads();
}

__global__ void __launch_bounds__(NTHR, 2) mega(Params P) {
    extern __shared__ __attribute__((aligned(16))) unsigned char lds_raw[];
    cg::grid_group grid = cg::this_grid();
    Ctx c;
    c.in = P.in; c.out = P.out; c.ws = P.ws; c.lds = (LAS unsigned char*)lds_raw; c.z = 0;
    c.tid = threadIdx.x; c.lane = c.tid & 63; c.wave = __builtin_amdgcn_readfirstlane(c.tid >> 6);
    c.gw = (int)blockIdx.x * NWAVES + c.wave; c.NGW = (int)gridDim.x * NWAVES; c.gt = (int)blockIdx.x * NTHR + c.tid; c.NGT = (int)gridDim.x * NTHR; c.bid = (int)blockIdx.x; c.nblk = (int)gridDim.x;
#define RF() do { int zs_ = 0; asm volatile("" : "+s"(zs_)); c.z = zs_; c.lds = (LAS unsigned char*)lds_raw + zs_; int z_ = 0; asm volatile("" : "+v"(z_)); const int l_ = (int)__builtin_amdgcn_mbcnt_hi(~0u, __builtin_amdgcn_mbcnt_lo(~0u, (unsigned)z_)); c.lane = l_; c.tid = c.wave * 64 + l_; c.bid = (int)blockIdx.x + zs_; c.nblk = (int)gridDim.x + zs_; c.gw = c.bid * NWAVES + c.wave; c.NGW = c.nblk * NWAVES; c.gt = c.bid * NTHR + c.tid; c.NGT = c.nblk * NTHR; } while (0)
    bf16* HB = c.W<bf16>(WS_HB); bf16* A0 = c.W<bf16>(WS_A0); bf16* A1 = c.W<bf16>(WS_A1); bf16* A2 = c.W<bf16>(WS_A2); bf16* Qb = c.W<bf16>(WS_Q);
    float* H32 = c.W<float>(WS_H32); float* R32 = c.W<float>(WS_R32);

    if (threadIdx.x < 16) ((volatile LAS unsigned*)(c.lds + MISC_OFF))[threadIdx.x] = 0u;
    __syncthreads();
    const XcdBarrier xbar = xcd_barrier_post(c.W<unsigned>(WS_CTL), (volatile LAS unsigned*)(c.lds + MISC_OFF));
#define GSYNC() do { RF(); xcd_barrier(xbar, c.tid); } while (0)
    RF(); prologue(c);
    grid.sync();
    for (int layer = 0; layer < 4; ++layer) {
        if (layer <= 1) {
            const bf16* Wt = c.W<bf16>(layer == 0 ? WS_W_S5IN : WS_W_PIN);
            RF(); run_gemm(c, HB, D, 0, Wt, 1024, 1024, EpiBf16<0>{A0, D, nullptr, nullptr, nullptr});
        } else if (layer == 2) {
            RF(); run_gemm(c, HB, D, 0, c.W<bf16>(WS_W_CIN), 2048, 1024, EpiBf16<1>{Qb, 2048, c.in[c.z + 24], nullptr, nullptr});
        } else {
            RF(); run_gemm(c, HB, D, 0, c.W<bf16>(WS_W_SIN), NPROJ, 1024, EpiSsdProj{Qb, c.W<bf16>(WS_XBC), c.W<float>(WS_DT)});
        }
        GSYNC();
        const bf16* Aout = A2; const bf16* Wout;
        if (layer == 0) {
            for (int r = 0; r < PR_S5; ++r) { RF(); phase_s5scan(c); }
            GSYNC();
            RF(); run_gemm(c, A1, D, 0, c.W<bf16>(WS_W_S5GLU), 1024, 1024, EpiBf16<3>{A2, D, c.in[c.z + 17], nullptr, A1});
            Wout = c.W<bf16>(WS_W_S5OUT);
        } else if (layer == 1) {
            RF(); phase_pool(c);
            GSYNC();
            RF(); run_gemm(c, A1, D, 256, c.W<bf16>(WS_W_PGRP), 1024, 256, EpiBf16<2>{A2, D, nullptr, c.in[c.z + 21], nullptr});
            Wout = c.W<bf16>(WS_W_POUT);
        } else if (layer == 2) {
            RF(); phase_cmlp_ln(c);
            GSYNC();
            RF(); phase_cmlp_mix(c);
            Aout = A1; Wout = c.W<bf16>(WS_W_COUT);
        } else {
            RF(); phase_ssd_conv(c);
            GSYNC();
            for (int r = 0; r < PR_SSD; ++r) { RF(); phase_ssd_scan(c); }
            GSYNC();
            RF(); phase_ssd_gatenorm(c);
            Aout = c.W<bf16>(WS_YN); Wout = c.W<bf16>(WS_W_SOUT);
        }
        GSYNC();
        if (layer == 3) { RF(); run_gemm(c, Aout, 2048, 0, Wout, 1024, 2048, EpiResid{H32, R32}); }
        else { RF(); run_gemm(c, Aout, 1024, 0, Wout, 1024, 1024, EpiResid{H32, R32}); }
        GSYNC();
        RF(); phase_ln1(c, layer);
        if (layer > 0) { RF(); cvt_tables(c, layer); }
        GSYNC();
        RF(); run_gemm(c, HB, D, 0, c.W<bf16>(WS_W_PQ) + (size_t)layer * 2048 * 1024, 2048, 1024, EpiBf16<0>{Qb, 2048, nullptr, nullptr, nullptr});
        GSYNC();
        for (int r = 0; r < PR_ROUTE; ++r) { RF(); phase_route(c, layer); }
        GSYNC();
        for (int r = 1; r < PR_GATHER; ++r) { RF(); phase_gather(c, layer, true); }
        RF(); phase_gather(c, layer, false);
        GSYNC();
    }
}
}

extern "C" void kernel_launch(void* const* d_in, const int* in_sizes, int n_in, void* d_out, int out_size, void* d_ws, size_t ws_size, hipStream_t stream) {
    static int grid = 0;
    if (grid == 0) {
        int dev = 0, cus = 0, per_cu = 0;
        if (hipGetDevice(&dev) != hipSuccess || hipDeviceGetAttribute(&cus, hipDeviceAttributeMultiprocessorCount, dev) != hipSuccess) { fprintf(stderr, "kernel_launch: device query failed\n"); grid = -1; return; }
        if (hipFuncSetAttribute((const void*)mk::mega, hipFuncAttributeMaxDynamicSharedMemorySize, mk::LDS_BYTES) != hipSuccess) { fprintf(stderr, "kernel_launch: hipFuncSetAttribute failed\n"); grid = -1; return; }
        if (hipOccupancyMaxActiveBlocksPerMultiprocessor(&per_cu, (const void*)mk::mega, mk::NTHR, mk::LDS_BYTES) != hipSuccess || per_cu < 1) { fprintf(stderr, "kernel_launch: occupancy query says %d blocks per CU\n", per_cu); grid = -1; return; }
        grid = cus;
        if (ws_size < mk::WS_END) { fprintf(stderr, "kernel_launch: workspace too small (%zu < %zu)\n", ws_size, (size_t)mk::WS_END); grid = -1; return; }
    }
    if (grid < 0) return;
    mk::Params p{};
    for (int i = 0; i < 46; ++i) p.in[i] = (const float*)d_in[i];
    p.out = (float*)d_out; p.ws = (unsigned char*)d_ws;
    if (hipMemsetAsync((char*)d_ws + mk::WS_CTL, 0, mk::CTL_BYTES, stream) != hipSuccess) { fprintf(stderr, "kernel_launch: memset failed\n"); return; }
    void* args[] = {&p};
    hipError_t e = hipLaunchCooperativeKernel((const void*)mk::mega, dim3(grid), dim3(mk::NTHR), args, mk::LDS_BYTES, stream);
    if (e != hipSuccess) fprintf(stderr, "cooperative launch failed: %s (grid %d)\n", hipGetErrorString(e), grid);
}
```

```cpp
#include <hip/hip_runtime.h>
#include <hip/hip_cooperative_groups.h>
#include <cstdio>
#include <cstdint>
#include <math.h>
namespace cg = cooperative_groups;

namespace pg8 {
#define PG8_LAS __attribute__((address_space(3)))
typedef unsigned short bf16_t;
typedef short bf16x8 __attribute__((ext_vector_type(8)));
typedef float f32x4 __attribute__((ext_vector_type(4)));
typedef unsigned u32x4 __attribute__((ext_vector_type(4)));
constexpr int BM = 256, BK = 64, HALF = 128, HTB = HALF * BK * 2, STAGE_BYTES = 8 * HTB, NXCD = 8, WGM = 8;
__host__ __device__ __forceinline__ int lds_byte(int r, int c) { const int st = (r >> 4) * 2 + (c >> 5), rr = r & 15, cc = c & 31, ob = rr * 64 + cc * 2; return st * 1024 + (ob ^ (((ob >> 9) & 1) << 5)); }
__host__ __device__ __forceinline__ void stage_rc(int b, int& R, int& C) { const int st = b / 1024, sb = b % 1024, swz = sb ^ (((sb >> 9) & 1) << 5); R = (st >> 1) * 16 + swz / 64; C = (st & 1) * 32 + (swz % 64) / 2; }
__host__ __device__ __forceinline__ int perm32(int rho) { const int n = rho >> 4, i = rho & 15; return 8 * (i >> 2) + 4 * n + (i & 3); }
struct Unit { int pm, pn; };
struct Gemm { const bf16_t* A; const bf16_t* Bt; int M, N, K, lda, a_pn_off; };
struct StaticOrder {
    int nM, nN, nwg, G, c;
    __host__ __device__ void init(int M, int N, int G_, int c_) { nM = M / BM; nN = N / BM; nwg = nM * nN; G = G_; c = c_; }
    __host__ __device__ bool next(int i, Unit& u) const {
        const long L = (long)i * G + c; if (L >= nwg) return false;
        int wgid = (int)L; { const int q = nwg / NXCD, r = nwg % NXCD, xcd = wgid % NXCD, off = wgid / NXCD; wgid = (xcd < r ? xcd * (q + 1) : r * (q + 1) + (xcd - r) * q) + off; }
        const int nig = WGM * nN, gid = wgid / nig, fm = gid * WGM, gsz = (nM - fm) < WGM ? (nM - fm) : WGM;
        u.pm = fm + ((wgid % nig) % gsz); u.pn = (wgid % nig) / gsz; return true;
    }
    __device__ __forceinline__ void a_ready(const Unit&) const {}
    __device__ __forceinline__ void done(const Unit&) const {}
};
__device__ __forceinline__ unsigned cvt_pk_bf16(float lo, float hi) { unsigned r; asm volatile("v_cvt_pk_bf16_f32 %0, %1, %2" : "=v"(r) : "v"(lo), "v"(hi)); return r; }
template <class Epi, class Sched, bool ALIGN_EPI = false, bool SP2 = false>
__device__ __forceinline__ void gemm_phase(PG8_LAS unsigned char* lds, const Gemm g, const Sched& S, const Epi& E, int tid_in) {
    int tid_ = tid_in; asm volatile("" : "+v"(tid_));
    const int tid = tid_, wid = __builtin_amdgcn_readfirstlane(tid >> 6), lane = tid & 63, wr = wid >> 2, wc = wid & 3, fr = lane & 15, fq = lane >> 4;
    const int K = g.K, nt = K / BK;
    unsigned voffA[2], voffB[2];
#pragma unroll
    for (int i = 0; i < 2; ++i) { int R, C; stage_rc(tid * 16 + i * 8192, R, C); const int Rb = Epi::PERM ? ((R & ~31) + perm32(R & 31)) : R;
        voffA[i] = (unsigned)(R * g.lda + C) * 2u; voffB[i] = (unsigned)(Rb * K + C) * 2u; }
    const size_t kstep = (size_t)(BK * 2);
    const size_t hstepA = (size_t)HALF * g.lda * 2, tstepA = 2 * hstepA;
    const size_t hstepB = (size_t)HALF * K * 2, tstepB = 2 * hstepB;
    const size_t apn = (size_t)g.a_pn_off * 2;
    const unsigned ldsw = (unsigned)wid * 1024u;
    const int aoff = lds_byte(wr * 64 + fr, fq * 8), boff = lds_byte(wc * 32 + fr, fq * 8);
#define PG8_SA(b, h) (((b) * 2 + (h)) * HTB)
#define PG8_SB(b, h) ((4 + (b) * 2 + (h)) * HTB)
#define PG8_STAGE(bufoff, gbase, voff) do { _Pragma("unroll") for (int _i = 0; _i < 2; ++_i) \
        __builtin_amdgcn_global_load_lds((const unsigned*)((const char*)(gbase) + (voff)[_i]), (PG8_LAS unsigned*)(lds + (bufoff) + ldsw + _i * 8192), 16, 0, 0); } while (0)
#define PG8_LDA(dst, b, h) do { _Pragma("unroll") for (int m = 0; m < 4; ++m) _Pragma("unroll") for (int k = 0; k < 2; ++k) dst[m][k] = *(const PG8_LAS bf16x8*)(lds + PG8_SA(b, h) + aoff + m * 2048 + k * 1024); } while (0)
#define PG8_LDB(dst, b, h) do { _Pragma("unroll") for (int n = 0; n < 2; ++n) _Pragma("unroll") for (int k = 0; k < 2; ++k) dst[n][k] = *(const PG8_LAS bf16x8*)(lds + PG8_SB(b, h) + boff + n * 2048 + k * 1024); } while (0)
#define PG8_MMA(ai, bj, At, Bt) do { __builtin_amdgcn_s_setprio(1); _Pragma("unroll") for (int m = 0; m < 4; ++m) _Pragma("unroll") for (int n = 0; n < 2; ++n) _Pragma("unroll") for (int k = 0; k < 2; ++k) \
        acc[ai][bj][m][n] = __builtin_amdgcn_mfma_f32_16x16x32_bf16(Bt[n][k], At[m][k], acc[ai][bj][m][n], 0, 0, 0); __builtin_amdgcn_s_setprio(0); } while (0)
#define PG8_WAIT_V(n) asm volatile("s_waitcnt vmcnt(" #n ")" ::: "memory")
#define PG8_WAIT_L(n) asm volatile("s_waitcnt lgkmcnt(" #n ")" ::: "memory")
#define PG8_BAR __builtin_amdgcn_s_barrier()
#define PG8_SCHED __builtin_amdgcn_sched_barrier(0)
    Unit cur, nxt; int ui = 0;
    if (!S.next(0, cur)) return;
    f32x4 acc[2][2][4][2];
#pragma unroll
    for (int a = 0; a < 2; ++a)
#pragma unroll
        for (int b = 0; b < 2; ++b)
#pragma unroll
            for (int m = 0; m < 4; ++m)
#pragma unroll
                for (int n = 0; n < 2; ++n) acc[a][b][m][n] = (f32x4){0.f, 0.f, 0.f, 0.f};
    bf16x8 At[4][2], B0[2][2], B1[2][2];
    const char* cA = (const char*)g.A + (size_t)cur.pm * tstepA + (size_t)cur.pn * apn; const char* cB = (const char*)g.Bt + (size_t)cur.pn * tstepB;
    S.a_ready(cur);
    if constexpr (SP2) {
        PG8_STAGE(PG8_SB(0, 0), cB, voffB); PG8_STAGE(PG8_SB(0, 1), cB + hstepB, voffB); PG8_STAGE(PG8_SA(0, 0), cA, voffA); PG8_STAGE(PG8_SA(0, 1), cA + hstepA, voffA);
        if (wr == 1) PG8_BAR;
        PG8_WAIT_V(2); PG8_BAR;
        PG8_STAGE(PG8_SB(1, 0), cB + kstep, voffB); PG8_STAGE(PG8_SA(1, 0), cA + kstep, voffA); PG8_STAGE(PG8_SB(1, 1), cB + hstepB + kstep, voffB);
        PG8_WAIT_V(6); PG8_BAR;
    } else {
        PG8_STAGE(PG8_SB(0, 0), cB, voffB); PG8_STAGE(PG8_SA(0, 0), cA, voffA); PG8_STAGE(PG8_SB(0, 1), cB + hstepB, voffB); PG8_STAGE(PG8_SA(0, 1), cA + hstepA, voffA);
        if (wr == 1) PG8_BAR;
        PG8_WAIT_V(4); PG8_BAR;
        PG8_STAGE(PG8_SB(1, 0), cB + kstep, voffB); PG8_STAGE(PG8_SA(1, 0), cA + kstep, voffA); PG8_STAGE(PG8_SB(1, 1), cB + hstepB + kstep, voffB);
        PG8_WAIT_V(6); PG8_BAR;
    }
    for (;;) {
        const bool has_next = S.next(ui + 1, nxt);
        const char* nA = has_next ? (const char*)g.A + (size_t)nxt.pm * tstepA + (size_t)nxt.pn * apn : cA; const char* nB = has_next ? (const char*)g.Bt + (size_t)nxt.pn * tstepB : cB;
#pragma nounroll
        for (int t = 0; t < nt; t += 2) {
            const bool last = (t == nt - 2);
            const char* a1 = cA + (size_t)(t + 1) * kstep;
            const char* a2 = last ? nA : cA + (size_t)(t + 2) * kstep; const char* b2 = last ? nB : cB + (size_t)(t + 2) * kstep;
            const char* a3 = a2 + kstep; const char* b3 = b2 + kstep;
            if (last && has_next) S.a_ready(nxt);
            if constexpr (SP2) {
            PG8_LDB(B0, 0, 0); PG8_LDB(B1, 0, 1); PG8_SCHED; PG8_LDA(At, 0, 0); PG8_STAGE(PG8_SA(1, 1), a1 + hstepA, voffA);
            PG8_WAIT_V(8); PG8_WAIT_L(0); PG8_BAR; PG8_MMA(0, 0, At, B0); PG8_MMA(0, 1, At, B1); PG8_BAR; PG8_SCHED;
            PG8_LDA(At, 0, 1); PG8_STAGE(PG8_SB(0, 0), b2, voffB); PG8_STAGE(PG8_SB(0, 1), b2 + hstepB, voffB); PG8_STAGE(PG8_SA(0, 0), a2, voffA);
            PG8_WAIT_V(8); PG8_WAIT_L(0); PG8_BAR; PG8_MMA(1, 0, At, B0); PG8_MMA(1, 1, At, B1); PG8_BAR; PG8_SCHED;
            PG8_LDB(B0, 1, 0); PG8_LDB(B1, 1, 1); PG8_SCHED; PG8_LDA(At, 1, 0); PG8_STAGE(PG8_SA(0, 1), a2 + hstepA, voffA);
            PG8_WAIT_V(8); PG8_WAIT_L(0); PG8_BAR; PG8_MMA(0, 0, At, B0); PG8_MMA(0, 1, At, B1); PG8_BAR; PG8_SCHED;
            PG8_LDA(At, 1, 1); PG8_STAGE(PG8_SB(1, 0), b3, voffB); PG8_STAGE(PG8_SB(1, 1), b3 + hstepB, voffB); PG8_STAGE(PG8_SA(1, 0), a3, voffA);
            PG8_WAIT_V(8); PG8_WAIT_L(0); PG8_BAR; PG8_MMA(1, 0, At, B0); PG8_MMA(1, 1, At, B1); PG8_BAR; PG8_SCHED;
            } else {
            PG8_LDB(B0, 0, 0); PG8_SCHED; PG8_LDA(At, 0, 0); PG8_STAGE(PG8_SA(1, 1), a1 + hstepA, voffA);
            PG8_WAIT_L(8); PG8_BAR; PG8_WAIT_L(0); PG8_MMA(0, 0, At, B0); PG8_BAR; PG8_SCHED;
            PG8_LDB(B1, 0, 1); PG8_STAGE(PG8_SB(0, 0), b2, voffB);
            PG8_BAR; PG8_WAIT_L(0); PG8_MMA(0, 1, At, B1); PG8_BAR;
            PG8_LDA(At, 0, 1); PG8_STAGE(PG8_SA(0, 0), a2, voffA);
            PG8_BAR; PG8_WAIT_L(0); PG8_MMA(1, 0, At, B0); PG8_BAR; PG8_SCHED;
            PG8_STAGE(PG8_SB(0, 1), b2 + hstepB, voffB);
            PG8_WAIT_V(6); PG8_BAR; PG8_MMA(1, 1, At, B1); PG8_BAR;
            PG8_LDB(B0, 1, 0); PG8_SCHED; PG8_LDA(At, 1, 0); PG8_STAGE(PG8_SA(0, 1), a2 + hstepA, voffA);
            PG8_WAIT_L(8); PG8_BAR; PG8_WAIT_L(0); PG8_MMA(0, 0, At, B0); PG8_BAR; PG8_SCHED;
            PG8_LDB(B1, 1, 1); PG8_STAGE(PG8_SB(1, 0), b3, voffB);
            PG8_BAR; PG8_WAIT_L(0); PG8_MMA(0, 1, At, B1); PG8_BAR;
            PG8_LDA(At, 1, 1); PG8_STAGE(PG8_SA(1, 0), a3, voffA);
            PG8_BAR; PG8_WAIT_L(0); PG8_MMA(1, 0, At, B0); PG8_BAR; PG8_SCHED;
            PG8_STAGE(PG8_SB(1, 1), b3 + hstepB, voffB);
            PG8_WAIT_V(6); PG8_BAR; PG8_MMA(1, 1, At, B1); PG8_BAR;
            }
        }
        if constexpr (ALIGN_EPI) { if (wr == 0) PG8_BAR; }
        if constexpr (!Epi::AFTER_DRAIN) { E(acc, cur, wr, wc, fr, fq); S.done(cur); }
        if (!has_next) break;
#pragma unroll
        for (int a = 0; a < 2; ++a)
#pragma unroll
            for (int b = 0; b < 2; ++b)
#pragma unroll
                for (int m = 0; m < 4; ++m)
#pragma unroll
                    for (int n = 0; n < 2; ++n) acc[a][b][m][n] = (f32x4){0.f, 0.f, 0.f, 0.f};
        cur = nxt; cA = nA; cB = nB; ++ui;
        if constexpr (ALIGN_EPI) { if (wr == 1) PG8_BAR; }
    }
    PG8_WAIT_V(0);
    if constexpr (!ALIGN_EPI) { if (wr == 0) PG8_BAR; }
    PG8_BAR;
    if constexpr (Epi::AFTER_DRAIN) { E.fused(acc, cur, wr, wc, fr, fq, lds, wid, lane); S.done(cur); }
#undef PG8_SA
#undef PG8_SB
#undef PG8_STAGE
#undef PG8_LDA
#undef PG8_LDB
#undef PG8_MMA
#undef PG8_WAIT_V
#undef PG8_WAIT_L
#undef PG8_BAR
#undef PG8_SCHED
}
}

#ifndef PR_GATHER
#define PR_GATHER 1
#endif
#ifndef PR_ROUTE
#define PR_ROUTE 1
#endif
#ifndef PR_S5
#define PR_S5 1
#endif
#ifndef PR_SSD
#define PR_SSD 1
#endif
#ifndef PR_GEMM
#define PR_GEMM 1
#endif
#ifndef PR_MISC
#define PR_MISC 1
#endif
namespace mk {
#define LAS __attribute__((address_space(3)))
typedef unsigned short bf16;
typedef unsigned v4u __attribute__((ext_vector_type(4)));
typedef unsigned v2u __attribute__((ext_vector_type(2)));
typedef float f32x4 __attribute__((ext_vector_type(4)));
typedef short bf16x8 __attribute__((ext_vector_type(8)));
using bf16x2 = __attribute__((ext_vector_type(2))) __bf16;

constexpr int D = 1024, T = 17408, TP = 16384, NWAVES = 8, NTHR = 512;
constexpr float ALPHA = 1.6817928305074290f;
constexpr float LN_EPS = 1e-5f, RMS_EPS = 1e-5f;
constexpr int LDS_BYTES = 160 * 1024;
constexpr int NPROJ = 5376, CONVD = 3072;

constexpr size_t MiB = 1u << 20;
constexpr size_t WS_W_S5IN = 0, WS_W_S5GLU = 2 * MiB, WS_W_S5OUT = 4 * MiB, WS_W_PIN = 6 * MiB, WS_W_PGRP = 8 * MiB, WS_W_POUT = 9 * MiB,
                 WS_W_CIN = 11 * MiB, WS_W_COUT = 15 * MiB, WS_W_SIN = 17 * MiB  , WS_W_SOUT = 28 * MiB, WS_W_PQ = 32 * MiB  ,
                 WS_KEYS = 48 * MiB  , WS_SMALL = 50 * MiB, WS_CTL = 52 * MiB  ;
constexpr size_t CTL_BYTES = 16384;
constexpr int MISC_OFF = LDS_BYTES - 64;
constexpr size_t WS_EU = 64 * MiB, WS_EV = 96 * MiB;
constexpr size_t WS_H32 = 128 * MiB, WS_R32 = 196 * MiB, WS_HB = 264 * MiB, WS_A0 = 298 * MiB, WS_A1 = 332 * MiB, WS_A2 = 366 * MiB;
constexpr size_t WS_Q = 400 * MiB  , WS_IDX = 468 * MiB  , WS_GATE = 477 * MiB  , WS_DT = 486 * MiB  ;
constexpr size_t WS_XBC = 490 * MiB  , WS_XC = 592 * MiB  , WS_Y = 694 * MiB  , WS_YN = 762 * MiB  , WS_SCU = 830 * MiB  , WS_END = 839 * MiB;
constexpr size_t SM_LBR = 0, SM_LBI = 4096, SM_BBR = 8192, SM_BBI = 8192 + 65536, SM_ISU = 8192 + 131072, SM_ISV = SM_ISU + 16384;

struct Params { const float* in[46]; float* out; unsigned char* ws; };

__device__ __forceinline__ unsigned f2bf(float f) { unsigned u = __builtin_bit_cast(unsigned, f); return (u + 0x7fffu + ((u >> 16) & 1u)) >> 16; }
__device__ __forceinline__ unsigned pk2(float lo, float hi) { return pg8::cvt_pk_bf16(lo, hi); }
__device__ __forceinline__ float bflo(unsigned w) { return __builtin_bit_cast(float, w << 16); }
__device__ __forceinline__ float bfhi(unsigned w) { return __builtin_bit_cast(float, w & 0xffff0000u); }
__device__ __forceinline__ float bf2f(bf16 b) { return __builtin_bit_cast(float, ((unsigned)b) << 16); }
__device__ __forceinline__ float sigmoid_f(float x) { return 1.f / (1.f + __expf(-x)); }
__device__ __forceinline__ float silu_f(float x) { return x * sigmoid_f(x); }
__device__ __forceinline__ float gelu_f(float x) { return x * sigmoid_f(1.5957691216057308f * (x + 0.044715f * x * x * x)); }
template <int O> __device__ __forceinline__ float shx_c(float v, int lane) {
    if constexpr (O < 32) return __builtin_bit_cast(float, __builtin_amdgcn_ds_swizzle(__builtin_bit_cast(int, v), (O << 10) | 0x1f));
    else return __builtin_bit_cast(float, __builtin_amdgcn_ds_bpermute((lane ^ O) << 2, __builtin_bit_cast(int, v)));
}
__device__ __forceinline__ float shx(float v, int o, int lane) {
    switch (o) { case 1: return shx_c<1>(v, lane); case 2: return shx_c<2>(v, lane); case 4: return shx_c<4>(v, lane); case 8: return shx_c<8>(v, lane); case 16: return shx_c<16>(v, lane); default: return shx_c<32>(v, lane); }
}
__device__ __forceinline__ float wave_sum(float v, int lane) {
#pragma unroll
    for (int o = 32; o >= 1; o >>= 1) v += shx(v, o, lane);
    return v;
}
__device__ __forceinline__ float dot2(unsigned w, unsigned x, float acc) { return __builtin_amdgcn_fdot2_f32_bf16(__builtin_bit_cast(bf16x2, w), __builtin_bit_cast(bf16x2, x), acc, false); }
__device__ __forceinline__ float reduce16(const float (&p)[16], int lane) {
    const bool b5 = lane & 32, b4 = lane & 16, b3 = lane & 8, b2 = lane & 4;
    float q[8], r[4], s[2], t;
#pragma unroll
    for (int i = 0; i < 8; ++i) { const float keep = b5 ? p[i + 8] : p[i], send = b5 ? p[i] : p[i + 8]; q[i] = keep + shx(send, 32, lane); }
#pragma unroll
    for (int i = 0; i < 4; ++i) { const float keep = b4 ? q[i + 4] : q[i], send = b4 ? q[i] : q[i + 4]; r[i] = keep + shx(send, 16, lane); }
#pragma unroll
    for (int i = 0; i < 2; ++i) { const float keep = b3 ? r[i + 2] : r[i], send = b3 ? r[i] : r[i + 2]; s[i] = keep + shx(send, 8, lane); }
    { const float keep = b2 ? s[1] : s[0], send = b2 ? s[0] : s[1]; t = keep + shx(send, 4, lane); }
    t += shx(t, 2, lane); t += shx(t, 1, lane);
    return t;
}
__device__ __forceinline__ float reduce8(const float (&p)[8], int lane) {
    const bool b5 = lane & 32, b4 = lane & 16, b3 = lane & 8;
    float q[4], r[2], t;
#pragma unroll
    for (int i = 0; i < 4; ++i) { const float keep = b5 ? p[i + 4] : p[i], send = b5 ? p[i] : p[i + 4]; q[i] = keep + shx(send, 32, lane); }
#pragma unroll
    for (int i = 0; i < 2; ++i) { const float keep = b4 ? q[i + 2] : q[i], send = b4 ? q[i] : q[i + 2]; r[i] = keep + shx(send, 16, lane); }
    { const float keep = b3 ? r[1] : r[0], send = b3 ? r[0] : r[1]; t = keep + shx(send, 8, lane); }
    t += shx(t, 4, lane); t += shx(t, 2, lane); t += shx(t, 1, lane);
    return t;
}
__device__ __forceinline__ void seq_info(int s, int& tok0, int& L) { if (s < 8) { tok0 = s << 11; L = 2048; } else { tok0 = TP + ((s - 8) << 3); L = 8; } }
__device__ __forceinline__ void tok_info(int t, int& s, int& l, int& tok0) {
    if (t < TP) { s = t >> 11; l = t & 2047; tok0 = s << 11; } else { const int b = (t - TP) >> 3; s = 8 + b; l = (t - TP) & 7; tok0 = TP + (b << 3); }
}

template <int MODE> struct EpiBf16 {
    static constexpr bool PERM = true, AFTER_DRAIN = false;
    bf16* O; int ldc; const float* bias; const float* scale; const bf16* G;
    __device__ __forceinline__ void operator()(const pg8::f32x4 (&acc)[2][2][4][2], const pg8::Unit& u, int wr, int wc, int fr_, int fq_) const {
        int fr = fr_, fq = fq_; asm volatile("" : "+v"(fr), "+v"(fq));
        const int row0 = u.pm * 256 + wr * 64 + fr, col0 = u.pn * 256 + wc * 32 + 8 * fq;
        f32x4 bv[2][2], sv[2][2];
#pragma unroll
        for (int bj = 0; bj < 2; ++bj)
#pragma unroll
            for (int n = 0; n < 2; ++n) {
                bv[bj][n] = bias ? *(const f32x4*)(bias + col0 + bj * 128 + 4 * n) : (f32x4){0.f, 0.f, 0.f, 0.f};
                sv[bj][n] = (MODE == 2) ? *(const f32x4*)(scale + col0 + bj * 128 + 4 * n) : (f32x4){1.f, 1.f, 1.f, 1.f};
            }
#pragma unroll
        for (int ai = 0; ai < 2; ++ai)
#pragma unroll
            for (int m = 0; m < 4; ++m) {
                const size_t roff = (size_t)(row0 + ai * 128 + m * 16) * ldc + col0;
#pragma unroll
                for (int bj = 0; bj < 2; ++bj) {
                    f32x4 v0 = acc[ai][bj][m][0] + bv[bj][0], v1 = acc[ai][bj][m][1] + bv[bj][1];
                    if (MODE == 1) {
#pragma unroll
                        for (int j = 0; j < 4; ++j) { v0[j] = gelu_f(v0[j]); v1[j] = gelu_f(v1[j]); }
                    }
                    if (MODE == 2) { v0 = v0 * sv[bj][0]; v1 = v1 * sv[bj][1]; }
                    if (MODE == 3) {
                        const v4u gw = *(const v4u*)(G + roff + bj * 128);
                        v0[0] = bflo(gw.x) * sigmoid_f(v0[0]); v0[1] = bfhi(gw.x) * sigmoid_f(v0[1]); v0[2] = bflo(gw.y) * sigmoid_f(v0[2]); v0[3] = bfhi(gw.y) * sigmoid_f(v0[3]);
                        v1[0] = bflo(gw.z) * sigmoid_f(v1[0]); v1[1] = bfhi(gw.z) * sigmoid_f(v1[1]); v1[2] = bflo(gw.w) * sigmoid_f(v1[2]); v1[3] = bfhi(gw.w) * sigmoid_f(v1[3]);
                    }
                    v4u w; w.x = pk2(v0[0], v0[1]); w.y = pk2(v0[2], v0[3]); w.z = pk2(v1[0], v1[1]); w.w = pk2(v1[2], v1[3]);
                    *(v4u*)(O + roff + bj * 128) = w;
                }
            }
    }
};
struct EpiResid {
    static constexpr bool PERM = false, AFTER_DRAIN = false;
    const float* H; float* R;
    __device__ __forceinline__ void operator()(const pg8::f32x4 (&acc)[2][2][4][2], const pg8::Unit& u, int wr, int wc, int fr_, int fq_) const {
        int fr = fr_, fq = fq_; asm volatile("" : "+v"(fr), "+v"(fq));
        const int row0 = u.pm * 256 + wr * 64 + fr, col0 = u.pn * 256 + wc * 32 + 4 * fq;
#pragma unroll
        for (int ai = 0; ai < 2; ++ai)
#pragma unroll
            for (int m = 0; m < 4; ++m) {
                const size_t roff = (size_t)(row0 + ai * 128 + m * 16) * D + col0;
#pragma unroll
                for (int bj = 0; bj < 2; ++bj)
#pragma unroll
                    for (int n = 0; n < 2; ++n) {
                        const f32x4 hv = *(const f32x4*)(H + roff + bj * 128 + n * 16);
                        *(f32x4*)(R + roff + bj * 128 + n * 16) = hv * ALPHA + acc[ai][bj][m][n];
                    }
            }
    }
};
struct EpiSsdProj {
    static constexpr bool PERM = true, AFTER_DRAIN = false;
    bf16* Z; bf16* XBC; float* DT;
    __device__ __forceinline__ void operator()(const pg8::f32x4 (&acc)[2][2][4][2], const pg8::Unit& u, int wr, int wc, int fr_, int fq_) const {
        int fr = fr_, fq = fq_; asm volatile("" : "+v"(fr), "+v"(fq));
        const int row0 = u.pm * 256 + wr * 64 + fr, col0 = u.pn * 256 + wc * 32 + 8 * fq;
#pragma unroll
        for (int ai = 0; ai < 2; ++ai)
#pragma unroll
            for (int m = 0; m < 4; ++m) {
                const size_t row = (size_t)(row0 + ai * 128 + m * 16);
#pragma unroll
                for (int bj = 0; bj < 2; ++bj) {
                    const f32x4 v0 = acc[ai][bj][m][0], v1 = acc[ai][bj][m][1];
                    const int col = col0 + bj * 128;
                    if (u.pn < 20) {
                        v4u w; w.x = pk2(v0[0], v0[1]); w.y = pk2(v0[2], v0[3]); w.z = pk2(v1[0], v1[1]); w.w = pk2(v1[2], v1[3]);
                        if (u.pn < 8) *(v4u*)(Z + row * 2048 + col) = w; else *(v4u*)(XBC + row * CONVD + (col - 2048)) = w;
                    } else if (col - 5120 < 32) {
                        *(f32x4*)(DT + row * 32 + (col - 5120)) = v0; *(f32x4*)(DT + row * 32 + (col - 5120) + 4) = v1;
                    }
                }
            }
    }
};

struct Ctx {
    const float* const* in; float* out; unsigned char* ws; LAS unsigned char* lds;
    int tid, lane, wave, gw, NGW, gt, NGT, bid, nblk;
    int z;
    template <class Tp> __device__ __forceinline__ Tp* W(size_t off) const { return (Tp*)(ws + (off + (size_t)(unsigned)z)); }
};

template <class Epi> __device__ __forceinline__ void run_gemm(const Ctx& c, const bf16* A, int lda, int a_pn_off, const bf16* Bt, int N, int K, const Epi& E) {
    pg8::Gemm g{A, Bt, T, N, K, lda, a_pn_off};
    pg8::StaticOrder S; S.init(T, N, c.nblk, c.bid);
    for (int r = 0; r < PR_GEMM; ++r) pg8::gemm_phase<Epi, pg8::StaticOrder, true, true>(c.lds, g, S, E, c.tid);
}

__device__ __forceinline__ void transpose_item(const float* __restrict__ Wm, int K, int N, bf16* WT, LAS float* scr, int item, int lane) {
    const int nblk = N / 32, kb = item / nblk, nb = item % nblk, k0 = 64 * kb, n0 = 32 * nb;
#pragma unroll 8
    for (int i = 0; i < 32; ++i) { const int kk = 2 * i + (lane >> 5); scr[kk * 33 + (lane & 31)] = Wm[(size_t)(k0 + kk) * N + n0 + (lane & 31)]; }
    asm volatile("s_waitcnt lgkmcnt(0)" ::: "memory");
    const int cc = lane & 7;
#pragma unroll
    for (int j = 0; j < 4; ++j) {
        const int n = (lane >> 3) + 8 * j; const LAS float* s = scr + (8 * cc) * 33 + n;
        v4u o; o.x = pk2(s[0 * 33], s[1 * 33]); o.y = pk2(s[2 * 33], s[3 * 33]); o.z = pk2(s[4 * 33], s[5 * 33]); o.w = pk2(s[6 * 33], s[7 * 33]);
        *(v4u*)(WT + (size_t)(n0 + n) * K + k0 + 8 * cc) = o;
    }
    asm volatile("s_waitcnt lgkmcnt(0)" ::: "memory");
}
__device__ __forceinline__ void transpose_mat(const Ctx& c, const float* Wm, int K, int N, bf16* WT) {
    LAS float* scr = (LAS float*)(c.lds + c.wave * 16384);
    const int nitems = (K / 64) * (N / 32);
    for (int it = c.gw; it < nitems; it += c.NGW) transpose_item(Wm, K, N, WT, scr, it, c.lane);
}
__device__ __forceinline__ void cvt_copy(const Ctx& c, const float* __restrict__ src, bf16* dst, size_t n) {
    for (size_t i = (size_t)c.gt * 8; i < n; i += (size_t)c.NGT * 8) {
        const f32x4 a = *(const f32x4*)(src + i), b = *(const f32x4*)(src + i + 4);
        v4u w; w.x = pk2(a[0], a[1]); w.y = pk2(a[2], a[3]); w.z = pk2(b[0], b[1]); w.w = pk2(b[2], b[3]);
        *(v4u*)(dst + i) = w;
    }
}
__device__ __forceinline__ float wave_max(float v, int lane) {
#pragma unroll
    for (int o = 32; o >= 1; o >>= 1) v = fmaxf(v, shx(v, o, lane));
    return v;
}
typedef float v16f __attribute__((ext_vector_type(16)));
typedef float v32f __attribute__((ext_vector_type(32)));
typedef unsigned v6u __attribute__((ext_vector_type(6)));
constexpr int EROW = 768;
#ifndef FP6_PACK_INTERLEAVED
#define FP6_PACK_INTERLEAVED 1
#endif
typedef unsigned v3u __attribute__((ext_vector_type(3)));
__device__ __forceinline__ void cvt_tables(const Ctx& c, int layer) {
    float* sm = c.W<float>(WS_SMALL);
    const int lane = c.lane;
    for (int rp = c.gw; rp < 16384; rp += c.NGW) {
        const int r0 = 2 * rp, tb = r0 >> 14, row = r0 & 16383;
        const float* src = c.in[c.z + 44 + tb] + ((size_t)layer * 16384 + row) * D + 16 * lane;
        f32x4 va[4], vb[4];
#pragma unroll
        for (int k = 0; k < 4; ++k) { va[k] = *(const f32x4*)(src + 4 * k); vb[k] = *(const f32x4*)(src + D + 4 * k); }
        float ma = 0.f, mb = 0.f;
#pragma unroll
        for (int k = 0; k < 4; ++k) {
            ma = fmaxf(fmaxf(fmaxf(fabsf(va[k][0]), fabsf(va[k][1])), fmaxf(fabsf(va[k][2]), fabsf(va[k][3]))), ma);
            mb = fmaxf(fmaxf(fmaxf(fabsf(vb[k][0]), fabsf(vb[k][1])), fmaxf(fabsf(vb[k][2]), fabsf(vb[k][3]))), mb);
        }
        ma = fmaxf(wave_max(ma, lane), 1e-30f); mb = fmaxf(wave_max(mb, lane), 1e-30f);
        const float sa = __builtin_bit_cast(float, __builtin_bit_cast(unsigned, 7.5f / ma) & 0xff800000u);
        const float sb = __builtin_bit_cast(float, __builtin_bit_cast(unsigned, 7.5f / mb) & 0xff800000u);
        float F[32];
#pragma unroll
        for (int k = 0; k < 4; ++k) {
#pragma unroll
            for (int j = 0; j < 4; ++j) { F[4 * k + j] = va[k][j] * sa; F[16 + 4 * k + j] = vb[k][j] * sb; }
        }
        v16f a, b;
#pragma unroll
        for (int i = 0; i < 16; ++i) { a[i] = FP6_PACK_INTERLEAVED ? F[2 * i] : F[i]; b[i] = FP6_PACK_INTERLEAVED ? F[2 * i + 1] : F[16 + i]; }
        const v6u pk = __builtin_amdgcn_cvt_scalef32_2xpk16_fp6_f32(a, b, 1.0f);
        unsigned char* dst = c.ws + (tb ? WS_EV : WS_EU) + (size_t)row * EROW + 12 * lane;
        *(v3u*)(dst) = (v3u){pk[0], pk[1], pk[2]};
        *(v3u*)(dst + EROW) = (v3u){pk[3], pk[4], pk[5]};
        if (lane == 0) { sm[(tb ? SM_ISV : SM_ISU) + row] = 1.0f / sa; sm[(tb ? SM_ISV : SM_ISU) + row + 1] = 1.0f / sb; }
    }
}
__device__ __forceinline__ void prologue(const Ctx& c) {
    transpose_mat(c, c.in[c.z + 7], 1024, 1024, c.W<bf16>(WS_W_S5IN));
    transpose_mat(c, c.in[c.z + 16], 1024, 1024, c.W<bf16>(WS_W_S5GLU));
    transpose_mat(c, c.in[c.z + 18], 1024, 1024, c.W<bf16>(WS_W_S5OUT));
    transpose_mat(c, c.in[c.z + 19], 1024, 1024, c.W<bf16>(WS_W_PIN));
    for (int g = 0; g < 4; ++g) transpose_mat(c, c.in[c.z + 20] + (size_t)g * 65536, 256, 256, c.W<bf16>(WS_W_PGRP) + (size_t)g * 65536);
    transpose_mat(c, c.in[c.z + 22], 1024, 1024, c.W<bf16>(WS_W_POUT));
    transpose_mat(c, c.in[c.z + 23], 1024, 2048, c.W<bf16>(WS_W_CIN));
    transpose_mat(c, c.in[c.z + 29], 1024, 1024, c.W<bf16>(WS_W_COUT));
    transpose_mat(c, c.in[c.z + 30], 1024, 5152, c.W<bf16>(WS_W_SIN));
    transpose_mat(c, c.in[c.z + 37], 2048, 1024, c.W<bf16>(WS_W_SOUT));
    for (int l = 0; l < 4; ++l) transpose_mat(c, c.in[c.z + 42] + (size_t)l * 1024 * 2048, 1024, 2048, c.W<bf16>(WS_W_PQ) + (size_t)l * 2048 * 1024);
    {
        v4u* z = (v4u*)(c.W<bf16>(WS_W_SIN) + (size_t)5152 * 1024);
        for (int i = c.gt; i < 224 * 1024 / 8; i += c.NGT) z[i] = (v4u){0u, 0u, 0u, 0u};
    }
    cvt_copy(c, c.in[c.z + 43], c.W<bf16>(WS_KEYS), (size_t)4 * 8 * 2 * 128 * 128);
    {
        float* H = c.W<float>(WS_H32); bf16* HB = c.W<bf16>(WS_HB);
        for (size_t i = (size_t)c.gt * 8; i < (size_t)T * D; i += (size_t)c.NGT * 8) {
            const float* src = (i < (size_t)TP * D) ? (c.in[c.z + 0] + i) : (c.in[c.z + 1] + (i - (size_t)TP * D));
            const f32x4 a = *(const f32x4*)(src), b = *(const f32x4*)(src + 4);
            *(f32x4*)(H + i) = a; *(f32x4*)(H + i + 4) = b;
            v4u w; w.x = pk2(a[0], a[1]); w.y = pk2(a[2], a[3]); w.z = pk2(b[0], b[1]); w.w = pk2(b[2], b[3]);
            *(v4u*)(HB + i) = w;
        }
    }
    if (c.gt < 4096) {
        const int gp = c.gt, g = gp >> 6;
        float* sm = c.W<float>(WS_SMALL);
        const float dt = expf(c.in[c.z + 10][g]);
        const float lr = c.in[c.z + 8][gp], li = c.in[c.z + 9][gp];
        const float mag = expf(lr * dt);
        const float br = mag * cosf(li * dt), bi = mag * sinf(li * dt);
        const float den = lr * lr + li * li;
        const float fr = ((br - 1.f) * lr + bi * li) / den, fi = (bi * lr - (br - 1.f) * li) / den;
        sm[SM_LBR + gp] = br; sm[SM_LBI + gp] = bi;
        for (int i = 0; i < 16; ++i) {
            const float xr = c.in[c.z + 11][gp * 16 + i], xi = c.in[c.z + 12][gp * 16 + i];
            sm[SM_BBR + gp * 16 + i] = fr * xr - fi * xi; sm[SM_BBI + gp * 16 + i] = fr * xi + fi * xr;
        }
    }
    cvt_tables(c, 0);
}

__device__ __forceinline__ void ln_row_store(const f32x4 (&v)[4], float mean, float rstd, const float* __restrict__ g, const float* __restrict__ b, float* o32, bf16* ob, int lane) {
#pragma unroll
    for (int h = 0; h < 2; ++h) {
        const int c0 = h * 512 + 8 * lane;
        const f32x4 g0 = *(const f32x4*)(g + c0), g1 = *(const f32x4*)(g + c0 + 4), b0 = *(const f32x4*)(b + c0), b1 = *(const f32x4*)(b + c0 + 4);
        const f32x4 o0 = (v[2 * h] - mean) * rstd * g0 + b0, o1 = (v[2 * h + 1] - mean) * rstd * g1 + b1;
        *(f32x4*)(o32 + c0) = o0; *(f32x4*)(o32 + c0 + 4) = o1;
        if (ob) { v4u w; w.x = pk2(o0[0], o0[1]); w.y = pk2(o0[2], o0[3]); w.z = pk2(o1[0], o1[1]); w.w = pk2(o1[2], o1[3]); *(v4u*)(ob + c0) = w; }
    }
}
__device__ __forceinline__ void ln_stats(const f32x4 (&v)[4], float& mean, float& rstd, int lane) {
    float s = 0.f;
#pragma unroll
    for (int k = 0; k < 4; ++k) s += (v[k][0] + v[k][1]) + (v[k][2] + v[k][3]);
    mean = wave_sum(s, lane) * (1.f / D);
    float q = 0.f;
#pragma unroll
    for (int k = 0; k < 4; ++k) { const f32x4 d = v[k] - mean; q += (d[0] * d[0] + d[1] * d[1]) + (d[2] * d[2] + d[3] * d[3]); }
    rstd = rsqrtf(wave_sum(q, lane) * (1.f / D) + LN_EPS);
}
__device__ __forceinline__ void phase_ln1(const Ctx& c, int layer) {
    const float* R = c.W<float>(WS_R32); float* H = c.W<float>(WS_H32); bf16* HB = c.W<bf16>(WS_HB);
    const float* g = c.in[c.z + 38] + layer * D; const float* b = c.in[c.z + 39] + layer * D;
    for (int t = c.gw; t < T; t += c.NGW) {
        f32x4 v[4];
#pragma unroll
        for (int h = 0; h < 2; ++h) { v[2 * h] = *(const f32x4*)(R + (size_t)t * D + h * 512 + 8 * c.lane); v[2 * h + 1] = *(const f32x4*)(R + (size_t)t * D + h * 512 + 8 * c.lane + 4); }
        float mean, rstd; ln_stats(v, mean, rstd, c.lane);
        ln_row_store(v, mean, rstd, g, b, H + (size_t)t * D, HB + (size_t)t * D, c.lane);
    }
}

__device__ __forceinline__ bf16x8 mk8(float a0, float a1, float a2, float a3, float a4, float a5, float a6, float a7) {
    v4u w; w.x = pk2(a0, a1); w.y = pk2(a2, a3); w.z = pk2(a4, a5); w.w = pk2(a6, a7); return __builtin_bit_cast(bf16x8, w);
}
constexpr int S5_BU_LD = 132  , S5_H_LD = 136  , S5_WAVE_BYTES = 16 * S5_BU_LD * 4 + 16 * S5_H_LD * 2;
__device__ __forceinline__ void phase_s5scan(const Ctx& c) {
    const bf16* U = c.W<bf16>(WS_A0); bf16* G = c.W<bf16>(WS_A1);
    const float* sm = c.W<float>(WS_SMALL);
    float* out = c.out;
    float* o_re_p = out + 17825792, *o_im_p = o_re_p + 32768, *o_re_s = out + 17825792 + 32768 * 2 + 122880 + 73728 + 2097152, *o_im_s = o_re_s + 524288;
    const int lane = c.lane, p = lane, fr = lane & 15, fq = lane >> 4;
    LAS float* BuT = (LAS float*)(c.lds + c.wave * S5_WAVE_BYTES);
    LAS bf16* Hi = (LAS bf16*)(c.lds + c.wave * S5_WAVE_BYTES + 16 * S5_BU_LD * 4);
    const int wslot = c.wave * c.nblk + c.bid;
    for (int unit = wslot; unit < 136 * 64; unit += c.NGW) {
        const int s = unit >> 6, g = unit & 63;
        int tok0, L; seq_info(s, tok0, L);
        bf16x8 Bf[8];
#pragma unroll
        for (int nt = 0; nt < 8; ++nt) {
            const int comp = 16 * nt + fr;
            const float* src = sm + ((comp < 64) ? SM_BBR : SM_BBI) + (size_t)(g * 64 + (comp & 63)) * 16 + 8 * (fq & 1);
            const f32x4 a = *(const f32x4*)src, b = *(const f32x4*)(src + 4);
            const bf16x8 v = mk8(a[0], a[1], a[2], a[3], b[0], b[1], b[2], b[3]);
            Bf[nt] = (fq < 2) ? v : (bf16x8){0, 0, 0, 0, 0, 0, 0, 0};
        }
        bf16x8 Cf[4];
#pragma unroll
        for (int ks = 0; ks < 4; ++ks) {
            const int comp0 = 32 * ks + 8 * fq;
            const float* src = ((ks < 2) ? c.in[c.z + 13] : c.in[c.z + 14]) + (size_t)(g * 16 + fr) * 64 + (comp0 & 63);
            const f32x4 a = *(const f32x4*)src, b = *(const f32x4*)(src + 4);
            const float sg = (ks < 2) ? 1.f : -1.f;
            Cf[ks] = mk8(sg * a[0], sg * a[1], sg * a[2], sg * a[3], sg * b[0], sg * b[1], sg * b[2], sg * b[3]);
        }
        const float lr = sm[SM_LBR + g * 64 + p], li = sm[SM_LBI + g * 64 + p];
        float hr = 0.f, hi = 0.f;
        if (s >= 8) { hr = c.in[c.z + 2][((s - 8) * 64 + g) * 64 + p]; hi = c.in[c.z + 3][((s - 8) * 64 + g) * 64 + p]; }
        const f32x4 dk4 = *(const f32x4*)(c.in[c.z + 15] + g * 16 + 4 * fq);
        const int ntile = (L + 15) >> 4;
        for (int tile = 0; tile < ntile; ++tile) {
            const int tb = tok0 + tile * 16;
            const bool valid = (tile * 16 + fr) < L;
            bf16x8 uf = {0, 0, 0, 0, 0, 0, 0, 0};
            if (fq < 2 && valid) uf = *(const bf16x8*)(U + (size_t)(tb + fr) * D + g * 16 + 8 * fq);
#pragma unroll
            for (int nt = 0; nt < 8; ++nt) {
                f32x4 acc = {0.f, 0.f, 0.f, 0.f};
                acc = __builtin_amdgcn_mfma_f32_16x16x32_bf16(Bf[nt], uf, acc, 0, 0, 0);
                *(LAS f32x4*)(BuT + fr * S5_BU_LD + 16 * nt + 4 * fq) = acc;
            }
            asm volatile("s_waitcnt lgkmcnt(0)" ::: "memory");
            const int nsteps = min(16, L - tile * 16);
#pragma unroll
            for (int t = 0; t < 16; ++t) {
                const float br = BuT[t * S5_BU_LD + p], bi = BuT[t * S5_BU_LD + 64 + p];
                const float nr = lr * hr - li * hi + br, ni = lr * hi + li * hr + bi;
                if (t < nsteps) { hr = nr; hi = ni; }
                Hi[t * S5_H_LD + p] = (bf16)f2bf(hr); Hi[t * S5_H_LD + 64 + p] = (bf16)f2bf(hi);
            }
            asm volatile("s_waitcnt lgkmcnt(0)" ::: "memory");
            f32x4 y = {0.f, 0.f, 0.f, 0.f};
#pragma unroll
            for (int ks = 0; ks < 4; ++ks) {
                const bf16x8 hf = *(const LAS bf16x8*)(Hi + fr * S5_H_LD + 32 * ks + 8 * fq);
                y = __builtin_amdgcn_mfma_f32_16x16x32_bf16(Cf[ks], hf, y, 0, 0, 0);
            }
            if (valid) {
                const v2u uq = *(const v2u*)(U + (size_t)(tb + fr) * D + g * 16 + 4 * fq);
                v2u o; o.x = pk2(gelu_f(y[0] + dk4[0] * bflo(uq.x)), gelu_f(y[1] + dk4[1] * bfhi(uq.x))); o.y = pk2(gelu_f(y[2] + dk4[2] * bflo(uq.y)), gelu_f(y[3] + dk4[3] * bfhi(uq.y)));
                *(v2u*)(G + (size_t)(tb + fr) * D + g * 16 + 4 * fq) = o;
            }
            asm volatile("" ::: "memory");
        }
        if (s < 8) { o_re_p[(s * 64 + g) * 64 + p] = hr; o_im_p[(s * 64 + g) * 64 + p] = hi; }
        else { o_re_s[((s - 8) * 64 + g) * 64 + p] = hr; o_im_s[((s - 8) * 64 + g) * 64 + p] = hi; }
    }
}

__device__ __forceinline__ void phase_pool(const Ctx& c) {
    const bf16* U = c.W<bf16>(WS_A0); bf16* P = c.W<bf16>(WS_A1);
    float* o_p = c.out + 17825792 + 65536, *o_s = c.out + 17825792 + 65536 + 122880 + 73728 + 2097152 + 1048576;
    for (size_t i = (size_t)c.gt; i < (size_t)T * 128; i += (size_t)c.NGT) {
        const int t = (int)(i >> 7), c0 = (int)(i & 127) * 8;
        int s, l, tok0; tok_info(t, s, l, tok0);
        const int w = 2 << (c0 >> 8);
        float sum[8];
#pragma unroll
        for (int j = 0; j < 8; ++j) sum[j] = 0.f;
        float cur[8];
        for (int k = 0; k < w; ++k) {
            const int ll = l - k;
            if (ll >= 0) {
                const v4u q = *(const v4u*)(U + (size_t)(tok0 + ll) * D + c0);
                const float f[8] = {bflo(q.x), bfhi(q.x), bflo(q.y), bfhi(q.y), bflo(q.z), bfhi(q.z), bflo(q.w), bfhi(q.w)};
#pragma unroll
                for (int j = 0; j < 8; ++j) { sum[j] += f[j]; if (k == 0) cur[j] = f[j]; }
            } else if (s >= 8) {
                const float* sp = c.in[c.z + 4] + ((size_t)(s - 8) * 15 + (15 + ll)) * D + c0;
                const f32x4 a = *(const f32x4*)sp, b = *(const f32x4*)(sp + 4);
                sum[0] += a[0]; sum[1] += a[1]; sum[2] += a[2]; sum[3] += a[3]; sum[4] += b[0]; sum[5] += b[1]; sum[6] += b[2]; sum[7] += b[3];
            }
        }
        const int pos = (s >= 8 ? 16384 : 0) + l;
        const float inv = 1.f / (float)min(pos + 1, w);
        v4u o; o.x = pk2(sum[0] * inv - cur[0], sum[1] * inv - cur[1]); o.y = pk2(sum[2] * inv - cur[2], sum[3] * inv - cur[3]);
        o.z = pk2(sum[4] * inv - cur[4], sum[5] * inv - cur[5]); o.w = pk2(sum[6] * inv - cur[6], sum[7] * inv - cur[7]);
        *(v4u*)(P + (size_t)t * D + c0) = o;
    }
    for (size_t i = (size_t)c.gt; i < (size_t)136 * 15 * D; i += (size_t)c.NGT) {
        const int ch = (int)(i & 1023); const int j = (int)((i >> 10) % 15); const int s = (int)(i / (15 * 1024));
        if (s < 8) o_p[((size_t)s * 15 + j) * D + ch] = bf2f(U[(size_t)(s * 2048 + 2033 + j) * D + ch]);
        else { const int b = s - 8; o_s[((size_t)b * 15 + j) * D + ch] = (j < 7) ? c.in[c.z + 4][((size_t)b * 15 + 8 + j) * D + ch] : bf2f(U[(size_t)(TP + b * 8 + (j - 7)) * D + ch]); }
    }
}

__device__ __forceinline__ void phase_cmlp_ln(const Ctx& c) {
    bf16* Z = c.W<bf16>(WS_Q);
    float* o_v = c.out + 17825792 + 65536 + 122880 + 73728 + 2097152 + 1048576 + 1966080;
    const float* g = c.in[c.z + 25]; const float* b = c.in[c.z + 26];
    for (int t = c.gw; t < T; t += c.NGW) {
        bf16* vr = Z + (size_t)t * 2048 + 1024;
        f32x4 v[4];
#pragma unroll
        for (int h = 0; h < 2; ++h) {
            const v4u q = *(const v4u*)(vr + h * 512 + 8 * c.lane);
            v[2 * h] = (f32x4){bflo(q.x), bfhi(q.x), bflo(q.y), bfhi(q.y)}; v[2 * h + 1] = (f32x4){bflo(q.z), bfhi(q.z), bflo(q.w), bfhi(q.w)};
        }
        float mean, rstd; ln_stats(v, mean, rstd, c.lane);
#pragma unroll
        for (int h = 0; h < 2; ++h) {
            const int c0 = h * 512 + 8 * c.lane;
            const f32x4 g0 = *(const f32x4*)(g + c0), g1 = *(const f32x4*)(g + c0 + 4), b0 = *(const f32x4*)(b + c0), b1 = *(const f32x4*)(b + c0 + 4);
            const f32x4 o0 = (v[2 * h] - mean) * rstd * g0 + b0, o1 = (v[2 * h + 1] - mean) * rstd * g1 + b1;
            v4u w; w.x = pk2(o0[0], o0[1]); w.y = pk2(o0[2], o0[3]); w.z = pk2(o1[0], o1[1]); w.w = pk2(o1[2], o1[3]);
            *(v4u*)(vr + c0) = w;
            if (t >= TP) { *(f32x4*)(o_v + (size_t)(t - TP) * D + c0) = o0; *(f32x4*)(o_v + (size_t)(t - TP) * D + c0 + 4) = o1; }
        }
    }
}
constexpr int CM_LD = 136, CM_WS = 0  , CM_VT = 34816  ;
__device__ __forceinline__ void phase_cmlp_mix(const Ctx& c) {
    const bf16* Z = c.W<bf16>(WS_Q); bf16* O = c.W<bf16>(WS_A1);
    LAS unsigned char* lds = c.lds;
    const int tid = c.tid, lane = c.lane, w = c.wave, fr = lane & 15, fq = lane >> 4;
    for (int unit = c.bid; unit < 128 * 4; unit += c.nblk) {
        const int chunk = unit >> 2, hd = unit & 3, tokc = chunk * 128;
#pragma unroll
        for (int k = 0; k < 4; ++k) {
            const int q = tid + 512 * k, row = q >> 4, cc = q & 15;
            const float* src = c.in[c.z + 27] + ((size_t)hd * 128 + row) * 128 + cc * 8;
            const f32x4 a = *(const f32x4*)src, b = *(const f32x4*)(src + 4);
            float f[8] = {a[0], a[1], a[2], a[3], b[0], b[1], b[2], b[3]};
#pragma unroll
            for (int j = 0; j < 8; ++j) f[j] = (cc * 8 + j <= row) ? f[j] : 0.f;
            v4u o; o.x = pk2(f[0], f[1]); o.y = pk2(f[2], f[3]); o.z = pk2(f[4], f[5]); o.w = pk2(f[6], f[7]);
            *(LAS v4u*)(lds + CM_WS + (row * CM_LD + cc * 8) * 2) = o;
        }
        {
            const int srow = tid & 127, dq = tid >> 7;
            const bf16* vs = Z + (size_t)(tokc + srow) * 2048 + 1024 + hd * 256 + dq * 64;
#pragma unroll
            for (int k = 0; k < 8; ++k) {
                const v4u q = *(const v4u*)(vs + 8 * k);
                const unsigned xw[4] = {q.x, q.y, q.z, q.w};
#pragma unroll
                for (int j = 0; j < 4; ++j) {
                    *(LAS bf16*)(lds + CM_VT + ((dq * 64 + 8 * k + 2 * j) * CM_LD + srow) * 2) = (bf16)(xw[j] & 0xffffu);
                    *(LAS bf16*)(lds + CM_VT + ((dq * 64 + 8 * k + 2 * j + 1) * CM_LD + srow) * 2) = (bf16)(xw[j] >> 16);
                }
            }
        }
        __syncthreads();
        f32x4 acc[16];
#pragma unroll
        for (int jd = 0; jd < 16; ++jd) acc[jd] = (f32x4){0.f, 0.f, 0.f, 0.f};
#pragma unroll
        for (int ks = 0; ks < 4; ++ks) {
            if (ks <= (w >> 1)) {
                const bf16x8 wf = *(const LAS bf16x8*)(lds + CM_WS + ((16 * w + fr) * CM_LD + ks * 32 + 8 * fq) * 2);
#pragma unroll
                for (int jd = 0; jd < 16; ++jd)
                    acc[jd] = __builtin_amdgcn_mfma_f32_16x16x32_bf16(*(const LAS bf16x8*)(lds + CM_VT + ((16 * jd + fr) * CM_LD + ks * 32 + 8 * fq) * 2), wf, acc[jd], 0, 0, 0);
            }
        }
        {
            const int t = 16 * w + fr; const size_t tok = (size_t)(tokc + t);
            const float bs = c.in[c.z + 28][hd * 128 + t];
#pragma unroll
            for (int jd = 0; jd < 16; ++jd) {
                const v2u uq = *(const v2u*)(Z + tok * 2048 + hd * 256 + 16 * jd + 4 * fq);
                v2u o; o.x = pk2(bflo(uq.x) * (acc[jd][0] + bs), bfhi(uq.x) * (acc[jd][1] + bs)); o.y = pk2(bflo(uq.y) * (acc[jd][2] + bs), bfhi(uq.y) * (acc[jd][3] + bs));
                *(v2u*)(O + tok * D + hd * 256 + 16 * jd + 4 * fq) = o;
            }
        }
        __syncthreads();
    }
    for (size_t i = (size_t)c.gt; i < (size_t)(T - TP) * 128; i += (size_t)c.NGT) {
        const int t = TP + (int)(i >> 7), c0 = (int)(i & 127) * 8;
        const int hd = c0 >> 8, tp = (t - TP) & 7, base = t - tp;
        float acc[8];
        const float bs = c.in[c.z + 28][hd * 128 + tp];
#pragma unroll
        for (int j = 0; j < 8; ++j) acc[j] = bs;
        const float* wr = c.in[c.z + 27] + ((size_t)hd * 128 + tp) * 128;
        for (int sp = 0; sp <= tp; ++sp) {
            const float wv = wr[sp];
            const v4u q = *(const v4u*)(Z + (size_t)(base + sp) * 2048 + 1024 + c0);
            acc[0] += wv * bflo(q.x); acc[1] += wv * bfhi(q.x); acc[2] += wv * bflo(q.y); acc[3] += wv * bfhi(q.y);
            acc[4] += wv * bflo(q.z); acc[5] += wv * bfhi(q.z); acc[6] += wv * bflo(q.w); acc[7] += wv * bfhi(q.w);
        }
        const v4u uq = *(const v4u*)(Z + (size_t)t * 2048 + c0);
        v4u o; o.x = pk2(bflo(uq.x) * acc[0], bfhi(uq.x) * acc[1]); o.y = pk2(bflo(uq.y) * acc[2], bfhi(uq.y) * acc[3]);
        o.z = pk2(bflo(uq.z) * acc[4], bfhi(uq.z) * acc[5]); o.w = pk2(bflo(uq.w) * acc[6], bfhi(uq.w) * acc[7]);
        *(v4u*)(O + (size_t)t * D + c0) = o;
    }
}

__device__ __forceinline__ void phase_ssd_conv(const Ctx& c) {
    const bf16* X = c.W<bf16>(WS_XBC); bf16* XC = c.W<bf16>(WS_XC);
    float* o_p = c.out + 17825792 + 65536 + 122880, *o_s = c.out + 17825792 + 65536 + 122880 + 73728 + 2097152 + 1048576 + 1966080 + 1048576;
    for (size_t i = (size_t)c.gt; i < (size_t)T * (CONVD / 8); i += (size_t)c.NGT) {
        const int t = (int)(i / (CONVD / 8)), c0 = (int)(i % (CONVD / 8)) * 8;
        int s, l, tok0; tok_info(t, s, l, tok0);
        float acc[8];
        { const f32x4 a = *(const f32x4*)(c.in[c.z + 32] + c0), b = *(const f32x4*)(c.in[c.z + 32] + c0 + 4); acc[0] = a[0]; acc[1] = a[1]; acc[2] = a[2]; acc[3] = a[3]; acc[4] = b[0]; acc[5] = b[1]; acc[6] = b[2]; acc[7] = b[3]; }
#pragma unroll
        for (int k = 0; k < 4; ++k) {
            const int src = l + k - 3;
            float f[8];
            if (src >= 0) {
                const v4u q = *(const v4u*)(X + (size_t)(tok0 + src) * CONVD + c0);
                f[0] = bflo(q.x); f[1] = bfhi(q.x); f[2] = bflo(q.y); f[3] = bfhi(q.y); f[4] = bflo(q.z); f[5] = bfhi(q.z); f[6] = bflo(q.w); f[7] = bfhi(q.w);
            } else if (s >= 8) {
                const float* sp = c.in[c.z + 5] + ((size_t)(s - 8) * 3 + (l + k)) * CONVD + c0;
                const f32x4 a = *(const f32x4*)sp, b = *(const f32x4*)(sp + 4);
                f[0] = a[0]; f[1] = a[1]; f[2] = a[2]; f[3] = a[3]; f[4] = b[0]; f[5] = b[1]; f[6] = b[2]; f[7] = b[3];
            } else {
#pragma unroll
                for (int j = 0; j < 8; ++j) f[j] = 0.f;
            }
            const f32x4 wa = *(const f32x4*)(c.in[c.z + 31] + k * CONVD + c0), wb = *(const f32x4*)(c.in[c.z + 31] + k * CONVD + c0 + 4);
            acc[0] += f[0] * wa[0]; acc[1] += f[1] * wa[1]; acc[2] += f[2] * wa[2]; acc[3] += f[3] * wa[3];
            acc[4] += f[4] * wb[0]; acc[5] += f[5] * wb[1]; acc[6] += f[6] * wb[2]; acc[7] += f[7] * wb[3];
        }
        v4u o; o.x = pk2(silu_f(acc[0]), silu_f(acc[1])); o.y = pk2(silu_f(acc[2]), silu_f(acc[3])); o.z = pk2(silu_f(acc[4]), silu_f(acc[5])); o.w = pk2(silu_f(acc[6]), silu_f(acc[7]));
        *(v4u*)(XC + (size_t)t * CONVD + c0) = o;
    }
    for (size_t i = (size_t)c.gt; i < (size_t)136 * 3 * CONVD; i += (size_t)c.NGT) {
        const int ch = (int)(i % CONVD); const int j = (int)((i / CONVD) % 3); const int s = (int)(i / (3 * CONVD));
        if (s < 8) o_p[((size_t)s * 3 + j) * CONVD + ch] = bf2f(X[(size_t)(s * 2048 + 2045 + j) * CONVD + ch]);
        else { const int b = s - 8; o_s[((size_t)b * 3 + j) * CONVD + ch] = bf2f(X[(size_t)(TP + b * 8 + 5 + j) * CONVD + ch]); }
    }
}
constexpr int SD_LD = 136;
constexpr int SD_C = 0, SD_B = 34816, SD_BT = 69632, SD_XT = 104448, SD_HB = 121856, SD_VEC = 139264;
__device__ __forceinline__ float softplus_f(float x) { return (x > 20.f) ? x : log1pf(__expf(x)); }
__device__ __forceinline__ void phase_ssd_scan(const Ctx& c) {
    const bf16* XC = c.W<bf16>(WS_XC); const float* DT = c.W<float>(WS_DT); bf16* Y = c.W<bf16>(WS_Y);
    float* o_p = c.out + 17825792 + 65536 + 122880 + 73728;
    float* o_s = c.out + 17825792 + 65536 + 122880 + 73728 + 2097152 + 1048576 + 1966080 + 1048576 + 1179648;
    const int tid = c.tid, lane = c.lane, w = c.wave, fr = lane & 15, fq = lane >> 4;
    LAS unsigned char* lds = c.lds;
    LAS float* csv = (LAS float*)(lds + SD_VEC); LAS float* dtv = csv + 128;
#define SD_FRAG(img, row, ks) (*(const LAS bf16x8*)(lds + (img) + ((row) * SD_LD + (ks) * 32 + 8 * fq) * 2))
    for (int unit = c.bid; unit < 8 * 32; unit += c.nblk) {
        const int s = unit >> 5, hd = unit & 31, g = hd >> 3;
        const float a = -__expf(c.in[c.z + 34][hd]), dtb = c.in[c.z + 33][hd], dk = c.in[c.z + 35][hd];
        f32x4 hacc[4];
#pragma unroll
        for (int jp = 0; jp < 4; ++jp) hacc[jp] = (f32x4){0.f, 0.f, 0.f, 0.f};
        for (int ch = 0; ch < 16; ++ch) {
            const int tokc = s * 2048 + ch * 128;
            if (w == 0) {
                const float dt0 = softplus_f(DT[(size_t)(tokc + lane) * 32 + hd] + dtb), dt1 = softplus_f(DT[(size_t)(tokc + 64 + lane) * 32 + hd] + dtb);
                float s0 = dt0 * a, s1 = dt1 * a;
#pragma unroll
                for (int o = 1; o < 64; o <<= 1) {
                    const float u0 = __builtin_bit_cast(float, __builtin_amdgcn_ds_bpermute(((lane - o) & 63) << 2, __builtin_bit_cast(int, s0)));
                    const float u1 = __builtin_bit_cast(float, __builtin_amdgcn_ds_bpermute(((lane - o) & 63) << 2, __builtin_bit_cast(int, s1)));
                    if (lane >= o) { s0 += u0; s1 += u1; }
                }
                const float tot0 = __builtin_bit_cast(float, __builtin_amdgcn_readlane(__builtin_bit_cast(int, s0), 63));
                csv[lane] = s0; csv[64 + lane] = tot0 + s1; dtv[lane] = dt0; dtv[64 + lane] = dt1;
            }
#pragma unroll
            for (int k = 0; k < 4; ++k) {
                const int q = tid + 512 * k, row = q >> 4, cc = q & 15;
                const bf16* src = XC + (size_t)(tokc + row) * CONVD + g * 128 + cc * 8;
                *(LAS v4u*)(lds + SD_C + (row * SD_LD + cc * 8) * 2) = *(const v4u*)(src + 2560);
                *(LAS v4u*)(lds + SD_B + (row * SD_LD + cc * 8) * 2) = *(const v4u*)(src + 2048);
            }
#pragma unroll
            for (int jp = 0; jp < 4; ++jp) {
                v2u hq; hq.x = pk2(hacc[jp][0], hacc[jp][1]); hq.y = pk2(hacc[jp][2], hacc[jp][3]);
                *(LAS v2u*)(lds + SD_HB + ((16 * jp + fr) * SD_LD + 16 * w + 4 * fq) * 2) = hq;
            }
            __syncthreads();
            {
                const int srow = tid & 127, qq = tid >> 7;
                const float sc = __expf(csv[127] - csv[srow]) * dtv[srow];
#pragma unroll
                for (int k = 0; k < 4; ++k) {
                    const int n0 = qq * 32 + k * 8;
                    const v4u bq = *(const LAS v4u*)(lds + SD_B + (srow * SD_LD + n0) * 2);
                    const float f[8] = {bflo(bq.x), bfhi(bq.x), bflo(bq.y), bfhi(bq.y), bflo(bq.z), bfhi(bq.z), bflo(bq.w), bfhi(bq.w)};
#pragma unroll
                    for (int j = 0; j < 8; ++j) *(LAS bf16*)(lds + SD_BT + ((n0 + j) * SD_LD + srow) * 2) = (bf16)f2bf(f[j] * sc);
                }
                const bf16* xs = XC + (size_t)(tokc + srow) * CONVD + hd * 64 + qq * 16;
                const v4u x0 = *(const v4u*)xs, x1 = *(const v4u*)(xs + 8);
                const unsigned xw[8] = {x0.x, x0.y, x0.z, x0.w, x1.x, x1.y, x1.z, x1.w};
#pragma unroll
                for (int j = 0; j < 8; ++j) {
                    *(LAS bf16*)(lds + SD_XT + ((qq * 16 + 2 * j) * SD_LD + srow) * 2) = (bf16)(xw[j] & 0xffffu);
                    *(LAS bf16*)(lds + SD_XT + ((qq * 16 + 2 * j + 1) * SD_LD + srow) * 2) = (bf16)(xw[j] >> 16);
                }
            }
            __syncthreads();
            const int jmax = w | 1;
            bf16x8 Cf[4];
#pragma unroll
            for (int ks = 0; ks < 4; ++ks) Cf[ks] = SD_FRAG(SD_C, 16 * w + fr, ks);
            f32x4 acc[8];
#pragma unroll
            for (int j = 0; j < 8; ++j) {
                acc[j] = (f32x4){0.f, 0.f, 0.f, 0.f};
                if (j <= jmax) {
#pragma unroll
                    for (int ks = 0; ks < 4; ++ks) acc[j] = __builtin_amdgcn_mfma_f32_16x16x32_bf16(SD_FRAG(SD_B, 16 * j + fr, ks), Cf[ks], acc[j], 0, 0, 0);
                }
            }
            {
                const float cdec = __expf(csv[127]);
                bf16x8 Bt[4];
#pragma unroll
                for (int ks = 0; ks < 4; ++ks) Bt[ks] = SD_FRAG(SD_BT, 16 * w + fr, ks);
#pragma unroll
                for (int jp = 0; jp < 4; ++jp) {
                    hacc[jp] = hacc[jp] * cdec;
#pragma unroll
                    for (int ks = 0; ks < 4; ++ks) hacc[jp] = __builtin_amdgcn_mfma_f32_16x16x32_bf16(Bt[ks], SD_FRAG(SD_XT, 16 * jp + fr, ks), hacc[jp], 0, 0, 0);
                }
            }
            __syncthreads();
            {
                const int t = 16 * w + fr; const float cst = csv[t];
#pragma unroll
                for (int j = 0; j < 8; ++j) {
                    if (j <= jmax) {
                        const f32x4 css = *(const LAS f32x4*)(csv + 16 * j + 4 * fq), dts = *(const LAS f32x4*)(dtv + 16 * j + 4 * fq);
                        float v[4];
#pragma unroll
                        for (int r = 0; r < 4; ++r) v[r] = (16 * j + 4 * fq + r <= t) ? acc[j][r] * __expf(cst - css[r]) * dts[r] : 0.f;
                        v2u lq; lq.x = pk2(v[0], v[1]); lq.y = pk2(v[2], v[3]);
                        *(LAS v2u*)(lds + SD_B + (t * SD_LD + 16 * j + 4 * fq) * 2) = lq;
                    }
                }
            }
            __syncthreads();
            {
                f32x4 a1[4], a2[4];
#pragma unroll
                for (int jp = 0; jp < 4; ++jp) { a1[jp] = (f32x4){0.f, 0.f, 0.f, 0.f}; a2[jp] = (f32x4){0.f, 0.f, 0.f, 0.f}; }
#pragma unroll
                for (int ks = 0; ks < 4; ++ks) {
                    if (ks <= (w >> 1)) {
                        const bf16x8 Lf = SD_FRAG(SD_B, 16 * w + fr, ks);
#pragma unroll
                        for (int jp = 0; jp < 4; ++jp) a1[jp] = __builtin_amdgcn_mfma_f32_16x16x32_bf16(SD_FRAG(SD_XT, 16 * jp + fr, ks), Lf, a1[jp], 0, 0, 0);
                    }
#pragma unroll
                    for (int jp = 0; jp < 4; ++jp) a2[jp] = __builtin_amdgcn_mfma_f32_16x16x32_bf16(SD_FRAG(SD_HB, 16 * jp + fr, ks), Cf[ks], a2[jp], 0, 0, 0);
                }
                const int t = 16 * w + fr; const float ecs = __expf(csv[t]);
                const size_t tok = (size_t)(tokc + t);
#pragma unroll
                for (int jp = 0; jp < 4; ++jp) {
                    const v2u xq = *(const v2u*)(XC + tok * CONVD + hd * 64 + 16 * jp + 4 * fq);
                    v2u yo; yo.x = pk2(a1[jp][0] + ecs * a2[jp][0] + dk * bflo(xq.x), a1[jp][1] + ecs * a2[jp][1] + dk * bfhi(xq.x));
                    yo.y = pk2(a1[jp][2] + ecs * a2[jp][2] + dk * bflo(xq.y), a1[jp][3] + ecs * a2[jp][3] + dk * bfhi(xq.y));
                    *(v2u*)(Y + tok * 2048 + hd * 64 + 16 * jp + 4 * fq) = yo;
                }
            }
            __syncthreads();
        }
#pragma unroll
        for (int jp = 0; jp < 4; ++jp) *(f32x4*)(o_p + (((size_t)s * 32 + hd) * 64 + 16 * jp + fr) * 128 + 16 * w + 4 * fq) = hacc[jp];
    }
#undef SD_FRAG
    __syncthreads();
    {
        LAS float* Bw = (LAS float*)(lds + w * 8192);
        LAS float* Cw = Bw + 1024;
        for (int unit = c.gw; unit < 128 * 32; unit += c.NGW) {
            const int b = unit >> 5, hd = unit & 31, g = hd >> 3, tok0 = TP + b * 8, p = lane;
            const float a = -__expf(c.in[c.z + 34][hd]), dtb = c.in[c.z + 33][hd], dk = c.in[c.z + 35][hd];
            {
                const int tk = lane >> 3, c0 = (lane & 7) * 16;
                const bf16* src = XC + (size_t)(tok0 + tk) * CONVD + g * 128 + c0;
                const v4u b0 = *(const v4u*)(src + 2048), b1 = *(const v4u*)(src + 2048 + 8), c0v = *(const v4u*)(src + 2560), c1v = *(const v4u*)(src + 2560 + 8);
                LAS float* bd = Bw + tk * 128 + c0; LAS float* cd = Cw + tk * 128 + c0;
                *(LAS f32x4*)(bd) = (f32x4){bflo(b0.x), bfhi(b0.x), bflo(b0.y), bfhi(b0.y)}; *(LAS f32x4*)(bd + 4) = (f32x4){bflo(b0.z), bfhi(b0.z), bflo(b0.w), bfhi(b0.w)};
                *(LAS f32x4*)(bd + 8) = (f32x4){bflo(b1.x), bfhi(b1.x), bflo(b1.y), bfhi(b1.y)}; *(LAS f32x4*)(bd + 12) = (f32x4){bflo(b1.z), bfhi(b1.z), bflo(b1.w), bfhi(b1.w)};
                *(LAS f32x4*)(cd) = (f32x4){bflo(c0v.x), bfhi(c0v.x), bflo(c0v.y), bfhi(c0v.y)}; *(LAS f32x4*)(cd + 4) = (f32x4){bflo(c0v.z), bfhi(c0v.z), bflo(c0v.w), bfhi(c0v.w)};
                *(LAS f32x4*)(cd + 8) = (f32x4){bflo(c1v.x), bfhi(c1v.x), bflo(c1v.y), bfhi(c1v.y)}; *(LAS f32x4*)(cd + 12) = (f32x4){bflo(c1v.z), bfhi(c1v.z), bflo(c1v.w), bfhi(c1v.w)};
            }
            float xv[8], dA[8], coef[8], yv[8];
#pragma unroll
            for (int t = 0; t < 8; ++t) {
                xv[t] = bf2f(XC[(size_t)(tok0 + t) * CONVD + hd * 64 + p]);
                const float dtv_ = softplus_f(DT[(size_t)(tok0 + t) * 32 + hd] + dtb);
                dA[t] = __expf(dtv_ * a); coef[t] = dtv_ * xv[t]; yv[t] = dk * xv[t];
            }
            asm volatile("s_waitcnt lgkmcnt(0)" ::: "memory");
            const float* hin = c.in[c.z + 6] + (((size_t)b * 32 + hd) * 64 + p) * 128;
            float* hout = o_s + (((size_t)b * 32 + hd) * 64 + p) * 128;
#pragma unroll 1
            for (int qt = 0; qt < 4; ++qt) {
                float h[32];
#pragma unroll
                for (int i = 0; i < 8; ++i) { const f32x4 q = *(const f32x4*)(hin + qt * 32 + 4 * i); h[4 * i] = q[0]; h[4 * i + 1] = q[1]; h[4 * i + 2] = q[2]; h[4 * i + 3] = q[3]; }
#pragma unroll
                for (int t = 0; t < 8; ++t) {
                    float ya = 0.f, yb = 0.f;
#pragma unroll
                    for (int i = 0; i < 8; ++i) {
                        const f32x4 bq = *(const LAS f32x4*)(Bw + t * 128 + qt * 32 + 4 * i), cq = *(const LAS f32x4*)(Cw + t * 128 + qt * 32 + 4 * i);
                        h[4 * i] = h[4 * i] * dA[t] + coef[t] * bq[0]; ya += cq[0] * h[4 * i];
                        h[4 * i + 1] = h[4 * i + 1] * dA[t] + coef[t] * bq[1]; yb += cq[1] * h[4 * i + 1];
                        h[4 * i + 2] = h[4 * i + 2] * dA[t] + coef[t] * bq[2]; ya += cq[2] * h[4 * i + 2];
                        h[4 * i + 3] = h[4 * i + 3] * dA[t] + coef[t] * bq[3]; yb += cq[3] * h[4 * i + 3];
                    }
                    yv[t] += ya + yb;
                    asm volatile("" ::: "memory");
                }
#pragma unroll
                for (int i = 0; i < 8; ++i) *(f32x4*)(hout + qt * 32 + 4 * i) = (f32x4){h[4 * i], h[4 * i + 1], h[4 * i + 2], h[4 * i + 3]};
            }
#pragma unroll
            for (int t = 0; t < 8; ++t) Y[(size_t)(tok0 + t) * 2048 + hd * 64 + p] = (bf16)f2bf(yv[t]);
            asm volatile("" ::: "memory");
        }
    }
}
__device__ __forceinline__ void phase_ssd_gatenorm(const Ctx& c) {
    const bf16* Y = c.W<bf16>(WS_Y); const bf16* Z = c.W<bf16>(WS_Q); bf16* YN = c.W<bf16>(WS_YN);
    for (int it = c.gw; it < T * 4; it += c.NGW) {
        const int t = it >> 2, c0 = (it & 3) * 512 + 8 * c.lane;
        const v4u yq = *(const v4u*)(Y + (size_t)t * 2048 + c0), zq = *(const v4u*)(Z + (size_t)t * 2048 + c0);
        const float yf[8] = {bflo(yq.x), bfhi(yq.x), bflo(yq.y), bfhi(yq.y), bflo(yq.z), bfhi(yq.z), bflo(yq.w), bfhi(yq.w)};
        const float zf[8] = {bflo(zq.x), bfhi(zq.x), bflo(zq.y), bfhi(zq.y), bflo(zq.z), bfhi(zq.z), bflo(zq.w), bfhi(zq.w)};
        float v[8]; float q = 0.f;
#pragma unroll
        for (int j = 0; j < 8; ++j) { v[j] = yf[j] * silu_f(zf[j]); q += v[j] * v[j]; }
        const float r = rsqrtf(wave_sum(q, c.lane) * (1.f / 512.f) + RMS_EPS);
        const f32x4 g0 = *(const f32x4*)(c.in[c.z + 36] + c0), g1 = *(const f32x4*)(c.in[c.z + 36] + c0 + 4);
        v4u o; o.x = pk2(v[0] * r * g0[0], v[1] * r * g0[1]); o.y = pk2(v[2] * r * g0[2], v[3] * r * g0[3]); o.z = pk2(v[4] * r * g1[0], v[5] * r * g1[1]); o.w = pk2(v[6] * r * g1[2], v[7] * r * g1[3]);
        *(v4u*)(YN + (size_t)t * 2048 + c0) = o;
    }
}

__device__ __forceinline__ unsigned ord_key(float s) { const unsigned u = __builtin_bit_cast(unsigned, s); return (u & 0x80000000u) ? ~u : (u | 0x80000000u); }
__device__ __forceinline__ float ord_dec(unsigned k) { const unsigned u = (k & 0x80000000u) ? (k & 0x7fffffffu) : ~k; return __builtin_bit_cast(float, u); }
__device__ __forceinline__ void ins16(unsigned (&Lk)[16], unsigned x) {
#pragma unroll
    for (int k = 0; k < 16; ++k) { const unsigned hi = max(Lk[k], x); x = min(Lk[k], x); Lk[k] = hi; }
}
__device__ __forceinline__ void ce_desc(unsigned& a, unsigned& b) { const unsigned hi = max(a, b), lo = min(a, b); a = hi; b = lo; }
__device__ __forceinline__ void ce_asc(unsigned& a, unsigned& b) { const unsigned hi = max(a, b), lo = min(a, b); a = lo; b = hi; }
__device__ __forceinline__ void sort16_desc(unsigned (&a)[16]) {
#pragma unroll
    for (int k = 2; k <= 16; k <<= 1)
#pragma unroll
        for (int j = k >> 1; j > 0; j >>= 1)
#pragma unroll
            for (int i = 0; i < 16; ++i) { const int l = i ^ j; if (l > i) { if ((i & k) == 0) ce_desc(a[i], a[l]); else ce_asc(a[i], a[l]); } }
}
__device__ __forceinline__ void bmerge16_desc(unsigned (&a)[16]) {
#pragma unroll
    for (int j = 8; j > 0; j >>= 1)
#pragma unroll
        for (int i = 0; i < 16; ++i) { const int l = i ^ j; if (l > i) ce_desc(a[i], a[l]); }
}
__device__ __forceinline__ void xmerge16(unsigned (&a)[16], int o, int lane) {
    unsigned pq[16];
#pragma unroll
    for (int k = 0; k < 16; ++k) pq[k] = (unsigned)__builtin_amdgcn_ds_bpermute((lane ^ o) << 2, (int)a[k]);
#pragma unroll
    for (int k = 0; k < 16; ++k) a[k] = max(a[k], pq[15 - k]);
    bmerge16_desc(a);
}
struct CandTab { unsigned char v[52]; };
constexpr CandTab make_cands() { CandTab t{}; int n = 0; for (int i = 0; i < 16; ++i) for (int j = 0; j < 16; ++j) if ((i + 1) * (j + 1) <= 16) t.v[n++] = (unsigned char)(i * 16 + j); return t; }
__device__ __forceinline__ void phase_route(const Ctx& c, int layer) {
    constexpr CandTab CT = make_cands();
    const bf16* Q = c.W<bf16>(WS_Q); const bf16* KEYS = c.W<bf16>(WS_KEYS) + (size_t)layer * 8 * 2 * 128 * 128;
    int* IDX = c.W<int>(WS_IDX); float* GATE = c.W<float>(WS_GATE); float* SCU = c.W<float>(WS_SCU);
    const float* ISU = c.W<float>(WS_SMALL) + SM_ISU; const float* ISV = c.W<float>(WS_SMALL) + SM_ISV;
    const int lane = c.lane, fr = lane & 15, fq = lane >> 4;
    constexpr int RK_LD = 136, RK_BYTES = 2 * 128 * RK_LD * 2;
    LAS unsigned* lists = (LAS unsigned*)(c.lds + RK_BYTES + c.wave * 2048);
    const int h = c.bid & 7;
    {
        const bf16* kg = KEYS + (size_t)h * 2 * 128 * 128;
        for (int q = c.tid; q < 2 * 128 * 16; q += NTHR) { const int row = q >> 4, cc = q & 15; *(LAS v4u*)(c.lds + (row * RK_LD + cc * 8) * 2) = *(const v4u*)(kg + (size_t)row * 128 + cc * 8); }
    }
    __syncthreads();
    const int nb8 = c.nblk >> 3;
    for (int tg = (c.bid >> 3) + nb8 * c.wave; tg < 1088; tg += nb8 * NWAVES) {
        const int tok0 = tg * 16;
        const bf16* qrow = Q + (size_t)(tok0 + fr) * 2048 + h * 256 + 8 * fq;
#pragma unroll
        for (int side = 0; side < 2; ++side) {
            bf16x8 qf[4];
#pragma unroll
            for (int ks = 0; ks < 4; ++ks) qf[ks] = *(const bf16x8*)(qrow + side * 128 + ks * 32);
            const LAS unsigned char* kb = c.lds + ((side * 128 + fr) * RK_LD + 8 * fq) * 2;
            unsigned A[16], B[16];
#pragma unroll
            for (int nt = 0; nt < 8; ++nt) {
                f32x4 acc = {0.f, 0.f, 0.f, 0.f};
#pragma unroll
                for (int ks = 0; ks < 4; ++ks) acc = __builtin_amdgcn_mfma_f32_16x16x32_bf16(*(const LAS bf16x8*)(kb + (nt * 16 * RK_LD + ks * 32) * 2), qf[ks], acc, 0, 0, 0);
#pragma unroll
                for (int r = 0; r < 4; ++r) {
                    const unsigned key = (ord_key(acc[r]) & ~127u) | (unsigned)(127 - (16 * nt + 4 * fq + r));
                    if (nt < 4) A[nt * 4 + r] = key; else B[(nt - 4) * 4 + r] = key;
                }
            }
            sort16_desc(A); sort16_desc(B);
#pragma unroll
            for (int k = 0; k < 16; ++k) A[k] = max(A[k], B[15 - k]);
            bmerge16_desc(A);
            xmerge16(A, 16, lane); xmerge16(A, 32, lane);
            if (fq == 0) {
#pragma unroll
                for (int k = 0; k < 4; ++k) *(LAS v4u*)(lists + (fr * 2 + side) * 16 + 4 * k) = (v4u){A[4 * k], A[4 * k + 1], A[4 * k + 2], A[4 * k + 3]};
            }
        }
        asm volatile("s_waitcnt lgkmcnt(0)" ::: "memory");
        int fq2 = fq, fr2 = fr; asm volatile("" : "+v"(fq2), "+v"(fr2));
        unsigned Cd[16];
#pragma unroll
        for (int k = 0; k < 13; ++k) {
            const int ij = (fq2 == 0) ? CT.v[k] : (fq2 == 1) ? CT.v[13 + k] : (fq2 == 2) ? CT.v[26 + k] : ((39 + k < 50) ? CT.v[(39 + k < 50) ? 39 + k : 0] : 0);
            const bool ok = (fq2 < 3) || (39 + k < 50);
            const unsigned k0 = lists[(fr2 * 2) * 16 + (ij >> 4)], k1 = lists[(fr2 * 2 + 1) * 16 + (ij & 15)];
            const unsigned x = (ord_key(ord_dec(k0 & ~127u) + ord_dec(k1 & ~127u)) & ~255u) | (unsigned)(255 - ij);
            Cd[k] = ok ? x : 0u;
        }
        Cd[13] = 0u; Cd[14] = 0u; Cd[15] = 0u;
        sort16_desc(Cd);
        xmerge16(Cd, 16, lane); xmerge16(Cd, 32, lane);
        float e[16], su[16]; int id[16]; float mx = 0.f, den = 0.f;
#pragma unroll
        for (int k = 0; k < 16; ++k) {
            const int pay = 255 - (int)(Cd[k] & 255u), i = pay >> 4, j = pay & 15;
            const unsigned k0 = lists[(fr2 * 2) * 16 + i], k1 = lists[(fr2 * 2 + 1) * 16 + j];
            id[k] = (127 - (int)(k0 & 127u)) * 128 + (127 - (int)(k1 & 127u));
            const float sv = ord_dec(k0 & ~127u) + ord_dec(k1 & ~127u);
            if (k == 0) mx = sv;
            e[k] = __expf(sv - mx); den += e[k];
        }
        const float inv = 1.f / den;
        int oi[4]; float og[4], ou[4];
#pragma unroll
        for (int r = 0; r < 4; ++r) {
            oi[r] = (fq2 == 0) ? id[r] : (fq2 == 1) ? id[4 + r] : (fq2 == 2) ? id[8 + r] : id[12 + r];
            og[r] = (fq2 == 0) ? e[r] : (fq2 == 1) ? e[4 + r] : (fq2 == 2) ? e[8 + r] : e[12 + r];
        }
#pragma unroll
        for (int r = 0; r < 4; ++r) { ou[r] = ISU[oi[r]]; og[r] *= inv * ISV[oi[r]]; }
        const size_t ob = (size_t)(tok0 + fr2) * 128 + h * 16 + 4 * fq2;
        *(int4*)(IDX + ob) = make_int4(oi[0], oi[1], oi[2], oi[3]);
        *(f32x4*)(GATE + ob) = (f32x4){og[0], og[1], og[2], og[3]};
        *(f32x4*)(SCU + ob) = (f32x4){ou[0], ou[1], ou[2], ou[3]};
        asm volatile("" ::: "memory");
        (void)su;
    }
}

typedef float f32x2 __attribute__((ext_vector_type(2)));
__device__ __forceinline__ void phase_gather(const Ctx& c, int layer, bool dummy) {
    const unsigned char* EU = c.ws + WS_EU; const unsigned char* EV = c.ws + WS_EV;
    const int* IDX = c.W<int>(WS_IDX); const float* GATE = c.W<float>(WS_GATE); const float* SCU = c.W<float>(WS_SCU);
    const float* H = c.W<float>(WS_H32); float* Ho = dummy ? c.W<float>(WS_R32) : c.W<float>(WS_H32); bf16* HB = dummy ? c.W<bf16>(WS_A0) : c.W<bf16>(WS_HB);
    const float* g = c.in[c.z + 40] + layer * D; const float* b = c.in[c.z + 41] + layer * D;
    const int lane = c.lane;
    const int ntw = (T - c.gw + c.NGW - 1) / c.NGW, nit = ntw * 16;
#define GT_TOK(it) (c.gw + ((it) >> 4) * c.NGW)
#define GT_IDX(it) (((it) < nit) ? IDX[(size_t)GT_TOK(it) * 128 + ((it) & 15) * 8 + (lane & 7)] : 0)
#define GT_GS(P, it) ((P)[(size_t)GT_TOK((it) < nit ? (it) : 0) * 128 + ((it) & 15) * 8 + ((lane >> 3) & 7)])
#define GT_ROW(TAB, idxreg, e) (*(const v3u*)((TAB) + (size_t)__builtin_amdgcn_readlane((idxreg), (e)) * EROW + 12 * lane))
    int idx_c = GT_IDX(0), idx_n = GT_IDX(1);
    float gate_c = GT_GS(GATE, 0), scu_c = GT_GS(SCU, 0);
    float xs[16], acc[16];
    v3u ru[8], rv[8];
#pragma unroll
    for (int e = 0; e < 8; ++e) { ru[e] = GT_ROW(EU, idx_c, e); rv[e] = GT_ROW(EV, idx_c, e); }
    for (int it = 0; it < nit; ++it) {
        const int t = GT_TOK(it), bt = it & 15;
        const int idx_nn = GT_IDX(it + 2);
        const float gate_n = GT_GS(GATE, it + 1), scu_n = GT_GS(SCU, it + 1);
        const float mygate = gate_c, myscu = scu_c;
        if (bt == 0) {
#pragma unroll
            for (int k = 0; k < 4; ++k) { const f32x4 hx = *(const f32x4*)(H + (size_t)t * D + 16 * lane + 4 * k); xs[4 * k] = hx[0]; xs[4 * k + 1] = hx[1]; xs[4 * k + 2] = hx[2]; xs[4 * k + 3] = hx[3]; }
#pragma unroll
            for (int i = 0; i < 16; ++i) acc[i] = 0.f;
        }
        float pv[8];
#pragma unroll
        for (int e = 0; e < 8; e += 2) {
            const v32f y = __builtin_amdgcn_cvt_scalef32_pk32_f32_fp6((v6u){ru[e][0], ru[e][1], ru[e][2], ru[e + 1][0], ru[e + 1][1], ru[e + 1][2]}, 1.0f);
            float d0 = 0.f, d1 = 0.f;
#pragma unroll
            for (int i = 0; i < 16; ++i) { d0 += y[i] * xs[i]; d1 += y[16 + i] * xs[i]; }
            pv[e] = d0; pv[e + 1] = d1;
            ru[e] = GT_ROW(EU, idx_n, e); ru[e + 1] = GT_ROW(EU, idx_n, e + 1);
        }
        const float tot = reduce8(pv, lane);
        const float wgt = mygate * gelu_f(tot * myscu);
#pragma unroll
        for (int e = 0; e < 8; e += 2) {
            const float w0 = __builtin_bit_cast(float, __builtin_amdgcn_readlane(__builtin_bit_cast(int, wgt), 8 * e));
            const float w1 = __builtin_bit_cast(float, __builtin_amdgcn_readlane(__builtin_bit_cast(int, wgt), 8 * e + 8));
            const v32f y = __builtin_amdgcn_cvt_scalef32_pk32_f32_fp6((v6u){rv[e][0], rv[e][1], rv[e][2], rv[e + 1][0], rv[e + 1][1], rv[e + 1][2]}, 1.0f);
#pragma unroll
            for (int i = 0; i < 16; ++i) acc[i] += y[i] * w0 + y[16 + i] * w1;
            rv[e] = GT_ROW(EV, idx_n, e); rv[e + 1] = GT_ROW(EV, idx_n, e + 1);
        }
        if (bt == 15) {
            int l2 = lane; asm volatile("" : "+v"(l2));
            f32x4 v[4];
#pragma unroll
            for (int k = 0; k < 4; ++k) v[k] = (f32x4){xs[4 * k], xs[4 * k + 1], xs[4 * k + 2], xs[4 * k + 3]} * ALPHA + (f32x4){acc[4 * k], acc[4 * k + 1], acc[4 * k + 2], acc[4 * k + 3]};
            float mean, rstd; ln_stats(v, mean, rstd, l2);
            float* o32 = ((layer == 3 && !dummy) ? c.out : Ho) + (size_t)t * D + 16 * l2;
            bf16* ob = (layer == 3 && !dummy) ? (bf16*)nullptr : HB + (size_t)t * D + 16 * l2;
            v4u wb[2];
#pragma unroll
            for (int k = 0; k < 4; ++k) {
                const f32x4 g4 = *(const f32x4*)(g + 16 * l2 + 4 * k), b4 = *(const f32x4*)(b + 16 * l2 + 4 * k);
                const f32x4 o = (v[k] - mean) * rstd * g4 + b4;
                *(f32x4*)(o32 + 4 * k) = o;
                if (k & 1) { wb[k >> 1].z = pk2(o[0], o[1]); wb[k >> 1].w = pk2(o[2], o[3]); } else { wb[k >> 1].x = pk2(o[0], o[1]); wb[k >> 1].y = pk2(o[2], o[3]); }
            }
            if (ob) { *(v4u*)(ob) = wb[0]; *(v4u*)(ob + 8) = wb[1]; }
        }
        idx_c = idx_n; idx_n = idx_nn; gate_c = gate_n; scu_c = scu_n;
    }
#undef GT_ROW
#undef GT_GS
#undef GT_IDX
#undef GT_TOK
}

#define XB_TMO      128
#define XB_XCNT(j)  (256  + 64 * (j))
#define XB_XSUB(j)  (1280 + 64 * (j))
#define XB_XGEN(j)  (2304 + 64 * (j))
#define XB_TOP      3328
#define XB_TOPGEN   3392
#define XCD_BAR_WORDS 3456
#define XB_SPIN_CAP (1u << 22)
__device__ __forceinline__ unsigned xb_ld(unsigned* p)              { return __hip_atomic_load(p, __ATOMIC_RELAXED, __HIP_MEMORY_SCOPE_AGENT); }
__device__ __forceinline__ unsigned xb_add(unsigned* p, unsigned v) { return __hip_atomic_fetch_add(p, v, __ATOMIC_RELAXED, __HIP_MEMORY_SCOPE_AGENT); }
__device__ __forceinline__ unsigned xb_xcc_id() { return (unsigned)__builtin_amdgcn_s_getreg((3 << 11) | 20) & 0xFu; }
#define XB_SPIN(cond, bar) do { unsigned _sp = 0; while (cond) { __builtin_amdgcn_s_sleep(1); \
    if ((++_sp & 255u) == 0u) { if (xb_ld(&(bar)[XB_TMO])) break; if (_sp > XB_SPIN_CAP) { atomicAdd(&(bar)[XB_TMO], 1u); break; } } } } while (0)
struct XcdBarrier { unsigned* bar; unsigned x; volatile LAS unsigned* st; };
__device__ __forceinline__ XcdBarrier xcd_barrier_post(unsigned* bar, volatile LAS unsigned* st) {
    XcdBarrier b; b.bar = bar; b.x = xb_xcc_id(); b.st = st;
    if (threadIdx.x == 0) (void)xb_add(&bar[XB_XCNT(b.x)], 1u);
    return b;
}
__device__ __forceinline__ void xcd_barrier_complete(unsigned* bar, unsigned x, unsigned& nloc, unsigned& nx) {
    const unsigned G = gridDim.x * gridDim.y * gridDim.z;
    unsigned sum, cnt, mine, sp = 0u;
    for (;;) {
        sum = 0u; cnt = 0u; mine = 0u;
#pragma unroll
        for (unsigned j = 0; j < 16; ++j) { const unsigned cc = xb_ld(&bar[XB_XCNT(j)]); sum += cc; cnt += (cc > 0u) ? 1u : 0u; mine = (j == x) ? cc : mine; }
        if (sum == G) break;
        __builtin_amdgcn_s_sleep(1);
        if ((++sp & 255u) == 0u) { if (xb_ld(&bar[XB_TMO])) break; if (sp > XB_SPIN_CAP) { atomicAdd(&bar[XB_TMO], 1u); break; } }
    }
    nloc = mine > 0u ? mine : 1u; nx = cnt > 0u ? cnt : 1u;
}
__device__ __forceinline__ void xcd_barrier(const XcdBarrier& b, int tid) {
    asm volatile("s_waitcnt vmcnt(0)" ::: "memory");
    __syncthreads();
    if (tid == 0) {
        unsigned* bar = b.bar;
        __builtin_amdgcn_s_waitcnt(0);
        unsigned nloc = b.st[0], nx = b.st[1];
        if (nloc == 0u) { xcd_barrier_complete(bar, b.x, nloc, nx); b.st[0] = nloc; b.st[1] = nx; }
        const unsigned old = xb_add(&bar[XB_XSUB(b.x)], 1u);
        const unsigned gen = old / nloc;
        if (old + 1u == (gen + 1u) * nloc) {
            __builtin_amdgcn_fence(__ATOMIC_RELEASE, "agent");
            asm volatile("s_waitcnt vmcnt(0)" ::: "memory");
            const unsigned og = xb_add(&bar[XB_TOP], 1u);
            const unsigned tg = og / nx;
            if (og + 1u == (tg + 1u) * nx) xb_add(&bar[XB_TOPGEN], 1u);
            else XB_SPIN(xb_ld(&bar[XB_TOPGEN]) == tg, bar);
            __builtin_amdgcn_fence(__ATOMIC_ACQUIRE, "agent");
            xb_add(&bar[XB_XGEN(b.x)], 1u);
            asm volatile("s_waitcnt vmcnt(0)" ::: "memory");
        } else {
            XB_SPIN(xb_ld(&bar[XB_XGEN(b.x)]) == gen, bar);
            __builtin_amdgcn_fence(__ATOMIC_ACQUIRE, "agent");
            asm volatile("s_waitcnt vmcnt(0)" ::: "memory");
        }
    }
    __syncthreads();
}

__global__ void __launch_bounds__(NTHR, 2) mega(Params P) {
    extern __shared__ __attribute__((aligned(16))) unsigned char lds_raw[];
    cg::grid_group grid = cg::this_grid();
    Ctx c;
    c.in = P.in; c.out = P.out; c.ws = P.ws; c.lds = (LAS unsigned char*)lds_raw; c.z = 0;
    c.tid = threadIdx.x; c.lane = c.tid & 63; c.wave = __builtin_amdgcn_readfirstlane(c.tid >> 6);
    c.gw = (int)blockIdx.x * NWAVES + c.wave; c.NGW = (int)gridDim.x * NWAVES; c.gt = (int)blockIdx.x * NTHR + c.tid; c.NGT = (int)gridDim.x * NTHR; c.bid = (int)blockIdx.x; c.nblk = (int)gridDim.x;
#define RF() do { int zs_ = 0; asm volatile("" : "+s"(zs_)); c.z = zs_; c.lds = (LAS unsigned char*)lds_raw + zs_; int z_ = 0; asm volatile("" : "+v"(z_)); const int l_ = (int)__builtin_amdgcn_mbcnt_hi(~0u, __builtin_amdgcn_mbcnt_lo(~0u, (unsigned)z_)); c.lane = l_; c.tid = c.wave * 64 + l_; c.bid = (int)blockIdx.x + zs_; c.nblk = (int)gridDim.x + zs_; c.gw = c.bid * NWAVES + c.wave; c.NGW = c.nblk * NWAVES; c.gt = c.bid * NTHR + c.tid; c.NGT = c.nblk * NTHR; } while (0)
    bf16* HB = c.W<bf16>(WS_HB); bf16* A0 = c.W<bf16>(WS_A0); bf16* A1 = c.W<bf16>(WS_A1); bf16* A2 = c.W<bf16>(WS_A2); bf16* Qb = c.W<bf16>(WS_Q);
    float* H32 = c.W<float>(WS_H32); float* R32 = c.W<float>(WS_R32);

    if (threadIdx.x < 16) ((volatile LAS unsigned*)(c.lds + MISC_OFF))[threadIdx.x] = 0u;
    __syncthreads();
    const XcdBarrier xbar = xcd_barrier_post(c.W<unsigned>(WS_CTL), (volatile LAS unsigned*)(c.lds + MISC_OFF));
#define GSYNC() do { RF(); xcd_barrier(xbar, c.tid); } while (0)
    RF(); prologue(c);
    grid.sync();
    for (int layer = 0; layer < 4; ++layer) {
        if (layer <= 1) {
            const bf16* Wt = c.W<bf16>(layer == 0 ? WS_W_S5IN : WS_W_PIN);
            RF(); run_gemm(c, HB, D, 0, Wt, 1024, 1024, EpiBf16<0>{A0, D, nullptr, nullptr, nullptr});
        } else if (layer == 2) {
            RF(); run_gemm(c, HB, D, 0, c.W<bf16>(WS_W_CIN), 2048, 1024, EpiBf16<1>{Qb, 2048, c.in[c.z + 24], nullptr, nullptr});
        } else {
            RF(); run_gemm(c, HB, D, 0, c.W<bf16>(WS_W_SIN), NPROJ, 1024, EpiSsdProj{Qb, c.W<bf16>(WS_XBC), c.W<float>(WS_DT)});
        }
        GSYNC();
        const bf16* Aout = A2; const bf16* Wout;
        if (layer == 0) {
            for (int r = 0; r < PR_S5; ++r) { RF(); phase_s5scan(c); }
            GSYNC();
            RF(); run_gemm(c, A1, D, 0, c.W<bf16>(WS_W_S5GLU), 1024, 1024, EpiBf16<3>{A2, D, c.in[c.z + 17], nullptr, A1});
            Wout = c.W<bf16>(WS_W_S5OUT);
        } else if (layer == 1) {
            RF(); phase_pool(c);
            GSYNC();
            RF(); run_gemm(c, A1, D, 256, c.W<bf16>(WS_W_PGRP), 1024, 256, EpiBf16<2>{A2, D, nullptr, c.in[c.z + 21], nullptr});
            Wout = c.W<bf16>(WS_W_POUT);
        } else if (layer == 2) {
            RF(); phase_cmlp_ln(c);
            GSYNC();
            RF(); phase_cmlp_mix(c);
            Aout = A1; Wout = c.W<bf16>(WS_W_COUT);
        } else {
            RF(); phase_ssd_conv(c);
            GSYNC();
            for (int r = 0; r < PR_SSD; ++r) { RF(); phase_ssd_scan(c); }
            GSYNC();
            RF(); phase_ssd_gatenorm(c);
            Aout = c.W<bf16>(WS_YN); Wout = c.W<bf16>(WS_W_SOUT);
        }
        GSYNC();
        if (layer == 3) { RF(); run_gemm(c, Aout, 2048, 0, Wout, 1024, 2048, EpiResid{H32, R32}); }
        else { RF(); run_gemm(c, Aout, 1024, 0, Wout, 1024, 1024, EpiResid{H32, R32}); }
        GSYNC();
        RF(); phase_ln1(c, layer);
        if (layer > 0) { RF(); cvt_tables(c, layer); }
        GSYNC();
        RF(); run_gemm(c, HB, D, 0, c.W<bf16>(WS_W_PQ) + (size_t)layer * 2048 * 1024, 2048, 1024, EpiBf16<0>{Qb, 2048, nullptr, nullptr, nullptr});
        GSYNC();
        for (int r = 0; r < PR_ROUTE; ++r) { RF(); phase_route(c, layer); }
        GSYNC();
        for (int r = 1; r < PR_GATHER; ++r) { RF(); phase_gather(c, layer, true); }
        RF(); phase_gather(c, layer, false);
        GSYNC();
    }
}
}

extern "C" void kernel_launch(void* const* d_in, const int* in_sizes, int n_in, void* d_out, int out_size, void* d_ws, size_t ws_size, hipStream_t stream) {
    static int grid = 0;
    if (grid == 0) {
        int dev = 0, cus = 0, per_cu = 0;
        if (hipGetDevice(&dev) != hipSuccess || hipDeviceGetAttribute(&cus, hipDeviceAttributeMultiprocessorCount, dev) != hipSuccess) { fprintf(stderr, "kernel_launch: device query failed\n"); grid = -1; return; }
        if (hipFuncSetAttribute((const void*)mk::mega, hipFuncAttributeMaxDynamicSharedMemorySize, mk::LDS_BYTES) != hipSuccess) { fprintf(stderr, "kernel_launch: hipFuncSetAttribute failed\n"); grid = -1; return; }
        if (hipOccupancyMaxActiveBlocksPerMultiprocessor(&per_cu, (const void*)mk::mega, mk::NTHR, mk::LDS_BYTES) != hipSuccess || per_cu < 1) { fprintf(stderr, "kernel_launch: occupancy query says %d blocks per CU\n", per_cu); grid = -1; return; }
        grid = cus;
        if (ws_size < mk::WS_END) { fprintf(stderr, "kernel_launch: workspace too small (%zu < %zu)\n", ws_size, (size_t)mk::WS_END); grid = -1; return; }
    }
    if (grid < 0) return;
    mk::Params p{};
    for (int i = 0; i < 46; ++i) p.in[i] = (const float*)d_in[i];
    p.out = (float*)d_out; p.ws = (unsigned char*)d_ws;
    if (hipMemsetAsync((char*)d_ws + mk::WS_CTL, 0, mk::CTL_BYTES, stream) != hipSuccess) { fprintf(stderr, "kernel_launch: memset failed\n"); return; }
    void* args[] = {&p};
    hipError_t e = hipLaunchCooperativeKernel((const void*)mk::mega, dim3(grid), dim3(mk::NTHR), args, mk::LDS_BYTES, stream);
    if (e != hipSuccess) fprintf(stderr, "cooperative launch failed: %s (grid %d)\n", hipGetErrorString(e), grid);
}
```

```cpp
#include <hip/hip_runtime.h>
#include <hip/hip_cooperative_groups.h>
#include <cstdio>
#include <cstdint>
#include <math.h>
namespace cg = cooperative_groups;

namespace pg8 {
#define PG8_LAS __attribute__((address_space(3)))
typedef unsigned short bf16_t;
typedef short bf16x8 __attribute__((ext_vector_type(8)));
typedef float f32x4 __attribute__((ext_vector_type(4)));
typedef unsigned u32x4 __attribute__((ext_vector_type(4)));
constexpr int BM = 256, BK = 64, HALF = 128, HTB = HALF * BK * 2, STAGE_BYTES = 8 * HTB, NXCD = 8, WGM = 8;
__host__ __device__ __forceinline__ int lds_byte(int r, int c) { const int st = (r >> 4) * 2 + (c >> 5), rr = r & 15, cc = c & 31, ob = rr * 64 + cc * 2; return st * 1024 + (ob ^ (((ob >> 9) & 1) << 5)); }
__host__ __device__ __forceinline__ void stage_rc(int b, int& R, int& C) { const int st = b / 1024, sb = b % 1024, swz = sb ^ (((sb >> 9) & 1) << 5); R = (st >> 1) * 16 + swz / 64; C = (st & 1) * 32 + (swz % 64) / 2; }
__host__ __device__ __forceinline__ int perm32(int rho) { const int n = rho >> 4, i = rho & 15; return 8 * (i >> 2) + 4 * n + (i & 3); }
struct Unit { int pm, pn; };
struct Gemm { const bf16_t* A; const bf16_t* Bt; int M, N, K, lda, a_pn_off; };
struct StaticOrder {
    int nM, nN, nwg, G, c;
    __host__ __device__ void init(int M, int N, int G_, int c_) { nM = M / BM; nN = N / BM; nwg = nM * nN; G = G_; c = c_; }
    __host__ __device__ bool next(int i, Unit& u) const {
        const long L = (long)i * G + c; if (L >= nwg) return false;
        int wgid = (int)L; { const int q = nwg / NXCD, r = nwg % NXCD, xcd = wgid % NXCD, off = wgid / NXCD; wgid = (xcd < r ? xcd * (q + 1) : r * (q + 1) + (xcd - r) * q) + off; }
        const int nig = WGM * nN, gid = wgid / nig, fm = gid * WGM, gsz = (nM - fm) < WGM ? (nM - fm) : WGM;
        u.pm = fm + ((wgid % nig) % gsz); u.pn = (wgid % nig) / gsz; return true;
    }
    __device__ __forceinline__ void a_ready(const Unit&) const {}
    __device__ __forceinline__ void done(const Unit&) const {}
};
__device__ __forceinline__ unsigned cvt_pk_bf16(float lo, float hi) { unsigned r; asm volatile("v_cvt_pk_bf16_f32 %0, %1, %2" : "=v"(r) : "v"(lo), "v"(hi)); return r; }
template <class Epi, class Sched, bool ALIGN_EPI = false, bool SP2 = false>
__device__ __forceinline__ void gemm_phase(PG8_LAS unsigned char* lds, const Gemm g, const Sched& S, const Epi& E, int tid_in) {
    int tid_ = tid_in; asm volatile("" : "+v"(tid_));
    const int tid = tid_, wid = __builtin_amdgcn_readfirstlane(tid >> 6), lane = tid & 63, wr = wid >> 2, wc = wid & 3, fr = lane & 15, fq = lane >> 4;
    const int K = g.K, nt = K / BK;
    unsigned voffA[2], voffB[2];
#pragma unroll
    for (int i = 0; i < 2; ++i) { int R, C; stage_rc(tid * 16 + i * 8192, R, C); const int Rb = Epi::PERM ? ((R & ~31) + perm32(R & 31)) : R;
        voffA[i] = (unsigned)(R * g.lda + C) * 2u; voffB[i] = (unsigned)(Rb * K + C) * 2u; }
    const size_t kstep = (size_t)(BK * 2);
    const size_t hstepA = (size_t)HALF * g.lda * 2, tstepA = 2 * hstepA;
    const size_t hstepB = (size_t)HALF * K * 2, tstepB = 2 * hstepB;
    const size_t apn = (size_t)g.a_pn_off * 2;
    const unsigned ldsw = (unsigned)wid * 1024u;
    const int aoff = lds_byte(wr * 64 + fr, fq * 8), boff = lds_byte(wc * 32 + fr, fq * 8);
#define PG8_SA(b, h) (((b) * 2 + (h)) * HTB)
#define PG8_SB(b, h) ((4 + (b) * 2 + (h)) * HTB)
#define PG8_STAGE(bufoff, gbase, voff) do { _Pragma("unroll") for (int _i = 0; _i < 2; ++_i) \
        __builtin_amdgcn_global_load_lds((const unsigned*)((const char*)(gbase) + (voff)[_i]), (PG8_LAS unsigned*)(lds + (bufoff) + ldsw + _i * 8192), 16, 0, 0); } while (0)
#define PG8_LDA(dst, b, h) do { _Pragma("unroll") for (int m = 0; m < 4; ++m) _Pragma("unroll") for (int k = 0; k < 2; ++k) dst[m][k] = *(const PG8_LAS bf16x8*)(lds + PG8_SA(b, h) + aoff + m * 2048 + k * 1024); } while (0)
#define PG8_LDB(dst, b, h) do { _Pragma("unroll") for (int n = 0; n < 2; ++n) _Pragma("unroll") for (int k = 0; k < 2; ++k) dst[n][k] = *(const PG8_LAS bf16x8*)(lds + PG8_SB(b, h) + boff + n * 2048 + k * 1024); } while (0)
#define PG8_MMA(ai, bj, At, Bt) do { __builtin_amdgcn_s_setprio(1); _Pragma("unroll") for (int m = 0; m < 4; ++m) _Pragma("unroll") for (int n = 0; n < 2; ++n) _Pragma("unroll") for (int k = 0; k < 2; ++k) \
        acc[ai][bj][m][n] = __builtin_amdgcn_mfma_f32_16x16x32_bf16(Bt[n][k], At[m][k], acc[ai][bj][m][n], 0, 0, 0); __builtin_amdgcn_s_setprio(0); } while (0)
#define PG8_WAIT_V(n) asm volatile("s_waitcnt vmcnt(" #n ")" ::: "memory")
#define PG8_WAIT_L(n) asm volatile("s_waitcnt lgkmcnt(" #n ")" ::: "memory")
#define PG8_BAR __builtin_amdgcn_s_barrier()
#define PG8_SCHED __builtin_amdgcn_sched_barrier(0)
    Unit cur, nxt; int ui = 0;
    if (!S.next(0, cur)) return;
    f32x4 acc[2][2][4][2];
#pragma unroll
    for (int a = 0; a < 2; ++a)
#pragma unroll
        for (int b = 0; b < 2; ++b)
#pragma unroll
            for (int m = 0; m < 4; ++m)
#pragma unroll
                for (int n = 0; n < 2; ++n) acc[a][b][m][n] = (f32x4){0.f, 0.f, 0.f, 0.f};
    bf16x8 At[4][2], B0[2][2], B1[2][2];
    const char* cA = (const char*)g.A + (size_t)cur.pm * tstepA + (size_t)cur.pn * apn; const char* cB = (const char*)g.Bt + (size_t)cur.pn * tstepB;
    S.a_ready(cur);
    if constexpr (SP2) {
        PG8_STAGE(PG8_SB(0, 0), cB, voffB); PG8_STAGE(PG8_SB(0, 1), cB + hstepB, voffB); PG8_STAGE(PG8_SA(0, 0), cA, voffA); PG8_STAGE(PG8_SA(0, 1), cA + hstepA, voffA);
        if (wr == 1) PG8_BAR;
        PG8_WAIT_V(2); PG8_BAR;
        PG8_STAGE(PG8_SB(1, 0), cB + kstep, voffB); PG8_STAGE(PG8_SA(1, 0), cA + kstep, voffA); PG8_STAGE(PG8_SB(1, 1), cB + hstepB + kstep, voffB);
        PG8_WAIT_V(6); PG8_BAR;
    } else {
        PG8_STAGE(PG8_SB(0, 0), cB, voffB); PG8_STAGE(PG8_SA(0, 0), cA, voffA); PG8_STAGE(PG8_SB(0, 1), cB + hstepB, voffB); PG8_STAGE(PG8_SA(0, 1), cA + hstepA, voffA);
        if (wr == 1) PG8_BAR;
        PG8_WAIT_V(4); PG8_BAR;
        PG8_STAGE(PG8_SB(1, 0), cB + kstep, voffB); PG8_STAGE(PG8_SA(1, 0), cA + kstep, voffA); PG8_STAGE(PG8_SB(1, 1), cB + hstepB + kstep, voffB);
        PG8_WAIT_V(6); PG8_BAR;
    }
    for (;;) {
        const bool has_next = S.next(ui + 1, nxt);
        const char* nA = has_next ? (const char*)g.A + (size_t)nxt.pm * tstepA + (size_t)nxt.pn * apn : cA; const char* nB = has_next ? (const char*)g.Bt + (size_t)nxt.pn * tstepB : cB;
#pragma nounroll
        for (int t = 0; t < nt; t += 2) {
            const bool last = (t == nt - 2);
            const char* a1 = cA + (size_t)(t + 1) * kstep;
            const char* a2 = last ? nA : cA + (size_t)(t + 2) * kstep; const char* b2 = last ? nB : cB + (size_t)(t + 2) * kstep;
            const char* a3 = a2 + kstep; const char* b3 = b2 + kstep;
            if (last && has_next) S.a_ready(nxt);
            if constexpr (SP2) {
            PG8_LDB(B0, 0, 0); PG8_LDB(B1, 0, 1); PG8_SCHED; PG8_LDA(At, 0, 0); PG8_STAGE(PG8_SA(1, 1), a1 + hstepA, voffA);
            PG8_WAIT_V(8); PG8_WAIT_L(0); PG8_BAR; PG8_MMA(0, 0, At, B0); PG8_MMA(0, 1, At, B1); PG8_BAR; PG8_SCHED;
            PG8_LDA(At, 0, 1); PG8_STAGE(PG8_SB(0, 0), b2, voffB); PG8_STAGE(PG8_SB(0, 1), b2 + hstepB, voffB); PG8_STAGE(PG8_SA(0, 0), a2, voffA);
            PG8_WAIT_V(8); PG8_WAIT_L(0); PG8_BAR; PG8_MMA(1, 0, At, B0); PG8_MMA(1, 1, At, B1); PG8_BAR; PG8_SCHED;
            PG8_LDB(B0, 1, 0); PG8_LDB(B1, 1, 1); PG8_SCHED; PG8_LDA(At, 1, 0); PG8_STAGE(PG8_SA(0, 1), a2 + hstepA, voffA);
            PG8_WAIT_V(8); PG8_WAIT_L(0); PG8_BAR; PG8_MMA(0, 0, At, B0); PG8_MMA(0, 1, At, B1); PG8_BAR; PG8_SCHED;
            PG8_LDA(At, 1, 1); PG8_STAGE(PG8_SB(1, 0), b3, voffB); PG8_STAGE(PG8_SB(1, 1), b3 + hstepB, voffB); PG8_STAGE(PG8_SA(1, 0), a3, voffA);
            PG8_WAIT_V(8); PG8_WAIT_L(0); PG8_BAR; PG8_MMA(1, 0, At, B0); PG8_MMA(1, 1, At, B1); PG8_BAR; PG8_SCHED;
            } else {
            PG8_LDB(B0, 0, 0); PG8_SCHED; PG8_LDA(At, 0, 0); PG8_STAGE(PG8_SA(1, 1), a1 + hstepA, voffA);
            PG8_WAIT_L(8); PG8_BAR; PG8_WAIT_L(0); PG8_MMA(0, 0, At, B0); PG8_BAR; PG8_SCHED;
            PG8_LDB(B1, 0, 1); PG8_STAGE(PG8_SB(0, 0), b2, voffB);
            PG8_BAR; PG8_WAIT_L(0); PG8_MMA(0, 1, At, B1); PG8_BAR;
            PG8_LDA(At, 0, 1); PG8_STAGE(PG8_SA(0, 0), a2, voffA);
            PG8_BAR; PG8_WAIT_L(0); PG8_MMA(1, 0, At, B0); PG8_BAR; PG8_SCHED;
            PG8_STAGE(PG8_SB(0, 1), b2 + hstepB, voffB);
            PG8_WAIT_V(6); PG8_BAR; PG8_MMA(1, 1, At, B1); PG8_BAR;
            PG8_LDB(B0, 1, 0); PG8_SCHED; PG8_LDA(At, 1, 0); PG8_STAGE(PG8_SA(0, 1), a2 + hstepA, voffA);
            PG8_WAIT_L(8); PG8_BAR; PG8_WAIT_L(0); PG8_MMA(0, 0, At, B0); PG8_BAR; PG8_SCHED;
            PG8_LDB(B1, 1, 1); PG8_STAGE(PG8_SB(1, 0), b3, voffB);
            PG8_BAR; PG8_WAIT_L(0); PG8_MMA(0, 1, At, B1); PG8_BAR;
            PG8_LDA(At, 1, 1); PG8_STAGE(PG8_SA(1, 0), a3, voffA);
            PG8_BAR; PG8_WAIT_L(0); PG8_MMA(1, 0, At, B0); PG8_BAR; PG8_SCHED;
            PG8_STAGE(PG8_SB(1, 1), b3 + hstepB, voffB);
            PG8_WAIT_V(6); PG8_BAR; PG8_MMA(1, 1, At, B1); PG8_BAR;
            }
        }
        if constexpr (ALIGN_EPI) { if (wr == 0) PG8_BAR; }
        if constexpr (!Epi::AFTER_DRAIN) { E(acc, cur, wr, wc, fr, fq); S.done(cur); }
        if (!has_next) break;
#pragma unroll
        for (int a = 0; a < 2; ++a)
#pragma unroll
            for (int b = 0; b < 2; ++b)
#pragma unroll
                for (int m = 0; m < 4; ++m)
#pragma unroll
                    for (int n = 0; n < 2; ++n) acc[a][b][m][n] = (f32x4){0.f, 0.f, 0.f, 0.f};
        cur = nxt; cA = nA; cB = nB; ++ui;
        if constexpr (ALIGN_EPI) { if (wr == 1) PG8_BAR; }
    }
    PG8_WAIT_V(0);
    if constexpr (!ALIGN_EPI) { if (wr == 0) PG8_BAR; }
    PG8_BAR;
    if constexpr (Epi::AFTER_DRAIN) { E.fused(acc, cur, wr, wc, fr, fq, lds, wid, lane); S.done(cur); }
#undef PG8_SA
#undef PG8_SB
#undef PG8_STAGE
#undef PG8_LDA
#undef PG8_LDB
#undef PG8_MMA
#undef PG8_WAIT_V
#undef PG8_WAIT_L
#undef PG8_BAR
#undef PG8_SCHED
}
}

#ifndef PR_GATHER
#define PR_GATHER 1
#endif
#ifndef PR_ROUTE
#define PR_ROUTE 1
#endif
#ifndef PR_S5
#define PR_S5 1
#endif
#ifndef PR_SSD
#define PR_SSD 1
#endif
#ifndef PR_GEMM
#define PR_GEMM 1
#endif
#ifndef PR_MISC
#define PR_MISC 1
#endif
namespace mk {
#define LAS __attribute__((address_space(3)))
typedef unsigned short bf16;
typedef unsigned v4u __attribute__((ext_vector_type(4)));
typedef unsigned v2u __attribute__((ext_vector_type(2)));
typedef float f32x4 __attribute__((ext_vector_type(4)));
typedef short bf16x8 __attribute__((ext_vector_type(8)));
using bf16x2 = __attribute__((ext_vector_type(2))) __bf16;

constexpr int D = 1024, T = 17408, TP = 16384, NWAVES = 8, NTHR = 512;
constexpr float ALPHA = 1.6817928305074290f;
constexpr float LN_EPS = 1e-5f, RMS_EPS = 1e-5f;
constexpr int LDS_BYTES = 160 * 1024;
constexpr int NPROJ = 5376, CONVD = 3072;

constexpr size_t MiB = 1u << 20;
constexpr size_t WS_W_S5IN = 0, WS_W_S5GLU = 2 * MiB, WS_W_S5OUT = 4 * MiB, WS_W_PIN = 6 * MiB, WS_W_PGRP = 8 * MiB, WS_W_POUT = 9 * MiB,
                 WS_W_CIN = 11 * MiB, WS_W_COUT = 15 * MiB, WS_W_SIN = 17 * MiB  , WS_W_SOUT = 28 * MiB, WS_W_PQ = 32 * MiB  ,
                 WS_KEYS = 48 * MiB  , WS_SMALL = 50 * MiB, WS_CTL = 52 * MiB  ;
constexpr size_t CTL_BYTES = 16384;
constexpr int MISC_OFF = LDS_BYTES - 64;
constexpr size_t WS_EU = 64 * MiB, WS_EV = 96 * MiB;
constexpr size_t WS_H32 = 128 * MiB, WS_R32 = 196 * MiB, WS_HB = 264 * MiB, WS_A0 = 298 * MiB, WS_A1 = 332 * MiB, WS_A2 = 366 * MiB;
constexpr size_t WS_Q = 400 * MiB  , WS_IDX = 468 * MiB  , WS_GATE = 477 * MiB  , WS_DT = 486 * MiB  ;
constexpr size_t WS_XBC = 490 * MiB  , WS_XC = 592 * MiB  , WS_Y = 694 * MiB  , WS_YN = 762 * MiB  , WS_SCU = 830 * MiB  , WS_END = 839 * MiB;
constexpr size_t SM_LBR = 0, SM_LBI = 4096, SM_BBR = 8192, SM_BBI = 8192 + 65536, SM_ISU = 8192 + 131072, SM_ISV = SM_ISU + 16384;

struct Params { const float* in[46]; float* out; unsigned char* ws; };

__device__ __forceinline__ unsigned f2bf(float f) { unsigned u = __builtin_bit_cast(unsigned, f); return (u + 0x7fffu + ((u >> 16) & 1u)) >> 16; }
__device__ __forceinline__ unsigned pk2(float lo, float hi) { return pg8::cvt_pk_bf16(lo, hi); }
__device__ __forceinline__ float bflo(unsigned w) { return __builtin_bit_cast(float, w << 16); }
__device__ __forceinline__ float bfhi(unsigned w) { return __builtin_bit_cast(float, w & 0xffff0000u); }
__device__ __forceinline__ float bf2f(bf16 b) { return __builtin_bit_cast(float, ((unsigned)b) << 16); }
__device__ __forceinline__ float sigmoid_f(float x) { return 1.f / (1.f + __expf(-x)); }
__device__ __forceinline__ float silu_f(float x) { return x * sigmoid_f(x); }
__device__ __forceinline__ float gelu_f(float x) { return x * sigmoid_f(1.5957691216057308f * (x + 0.044715f * x * x * x)); }
template <int O> __device__ __forceinline__ float shx_c(float v, int lane) {
    if constexpr (O < 32) return __builtin_bit_cast(float, __builtin_amdgcn_ds_swizzle(__builtin_bit_cast(int, v), (O << 10) | 0x1f));
    else return __builtin_bit_cast(float, __builtin_amdgcn_ds_bpermute((lane ^ O) << 2, __builtin_bit_cast(int, v)));
}
__device__ __forceinline__ float shx(float v, int o, int lane) {
    switch (o) { case 1: return shx_c<1>(v, lane); case 2: return shx_c<2>(v, lane); case 4: return shx_c<4>(v, lane); case 8: return shx_c<8>(v, lane); case 16: return shx_c<16>(v, lane); default: return shx_c<32>(v, lane); }
}
__device__ __forceinline__ float wave_sum(float v, int lane) {
#pragma unroll
    for (int o = 32; o >= 1; o >>= 1) v += shx(v, o, lane);
    return v;
}
__device__ __forceinline__ float dot2(unsigned w, unsigned x, float acc) { return __builtin_amdgcn_fdot2_f32_bf16(__builtin_bit_cast(bf16x2, w), __builtin_bit_cast(bf16x2, x), acc, false); }
__device__ __forceinline__ float reduce16(const float (&p)[16], int lane) {
    const bool b5 = lane & 32, b4 = lane & 16, b3 = lane & 8, b2 = lane & 4;
    float q[8], r[4], s[2], t;
#pragma unroll
    for (int i = 0; i < 8; ++i) { const float keep = b5 ? p[i + 8] : p[i], send = b5 ? p[i] : p[i + 8]; q[i] = keep + shx(send, 32, lane); }
#pragma unroll
    for (int i = 0; i < 4; ++i) { const float keep = b4 ? q[i + 4] : q[i], send = b4 ? q[i] : q[i + 4]; r[i] = keep + shx(send, 16, lane); }
#pragma unroll
    for (int i = 0; i < 2; ++i) { const float keep = b3 ? r[i + 2] : r[i], send = b3 ? r[i] : r[i + 2]; s[i] = keep + shx(send, 8, lane); }
    { const float keep = b2 ? s[1] : s[0], send = b2 ? s[0] : s[1]; t = keep + shx(send, 4, lane); }
    t += shx(t, 2, lane); t += shx(t, 1, lane);
    return t;
}
__device__ __forceinline__ float reduce8(const float (&p)[8], int lane) {
    const bool b5 = lane & 32, b4 = lane & 16, b3 = lane & 8;
    float q[4], r[2], t;
#pragma unroll
    for (int i = 0; i < 4; ++i) { const float keep = b5 ? p[i + 4] : p[i], send = b5 ? p[i] : p[i + 4]; q[i] = keep + shx(send, 32, lane); }
#pragma unroll
    for (int i = 0; i < 2; ++i) { const float keep = b4 ? q[i + 2] : q[i], send = b4 ? q[i] : q[i + 2]; r[i] = keep + shx(send, 16, lane); }
    { const float keep = b3 ? r[1] : r[0], send = b3 ? r[0] : r[1]; t = keep + shx(send, 8, lane); }
    t += shx(t, 4, lane); t += shx(t, 2, lane); t += shx(t, 1, lane);
    return t;
}
__device__ __forceinline__ void seq_info(int s, int& tok0, int& L) { if (s < 8) { tok0 = s << 11; L = 2048; } else { tok0 = TP + ((s - 8) << 3); L = 8; } }
__device__ __forceinline__ void tok_info(int t, int& s, int& l, int& tok0) {
    if (t < TP) { s = t >> 11; l = t & 2047; tok0 = s << 11; } else { const int b = (t - TP) >> 3; s = 8 + b; l = (t - TP) & 7; tok0 = TP + (b << 3); }
}

template <int MODE> struct EpiBf16 {
    static constexpr bool PERM = true, AFTER_DRAIN = false;
    bf16* O; int ldc; const float* bias; const float* scale; const bf16* G;
    __device__ __forceinline__ void operator()(const pg8::f32x4 (&acc)[2][2][4][2], const pg8::Unit& u, int wr, int wc, int fr_, int fq_) const {
        int fr = fr_, fq = fq_; asm volatile("" : "+v"(fr), "+v"(fq));
        const int row0 = u.pm * 256 + wr * 64 + fr, col0 = u.pn * 256 + wc * 32 + 8 * fq;
        f32x4 bv[2][2], sv[2][2];
#pragma unroll
        for (int bj = 0; bj < 2; ++bj)
#pragma unroll
            for (int n = 0; n < 2; ++n) {
                bv[bj][n] = bias ? *(const f32x4*)(bias + col0 + bj * 128 + 4 * n) : (f32x4){0.f, 0.f, 0.f, 0.f};
                sv[bj][n] = (MODE == 2) ? *(const f32x4*)(scale + col0 + bj * 128 + 4 * n) : (f32x4){1.f, 1.f, 1.f, 1.f};
            }
#pragma unroll
        for (int ai = 0; ai < 2; ++ai)
#pragma unroll
            for (int m = 0; m < 4; ++m) {
                const size_t roff = (size_t)(row0 + ai * 128 + m * 16) * ldc + col0;
#pragma unroll
                for (int bj = 0; bj < 2; ++bj) {
                    f32x4 v0 = acc[ai][bj][m][0] + bv[bj][0], v1 = acc[ai][bj][m][1] + bv[bj][1];
                    if (MODE == 1) {
#pragma unroll
                        for (int j = 0; j < 4; ++j) { v0[j] = gelu_f(v0[j]); v1[j] = gelu_f(v1[j]); }
                    }
                    if (MODE == 2) { v0 = v0 * sv[bj][0]; v1 = v1 * sv[bj][1]; }
                    if (MODE == 3) {
                        const v4u gw = *(const v4u*)(G + roff + bj * 128);
                        v0[0] = bflo(gw.x) * sigmoid_f(v0[0]); v0[1] = bfhi(gw.x) * sigmoid_f(v0[1]); v0[2] = bflo(gw.y) * sigmoid_f(v0[2]); v0[3] = bfhi(gw.y) * sigmoid_f(v0[3]);
                        v1[0] = bflo(gw.z) * sigmoid_f(v1[0]); v1[1] = bfhi(gw.z) * sigmoid_f(v1[1]); v1[2] = bflo(gw.w) * sigmoid_f(v1[2]); v1[3] = bfhi(gw.w) * sigmoid_f(v1[3]);
                    }
                    v4u w; w.x = pk2(v0[0], v0[1]); w.y = pk2(v0[2], v0[3]); w.z = pk2(v1[0], v1[1]); w.w = pk2(v1[2], v1[3]);
                    *(v4u*)(O + roff + bj * 128) = w;
                }
            }
    }
};
struct EpiResid {
    static constexpr bool PERM = false, AFTER_DRAIN = false;
    const float* H; float* R;
    __device__ __forceinline__ void operator()(const pg8::f32x4 (&acc)[2][2][4][2], const pg8::Unit& u, int wr, int wc, int fr_, int fq_) const {
        int fr = fr_, fq = fq_; asm volatile("" : "+v"(fr), "+v"(fq));
        const int row0 = u.pm * 256 + wr * 64 + fr, col0 = u.pn * 256 + wc * 32 + 4 * fq;
#pragma unroll
        for (int ai = 0; ai < 2; ++ai)
#pragma unroll
            for (int m = 0; m < 4; ++m) {
                const size_t roff = (size_t)(row0 + ai * 128 + m * 16) * D + col0;
#pragma unroll
                for (int bj = 0; bj < 2; ++bj)
#pragma unroll
                    for (int n = 0; n < 2; ++n) {
                        const f32x4 hv = *(const f32x4*)(H + roff + bj * 128 + n * 16);
                        *(f32x4*)(R + roff + bj * 128 + n * 16) = hv * ALPHA + acc[ai][bj][m][n];
                    }
            }
    }
};
struct EpiSsdProj {
    static constexpr bool PERM = true, AFTER_DRAIN = false;
    bf16* Z; bf16* XBC; float* DT;
    __device__ __forceinline__ void operator()(const pg8::f32x4 (&acc)[2][2][4][2], const pg8::Unit& u, int wr, int wc, int fr_, int fq_) const {
        int fr = fr_, fq = fq_; asm volatile("" : "+v"(fr), "+v"(fq));
        const int row0 = u.pm * 256 + wr * 64 + fr, col0 = u.pn * 256 + wc * 32 + 8 * fq;
#pragma unroll
        for (int ai = 0; ai < 2; ++ai)
#pragma unroll
            for (int m = 0; m < 4; ++m) {
                const size_t row = (size_t)(row0 + ai * 128 + m * 16);
#pragma unroll
                for (int bj = 0; bj < 2; ++bj) {
                    const f32x4 v0 = acc[ai][bj][m][0], v1 = acc[ai][bj][m][1];
                    const int col = col0 + bj * 128;
                    if (u.pn < 20) {
                        v4u w; w.x = pk2(v0[0], v0[1]); w.y = pk2(v0[2], v0[3]); w.z = pk2(v1[0], v1[1]); w.w = pk2(v1[2], v1[3]);
                        if (u.pn < 8) *(v4u*)(Z + row * 2048 + col) = w; else *(v4u*)(XBC + row * CONVD + (col - 2048)) = w;
                    } else if (col - 5120 < 32) {
                        *(f32x4*)(DT + row * 32 + (col - 5120)) = v0; *(f32x4*)(DT + row * 32 + (col - 5120) + 4) = v1;
                    }
                }
            }
    }
};

struct Ctx {
    const float* const* in; float* out; unsigned char* ws; LAS unsigned char* lds;
    int tid, lane, wave, gw, NGW, gt, NGT, bid, nblk;
    int z;
    template <class Tp> __device__ __forceinline__ Tp* W(size_t off) const { return (Tp*)(ws + (off + (size_t)(unsigned)z)); }
};

template <class Epi> __device__ __forceinline__ void run_gemm(const Ctx& c, const bf16* A, int lda, int a_pn_off, const bf16* Bt, int N, int K, const Epi& E) {
    pg8::Gemm g{A, Bt, T, N, K, lda, a_pn_off};
    pg8::StaticOrder S; S.init(T, N, c.nblk, c.bid);
    for (int r = 0; r < PR_GEMM; ++r) pg8::gemm_phase<Epi, pg8::StaticOrder, true, true>(c.lds, g, S, E, c.tid);
}

__device__ __forceinline__ void transpose_item(const float* __restrict__ Wm, int K, int N, bf16* WT, LAS float* scr, int item, int lane) {
    const int nblk = N / 32, kb = item / nblk, nb = item % nblk, k0 = 64 * kb, n0 = 32 * nb;
#pragma unroll 8
    for (int i = 0; i < 32; ++i) { const int kk = 2 * i + (lane >> 5); scr[kk * 33 + (lane & 31)] = Wm[(size_t)(k0 + kk) * N + n0 + (lane & 31)]; }
    asm volatile("s_waitcnt lgkmcnt(0)" ::: "memory");
    const int cc = lane & 7;
#pragma unroll
    for (int j = 0; j < 4; ++j) {
        const int n = (lane >> 3) + 8 * j; const LAS float* s = scr + (8 * cc) * 33 + n;
        v4u o; o.x = pk2(s[0 * 33], s[1 * 33]); o.y = pk2(s[2 * 33], s[3 * 33]); o.z = pk2(s[4 * 33], s[5 * 33]); o.w = pk2(s[6 * 33], s[7 * 33]);
        *(v4u*)(WT + (size_t)(n0 + n) * K + k0 + 8 * cc) = o;
    }
    asm volatile("s_waitcnt lgkmcnt(0)" ::: "memory");
}
__device__ __forceinline__ void transpose_mat(const Ctx& c, const float* Wm, int K, int N, bf16* WT) {
    LAS float* scr = (LAS float*)(c.lds + c.wave * 16384);
    const int nitems = (K / 64) * (N / 32);
    for (int it = c.gw; it < nitems; it += c.NGW) transpose_item(Wm, K, N, WT, scr, it, c.lane);
}
__device__ __forceinline__ void cvt_copy(const Ctx& c, const float* __restrict__ src, bf16* dst, size_t n) {
    for (size_t i = (size_t)c.gt * 8; i < n; i += (size_t)c.NGT * 8) {
        const f32x4 a = *(const f32x4*)(src + i), b = *(const f32x4*)(src + i + 4);
        v4u w; w.x = pk2(a[0], a[1]); w.y = pk2(a[2], a[3]); w.z = pk2(b[0], b[1]); w.w = pk2(b[2], b[3]);
        *(v4u*)(dst + i) = w;
    }
}
__device__ __forceinline__ float wave_max(float v, int lane) {
#pragma unroll
    for (int o = 32; o >= 1; o >>= 1) v = fmaxf(v, shx(v, o, lane));
    return v;
}
typedef float v16f __attribute__((ext_vector_type(16)));
typedef float v32f __attribute__((ext_vector_type(32)));
typedef unsigned v6u __attribute__((ext_vector_type(6)));
constexpr int EROW = 768;
#ifndef FP6_PACK_INTERLEAVED
#define FP6_PACK_INTERLEAVED 1
#endif
typedef unsigned v3u __attribute__((ext_vector_type(3)));
__device__ __forceinline__ void cvt_tables(const Ctx& c, int layer) {
    float* sm = c.W<float>(WS_SMALL);
    const int lane = c.lane;
    for (int rp = c.gw; rp < 16384; rp += c.NGW) {
        const int r0 = 2 * rp, tb = r0 >> 14, row = r0 & 16383;
        const float* src = c.in[c.z + 44 + tb] + ((size_t)layer * 16384 + row) * D + 16 * lane;
        f32x4 va[4], vb[4];
#pragma unroll
        for (int k = 0; k < 4; ++k) { va[k] = *(const f32x4*)(src + 4 * k); vb[k] = *(const f32x4*)(src + D + 4 * k); }
        float ma = 0.f, mb = 0.f;
#pragma unroll
        for (int k = 0; k < 4; ++k) {
            ma = fmaxf(fmaxf(fmaxf(fabsf(va[k][0]), fabsf(va[k][1])), fmaxf(fabsf(va[k][2]), fabsf(va[k][3]))), ma);
            mb = fmaxf(fmaxf(fmaxf(fabsf(vb[k][0]), fabsf(vb[k][1])), fmaxf(fabsf(vb[k][2]), fabsf(vb[k][3]))), mb);
        }
        ma = fmaxf(wave_max(ma, lane), 1e-30f); mb = fmaxf(wave_max(mb, lane), 1e-30f);
        const float sa = __builtin_bit_cast(float, __builtin_bit_cast(unsigned, 7.5f / ma) & 0xff800000u);
        const float sb = __builtin_bit_cast(float, __builtin_bit_cast(unsigned, 7.5f / mb) & 0xff800000u);
        float F[32];
#pragma unroll
        for (int k = 0; k < 4; ++k) {
#pragma unroll
            for (int j = 0; j < 4; ++j) { F[4 * k + j] = va[k][j] * sa; F[16 + 4 * k + j] = vb[k][j] * sb; }
        }
        v16f a, b;
#pragma unroll
        for (int i = 0; i < 16; ++i) { a[i] = FP6_PACK_INTERLEAVED ? F[2 * i] : F[i]; b[i] = FP6_PACK_INTERLEAVED ? F[2 * i + 1] : F[16 + i]; }
        const v6u pk = __builtin_amdgcn_cvt_scalef32_2xpk16_fp6_f32(a, b, 1.0f);
        unsigned char* dst = c.ws + (tb ? WS_EV : WS_EU) + (size_t)row * EROW + 12 * lane;
        *(v3u*)(dst) = (v3u){pk[0], pk[1], pk[2]};
        *(v3u*)(dst + EROW) = (v3u){pk[3], pk[4], pk[5]};
        if (lane == 0) { sm[(tb ? SM_ISV : SM_ISU) + row] = 1.0f / sa; sm[(tb ? SM_ISV : SM_ISU) + row + 1] = 1.0f / sb; }
    }
}
__device__ __forceinline__ void prologue(const Ctx& c) {
    transpose_mat(c, c.in[c.z + 7], 1024, 1024, c.W<bf16>(WS_W_S5IN));
    transpose_mat(c, c.in[c.z + 16], 1024, 1024, c.W<bf16>(WS_W_S5GLU));
    transpose_mat(c, c.in[c.z + 18], 1024, 1024, c.W<bf16>(WS_W_S5OUT));
    transpose_mat(c, c.in[c.z + 19], 1024, 1024, c.W<bf16>(WS_W_PIN));
    for (int g = 0; g < 4; ++g) transpose_mat(c, c.in[c.z + 20] + (size_t)g * 65536, 256, 256, c.W<bf16>(WS_W_PGRP) + (size_t)g * 65536);
    transpose_mat(c, c.in[c.z + 22], 1024, 1024, c.W<bf16>(WS_W_POUT));
    transpose_mat(c, c.in[c.z + 23], 1024, 2048, c.W<bf16>(WS_W_CIN));
    transpose_mat(c, c.in[c.z + 29], 1024, 1024, c.W<bf16>(WS_W_COUT));
    transpose_mat(c, c.in[c.z + 30], 1024, 5152, c.W<bf16>(WS_W_SIN));
    transpose_mat(c, c.in[c.z + 37], 2048, 1024, c.W<bf16>(WS_W_SOUT));
    for (int l = 0; l < 4; ++l) transpose_mat(c, c.in[c.z + 42] + (size_t)l * 1024 * 2048, 1024, 2048, c.W<bf16>(WS_W_PQ) + (size_t)l * 2048 * 1024);
    {
        v4u* z = (v4u*)(c.W<bf16>(WS_W_SIN) + (size_t)5152 * 1024);
        for (int i = c.gt; i < 224 * 1024 / 8; i += c.NGT) z[i] = (v4u){0u, 0u, 0u, 0u};
    }
    cvt_copy(c, c.in[c.z + 43], c.W<bf16>(WS_KEYS), (size_t)4 * 8 * 2 * 128 * 128);
    {
        float* H = c.W<float>(WS_H32); bf16* HB = c.W<bf16>(WS_HB);
        for (size_t i = (size_t)c.gt * 8; i < (size_t)T * D; i += (size_t)c.NGT * 8) {
            const float* src = (i < (size_t)TP * D) ? (c.in[c.z + 0] + i) : (c.in[c.z + 1] + (i - (size_t)TP * D));
            const f32x4 a = *(const f32x4*)(src), b = *(const f32x4*)(src + 4);
            *(f32x4*)(H + i) = a; *(f32x4*)(H + i + 4) = b;
            v4u w; w.x = pk2(a[0], a[1]); w.y = pk2(a[2], a[3]); w.z = pk2(b[0], b[1]); w.w = pk2(b[2], b[3]);
            *(v4u*)(HB + i) = w;
        }
    }
    if (c.gt < 4096) {
        const int gp = c.gt, g = gp >> 6;
        float* sm = c.W<float>(WS_SMALL);
        const float dt = expf(c.in[c.z + 10][g]);
        const float lr = c.in[c.z + 8][gp], li = c.in[c.z + 9][gp];
        const float mag = expf(lr * dt);
        const float br = mag * cosf(li * dt), bi = mag * sinf(li * dt);
        const float den = lr * lr + li * li;
        const float fr = ((br - 1.f) * lr + bi * li) / den, fi = (bi * lr - (br - 1.f) * li) / den;
        sm[SM_LBR + gp] = br; sm[SM_LBI + gp] = bi;
        for (int i = 0; i < 16; ++i) {
            const float xr = c.in[c.z + 11][gp * 16 + i], xi = c.in[c.z + 12][gp * 16 + i];
            sm[SM_BBR + gp * 16 + i] = fr * xr - fi * xi; sm[SM_BBI + gp * 16 + i] = fr * xi + fi * xr;
        }
    }
    cvt_tables(c, 0);
}

__device__ __forceinline__ void ln_row_store(const f32x4 (&v)[4], float mean, float rstd, const float* __restrict__ g, const float* __restrict__ b, float* o32, bf16* ob, int lane) {
#pragma unroll
    for (int h = 0; h < 2; ++h) {
        const int c0 = h * 512 + 8 * lane;
        const f32x4 g0 = *(const f32x4*)(g + c0), g1 = *(const f32x4*)(g + c0 + 4), b0 = *(const f32x4*)(b + c0), b1 = *(const f32x4*)(b + c0 + 4);
        const f32x4 o0 = (v[2 * h] - mean) * rstd * g0 + b0, o1 = (v[2 * h + 1] - mean) * rstd * g1 + b1;
        *(f32x4*)(o32 + c0) = o0; *(f32x4*)(o32 + c0 + 4) = o1;
        if (ob) { v4u w; w.x = pk2(o0[0], o0[1]); w.y = pk2(o0[2], o0[3]); w.z = pk2(o1[0], o1[1]); w.w = pk2(o1[2], o1[3]); *(v4u*)(ob + c0) = w; }
    }
}
__device__ __forceinline__ void ln_stats(const f32x4 (&v)[4], float& mean, float& rstd, int lane) {
    float s = 0.f;
#pragma unroll
    for (int k = 0; k < 4; ++k) s += (v[k][0] + v[k][1]) + (v[k][2] + v[k][3]);
    mean = wave_sum(s, lane) * (1.f / D);
    float q = 0.f;
#pragma unroll
    for (int k = 0; k < 4; ++k) { const f32x4 d = v[k] - mean; q += (d[0] * d[0] + d[1] * d[1]) + (d[2] * d[2] + d[3] * d[3]); }
    rstd = rsqrtf(wave_sum(q, lane) * (1.f / D) + LN_EPS);
}
__device__ __forceinline__ void phase_ln1(const Ctx& c, int layer) {
    const float* R = c.W<float>(WS_R32); float* H = c.W<float>(WS_H32); bf16* HB = c.W<bf16>(WS_HB);
    const float* g = c.in[c.z + 38] + layer * D; const float* b = c.in[c.z + 39] + layer * D;
    for (int t = c.gw; t < T; t += c.NGW) {
        f32x4 v[4];
#pragma unroll
        for (int h = 0; h < 2; ++h) { v[2 * h] = *(const f32x4*)(R + (size_t)t * D + h * 512 + 8 * c.lane); v[2 * h + 1] = *(const f32x4*)(R + (size_t)t * D + h * 512 + 8 * c.lane + 4); }
        float mean, rstd; ln_stats(v, mean, rstd, c.lane);
        ln_row_store(v, mean, rstd, g, b, H + (size_t)t * D, HB + (size_t)t * D, c.lane);
    }
}

__device__ __forceinline__ bf16x8 mk8(float a0, float a1, float a2, float a3, float a4, float a5, float a6, float a7) {
    v4u w; w.x = pk2(a0, a1); w.y = pk2(a2, a3); w.z = pk2(a4, a5); w.w = pk2(a6, a7); return __builtin_bit_cast(bf16x8, w);
}
constexpr int S5_BU_LD = 132  , S5_H_LD = 136  , S5_WAVE_BYTES = 16 * S5_BU_LD * 4 + 16 * S5_H_LD * 2;
__device__ __forceinline__ void phase_s5scan(const Ctx& c) {
    const bf16* U = c.W<bf16>(WS_A0); bf16* G = c.W<bf16>(WS_A1);
    const float* sm = c.W<float>(WS_SMALL);
    float* out = c.out;
    float* o_re_p = out + 17825792, *o_im_p = o_re_p + 32768, *o_re_s = out + 17825792 + 32768 * 2 + 122880 + 73728 + 2097152, *o_im_s = o_re_s + 524288;
    const int lane = c.lane, p = lane, fr = lane & 15, fq = lane >> 4;
    LAS float* BuT = (LAS float*)(c.lds + c.wave * S5_WAVE_BYTES);
    LAS bf16* Hi = (LAS bf16*)(c.lds + c.wave * S5_WAVE_BYTES + 16 * S5_BU_LD * 4);
    const int wslot = c.wave * c.nblk + c.bid;
    for (int unit = wslot; unit < 136 * 64; unit += c.NGW) {
        const int s = unit >> 6, g = unit & 63;
        int tok0, L; seq_info(s, tok0, L);
        bf16x8 Bf[8];
#pragma unroll
        for (int nt = 0; nt < 8; ++nt) {
            const int comp = 16 * nt + fr;
            const float* src = sm + ((comp < 64) ? SM_BBR : SM_BBI) + (size_t)(g * 64 + (comp & 63)) * 16 + 8 * (fq & 1);
            const f32x4 a = *(const f32x4*)src, b = *(const f32x4*)(src + 4);
            const bf16x8 v = mk8(a[0], a[1], a[2], a[3], b[0], b[1], b[2], b[3]);
            Bf[nt] = (fq < 2) ? v : (bf16x8){0, 0, 0, 0, 0, 0, 0, 0};
        }
        bf16x8 Cf[4];
#pragma unroll
        for (int ks = 0; ks < 4; ++ks) {
            const int comp0 = 32 * ks + 8 * fq;
            const float* src = ((ks < 2) ? c.in[c.z + 13] : c.in[c.z + 14]) + (size_t)(g * 16 + fr) * 64 + (comp0 & 63);
            const f32x4 a = *(const f32x4*)src, b = *(const f32x4*)(src + 4);
            const float sg = (ks < 2) ? 1.f : -1.f;
            Cf[ks] = mk8(sg * a[0], sg * a[1], sg * a[2], sg * a[3], sg * b[0], sg * b[1], sg * b[2], sg * b[3]);
        }
        const float lr = sm[SM_LBR + g * 64 + p], li = sm[SM_LBI + g * 64 + p];
        float hr = 0.f, hi = 0.f;
        if (s >= 8) { hr = c.in[c.z + 2][((s - 8) * 64 + g) * 64 + p]; hi = c.in[c.z + 3][((s - 8) * 64 + g) * 64 + p]; }
        const f32x4 dk4 = *(const f32x4*)(c.in[c.z + 15] + g * 16 + 4 * fq);
        const int ntile = (L + 15) >> 4;
        bf16x8 uf_n = {0, 0, 0, 0, 0, 0, 0, 0}; v2u uq_n = {0u, 0u};
        if (fr < L) { if (fq < 2) uf_n = *(const bf16x8*)(U + (size_t)(tok0 + fr) * D + g * 16 + 8 * fq); uq_n = *(const v2u*)(U + (size_t)(tok0 + fr) * D + g * 16 + 4 * fq); }
        for (int tile = 0; tile < ntile; ++tile) {
            const int tb = tok0 + tile * 16;
            const bool valid = (tile * 16 + fr) < L;
            const bf16x8 uf = uf_n; const v2u uq = uq_n;
            uf_n = (bf16x8){0, 0, 0, 0, 0, 0, 0, 0}; uq_n = (v2u){0u, 0u};
            if ((tile + 1) * 16 + fr < L) { if (fq < 2) uf_n = *(const bf16x8*)(U + (size_t)(tb + 16 + fr) * D + g * 16 + 8 * fq); uq_n = *(const v2u*)(U + (size_t)(tb + 16 + fr) * D + g * 16 + 4 * fq); }
#pragma unroll
            for (int nt = 0; nt < 8; ++nt) {
                f32x4 acc = {0.f, 0.f, 0.f, 0.f};
                acc = __builtin_amdgcn_mfma_f32_16x16x32_bf16(Bf[nt], uf, acc, 0, 0, 0);
                *(LAS f32x4*)(BuT + fr * S5_BU_LD + 16 * nt + 4 * fq) = acc;
            }
            asm volatile("s_waitcnt lgkmcnt(0)" ::: "memory");
            const int nsteps = min(16, L - tile * 16);
#pragma unroll
            for (int t = 0; t < 16; ++t) {
                const float br = BuT[t * S5_BU_LD + p], bi = BuT[t * S5_BU_LD + 64 + p];
                const float nr = lr * hr - li * hi + br, ni = lr * hi + li * hr + bi;
                if (t < nsteps) { hr = nr; hi = ni; }
                Hi[t * S5_H_LD + p] = (bf16)f2bf(hr); Hi[t * S5_H_LD + 64 + p] = (bf16)f2bf(hi);
            }
            asm volatile("s_waitcnt lgkmcnt(0)" ::: "memory");
            f32x4 y = {0.f, 0.f, 0.f, 0.f};
#pragma unroll
            for (int ks = 0; ks < 4; ++ks) {
                const bf16x8 hf = *(const LAS bf16x8*)(Hi + fr * S5_H_LD + 32 * ks + 8 * fq);
                y = __builtin_amdgcn_mfma_f32_16x16x32_bf16(Cf[ks], hf, y, 0, 0, 0);
            }
            if (valid) {
                v2u o; o.x = pk2(gelu_f(y[0] + dk4[0] * bflo(uq.x)), gelu_f(y[1] + dk4[1] * bfhi(uq.x))); o.y = pk2(gelu_f(y[2] + dk4[2] * bflo(uq.y)), gelu_f(y[3] + dk4[3] * bfhi(uq.y)));
                *(v2u*)(G + (size_t)(tb + fr) * D + g * 16 + 4 * fq) = o;
            }
            asm volatile("" ::: "memory");
        }
        if (s < 8) { o_re_p[(s * 64 + g) * 64 + p] = hr; o_im_p[(s * 64 + g) * 64 + p] = hi; }
        else { o_re_s[((s - 8) * 64 + g) * 64 + p] = hr; o_im_s[((s - 8) * 64 + g) * 64 + p] = hi; }
    }
}

__device__ __forceinline__ void unpack8(const v4u q, float (&f)[8]) { f[0] = bflo(q.x); f[1] = bfhi(q.x); f[2] = bflo(q.y); f[3] = bfhi(q.y); f[4] = bflo(q.z); f[5] = bfhi(q.z); f[6] = bflo(q.w); f[7] = bfhi(q.w); }
__device__ __forceinline__ void phase_pool(const Ctx& c) {
    const bf16* U = c.W<bf16>(WS_A0); bf16* P = c.W<bf16>(WS_A1);
    float* o_p = c.out + 17825792 + 65536, *o_s = c.out + 17825792 + 65536 + 122880 + 73728 + 2097152 + 1048576;
    for (int item = c.gt; item < 384 * 128; item += c.NGT) {
        const int rg = item >> 7, c0 = (item & 127) * 8, w = 2 << (c0 >> 8);
        int tok0, l0, n, sb;
        if (rg < 256) { tok0 = (rg >> 5) << 11; l0 = (rg & 31) * 64; n = 64; sb = -1; } else { sb = rg - 256; tok0 = TP + sb * 8; l0 = 0; n = 8; }
        float sum[8];
#pragma unroll
        for (int j = 0; j < 8; ++j) sum[j] = 0.f;
        for (int k = 1; k < w; ++k) {
            const int ll = l0 - k; float f[8];
            if (ll >= 0) unpack8(*(const v4u*)(U + (size_t)(tok0 + ll) * D + c0), f);
            else if (sb >= 0) { const float* sp = c.in[c.z + 4] + ((size_t)sb * 15 + (15 + ll)) * D + c0; const f32x4 a = *(const f32x4*)sp, b = *(const f32x4*)(sp + 4); f[0] = a[0]; f[1] = a[1]; f[2] = a[2]; f[3] = a[3]; f[4] = b[0]; f[5] = b[1]; f[6] = b[2]; f[7] = b[3]; }
            else {
#pragma unroll
                for (int j = 0; j < 8; ++j) f[j] = 0.f;
            }
#pragma unroll
            for (int j = 0; j < 8; ++j) sum[j] += f[j];
        }
        for (int i = 0; i < n; ++i) {
            const int l = l0 + i; float cur[8], old[8];
            unpack8(*(const v4u*)(U + (size_t)(tok0 + l) * D + c0), cur);
#pragma unroll
            for (int j = 0; j < 8; ++j) sum[j] += cur[j];
            const int pos = (sb >= 0 ? 16384 : 0) + l;
            const float inv = 1.f / (float)min(pos + 1, w);
            v4u o; o.x = pk2(sum[0] * inv - cur[0], sum[1] * inv - cur[1]); o.y = pk2(sum[2] * inv - cur[2], sum[3] * inv - cur[3]);
            o.z = pk2(sum[4] * inv - cur[4], sum[5] * inv - cur[5]); o.w = pk2(sum[6] * inv - cur[6], sum[7] * inv - cur[7]);
            *(v4u*)(P + (size_t)(tok0 + l) * D + c0) = o;
            const int lo = l - w + 1;
            if (lo >= 0) unpack8(*(const v4u*)(U + (size_t)(tok0 + lo) * D + c0), old);
            else if (sb >= 0) { const float* sp = c.in[c.z + 4] + ((size_t)sb * 15 + (15 + lo)) * D + c0; const f32x4 a = *(const f32x4*)sp, b = *(const f32x4*)(sp + 4); old[0] = a[0]; old[1] = a[1]; old[2] = a[2]; old[3] = a[3]; old[4] = b[0]; old[5] = b[1]; old[6] = b[2]; old[7] = b[3]; }
            else {
#pragma unroll
                for (int j = 0; j < 8; ++j) old[j] = 0.f;
            }
#pragma unroll
            for (int j = 0; j < 8; ++j) sum[j] -= old[j];
        }
    }
    for (size_t i = (size_t)c.gt; i < (size_t)136 * 15 * D; i += (size_t)c.NGT) {
        const int ch = (int)(i & 1023); const int j = (int)((i >> 10) % 15); const int s = (int)(i / (15 * 1024));
        if (s < 8) o_p[((size_t)s * 15 + j) * D + ch] = bf2f(U[(size_t)(s * 2048 + 2033 + j) * D + ch]);
        else { const int b = s - 8; o_s[((size_t)b * 15 + j) * D + ch] = (j < 7) ? c.in[c.z + 4][((size_t)b * 15 + 8 + j) * D + ch] : bf2f(U[(size_t)(TP + b * 8 + (j - 7)) * D + ch]); }
    }
}

__device__ __forceinline__ void phase_cmlp_ln(const Ctx& c) {
    bf16* Z = c.W<bf16>(WS_Q);
    float* o_v = c.out + 17825792 + 65536 + 122880 + 73728 + 2097152 + 1048576 + 1966080;
    const float* g = c.in[c.z + 25]; const float* b = c.in[c.z + 26];
    for (int t = c.gw; t < T; t += c.NGW) {
        bf16* vr = Z + (size_t)t * 2048 + 1024;
        f32x4 v[4];
#pragma unroll
        for (int h = 0; h < 2; ++h) {
            const v4u q = *(const v4u*)(vr + h * 512 + 8 * c.lane);
            v[2 * h] = (f32x4){bflo(q.x), bfhi(q.x), bflo(q.y), bfhi(q.y)}; v[2 * h + 1] = (f32x4){bflo(q.z), bfhi(q.z), bflo(q.w), bfhi(q.w)};
        }
        float mean, rstd; ln_stats(v, mean, rstd, c.lane);
#pragma unroll
        for (int h = 0; h < 2; ++h) {
            const int c0 = h * 512 + 8 * c.lane;
            const f32x4 g0 = *(const f32x4*)(g + c0), g1 = *(const f32x4*)(g + c0 + 4), b0 = *(const f32x4*)(b + c0), b1 = *(const f32x4*)(b + c0 + 4);
            const f32x4 o0 = (v[2 * h] - mean) * rstd * g0 + b0, o1 = (v[2 * h + 1] - mean) * rstd * g1 + b1;
            v4u w; w.x = pk2(o0[0], o0[1]); w.y = pk2(o0[2], o0[3]); w.z = pk2(o1[0], o1[1]); w.w = pk2(o1[2], o1[3]);
            *(v4u*)(vr + c0) = w;
            if (t >= TP) { *(f32x4*)(o_v + (size_t)(t - TP) * D + c0) = o0; *(f32x4*)(o_v + (size_t)(t - TP) * D + c0 + 4) = o1; }
        }
    }
}
constexpr int CM_LD = 136, CM_WS = 0  , CM_VT = 34816  ;
__device__ __forceinline__ void phase_cmlp_mix(const Ctx& c) {
    const bf16* Z = c.W<bf16>(WS_Q); bf16* O = c.W<bf16>(WS_A1);
    LAS unsigned char* lds = c.lds;
    const int tid = c.tid, lane = c.lane, w = c.wave, fr = lane & 15, fq = lane >> 4;
    for (int unit = c.bid; unit < 128 * 4; unit += c.nblk) {
        const int chunk = unit >> 2, hd = unit & 3, tokc = chunk * 128;
#pragma unroll
        for (int k = 0; k < 4; ++k) {
            const int q = tid + 512 * k, row = q >> 4, cc = q & 15;
            const float* src = c.in[c.z + 27] + ((size_t)hd * 128 + row) * 128 + cc * 8;
            const f32x4 a = *(const f32x4*)src, b = *(const f32x4*)(src + 4);
            float f[8] = {a[0], a[1], a[2], a[3], b[0], b[1], b[2], b[3]};
#pragma unroll
            for (int j = 0; j < 8; ++j) f[j] = (cc * 8 + j <= row) ? f[j] : 0.f;
            v4u o; o.x = pk2(f[0], f[1]); o.y = pk2(f[2], f[3]); o.z = pk2(f[4], f[5]); o.w = pk2(f[6], f[7]);
            *(LAS v4u*)(lds + CM_WS + (row * CM_LD + cc * 8) * 2) = o;
        }
        {
            const int srow = tid & 127, dq = tid >> 7;
            const bf16* vs = Z + (size_t)(tokc + srow) * 2048 + 1024 + hd * 256 + dq * 64;
#pragma unroll
            for (int k = 0; k < 8; ++k) {
                const v4u q = *(const v4u*)(vs + 8 * k);
                const unsigned xw[4] = {q.x, q.y, q.z, q.w};
#pragma unroll
                for (int j = 0; j < 4; ++j) {
                    *(LAS bf16*)(lds + CM_VT + ((dq * 64 + 8 * k + 2 * j) * CM_LD + srow) * 2) = (bf16)(xw[j] & 0xffffu);
                    *(LAS bf16*)(lds + CM_VT + ((dq * 64 + 8 * k + 2 * j + 1) * CM_LD + srow) * 2) = (bf16)(xw[j] >> 16);
                }
            }
        }
        __syncthreads();
        f32x4 acc[16];
#pragma unroll
        for (int jd = 0; jd < 16; ++jd) acc[jd] = (f32x4){0.f, 0.f, 0.f, 0.f};
#pragma unroll
        for (int ks = 0; ks < 4; ++ks) {
            if (ks <= (w >> 1)) {
                const bf16x8 wf = *(const LAS bf16x8*)(lds + CM_WS + ((16 * w + fr) * CM_LD + ks * 32 + 8 * fq) * 2);
#pragma unroll
                for (int jd = 0; jd < 16; ++jd)
                    acc[jd] = __builtin_amdgcn_mfma_f32_16x16x32_bf16(*(const LAS bf16x8*)(lds + CM_VT + ((16 * jd + fr) * CM_LD + ks * 32 + 8 * fq) * 2), wf, acc[jd], 0, 0, 0);
            }
        }
        {
            const int t = 16 * w + fr; const size_t tok = (size_t)(tokc + t);
            const float bs = c.in[c.z + 28][hd * 128 + t];
#pragma unroll
            for (int jd = 0; jd < 16; ++jd) {
                const v2u uq = *(const v2u*)(Z + tok * 2048 + hd * 256 + 16 * jd + 4 * fq);
                v2u o; o.x = pk2(bflo(uq.x) * (acc[jd][0] + bs), bfhi(uq.x) * (acc[jd][1] + bs)); o.y = pk2(bflo(uq.y) * (acc[jd][2] + bs), bfhi(uq.y) * (acc[jd][3] + bs));
                *(v2u*)(O + tok * D + hd * 256 + 16 * jd + 4 * fq) = o;
            }
        }
        __syncthreads();
    }
    for (size_t i = (size_t)c.gt; i < (size_t)(T - TP) * 128; i += (size_t)c.NGT) {
        const int t = TP + (int)(i >> 7), c0 = (int)(i & 127) * 8;
        const int hd = c0 >> 8, tp = (t - TP) & 7, base = t - tp;
        float acc[8];
        const float bs = c.in[c.z + 28][hd * 128 + tp];
#pragma unroll
        for (int j = 0; j < 8; ++j) acc[j] = bs;
        const float* wr = c.in[c.z + 27] + ((size_t)hd * 128 + tp) * 128;
        for (int sp = 0; sp <= tp; ++sp) {
            const float wv = wr[sp];
            const v4u q = *(const v4u*)(Z + (size_t)(base + sp) * 2048 + 1024 + c0);
            acc[0] += wv * bflo(q.x); acc[1] += wv * bfhi(q.x); acc[2] += wv * bflo(q.y); acc[3] += wv * bfhi(q.y);
            acc[4] += wv * bflo(q.z); acc[5] += wv * bfhi(q.z); acc[6] += wv * bflo(q.w); acc[7] += wv * bfhi(q.w);
        }
        const v4u uq = *(const v4u*)(Z + (size_t)t * 2048 + c0);
        v4u o; o.x = pk2(bflo(uq.x) * acc[0], bfhi(uq.x) * acc[1]); o.y = pk2(bflo(uq.y) * acc[2], bfhi(uq.y) * acc[3]);
        o.z = pk2(bflo(uq.z) * acc[4], bfhi(uq.z) * acc[5]); o.w = pk2(bflo(uq.w) * acc[6], bfhi(uq.w) * acc[7]);
        *(v4u*)(O + (size_t)t * D + c0) = o;
    }
}

__device__ __forceinline__ void phase_ssd_conv(const Ctx& c) {
    const bf16* X = c.W<bf16>(WS_XBC); bf16* XC = c.W<bf16>(WS_XC);
    float* o_p = c.out + 17825792 + 65536 + 122880, *o_s = c.out + 17825792 + 65536 + 122880 + 73728 + 2097152 + 1048576 + 1966080 + 1048576;
    for (int item = c.gt; item < 384 * 384; item += c.NGT) {
        const int rg = item / 384, c0 = (item % 384) * 8;
        int tok0, l0, n, sb;
        if (rg < 256) { tok0 = (rg >> 5) << 11; l0 = (rg & 31) * 64; n = 64; sb = -1; } else { sb = rg - 256; tok0 = TP + sb * 8; l0 = 0; n = 8; }
        float wt[4][8], bias[8];
#pragma unroll
        for (int k = 0; k < 4; ++k) { const f32x4 a = *(const f32x4*)(c.in[c.z + 31] + k * CONVD + c0), b = *(const f32x4*)(c.in[c.z + 31] + k * CONVD + c0 + 4);
            wt[k][0] = a[0]; wt[k][1] = a[1]; wt[k][2] = a[2]; wt[k][3] = a[3]; wt[k][4] = b[0]; wt[k][5] = b[1]; wt[k][6] = b[2]; wt[k][7] = b[3]; }
        { const f32x4 a = *(const f32x4*)(c.in[c.z + 32] + c0), b = *(const f32x4*)(c.in[c.z + 32] + c0 + 4); bias[0] = a[0]; bias[1] = a[1]; bias[2] = a[2]; bias[3] = a[3]; bias[4] = b[0]; bias[5] = b[1]; bias[6] = b[2]; bias[7] = b[3]; }
        float r0[8], r1[8], r2[8];
#pragma unroll
        for (int k = 0; k < 3; ++k) {
            const int src = l0 - 3 + k; float f[8];
            if (src >= 0) unpack8(*(const v4u*)(X + (size_t)(tok0 + src) * CONVD + c0), f);
            else if (sb >= 0) { const float* sp = c.in[c.z + 5] + ((size_t)sb * 3 + (3 + src)) * CONVD + c0; const f32x4 a = *(const f32x4*)sp, b = *(const f32x4*)(sp + 4); f[0] = a[0]; f[1] = a[1]; f[2] = a[2]; f[3] = a[3]; f[4] = b[0]; f[5] = b[1]; f[6] = b[2]; f[7] = b[3]; }
            else {
#pragma unroll
                for (int j = 0; j < 8; ++j) f[j] = 0.f;
            }
#pragma unroll
            for (int j = 0; j < 8; ++j) { if (k == 0) r0[j] = f[j]; else if (k == 1) r1[j] = f[j]; else r2[j] = f[j]; }
        }
        for (int i = 0; i < n; ++i) {
            float cur[8], o[8];
            unpack8(*(const v4u*)(X + (size_t)(tok0 + l0 + i) * CONVD + c0), cur);
#pragma unroll
            for (int j = 0; j < 8; ++j) { o[j] = silu_f(bias[j] + r0[j] * wt[0][j] + r1[j] * wt[1][j] + r2[j] * wt[2][j] + cur[j] * wt[3][j]); r0[j] = r1[j]; r1[j] = r2[j]; r2[j] = cur[j]; }
            v4u q; q.x = pk2(o[0], o[1]); q.y = pk2(o[2], o[3]); q.z = pk2(o[4], o[5]); q.w = pk2(o[6], o[7]);
            *(v4u*)(XC + (size_t)(tok0 + l0 + i) * CONVD + c0) = q;
        }
    }
    for (size_t i = (size_t)c.gt; i < (size_t)136 * 3 * CONVD; i += (size_t)c.NGT) {
        const int ch = (int)(i % CONVD); const int j = (int)((i / CONVD) % 3); const int s = (int)(i / (3 * CONVD));
        if (s < 8) o_p[((size_t)s * 3 + j) * CONVD + ch] = bf2f(X[(size_t)(s * 2048 + 2045 + j) * CONVD + ch]);
        else { const int b = s - 8; o_s[((size_t)b * 3 + j) * CONVD + ch] = bf2f(X[(size_t)(TP + b * 8 + 5 + j) * CONVD + ch]); }
    }
}
constexpr int SD_LD = 136;
constexpr int SD_C = 0, SD_B = 34816, SD_BT = 69632, SD_XT = 104448, SD_HB = 121856, SD_VEC = 139264;
__device__ __forceinline__ float softplus_f(float x) { return (x > 20.f) ? x : log1pf(__expf(x)); }
__device__ __forceinline__ void phase_ssd_scan(const Ctx& c) {
    const bf16* XC = c.W<bf16>(WS_XC); const float* DT = c.W<float>(WS_DT); bf16* Y = c.W<bf16>(WS_Y);
    float* o_p = c.out + 17825792 + 65536 + 122880 + 73728;
    float* o_s = c.out + 17825792 + 65536 + 122880 + 73728 + 2097152 + 1048576 + 1966080 + 1048576 + 1179648;
    const int tid = c.tid, lane = c.lane, w = c.wave, fr = lane & 15, fq = lane >> 4;
    LAS unsigned char* lds = c.lds;
    LAS float* csv = (LAS float*)(lds + SD_VEC); LAS float* dtv = csv + 128;
#define SD_FRAG(img, row, ks) (*(const LAS bf16x8*)(lds + (img) + ((row) * SD_LD + (ks) * 32 + 8 * fq) * 2))
    for (int unit = c.bid; unit < 8 * 32; unit += c.nblk) {
        const int s = unit >> 5, hd = unit & 31, g = hd >> 3;
        const float a = -__expf(c.in[c.z + 34][hd]), dtb = c.in[c.z + 33][hd], dk = c.in[c.z + 35][hd];
        f32x4 hacc[4];
#pragma unroll
        for (int jp = 0; jp < 4; ++jp) hacc[jp] = (f32x4){0.f, 0.f, 0.f, 0.f};
        for (int ch = 0; ch < 16; ++ch) {
            const int tokc = s * 2048 + ch * 128;
            if (w == 0) {
                const float dt0 = softplus_f(DT[(size_t)(tokc + lane) * 32 + hd] + dtb), dt1 = softplus_f(DT[(size_t)(tokc + 64 + lane) * 32 + hd] + dtb);
                float s0 = dt0 * a, s1 = dt1 * a;
#pragma unroll
                for (int o = 1; o < 64; o <<= 1) {
                    const float u0 = __builtin_bit_cast(float, __builtin_amdgcn_ds_bpermute(((lane - o) & 63) << 2, __builtin_bit_cast(int, s0)));
                    const float u1 = __builtin_bit_cast(float, __builtin_amdgcn_ds_bpermute(((lane - o) & 63) << 2, __builtin_bit_cast(int, s1)));
                    if (lane >= o) { s0 += u0; s1 += u1; }
                }
                const float tot0 = __builtin_bit_cast(float, __builtin_amdgcn_readlane(__builtin_bit_cast(int, s0), 63));
                csv[lane] = s0; csv[64 + lane] = tot0 + s1; dtv[lane] = dt0; dtv[64 + lane] = dt1;
            }
#pragma unroll
            for (int k = 0; k < 4; ++k) {
                const int q = tid + 512 * k, row = q >> 4, cc = q & 15;
                const bf16* src = XC + (size_t)(tokc + row) * CONVD + g * 128 + cc * 8;
                *(LAS v4u*)(lds + SD_C + (row * SD_LD + cc * 8) * 2) = *(const v4u*)(src + 2560);
                *(LAS v4u*)(lds + SD_B + (row * SD_LD + cc * 8) * 2) = *(const v4u*)(src + 2048);
            }
#pragma unroll
            for (int jp = 0; jp < 4; ++jp) {
                v2u hq; hq.x = pk2(hacc[jp][0], hacc[jp][1]); hq.y = pk2(hacc[jp][2], hacc[jp][3]);
                *(LAS v2u*)(lds + SD_HB + ((16 * jp + fr) * SD_LD + 16 * w + 4 * fq) * 2) = hq;
            }
            __syncthreads();
            {
                const int srow = tid & 127, qq = tid >> 7;
                const float sc = __expf(csv[127] - csv[srow]) * dtv[srow];
#pragma unroll
                for (int k = 0; k < 4; ++k) {
                    const int n0 = qq * 32 + k * 8;
                    const v4u bq = *(const LAS v4u*)(lds + SD_B + (srow * SD_LD + n0) * 2);
                    const float f[8] = {bflo(bq.x), bfhi(bq.x), bflo(bq.y), bfhi(bq.y), bflo(bq.z), bfhi(bq.z), bflo(bq.w), bfhi(bq.w)};
#pragma unroll
                    for (int j = 0; j < 8; ++j) *(LAS bf16*)(lds + SD_BT + ((n0 + j) * SD_LD + srow) * 2) = (bf16)f2bf(f[j] * sc);
                }
                const bf16* xs = XC + (size_t)(tokc + srow) * CONVD + hd * 64 + qq * 16;
                const v4u x0 = *(const v4u*)xs, x1 = *(const v4u*)(xs + 8);
                const unsigned xw[8] = {x0.x, x0.y, x0.z, x0.w, x1.x, x1.y, x1.z, x1.w};
#pragma unroll
                for (int j = 0; j < 8; ++j) {
                    *(LAS bf16*)(lds + SD_XT + ((qq * 16 + 2 * j) * SD_LD + srow) * 2) = (bf16)(xw[j] & 0xffffu);
                    *(LAS bf16*)(lds + SD_XT + ((qq * 16 + 2 * j + 1) * SD_LD + srow) * 2) = (bf16)(xw[j] >> 16);
                }
            }
            __syncthreads();
            const int jmax = w | 1;
            bf16x8 Cf[4];
#pragma unroll
            for (int ks = 0; ks < 4; ++ks) Cf[ks] = SD_FRAG(SD_C, 16 * w + fr, ks);
            f32x4 acc[8];
#pragma unroll
            for (int j = 0; j < 8; ++j) {
                acc[j] = (f32x4){0.f, 0.f, 0.f, 0.f};
                if (j <= jmax) {
#pragma unroll
                    for (int ks = 0; ks < 4; ++ks) acc[j] = __builtin_amdgcn_mfma_f32_16x16x32_bf16(SD_FRAG(SD_B, 16 * j + fr, ks), Cf[ks], acc[j], 0, 0, 0);
                }
            }
            {
                const float cdec = __expf(csv[127]);
                bf16x8 Bt[4];
#pragma unroll
                for (int ks = 0; ks < 4; ++ks) Bt[ks] = SD_FRAG(SD_BT, 16 * w + fr, ks);
#pragma unroll
                for (int jp = 0; jp < 4; ++jp) {
                    hacc[jp] = hacc[jp] * cdec;
#pragma unroll
                    for (int ks = 0; ks < 4; ++ks) hacc[jp] = __builtin_amdgcn_mfma_f32_16x16x32_bf16(Bt[ks], SD_FRAG(SD_XT, 16 * jp + fr, ks), hacc[jp], 0, 0, 0);
                }
            }
            __syncthreads();
            {
                const int t = 16 * w + fr; const float cst = csv[t];
#pragma unroll
                for (int j = 0; j < 8; ++j) {
                    if (j <= jmax) {
                        const f32x4 css = *(const LAS f32x4*)(csv + 16 * j + 4 * fq), dts = *(const LAS f32x4*)(dtv + 16 * j + 4 * fq);
                        float v[4];
#pragma unroll
                        for (int r = 0; r < 4; ++r) v[r] = (16 * j + 4 * fq + r <= t) ? acc[j][r] * __expf(cst - css[r]) * dts[r] : 0.f;
                        v2u lq; lq.x = pk2(v[0], v[1]); lq.y = pk2(v[2], v[3]);
                        *(LAS v2u*)(lds + SD_B + (t * SD_LD + 16 * j + 4 * fq) * 2) = lq;
                    }
                }
            }
            __syncthreads();
            {
                f32x4 a1[4], a2[4];
#pragma unroll
                for (int jp = 0; jp < 4; ++jp) { a1[jp] = (f32x4){0.f, 0.f, 0.f, 0.f}; a2[jp] = (f32x4){0.f, 0.f, 0.f, 0.f}; }
#pragma unroll
                for (int ks = 0; ks < 4; ++ks) {
                    if (ks <= (w >> 1)) {
                        const bf16x8 Lf = SD_FRAG(SD_B, 16 * w + fr, ks);
#pragma unroll
                        for (int jp = 0; jp < 4; ++jp) a1[jp] = __builtin_amdgcn_mfma_f32_16x16x32_bf16(SD_FRAG(SD_XT, 16 * jp + fr, ks), Lf, a1[jp], 0, 0, 0);
                    }
#pragma unroll
                    for (int jp = 0; jp < 4; ++jp) a2[jp] = __builtin_amdgcn_mfma_f32_16x16x32_bf16(SD_FRAG(SD_HB, 16 * jp + fr, ks), Cf[ks], a2[jp], 0, 0, 0);
                }
                const int t = 16 * w + fr; const float ecs = __expf(csv[t]);
                const size_t tok = (size_t)(tokc + t);
#pragma unroll
                for (int jp = 0; jp < 4; ++jp) {
                    const v2u xq = *(const v2u*)(XC + tok * CONVD + hd * 64 + 16 * jp + 4 * fq);
                    v2u yo; yo.x = pk2(a1[jp][0] + ecs * a2[jp][0] + dk * bflo(xq.x), a1[jp][1] + ecs * a2[jp][1] + dk * bfhi(xq.x));
                    yo.y = pk2(a1[jp][2] + ecs * a2[jp][2] + dk * bflo(xq.y), a1[jp][3] + ecs * a2[jp][3] + dk * bfhi(xq.y));
                    *(v2u*)(Y + tok * 2048 + hd * 64 + 16 * jp + 4 * fq) = yo;
                }
            }
            __syncthreads();
        }
#pragma unroll
        for (int jp = 0; jp < 4; ++jp) *(f32x4*)(o_p + (((size_t)s * 32 + hd) * 64 + 16 * jp + fr) * 128 + 16 * w + 4 * fq) = hacc[jp];
    }
#undef SD_FRAG
    __syncthreads();
    {
        LAS float* Bw = (LAS float*)(lds + w * 8192);
        LAS float* Cw = Bw + 1024;
        for (int unit = c.gw; unit < 128 * 32; unit += c.NGW) {
            const int b = unit >> 5, hd = unit & 31, g = hd >> 3, tok0 = TP + b * 8, p = lane;
            const float a = -__expf(c.in[c.z + 34][hd]), dtb = c.in[c.z + 33][hd], dk = c.in[c.z + 35][hd];
            {
                const int tk = lane >> 3, c0 = (lane & 7) * 16;
                const bf16* src = XC + (size_t)(tok0 + tk) * CONVD + g * 128 + c0;
                const v4u b0 = *(const v4u*)(src + 2048), b1 = *(const v4u*)(src + 2048 + 8), c0v = *(const v4u*)(src + 2560), c1v = *(const v4u*)(src + 2560 + 8);
                LAS float* bd = Bw + tk * 128 + c0; LAS float* cd = Cw + tk * 128 + c0;
                *(LAS f32x4*)(bd) = (f32x4){bflo(b0.x), bfhi(b0.x), bflo(b0.y), bfhi(b0.y)}; *(LAS f32x4*)(bd + 4) = (f32x4){bflo(b0.z), bfhi(b0.z), bflo(b0.w), bfhi(b0.w)};
                *(LAS f32x4*)(bd + 8) = (f32x4){bflo(b1.x), bfhi(b1.x), bflo(b1.y), bfhi(b1.y)}; *(LAS f32x4*)(bd + 12) = (f32x4){bflo(b1.z), bfhi(b1.z), bflo(b1.w), bfhi(b1.w)};
                *(LAS f32x4*)(cd) = (f32x4){bflo(c0v.x), bfhi(c0v.x), bflo(c0v.y), bfhi(c0v.y)}; *(LAS f32x4*)(cd + 4) = (f32x4){bflo(c0v.z), bfhi(c0v.z), bflo(c0v.w), bfhi(c0v.w)};
                *(LAS f32x4*)(cd + 8) = (f32x4){bflo(c1v.x), bfhi(c1v.x), bflo(c1v.y), bfhi(c1v.y)}; *(LAS f32x4*)(cd + 12) = (f32x4){bflo(c1v.z), bfhi(c1v.z), bflo(c1v.w), bfhi(c1v.w)};
            }
            float xv[8], dA[8], coef[8], yv[8];
#pragma unroll
            for (int t = 0; t < 8; ++t) {
                xv[t] = bf2f(XC[(size_t)(tok0 + t) * CONVD + hd * 64 + p]);
                const float dtv_ = softplus_f(DT[(size_t)(tok0 + t) * 32 + hd] + dtb);
                dA[t] = __expf(dtv_ * a); coef[t] = dtv_ * xv[t]; yv[t] = dk * xv[t];
            }
            asm volatile("s_waitcnt lgkmcnt(0)" ::: "memory");
            const float* hin = c.in[c.z + 6] + (((size_t)b * 32 + hd) * 64 + p) * 128;
            float* hout = o_s + (((size_t)b * 32 + hd) * 64 + p) * 128;
#pragma unroll 1
            for (int qt = 0; qt < 4; ++qt) {
                float h[32];
#pragma unroll
                for (int i = 0; i < 8; ++i) { const f32x4 q = *(const f32x4*)(hin + qt * 32 + 4 * i); h[4 * i] = q[0]; h[4 * i + 1] = q[1]; h[4 * i + 2] = q[2]; h[4 * i + 3] = q[3]; }
#pragma unroll
                for (int t = 0; t < 8; ++t) {
                    float ya = 0.f, yb = 0.f;
#pragma unroll
                    for (int i = 0; i < 8; ++i) {
                        const f32x4 bq = *(const LAS f32x4*)(Bw + t * 128 + qt * 32 + 4 * i), cq = *(const LAS f32x4*)(Cw + t * 128 + qt * 32 + 4 * i);
                        h[4 * i] = h[4 * i] * dA[t] + coef[t] * bq[0]; ya += cq[0] * h[4 * i];
                        h[4 * i + 1] = h[4 * i + 1] * dA[t] + coef[t] * bq[1]; yb += cq[1] * h[4 * i + 1];
                        h[4 * i + 2] = h[4 * i + 2] * dA[t] + coef[t] * bq[2]; ya += cq[2] * h[4 * i + 2];
                        h[4 * i + 3] = h[4 * i + 3] * dA[t] + coef[t] * bq[3]; yb += cq[3] * h[4 * i + 3];
                    }
                    yv[t] += ya + yb;
                    asm volatile("" ::: "memory");
                }
#pragma unroll
                for (int i = 0; i < 8; ++i) *(f32x4*)(hout + qt * 32 + 4 * i) = (f32x4){h[4 * i], h[4 * i + 1], h[4 * i + 2], h[4 * i + 3]};
            }
#pragma unroll
            for (int t = 0; t < 8; ++t) Y[(size_t)(tok0 + t) * 2048 + hd * 64 + p] = (bf16)f2bf(yv[t]);
            asm volatile("" ::: "memory");
        }
    }
}
__device__ __forceinline__ void phase_ssd_gatenorm(const Ctx& c) {
    const bf16* Y = c.W<bf16>(WS_Y); const bf16* Z = c.W<bf16>(WS_Q); bf16* YN = c.W<bf16>(WS_YN);
    for (int it = c.gw; it < T * 4; it += c.NGW) {
        const int t = it >> 2, c0 = (it & 3) * 512 + 8 * c.lane;
        const v4u yq = *(const v4u*)(Y + (size_t)t * 2048 + c0), zq = *(const v4u*)(Z + (size_t)t * 2048 + c0);
        const float yf[8] = {bflo(yq.x), bfhi(yq.x), bflo(yq.y), bfhi(yq.y), bflo(yq.z), bfhi(yq.z), bflo(yq.w), bfhi(yq.w)};
        const float zf[8] = {bflo(zq.x), bfhi(zq.x), bflo(zq.y), bfhi(zq.y), bflo(zq.z), bfhi(zq.z), bflo(zq.w), bfhi(zq.w)};
        float v[8]; float q = 0.f;
#pragma unroll
        for (int j = 0; j < 8; ++j) { v[j] = yf[j] * silu_f(zf[j]); q += v[j] * v[j]; }
        const float r = rsqrtf(wave_sum(q, c.lane) * (1.f / 512.f) + RMS_EPS);
        const f32x4 g0 = *(const f32x4*)(c.in[c.z + 36] + c0), g1 = *(const f32x4*)(c.in[c.z + 36] + c0 + 4);
        v4u o; o.x = pk2(v[0] * r * g0[0], v[1] * r * g0[1]); o.y = pk2(v[2] * r * g0[2], v[3] * r * g0[3]); o.z = pk2(v[4] * r * g1[0], v[5] * r * g1[1]); o.w = pk2(v[6] * r * g1[2], v[7] * r * g1[3]);
        *(v4u*)(YN + (size_t)t * 2048 + c0) = o;
    }
}

__device__ __forceinline__ unsigned ord_key(float s) { const unsigned u = __builtin_bit_cast(unsigned, s); return (u & 0x80000000u) ? ~u : (u | 0x80000000u); }
__device__ __forceinline__ float ord_dec(unsigned k) { const unsigned u = (k & 0x80000000u) ? (k & 0x7fffffffu) : ~k; return __builtin_bit_cast(float, u); }
__device__ __forceinline__ void ins16(unsigned (&Lk)[16], unsigned x) {
#pragma unroll
    for (int k = 0; k < 16; ++k) { const unsigned hi = max(Lk[k], x); x = min(Lk[k], x); Lk[k] = hi; }
}
__device__ __forceinline__ void ce_desc(unsigned& a, unsigned& b) { const unsigned hi = max(a, b), lo = min(a, b); a = hi; b = lo; }
__device__ __forceinline__ void ce_asc(unsigned& a, unsigned& b) { const unsigned hi = max(a, b), lo = min(a, b); a = lo; b = hi; }
__device__ __forceinline__ void sort16_desc(unsigned (&a)[16]) {
#pragma unroll
    for (int k = 2; k <= 16; k <<= 1)
#pragma unroll
        for (int j = k >> 1; j > 0; j >>= 1)
#pragma unroll
            for (int i = 0; i < 16; ++i) { const int l = i ^ j; if (l > i) { if ((i & k) == 0) ce_desc(a[i], a[l]); else ce_asc(a[i], a[l]); } }
}
__device__ __forceinline__ void bmerge16_desc(unsigned (&a)[16]) {
#pragma unroll
    for (int j = 8; j > 0; j >>= 1)
#pragma unroll
        for (int i = 0; i < 16; ++i) { const int l = i ^ j; if (l > i) ce_desc(a[i], a[l]); }
}
__device__ __forceinline__ void xmerge16(unsigned (&a)[16], int o, int lane) {
    unsigned pq[16];
#pragma unroll
    for (int k = 0; k < 16; ++k) pq[k] = (unsigned)__builtin_amdgcn_ds_bpermute((lane ^ o) << 2, (int)a[k]);
#pragma unroll
    for (int k = 0; k < 16; ++k) a[k] = max(a[k], pq[15 - k]);
    bmerge16_desc(a);
}
struct CandTab { unsigned char v[52]; };
constexpr CandTab make_cands() { CandTab t{}; int n = 0; for (int i = 0; i < 16; ++i) for (int j = 0; j < 16; ++j) if ((i + 1) * (j + 1) <= 16) t.v[n++] = (unsigned char)(i * 16 + j); return t; }
__device__ __forceinline__ void phase_route(const Ctx& c, int layer) {
    constexpr CandTab CT = make_cands();
    const bf16* Q = c.W<bf16>(WS_Q); const bf16* KEYS = c.W<bf16>(WS_KEYS) + (size_t)layer * 8 * 2 * 128 * 128;
    int* IDX = c.W<int>(WS_IDX); float* GATE = c.W<float>(WS_GATE); float* SCU = c.W<float>(WS_SCU);
    const float* ISU = c.W<float>(WS_SMALL) + SM_ISU; const float* ISV = c.W<float>(WS_SMALL) + SM_ISV;
    const int lane = c.lane, fr = lane & 15, fq = lane >> 4;
    constexpr int RK_LD = 136, RK_BYTES = 2 * 128 * RK_LD * 2;
    LAS unsigned* lists = (LAS unsigned*)(c.lds + RK_BYTES + c.wave * 2048);
    const int h = c.bid & 7;
    {
        const bf16* kg = KEYS + (size_t)h * 2 * 128 * 128;
        for (int q = c.tid; q < 2 * 128 * 16; q += NTHR) { const int row = q >> 4, cc = q & 15; *(LAS v4u*)(c.lds + (row * RK_LD + cc * 8) * 2) = *(const v4u*)(kg + (size_t)row * 128 + cc * 8); }
    }
    __syncthreads();
    const int nb8 = c.nblk >> 3;
    for (int tg = (c.bid >> 3) + nb8 * c.wave; tg < 1088; tg += nb8 * NWAVES) {
        const int tok0 = tg * 16;
        const bf16* qrow = Q + (size_t)(tok0 + fr) * 2048 + h * 256 + 8 * fq;
#pragma unroll
        for (int side = 0; side < 2; ++side) {
            bf16x8 qf[4];
#pragma unroll
            for (int ks = 0; ks < 4; ++ks) qf[ks] = *(const bf16x8*)(qrow + side * 128 + ks * 32);
            const LAS unsigned char* kb = c.lds + ((side * 128 + fr) * RK_LD + 8 * fq) * 2;
            unsigned A[16], B[16];
#pragma unroll
            for (int nt = 0; nt < 8; ++nt) {
                f32x4 acc = {0.f, 0.f, 0.f, 0.f};
#pragma unroll
                for (int ks = 0; ks < 4; ++ks) acc = __builtin_amdgcn_mfma_f32_16x16x32_bf16(*(const LAS bf16x8*)(kb + (nt * 16 * RK_LD + ks * 32) * 2), qf[ks], acc, 0, 0, 0);
#pragma unroll
                for (int r = 0; r < 4; ++r) {
                    const unsigned key = (ord_key(acc[r]) & ~127u) | (unsigned)(127 - (16 * nt + 4 * fq + r));
                    if (nt < 4) A[nt * 4 + r] = key; else B[(nt - 4) * 4 + r] = key;
                }
            }
            sort16_desc(A); sort16_desc(B);
#pragma unroll
            for (int k = 0; k < 16; ++k) A[k] = max(A[k], B[15 - k]);
            bmerge16_desc(A);
            xmerge16(A, 16, lane); xmerge16(A, 32, lane);
            if (fq == 0) {
#pragma unroll
                for (int k = 0; k < 4; ++k) *(LAS v4u*)(lists + (fr * 2 + side) * 16 + 4 * k) = (v4u){A[4 * k], A[4 * k + 1], A[4 * k + 2], A[4 * k + 3]};
            }
        }
        asm volatile("s_waitcnt lgkmcnt(0)" ::: "memory");
        int fq2 = fq, fr2 = fr; asm volatile("" : "+v"(fq2), "+v"(fr2));
        unsigned Cd[16];
#pragma unroll
        for (int k = 0; k < 13; ++k) {
            const int ij = (fq2 == 0) ? CT.v[k] : (fq2 == 1) ? CT.v[13 + k] : (fq2 == 2) ? CT.v[26 + k] : ((39 + k < 50) ? CT.v[(39 + k < 50) ? 39 + k : 0] : 0);
            const bool ok = (fq2 < 3) || (39 + k < 50);
            const unsigned k0 = lists[(fr2 * 2) * 16 + (ij >> 4)], k1 = lists[(fr2 * 2 + 1) * 16 + (ij & 15)];
            const unsigned x = (ord_key(ord_dec(k0 & ~127u) + ord_dec(k1 & ~127u)) & ~255u) | (unsigned)(255 - ij);
            Cd[k] = ok ? x : 0u;
        }
        Cd[13] = 0u; Cd[14] = 0u; Cd[15] = 0u;
        sort16_desc(Cd);
        xmerge16(Cd, 16, lane); xmerge16(Cd, 32, lane);
        float e[16], su[16]; int id[16]; float mx = 0.f, den = 0.f;
#pragma unroll
        for (int k = 0; k < 16; ++k) {
            const int pay = 255 - (int)(Cd[k] & 255u), i = pay >> 4, j = pay & 15;
            const unsigned k0 = lists[(fr2 * 2) * 16 + i], k1 = lists[(fr2 * 2 + 1) * 16 + j];
            id[k] = (127 - (int)(k0 & 127u)) * 128 + (127 - (int)(k1 & 127u));
            const float sv = ord_dec(k0 & ~127u) + ord_dec(k1 & ~127u);
            if (k == 0) mx = sv;
            e[k] = __expf(sv - mx); den += e[k];
        }
        const float inv = 1.f / den;
        int oi[4]; float og[4], ou[4];
#pragma unroll
        for (int r = 0; r < 4; ++r) {
            oi[r] = (fq2 == 0) ? id[r] : (fq2 == 1) ? id[4 + r] : (fq2 == 2) ? id[8 + r] : id[12 + r];
            og[r] = (fq2 == 0) ? e[r] : (fq2 == 1) ? e[4 + r] : (fq2 == 2) ? e[8 + r] : e[12 + r];
        }
#pragma unroll
        for (int r = 0; r < 4; ++r) { ou[r] = ISU[oi[r]]; og[r] *= inv * ISV[oi[r]]; }
        const size_t ob = (size_t)(tok0 + fr2) * 128 + h * 16 + 4 * fq2;
        *(int4*)(IDX + ob) = make_int4(oi[0], oi[1], oi[2], oi[3]);
        *(f32x4*)(GATE + ob) = (f32x4){og[0], og[1], og[2], og[3]};
        *(f32x4*)(SCU + ob) = (f32x4){ou[0], ou[1], ou[2], ou[3]};
        asm volatile("" ::: "memory");
        (void)su;
    }
}

typedef float f32x2 __attribute__((ext_vector_type(2)));
__device__ __forceinline__ void phase_gather(const Ctx& c, int layer, bool dummy) {
    const unsigned char* EU = c.ws + WS_EU; const unsigned char* EV = c.ws + WS_EV;
    const int* IDX = c.W<int>(WS_IDX); const float* GATE = c.W<float>(WS_GATE); const float* SCU = c.W<float>(WS_SCU);
    const float* H = c.W<float>(WS_H32); float* Ho = dummy ? c.W<float>(WS_R32) : c.W<float>(WS_H32); bf16* HB = dummy ? c.W<bf16>(WS_A0) : c.W<bf16>(WS_HB);
    const float* g = c.in[c.z + 40] + layer * D; const float* b = c.in[c.z + 41] + layer * D;
    const int lane = c.lane;
    const int ntw = (T - c.gw + c.NGW - 1) / c.NGW, nit = ntw * 16;
#define GT_TOK(it) (c.gw + ((it) >> 4) * c.NGW)
#define GT_IDX(it) (((it) < nit) ? IDX[(size_t)GT_TOK(it) * 128 + ((it) & 15) * 8 + (lane & 7)] : 0)
#define GT_GS(P, it) ((P)[(size_t)GT_TOK((it) < nit ? (it) : 0) * 128 + ((it) & 15) * 8 + ((lane >> 3) & 7)])
#define GT_ROW(TAB, idxreg, e) (*(const v3u*)((TAB) + (size_t)__builtin_amdgcn_readlane((idxreg), (e)) * EROW + 12 * lane))
    int idx_c = GT_IDX(0), idx_n = GT_IDX(1);
    float gate_c = GT_GS(GATE, 0), scu_c = GT_GS(SCU, 0);
    float xs[16], acc[16];
    v3u ru[8], rv[8];
#pragma unroll
    for (int e = 0; e < 8; ++e) { ru[e] = GT_ROW(EU, idx_c, e); rv[e] = GT_ROW(EV, idx_c, e); }
    for (int it = 0; it < nit; ++it) {
        const int t = GT_TOK(it), bt = it & 15;
        const int idx_nn = GT_IDX(it + 2);
        const float gate_n = GT_GS(GATE, it + 1), scu_n = GT_GS(SCU, it + 1);
        const float mygate = gate_c, myscu = scu_c;
        if (bt == 0) {
#pragma unroll
            for (int k = 0; k < 4; ++k) { const f32x4 hx = *(const f32x4*)(H + (size_t)t * D + 16 * lane + 4 * k); xs[4 * k] = hx[0]; xs[4 * k + 1] = hx[1]; xs[4 * k + 2] = hx[2]; xs[4 * k + 3] = hx[3]; }
#pragma unroll
            for (int i = 0; i < 16; ++i) acc[i] = 0.f;
        }
        float pv[8];
#pragma unroll
        for (int e = 0; e < 8; e += 2) {
            const v32f y = __builtin_amdgcn_cvt_scalef32_pk32_f32_fp6((v6u){ru[e][0], ru[e][1], ru[e][2], ru[e + 1][0], ru[e + 1][1], ru[e + 1][2]}, 1.0f);
            float d0 = 0.f, d1 = 0.f;
#pragma unroll
            for (int i = 0; i < 16; ++i) { d0 += y[i] * xs[i]; d1 += y[16 + i] * xs[i]; }
            pv[e] = d0; pv[e + 1] = d1;
            ru[e] = GT_ROW(EU, idx_n, e); ru[e + 1] = GT_ROW(EU, idx_n, e + 1);
        }
        const float tot = reduce8(pv, lane);
        const float wgt = mygate * gelu_f(tot * myscu);
#pragma unroll
        for (int e = 0; e < 8; e += 2) {
            const float w0 = __builtin_bit_cast(float, __builtin_amdgcn_readlane(__builtin_bit_cast(int, wgt), 8 * e));
            const float w1 = __builtin_bit_cast(float, __builtin_amdgcn_readlane(__builtin_bit_cast(int, wgt), 8 * e + 8));
            const v32f y = __builtin_amdgcn_cvt_scalef32_pk32_f32_fp6((v6u){rv[e][0], rv[e][1], rv[e][2], rv[e + 1][0], rv[e + 1][1], rv[e + 1][2]}, 1.0f);
#pragma unroll
            for (int i = 0; i < 16; ++i) acc[i] += y[i] * w0 + y[16 + i] * w1;
            rv[e] = GT_ROW(EV, idx_n, e); rv[e + 1] = GT_ROW(EV, idx_n, e + 1);
        }
        if (bt == 15) {
            int l2 = lane; asm volatile("" : "+v"(l2));
            f32x4 v[4];
#pragma unroll
            for (int k = 0; k < 4; ++k) v[k] = (f32x4){xs[4 * k], xs[4 * k + 1], xs[4 * k + 2], xs[4 * k + 3]} * ALPHA + (f32x4){acc[4 * k], acc[4 * k + 1], acc[4 * k + 2], acc[4 * k + 3]};
            float mean, rstd; ln_stats(v, mean, rstd, l2);
            float* o32 = ((layer == 3 && !dummy) ? c.out : Ho) + (size_t)t * D + 16 * l2;
            bf16* ob = (layer == 3 && !dummy) ? (bf16*)nullptr : HB + (size_t)t * D + 16 * l2;
            v4u wb[2];
#pragma unroll
            for (int k = 0; k < 4; ++k) {
                const f32x4 g4 = *(const f32x4*)(g + 16 * l2 + 4 * k), b4 = *(const f32x4*)(b + 16 * l2 + 4 * k);
                const f32x4 o = (v[k] - mean) * rstd * g4 + b4;
                *(f32x4*)(o32 + 4 * k) = o;
                if (k & 1) { wb[k >> 1].z = pk2(o[0], o[1]); wb[k >> 1].w = pk2(o[2], o[3]); } else { wb[k >> 1].x = pk2(o[0], o[1]); wb[k >> 1].y = pk2(o[2], o[3]); }
            }
            if (ob) { *(v4u*)(ob) = wb[0]; *(v4u*)(ob + 8) = wb[1]; }
        }
        idx_c = idx_n; idx_n = idx_nn; gate_c = gate_n; scu_c = scu_n;
    }
#undef GT_ROW
#undef GT_GS
#undef GT_IDX
#undef GT_TOK
}

#define XB_TMO      128
#define XB_XCNT(j)  (256  + 64 * (j))
#define XB_XSUB(j)  (1280 + 64 * (j))
#define XB_XGEN(j)  (2304 + 64 * (j))
#define XB_TOP      3328
#define XB_TOPGEN   3392
#define XCD_BAR_WORDS 3456
#define XB_SPIN_CAP (1u << 22)
__device__ __forceinline__ unsigned xb_ld(unsigned* p)              { return __hip_atomic_load(p, __ATOMIC_RELAXED, __HIP_MEMORY_SCOPE_AGENT); }
__device__ __forceinline__ unsigned xb_add(unsigned* p, unsigned v) { return __hip_atomic_fetch_add(p, v, __ATOMIC_RELAXED, __HIP_MEMORY_SCOPE_AGENT); }
__device__ __forceinline__ unsigned xb_xcc_id() { return (unsigned)__builtin_amdgcn_s_getreg((3 << 11) | 20) & 0xFu; }
#define XB_SPIN(cond, bar) do { unsigned _sp = 0; while (cond) { __builtin_amdgcn_s_sleep(1); \
    if ((++_sp & 255u) == 0u) { if (xb_ld(&(bar)[XB_TMO])) break; if (_sp > XB_SPIN_CAP) { atomicAdd(&(bar)[XB_TMO], 1u); break; } } } } while (0)
struct XcdBarrier { unsigned* bar; unsigned x; volatile LAS unsigned* st; };
__device__ __forceinline__ XcdBarrier xcd_barrier_post(unsigned* bar, volatile LAS unsigned* st) {
    XcdBarrier b; b.bar = bar; b.x = xb_xcc_id(); b.st = st;
    if (threadIdx.x == 0) (void)xb_add(&bar[XB_XCNT(b.x)], 1u);
    return b;
}
__device__ __forceinline__ void xcd_barrier_complete(unsigned* bar, unsigned x, unsigned& nloc, unsigned& nx) {
    const unsigned G = gridDim.x * gridDim.y * gridDim.z;
    unsigned sum, cnt, mine, sp = 0u;
    for (;;) {
        sum = 0u; cnt = 0u; mine = 0u;
#pragma unroll
        for (unsigned j = 0; j < 16; ++j) { const unsigned cc = xb_ld(&bar[XB_XCNT(j)]); sum += cc; cnt += (cc > 0u) ? 1u : 0u; mine = (j == x) ? cc : mine; }
        if (sum == G) break;
        __builtin_amdgcn_s_sleep(1);
        if ((++sp & 255u) == 0u) { if (xb_ld(&bar[XB_TMO])) break; if (sp > XB_SPIN_CAP) { atomicAdd(&bar[XB_TMO], 1u); break; } }
    }
    nloc = mine > 0u ? mine : 1u; nx = cnt > 0u ? cnt : 1u;
}
__device__ __forceinline__ void xcd_barrier(const XcdBarrier& b, int tid) {
    asm volatile("s_waitcnt vmcnt(0)" ::: "memory");
    __syncthreads();
    if (tid == 0) {
        unsigned* bar = b.bar;
        __builtin_amdgcn_s_waitcnt(0);
        unsigned nloc = b.st[0], nx = b.st[1];
        if (nloc == 0u) { xcd_barrier_complete(bar, b.x, nloc, nx); b.st[0] = nloc; b.st[1] = nx; }
        const unsigned old = xb_add(&bar[XB_XSUB(b.x)], 1u);
        const unsigned gen = old / nloc;
        if (old + 1u == (gen + 1u) * nloc) {
            __builtin_amdgcn_fence(__ATOMIC_RELEASE, "agent");
            asm volatile("s_waitcnt vmcnt(0)" ::: "memory");
            const unsigned og = xb_add(&bar[XB_TOP], 1u);
            const unsigned tg = og / nx;
            if (og + 1u == (tg + 1u) * nx) xb_add(&bar[XB_TOPGEN], 1u);
            else XB_SPIN(xb_ld(&bar[XB_TOPGEN]) == tg, bar);
            __builtin_amdgcn_fence(__ATOMIC_ACQUIRE, "agent");
            xb_add(&bar[XB_XGEN(b.x)], 1u);
            asm volatile("s_waitcnt vmcnt(0)" ::: "memory");
        } else {
            XB_SPIN(xb_ld(&bar[XB_XGEN(b.x)]) == gen, bar);
            __builtin_amdgcn_fence(__ATOMIC_ACQUIRE, "agent");
            asm volatile("s_waitcnt vmcnt(0)" ::: "memory");
        }
    }
    __syncthreads();
}

__global__ void __launch_bounds__(NTHR, 2) mega(Params P) {
    extern __shared__ __attribute__((aligned(16))) unsigned char lds_raw[];
    cg::grid_group grid = cg::this_grid();
    Ctx c;
    c.in = P.in; c.out = P.out; c.ws = P.ws; c.lds = (LAS unsigned char*)lds_raw; c.z = 0;
    c.tid = threadIdx.x; c.lane = c.tid & 63; c.wave = __builtin_amdgcn_readfirstlane(c.tid >> 6);
    c.gw = (int)blockIdx.x * NWAVES + c.wave; c.NGW = (int)gridDim.x * NWAVES; c.gt = (int)blockIdx.x * NTHR + c.tid; c.NGT = (int)gridDim.x * NTHR; c.bid = (int)blockIdx.x; c.nblk = (int)gridDim.x;
#define RF() do { int zs_ = 0; asm volatile("" : "+s"(zs_)); c.z = zs_; c.lds = (LAS unsigned char*)lds_raw + zs_; int z_ = 0; asm volatile("" : "+v"(z_)); const int l_ = (int)__builtin_amdgcn_mbcnt_hi(~0u, __builtin_amdgcn_mbcnt_lo(~0u, (unsigned)z_)); c.lane = l_; c.tid = c.wave * 64 + l_; c.bid = (int)blockIdx.x + zs_; c.nblk = (int)gridDim.x + zs_; c.gw = c.bid * NWAVES + c.wave; c.NGW = c.nblk * NWAVES; c.gt = c.bid * NTHR + c.tid; c.NGT = c.nblk * NTHR; } while (0)
    bf16* HB = c.W<bf16>(WS_HB); bf16* A0 = c.W<bf16>(WS_A0); bf16* A1 = c.W<bf16>(WS_A1); bf16* A2 = c.W<bf16>(WS_A2); bf16* Qb = c.W<bf16>(WS_Q);
    float* H32 = c.W<float>(WS_H32); float* R32 = c.W<float>(WS_R32);

    if (threadIdx.x < 16) ((volatile LAS unsigned*)(c.lds + MISC_OFF))[threadIdx.x] = 0u;
    __syncthreads();
    const XcdBarrier xbar = xcd_barrier_post(c.W<unsigned>(WS_CTL), (volatile LAS unsigned*)(c.lds + MISC_OFF));
#define GSYNC() do { RF(); xcd_barrier(xbar, c.tid); } while (0)
    RF(); prologue(c);
    grid.sync();
    for (int layer = 0; layer < 4; ++layer) {
        if (layer <= 1) {
            const bf16* Wt = c.W<bf16>(layer == 0 ? WS_W_S5IN : WS_W_PIN);
            RF(); run_gemm(c, HB, D, 0, Wt, 1024, 1024, EpiBf16<0>{A0, D, nullptr, nullptr, nullptr});
        } else if (layer == 2) {
            RF(); run_gemm(c, HB, D, 0, c.W<bf16>(WS_W_CIN), 2048, 1024, EpiBf16<1>{Qb, 2048, c.in[c.z + 24], nullptr, nullptr});
        } else {
            RF(); run_gemm(c, HB, D, 0, c.W<bf16>(WS_W_SIN), NPROJ, 1024, EpiSsdProj{Qb, c.W<bf16>(WS_XBC), c.W<float>(WS_DT)});
        }
        GSYNC();
        const bf16* Aout = A2; const bf16* Wout;
        if (layer == 0) {
            for (int r = 0; r < PR_S5; ++r) { RF(); phase_s5scan(c); }
            GSYNC();
            RF(); run_gemm(c, A1, D, 0, c.W<bf16>(WS_W_S5GLU), 1024, 1024, EpiBf16<3>{A2, D, c.in[c.z + 17], nullptr, A1});
            Wout = c.W<bf16>(WS_W_S5OUT);
        } else if (layer == 1) {
            RF(); phase_pool(c);
            GSYNC();
            RF(); run_gemm(c, A1, D, 256, c.W<bf16>(WS_W_PGRP), 1024, 256, EpiBf16<2>{A2, D, nullptr, c.in[c.z + 21], nullptr});
            Wout = c.W<bf16>(WS_W_POUT);
        } else if (layer == 2) {
            RF(); phase_cmlp_ln(c);
            GSYNC();
            RF(); phase_cmlp_mix(c);
            Aout = A1; Wout = c.W<bf16>(WS_W_COUT);
        } else {
            RF(); phase_ssd_conv(c);
            GSYNC();
            for (int r = 0; r < PR_SSD; ++r) { RF(); phase_ssd_scan(c); }
            GSYNC();
            RF(); phase_ssd_gatenorm(c);
            Aout = c.W<bf16>(WS_YN); Wout = c.W<bf16>(WS_W_SOUT);
        }
        GSYNC();
        if (layer == 3) { RF(); run_gemm(c, Aout, 2048, 0, Wout, 1024, 2048, EpiResid{H32, R32}); }
        else { RF(); run_gemm(c, Aout, 1024, 0, Wout, 1024, 1024, EpiResid{H32, R32}); }
        GSYNC();
        RF(); phase_ln1(c, layer);
        if (layer > 0) { RF(); cvt_tables(c, layer); }
        GSYNC();
        RF(); run_gemm(c, HB, D, 0, c.W<bf16>(WS_W_PQ) + (size_t)layer * 2048 * 1024, 2048, 1024, EpiBf16<0>{Qb, 2048, nullptr, nullptr, nullptr});
        GSYNC();
        for (int r = 0; r < PR_ROUTE; ++r) { RF(); phase_route(c, layer); }
        GSYNC();
        for (int r = 1; r < PR_GATHER; ++r) { RF(); phase_gather(c, layer, true); }
        RF(); phase_gather(c, layer, false);
        GSYNC();
    }
}
}

extern "C" void kernel_launch(void* const* d_in, const int* in_sizes, int n_in, void* d_out, int out_size, void* d_ws, size_t ws_size, hipStream_t stream) {
    static int grid = 0;
    if (grid == 0) {
        int dev = 0, cus = 0, per_cu = 0;
        if (hipGetDevice(&dev) != hipSuccess || hipDeviceGetAttribute(&cus, hipDeviceAttributeMultiprocessorCount, dev) != hipSuccess) { fprintf(stderr, "kernel_launch: device query failed\n"); grid = -1; return; }
        if (hipFuncSetAttribute((const void*)mk::mega, hipFuncAttributeMaxDynamicSharedMemorySize, mk::LDS_BYTES) != hipSuccess) { fprintf(stderr, "kernel_launch: hipFuncSetAttribute failed\n"); grid = -1; return; }
        if (hipOccupancyMaxActiveBlocksPerMultiprocessor(&per_cu, (const void*)mk::mega, mk::NTHR, mk::LDS_BYTES) != hipSuccess || per_cu < 1) { fprintf(stderr, "kernel_launch: occupancy query says %d blocks per CU\n", per_cu); grid = -1; return; }
        grid = cus;
        if (ws_size < mk::WS_END) { fprintf(stderr, "kernel_launch: workspace too small (%zu < %zu)\n", ws_size, (size_t)mk::WS_END); grid = -1; return; }
    }
    if (grid < 0) return;
    mk::Params p{};
    for (int i = 0; i < 46; ++i) p.in[i] = (const float*)d_in[i];
    p.out = (float*)d_out; p.ws = (unsigned char*)d_ws;
    if (hipMemsetAsync((char*)d_ws + mk::WS_CTL, 0, mk::CTL_BYTES, stream) != hipSuccess) { fprintf(stderr, "kernel_launch: memset failed\n"); return; }
    void* args[] = {&p};
    hipError_t e = hipLaunchCooperativeKernel((const void*)mk::mega, dim3(grid), dim3(mk::NTHR), args, mk::LDS_BYTES, stream);
    if (e != hipSuccess) fprintf(stderr, "cooperative launch failed: %s (grid %d)\n", hipGetErrorString(e), grid);
}
```

```cpp
#include <hip/hip_runtime.h>
#include <hip/hip_cooperative_groups.h>
#include <cstdio>
#include <cstdint>
#include <math.h>
namespace cg = cooperative_groups;

namespace pg8 {
#define PG8_LAS __attribute__((address_space(3)))
typedef unsigned short bf16_t;
typedef short bf16x8 __attribute__((ext_vector_type(8)));
typedef float f32x4 __attribute__((ext_vector_type(4)));
typedef unsigned u32x4 __attribute__((ext_vector_type(4)));
constexpr int BM = 256, BK = 64, HALF = 128, HTB = HALF * BK * 2, STAGE_BYTES = 8 * HTB, NXCD = 8, WGM = 8;
__host__ __device__ __forceinline__ int lds_byte(int r, int c) { const int st = (r >> 4) * 2 + (c >> 5), rr = r & 15, cc = c & 31, ob = rr * 64 + cc * 2; return st * 1024 + (ob ^ (((ob >> 9) & 1) << 5)); }
__host__ __device__ __forceinline__ void stage_rc(int b, int& R, int& C) { const int st = b / 1024, sb = b % 1024, swz = sb ^ (((sb >> 9) & 1) << 5); R = (st >> 1) * 16 + swz / 64; C = (st & 1) * 32 + (swz % 64) / 2; }
__host__ __device__ __forceinline__ int perm32(int rho) { const int n = rho >> 4, i = rho & 15; return 8 * (i >> 2) + 4 * n + (i & 3); }
struct Unit { int pm, pn; };
struct Gemm { const bf16_t* A; const bf16_t* Bt; int M, N, K, lda, a_pn_off; };
struct StaticOrder {
    int nM, nN, nwg, G, c;
    __host__ __device__ void init(int M, int N, int G_, int c_) { nM = M / BM; nN = N / BM; nwg = nM * nN; G = G_; c = c_; }
    __host__ __device__ bool next(int i, Unit& u) const {
        const long L = (long)i * G + c; if (L >= nwg) return false;
        int wgid = (int)L; { const int q = nwg / NXCD, r = nwg % NXCD, xcd = wgid % NXCD, off = wgid / NXCD; wgid = (xcd < r ? xcd * (q + 1) : r * (q + 1) + (xcd - r) * q) + off; }
        const int nig = WGM * nN, gid = wgid / nig, fm = gid * WGM, gsz = (nM - fm) < WGM ? (nM - fm) : WGM;
        u.pm = fm + ((wgid % nig) % gsz); u.pn = (wgid % nig) / gsz; return true;
    }
    __device__ __forceinline__ void a_ready(const Unit&) const {}
    __device__ __forceinline__ void done(const Unit&) const {}
};
__device__ __forceinline__ unsigned cvt_pk_bf16(float lo, float hi) { unsigned r; asm volatile("v_cvt_pk_bf16_f32 %0, %1, %2" : "=v"(r) : "v"(lo), "v"(hi)); return r; }
template <class Epi, class Sched, bool ALIGN_EPI = false, bool SP2 = false>
__device__ __forceinline__ void gemm_phase(PG8_LAS unsigned char* lds, const Gemm g, const Sched& S, const Epi& E, int tid_in) {
    int tid_ = tid_in; asm volatile("" : "+v"(tid_));
    const int tid = tid_, wid = __builtin_amdgcn_readfirstlane(tid >> 6), lane = tid & 63, wr = wid >> 2, wc = wid & 3, fr = lane & 15, fq = lane >> 4;
    const int K = g.K, nt = K / BK;
    unsigned voffA[2], voffB[2];
#pragma unroll
    for (int i = 0; i < 2; ++i) { int R, C; stage_rc(tid * 16 + i * 8192, R, C); const int Rb = Epi::PERM ? ((R & ~31) + perm32(R & 31)) : R;
        voffA[i] = (unsigned)(R * g.lda + C) * 2u; voffB[i] = (unsigned)(Rb * K + C) * 2u; }
    const size_t kstep = (size_t)(BK * 2);
    const size_t hstepA = (size_t)HALF * g.lda * 2, tstepA = 2 * hstepA;
    const size_t hstepB = (size_t)HALF * K * 2, tstepB = 2 * hstepB;
    const size_t apn = (size_t)g.a_pn_off * 2;
    const unsigned ldsw = (unsigned)wid * 1024u;
    const int aoff = lds_byte(wr * 64 + fr, fq * 8), boff = lds_byte(wc * 32 + fr, fq * 8);
#define PG8_SA(b, h) (((b) * 2 + (h)) * HTB)
#define PG8_SB(b, h) ((4 + (b) * 2 + (h)) * HTB)
#define PG8_STAGE(bufoff, gbase, voff) do { _Pragma("unroll") for (int _i = 0; _i < 2; ++_i) \
        __builtin_amdgcn_global_load_lds((const unsigned*)((const char*)(gbase) + (voff)[_i]), (PG8_LAS unsigned*)(lds + (bufoff) + ldsw + _i * 8192), 16, 0, 0); } while (0)
#define PG8_LDA(dst, b, h) do { _Pragma("unroll") for (int m = 0; m < 4; ++m) _Pragma("unroll") for (int k = 0; k < 2; ++k) dst[m][k] = *(const PG8_LAS bf16x8*)(lds + PG8_SA(b, h) + aoff + m * 2048 + k * 1024); } while (0)
#define PG8_LDB(dst, b, h) do { _Pragma("unroll") for (int n = 0; n < 2; ++n) _Pragma("unroll") for (int k = 0; k < 2; ++k) dst[n][k] = *(const PG8_LAS bf16x8*)(lds + PG8_SB(b, h) + boff + n * 2048 + k * 1024); } while (0)
#define PG8_MMA(ai, bj, At, Bt) do { __builtin_amdgcn_s_setprio(1); _Pragma("unroll") for (int m = 0; m < 4; ++m) _Pragma("unroll") for (int n = 0; n < 2; ++n) _Pragma("unroll") for (int k = 0; k < 2; ++k) \
        acc[ai][bj][m][n] = __builtin_amdgcn_mfma_f32_16x16x32_bf16(Bt[n][k], At[m][k], acc[ai][bj][m][n], 0, 0, 0); __builtin_amdgcn_s_setprio(0); } while (0)
#define PG8_WAIT_V(n) asm volatile("s_waitcnt vmcnt(" #n ")" ::: "memory")
#define PG8_WAIT_L(n) asm volatile("s_waitcnt lgkmcnt(" #n ")" ::: "memory")
#define PG8_BAR __builtin_amdgcn_s_barrier()
#define PG8_SCHED __builtin_amdgcn_sched_barrier(0)
    Unit cur, nxt; int ui = 0;
    if (!S.next(0, cur)) return;
    f32x4 acc[2][2][4][2];
#pragma unroll
    for (int a = 0; a < 2; ++a)
#pragma unroll
        for (int b = 0; b < 2; ++b)
#pragma unroll
            for (int m = 0; m < 4; ++m)
#pragma unroll
                for (int n = 0; n < 2; ++n) acc[a][b][m][n] = (f32x4){0.f, 0.f, 0.f, 0.f};
    bf16x8 At[4][2], B0[2][2], B1[2][2];
    const char* cA = (const char*)g.A + (size_t)cur.pm * tstepA + (size_t)cur.pn * apn; const char* cB = (const char*)g.Bt + (size_t)cur.pn * tstepB;
    S.a_ready(cur);
    if constexpr (SP2) {
        PG8_STAGE(PG8_SB(0, 0), cB, voffB); PG8_STAGE(PG8_SB(0, 1), cB + hstepB, voffB); PG8_STAGE(PG8_SA(0, 0), cA, voffA); PG8_STAGE(PG8_SA(0, 1), cA + hstepA, voffA);
        if (wr == 1) PG8_BAR;
        PG8_WAIT_V(2); PG8_BAR;
        PG8_STAGE(PG8_SB(1, 0), cB + kstep, voffB); PG8_STAGE(PG8_SA(1, 0), cA + kstep, voffA); PG8_STAGE(PG8_SB(1, 1), cB + hstepB + kstep, voffB);
        PG8_WAIT_V(6); PG8_BAR;
    } else {
        PG8_STAGE(PG8_SB(0, 0), cB, voffB); PG8_STAGE(PG8_SA(0, 0), cA, voffA); PG8_STAGE(PG8_SB(0, 1), cB + hstepB, voffB); PG8_STAGE(PG8_SA(0, 1), cA + hstepA, voffA);
        if (wr == 1) PG8_BAR;
        PG8_WAIT_V(4); PG8_BAR;
        PG8_STAGE(PG8_SB(1, 0), cB + kstep, voffB); PG8_STAGE(PG8_SA(1, 0), cA + kstep, voffA); PG8_STAGE(PG8_SB(1, 1), cB + hstepB + kstep, voffB);
        PG8_WAIT_V(6); PG8_BAR;
    }
    for (;;) {
        const bool has_next = S.next(ui + 1, nxt);
        const char* nA = has_next ? (const char*)g.A + (size_t)nxt.pm * tstepA + (size_t)nxt.pn * apn : cA; const char* nB = has_next ? (const char*)g.Bt + (size_t)nxt.pn * tstepB : cB;
#pragma nounroll
        for (int t = 0; t < nt; t += 2) {
            const bool last = (t == nt - 2);
            const char* a1 = cA + (size_t)(t + 1) * kstep;
            const char* a2 = last ? nA : cA + (size_t)(t + 2) * kstep; const char* b2 = last ? nB : cB + (size_t)(t + 2) * kstep;
            const char* a3 = a2 + kstep; const char* b3 = b2 + kstep;
            if (last && has_next) S.a_ready(nxt);
            if constexpr (SP2) {
            PG8_LDB(B0, 0, 0); PG8_LDB(B1, 0, 1); PG8_SCHED; PG8_LDA(At, 0, 0); PG8_STAGE(PG8_SA(1, 1), a1 + hstepA, voffA);
            PG8_WAIT_V(8); PG8_WAIT_L(0); PG8_BAR; PG8_MMA(0, 0, At, B0); PG8_MMA(0, 1, At, B1); PG8_BAR; PG8_SCHED;
            PG8_LDA(At, 0, 1); PG8_STAGE(PG8_SB(0, 0), b2, voffB); PG8_STAGE(PG8_SB(0, 1), b2 + hstepB, voffB); PG8_STAGE(PG8_SA(0, 0), a2, voffA);
            PG8_WAIT_V(8); PG8_WAIT_L(0); PG8_BAR; PG8_MMA(1, 0, At, B0); PG8_MMA(1, 1, At, B1); PG8_BAR; PG8_SCHED;
            PG8_LDB(B0, 1, 0); PG8_LDB(B1, 1, 1); PG8_SCHED; PG8_LDA(At, 1, 0); PG8_STAGE(PG8_SA(0, 1), a2 + hstepA, voffA);
            PG8_WAIT_V(8); PG8_WAIT_L(0); PG8_BAR; PG8_MMA(0, 0, At, B0); PG8_MMA(0, 1, At, B1); PG8_BAR; PG8_SCHED;
            PG8_LDA(At, 1, 1); PG8_STAGE(PG8_SB(1, 0), b3, voffB); PG8_STAGE(PG8_SB(1, 1), b3 + hstepB, voffB); PG8_STAGE(PG8_SA(1, 0), a3, voffA);
            PG8_WAIT_V(8); PG8_WAIT_L(0); PG8_BAR; PG8_MMA(1, 0, At, B0); PG8_MMA(1, 1, At, B1); PG8_BAR; PG8_SCHED;
            } else {
            PG8_LDB(B0, 0, 0); PG8_SCHED; PG8_LDA(At, 0, 0); PG8_STAGE(PG8_SA(1, 1), a1 + hstepA, voffA);
            PG8_WAIT_L(8); PG8_BAR; PG8_WAIT_L(0); PG8_MMA(0, 0, At, B0); PG8_BAR; PG8_SCHED;
            PG8_LDB(B1, 0, 1); PG8_STAGE(PG8_SB(0, 0), b2, voffB);
            PG8_BAR; PG8_WAIT_L(0); PG8_MMA(0, 1, At, B1); PG8_BAR;
            PG8_LDA(At, 0, 1); PG8_STAGE(PG8_SA(0, 0), a2, voffA);
            PG8_BAR; PG8_WAIT_L(0); PG8_MMA(1, 0, At, B0); PG8_BAR; PG8_SCHED;
            PG8_STAGE(PG8_SB(0, 1), b2 + hstepB, voffB);
            PG8_WAIT_V(6); PG8_BAR; PG8_MMA(1, 1, At, B1); PG8_BAR;
            PG8_LDB(B0, 1, 0); PG8_SCHED; PG8_LDA(At, 1, 0); PG8_STAGE(PG8_SA(0, 1), a2 + hstepA, voffA);
            PG8_WAIT_L(8); PG8_BAR; PG8_WAIT_L(0); PG8_MMA(0, 0, At, B0); PG8_BAR; PG8_SCHED;
            PG8_LDB(B1, 1, 1); PG8_STAGE(PG8_SB(1, 0), b3, voffB);
            PG8_BAR; PG8_WAIT_L(0); PG8_MMA(0, 1, At, B1); PG8_BAR;
            PG8_LDA(At, 1, 1); PG8_STAGE(PG8_SA(1, 0), a3, voffA);
            PG8_BAR; PG8_WAIT_L(0); PG8_MMA(1, 0, At, B0); PG8_BAR; PG8_SCHED;
            PG8_STAGE(PG8_SB(1, 1), b3 + hstepB, voffB);
            PG8_WAIT_V(6); PG8_BAR; PG8_MMA(1, 1, At, B1); PG8_BAR;
            }
        }
        if constexpr (ALIGN_EPI) { if (wr == 0) PG8_BAR; }
        if constexpr (!Epi::AFTER_DRAIN) { E(acc, cur, wr, wc, fr, fq); S.done(cur); }
        if (!has_next) break;
#pragma unroll
        for (int a = 0; a < 2; ++a)
#pragma unroll
            for (int b = 0; b < 2; ++b)
#pragma unroll
                for (int m = 0; m < 4; ++m)
#pragma unroll
                    for (int n = 0; n < 2; ++n) acc[a][b][m][n] = (f32x4){0.f, 0.f, 0.f, 0.f};
        cur = nxt; cA = nA; cB = nB; ++ui;
        if constexpr (ALIGN_EPI) { if (wr == 1) PG8_BAR; }
    }
    PG8_WAIT_V(0);
    if constexpr (!ALIGN_EPI) { if (wr == 0) PG8_BAR; }
    PG8_BAR;
    if constexpr (Epi::AFTER_DRAIN) { E.fused(acc, cur, wr, wc, fr, fq, lds, wid, lane); S.done(cur); }
#undef PG8_SA
#undef PG8_SB
#undef PG8_STAGE
#undef PG8_LDA
#undef PG8_LDB
#undef PG8_MMA
#undef PG8_WAIT_V
#undef PG8_WAIT_L
#undef PG8_BAR
#undef PG8_SCHED
}
}

#ifndef PR_GATHER
#define PR_GATHER 1
#endif
#ifndef PR_ROUTE
#define PR_ROUTE 1
#endif
#ifndef PR_S5
#define PR_S5 1
#endif
#ifndef PR_SSD
#define PR_SSD 1
#endif
#ifndef PR_GEMM
#define PR_GEMM 1
#endif
#ifndef PR_MISC
#define PR_MISC 1
#endif
namespace mk {
#define LAS __attribute__((address_space(3)))
typedef unsigned short bf16;
typedef unsigned v4u __attribute__((ext_vector_type(4)));
typedef unsigned v2u __attribute__((ext_vector_type(2)));
typedef float f32x4 __attribute__((ext_vector_type(4)));
typedef short bf16x8 __attribute__((ext_vector_type(8)));
using bf16x2 = __attribute__((ext_vector_type(2))) __bf16;

constexpr int D = 1024, T = 17408, TP = 16384, NWAVES = 8, NTHR = 512;
constexpr float ALPHA = 1.6817928305074290f;
constexpr float LN_EPS = 1e-5f, RMS_EPS = 1e-5f;
constexpr int LDS_BYTES = 160 * 1024;
constexpr int NPROJ = 5376, CONVD = 3072;

constexpr size_t MiB = 1u << 20;
constexpr size_t WS_W_S5IN = 0, WS_W_S5GLU = 2 * MiB, WS_W_S5OUT = 4 * MiB, WS_W_PIN = 6 * MiB, WS_W_PGRP = 8 * MiB, WS_W_POUT = 9 * MiB,
                 WS_W_CIN = 11 * MiB, WS_W_COUT = 15 * MiB, WS_W_SIN = 17 * MiB  , WS_W_SOUT = 28 * MiB, WS_W_PQ = 32 * MiB  ,
                 WS_KEYS = 48 * MiB  , WS_SMALL = 50 * MiB, WS_CTL = 52 * MiB  ;
constexpr size_t CTL_BYTES = 16384;
constexpr int MISC_OFF = LDS_BYTES - 64;
constexpr size_t WS_EU = 64 * MiB, WS_EV = 96 * MiB;
constexpr size_t WS_H32 = 128 * MiB, WS_R32 = 196 * MiB, WS_HB = 264 * MiB, WS_A0 = 298 * MiB, WS_A1 = 332 * MiB, WS_A2 = 366 * MiB;
constexpr size_t WS_Q = 400 * MiB  , WS_IDX = 468 * MiB  , WS_GATE = 477 * MiB  , WS_DT = 486 * MiB  ;
constexpr size_t WS_XBC = 490 * MiB  , WS_XC = 592 * MiB  , WS_Y = 694 * MiB  , WS_YN = 762 * MiB  , WS_SCU = 830 * MiB  , WS_END = 839 * MiB;
constexpr size_t SM_LBR = 0, SM_LBI = 4096, SM_BBR = 8192, SM_BBI = 8192 + 65536, SM_ISU = 8192 + 131072, SM_ISV = SM_ISU + 16384;

struct Params { const float* in[46]; float* out; unsigned char* ws; };

__device__ __forceinline__ unsigned f2bf(float f) { unsigned u = __builtin_bit_cast(unsigned, f); return (u + 0x7fffu + ((u >> 16) & 1u)) >> 16; }
__device__ __forceinline__ unsigned pk2(float lo, float hi) { return pg8::cvt_pk_bf16(lo, hi); }
__device__ __forceinline__ float bflo(unsigned w) { return __builtin_bit_cast(float, w << 16); }
__device__ __forceinline__ float bfhi(unsigned w) { return __builtin_bit_cast(float, w & 0xffff0000u); }
__device__ __forceinline__ float bf2f(bf16 b) { return __builtin_bit_cast(float, ((unsigned)b) << 16); }
__device__ __forceinline__ float sigmoid_f(float x) { return 1.f / (1.f + __expf(-x)); }
__device__ __forceinline__ float silu_f(float x) { return x * sigmoid_f(x); }
__device__ __forceinline__ float gelu_f(float x) { return x * sigmoid_f(1.5957691216057308f * (x + 0.044715f * x * x * x)); }
template <int O> __device__ __forceinline__ float shx_c(float v, int lane) {
    if constexpr (O < 32) return __builtin_bit_cast(float, __builtin_amdgcn_ds_swizzle(__builtin_bit_cast(int, v), (O << 10) | 0x1f));
    else return __builtin_bit_cast(float, __builtin_amdgcn_ds_bpermute((lane ^ O) << 2, __builtin_bit_cast(int, v)));
}
__device__ __forceinline__ float shx(float v, int o, int lane) {
    switch (o) { case 1: return shx_c<1>(v, lane); case 2: return shx_c<2>(v, lane); case 4: return shx_c<4>(v, lane); case 8: return shx_c<8>(v, lane); case 16: return shx_c<16>(v, lane); default: return shx_c<32>(v, lane); }
}
__device__ __forceinline__ float wave_sum(float v, int lane) {
#pragma unroll
    for (int o = 32; o >= 1; o >>= 1) v += shx(v, o, lane);
    return v;
}
__device__ __forceinline__ float dot2(unsigned w, unsigned x, float acc) { return __builtin_amdgcn_fdot2_f32_bf16(__builtin_bit_cast(bf16x2, w), __builtin_bit_cast(bf16x2, x), acc, false); }
__device__ __forceinline__ float reduce16(const float (&p)[16], int lane) {
    const bool b5 = lane & 32, b4 = lane & 16, b3 = lane & 8, b2 = lane & 4;
    float q[8], r[4], s[2], t;
#pragma unroll
    for (int i = 0; i < 8; ++i) { const float keep = b5 ? p[i + 8] : p[i], send = b5 ? p[i] : p[i + 8]; q[i] = keep + shx(send, 32, lane); }
#pragma unroll
    for (int i = 0; i < 4; ++i) { const float keep = b4 ? q[i + 4] : q[i], send = b4 ? q[i] : q[i + 4]; r[i] = keep + shx(send, 16, lane); }
#pragma unroll
    for (int i = 0; i < 2; ++i) { const float keep = b3 ? r[i + 2] : r[i], send = b3 ? r[i] : r[i + 2]; s[i] = keep + shx(send, 8, lane); }
    { const float keep = b2 ? s[1] : s[0], send = b2 ? s[0] : s[1]; t = keep + shx(send, 4, lane); }
    t += shx(t, 2, lane); t += shx(t, 1, lane);
    return t;
}
__device__ __forceinline__ float reduce8(const float (&p)[8], int lane) {
    const bool b5 = lane & 32, b4 = lane & 16, b3 = lane & 8;
    float q[4], r[2], t;
#pragma unroll
    for (int i = 0; i < 4; ++i) { const float keep = b5 ? p[i + 4] : p[i], send = b5 ? p[i] : p[i + 4]; q[i] = keep + shx(send, 32, lane); }
#pragma unroll
    for (int i = 0; i < 2; ++i) { const float keep = b4 ? q[i + 2] : q[i], send = b4 ? q[i] : q[i + 2]; r[i] = keep + shx(send, 16, lane); }
    { const float keep = b3 ? r[1] : r[0], send = b3 ? r[0] : r[1]; t = keep + shx(send, 8, lane); }
    t += shx(t, 4, lane); t += shx(t, 2, lane); t += shx(t, 1, lane);
    return t;
}
__device__ __forceinline__ void seq_info(int s, int& tok0, int& L) { if (s < 8) { tok0 = s << 11; L = 2048; } else { tok0 = TP + ((s - 8) << 3); L = 8; } }
__device__ __forceinline__ void tok_info(int t, int& s, int& l, int& tok0) {
    if (t < TP) { s = t >> 11; l = t & 2047; tok0 = s << 11; } else { const int b = (t - TP) >> 3; s = 8 + b; l = (t - TP) & 7; tok0 = TP + (b << 3); }
}

template <int MODE> struct EpiBf16 {
    static constexpr bool PERM = true, AFTER_DRAIN = false;
    bf16* O; int ldc; const float* bias; const float* scale; const bf16* G;
    __device__ __forceinline__ void operator()(const pg8::f32x4 (&acc)[2][2][4][2], const pg8::Unit& u, int wr, int wc, int fr_, int fq_) const {
        int fr = fr_, fq = fq_; asm volatile("" : "+v"(fr), "+v"(fq));
        const int row0 = u.pm * 256 + wr * 64 + fr, col0 = u.pn * 256 + wc * 32 + 8 * fq;
        f32x4 bv[2][2], sv[2][2];
#pragma unroll
        for (int bj = 0; bj < 2; ++bj)
#pragma unroll
            for (int n = 0; n < 2; ++n) {
                bv[bj][n] = bias ? *(const f32x4*)(bias + col0 + bj * 128 + 4 * n) : (f32x4){0.f, 0.f, 0.f, 0.f};
                sv[bj][n] = (MODE == 2) ? *(const f32x4*)(scale + col0 + bj * 128 + 4 * n) : (f32x4){1.f, 1.f, 1.f, 1.f};
            }
#pragma unroll
        for (int ai = 0; ai < 2; ++ai)
#pragma unroll
            for (int m = 0; m < 4; ++m) {
                const size_t roff = (size_t)(row0 + ai * 128 + m * 16) * ldc + col0;
#pragma unroll
                for (int bj = 0; bj < 2; ++bj) {
                    f32x4 v0 = acc[ai][bj][m][0] + bv[bj][0], v1 = acc[ai][bj][m][1] + bv[bj][1];
                    if (MODE == 1) {
#pragma unroll
                        for (int j = 0; j < 4; ++j) { v0[j] = gelu_f(v0[j]); v1[j] = gelu_f(v1[j]); }
                    }
                    if (MODE == 2) { v0 = v0 * sv[bj][0]; v1 = v1 * sv[bj][1]; }
                    if (MODE == 3) {
                        const v4u gw = *(const v4u*)(G + roff + bj * 128);
                        v0[0] = bflo(gw.x) * sigmoid_f(v0[0]); v0[1] = bfhi(gw.x) * sigmoid_f(v0[1]); v0[2] = bflo(gw.y) * sigmoid_f(v0[2]); v0[3] = bfhi(gw.y) * sigmoid_f(v0[3]);
                        v1[0] = bflo(gw.z) * sigmoid_f(v1[0]); v1[1] = bfhi(gw.z) * sigmoid_f(v1[1]); v1[2] = bflo(gw.w) * sigmoid_f(v1[2]); v1[3] = bfhi(gw.w) * sigmoid_f(v1[3]);
                    }
                    v4u w; w.x = pk2(v0[0], v0[1]); w.y = pk2(v0[2], v0[3]); w.z = pk2(v1[0], v1[1]); w.w = pk2(v1[2], v1[3]);
                    *(v4u*)(O + roff + bj * 128) = w;
                }
            }
    }
};
struct EpiResid {
    static constexpr bool PERM = false, AFTER_DRAIN = false;
    const float* H; float* R;
    __device__ __forceinline__ void operator()(const pg8::f32x4 (&acc)[2][2][4][2], const pg8::Unit& u, int wr, int wc, int fr_, int fq_) const {
        int fr = fr_, fq = fq_; asm volatile("" : "+v"(fr), "+v"(fq));
        const int row0 = u.pm * 256 + wr * 64 + fr, col0 = u.pn * 256 + wc * 32 + 4 * fq;
#pragma unroll
        for (int ai = 0; ai < 2; ++ai)
#pragma unroll
            for (int m = 0; m < 4; ++m) {
                const size_t roff = (size_t)(row0 + ai * 128 + m * 16) * D + col0;
#pragma unroll
                for (int bj = 0; bj < 2; ++bj)
#pragma unroll
                    for (int n = 0; n < 2; ++n) {
                        const f32x4 hv = *(const f32x4*)(H + roff + bj * 128 + n * 16);
                        *(f32x4*)(R + roff + bj * 128 + n * 16) = hv * ALPHA + acc[ai][bj][m][n];
                    }
            }
    }
};
struct EpiSsdProj {
    static constexpr bool PERM = true, AFTER_DRAIN = false;
    bf16* Z; bf16* XBC; float* DT;
    __device__ __forceinline__ void operator()(const pg8::f32x4 (&acc)[2][2][4][2], const pg8::Unit& u, int wr, int wc, int fr_, int fq_) const {
        int fr = fr_, fq = fq_; asm volatile("" : "+v"(fr), "+v"(fq));
        const int row0 = u.pm * 256 + wr * 64 + fr, col0 = u.pn * 256 + wc * 32 + 8 * fq;
#pragma unroll
        for (int ai = 0; ai < 2; ++ai)
#pragma unroll
            for (int m = 0; m < 4; ++m) {
                const size_t row = (size_t)(row0 + ai * 128 + m * 16);
#pragma unroll
                for (int bj = 0; bj < 2; ++bj) {
                    const f32x4 v0 = acc[ai][bj][m][0], v1 = acc[ai][bj][m][1];
                    const int col = col0 + bj * 128;
                    if (u.pn < 20) {
                        v4u w; w.x = pk2(v0[0], v0[1]); w.y = pk2(v0[2], v0[3]); w.z = pk2(v1[0], v1[1]); w.w = pk2(v1[2], v1[3]);
                        if (u.pn < 8) *(v4u*)(Z + row * 2048 + col) = w; else *(v4u*)(XBC + row * CONVD + (col - 2048)) = w;
                    } else if (col - 5120 < 32) {
                        *(f32x4*)(DT + row * 32 + (col - 5120)) = v0; *(f32x4*)(DT + row * 32 + (col - 5120) + 4) = v1;
                    }
                }
            }
    }
};

struct Ctx {
    const float* const* in; float* out; unsigned char* ws; LAS unsigned char* lds;
    int tid, lane, wave, gw, NGW, gt, NGT, bid, nblk;
    int z;
    template <class Tp> __device__ __forceinline__ Tp* W(size_t off) const { return (Tp*)(ws + (off + (size_t)(unsigned)z)); }
};

template <class Epi> __device__ __forceinline__ void run_gemm(const Ctx& c, const bf16* A, int lda, int a_pn_off, const bf16* Bt, int N, int K, const Epi& E) {
    pg8::Gemm g{A, Bt, T, N, K, lda, a_pn_off};
    pg8::StaticOrder S; S.init(T, N, c.nblk, c.bid);
    for (int r = 0; r < PR_GEMM; ++r) pg8::gemm_phase<Epi, pg8::StaticOrder, true, true>(c.lds, g, S, E, c.tid);
}

__device__ __forceinline__ void transpose_item(const float* __restrict__ Wm, int K, int N, bf16* WT, LAS float* scr, int item, int lane) {
    const int nblk = N / 32, kb = item / nblk, nb = item % nblk, k0 = 64 * kb, n0 = 32 * nb;
#pragma unroll 8
    for (int i = 0; i < 32; ++i) { const int kk = 2 * i + (lane >> 5); scr[kk * 33 + (lane & 31)] = Wm[(size_t)(k0 + kk) * N + n0 + (lane & 31)]; }
    asm volatile("s_waitcnt lgkmcnt(0)" ::: "memory");
    const int cc = lane & 7;
#pragma unroll
    for (int j = 0; j < 4; ++j) {
        const int n = (lane >> 3) + 8 * j; const LAS float* s = scr + (8 * cc) * 33 + n;
        v4u o; o.x = pk2(s[0 * 33], s[1 * 33]); o.y = pk2(s[2 * 33], s[3 * 33]); o.z = pk2(s[4 * 33], s[5 * 33]); o.w = pk2(s[6 * 33], s[7 * 33]);
        *(v4u*)(WT + (size_t)(n0 + n) * K + k0 + 8 * cc) = o;
    }
    asm volatile("s_waitcnt lgkmcnt(0)" ::: "memory");
}
__device__ __forceinline__ void transpose_mat(const Ctx& c, const float* Wm, int K, int N, bf16* WT) {
    LAS float* scr = (LAS float*)(c.lds + c.wave * 16384);
    const int nitems = (K / 64) * (N / 32);
    for (int it = c.gw; it < nitems; it += c.NGW) transpose_item(Wm, K, N, WT, scr, it, c.lane);
}
__device__ __forceinline__ void cvt_copy(const Ctx& c, const float* __restrict__ src, bf16* dst, size_t n) {
    for (size_t i = (size_t)c.gt * 8; i < n; i += (size_t)c.NGT * 8) {
        const f32x4 a = *(const f32x4*)(src + i), b = *(const f32x4*)(src + i + 4);
        v4u w; w.x = pk2(a[0], a[1]); w.y = pk2(a[2], a[3]); w.z = pk2(b[0], b[1]); w.w = pk2(b[2], b[3]);
        *(v4u*)(dst + i) = w;
    }
}
__device__ __forceinline__ float wave_max(float v, int lane) {
#pragma unroll
    for (int o = 32; o >= 1; o >>= 1) v = fmaxf(v, shx(v, o, lane));
    return v;
}
typedef float v16f __attribute__((ext_vector_type(16)));
typedef float v32f __attribute__((ext_vector_type(32)));
typedef unsigned v6u __attribute__((ext_vector_type(6)));
constexpr int EROW = 768;
#ifndef FP6_PACK_INTERLEAVED
#define FP6_PACK_INTERLEAVED 1
#endif
typedef unsigned v3u __attribute__((ext_vector_type(3)));
__device__ __forceinline__ void cvt_tables(const Ctx& c, int layer) {
    float* sm = c.W<float>(WS_SMALL);
    const int lane = c.lane;
    for (int rp = c.gw; rp < 16384; rp += c.NGW) {
        const int r0 = 2 * rp, tb = r0 >> 14, row = r0 & 16383;
        const float* src = c.in[c.z + 44 + tb] + ((size_t)layer * 16384 + row) * D + 16 * lane;
        f32x4 va[4], vb[4];
#pragma unroll
        for (int k = 0; k < 4; ++k) { va[k] = *(const f32x4*)(src + 4 * k); vb[k] = *(const f32x4*)(src + D + 4 * k); }
        float ma = 0.f, mb = 0.f;
#pragma unroll
        for (int k = 0; k < 4; ++k) {
            ma = fmaxf(fmaxf(fmaxf(fabsf(va[k][0]), fabsf(va[k][1])), fmaxf(fabsf(va[k][2]), fabsf(va[k][3]))), ma);
            mb = fmaxf(fmaxf(fmaxf(fabsf(vb[k][0]), fabsf(vb[k][1])), fmaxf(fabsf(vb[k][2]), fabsf(vb[k][3]))), mb);
        }
        ma = fmaxf(wave_max(ma, lane), 1e-30f); mb = fmaxf(wave_max(mb, lane), 1e-30f);
        const float sa = __builtin_bit_cast(float, __builtin_bit_cast(unsigned, 7.5f / ma) & 0xff800000u);
        const float sb = __builtin_bit_cast(float, __builtin_bit_cast(unsigned, 7.5f / mb) & 0xff800000u);
        float F[32];
#pragma unroll
        for (int k = 0; k < 4; ++k) {
#pragma unroll
            for (int j = 0; j < 4; ++j) { F[4 * k + j] = va[k][j] * sa; F[16 + 4 * k + j] = vb[k][j] * sb; }
        }
        v16f a, b;
#pragma unroll
        for (int i = 0; i < 16; ++i) { a[i] = FP6_PACK_INTERLEAVED ? F[2 * i] : F[i]; b[i] = FP6_PACK_INTERLEAVED ? F[2 * i + 1] : F[16 + i]; }
        const v6u pk = __builtin_amdgcn_cvt_scalef32_2xpk16_fp6_f32(a, b, 1.0f);
        unsigned char* dst = c.ws + (tb ? WS_EV : WS_EU) + (size_t)row * EROW + 12 * lane;
        *(v3u*)(dst) = (v3u){pk[0], pk[1], pk[2]};
        *(v3u*)(dst + EROW) = (v3u){pk[3], pk[4], pk[5]};
        if (lane == 0) { sm[(tb ? SM_ISV : SM_ISU) + row] = 1.0f / sa; sm[(tb ? SM_ISV : SM_ISU) + row + 1] = 1.0f / sb; }
    }
}
__device__ __forceinline__ void prologue(const Ctx& c) {
    transpose_mat(c, c.in[c.z + 7], 1024, 1024, c.W<bf16>(WS_W_S5IN));
    transpose_mat(c, c.in[c.z + 16], 1024, 1024, c.W<bf16>(WS_W_S5GLU));
    transpose_mat(c, c.in[c.z + 18], 1024, 1024, c.W<bf16>(WS_W_S5OUT));
    transpose_mat(c, c.in[c.z + 19], 1024, 1024, c.W<bf16>(WS_W_PIN));
    for (int g = 0; g < 4; ++g) transpose_mat(c, c.in[c.z + 20] + (size_t)g * 65536, 256, 256, c.W<bf16>(WS_W_PGRP) + (size_t)g * 65536);
    transpose_mat(c, c.in[c.z + 22], 1024, 1024, c.W<bf16>(WS_W_POUT));
    transpose_mat(c, c.in[c.z + 23], 1024, 2048, c.W<bf16>(WS_W_CIN));
    transpose_mat(c, c.in[c.z + 29], 1024, 1024, c.W<bf16>(WS_W_COUT));
    transpose_mat(c, c.in[c.z + 30], 1024, 5152, c.W<bf16>(WS_W_SIN));
    transpose_mat(c, c.in[c.z + 37], 2048, 1024, c.W<bf16>(WS_W_SOUT));
    for (int l = 0; l < 4; ++l) transpose_mat(c, c.in[c.z + 42] + (size_t)l * 1024 * 2048, 1024, 2048, c.W<bf16>(WS_W_PQ) + (size_t)l * 2048 * 1024);
    {
        v4u* z = (v4u*)(c.W<bf16>(WS_W_SIN) + (size_t)5152 * 1024);
        for (int i = c.gt; i < 224 * 1024 / 8; i += c.NGT) z[i] = (v4u){0u, 0u, 0u, 0u};
    }
    cvt_copy(c, c.in[c.z + 43], c.W<bf16>(WS_KEYS), (size_t)4 * 8 * 2 * 128 * 128);
    {
        float* H = c.W<float>(WS_H32); bf16* HB = c.W<bf16>(WS_HB);
        for (size_t i = (size_t)c.gt * 8; i < (size_t)T * D; i += (size_t)c.NGT * 8) {
            const float* src = (i < (size_t)TP * D) ? (c.in[c.z + 0] + i) : (c.in[c.z + 1] + (i - (size_t)TP * D));
            const f32x4 a = *(const f32x4*)(src), b = *(const f32x4*)(src + 4);
            *(f32x4*)(H + i) = a; *(f32x4*)(H + i + 4) = b;
            v4u w; w.x = pk2(a[0], a[1]); w.y = pk2(a[2], a[3]); w.z = pk2(b[0], b[1]); w.w = pk2(b[2], b[3]);
            *(v4u*)(HB + i) = w;
        }
    }
    if (c.gt < 4096) {
        const int gp = c.gt, g = gp >> 6;
        float* sm = c.W<float>(WS_SMALL);
        const float dt = expf(c.in[c.z + 10][g]);
        const float lr = c.in[c.z + 8][gp], li = c.in[c.z + 9][gp];
        const float mag = expf(lr * dt);
        const float br = mag * cosf(li * dt), bi = mag * sinf(li * dt);
        const float den = lr * lr + li * li;
        const float fr = ((br - 1.f) * lr + bi * li) / den, fi = (bi * lr - (br - 1.f) * li) / den;
        sm[SM_LBR + gp] = br; sm[SM_LBI + gp] = bi;
        for (int i = 0; i < 16; ++i) {
            const float xr = c.in[c.z + 11][gp * 16 + i], xi = c.in[c.z + 12][gp * 16 + i];
            sm[SM_BBR + gp * 16 + i] = fr * xr - fi * xi; sm[SM_BBI + gp * 16 + i] = fr * xi + fi * xr;
        }
    }
    cvt_tables(c, 0);
}

__device__ __forceinline__ void ln_row_store(const f32x4 (&v)[4], float mean, float rstd, const float* __restrict__ g, const float* __restrict__ b, float* o32, bf16* ob, int lane) {
#pragma unroll
    for (int h = 0; h < 2; ++h) {
        const int c0 = h * 512 + 8 * lane;
        const f32x4 g0 = *(const f32x4*)(g + c0), g1 = *(const f32x4*)(g + c0 + 4), b0 = *(const f32x4*)(b + c0), b1 = *(const f32x4*)(b + c0 + 4);
        const f32x4 o0 = (v[2 * h] - mean) * rstd * g0 + b0, o1 = (v[2 * h + 1] - mean) * rstd * g1 + b1;
        *(f32x4*)(o32 + c0) = o0; *(f32x4*)(o32 + c0 + 4) = o1;
        if (ob) { v4u w; w.x = pk2(o0[0], o0[1]); w.y = pk2(o0[2], o0[3]); w.z = pk2(o1[0], o1[1]); w.w = pk2(o1[2], o1[3]); *(v4u*)(ob + c0) = w; }
    }
}
__device__ __forceinline__ void ln_stats(const f32x4 (&v)[4], float& mean, float& rstd, int lane) {
    float s = 0.f;
#pragma unroll
    for (int k = 0; k < 4; ++k) s += (v[k][0] + v[k][1]) + (v[k][2] + v[k][3]);
    mean = wave_sum(s, lane) * (1.f / D);
    float q = 0.f;
#pragma unroll
    for (int k = 0; k < 4; ++k) { const f32x4 d = v[k] - mean; q += (d[0] * d[0] + d[1] * d[1]) + (d[2] * d[2] + d[3] * d[3]); }
    rstd = rsqrtf(wave_sum(q, lane) * (1.f / D) + LN_EPS);
}
__device__ __forceinline__ void phase_ln1(const Ctx& c, int layer) {
    const float* R = c.W<float>(WS_R32); float* H = c.W<float>(WS_H32); bf16* HB = c.W<bf16>(WS_HB);
    const float* g = c.in[c.z + 38] + layer * D; const float* b = c.in[c.z + 39] + layer * D;
    for (int t = c.gw; t < T; t += c.NGW) {
        f32x4 v[4];
#pragma unroll
        for (int h = 0; h < 2; ++h) { v[2 * h] = *(const f32x4*)(R + (size_t)t * D + h * 512 + 8 * c.lane); v[2 * h + 1] = *(const f32x4*)(R + (size_t)t * D + h * 512 + 8 * c.lane + 4); }
        float mean, rstd; ln_stats(v, mean, rstd, c.lane);
        ln_row_store(v, mean, rstd, g, b, H + (size_t)t * D, HB + (size_t)t * D, c.lane);
    }
}

__device__ __forceinline__ bf16x8 mk8(float a0, float a1, float a2, float a3, float a4, float a5, float a6, float a7) {
    v4u w; w.x = pk2(a0, a1); w.y = pk2(a2, a3); w.z = pk2(a4, a5); w.w = pk2(a6, a7); return __builtin_bit_cast(bf16x8, w);
}
constexpr int S5_BU_LD = 132  , S5_H_LD = 136  , S5_WAVE_BYTES = 16 * S5_BU_LD * 4 + 16 * S5_H_LD * 2;
__device__ __forceinline__ void phase_s5scan(const Ctx& c) {
    const bf16* U = c.W<bf16>(WS_A0); bf16* G = c.W<bf16>(WS_A1);
    const float* sm = c.W<float>(WS_SMALL);
    float* out = c.out;
    float* o_re_p = out + 17825792, *o_im_p = o_re_p + 32768, *o_re_s = out + 17825792 + 32768 * 2 + 122880 + 73728 + 2097152, *o_im_s = o_re_s + 524288;
    const int lane = c.lane, p = lane, fr = lane & 15, fq = lane >> 4;
    LAS float* BuT = (LAS float*)(c.lds + c.wave * S5_WAVE_BYTES);
    LAS bf16* Hi = (LAS bf16*)(c.lds + c.wave * S5_WAVE_BYTES + 16 * S5_BU_LD * 4);
    const int wslot = c.wave * c.nblk + c.bid;
    for (int unit = wslot; unit < 136 * 64; unit += c.NGW) {
        const int s = unit >> 6, g = unit & 63;
        int tok0, L; seq_info(s, tok0, L);
        bf16x8 Bf[8];
#pragma unroll
        for (int nt = 0; nt < 8; ++nt) {
            const int comp = 16 * nt + fr;
            const float* src = sm + ((comp < 64) ? SM_BBR : SM_BBI) + (size_t)(g * 64 + (comp & 63)) * 16 + 8 * (fq & 1);
            const f32x4 a = *(const f32x4*)src, b = *(const f32x4*)(src + 4);
            const bf16x8 v = mk8(a[0], a[1], a[2], a[3], b[0], b[1], b[2], b[3]);
            Bf[nt] = (fq < 2) ? v : (bf16x8){0, 0, 0, 0, 0, 0, 0, 0};
        }
        bf16x8 Cf[4];
#pragma unroll
        for (int ks = 0; ks < 4; ++ks) {
            const int comp0 = 32 * ks + 8 * fq;
            const float* src = ((ks < 2) ? c.in[c.z + 13] : c.in[c.z + 14]) + (size_t)(g * 16 + fr) * 64 + (comp0 & 63);
            const f32x4 a = *(const f32x4*)src, b = *(const f32x4*)(src + 4);
            const float sg = (ks < 2) ? 1.f : -1.f;
            Cf[ks] = mk8(sg * a[0], sg * a[1], sg * a[2], sg * a[3], sg * b[0], sg * b[1], sg * b[2], sg * b[3]);
        }
        const float lr = sm[SM_LBR + g * 64 + p], li = sm[SM_LBI + g * 64 + p];
        float hr = 0.f, hi = 0.f;
        if (s >= 8) { hr = c.in[c.z + 2][((s - 8) * 64 + g) * 64 + p]; hi = c.in[c.z + 3][((s - 8) * 64 + g) * 64 + p]; }
        const f32x4 dk4 = *(const f32x4*)(c.in[c.z + 15] + g * 16 + 4 * fq);
        const int ntile = (L + 15) >> 4;
        bf16x8 uf_n = {0, 0, 0, 0, 0, 0, 0, 0}; v2u uq_n = {0u, 0u};
        if (fr < L) { if (fq < 2) uf_n = *(const bf16x8*)(U + (size_t)(tok0 + fr) * D + g * 16 + 8 * fq); uq_n = *(const v2u*)(U + (size_t)(tok0 + fr) * D + g * 16 + 4 * fq); }
        for (int tile = 0; tile < ntile; ++tile) {
            const int tb = tok0 + tile * 16;
            const bool valid = (tile * 16 + fr) < L;
            const bf16x8 uf = uf_n; const v2u uq = uq_n;
            uf_n = (bf16x8){0, 0, 0, 0, 0, 0, 0, 0}; uq_n = (v2u){0u, 0u};
            if ((tile + 1) * 16 + fr < L) { if (fq < 2) uf_n = *(const bf16x8*)(U + (size_t)(tb + 16 + fr) * D + g * 16 + 8 * fq); uq_n = *(const v2u*)(U + (size_t)(tb + 16 + fr) * D + g * 16 + 4 * fq); }
#pragma unroll
            for (int nt = 0; nt < 8; ++nt) {
                f32x4 acc = {0.f, 0.f, 0.f, 0.f};
                acc = __builtin_amdgcn_mfma_f32_16x16x32_bf16(Bf[nt], uf, acc, 0, 0, 0);
                *(LAS f32x4*)(BuT + fr * S5_BU_LD + 16 * nt + 4 * fq) = acc;
            }
            asm volatile("s_waitcnt lgkmcnt(0)" ::: "memory");
            const int nsteps = min(16, L - tile * 16);
#pragma unroll
            for (int t = 0; t < 16; ++t) {
                const float br = BuT[t * S5_BU_LD + p], bi = BuT[t * S5_BU_LD + 64 + p];
                const float nr = lr * hr - li * hi + br, ni = lr * hi + li * hr + bi;
                if (t < nsteps) { hr = nr; hi = ni; }
                Hi[t * S5_H_LD + p] = (bf16)f2bf(hr); Hi[t * S5_H_LD + 64 + p] = (bf16)f2bf(hi);
            }
            asm volatile("s_waitcnt lgkmcnt(0)" ::: "memory");
            f32x4 y = {0.f, 0.f, 0.f, 0.f};
#pragma unroll
            for (int ks = 0; ks < 4; ++ks) {
                const bf16x8 hf = *(const LAS bf16x8*)(Hi + fr * S5_H_LD + 32 * ks + 8 * fq);
                y = __builtin_amdgcn_mfma_f32_16x16x32_bf16(Cf[ks], hf, y, 0, 0, 0);
            }
            if (valid) {
                v2u o; o.x = pk2(gelu_f(y[0] + dk4[0] * bflo(uq.x)), gelu_f(y[1] + dk4[1] * bfhi(uq.x))); o.y = pk2(gelu_f(y[2] + dk4[2] * bflo(uq.y)), gelu_f(y[3] + dk4[3] * bfhi(uq.y)));
                *(v2u*)(G + (size_t)(tb + fr) * D + g * 16 + 4 * fq) = o;
            }
            asm volatile("" ::: "memory");
        }
        if (s < 8) { o_re_p[(s * 64 + g) * 64 + p] = hr; o_im_p[(s * 64 + g) * 64 + p] = hi; }
        else { o_re_s[((s - 8) * 64 + g) * 64 + p] = hr; o_im_s[((s - 8) * 64 + g) * 64 + p] = hi; }
    }
}

__device__ __forceinline__ void unpack8(const v4u q, float (&f)[8]) { f[0] = bflo(q.x); f[1] = bfhi(q.x); f[2] = bflo(q.y); f[3] = bfhi(q.y); f[4] = bflo(q.z); f[5] = bfhi(q.z); f[6] = bflo(q.w); f[7] = bfhi(q.w); }
__device__ __forceinline__ void phase_pool(const Ctx& c) {
    const bf16* U = c.W<bf16>(WS_A0); bf16* P = c.W<bf16>(WS_A1);
    float* o_p = c.out + 17825792 + 65536, *o_s = c.out + 17825792 + 65536 + 122880 + 73728 + 2097152 + 1048576;
    for (int item = c.gt; item < 384 * 128; item += c.NGT) {
        const int rg = item >> 7, c0 = (item & 127) * 8, w = 2 << (c0 >> 8);
        int tok0, l0, n, sb;
        if (rg < 256) { tok0 = (rg >> 5) << 11; l0 = (rg & 31) * 64; n = 64; sb = -1; } else { sb = rg - 256; tok0 = TP + sb * 8; l0 = 0; n = 8; }
        float sum[8];
#pragma unroll
        for (int j = 0; j < 8; ++j) sum[j] = 0.f;
        for (int k = 1; k < w; ++k) {
            const int ll = l0 - k; float f[8];
            if (ll >= 0) unpack8(*(const v4u*)(U + (size_t)(tok0 + ll) * D + c0), f);
            else if (sb >= 0) { const float* sp = c.in[c.z + 4] + ((size_t)sb * 15 + (15 + ll)) * D + c0; const f32x4 a = *(const f32x4*)sp, b = *(const f32x4*)(sp + 4); f[0] = a[0]; f[1] = a[1]; f[2] = a[2]; f[3] = a[3]; f[4] = b[0]; f[5] = b[1]; f[6] = b[2]; f[7] = b[3]; }
            else {
#pragma unroll
                for (int j = 0; j < 8; ++j) f[j] = 0.f;
            }
#pragma unroll
            for (int j = 0; j < 8; ++j) sum[j] += f[j];
        }
        for (int i = 0; i < n; ++i) {
            const int l = l0 + i; float cur[8], old[8];
            unpack8(*(const v4u*)(U + (size_t)(tok0 + l) * D + c0), cur);
#pragma unroll
            for (int j = 0; j < 8; ++j) sum[j] += cur[j];
            const int pos = (sb >= 0 ? 16384 : 0) + l;
            const float inv = 1.f / (float)min(pos + 1, w);
            v4u o; o.x = pk2(sum[0] * inv - cur[0], sum[1] * inv - cur[1]); o.y = pk2(sum[2] * inv - cur[2], sum[3] * inv - cur[3]);
            o.z = pk2(sum[4] * inv - cur[4], sum[5] * inv - cur[5]); o.w = pk2(sum[6] * inv - cur[6], sum[7] * inv - cur[7]);
            *(v4u*)(P + (size_t)(tok0 + l) * D + c0) = o;
            const int lo = l - w + 1;
            if (lo >= 0) unpack8(*(const v4u*)(U + (size_t)(tok0 + lo) * D + c0), old);
            else if (sb >= 0) { const float* sp = c.in[c.z + 4] + ((size_t)sb * 15 + (15 + lo)) * D + c0; const f32x4 a = *(const f32x4*)sp, b = *(const f32x4*)(sp + 4); old[0] = a[0]; old[1] = a[1]; old[2] = a[2]; old[3] = a[3]; old[4] = b[0]; old[5] = b[1]; old[6] = b[2]; old[7] = b[3]; }
            else {
#pragma unroll
                for (int j = 0; j < 8; ++j) old[j] = 0.f;
            }
#pragma unroll
            for (int j = 0; j < 8; ++j) sum[j] -= old[j];
        }
    }
    for (size_t i = (size_t)c.gt; i < (size_t)136 * 15 * D; i += (size_t)c.NGT) {
        const int ch = (int)(i & 1023); const int j = (int)((i >> 10) % 15); const int s = (int)(i / (15 * 1024));
        if (s < 8) o_p[((size_t)s * 15 + j) * D + ch] = bf2f(U[(size_t)(s * 2048 + 2033 + j) * D + ch]);
        else { const int b = s - 8; o_s[((size_t)b * 15 + j) * D + ch] = (j < 7) ? c.in[c.z + 4][((size_t)b * 15 + 8 + j) * D + ch] : bf2f(U[(size_t)(TP + b * 8 + (j - 7)) * D + ch]); }
    }
}

__device__ __forceinline__ void phase_cmlp_ln(const Ctx& c) {
    bf16* Z = c.W<bf16>(WS_Q);
    float* o_v = c.out + 17825792 + 65536 + 122880 + 73728 + 2097152 + 1048576 + 1966080;
    const float* g = c.in[c.z + 25]; const float* b = c.in[c.z + 26];
    for (int t = c.gw; t < T; t += c.NGW) {
        bf16* vr = Z + (size_t)t * 2048 + 1024;
        f32x4 v[4];
#pragma unroll
        for (int h = 0; h < 2; ++h) {
            const v4u q = *(const v4u*)(vr + h * 512 + 8 * c.lane);
            v[2 * h] = (f32x4){bflo(q.x), bfhi(q.x), bflo(q.y), bfhi(q.y)}; v[2 * h + 1] = (f32x4){bflo(q.z), bfhi(q.z), bflo(q.w), bfhi(q.w)};
        }
        float mean, rstd; ln_stats(v, mean, rstd, c.lane);
#pragma unroll
        for (int h = 0; h < 2; ++h) {
            const int c0 = h * 512 + 8 * c.lane;
            const f32x4 g0 = *(const f32x4*)(g + c0), g1 = *(const f32x4*)(g + c0 + 4), b0 = *(const f32x4*)(b + c0), b1 = *(const f32x4*)(b + c0 + 4);
            const f32x4 o0 = (v[2 * h] - mean) * rstd * g0 + b0, o1 = (v[2 * h + 1] - mean) * rstd * g1 + b1;
            v4u w; w.x = pk2(o0[0], o0[1]); w.y = pk2(o0[2], o0[3]); w.z = pk2(o1[0], o1[1]); w.w = pk2(o1[2], o1[3]);
            *(v4u*)(vr + c0) = w;
            if (t >= TP) { *(f32x4*)(o_v + (size_t)(t - TP) * D + c0) = o0; *(f32x4*)(o_v + (size_t)(t - TP) * D + c0 + 4) = o1; }
        }
    }
}
constexpr int CM_LD = 136, CM_WS = 0  , CM_VT = 34816  ;
__device__ __forceinline__ void phase_cmlp_mix(const Ctx& c) {
    const bf16* Z = c.W<bf16>(WS_Q); bf16* O = c.W<bf16>(WS_A1);
    LAS unsigned char* lds = c.lds;
    const int tid = c.tid, lane = c.lane, w = c.wave, fr = lane & 15, fq = lane >> 4;
    for (int unit = c.bid; unit < 128 * 4; unit += c.nblk) {
        const int chunk = unit >> 2, hd = unit & 3, tokc = chunk * 128;
#pragma unroll
        for (int k = 0; k < 4; ++k) {
            const int q = tid + 512 * k, row = q >> 4, cc = q & 15;
            const float* src = c.in[c.z + 27] + ((size_t)hd * 128 + row) * 128 + cc * 8;
            const f32x4 a = *(const f32x4*)src, b = *(const f32x4*)(src + 4);
            float f[8] = {a[0], a[1], a[2], a[3], b[0], b[1], b[2], b[3]};
#pragma unroll
            for (int j = 0; j < 8; ++j) f[j] = (cc * 8 + j <= row) ? f[j] : 0.f;
            v4u o; o.x = pk2(f[0], f[1]); o.y = pk2(f[2], f[3]); o.z = pk2(f[4], f[5]); o.w = pk2(f[6], f[7]);
            *(LAS v4u*)(lds + CM_WS + (row * CM_LD + cc * 8) * 2) = o;
        }
        {
            const int srow = tid & 127, dq = tid >> 7;
            const bf16* vs = Z + (size_t)(tokc + srow) * 2048 + 1024 + hd * 256 + dq * 64;
#pragma unroll
            for (int k = 0; k < 8; ++k) {
                const v4u q = *(const v4u*)(vs + 8 * k);
                const unsigned xw[4] = {q.x, q.y, q.z, q.w};
#pragma unroll
                for (int j = 0; j < 4; ++j) {
                    *(LAS bf16*)(lds + CM_VT + ((dq * 64 + 8 * k + 2 * j) * CM_LD + srow) * 2) = (bf16)(xw[j] & 0xffffu);
                    *(LAS bf16*)(lds + CM_VT + ((dq * 64 + 8 * k + 2 * j + 1) * CM_LD + srow) * 2) = (bf16)(xw[j] >> 16);
                }
            }
        }
        __syncthreads();
        f32x4 acc[16];
#pragma unroll
        for (int jd = 0; jd < 16; ++jd) acc[jd] = (f32x4){0.f, 0.f, 0.f, 0.f};
#pragma unroll
        for (int ks = 0; ks < 4; ++ks) {
            if (ks <= (w >> 1)) {
                const bf16x8 wf = *(const LAS bf16x8*)(lds + CM_WS + ((16 * w + fr) * CM_LD + ks * 32 + 8 * fq) * 2);
#pragma unroll
                for (int jd = 0; jd < 16; ++jd)
                    acc[jd] = __builtin_amdgcn_mfma_f32_16x16x32_bf16(*(const LAS bf16x8*)(lds + CM_VT + ((16 * jd + fr) * CM_LD + ks * 32 + 8 * fq) * 2), wf, acc[jd], 0, 0, 0);
            }
        }
        {
            const int t = 16 * w + fr; const size_t tok = (size_t)(tokc + t);
            const float bs = c.in[c.z + 28][hd * 128 + t];
#pragma unroll
            for (int jd = 0; jd < 16; ++jd) {
                const v2u uq = *(const v2u*)(Z + tok * 2048 + hd * 256 + 16 * jd + 4 * fq);
                v2u o; o.x = pk2(bflo(uq.x) * (acc[jd][0] + bs), bfhi(uq.x) * (acc[jd][1] + bs)); o.y = pk2(bflo(uq.y) * (acc[jd][2] + bs), bfhi(uq.y) * (acc[jd][3] + bs));
                *(v2u*)(O + tok * D + hd * 256 + 16 * jd + 4 * fq) = o;
            }
        }
        __syncthreads();
    }
    for (size_t i = (size_t)c.gt; i < (size_t)(T - TP) * 128; i += (size_t)c.NGT) {
        const int t = TP + (int)(i >> 7), c0 = (int)(i & 127) * 8;
        const int hd = c0 >> 8, tp = (t - TP) & 7, base = t - tp;
        float acc[8];
        const float bs = c.in[c.z + 28][hd * 128 + tp];
#pragma unroll
        for (int j = 0; j < 8; ++j) acc[j] = bs;
        const float* wr = c.in[c.z + 27] + ((size_t)hd * 128 + tp) * 128;
        for (int sp = 0; sp <= tp; ++sp) {
            const float wv = wr[sp];
            const v4u q = *(const v4u*)(Z + (size_t)(base + sp) * 2048 + 1024 + c0);
            acc[0] += wv * bflo(q.x); acc[1] += wv * bfhi(q.x); acc[2] += wv * bflo(q.y); acc[3] += wv * bfhi(q.y);
            acc[4] += wv * bflo(q.z); acc[5] += wv * bfhi(q.z); acc[6] += wv * bflo(q.w); acc[7] += wv * bfhi(q.w);
        }
        const v4u uq = *(const v4u*)(Z + (size_t)t * 2048 + c0);
        v4u o; o.x = pk2(bflo(uq.x) * acc[0], bfhi(uq.x) * acc[1]); o.y = pk2(bflo(uq.y) * acc[2], bfhi(uq.y) * acc[3]);
        o.z = pk2(bflo(uq.z) * acc[4], bfhi(uq.z) * acc[5]); o.w = pk2(bflo(uq.w) * acc[6], bfhi(uq.w) * acc[7]);
        *(v4u*)(O + (size_t)t * D + c0) = o;
    }
}

__device__ __forceinline__ void phase_ssd_conv(const Ctx& c) {
    const bf16* X = c.W<bf16>(WS_XBC); bf16* XC = c.W<bf16>(WS_XC);
    float* o_p = c.out + 17825792 + 65536 + 122880, *o_s = c.out + 17825792 + 65536 + 122880 + 73728 + 2097152 + 1048576 + 1966080 + 1048576;
    for (int item = c.gt; item < 384 * 384; item += c.NGT) {
        const int rg = item / 384, c0 = (item % 384) * 8;
        int tok0, l0, n, sb;
        if (rg < 256) { tok0 = (rg >> 5) << 11; l0 = (rg & 31) * 64; n = 64; sb = -1; } else { sb = rg - 256; tok0 = TP + sb * 8; l0 = 0; n = 8; }
        float wt[4][8], bias[8];
#pragma unroll
        for (int k = 0; k < 4; ++k) { const f32x4 a = *(const f32x4*)(c.in[c.z + 31] + k * CONVD + c0), b = *(const f32x4*)(c.in[c.z + 31] + k * CONVD + c0 + 4);
            wt[k][0] = a[0]; wt[k][1] = a[1]; wt[k][2] = a[2]; wt[k][3] = a[3]; wt[k][4] = b[0]; wt[k][5] = b[1]; wt[k][6] = b[2]; wt[k][7] = b[3]; }
        { const f32x4 a = *(const f32x4*)(c.in[c.z + 32] + c0), b = *(const f32x4*)(c.in[c.z + 32] + c0 + 4); bias[0] = a[0]; bias[1] = a[1]; bias[2] = a[2]; bias[3] = a[3]; bias[4] = b[0]; bias[5] = b[1]; bias[6] = b[2]; bias[7] = b[3]; }
        float r0[8], r1[8], r2[8];
#pragma unroll
        for (int k = 0; k < 3; ++k) {
            const int src = l0 - 3 + k; float f[8];
            if (src >= 0) unpack8(*(const v4u*)(X + (size_t)(tok0 + src) * CONVD + c0), f);
            else if (sb >= 0) { const float* sp = c.in[c.z + 5] + ((size_t)sb * 3 + (3 + src)) * CONVD + c0; const f32x4 a = *(const f32x4*)sp, b = *(const f32x4*)(sp + 4); f[0] = a[0]; f[1] = a[1]; f[2] = a[2]; f[3] = a[3]; f[4] = b[0]; f[5] = b[1]; f[6] = b[2]; f[7] = b[3]; }
            else {
#pragma unroll
                for (int j = 0; j < 8; ++j) f[j] = 0.f;
            }
#pragma unroll
            for (int j = 0; j < 8; ++j) { if (k == 0) r0[j] = f[j]; else if (k == 1) r1[j] = f[j]; else r2[j] = f[j]; }
        }
        for (int i = 0; i < n; ++i) {
            float cur[8], o[8];
            unpack8(*(const v4u*)(X + (size_t)(tok0 + l0 + i) * CONVD + c0), cur);
#pragma unroll
            for (int j = 0; j < 8; ++j) { o[j] = silu_f(bias[j] + r0[j] * wt[0][j] + r1[j] * wt[1][j] + r2[j] * wt[2][j] + cur[j] * wt[3][j]); r0[j] = r1[j]; r1[j] = r2[j]; r2[j] = cur[j]; }
            v4u q; q.x = pk2(o[0], o[1]); q.y = pk2(o[2], o[3]); q.z = pk2(o[4], o[5]); q.w = pk2(o[6], o[7]);
            *(v4u*)(XC + (size_t)(tok0 + l0 + i) * CONVD + c0) = q;
        }
    }
    for (size_t i = (size_t)c.gt; i < (size_t)136 * 3 * CONVD; i += (size_t)c.NGT) {
        const int ch = (int)(i % CONVD); const int j = (int)((i / CONVD) % 3); const int s = (int)(i / (3 * CONVD));
        if (s < 8) o_p[((size_t)s * 3 + j) * CONVD + ch] = bf2f(X[(size_t)(s * 2048 + 2045 + j) * CONVD + ch]);
        else { const int b = s - 8; o_s[((size_t)b * 3 + j) * CONVD + ch] = bf2f(X[(size_t)(TP + b * 8 + 5 + j) * CONVD + ch]); }
    }
}
constexpr int SD_LD = 136;
constexpr int SD_C = 0, SD_B = 34816, SD_BT = 69632, SD_XT = 104448, SD_HB = 121856, SD_VEC = 139264;
__device__ __forceinline__ float softplus_f(float x) { return (x > 20.f) ? x : log1pf(__expf(x)); }
__device__ __forceinline__ void phase_ssd_scan(const Ctx& c) {
    const bf16* XC = c.W<bf16>(WS_XC); const float* DT = c.W<float>(WS_DT); bf16* Y = c.W<bf16>(WS_Y);
    float* o_p = c.out + 17825792 + 65536 + 122880 + 73728;
    float* o_s = c.out + 17825792 + 65536 + 122880 + 73728 + 2097152 + 1048576 + 1966080 + 1048576 + 1179648;
    const int tid = c.tid, lane = c.lane, w = c.wave, fr = lane & 15, fq = lane >> 4;
    LAS unsigned char* lds = c.lds;
    LAS float* csv = (LAS float*)(lds + SD_VEC); LAS float* dtv = csv + 128;
#define SD_FRAG(img, row, ks) (*(const LAS bf16x8*)(lds + (img) + ((row) * SD_LD + (ks) * 32 + 8 * fq) * 2))
    for (int unit = c.bid; unit < 8 * 32; unit += c.nblk) {
        const int s = unit >> 5, hd = unit & 31, g = hd >> 3;
        const float a = -__expf(c.in[c.z + 34][hd]), dtb = c.in[c.z + 33][hd], dk = c.in[c.z + 35][hd];
        f32x4 hacc[4];
#pragma unroll
        for (int jp = 0; jp < 4; ++jp) hacc[jp] = (f32x4){0.f, 0.f, 0.f, 0.f};
        for (int ch = 0; ch < 16; ++ch) {
            const int tokc = s * 2048 + ch * 128;
            if (w == 0) {
                const float dt0 = softplus_f(DT[(size_t)(tokc + lane) * 32 + hd] + dtb), dt1 = softplus_f(DT[(size_t)(tokc + 64 + lane) * 32 + hd] + dtb);
                float s0 = dt0 * a, s1 = dt1 * a;
#pragma unroll
                for (int o = 1; o < 64; o <<= 1) {
                    const float u0 = __builtin_bit_cast(float, __builtin_amdgcn_ds_bpermute(((lane - o) & 63) << 2, __builtin_bit_cast(int, s0)));
                    const float u1 = __builtin_bit_cast(float, __builtin_amdgcn_ds_bpermute(((lane - o) & 63) << 2, __builtin_bit_cast(int, s1)));
                    if (lane >= o) { s0 += u0; s1 += u1; }
                }
                const float tot0 = __builtin_bit_cast(float, __builtin_amdgcn_readlane(__builtin_bit_cast(int, s0), 63));
                csv[lane] = s0; csv[64 + lane] = tot0 + s1; dtv[lane] = dt0; dtv[64 + lane] = dt1;
            }
#pragma unroll
            for (int k = 0; k < 4; ++k) {
                const int q = tid + 512 * k, row = q >> 4, cc = q & 15;
                const bf16* src = XC + (size_t)(tokc + row) * CONVD + g * 128 + cc * 8;
                *(LAS v4u*)(lds + SD_C + (row * SD_LD + cc * 8) * 2) = *(const v4u*)(src + 2560);
                *(LAS v4u*)(lds + SD_B + (row * SD_LD + cc * 8) * 2) = *(const v4u*)(src + 2048);
            }
#pragma unroll
            for (int jp = 0; jp < 4; ++jp) {
                v2u hq; hq.x = pk2(hacc[jp][0], hacc[jp][1]); hq.y = pk2(hacc[jp][2], hacc[jp][3]);
                *(LAS v2u*)(lds + SD_HB + ((16 * jp + fr) * SD_LD + 16 * w + 4 * fq) * 2) = hq;
            }
            __syncthreads();
            {
                const int srow = tid & 127, qq = tid >> 7;
                const float sc = __expf(csv[127] - csv[srow]) * dtv[srow];
#pragma unroll
                for (int k = 0; k < 4; ++k) {
                    const int n0 = qq * 32 + k * 8;
                    const v4u bq = *(const LAS v4u*)(lds + SD_B + (srow * SD_LD + n0) * 2);
                    const float f[8] = {bflo(bq.x), bfhi(bq.x), bflo(bq.y), bfhi(bq.y), bflo(bq.z), bfhi(bq.z), bflo(bq.w), bfhi(bq.w)};
#pragma unroll
                    for (int j = 0; j < 8; ++j) *(LAS bf16*)(lds + SD_BT + ((n0 + j) * SD_LD + srow) * 2) = (bf16)f2bf(f[j] * sc);
                }
                const bf16* xs = XC + (size_t)(tokc + srow) * CONVD + hd * 64 + qq * 16;
                const v4u x0 = *(const v4u*)xs, x1 = *(const v4u*)(xs + 8);
                const unsigned xw[8] = {x0.x, x0.y, x0.z, x0.w, x1.x, x1.y, x1.z, x1.w};
#pragma unroll
                for (int j = 0; j < 8; ++j) {
                    *(LAS bf16*)(lds + SD_XT + ((qq * 16 + 2 * j) * SD_LD + srow) * 2) = (bf16)(xw[j] & 0xffffu);
                    *(LAS bf16*)(lds + SD_XT + ((qq * 16 + 2 * j + 1) * SD_LD + srow) * 2) = (bf16)(xw[j] >> 16);
                }
            }
            __syncthreads();
            const int jmax = w | 1;
            bf16x8 Cf[4];
#pragma unroll
            for (int ks = 0; ks < 4; ++ks) Cf[ks] = SD_FRAG(SD_C, 16 * w + fr, ks);
            f32x4 acc[8];
#pragma unroll
            for (int j = 0; j < 8; ++j) {
                acc[j] = (f32x4){0.f, 0.f, 0.f, 0.f};
                if (j <= jmax) {
#pragma unroll
                    for (int ks = 0; ks < 4; ++ks) acc[j] = __builtin_amdgcn_mfma_f32_16x16x32_bf16(SD_FRAG(SD_B, 16 * j + fr, ks), Cf[ks], acc[j], 0, 0, 0);
                }
            }
            {
                const float cdec = __expf(csv[127]);
                bf16x8 Bt[4];
#pragma unroll
                for (int ks = 0; ks < 4; ++ks) Bt[ks] = SD_FRAG(SD_BT, 16 * w + fr, ks);
#pragma unroll
                for (int jp = 0; jp < 4; ++jp) {
                    hacc[jp] = hacc[jp] * cdec;
#pragma unroll
                    for (int ks = 0; ks < 4; ++ks) hacc[jp] = __builtin_amdgcn_mfma_f32_16x16x32_bf16(Bt[ks], SD_FRAG(SD_XT, 16 * jp + fr, ks), hacc[jp], 0, 0, 0);
                }
            }
            __syncthreads();
            {
                const int t = 16 * w + fr; const float cst = csv[t];
#pragma unroll
                for (int j = 0; j < 8; ++j) {
                    if (j <= jmax) {
                        const f32x4 css = *(const LAS f32x4*)(csv + 16 * j + 4 * fq), dts = *(const LAS f32x4*)(dtv + 16 * j + 4 * fq);
                        float v[4];
#pragma unroll
                        for (int r = 0; r < 4; ++r) v[r] = (16 * j + 4 * fq + r <= t) ? acc[j][r] * __expf(cst - css[r]) * dts[r] : 0.f;
                        v2u lq; lq.x = pk2(v[0], v[1]); lq.y = pk2(v[2], v[3]);
                        *(LAS v2u*)(lds + SD_B + (t * SD_LD + 16 * j + 4 * fq) * 2) = lq;
                    }
                }
            }
            __syncthreads();
            {
                f32x4 a1[4], a2[4];
#pragma unroll
                for (int jp = 0; jp < 4; ++jp) { a1[jp] = (f32x4){0.f, 0.f, 0.f, 0.f}; a2[jp] = (f32x4){0.f, 0.f, 0.f, 0.f}; }
#pragma unroll
                for (int ks = 0; ks < 4; ++ks) {
                    if (ks <= (w >> 1)) {
                        const bf16x8 Lf = SD_FRAG(SD_B, 16 * w + fr, ks);
#pragma unroll
                        for (int jp = 0; jp < 4; ++jp) a1[jp] = __builtin_amdgcn_mfma_f32_16x16x32_bf16(SD_FRAG(SD_XT, 16 * jp + fr, ks), Lf, a1[jp], 0, 0, 0);
                    }
#pragma unroll
                    for (int jp = 0; jp < 4; ++jp) a2[jp] = __builtin_amdgcn_mfma_f32_16x16x32_bf16(SD_FRAG(SD_HB, 16 * jp + fr, ks), Cf[ks], a2[jp], 0, 0, 0);
                }
                const int t = 16 * w + fr; const float ecs = __expf(csv[t]);
                const size_t tok = (size_t)(tokc + t);
#pragma unroll
                for (int jp = 0; jp < 4; ++jp) {
                    const v2u xq = *(const v2u*)(XC + tok * CONVD + hd * 64 + 16 * jp + 4 * fq);
                    v2u yo; yo.x = pk2(a1[jp][0] + ecs * a2[jp][0] + dk * bflo(xq.x), a1[jp][1] + ecs * a2[jp][1] + dk * bfhi(xq.x));
                    yo.y = pk2(a1[jp][2] + ecs * a2[jp][2] + dk * bflo(xq.y), a1[jp][3] + ecs * a2[jp][3] + dk * bfhi(xq.y));
                    *(v2u*)(Y + tok * 2048 + hd * 64 + 16 * jp + 4 * fq) = yo;
                }
            }
            __syncthreads();
        }
#pragma unroll
        for (int jp = 0; jp < 4; ++jp) *(f32x4*)(o_p + (((size_t)s * 32 + hd) * 64 + 16 * jp + fr) * 128 + 16 * w + 4 * fq) = hacc[jp];
    }
#undef SD_FRAG
    __syncthreads();
    {
        LAS float* Bw = (LAS float*)(lds + w * 8192);
        LAS float* Cw = Bw + 1024;
        for (int unit = c.gw; unit < 128 * 32; unit += c.NGW) {
            const int b = unit >> 5, hd = unit & 31, g = hd >> 3, tok0 = TP + b * 8, p = lane;
            const float a = -__expf(c.in[c.z + 34][hd]), dtb = c.in[c.z + 33][hd], dk = c.in[c.z + 35][hd];
            {
                const int tk = lane >> 3, c0 = (lane & 7) * 16;
                const bf16* src = XC + (size_t)(tok0 + tk) * CONVD + g * 128 + c0;
                const v4u b0 = *(const v4u*)(src + 2048), b1 = *(const v4u*)(src + 2048 + 8), c0v = *(const v4u*)(src + 2560), c1v = *(const v4u*)(src + 2560 + 8);
                LAS float* bd = Bw + tk * 128 + c0; LAS float* cd = Cw + tk * 128 + c0;
                *(LAS f32x4*)(bd) = (f32x4){bflo(b0.x), bfhi(b0.x), bflo(b0.y), bfhi(b0.y)}; *(LAS f32x4*)(bd + 4) = (f32x4){bflo(b0.z), bfhi(b0.z), bflo(b0.w), bfhi(b0.w)};
                *(LAS f32x4*)(bd + 8) = (f32x4){bflo(b1.x), bfhi(b1.x), bflo(b1.y), bfhi(b1.y)}; *(LAS f32x4*)(bd + 12) = (f32x4){bflo(b1.z), bfhi(b1.z), bflo(b1.w), bfhi(b1.w)};
                *(LAS f32x4*)(cd) = (f32x4){bflo(c0v.x), bfhi(c0v.x), bflo(c0v.y), bfhi(c0v.y)}; *(LAS f32x4*)(cd + 4) = (f32x4){bflo(c0v.z), bfhi(c0v.z), bflo(c0v.w), bfhi(c0v.w)};
                *(LAS f32x4*)(cd + 8) = (f32x4){bflo(c1v.x), bfhi(c1v.x), bflo(c1v.y), bfhi(c1v.y)}; *(LAS f32x4*)(cd + 12) = (f32x4){bflo(c1v.z), bfhi(c1v.z), bflo(c1v.w), bfhi(c1v.w)};
            }
            float xv[8], dA[8], coef[8], yv[8];
#pragma unroll
            for (int t = 0; t < 8; ++t) {
                xv[t] = bf2f(XC[(size_t)(tok0 + t) * CONVD + hd * 64 + p]);
                const float dtv_ = softplus_f(DT[(size_t)(tok0 + t) * 32 + hd] + dtb);
                dA[t] = __expf(dtv_ * a); coef[t] = dtv_ * xv[t]; yv[t] = dk * xv[t];
            }
            asm volatile("s_waitcnt lgkmcnt(0)" ::: "memory");
            const float* hin = c.in[c.z + 6] + (((size_t)b * 32 + hd) * 64 + p) * 128;
            float* hout = o_s + (((size_t)b * 32 + hd) * 64 + p) * 128;
#pragma unroll 1
            for (int qt = 0; qt < 4; ++qt) {
                float h[32];
#pragma unroll
                for (int i = 0; i < 8; ++i) { const f32x4 q = *(const f32x4*)(hin + qt * 32 + 4 * i); h[4 * i] = q[0]; h[4 * i + 1] = q[1]; h[4 * i + 2] = q[2]; h[4 * i + 3] = q[3]; }
#pragma unroll
                for (int t = 0; t < 8; ++t) {
                    float ya = 0.f, yb = 0.f;
#pragma unroll
                    for (int i = 0; i < 8; ++i) {
                        const f32x4 bq = *(const LAS f32x4*)(Bw + t * 128 + qt * 32 + 4 * i), cq = *(const LAS f32x4*)(Cw + t * 128 + qt * 32 + 4 * i);
                        h[4 * i] = h[4 * i] * dA[t] + coef[t] * bq[0]; ya += cq[0] * h[4 * i];
                        h[4 * i + 1] = h[4 * i + 1] * dA[t] + coef[t] * bq[1]; yb += cq[1] * h[4 * i + 1];
                        h[4 * i + 2] = h[4 * i + 2] * dA[t] + coef[t] * bq[2]; ya += cq[2] * h[4 * i + 2];
                        h[4 * i + 3] = h[4 * i + 3] * dA[t] + coef[t] * bq[3]; yb += cq[3] * h[4 * i + 3];
                    }
                    yv[t] += ya + yb;
                    asm volatile("" ::: "memory");
                }
#pragma unroll
                for (int i = 0; i < 8; ++i) *(f32x4*)(hout + qt * 32 + 4 * i) = (f32x4){h[4 * i], h[4 * i + 1], h[4 * i + 2], h[4 * i + 3]};
            }
#pragma unroll
            for (int t = 0; t < 8; ++t) Y[(size_t)(tok0 + t) * 2048 + hd * 64 + p] = (bf16)f2bf(yv[t]);
            asm volatile("" ::: "memory");
        }
    }
}
__device__ __forceinline__ void phase_ssd_gatenorm(const Ctx& c) {
    const bf16* Y = c.W<bf16>(WS_Y); const bf16* Z = c.W<bf16>(WS_Q); bf16* YN = c.W<bf16>(WS_YN);
    for (int it = c.gw; it < T * 4; it += c.NGW) {
        const int t = it >> 2, c0 = (it & 3) * 512 + 8 * c.lane;
        const v4u yq = *(const v4u*)(Y + (size_t)t * 2048 + c0), zq = *(const v4u*)(Z + (size_t)t * 2048 + c0);
        const float yf[8] = {bflo(yq.x), bfhi(yq.x), bflo(yq.y), bfhi(yq.y), bflo(yq.z), bfhi(yq.z), bflo(yq.w), bfhi(yq.w)};
        const float zf[8] = {bflo(zq.x), bfhi(zq.x), bflo(zq.y), bfhi(zq.y), bflo(zq.z), bfhi(zq.z), bflo(zq.w), bfhi(zq.w)};
        float v[8]; float q = 0.f;
#pragma unroll
        for (int j = 0; j < 8; ++j) { v[j] = yf[j] * silu_f(zf[j]); q += v[j] * v[j]; }
        const float r = rsqrtf(wave_sum(q, c.lane) * (1.f / 512.f) + RMS_EPS);
        const f32x4 g0 = *(const f32x4*)(c.in[c.z + 36] + c0), g1 = *(const f32x4*)(c.in[c.z + 36] + c0 + 4);
        v4u o; o.x = pk2(v[0] * r * g0[0], v[1] * r * g0[1]); o.y = pk2(v[2] * r * g0[2], v[3] * r * g0[3]); o.z = pk2(v[4] * r * g1[0], v[5] * r * g1[1]); o.w = pk2(v[6] * r * g1[2], v[7] * r * g1[3]);
        *(v4u*)(YN + (size_t)t * 2048 + c0) = o;
    }
}

__device__ __forceinline__ unsigned ord_key(float s) { const unsigned u = __builtin_bit_cast(unsigned, s); return (u & 0x80000000u) ? ~u : (u | 0x80000000u); }
__device__ __forceinline__ float ord_dec(unsigned k) { const unsigned u = (k & 0x80000000u) ? (k & 0x7fffffffu) : ~k; return __builtin_bit_cast(float, u); }
__device__ __forceinline__ void ins16(unsigned (&Lk)[16], unsigned x) {
#pragma unroll
    for (int k = 0; k < 16; ++k) { const unsigned hi = max(Lk[k], x); x = min(Lk[k], x); Lk[k] = hi; }
}
__device__ __forceinline__ void ce_desc(unsigned& a, unsigned& b) { const unsigned hi = max(a, b), lo = min(a, b); a = hi; b = lo; }
__device__ __forceinline__ void ce_asc(unsigned& a, unsigned& b) { const unsigned hi = max(a, b), lo = min(a, b); a = lo; b = hi; }
__device__ __forceinline__ void sort16_desc(unsigned (&a)[16]) {
#pragma unroll
    for (int k = 2; k <= 16; k <<= 1)
#pragma unroll
        for (int j = k >> 1; j > 0; j >>= 1)
#pragma unroll
            for (int i = 0; i < 16; ++i) { const int l = i ^ j; if (l > i) { if ((i & k) == 0) ce_desc(a[i], a[l]); else ce_asc(a[i], a[l]); } }
}
__device__ __forceinline__ void bmerge16_desc(unsigned (&a)[16]) {
#pragma unroll
    for (int j = 8; j > 0; j >>= 1)
#pragma unroll
        for (int i = 0; i < 16; ++i) { const int l = i ^ j; if (l > i) ce_desc(a[i], a[l]); }
}
__device__ __forceinline__ void xmerge16(unsigned (&a)[16], int o, int lane) {
    unsigned pq[16];
#pragma unroll
    for (int k = 0; k < 16; ++k) pq[k] = (unsigned)__builtin_amdgcn_ds_bpermute((lane ^ o) << 2, (int)a[k]);
#pragma unroll
    for (int k = 0; k < 16; ++k) a[k] = max(a[k], pq[15 - k]);
    bmerge16_desc(a);
}
struct CandTab { unsigned char v[52]; };
constexpr CandTab make_cands() { CandTab t{}; int n = 0; for (int i = 0; i < 16; ++i) for (int j = 0; j < 16; ++j) if ((i + 1) * (j + 1) <= 16) t.v[n++] = (unsigned char)(i * 16 + j); return t; }
__device__ __forceinline__ void phase_route(const Ctx& c, int layer) {
    constexpr CandTab CT = make_cands();
    const bf16* Q = c.W<bf16>(WS_Q); const bf16* KEYS = c.W<bf16>(WS_KEYS) + (size_t)layer * 8 * 2 * 128 * 128;
    int* IDX = c.W<int>(WS_IDX); float* GATE = c.W<float>(WS_GATE); float* SCU = c.W<float>(WS_SCU);
    const float* ISU = c.W<float>(WS_SMALL) + SM_ISU; const float* ISV = c.W<float>(WS_SMALL) + SM_ISV;
    const int lane = c.lane, fr = lane & 15, fq = lane >> 4;
    constexpr int RK_LD = 136, RK_BYTES = 2 * 128 * RK_LD * 2;
    LAS unsigned* lists = (LAS unsigned*)(c.lds + RK_BYTES + c.wave * 2048);
    const int h = c.bid & 7;
    {
        const bf16* kg = KEYS + (size_t)h * 2 * 128 * 128;
        for (int q = c.tid; q < 2 * 128 * 16; q += NTHR) { const int row = q >> 4, cc = q & 15; *(LAS v4u*)(c.lds + (row * RK_LD + cc * 8) * 2) = *(const v4u*)(kg + (size_t)row * 128 + cc * 8); }
    }
    __syncthreads();
    const int nb8 = c.nblk >> 3;
    for (int tg = (c.bid >> 3) + nb8 * c.wave; tg < 1088; tg += nb8 * NWAVES) {
        const int tok0 = tg * 16;
        const bf16* qrow = Q + (size_t)(tok0 + fr) * 2048 + h * 256 + 8 * fq;
#pragma unroll
        for (int side = 0; side < 2; ++side) {
            bf16x8 qf[4];
#pragma unroll
            for (int ks = 0; ks < 4; ++ks) qf[ks] = *(const bf16x8*)(qrow + side * 128 + ks * 32);
            const LAS unsigned char* kb = c.lds + ((side * 128 + fr) * RK_LD + 8 * fq) * 2;
            unsigned A[16], B[16];
#pragma unroll
            for (int nt = 0; nt < 8; ++nt) {
                f32x4 acc = {0.f, 0.f, 0.f, 0.f};
#pragma unroll
                for (int ks = 0; ks < 4; ++ks) acc = __builtin_amdgcn_mfma_f32_16x16x32_bf16(*(const LAS bf16x8*)(kb + (nt * 16 * RK_LD + ks * 32) * 2), qf[ks], acc, 0, 0, 0);
#pragma unroll
                for (int r = 0; r < 4; ++r) {
                    const unsigned key = (ord_key(acc[r]) & ~127u) | (unsigned)(127 - (16 * nt + 4 * fq + r));
                    if (nt < 4) A[nt * 4 + r] = key; else B[(nt - 4) * 4 + r] = key;
                }
            }
            sort16_desc(A); sort16_desc(B);
#pragma unroll
            for (int k = 0; k < 16; ++k) A[k] = max(A[k], B[15 - k]);
            bmerge16_desc(A);
            xmerge16(A, 16, lane); xmerge16(A, 32, lane);
            if (fq == 0) {
#pragma unroll
                for (int k = 0; k < 4; ++k) *(LAS v4u*)(lists + (fr * 2 + side) * 16 + 4 * k) = (v4u){A[4 * k], A[4 * k + 1], A[4 * k + 2], A[4 * k + 3]};
            }
        }
        asm volatile("s_waitcnt lgkmcnt(0)" ::: "memory");
        int fq2 = fq, fr2 = fr; asm volatile("" : "+v"(fq2), "+v"(fr2));
        unsigned Cd[16];
#pragma unroll
        for (int k = 0; k < 13; ++k) {
            const int ij = (fq2 == 0) ? CT.v[k] : (fq2 == 1) ? CT.v[13 + k] : (fq2 == 2) ? CT.v[26 + k] : ((39 + k < 50) ? CT.v[(39 + k < 50) ? 39 + k : 0] : 0);
            const bool ok = (fq2 < 3) || (39 + k < 50);
            const unsigned k0 = lists[(fr2 * 2) * 16 + (ij >> 4)], k1 = lists[(fr2 * 2 + 1) * 16 + (ij & 15)];
            const unsigned x = (ord_key(ord_dec(k0 & ~127u) + ord_dec(k1 & ~127u)) & ~255u) | (unsigned)(255 - ij);
            Cd[k] = ok ? x : 0u;
        }
        Cd[13] = 0u; Cd[14] = 0u; Cd[15] = 0u;
        sort16_desc(Cd);
        xmerge16(Cd, 16, lane); xmerge16(Cd, 32, lane);
        float e[16], su[16]; int id[16]; float mx = 0.f, den = 0.f;
#pragma unroll
        for (int k = 0; k < 16; ++k) {
            const int pay = 255 - (int)(Cd[k] & 255u), i = pay >> 4, j = pay & 15;
            const unsigned k0 = lists[(fr2 * 2) * 16 + i], k1 = lists[(fr2 * 2 + 1) * 16 + j];
            id[k] = (127 - (int)(k0 & 127u)) * 128 + (127 - (int)(k1 & 127u));
            const float sv = ord_dec(k0 & ~127u) + ord_dec(k1 & ~127u);
            if (k == 0) mx = sv;
            e[k] = __expf(sv - mx); den += e[k];
        }
        const float inv = 1.f / den;
        int oi[4]; float og[4], ou[4];
#pragma unroll
        for (int r = 0; r < 4; ++r) {
            oi[r] = (fq2 == 0) ? id[r] : (fq2 == 1) ? id[4 + r] : (fq2 == 2) ? id[8 + r] : id[12 + r];
            og[r] = (fq2 == 0) ? e[r] : (fq2 == 1) ? e[4 + r] : (fq2 == 2) ? e[8 + r] : e[12 + r];
        }
#pragma unroll
        for (int r = 0; r < 4; ++r) { ou[r] = ISU[oi[r]]; og[r] *= inv * ISV[oi[r]]; }
        const size_t ob = (size_t)(tok0 + fr2) * 128 + h * 16 + 4 * fq2;
        *(int4*)(IDX + ob) = make_int4(oi[0], oi[1], oi[2], oi[3]);
        *(f32x4*)(GATE + ob) = (f32x4){og[0], og[1], og[2], og[3]};
        *(f32x4*)(SCU + ob) = (f32x4){ou[0], ou[1], ou[2], ou[3]};
        asm volatile("" ::: "memory");
        (void)su;
    }
}

__device__ __forceinline__ unsigned shxu(unsigned v, int o, int lane) { return __builtin_bit_cast(unsigned, shx(__builtin_bit_cast(float, v), o, lane)); }
constexpr int GS_TOK = 128 * 12, GS_WAVE = 9 * GS_TOK;
__device__ __forceinline__ void sort_tokens_to_lds(const Ctx& c, LAS unsigned char* sl, int ntw) {
    const int* IDX = c.W<int>(WS_IDX); const float* GATE = c.W<float>(WS_GATE); const float* SCU = c.W<float>(WS_SCU);
    const int lane = c.lane;
    for (int j = 0; j < ntw; ++j) {
        const size_t base = (size_t)(c.gw + j * c.NGW) * 128;
        unsigned k0 = ((unsigned)IDX[base + lane] << 7) | (unsigned)lane, k1 = ((unsigned)IDX[base + 64 + lane] << 7) | (unsigned)(64 + lane);
#pragma unroll
        for (int k = 2; k <= 128; k <<= 1) {
#pragma unroll
            for (int jd = k >> 1; jd > 0; jd >>= 1) {
                if (jd == 64) { const unsigned lo = min(k0, k1), hi = max(k0, k1); k0 = lo; k1 = hi; }
                else {
                    const unsigned p0 = shxu(k0, jd, lane), p1 = shxu(k1, jd, lane);
                    const bool lower = (lane & jd) == 0;
                    const bool asc0 = (k == 128) ? true : (k == 64) ? true : ((lane & k) == 0);
                    const bool asc1 = (k == 128) ? true : (k == 64) ? false : ((lane & k) == 0);
                    k0 = (lower == asc0) ? min(k0, p0) : max(k0, p0);
                    k1 = (lower == asc1) ? min(k1, p1) : max(k1, p1);
                }
            }
        }
        const int s0 = (int)(k0 & 127u), s1 = (int)(k1 & 127u);
        LAS int* li = (LAS int*)(sl + j * GS_TOK); LAS float* lg = (LAS float*)(sl + j * GS_TOK + 512); LAS float* lu = (LAS float*)(sl + j * GS_TOK + 1024);
        li[lane] = (int)(k0 >> 7); li[64 + lane] = (int)(k1 >> 7);
        lg[lane] = GATE[base + s0]; lg[64 + lane] = GATE[base + s1]; lu[lane] = SCU[base + s0]; lu[64 + lane] = SCU[base + s1];
    }
    asm volatile("s_waitcnt vmcnt(0) lgkmcnt(0)" ::: "memory");
}

typedef float f32x2 __attribute__((ext_vector_type(2)));
__device__ __forceinline__ void phase_gather(const Ctx& c, int layer, bool dummy) {
    const unsigned char* EU = c.ws + WS_EU; const unsigned char* EV = c.ws + WS_EV;
    const float* H = c.W<float>(WS_H32); float* Ho = dummy ? c.W<float>(WS_R32) : c.W<float>(WS_H32); bf16* HB = dummy ? c.W<bf16>(WS_A0) : c.W<bf16>(WS_HB);
    const float* g = c.in[c.z + 40] + layer * D; const float* b = c.in[c.z + 41] + layer * D;
    const int lane = c.lane;
    const int ntw = (T - c.gw + c.NGW - 1) / c.NGW, nit = ntw * 16;
    LAS unsigned char* sl = c.lds + c.wave * GS_WAVE;
    sort_tokens_to_lds(c, sl, ntw);
#define GT_TOK(it) (c.gw + ((it) >> 4) * c.NGW)
#define GT_IDX(it) (((it) < nit) ? ((const LAS int*)(sl + ((it) >> 4) * GS_TOK))[((it) & 15) * 8 + (lane & 7)] : 0)
#define GT_GS(P, it) (((const LAS float*)(sl + (((it) < nit ? (it) : 0) >> 4) * GS_TOK + (P)))[((it) & 15) * 8 + ((lane >> 3) & 7)])
#define GT_ROW(TAB, idxreg, e) (*(const v3u*)((TAB) + (size_t)__builtin_amdgcn_readlane((idxreg), (e)) * EROW + 12 * lane))
    int idx_c = GT_IDX(0), idx_n = GT_IDX(1);
    float gate_c = GT_GS(512, 0), scu_c = GT_GS(1024, 0);
    float xs[16], acc[16];
    v3u ru[8], rv[8];
#pragma unroll
    for (int e = 0; e < 8; ++e) { ru[e] = GT_ROW(EU, idx_c, e); rv[e] = GT_ROW(EV, idx_c, e); }
    for (int it = 0; it < nit; ++it) {
        const int t = GT_TOK(it), bt = it & 15;
        const int idx_nn = GT_IDX(it + 2);
        const float gate_n = GT_GS(512, it + 1), scu_n = GT_GS(1024, it + 1);
        const float mygate = gate_c, myscu = scu_c;
        if (bt == 0) {
#pragma unroll
            for (int k = 0; k < 4; ++k) { const f32x4 hx = *(const f32x4*)(H + (size_t)t * D + 16 * lane + 4 * k); xs[4 * k] = hx[0]; xs[4 * k + 1] = hx[1]; xs[4 * k + 2] = hx[2]; xs[4 * k + 3] = hx[3]; }
#pragma unroll
            for (int i = 0; i < 16; ++i) acc[i] = 0.f;
        }
        float pv[8];
#pragma unroll
        for (int e = 0; e < 8; e += 2) {
            const v32f y = __builtin_amdgcn_cvt_scalef32_pk32_f32_fp6((v6u){ru[e][0], ru[e][1], ru[e][2], ru[e + 1][0], ru[e + 1][1], ru[e + 1][2]}, 1.0f);
            float d0 = 0.f, d1 = 0.f;
#pragma unroll
            for (int i = 0; i < 16; ++i) { d0 += y[i] * xs[i]; d1 += y[16 + i] * xs[i]; }
            pv[e] = d0; pv[e + 1] = d1;
            ru[e] = GT_ROW(EU, idx_n, e); ru[e + 1] = GT_ROW(EU, idx_n, e + 1);
        }
        const float tot = reduce8(pv, lane);
        const float wgt = mygate * gelu_f(tot * myscu);
#pragma unroll
        for (int e = 0; e < 8; e += 2) {
            const float w0 = __builtin_bit_cast(float, __builtin_amdgcn_readlane(__builtin_bit_cast(int, wgt), 8 * e));
            const float w1 = __builtin_bit_cast(float, __builtin_amdgcn_readlane(__builtin_bit_cast(int, wgt), 8 * e + 8));
            const v32f y = __builtin_amdgcn_cvt_scalef32_pk32_f32_fp6((v6u){rv[e][0], rv[e][1], rv[e][2], rv[e + 1][0], rv[e + 1][1], rv[e + 1][2]}, 1.0f);
#pragma unroll
            for (int i = 0; i < 16; ++i) acc[i] += y[i] * w0 + y[16 + i] * w1;
            rv[e] = GT_ROW(EV, idx_n, e); rv[e + 1] = GT_ROW(EV, idx_n, e + 1);
        }
        if (bt == 15) {
            int l2 = lane; asm volatile("" : "+v"(l2));
            f32x4 v[4];
#pragma unroll
            for (int k = 0; k < 4; ++k) v[k] = (f32x4){xs[4 * k], xs[4 * k + 1], xs[4 * k + 2], xs[4 * k + 3]} * ALPHA + (f32x4){acc[4 * k], acc[4 * k + 1], acc[4 * k + 2], acc[4 * k + 3]};
            float mean, rstd; ln_stats(v, mean, rstd, l2);
            float* o32 = ((layer == 3 && !dummy) ? c.out : Ho) + (size_t)t * D + 16 * l2;
            bf16* ob = (layer == 3 && !dummy) ? (bf16*)nullptr : HB + (size_t)t * D + 16 * l2;
            v4u wb[2];
#pragma unroll
            for (int k = 0; k < 4; ++k) {
                const f32x4 g4 = *(const f32x4*)(g + 16 * l2 + 4 * k), b4 = *(const f32x4*)(b + 16 * l2 + 4 * k);
                const f32x4 o = (v[k] - mean) * rstd * g4 + b4;
                *(f32x4*)(o32 + 4 * k) = o;
                if (k & 1) { wb[k >> 1].z = pk2(o[0], o[1]); wb[k >> 1].w = pk2(o[2], o[3]); } else { wb[k >> 1].x = pk2(o[0], o[1]); wb[k >> 1].y = pk2(o[2], o[3]); }
            }
            if (ob) { *(v4u*)(ob) = wb[0]; *(v4u*)(ob + 8) = wb[1]; }
        }
        idx_c = idx_n; idx_n = idx_nn; gate_c = gate_n; scu_c = scu_n;
    }
#undef GT_ROW
#undef GT_GS
#undef GT_IDX
#undef GT_TOK
}

#define XB_TMO      128
#define XB_XCNT(j)  (256  + 64 * (j))
#define XB_XSUB(j)  (1280 + 64 * (j))
#define XB_XGEN(j)  (2304 + 64 * (j))
#define XB_TOP      3328
#define XB_TOPGEN   3392
#define XCD_BAR_WORDS 3456
#define XB_SPIN_CAP (1u << 22)
__device__ __forceinline__ unsigned xb_ld(unsigned* p)              { return __hip_atomic_load(p, __ATOMIC_RELAXED, __HIP_MEMORY_SCOPE_AGENT); }
__device__ __forceinline__ unsigned xb_add(unsigned* p, unsigned v) { return __hip_atomic_fetch_add(p, v, __ATOMIC_RELAXED, __HIP_MEMORY_SCOPE_AGENT); }
__device__ __forceinline__ unsigned xb_xcc_id() { return (unsigned)__builtin_amdgcn_s_getreg((3 << 11) | 20) & 0xFu; }
#define XB_SPIN(cond, bar) do { unsigned _sp = 0; while (cond) { __builtin_amdgcn_s_sleep(1); \
    if ((++_sp & 255u) == 0u) { if (xb_ld(&(bar)[XB_TMO])) break; if (_sp > XB_SPIN_CAP) { atomicAdd(&(bar)[XB_TMO], 1u); break; } } } } while (0)
struct XcdBarrier { unsigned* bar; unsigned x; volatile LAS unsigned* st; };
__device__ __forceinline__ XcdBarrier xcd_barrier_post(unsigned* bar, volatile LAS unsigned* st) {
    XcdBarrier b; b.bar = bar; b.x = xb_xcc_id(); b.st = st;
    if (threadIdx.x == 0) (void)xb_add(&bar[XB_XCNT(b.x)], 1u);
    return b;
}
__device__ __forceinline__ void xcd_barrier_complete(unsigned* bar, unsigned x, unsigned& nloc, unsigned& nx) {
    const unsigned G = gridDim.x * gridDim.y * gridDim.z;
    unsigned sum, cnt, mine, sp = 0u;
    for (;;) {
        sum = 0u; cnt = 0u; mine = 0u;
#pragma unroll
        for (unsigned j = 0; j < 16; ++j) { const unsigned cc = xb_ld(&bar[XB_XCNT(j)]); sum += cc; cnt += (cc > 0u) ? 1u : 0u; mine = (j == x) ? cc : mine; }
        if (sum == G) break;
        __builtin_amdgcn_s_sleep(1);
        if ((++sp & 255u) == 0u) { if (xb_ld(&bar[XB_TMO])) break; if (sp > XB_SPIN_CAP) { atomicAdd(&bar[XB_TMO], 1u); break; } }
    }
    nloc = mine > 0u ? mine : 1u; nx = cnt > 0u ? cnt : 1u;
}
__device__ __forceinline__ void xcd_barrier(const XcdBarrier& b, int tid) {
    asm volatile("s_waitcnt vmcnt(0)" ::: "memory");
    __syncthreads();
    if (tid == 0) {
        unsigned* bar = b.bar;
        __builtin_amdgcn_s_waitcnt(0);
        unsigned nloc = b.st[0], nx = b.st[1];
        if (nloc == 0u) { xcd_barrier_complete(bar, b.x, nloc, nx); b.st[0] = nloc; b.st[1] = nx; }
        const unsigned old = xb_add(&bar[XB_XSUB(b.x)], 1u);
        const unsigned gen = old / nloc;
        if (old + 1u == (gen + 1u) * nloc) {
            __builtin_amdgcn_fence(__ATOMIC_RELEASE, "agent");
            asm volatile("s_waitcnt vmcnt(0)" ::: "memory");
            const unsigned og = xb_add(&bar[XB_TOP], 1u);
            const unsigned tg = og / nx;
            if (og + 1u == (tg + 1u) * nx) xb_add(&bar[XB_TOPGEN], 1u);
            else XB_SPIN(xb_ld(&bar[XB_TOPGEN]) == tg, bar);
            __builtin_amdgcn_fence(__ATOMIC_ACQUIRE, "agent");
            xb_add(&bar[XB_XGEN(b.x)], 1u);
            asm volatile("s_waitcnt vmcnt(0)" ::: "memory");
        } else {
            XB_SPIN(xb_ld(&bar[XB_XGEN(b.x)]) == gen, bar);
            __builtin_amdgcn_fence(__ATOMIC_ACQUIRE, "agent");
            asm volatile("s_waitcnt vmcnt(0)" ::: "memory");
        }
    }
    __syncthreads();
}

__global__ void __launch_bounds__(NTHR, 2) mega(Params P) {
    extern __shared__ __attribute__((aligned(16))) unsigned char lds_raw[];
    cg::grid_group grid = cg::this_grid();
    Ctx c;
    c.in = P.in; c.out = P.out; c.ws = P.ws; c.lds = (LAS unsigned char*)lds_raw; c.z = 0;
    c.tid = threadIdx.x; c.lane = c.tid & 63; c.wave = __builtin_amdgcn_readfirstlane(c.tid >> 6);
    c.gw = (int)blockIdx.x * NWAVES + c.wave; c.NGW = (int)gridDim.x * NWAVES; c.gt = (int)blockIdx.x * NTHR + c.tid; c.NGT = (int)gridDim.x * NTHR; c.bid = (int)blockIdx.x; c.nblk = (int)gridDim.x;
#define RF() do { int zs_ = 0; asm volatile("" : "+s"(zs_)); c.z = zs_; c.lds = (LAS unsigned char*)lds_raw + zs_; int z_ = 0; asm volatile("" : "+v"(z_)); const int l_ = (int)__builtin_amdgcn_mbcnt_hi(~0u, __builtin_amdgcn_mbcnt_lo(~0u, (unsigned)z_)); c.lane = l_; c.tid = c.wave * 64 + l_; c.bid = (int)blockIdx.x + zs_; c.nblk = (int)gridDim.x + zs_; c.gw = c.bid * NWAVES + c.wave; c.NGW = c.nblk * NWAVES; c.gt = c.bid * NTHR + c.tid; c.NGT = c.nblk * NTHR; } while (0)
    bf16* HB = c.W<bf16>(WS_HB); bf16* A0 = c.W<bf16>(WS_A0); bf16* A1 = c.W<bf16>(WS_A1); bf16* A2 = c.W<bf16>(WS_A2); bf16* Qb = c.W<bf16>(WS_Q);
    float* H32 = c.W<float>(WS_H32); float* R32 = c.W<float>(WS_R32);

    if (threadIdx.x < 16) ((volatile LAS unsigned*)(c.lds + MISC_OFF))[threadIdx.x] = 0u;
    __syncthreads();
    const XcdBarrier xbar = xcd_barrier_post(c.W<unsigned>(WS_CTL), (volatile LAS unsigned*)(c.lds + MISC_OFF));
#define GSYNC() do { RF(); xcd_barrier(xbar, c.tid); } while (0)
    RF(); prologue(c);
    grid.sync();
    for (int layer = 0; layer < 4; ++layer) {
        if (layer <= 1) {
            const bf16* Wt = c.W<bf16>(layer == 0 ? WS_W_S5IN : WS_W_PIN);
            RF(); run_gemm(c, HB, D, 0, Wt, 1024, 1024, EpiBf16<0>{A0, D, nullptr, nullptr, nullptr});
        } else if (layer == 2) {
            RF(); run_gemm(c, HB, D, 0, c.W<bf16>(WS_W_CIN), 2048, 1024, EpiBf16<1>{Qb, 2048, c.in[c.z + 24], nullptr, nullptr});
        } else {
            RF(); run_gemm(c, HB, D, 0, c.W<bf16>(WS_W_SIN), NPROJ, 1024, EpiSsdProj{Qb, c.W<bf16>(WS_XBC), c.W<float>(WS_DT)});
        }
        GSYNC();
        const bf16* Aout = A2; const bf16* Wout;
        if (layer == 0) {
            for (int r = 0; r < PR_S5; ++r) { RF(); phase_s5scan(c); }
            GSYNC();
            RF(); run_gemm(c, A1, D, 0, c.W<bf16>(WS_W_S5GLU), 1024, 1024, EpiBf16<3>{A2, D, c.in[c.z + 17], nullptr, A1});
            Wout = c.W<bf16>(WS_W_S5OUT);
        } else if (layer == 1) {
            RF(); phase_pool(c);
            GSYNC();
            RF(); run_gemm(c, A1, D, 256, c.W<bf16>(WS_W_PGRP), 1024, 256, EpiBf16<2>{A2, D, nullptr, c.in[c.z + 21], nullptr});
            Wout = c.W<bf16>(WS_W_POUT);
        } else if (layer == 2) {
            RF(); phase_cmlp_ln(c);
            GSYNC();
            RF(); phase_cmlp_mix(c);
            Aout = A1; Wout = c.W<bf16>(WS_W_COUT);
        } else {
            RF(); phase_ssd_conv(c);
            GSYNC();
            for (int r = 0; r < PR_SSD; ++r) { RF(); phase_ssd_scan(c); }
            GSYNC();
            RF(); phase_ssd_gatenorm(c);
            Aout = c.W<bf16>(WS_YN); Wout = c.W<bf16>(WS_W_SOUT);
        }
        GSYNC();
        if (layer == 3) { RF(); run_gemm(c, Aout, 2048, 0, Wout, 1024, 2048, EpiResid{H32, R32}); }
        else { RF(); run_gemm(c, Aout, 1024, 0, Wout, 1024, 1024, EpiResid{H32, R32}); }
        GSYNC();
        RF(); phase_ln1(c, layer);
        if (layer > 0) { RF(); cvt_tables(c, layer); }
        GSYNC();
        RF(); run_gemm(c, HB, D, 0, c.W<bf16>(WS_W_PQ) + (size_t)layer * 2048 * 1024, 2048, 1024, EpiBf16<0>{Qb, 2048, nullptr, nullptr, nullptr});
        GSYNC();
        for (int r = 0; r < PR_ROUTE; ++r) { RF(); phase_route(c, layer); }
        GSYNC();
        for (int r = 1; r < PR_GATHER; ++r) { RF(); phase_gather(c, layer, true); }
        RF(); phase_gather(c, layer, false);
        GSYNC();
    }
}
}

extern "C" void kernel_launch(void* const* d_in, const int* in_sizes, int n_in, void* d_out, int out_size, void* d_ws, size_t ws_size, hipStream_t stream) {
    static int grid = 0;
    if (grid == 0) {
        int dev = 0, cus = 0, per_cu = 0;
        if (hipGetDevice(&dev) != hipSuccess || hipDeviceGetAttribute(&cus, hipDeviceAttributeMultiprocessorCount, dev) != hipSuccess) { fprintf(stderr, "kernel_launch: device query failed\n"); grid = -1; return; }
        if (hipFuncSetAttribute((const void*)mk::mega, hipFuncAttributeMaxDynamicSharedMemorySize, mk::LDS_BYTES) != hipSuccess) { fprintf(stderr, "kernel_launch: hipFuncSetAttribute failed\n"); grid = -1; return; }
        if (hipOccupancyMaxActiveBlocksPerMultiprocessor(&per_cu, (const void*)mk::mega, mk::NTHR, mk::LDS_BYTES) != hipSuccess || per_cu < 1) { fprintf(stderr, "kernel_launch: occupancy query says %d blocks per CU\n", per_cu); grid = -1; return; }
        grid = cus;
        if (ws_size < mk::WS_END) { fprintf(stderr, "kernel_launch: workspace too small (%zu < %zu)\n", ws_size, (size_t)mk::WS_END); grid = -1; return; }
    }
    if (grid < 0) return;
    mk::Params p{};
    for (int i = 0; i < 46; ++i) p.in[i] = (const float*)d_in[i];
    p.out = (float*)d_out; p.ws = (unsigned char*)d_ws;
    if (hipMemsetAsync((char*)d_ws + mk::WS_CTL, 0, mk::CTL_BYTES, stream) != hipSuccess) { fprintf(stderr, "kernel_launch: memset failed\n"); return; }
    void* args[] = {&p};
    hipError_t e = hipLaunchCooperativeKernel((const void*)mk::mega, dim3(grid), dim3(mk::NTHR), args, mk::LDS_BYTES, stream);
    if (e != hipSuccess) fprintf(stderr, "cooperative launch failed: %s (grid %d)\n", hipGetErrorString(e), grid);
}
```

```cpp
#include <hip/hip_runtime.h>
#include <hip/hip_cooperative_groups.h>
#include <cstdio>
#include <cstdint>
#include <math.h>
namespace cg = cooperative_groups;

namespace pg8 {
#define PG8_LAS __attribute__((address_space(3)))
typedef unsigned short bf16_t;
typedef short bf16x8 __attribute__((ext_vector_type(8)));
typedef float f32x4 __attribute__((ext_vector_type(4)));
typedef unsigned u32x4 __attribute__((ext_vector_type(4)));
constexpr int BM = 256, BK = 64, HALF = 128, HTB = HALF * BK * 2, STAGE_BYTES = 8 * HTB, NXCD = 8, WGM = 8;
__host__ __device__ __forceinline__ int lds_byte(int r, int c) { const int st = (r >> 4) * 2 + (c >> 5), rr = r & 15, cc = c & 31, ob = rr * 64 + cc * 2; return st * 1024 + (ob ^ (((ob >> 9) & 1) << 5)); }
__host__ __device__ __forceinline__ void stage_rc(int b, int& R, int& C) { const int st = b / 1024, sb = b % 1024, swz = sb ^ (((sb >> 9) & 1) << 5); R = (st >> 1) * 16 + swz / 64; C = (st & 1) * 32 + (swz % 64) / 2; }
__host__ __device__ __forceinline__ int perm32(int rho) { const int n = rho >> 4, i = rho & 15; return 8 * (i >> 2) + 4 * n + (i & 3); }
struct Unit { int pm, pn; };
struct Gemm { const bf16_t* A; const bf16_t* Bt; int M, N, K, lda, a_pn_off; };
struct StaticOrder {
    int nM, nN, nwg, G, c;
    __host__ __device__ void init(int M, int N, int G_, int c_) { nM = M / BM; nN = N / BM; nwg = nM * nN; G = G_; c = c_; }
    __host__ __device__ bool next(int i, Unit& u) const {
        const long L = (long)i * G + c; if (L >= nwg) return false;
        int wgid = (int)L; { const int q = nwg / NXCD, r = nwg % NXCD, xcd = wgid % NXCD, off = wgid / NXCD; wgid = (xcd < r ? xcd * (q + 1) : r * (q + 1) + (xcd - r) * q) + off; }
        const int nig = WGM * nN, gid = wgid / nig, fm = gid * WGM, gsz = (nM - fm) < WGM ? (nM - fm) : WGM;
        u.pm = fm + ((wgid % nig) % gsz); u.pn = (wgid % nig) / gsz; return true;
    }
    __device__ __forceinline__ void a_ready(const Unit&) const {}
    __device__ __forceinline__ void done(const Unit&) const {}
};
__device__ __forceinline__ unsigned rne1(float f) { unsigned u = __builtin_bit_cast(unsigned, f); return (u + 0x7fffu + ((u >> 16) & 1u)) >> 16; }
__device__ __forceinline__ unsigned cvt_pk_bf16(float lo, float hi) { return rne1(lo) | (rne1(hi) << 16); }
template <class Epi, class Sched, bool ALIGN_EPI = false, bool SP2 = false>
__device__ __forceinline__ void gemm_phase(PG8_LAS unsigned char* lds, const Gemm g, const Sched& S, const Epi& E, int tid_in) {
    int tid_ = tid_in; asm volatile("" : "+v"(tid_));
    const int tid = tid_, wid = __builtin_amdgcn_readfirstlane(tid >> 6), lane = tid & 63, wr = wid >> 2, wc = wid & 3, fr = lane & 15, fq = lane >> 4;
    const int K = g.K, nt = K / BK;
    unsigned voffA[2], voffB[2];
#pragma unroll
    for (int i = 0; i < 2; ++i) { int R, C; stage_rc(tid * 16 + i * 8192, R, C); const int Rb = Epi::PERM ? ((R & ~31) + perm32(R & 31)) : R;
        voffA[i] = (unsigned)(R * g.lda + C) * 2u; voffB[i] = (unsigned)(Rb * K + C) * 2u; }
    const size_t kstep = (size_t)(BK * 2);
    const size_t hstepA = (size_t)HALF * g.lda * 2, tstepA = 2 * hstepA;
    const size_t hstepB = (size_t)HALF * K * 2, tstepB = 2 * hstepB;
    const size_t apn = (size_t)g.a_pn_off * 2;
    const unsigned ldsw = (unsigned)wid * 1024u;
    const int aoff = lds_byte(wr * 64 + fr, fq * 8), boff = lds_byte(wc * 32 + fr, fq * 8);
#define PG8_SA(b, h) (((b) * 2 + (h)) * HTB)
#define PG8_SB(b, h) ((4 + (b) * 2 + (h)) * HTB)
#define PG8_STAGE(bufoff, gbase, voff) do { _Pragma("unroll") for (int _i = 0; _i < 2; ++_i) \
        __builtin_amdgcn_global_load_lds((const unsigned*)((const char*)(gbase) + (voff)[_i]), (PG8_LAS unsigned*)(lds + (bufoff) + ldsw + _i * 8192), 16, 0, 0); } while (0)
#define PG8_LDA(dst, b, h) do { _Pragma("unroll") for (int m = 0; m < 4; ++m) _Pragma("unroll") for (int k = 0; k < 2; ++k) dst[m][k] = *(const PG8_LAS bf16x8*)(lds + PG8_SA(b, h) + aoff + m * 2048 + k * 1024); } while (0)
#define PG8_LDB(dst, b, h) do { _Pragma("unroll") for (int n = 0; n < 2; ++n) _Pragma("unroll") for (int k = 0; k < 2; ++k) dst[n][k] = *(const PG8_LAS bf16x8*)(lds + PG8_SB(b, h) + boff + n * 2048 + k * 1024); } while (0)
#define PG8_MMA(ai, bj, At, Bt) do { __builtin_amdgcn_s_setprio(1); _Pragma("unroll") for (int m = 0; m < 4; ++m) _Pragma("unroll") for (int n = 0; n < 2; ++n) _Pragma("unroll") for (int k = 0; k < 2; ++k) \
        acc[ai][bj][m][n] = __builtin_amdgcn_mfma_f32_16x16x32_bf16(Bt[n][k], At[m][k], acc[ai][bj][m][n], 0, 0, 0); __builtin_amdgcn_s_setprio(0); } while (0)
#define PG8_WAIT_V(n) asm volatile("s_waitcnt vmcnt(" #n ")" ::: "memory")
#define PG8_WAIT_L(n) asm volatile("s_waitcnt lgkmcnt(" #n ")" ::: "memory")
#define PG8_BAR __builtin_amdgcn_s_barrier()
#define PG8_SCHED __builtin_amdgcn_sched_barrier(0)
    Unit cur, nxt; int ui = 0;
    if (!S.next(0, cur)) return;
    f32x4 acc[2][2][4][2];
#pragma unroll
    for (int a = 0; a < 2; ++a)
#pragma unroll
        for (int b = 0; b < 2; ++b)
#pragma unroll
            for (int m = 0; m < 4; ++m)
#pragma unroll
                for (int n = 0; n < 2; ++n) acc[a][b][m][n] = (f32x4){0.f, 0.f, 0.f, 0.f};
    bf16x8 At[4][2], B0[2][2], B1[2][2];
    const char* cA = (const char*)g.A + (size_t)cur.pm * tstepA + (size_t)cur.pn * apn; const char* cB = (const char*)g.Bt + (size_t)cur.pn * tstepB;
    S.a_ready(cur);
    if constexpr (SP2) {
        PG8_STAGE(PG8_SB(0, 0), cB, voffB); PG8_STAGE(PG8_SB(0, 1), cB + hstepB, voffB); PG8_STAGE(PG8_SA(0, 0), cA, voffA); PG8_STAGE(PG8_SA(0, 1), cA + hstepA, voffA);
        if (wr == 1) PG8_BAR;
        PG8_WAIT_V(2); PG8_BAR;
        PG8_STAGE(PG8_SB(1, 0), cB + kstep, voffB); PG8_STAGE(PG8_SA(1, 0), cA + kstep, voffA); PG8_STAGE(PG8_SB(1, 1), cB + hstepB + kstep, voffB);
        PG8_WAIT_V(6); PG8_BAR;
    } else {
        PG8_STAGE(PG8_SB(0, 0), cB, voffB); PG8_STAGE(PG8_SA(0, 0), cA, voffA); PG8_STAGE(PG8_SB(0, 1), cB + hstepB, voffB); PG8_STAGE(PG8_SA(0, 1), cA + hstepA, voffA);
        if (wr == 1) PG8_BAR;
        PG8_WAIT_V(4); PG8_BAR;
        PG8_STAGE(PG8_SB(1, 0), cB + kstep, voffB); PG8_STAGE(PG8_SA(1, 0), cA + kstep, voffA); PG8_STAGE(PG8_SB(1, 1), cB + hstepB + kstep, voffB);
        PG8_WAIT_V(6); PG8_BAR;
    }
    for (;;) {
        const bool has_next = S.next(ui + 1, nxt);
        const char* nA = has_next ? (const char*)g.A + (size_t)nxt.pm * tstepA + (size_t)nxt.pn * apn : cA; const char* nB = has_next ? (const char*)g.Bt + (size_t)nxt.pn * tstepB : cB;
#pragma nounroll
        for (int t = 0; t < nt; t += 2) {
            const bool last = (t == nt - 2);
            const char* a1 = cA + (size_t)(t + 1) * kstep;
            const char* a2 = last ? nA : cA + (size_t)(t + 2) * kstep; const char* b2 = last ? nB : cB + (size_t)(t + 2) * kstep;
            const char* a3 = a2 + kstep; const char* b3 = b2 + kstep;
            if (last && has_next) S.a_ready(nxt);
            if constexpr (SP2) {
            PG8_LDB(B0, 0, 0); PG8_LDB(B1, 0, 1); PG8_SCHED; PG8_LDA(At, 0, 0); PG8_STAGE(PG8_SA(1, 1), a1 + hstepA, voffA);
            PG8_WAIT_V(8); PG8_WAIT_L(0); PG8_BAR; PG8_MMA(0, 0, At, B0); PG8_MMA(0, 1, At, B1); PG8_BAR; PG8_SCHED;
            PG8_LDA(At, 0, 1); PG8_STAGE(PG8_SB(0, 0), b2, voffB); PG8_STAGE(PG8_SB(0, 1), b2 + hstepB, voffB); PG8_STAGE(PG8_SA(0, 0), a2, voffA);
            PG8_WAIT_V(8); PG8_WAIT_L(0); PG8_BAR; PG8_MMA(1, 0, At, B0); PG8_MMA(1, 1, At, B1); PG8_BAR; PG8_SCHED;
            PG8_LDB(B0, 1, 0); PG8_LDB(B1, 1, 1); PG8_SCHED; PG8_LDA(At, 1, 0); PG8_STAGE(PG8_SA(0, 1), a2 + hstepA, voffA);
            PG8_WAIT_V(8); PG8_WAIT_L(0); PG8_BAR; PG8_MMA(0, 0, At, B0); PG8_MMA(0, 1, At, B1); PG8_BAR; PG8_SCHED;
            PG8_LDA(At, 1, 1); PG8_STAGE(PG8_SB(1, 0), b3, voffB); PG8_STAGE(PG8_SB(1, 1), b3 + hstepB, voffB); PG8_STAGE(PG8_SA(1, 0), a3, voffA);
            PG8_WAIT_V(8); PG8_WAIT_L(0); PG8_BAR; PG8_MMA(1, 0, At, B0); PG8_MMA(1, 1, At, B1); PG8_BAR; PG8_SCHED;
            } else {
            PG8_LDB(B0, 0, 0); PG8_SCHED; PG8_LDA(At, 0, 0); PG8_STAGE(PG8_SA(1, 1), a1 + hstepA, voffA);
            PG8_WAIT_L(8); PG8_BAR; PG8_WAIT_L(0); PG8_MMA(0, 0, At, B0); PG8_BAR; PG8_SCHED;
            PG8_LDB(B1, 0, 1); PG8_STAGE(PG8_SB(0, 0), b2, voffB);
            PG8_BAR; PG8_WAIT_L(0); PG8_MMA(0, 1, At, B1); PG8_BAR;
            PG8_LDA(At, 0, 1); PG8_STAGE(PG8_SA(0, 0), a2, voffA);
            PG8_BAR; PG8_WAIT_L(0); PG8_MMA(1, 0, At, B0); PG8_BAR; PG8_SCHED;
            PG8_STAGE(PG8_SB(0, 1), b2 + hstepB, voffB);
            PG8_WAIT_V(6); PG8_BAR; PG8_MMA(1, 1, At, B1); PG8_BAR;
            PG8_LDB(B0, 1, 0); PG8_SCHED; PG8_LDA(At, 1, 0); PG8_STAGE(PG8_SA(0, 1), a2 + hstepA, voffA);
            PG8_WAIT_L(8); PG8_BAR; PG8_WAIT_L(0); PG8_MMA(0, 0, At, B0); PG8_BAR; PG8_SCHED;
            PG8_LDB(B1, 1, 1); PG8_STAGE(PG8_SB(1, 0), b3, voffB);
            PG8_BAR; PG8_WAIT_L(0); PG8_MMA(0, 1, At, B1); PG8_BAR;
            PG8_LDA(At, 1, 1); PG8_STAGE(PG8_SA(1, 0), a3, voffA);
            PG8_BAR; PG8_WAIT_L(0); PG8_MMA(1, 0, At, B0); PG8_BAR; PG8_SCHED;
            PG8_STAGE(PG8_SB(1, 1), b3 + hstepB, voffB);
            PG8_WAIT_V(6); PG8_BAR; PG8_MMA(1, 1, At, B1); PG8_BAR;
            }
        }
        if constexpr (ALIGN_EPI) { if (wr == 0) PG8_BAR; }
        if constexpr (!Epi::AFTER_DRAIN) { E(acc, cur, wr, wc, fr, fq); S.done(cur); }
        if (!has_next) break;
#pragma unroll
        for (int a = 0; a < 2; ++a)
#pragma unroll
            for (int b = 0; b < 2; ++b)
#pragma unroll
                for (int m = 0; m < 4; ++m)
#pragma unroll
                    for (int n = 0; n < 2; ++n) acc[a][b][m][n] = (f32x4){0.f, 0.f, 0.f, 0.f};
        cur = nxt; cA = nA; cB = nB; ++ui;
        if constexpr (ALIGN_EPI) { if (wr == 1) PG8_BAR; }
    }
    PG8_WAIT_V(0);
    if constexpr (!ALIGN_EPI) { if (wr == 0) PG8_BAR; }
    PG8_BAR;
    if constexpr (Epi::AFTER_DRAIN) { E.fused(acc, cur, wr, wc, fr, fq, lds, wid, lane); S.done(cur); }
#undef PG8_SA
#undef PG8_SB
#undef PG8_STAGE
#undef PG8_LDA
#undef PG8_LDB
#undef PG8_MMA
#undef PG8_WAIT_V
#undef PG8_WAIT_L
#undef PG8_BAR
#undef PG8_SCHED
}
}

#ifndef PR_GATHER
#define PR_GATHER 1
#endif
#ifndef PR_ROUTE
#define PR_ROUTE 1
#endif
#ifndef PR_S5
#define PR_S5 1
#endif
#ifndef PR_SSD
#define PR_SSD 1
#endif
#ifndef PR_GEMM
#define PR_GEMM 1
#endif
#ifndef PR_MISC
#define PR_MISC 1
#endif
namespace mk {
#define LAS __attribute__((address_space(3)))
typedef unsigned short bf16;
typedef unsigned v4u __attribute__((ext_vector_type(4)));
typedef unsigned v2u __attribute__((ext_vector_type(2)));
typedef float f32x4 __attribute__((ext_vector_type(4)));
typedef short bf16x8 __attribute__((ext_vector_type(8)));
using bf16x2 = __attribute__((ext_vector_type(2))) __bf16;

constexpr int D = 1024, T = 17408, TP = 16384, NWAVES = 8, NTHR = 512;
constexpr float ALPHA = 1.6817928305074290f;
constexpr float LN_EPS = 1e-5f, RMS_EPS = 1e-5f;
constexpr int LDS_BYTES = 160 * 1024;
constexpr int NPROJ = 5376, CONVD = 3072;

constexpr size_t MiB = 1u << 20;
constexpr size_t WS_W_S5IN = 0, WS_W_S5GLU = 2 * MiB, WS_W_S5OUT = 4 * MiB, WS_W_PIN = 6 * MiB, WS_W_PGRP = 8 * MiB, WS_W_POUT = 9 * MiB,
                 WS_W_CIN = 11 * MiB, WS_W_COUT = 15 * MiB, WS_W_SIN = 17 * MiB  , WS_W_SOUT = 28 * MiB, WS_W_PQ = 32 * MiB  ,
                 WS_KEYS = 48 * MiB  , WS_SMALL = 50 * MiB, WS_CTL = 52 * MiB  ;
constexpr size_t CTL_BYTES = 16384;
constexpr int MISC_OFF = LDS_BYTES - 64;
constexpr size_t WS_EU = 64 * MiB, WS_EV = 96 * MiB;
constexpr size_t WS_H32 = 128 * MiB, WS_R32 = 196 * MiB, WS_HB = 264 * MiB, WS_A0 = 298 * MiB, WS_A1 = 332 * MiB, WS_A2 = 366 * MiB;
constexpr size_t WS_Q = 400 * MiB  , WS_IDX = 468 * MiB  , WS_GATE = 477 * MiB  , WS_DT = 486 * MiB  ;
constexpr size_t WS_XBC = 490 * MiB  , WS_XC = 592 * MiB  , WS_Y = 694 * MiB  , WS_YN = 762 * MiB  , WS_SCU = 830 * MiB  , WS_END = 839 * MiB;
constexpr size_t SM_LBR = 0, SM_LBI = 4096, SM_BBR = 8192, SM_BBI = 8192 + 65536, SM_ISU = 8192 + 131072, SM_ISV = SM_ISU + 16384;

struct Params { const float* in[46]; float* out; unsigned char* ws; };

__device__ __forceinline__ unsigned f2bf(float f) { unsigned u = __builtin_bit_cast(unsigned, f); return (u + 0x7fffu + ((u >> 16) & 1u)) >> 16; }
__device__ __forceinline__ unsigned f2bf_fast(float f) { return (__builtin_bit_cast(unsigned, f) + 0x8000u) >> 16; }
__device__ __forceinline__ unsigned pk2(float lo, float hi) { return pg8::cvt_pk_bf16(lo, hi); }
__device__ __forceinline__ float bflo(unsigned w) { return __builtin_bit_cast(float, w << 16); }
__device__ __forceinline__ float bfhi(unsigned w) { return __builtin_bit_cast(float, w & 0xffff0000u); }
__device__ __forceinline__ float bf2f(bf16 b) { return __builtin_bit_cast(float, ((unsigned)b) << 16); }
__device__ __forceinline__ float sigmoid_f(float x) { return __builtin_amdgcn_rcpf(1.f + __expf(-x)); }
__device__ __forceinline__ float silu_f(float x) { return x * sigmoid_f(x); }
__device__ __forceinline__ float gelu_f(float x) { return x * sigmoid_f(1.5957691216057308f * (x + 0.044715f * x * x * x)); }
template <int O> __device__ __forceinline__ float shx_c(float v, int lane) {
    const int iv = __builtin_bit_cast(int, v);
    if constexpr (O == 1) return __builtin_bit_cast(float, __builtin_amdgcn_update_dpp(0, iv, 0xB1, 0xf, 0xf, false));
    else if constexpr (O == 2) return __builtin_bit_cast(float, __builtin_amdgcn_update_dpp(0, iv, 0x4E, 0xf, 0xf, false));
    else if constexpr (O == 4) { const int a = __builtin_amdgcn_update_dpp(iv, iv, 0x104, 0xf, 0x5, false); return __builtin_bit_cast(float, __builtin_amdgcn_update_dpp(a, iv, 0x114, 0xf, 0xA, false)); }
    else if constexpr (O == 8) return __builtin_bit_cast(float, __builtin_amdgcn_update_dpp(0, iv, 0x128, 0xf, 0xf, false));
    else if constexpr (O < 32) return __builtin_bit_cast(float, __builtin_amdgcn_ds_swizzle(iv, (O << 10) | 0x1f));
    else return __builtin_bit_cast(float, __builtin_amdgcn_ds_bpermute((lane ^ O) << 2, iv));
}
__device__ __forceinline__ float shx(float v, int o, int lane) {
    switch (o) { case 1: return shx_c<1>(v, lane); case 2: return shx_c<2>(v, lane); case 4: return shx_c<4>(v, lane); case 8: return shx_c<8>(v, lane); case 16: return shx_c<16>(v, lane); default: return shx_c<32>(v, lane); }
}
__device__ __forceinline__ float wave_sum(float v, int lane) {
    v += shx_c<32>(v, lane); v += shx_c<16>(v, lane); v += shx_c<8>(v, lane); v += shx_c<4>(v, lane); v += shx_c<2>(v, lane); v += shx_c<1>(v, lane);
    return v;
}
__device__ __forceinline__ float dot2(unsigned w, unsigned x, float acc) { return __builtin_amdgcn_fdot2_f32_bf16(__builtin_bit_cast(bf16x2, w), __builtin_bit_cast(bf16x2, x), acc, false); }
__device__ __forceinline__ float reduce16(const float (&p)[16], int lane) {
    const bool b5 = lane & 32, b4 = lane & 16, b3 = lane & 8, b2 = lane & 4;
    float q[8], r[4], s[2], t;
#pragma unroll
    for (int i = 0; i < 8; ++i) { const float keep = b5 ? p[i + 8] : p[i], send = b5 ? p[i] : p[i + 8]; q[i] = keep + shx(send, 32, lane); }
#pragma unroll
    for (int i = 0; i < 4; ++i) { const float keep = b4 ? q[i + 4] : q[i], send = b4 ? q[i] : q[i + 4]; r[i] = keep + shx(send, 16, lane); }
#pragma unroll
    for (int i = 0; i < 2; ++i) { const float keep = b3 ? r[i + 2] : r[i], send = b3 ? r[i] : r[i + 2]; s[i] = keep + shx(send, 8, lane); }
    { const float keep = b2 ? s[1] : s[0], send = b2 ? s[0] : s[1]; t = keep + shx(send, 4, lane); }
    t += shx(t, 2, lane); t += shx(t, 1, lane);
    return t;
}
template <int CTRL> __device__ __forceinline__ float dppf(float v) { return __builtin_bit_cast(float, __builtin_amdgcn_update_dpp(0, __builtin_bit_cast(int, v), CTRL, 0xf, 0xf, false)); }
__device__ __forceinline__ float reduce8d(const float (&p)[8], int lane) {
    const bool b2 = lane & 4, b1 = lane & 2, b0 = lane & 1;
    float q[4], r[2], t;
#pragma unroll
    for (int i = 0; i < 4; ++i) { const float keep = b2 ? p[i + 4] : p[i], send = b2 ? p[i] : p[i + 4]; q[i] = keep + dppf<0x141>(send); }
#pragma unroll
    for (int i = 0; i < 2; ++i) { const float keep = b1 ? q[i + 2] : q[i], send = b1 ? q[i] : q[i + 2]; r[i] = keep + dppf<0x4E>(send); }
    { const float keep = b0 ? r[1] : r[0], send = b0 ? r[0] : r[1]; t = keep + dppf<0xB1>(send); }
    t += dppf<0x128>(t);
    t += shx_c<16>(t, lane); t += shx_c<32>(t, lane);
    return t;
}
__device__ __forceinline__ float reduce16d(const float (&p)[16], int lane) {
    const bool b3 = lane & 8, b2 = lane & 4, b1 = lane & 2, b0 = lane & 1;
    float o[8], q[4], r[2], t;
#pragma unroll
    for (int i = 0; i < 8; ++i) { const float keep = b3 ? p[i + 8] : p[i], send = b3 ? p[i] : p[i + 8]; o[i] = keep + dppf<0x128>(send); }
#pragma unroll
    for (int i = 0; i < 4; ++i) { const float keep = b2 ? o[i + 4] : o[i], send = b2 ? o[i] : o[i + 4]; q[i] = keep + dppf<0x141>(send); }
#pragma unroll
    for (int i = 0; i < 2; ++i) { const float keep = b1 ? q[i + 2] : q[i], send = b1 ? q[i] : q[i + 2]; r[i] = keep + dppf<0x4E>(send); }
    { const float keep = b0 ? r[1] : r[0], send = b0 ? r[0] : r[1]; t = keep + dppf<0xB1>(send); }
    t += shx_c<16>(t, lane); t += shx_c<32>(t, lane);
    return t;
}
__device__ __forceinline__ float reduce8(const float (&p)[8], int lane) {
    const bool b5 = lane & 32, b4 = lane & 16, b3 = lane & 8;
    float q[4], r[2], t;
#pragma unroll
    for (int i = 0; i < 4; ++i) { const float keep = b5 ? p[i + 4] : p[i], send = b5 ? p[i] : p[i + 4]; q[i] = keep + shx(send, 32, lane); }
#pragma unroll
    for (int i = 0; i < 2; ++i) { const float keep = b4 ? q[i + 2] : q[i], send = b4 ? q[i] : q[i + 2]; r[i] = keep + shx(send, 16, lane); }
    { const float keep = b3 ? r[1] : r[0], send = b3 ? r[0] : r[1]; t = keep + shx(send, 8, lane); }
    t += shx(t, 4, lane); t += shx(t, 2, lane); t += shx(t, 1, lane);
    return t;
}
__device__ __forceinline__ void seq_info(int s, int& tok0, int& L) { if (s < 8) { tok0 = s << 11; L = 2048; } else { tok0 = TP + ((s - 8) << 3); L = 8; } }
__device__ __forceinline__ void tok_info(int t, int& s, int& l, int& tok0) {
    if (t < TP) { s = t >> 11; l = t & 2047; tok0 = s << 11; } else { const int b = (t - TP) >> 3; s = 8 + b; l = (t - TP) & 7; tok0 = TP + (b << 3); }
}

template <int MODE> struct EpiBf16 {
    static constexpr bool PERM = true, AFTER_DRAIN = false;
    bf16* O; int ldc; const float* bias; const float* scale; const bf16* G;
    __device__ __forceinline__ void operator()(const pg8::f32x4 (&acc)[2][2][4][2], const pg8::Unit& u, int wr, int wc, int fr_, int fq_) const {
        int fr = fr_, fq = fq_; asm volatile("" : "+v"(fr), "+v"(fq));
        const int row0 = u.pm * 256 + wr * 64 + fr, col0 = u.pn * 256 + wc * 32 + 8 * fq;
        f32x4 bv[2][2], sv[2][2];
#pragma unroll
        for (int bj = 0; bj < 2; ++bj)
#pragma unroll
            for (int n = 0; n < 2; ++n) {
                bv[bj][n] = bias ? *(const f32x4*)(bias + col0 + bj * 128 + 4 * n) : (f32x4){0.f, 0.f, 0.f, 0.f};
                sv[bj][n] = (MODE == 2) ? *(const f32x4*)(scale + col0 + bj * 128 + 4 * n) : (f32x4){1.f, 1.f, 1.f, 1.f};
            }
#pragma unroll
        for (int ai = 0; ai < 2; ++ai)
#pragma unroll
            for (int m = 0; m < 4; ++m) {
                const size_t roff = (size_t)(row0 + ai * 128 + m * 16) * ldc + col0;
#pragma unroll
                for (int bj = 0; bj < 2; ++bj) {
                    f32x4 v0 = acc[ai][bj][m][0] + bv[bj][0], v1 = acc[ai][bj][m][1] + bv[bj][1];
                    if (MODE == 1) {
#pragma unroll
                        for (int j = 0; j < 4; ++j) { v0[j] = gelu_f(v0[j]); v1[j] = gelu_f(v1[j]); }
                    }
                    if (MODE == 2) { v0 = v0 * sv[bj][0]; v1 = v1 * sv[bj][1]; }
                    if (MODE == 3) {
                        const v4u gw = *(const v4u*)(G + roff + bj * 128);
                        v0[0] = bflo(gw.x) * sigmoid_f(v0[0]); v0[1] = bfhi(gw.x) * sigmoid_f(v0[1]); v0[2] = bflo(gw.y) * sigmoid_f(v0[2]); v0[3] = bfhi(gw.y) * sigmoid_f(v0[3]);
                        v1[0] = bflo(gw.z) * sigmoid_f(v1[0]); v1[1] = bfhi(gw.z) * sigmoid_f(v1[1]); v1[2] = bflo(gw.w) * sigmoid_f(v1[2]); v1[3] = bfhi(gw.w) * sigmoid_f(v1[3]);
                    }
                    v4u w; w.x = pk2(v0[0], v0[1]); w.y = pk2(v0[2], v0[3]); w.z = pk2(v1[0], v1[1]); w.w = pk2(v1[2], v1[3]);
                    *(v4u*)(O + roff + bj * 128) = w;
                }
            }
    }
    __device__ __forceinline__ void store4(int row, int col, f32x4 v) const {
        if (bias) v = v + *(const f32x4*)(bias + col);
        if (MODE == 1) { v[0] = gelu_f(v[0]); v[1] = gelu_f(v[1]); v[2] = gelu_f(v[2]); v[3] = gelu_f(v[3]); }
        if (MODE == 2) v = v * *(const f32x4*)(scale + col);
        if (MODE == 3) { const v2u gw = *(const v2u*)(G + (size_t)row * ldc + col);
            v[0] = bflo(gw.x) * sigmoid_f(v[0]); v[1] = bfhi(gw.x) * sigmoid_f(v[1]); v[2] = bflo(gw.y) * sigmoid_f(v[2]); v[3] = bfhi(gw.y) * sigmoid_f(v[3]); }
        v2u w; w.x = pk2(v[0], v[1]); w.y = pk2(v[2], v[3]);
        *(v2u*)(O + (size_t)row * ldc + col) = w;
    }
};
struct EpiResid {
    static constexpr bool PERM = false, AFTER_DRAIN = false;
    const float* H; float* R;
    __device__ __forceinline__ void operator()(const pg8::f32x4 (&acc)[2][2][4][2], const pg8::Unit& u, int wr, int wc, int fr_, int fq_) const {
        int fr = fr_, fq = fq_; asm volatile("" : "+v"(fr), "+v"(fq));
        const int row0 = u.pm * 256 + wr * 64 + fr, col0 = u.pn * 256 + wc * 32 + 4 * fq;
#pragma unroll
        for (int ai = 0; ai < 2; ++ai)
#pragma unroll
            for (int m = 0; m < 4; ++m) {
                const size_t roff = (size_t)(row0 + ai * 128 + m * 16) * D + col0;
#pragma unroll
                for (int bj = 0; bj < 2; ++bj)
#pragma unroll
                    for (int n = 0; n < 2; ++n) {
                        const f32x4 hv = *(const f32x4*)(H + roff + bj * 128 + n * 16);
                        *(f32x4*)(R + roff + bj * 128 + n * 16) = hv * ALPHA + acc[ai][bj][m][n];
                    }
            }
    }
    __device__ __forceinline__ void store4(int row, int col, f32x4 v) const {
        *(f32x4*)(R + (size_t)row * D + col) = *(const f32x4*)(H + (size_t)row * D + col) * ALPHA + v;
    }
};
struct EpiSsdProj {
    static constexpr bool PERM = true, AFTER_DRAIN = false;
    bf16* Z; bf16* XBC; float* DT;
    __device__ __forceinline__ void operator()(const pg8::f32x4 (&acc)[2][2][4][2], const pg8::Unit& u, int wr, int wc, int fr_, int fq_) const {
        int fr = fr_, fq = fq_; asm volatile("" : "+v"(fr), "+v"(fq));
        const int row0 = u.pm * 256 + wr * 64 + fr, col0 = u.pn * 256 + wc * 32 + 8 * fq;
#pragma unroll
        for (int ai = 0; ai < 2; ++ai)
#pragma unroll
            for (int m = 0; m < 4; ++m) {
                const size_t row = (size_t)(row0 + ai * 128 + m * 16);
#pragma unroll
                for (int bj = 0; bj < 2; ++bj) {
                    const f32x4 v0 = acc[ai][bj][m][0], v1 = acc[ai][bj][m][1];
                    const int col = col0 + bj * 128;
                    if (u.pn < 20) {
                        v4u w; w.x = pk2(v0[0], v0[1]); w.y = pk2(v0[2], v0[3]); w.z = pk2(v1[0], v1[1]); w.w = pk2(v1[2], v1[3]);
                        if (u.pn < 8) *(v4u*)(Z + row * 2048 + col) = w; else *(v4u*)(XBC + row * CONVD + (col - 2048)) = w;
                    } else if (col - 5120 < 32) {
                        *(f32x4*)(DT + row * 32 + (col - 5120)) = v0; *(f32x4*)(DT + row * 32 + (col - 5120) + 4) = v1;
                    }
                }
            }
    }
};

struct Ctx {
    const float* const* in; float* out; unsigned char* ws; LAS unsigned char* lds;
    int tid, lane, wave, gw, NGW, gt, NGT, bid, nblk;
    int z;
    template <class Tp> __device__ __forceinline__ Tp* W(size_t off) const { return (Tp*)(ws + (off + (size_t)(unsigned)z)); }
};

template <class Epi> __device__ __forceinline__ void run_gemm_m(const Ctx& c, int M, const bf16* A, int lda, int a_pn_off, const bf16* Bt, int N, int K, const Epi& E) {
    pg8::Gemm g{A, Bt, M, N, K, lda, a_pn_off};
    pg8::StaticOrder S; S.init(M, N, c.nblk, c.bid);
    for (int r = 0; r < PR_GEMM; ++r) pg8::gemm_phase<Epi, pg8::StaticOrder, true, true>(c.lds, g, S, E, c.tid);
}
constexpr int SG_LD = 136, SG_TILE = 64 * SG_LD * 2;
template <class Epi> __device__ __forceinline__ void small_gemm(const Ctx& c, const bf16* A, int lda, int a_pn_off, const bf16* Bt, int N, int K, const Epi& E) {
    int ln = c.lane; asm volatile("" : "+v"(ln));
    const int fr = ln & 15, fq = ln >> 4, w = c.wave, tid = w * 64 + ln;
    const int nct = N >> 6, ntiles = 16 * nct, nkt = K >> 7;
    const int r0 = tid >> 4, cc = tid & 15;
    LAS unsigned char* lds = c.lds;
    for (int tau = c.bid; tau < ntiles; tau += c.nblk) {
        const int mt = tau / nct, nt = tau - mt * nct, row0 = TP + mt * 64, col0 = nt * 64;
        const bf16* ap = A + (size_t)(row0 + r0) * lda + (size_t)(col0 >> 8) * a_pn_off + cc * 8;
        const bf16* bp = Bt + (size_t)(col0 + r0) * K + cc * 8;
        const size_t a32 = (size_t)32 * lda, b32 = (size_t)32 * K;
        v4u ra[2][2], rb[2][2];
        f32x4 acc0 = {0.f, 0.f, 0.f, 0.f}, acc1 = {0.f, 0.f, 0.f, 0.f};
#define SG_LOAD(st, kt) do { ra[st][0] = *(const v4u*)(ap + (kt) * 128); ra[st][1] = *(const v4u*)(ap + a32 + (kt) * 128); rb[st][0] = *(const v4u*)(bp + (kt) * 128); rb[st][1] = *(const v4u*)(bp + b32 + (kt) * 128); } while (0)
#define SG_WRITE(st, buf) do { LAS unsigned char* d_ = lds + (buf) * 2 * SG_TILE + (r0 * SG_LD + cc * 8) * 2; \
            *(LAS v4u*)(d_) = ra[st][0]; *(LAS v4u*)(d_ + 32 * SG_LD * 2) = ra[st][1]; *(LAS v4u*)(d_ + SG_TILE) = rb[st][0]; *(LAS v4u*)(d_ + SG_TILE + 32 * SG_LD * 2) = rb[st][1]; } while (0)
#define SG_COMPUTE(buf) do { const LAS unsigned char* a_ = lds + (buf) * 2 * SG_TILE + (((w >> 1) * 16 + fr) * SG_LD + 8 * fq) * 2; \
            const LAS unsigned char* b_ = lds + (buf) * 2 * SG_TILE + SG_TILE + (((w & 1) * 32 + fr) * SG_LD + 8 * fq) * 2; \
            _Pragma("unroll") for (int ks = 0; ks < 4; ++ks) { const bf16x8 af = *(const LAS bf16x8*)(a_ + ks * 64); \
                acc0 = __builtin_amdgcn_mfma_f32_16x16x32_bf16(*(const LAS bf16x8*)(b_ + ks * 64), af, acc0, 0, 0, 0); \
                acc1 = __builtin_amdgcn_mfma_f32_16x16x32_bf16(*(const LAS bf16x8*)(b_ + 16 * SG_LD * 2 + ks * 64), af, acc1, 0, 0, 0); } } while (0)
        SG_LOAD(0, 0);
        if (nkt > 1) SG_LOAD(1, 1);
        __syncthreads();
        SG_WRITE(0, 0);
        __syncthreads();
        for (int kt = 0; kt < nkt; kt += 2) {
            if (kt + 2 < nkt) SG_LOAD(0, kt + 2);
            SG_COMPUTE(0);
            if (kt + 1 < nkt) {
                SG_WRITE(1, 1);
                __syncthreads();
                if (kt + 3 < nkt) SG_LOAD(1, kt + 3);
                SG_COMPUTE(1);
                if (kt + 2 < nkt) { __syncthreads(); SG_WRITE(0, 0); __syncthreads(); }
            }
        }
#undef SG_LOAD
#undef SG_WRITE
#undef SG_COMPUTE
        E.store4(row0 + (w >> 1) * 16 + fr, col0 + (w & 1) * 32 + 4 * fq, acc0);
        E.store4(row0 + (w >> 1) * 16 + fr, col0 + (w & 1) * 32 + 16 + 4 * fq, acc1);
    }
    __syncthreads();
}
template <class Epi> __device__ __forceinline__ void run_gemm(const Ctx& c, const bf16* A, int lda, int a_pn_off, const bf16* Bt, int N, int K, const Epi& E) {
    run_gemm_m(c, TP, A, lda, a_pn_off, Bt, N, K, E);
    small_gemm(c, A, lda, a_pn_off, Bt, N, K, E);
}
template <class Epi> __device__ __forceinline__ void run_gemm_all(const Ctx& c, const bf16* A, int lda, int a_pn_off, const bf16* Bt, int N, int K, const Epi& E) {
    run_gemm_m(c, T, A, lda, a_pn_off, Bt, N, K, E);
}

__device__ __forceinline__ void transpose_item(const float* __restrict__ Wm, int K, int N, bf16* WT, LAS float* scr, int item, int lane) {
    const int nblk = N / 32, kb = item / nblk, nb = item % nblk, k0 = 64 * kb, n0 = 32 * nb;
#pragma unroll 8
    for (int i = 0; i < 32; ++i) { const int kk = 2 * i + (lane >> 5); scr[kk * 33 + (lane & 31)] = Wm[(size_t)(k0 + kk) * N + n0 + (lane & 31)]; }
    asm volatile("s_waitcnt lgkmcnt(0)" ::: "memory");
    const int cc = lane & 7;
#pragma unroll
    for (int j = 0; j < 4; ++j) {
        const int n = (lane >> 3) + 8 * j; const LAS float* s = scr + (8 * cc) * 33 + n;
        v4u o; o.x = pk2(s[0 * 33], s[1 * 33]); o.y = pk2(s[2 * 33], s[3 * 33]); o.z = pk2(s[4 * 33], s[5 * 33]); o.w = pk2(s[6 * 33], s[7 * 33]);
        *(v4u*)(WT + (size_t)(n0 + n) * K + k0 + 8 * cc) = o;
    }
    asm volatile("s_waitcnt lgkmcnt(0)" ::: "memory");
}
__device__ __forceinline__ void transpose_mat(const Ctx& c, const float* Wm, int K, int N, bf16* WT, int& base) {
    LAS float* scr = (LAS float*)(c.lds + c.wave * 16384);
    const int nitems = (K / 64) * (N / 32);
    int first = c.gw - (base % c.NGW); if (first < 0) first += c.NGW;
    for (int it = first; it < nitems; it += c.NGW) transpose_item(Wm, K, N, WT, scr, it, c.lane);
    base += nitems;
}
__device__ __forceinline__ void cvt_copy(const Ctx& c, const float* __restrict__ src, bf16* dst, size_t n) {
    for (size_t i = (size_t)c.gt * 8; i < n; i += (size_t)c.NGT * 8) {
        const f32x4 a = *(const f32x4*)(src + i), b = *(const f32x4*)(src + i + 4);
        v4u w; w.x = pk2(a[0], a[1]); w.y = pk2(a[2], a[3]); w.z = pk2(b[0], b[1]); w.w = pk2(b[2], b[3]);
        *(v4u*)(dst + i) = w;
    }
}
__device__ __forceinline__ float wave_max(float v, int lane) {
    v = fmaxf(v, shx_c<32>(v, lane)); v = fmaxf(v, shx_c<16>(v, lane)); v = fmaxf(v, shx_c<8>(v, lane)); v = fmaxf(v, shx_c<4>(v, lane)); v = fmaxf(v, shx_c<2>(v, lane)); v = fmaxf(v, shx_c<1>(v, lane));
    return v;
}
typedef float v16f __attribute__((ext_vector_type(16)));
typedef float v32f __attribute__((ext_vector_type(32)));
typedef unsigned v6u __attribute__((ext_vector_type(6)));
constexpr int EROW = 768, VROW = 512;
#ifndef FP6_PACK_INTERLEAVED
#define FP6_PACK_INTERLEAVED 1
#endif
typedef unsigned v3u __attribute__((ext_vector_type(3)));
__device__ __forceinline__ unsigned fp4_pack8(const f32x4 lo, const f32x4 hi, const float q) {
    unsigned d = 0;
    d = __builtin_amdgcn_cvt_scalef32_pk_fp4_f32(d, lo[0] * q, lo[1] * q, 1.0f, 0);
    d = __builtin_amdgcn_cvt_scalef32_pk_fp4_f32(d, lo[2] * q, lo[3] * q, 1.0f, 1);
    d = __builtin_amdgcn_cvt_scalef32_pk_fp4_f32(d, hi[0] * q, hi[1] * q, 1.0f, 2);
    d = __builtin_amdgcn_cvt_scalef32_pk_fp4_f32(d, hi[2] * q, hi[3] * q, 1.0f, 3);
    return d;
}
__device__ __forceinline__ void cvt_tables(const Ctx& c, int layer) {
    float* sm = c.W<float>(WS_SMALL);
    const int lane = c.lane;
    f32x4 na[4], nb[4];
    {
        const int r0 = 2 * c.gw, tb = r0 >> 14, row = r0 & 16383;
        const float* src = c.in[c.z + 44 + tb] + ((size_t)layer * 16384 + row) * D + 16 * lane;
#pragma unroll
        for (int k = 0; k < 4; ++k) { na[k] = *(const f32x4*)(src + 4 * k); nb[k] = *(const f32x4*)(src + D + 4 * k); }
    }
    for (int rp = c.gw; rp < 16384; rp += c.NGW) {
        const int r0 = 2 * rp, tb = r0 >> 14, row = r0 & 16383;
        f32x4 va[4], vb[4];
#pragma unroll
        for (int k = 0; k < 4; ++k) { va[k] = na[k]; vb[k] = nb[k]; }
        if (rp + c.NGW < 16384) {
            const int r1 = 2 * (rp + c.NGW), tb1 = r1 >> 14, row1 = r1 & 16383;
            const float* src1 = c.in[c.z + 44 + tb1] + ((size_t)layer * 16384 + row1) * D + 16 * lane;
#pragma unroll
            for (int k = 0; k < 4; ++k) { na[k] = *(const f32x4*)(src1 + 4 * k); nb[k] = *(const f32x4*)(src1 + D + 4 * k); }
        }
        float ma = 0.f, mb = 0.f;
#pragma unroll
        for (int k = 0; k < 4; ++k) {
            ma = fmaxf(fmaxf(fmaxf(fabsf(va[k][0]), fabsf(va[k][1])), fmaxf(fabsf(va[k][2]), fabsf(va[k][3]))), ma);
            mb = fmaxf(fmaxf(fmaxf(fabsf(vb[k][0]), fabsf(vb[k][1])), fmaxf(fabsf(vb[k][2]), fabsf(vb[k][3]))), mb);
        }
        ma = fmaxf(wave_max(ma, lane), 1e-30f); mb = fmaxf(wave_max(mb, lane), 1e-30f);
        if (tb) {
            const float qa = 6.0f / ma, qb = 6.0f / mb;
            const unsigned a0 = fp4_pack8(va[0], va[1], qa), a1 = fp4_pack8(va[2], va[3], qa), b0 = fp4_pack8(vb[0], vb[1], qb), b1 = fp4_pack8(vb[2], vb[3], qb);
            unsigned char* dv = c.ws + WS_EV + (size_t)row * VROW + 8 * lane;
            *(v2u*)(dv) = (v2u){a0, a1};
            *(v2u*)(dv + VROW) = (v2u){b0, b1};
            if (lane == 0) { sm[SM_ISV + row] = ma * (1.0f / 6.0f); sm[SM_ISV + row + 1] = mb * (1.0f / 6.0f); }
            continue;
        }
        const float sa = __builtin_bit_cast(float, __builtin_bit_cast(unsigned, 7.5f / ma) & 0xff800000u);
        const float sb = __builtin_bit_cast(float, __builtin_bit_cast(unsigned, 7.5f / mb) & 0xff800000u);
        float F[32];
#pragma unroll
        for (int k = 0; k < 4; ++k) {
#pragma unroll
            for (int j = 0; j < 4; ++j) { F[4 * k + j] = va[k][j] * sa; F[16 + 4 * k + j] = vb[k][j] * sb; }
        }
        v16f a, b;
#pragma unroll
        for (int i = 0; i < 16; ++i) { a[i] = FP6_PACK_INTERLEAVED ? F[2 * i] : F[i]; b[i] = FP6_PACK_INTERLEAVED ? F[2 * i + 1] : F[16 + i]; }
        const v6u pk = __builtin_amdgcn_cvt_scalef32_2xpk16_fp6_f32(a, b, 1.0f);
        unsigned char* dst = c.ws + (tb ? WS_EV : WS_EU) + (size_t)row * EROW + 12 * lane;
        *(v3u*)(dst) = (v3u){pk[0], pk[1], pk[2]};
        *(v3u*)(dst + EROW) = (v3u){pk[3], pk[4], pk[5]};
        if (lane == 0) { sm[(tb ? SM_ISV : SM_ISU) + row] = 1.0f / sa; sm[(tb ? SM_ISV : SM_ISU) + row + 1] = 1.0f / sb; }
    }
}
__device__ __forceinline__ void prologue(const Ctx& c) {
    int tb_ = 0;
    transpose_mat(c, c.in[c.z + 7], 1024, 1024, c.W<bf16>(WS_W_S5IN), tb_);
    transpose_mat(c, c.in[c.z + 16], 1024, 1024, c.W<bf16>(WS_W_S5GLU), tb_);
    transpose_mat(c, c.in[c.z + 18], 1024, 1024, c.W<bf16>(WS_W_S5OUT), tb_);
    transpose_mat(c, c.in[c.z + 19], 1024, 1024, c.W<bf16>(WS_W_PIN), tb_);
    for (int g = 0; g < 4; ++g) transpose_mat(c, c.in[c.z + 20] + (size_t)g * 65536, 256, 256, c.W<bf16>(WS_W_PGRP) + (size_t)g * 65536, tb_);
    transpose_mat(c, c.in[c.z + 22], 1024, 1024, c.W<bf16>(WS_W_POUT), tb_);
    transpose_mat(c, c.in[c.z + 23], 1024, 2048, c.W<bf16>(WS_W_CIN), tb_);
    transpose_mat(c, c.in[c.z + 29], 1024, 1024, c.W<bf16>(WS_W_COUT), tb_);
    transpose_mat(c, c.in[c.z + 30], 1024, 5152, c.W<bf16>(WS_W_SIN), tb_);
    transpose_mat(c, c.in[c.z + 37], 2048, 1024, c.W<bf16>(WS_W_SOUT), tb_);
    for (int l = 0; l < 4; ++l) transpose_mat(c, c.in[c.z + 42] + (size_t)l * 1024 * 2048, 1024, 2048, c.W<bf16>(WS_W_PQ) + (size_t)l * 2048 * 1024, tb_);
    {
        v4u* z = (v4u*)(c.W<bf16>(WS_W_SIN) + (size_t)5152 * 1024);
        for (int i = c.gt; i < 224 * 1024 / 8; i += c.NGT) z[i] = (v4u){0u, 0u, 0u, 0u};
    }
    cvt_copy(c, c.in[c.z + 43], c.W<bf16>(WS_KEYS), (size_t)4 * 8 * 2 * 128 * 128);
    {
        bf16* HB = c.W<bf16>(WS_HB);
        const size_t NP = (size_t)T * D / 8, stride = (size_t)c.NGT;
        for (size_t i0 = (size_t)c.gt; i0 < NP; i0 += 4 * stride) {
            f32x4 a[4], b[4];
#pragma unroll
            for (int u = 0; u < 4; ++u) {
                const size_t i = (i0 + u * stride) * 8;
                if (i0 + u * stride < NP) { const float* src = (i < (size_t)TP * D) ? (c.in[c.z + 0] + i) : (c.in[c.z + 1] + (i - (size_t)TP * D)); a[u] = *(const f32x4*)(src); b[u] = *(const f32x4*)(src + 4); }
            }
#pragma unroll
            for (int u = 0; u < 4; ++u) {
                if (i0 + u * stride < NP) {
                    v4u w; w.x = pk2(a[u][0], a[u][1]); w.y = pk2(a[u][2], a[u][3]); w.z = pk2(b[u][0], b[u][1]); w.w = pk2(b[u][2], b[u][3]);
                    *(v4u*)(HB + (i0 + u * stride) * 8) = w;
                }
            }
        }
    }
    if (c.gt < 4096) {
        const int gp = c.gt, g = gp >> 6;
        float* sm = c.W<float>(WS_SMALL);
        const float dt = expf(c.in[c.z + 10][g]);
        const float lr = c.in[c.z + 8][gp], li = c.in[c.z + 9][gp];
        const float mag = expf(lr * dt);
        const float br = mag * cosf(li * dt), bi = mag * sinf(li * dt);
        const float den = lr * lr + li * li;
        const float fr = ((br - 1.f) * lr + bi * li) / den, fi = (bi * lr - (br - 1.f) * li) / den;
        sm[SM_LBR + gp] = br; sm[SM_LBI + gp] = bi;
        for (int i = 0; i < 16; ++i) {
            const float xr = c.in[c.z + 11][gp * 16 + i], xi = c.in[c.z + 12][gp * 16 + i];
            sm[SM_BBR + gp * 16 + i] = fr * xr - fi * xi; sm[SM_BBI + gp * 16 + i] = fr * xi + fi * xr;
        }
    }
    cvt_tables(c, 0);
}

__device__ __forceinline__ void ln_row_store(const f32x4 (&v)[4], float mean, float rstd, const float* __restrict__ g, const float* __restrict__ b, float* o32, bf16* ob, int lane) {
#pragma unroll
    for (int h = 0; h < 2; ++h) {
        const int c0 = h * 512 + 8 * lane;
        const f32x4 g0 = *(const f32x4*)(g + c0), g1 = *(const f32x4*)(g + c0 + 4), b0 = *(const f32x4*)(b + c0), b1 = *(const f32x4*)(b + c0 + 4);
        const f32x4 o0 = (v[2 * h] - mean) * rstd * g0 + b0, o1 = (v[2 * h + 1] - mean) * rstd * g1 + b1;
        *(f32x4*)(o32 + c0) = o0; *(f32x4*)(o32 + c0 + 4) = o1;
        if (ob) { v4u w; w.x = pk2(o0[0], o0[1]); w.y = pk2(o0[2], o0[3]); w.z = pk2(o1[0], o1[1]); w.w = pk2(o1[2], o1[3]); *(v4u*)(ob + c0) = w; }
    }
}
__device__ __forceinline__ void ln_stats(const f32x4 (&v)[4], float& mean, float& rstd, int lane) {
    float s = 0.f;
#pragma unroll
    for (int k = 0; k < 4; ++k) s += (v[k][0] + v[k][1]) + (v[k][2] + v[k][3]);
    mean = wave_sum(s, lane) * (1.f / D);
    float q = 0.f;
#pragma unroll
    for (int k = 0; k < 4; ++k) { const f32x4 d = v[k] - mean; q += (d[0] * d[0] + d[1] * d[1]) + (d[2] * d[2] + d[3] * d[3]); }
    rstd = rsqrtf(wave_sum(q, lane) * (1.f / D) + LN_EPS);
}
__device__ __forceinline__ void phase_ln1(const Ctx& c, int layer) {
    const bf16* MIX = c.W<bf16>(WS_A0); float* H = c.W<float>(WS_H32); bf16* HB = c.W<bf16>(WS_HB);
    const float* g = c.in[c.z + 38] + layer * D; const float* b = c.in[c.z + 39] + layer * D;
    const float* x0 = c.in[c.z + 0]; const float* x1 = c.in[c.z + 1] - (size_t)TP * D;
#define LN1_SRC(t) ((layer == 0) ? (((t) < TP) ? x0 : x1) : (const float*)H)
    f32x4 hn[4]; v4u mn[2];
#pragma unroll
    for (int h = 0; h < 2; ++h) { const float* hs = LN1_SRC(c.gw); hn[2 * h] = *(const f32x4*)(hs + (size_t)c.gw * D + h * 512 + 8 * c.lane); hn[2 * h + 1] = *(const f32x4*)(hs + (size_t)c.gw * D + h * 512 + 8 * c.lane + 4); mn[h] = *(const v4u*)(MIX + (size_t)c.gw * D + h * 512 + 8 * c.lane); }
    for (int t = c.gw; t < T; t += c.NGW) {
        f32x4 v[4];
#pragma unroll
        for (int h = 0; h < 2; ++h) {
            v[2 * h] = hn[2 * h] * ALPHA + (f32x4){bflo(mn[h].x), bfhi(mn[h].x), bflo(mn[h].y), bfhi(mn[h].y)};
            v[2 * h + 1] = hn[2 * h + 1] * ALPHA + (f32x4){bflo(mn[h].z), bfhi(mn[h].z), bflo(mn[h].w), bfhi(mn[h].w)};
        }
        if (t + c.NGW < T) {
#pragma unroll
            for (int h = 0; h < 2; ++h) { const float* hs = LN1_SRC(t + c.NGW); hn[2 * h] = *(const f32x4*)(hs + (size_t)(t + c.NGW) * D + h * 512 + 8 * c.lane); hn[2 * h + 1] = *(const f32x4*)(hs + (size_t)(t + c.NGW) * D + h * 512 + 8 * c.lane + 4); mn[h] = *(const v4u*)(MIX + (size_t)(t + c.NGW) * D + h * 512 + 8 * c.lane); }
        }
        float mean, rstd; ln_stats(v, mean, rstd, c.lane);
        ln_row_store(v, mean, rstd, g, b, H + (size_t)t * D, HB + (size_t)t * D, c.lane);
    }
#undef LN1_SRC
}

__device__ __forceinline__ bf16x8 mk8(float a0, float a1, float a2, float a3, float a4, float a5, float a6, float a7) {
    v4u w; w.x = pk2(a0, a1); w.y = pk2(a2, a3); w.z = pk2(a4, a5); w.w = pk2(a6, a7); return __builtin_bit_cast(bf16x8, w);
}
constexpr int S5_BU_LD = 132  , S5_H_LD = 136  , S5_WAVE_BYTES = 16 * S5_BU_LD * 4 + 16 * S5_H_LD * 2;
constexpr int S5_CE_OFF = 8 * S5_WAVE_BYTES;
#define S5_LOAD_FRAGS(g) \
        bf16x8 Bf[8]; \
        _Pragma("unroll") for (int nt = 0; nt < 8; ++nt) { \
            const int comp = 16 * nt + fr; \
            const float* src = sm + ((comp < 64) ? SM_BBR : SM_BBI) + (size_t)((g) * 64 + (comp & 63)) * 16 + 8 * (fq & 1); \
            const f32x4 a = *(const f32x4*)src, b = *(const f32x4*)(src + 4); \
            const bf16x8 v = mk8(a[0], a[1], a[2], a[3], b[0], b[1], b[2], b[3]); \
            Bf[nt] = (fq < 2) ? v : (bf16x8){0, 0, 0, 0, 0, 0, 0, 0}; } \
        bf16x8 Cf[4]; \
        _Pragma("unroll") for (int ks = 0; ks < 4; ++ks) { \
            const int comp0 = 32 * ks + 8 * fq; \
            const float* src = ((ks < 2) ? c.in[c.z + 13] : c.in[c.z + 14]) + (size_t)((g) * 16 + fr) * 64 + (comp0 & 63); \
            const f32x4 a = *(const f32x4*)src, b = *(const f32x4*)(src + 4); \
            const float sg = (ks < 2) ? 1.f : -1.f; \
            Cf[ks] = mk8(sg * a[0], sg * a[1], sg * a[2], sg * a[3], sg * b[0], sg * b[1], sg * b[2], sg * b[3]); } \
        const float lr = sm[SM_LBR + (g) * 64 + p], li = sm[SM_LBI + (g) * 64 + p]; \
        const f32x4 dk4 = *(const f32x4*)(c.in[c.z + 15] + (g) * 16 + 4 * fq);
__device__ __forceinline__ void phase_s5scan(const Ctx& c) {
    const bf16* U = c.W<bf16>(WS_A0); bf16* G = c.W<bf16>(WS_A1); float* YL = c.W<float>(WS_R32);
    const float* sm = c.W<float>(WS_SMALL);
    float* out = c.out;
    float* o_re_p = out + 17825792, *o_im_p = o_re_p + 32768, *o_re_s = out + 17825792 + 32768 * 2 + 122880 + 73728 + 2097152, *o_im_s = o_re_s + 524288;
    const int lane = c.lane, p = lane, fr = lane & 15, fq = lane >> 4, w = c.wave;
    LAS float* BuT = (LAS float*)(c.lds + w * S5_WAVE_BYTES);
    LAS bf16* Hi = (LAS bf16*)(c.lds + w * S5_WAVE_BYTES + 16 * S5_BU_LD * 4);
    LAS float* CE = (LAS float*)(c.lds + S5_CE_OFF);
    for (int pair = c.bid; pair < 256; pair += c.nblk) {
        const int unit = 2 * pair + (w >> 2), s = unit >> 6, g = unit & 63, seg = w & 3, tokS = s * 2048 + seg * 512;
        S5_LOAD_FRAGS(g)
        float hr = 0.f, hi = 0.f;
        bf16x8 uf_n = {0, 0, 0, 0, 0, 0, 0, 0}; v2u uq_n;
        if (fq < 2) uf_n = *(const bf16x8*)(U + (size_t)(tokS + fr) * D + g * 16 + 8 * fq);
        uq_n = *(const v2u*)(U + (size_t)(tokS + fr) * D + g * 16 + 4 * fq);
        for (int tile = 0; tile < 32; ++tile) {
            const int tb = tokS + tile * 16;
            const bf16x8 uf = uf_n; const v2u uq = uq_n;
            if (tile + 1 < 32) { if (fq < 2) uf_n = *(const bf16x8*)(U + (size_t)(tb + 16 + fr) * D + g * 16 + 8 * fq); uq_n = *(const v2u*)(U + (size_t)(tb + 16 + fr) * D + g * 16 + 4 * fq); }
#pragma unroll
            for (int nt = 0; nt < 8; ++nt) {
                f32x4 acc = {0.f, 0.f, 0.f, 0.f};
                acc = __builtin_amdgcn_mfma_f32_16x16x32_bf16(Bf[nt], uf, acc, 0, 0, 0);
                *(LAS f32x4*)(BuT + fr * S5_BU_LD + 16 * nt + 4 * fq) = acc;
            }
            asm volatile("s_waitcnt lgkmcnt(0)" ::: "memory");
#pragma unroll
            for (int t = 0; t < 16; ++t) {
                const float br = BuT[t * S5_BU_LD + p], bi = BuT[t * S5_BU_LD + 64 + p];
                const float nr = lr * hr - li * hi + br, ni = lr * hi + li * hr + bi;
                hr = nr; hi = ni;
                Hi[t * S5_H_LD + p] = (bf16)f2bf_fast(hr); Hi[t * S5_H_LD + 64 + p] = (bf16)f2bf_fast(hi);
            }
            asm volatile("s_waitcnt lgkmcnt(0)" ::: "memory");
            f32x4 y = {0.f, 0.f, 0.f, 0.f};
#pragma unroll
            for (int ks = 0; ks < 4; ++ks) y = __builtin_amdgcn_mfma_f32_16x16x32_bf16(Cf[ks], *(const LAS bf16x8*)(Hi + fr * S5_H_LD + 32 * ks + 8 * fq), y, 0, 0, 0);
            y[0] += dk4[0] * bflo(uq.x); y[1] += dk4[1] * bfhi(uq.x); y[2] += dk4[2] * bflo(uq.y); y[3] += dk4[3] * bfhi(uq.y);
            *(f32x4*)(YL + (size_t)(tb + fr) * D + g * 16 + 4 * fq) = y;
            asm volatile("" ::: "memory");
        }
        CE[((w >> 2) * 4 + seg) * 128 + p] = hr; CE[((w >> 2) * 4 + seg) * 128 + 64 + p] = hi;
        float pr = lr, pi = li;
#pragma unroll
        for (int k = 0; k < 9; ++k) { const float nr = pr * pr - pi * pi, ni = 2.f * pr * pi; pr = nr; pi = ni; }
        asm volatile("s_waitcnt vmcnt(0)" ::: "memory");
        __syncthreads();
        float sr = 0.f, si = 0.f;
        for (int kk = 0; kk < seg; ++kk) {
            const float er = CE[((w >> 2) * 4 + kk) * 128 + p], ei = CE[((w >> 2) * 4 + kk) * 128 + 64 + p];
            const float nr = pr * sr - pi * si + er, ni = pr * si + pi * sr + ei; sr = nr; si = ni;
        }
        if (seg == 3) { o_re_p[(s * 64 + g) * 64 + p] = pr * sr - pi * si + hr; o_im_p[(s * 64 + g) * 64 + p] = pr * si + pi * sr + hi; }
        float rr = sr, ri = si;
        f32x4 yl_n = *(const f32x4*)(YL + (size_t)(tokS + fr) * D + g * 16 + 4 * fq);
        for (int tile = 0; tile < 32; ++tile) {
            const int tb = tokS + tile * 16;
            const f32x4 yl = yl_n;
            if (tile + 1 < 32) yl_n = *(const f32x4*)(YL + (size_t)(tb + 16 + fr) * D + g * 16 + 4 * fq);
#pragma unroll
            for (int t = 0; t < 16; ++t) {
                const float nr = lr * rr - li * ri, ni = lr * ri + li * rr; rr = nr; ri = ni;
                Hi[t * S5_H_LD + p] = (bf16)f2bf_fast(rr); Hi[t * S5_H_LD + 64 + p] = (bf16)f2bf_fast(ri);
            }
            asm volatile("s_waitcnt lgkmcnt(0)" ::: "memory");
            f32x4 y = yl;
#pragma unroll
            for (int ks = 0; ks < 4; ++ks) y = __builtin_amdgcn_mfma_f32_16x16x32_bf16(Cf[ks], *(const LAS bf16x8*)(Hi + fr * S5_H_LD + 32 * ks + 8 * fq), y, 0, 0, 0);
            v2u o; o.x = pk2(gelu_f(y[0]), gelu_f(y[1])); o.y = pk2(gelu_f(y[2]), gelu_f(y[3]));
            *(v2u*)(G + (size_t)(tb + fr) * D + g * 16 + 4 * fq) = o;
            asm volatile("" ::: "memory");
        }
        __syncthreads();
    }
    for (int unit = 8 * 64 + c.gw; unit < 136 * 64; unit += c.NGW) {
        const int s = unit >> 6, g = unit & 63, tok0 = TP + ((s - 8) << 3);
        S5_LOAD_FRAGS(g)
        float hr = c.in[c.z + 2][((s - 8) * 64 + g) * 64 + p], hi = c.in[c.z + 3][((s - 8) * 64 + g) * 64 + p];
        const bool valid = fr < 8;
        bf16x8 uf = {0, 0, 0, 0, 0, 0, 0, 0}; v2u uq = {0u, 0u};
        if (valid) { if (fq < 2) uf = *(const bf16x8*)(U + (size_t)(tok0 + fr) * D + g * 16 + 8 * fq); uq = *(const v2u*)(U + (size_t)(tok0 + fr) * D + g * 16 + 4 * fq); }
#pragma unroll
        for (int nt = 0; nt < 8; ++nt) {
            f32x4 acc = {0.f, 0.f, 0.f, 0.f};
            acc = __builtin_amdgcn_mfma_f32_16x16x32_bf16(Bf[nt], uf, acc, 0, 0, 0);
            *(LAS f32x4*)(BuT + fr * S5_BU_LD + 16 * nt + 4 * fq) = acc;
        }
        asm volatile("s_waitcnt lgkmcnt(0)" ::: "memory");
#pragma unroll
        for (int t = 0; t < 16; ++t) {
            const float br = BuT[t * S5_BU_LD + p], bi = BuT[t * S5_BU_LD + 64 + p];
            const float nr = lr * hr - li * hi + br, ni = lr * hi + li * hr + bi;
            if (t < 8) { hr = nr; hi = ni; }
            Hi[t * S5_H_LD + p] = (bf16)f2bf_fast(hr); Hi[t * S5_H_LD + 64 + p] = (bf16)f2bf_fast(hi);
        }
        asm volatile("s_waitcnt lgkmcnt(0)" ::: "memory");
        f32x4 y = {0.f, 0.f, 0.f, 0.f};
#pragma unroll
        for (int ks = 0; ks < 4; ++ks) y = __builtin_amdgcn_mfma_f32_16x16x32_bf16(Cf[ks], *(const LAS bf16x8*)(Hi + fr * S5_H_LD + 32 * ks + 8 * fq), y, 0, 0, 0);
        if (valid) {
            v2u o; o.x = pk2(gelu_f(y[0] + dk4[0] * bflo(uq.x)), gelu_f(y[1] + dk4[1] * bfhi(uq.x))); o.y = pk2(gelu_f(y[2] + dk4[2] * bflo(uq.y)), gelu_f(y[3] + dk4[3] * bfhi(uq.y)));
            *(v2u*)(G + (size_t)(tok0 + fr) * D + g * 16 + 4 * fq) = o;
        }
        o_re_s[((s - 8) * 64 + g) * 64 + p] = hr; o_im_s[((s - 8) * 64 + g) * 64 + p] = hi;
        asm volatile("" ::: "memory");
    }
}
#undef S5_LOAD_FRAGS

__device__ __forceinline__ void unpack8(const v4u q, float (&f)[8]) { f[0] = bflo(q.x); f[1] = bfhi(q.x); f[2] = bflo(q.y); f[3] = bfhi(q.y); f[4] = bflo(q.z); f[5] = bfhi(q.z); f[6] = bflo(q.w); f[7] = bfhi(q.w); }
__device__ __forceinline__ void phase_pool(const Ctx& c) {
    const bf16* U = c.W<bf16>(WS_A0); bf16* P = c.W<bf16>(WS_A1);
    float* o_p = c.out + 17825792 + 65536, *o_s = c.out + 17825792 + 65536 + 122880 + 73728 + 2097152 + 1048576;
    for (int item = c.gt; item < 640 * 128; item += c.NGT) {
        const int rg = item >> 7, c0 = (item & 127) * 8, w = 2 << (c0 >> 8);
        int tok0, l0, n, sb;
        if (rg < 512) { tok0 = (rg >> 6) << 11; l0 = (rg & 63) * 32; n = 32; sb = -1; } else { sb = rg - 512; tok0 = TP + sb * 8; l0 = 0; n = 8; }
        float sum[8];
#pragma unroll
        for (int j = 0; j < 8; ++j) sum[j] = 0.f;
        for (int k = 1; k < w; ++k) {
            const int ll = l0 - k; float f[8];
            if (ll >= 0) unpack8(*(const v4u*)(U + (size_t)(tok0 + ll) * D + c0), f);
            else if (sb >= 0) { const float* sp = c.in[c.z + 4] + ((size_t)sb * 15 + (15 + ll)) * D + c0; const f32x4 a = *(const f32x4*)sp, b = *(const f32x4*)(sp + 4); f[0] = a[0]; f[1] = a[1]; f[2] = a[2]; f[3] = a[3]; f[4] = b[0]; f[5] = b[1]; f[6] = b[2]; f[7] = b[3]; }
            else {
#pragma unroll
                for (int j = 0; j < 8; ++j) f[j] = 0.f;
            }
#pragma unroll
            for (int j = 0; j < 8; ++j) sum[j] += f[j];
        }
        for (int i4 = 0; i4 < n; i4 += 4) {
          v4u rin[4], rout[4];
#pragma unroll
          for (int u = 0; u < 4; ++u) {
              const int l = l0 + i4 + u, lo = l - w + 1;
              rin[u] = *(const v4u*)(U + (size_t)(tok0 + l) * D + c0);
              rout[u] = (lo >= 0) ? *(const v4u*)(U + (size_t)(tok0 + lo) * D + c0) : (v4u){0u, 0u, 0u, 0u};
          }
#pragma unroll
          for (int u = 0; u < 4; ++u) {
            const int i = i4 + u;
            const int l = l0 + i; float cur[8], old[8];
            unpack8(rin[u], cur);
#pragma unroll
            for (int j = 0; j < 8; ++j) sum[j] += cur[j];
            const int pos = (sb >= 0 ? 16384 : 0) + l;
            const float inv = __builtin_amdgcn_rcpf((float)min(pos + 1, w));
            v4u o; o.x = pk2(sum[0] * inv - cur[0], sum[1] * inv - cur[1]); o.y = pk2(sum[2] * inv - cur[2], sum[3] * inv - cur[3]);
            o.z = pk2(sum[4] * inv - cur[4], sum[5] * inv - cur[5]); o.w = pk2(sum[6] * inv - cur[6], sum[7] * inv - cur[7]);
            *(v4u*)(P + (size_t)(tok0 + l) * D + c0) = o;
            const int lo = l - w + 1;
            if (lo >= 0) unpack8(rout[u], old);
            else if (sb >= 0) { const float* sp = c.in[c.z + 4] + ((size_t)sb * 15 + (15 + lo)) * D + c0; const f32x4 a = *(const f32x4*)sp, b = *(const f32x4*)(sp + 4); old[0] = a[0]; old[1] = a[1]; old[2] = a[2]; old[3] = a[3]; old[4] = b[0]; old[5] = b[1]; old[6] = b[2]; old[7] = b[3]; }
            else {
#pragma unroll
                for (int j = 0; j < 8; ++j) old[j] = 0.f;
            }
#pragma unroll
            for (int j = 0; j < 8; ++j) sum[j] -= old[j];
          }
        }
    }
    for (size_t i = (size_t)c.gt; i < (size_t)136 * 15 * D; i += (size_t)c.NGT) {
        const int ch = (int)(i & 1023); const int j = (int)((i >> 10) % 15); const int s = (int)(i / (15 * 1024));
        if (s < 8) o_p[((size_t)s * 15 + j) * D + ch] = bf2f(U[(size_t)(s * 2048 + 2033 + j) * D + ch]);
        else { const int b = s - 8; o_s[((size_t)b * 15 + j) * D + ch] = (j < 7) ? c.in[c.z + 4][((size_t)b * 15 + 8 + j) * D + ch] : bf2f(U[(size_t)(TP + b * 8 + (j - 7)) * D + ch]); }
    }
}

__device__ __forceinline__ void phase_cmlp_ln(const Ctx& c) {
    bf16* Z = c.W<bf16>(WS_Q);
    float* o_v = c.out + 17825792 + 65536 + 122880 + 73728 + 2097152 + 1048576 + 1966080;
    const float* g = c.in[c.z + 25]; const float* b = c.in[c.z + 26];
    v4u qn[2], qnn[2];
#pragma unroll
    for (int h = 0; h < 2; ++h) { qn[h] = *(const v4u*)(Z + (size_t)c.gw * 2048 + 1024 + h * 512 + 8 * c.lane); qnn[h] = *(const v4u*)(Z + (size_t)(c.gw + c.NGW) * 2048 + 1024 + h * 512 + 8 * c.lane); }
    for (int t = c.gw; t < T; t += c.NGW) {
        bf16* vr = Z + (size_t)t * 2048 + 1024;
        f32x4 v[4];
        const v4u qc[2] = {qn[0], qn[1]};
        qn[0] = qnn[0]; qn[1] = qnn[1];
        if (t + 2 * c.NGW < T) {
#pragma unroll
            for (int h = 0; h < 2; ++h) qnn[h] = *(const v4u*)(Z + (size_t)(t + 2 * c.NGW) * 2048 + 1024 + h * 512 + 8 * c.lane);
        }
#pragma unroll
        for (int h = 0; h < 2; ++h) {
            const v4u q = qc[h];
            v[2 * h] = (f32x4){bflo(q.x), bfhi(q.x), bflo(q.y), bfhi(q.y)}; v[2 * h + 1] = (f32x4){bflo(q.z), bfhi(q.z), bflo(q.w), bfhi(q.w)};
        }
        float mean, rstd; ln_stats(v, mean, rstd, c.lane);
#pragma unroll
        for (int h = 0; h < 2; ++h) {
            const int c0 = h * 512 + 8 * c.lane;
            const f32x4 g0 = *(const f32x4*)(g + c0), g1 = *(const f32x4*)(g + c0 + 4), b0 = *(const f32x4*)(b + c0), b1 = *(const f32x4*)(b + c0 + 4);
            const f32x4 o0 = (v[2 * h] - mean) * rstd * g0 + b0, o1 = (v[2 * h + 1] - mean) * rstd * g1 + b1;
            v4u w; w.x = pk2(o0[0], o0[1]); w.y = pk2(o0[2], o0[3]); w.z = pk2(o1[0], o1[1]); w.w = pk2(o1[2], o1[3]);
            *(v4u*)(vr + c0) = w;
            if (t >= TP) { *(f32x4*)(o_v + (size_t)(t - TP) * D + c0) = o0; *(f32x4*)(o_v + (size_t)(t - TP) * D + c0 + 4) = o1; }
        }
    }
}
constexpr int CM_LD = 136, CM_WS = 0  , CM_VT = 34816  ;
__device__ __forceinline__ void phase_cmlp_mix(const Ctx& c) {
    const bf16* Z = c.W<bf16>(WS_Q); bf16* O = c.W<bf16>(WS_A1);
    LAS unsigned char* lds = c.lds;
    const int tid = c.tid, lane = c.lane, w = c.wave, fr = lane & 15, fq = lane >> 4;
    for (int unit = c.bid; unit < 128 * 4; unit += c.nblk) {
        const int chunk = unit >> 2, hd = unit & 3, tokc = chunk * 128;
#pragma unroll
        for (int k = 0; k < 4; ++k) {
            const int q = tid + 512 * k, row = q >> 4, cc = q & 15;
            const float* src = c.in[c.z + 27] + ((size_t)hd * 128 + row) * 128 + cc * 8;
            const f32x4 a = *(const f32x4*)src, b = *(const f32x4*)(src + 4);
            float f[8] = {a[0], a[1], a[2], a[3], b[0], b[1], b[2], b[3]};
#pragma unroll
            for (int j = 0; j < 8; ++j) f[j] = (cc * 8 + j <= row) ? f[j] : 0.f;
            v4u o; o.x = pk2(f[0], f[1]); o.y = pk2(f[2], f[3]); o.z = pk2(f[4], f[5]); o.w = pk2(f[6], f[7]);
            *(LAS v4u*)(lds + CM_WS + (row * CM_LD + cc * 8) * 2) = o;
        }
        {
            const int srow = tid & 127, dq = tid >> 7;
            const bf16* vs = Z + (size_t)(tokc + srow) * 2048 + 1024 + hd * 256 + dq * 64;
#pragma unroll
            for (int k = 0; k < 8; ++k) {
                const v4u q = *(const v4u*)(vs + 8 * k);
                const unsigned xw[4] = {q.x, q.y, q.z, q.w};
#pragma unroll
                for (int j = 0; j < 4; ++j) {
                    *(LAS bf16*)(lds + CM_VT + ((dq * 64 + 8 * k + 2 * j) * CM_LD + srow) * 2) = (bf16)(xw[j] & 0xffffu);
                    *(LAS bf16*)(lds + CM_VT + ((dq * 64 + 8 * k + 2 * j + 1) * CM_LD + srow) * 2) = (bf16)(xw[j] >> 16);
                }
            }
        }
        __syncthreads();
        f32x4 acc[16];
#pragma unroll
        for (int jd = 0; jd < 16; ++jd) acc[jd] = (f32x4){0.f, 0.f, 0.f, 0.f};
#pragma unroll
        for (int ks = 0; ks < 4; ++ks) {
            if (ks <= (w >> 1)) {
                const bf16x8 wf = *(const LAS bf16x8*)(lds + CM_WS + ((16 * w + fr) * CM_LD + ks * 32 + 8 * fq) * 2);
#pragma unroll
                for (int jd = 0; jd < 16; ++jd)
                    acc[jd] = __builtin_amdgcn_mfma_f32_16x16x32_bf16(*(const LAS bf16x8*)(lds + CM_VT + ((16 * jd + fr) * CM_LD + ks * 32 + 8 * fq) * 2), wf, acc[jd], 0, 0, 0);
            }
        }
        {
            const int t = 16 * w + fr; const size_t tok = (size_t)(tokc + t);
            const float bs = c.in[c.z + 28][hd * 128 + t];
#pragma unroll
            for (int jd = 0; jd < 16; ++jd) {
                const v2u uq = *(const v2u*)(Z + tok * 2048 + hd * 256 + 16 * jd + 4 * fq);
                v2u o; o.x = pk2(bflo(uq.x) * (acc[jd][0] + bs), bfhi(uq.x) * (acc[jd][1] + bs)); o.y = pk2(bflo(uq.y) * (acc[jd][2] + bs), bfhi(uq.y) * (acc[jd][3] + bs));
                *(v2u*)(O + tok * D + hd * 256 + 16 * jd + 4 * fq) = o;
            }
        }
        __syncthreads();
    }
    for (size_t i = (size_t)c.gt; i < (size_t)(T - TP) * 128; i += (size_t)c.NGT) {
        const int t = TP + (int)(i >> 7), c0 = (int)(i & 127) * 8;
        const int hd = c0 >> 8, tp = (t - TP) & 7, base = t - tp;
        float acc[8];
        const float bs = c.in[c.z + 28][hd * 128 + tp];
#pragma unroll
        for (int j = 0; j < 8; ++j) acc[j] = bs;
        const float* wr = c.in[c.z + 27] + ((size_t)hd * 128 + tp) * 128;
        for (int sp = 0; sp <= tp; ++sp) {
            const float wv = wr[sp];
            const v4u q = *(const v4u*)(Z + (size_t)(base + sp) * 2048 + 1024 + c0);
            acc[0] += wv * bflo(q.x); acc[1] += wv * bfhi(q.x); acc[2] += wv * bflo(q.y); acc[3] += wv * bfhi(q.y);
            acc[4] += wv * bflo(q.z); acc[5] += wv * bfhi(q.z); acc[6] += wv * bflo(q.w); acc[7] += wv * bfhi(q.w);
        }
        const v4u uq = *(const v4u*)(Z + (size_t)t * 2048 + c0);
        v4u o; o.x = pk2(bflo(uq.x) * acc[0], bfhi(uq.x) * acc[1]); o.y = pk2(bflo(uq.y) * acc[2], bfhi(uq.y) * acc[3]);
        o.z = pk2(bflo(uq.z) * acc[4], bfhi(uq.z) * acc[5]); o.w = pk2(bflo(uq.w) * acc[6], bfhi(uq.w) * acc[7]);
        *(v4u*)(O + (size_t)t * D + c0) = o;
    }
}

__device__ __forceinline__ void phase_ssd_conv(const Ctx& c) {
    const bf16* X = c.W<bf16>(WS_XBC); bf16* XC = c.W<bf16>(WS_XC);
    float* o_p = c.out + 17825792 + 65536 + 122880, *o_s = c.out + 17825792 + 65536 + 122880 + 73728 + 2097152 + 1048576 + 1966080 + 1048576;
    for (int item = c.gt; item < 640 * 384; item += c.NGT) {
        const int rg = item / 384, c0 = (item % 384) * 8;
        int tok0, l0, n, sb;
        if (rg < 512) { tok0 = (rg >> 6) << 11; l0 = (rg & 63) * 32; n = 32; sb = -1; } else { sb = rg - 512; tok0 = TP + sb * 8; l0 = 0; n = 8; }
        float wt[4][8], bias[8];
#pragma unroll
        for (int k = 0; k < 4; ++k) { const f32x4 a = *(const f32x4*)(c.in[c.z + 31] + k * CONVD + c0), b = *(const f32x4*)(c.in[c.z + 31] + k * CONVD + c0 + 4);
            wt[k][0] = a[0]; wt[k][1] = a[1]; wt[k][2] = a[2]; wt[k][3] = a[3]; wt[k][4] = b[0]; wt[k][5] = b[1]; wt[k][6] = b[2]; wt[k][7] = b[3]; }
        { const f32x4 a = *(const f32x4*)(c.in[c.z + 32] + c0), b = *(const f32x4*)(c.in[c.z + 32] + c0 + 4); bias[0] = a[0]; bias[1] = a[1]; bias[2] = a[2]; bias[3] = a[3]; bias[4] = b[0]; bias[5] = b[1]; bias[6] = b[2]; bias[7] = b[3]; }
        float r0[8], r1[8], r2[8];
#pragma unroll
        for (int k = 0; k < 3; ++k) {
            const int src = l0 - 3 + k; float f[8];
            if (src >= 0) unpack8(*(const v4u*)(X + (size_t)(tok0 + src) * CONVD + c0), f);
            else if (sb >= 0) { const float* sp = c.in[c.z + 5] + ((size_t)sb * 3 + (3 + src)) * CONVD + c0; const f32x4 a = *(const f32x4*)sp, b = *(const f32x4*)(sp + 4); f[0] = a[0]; f[1] = a[1]; f[2] = a[2]; f[3] = a[3]; f[4] = b[0]; f[5] = b[1]; f[6] = b[2]; f[7] = b[3]; }
            else {
#pragma unroll
                for (int j = 0; j < 8; ++j) f[j] = 0.f;
            }
#pragma unroll
            for (int j = 0; j < 8; ++j) { if (k == 0) r0[j] = f[j]; else if (k == 1) r1[j] = f[j]; else r2[j] = f[j]; }
        }
        v4u rn[4];
#pragma unroll
        for (int u = 0; u < 4; ++u) rn[u] = *(const v4u*)(X + (size_t)(tok0 + l0 + u) * CONVD + c0);
        for (int i = 0; i < n; i += 4) {
            v4u rq[4];
#pragma unroll
            for (int u = 0; u < 4; ++u) rq[u] = rn[u];
            if (i + 4 < n) {
#pragma unroll
                for (int u = 0; u < 4; ++u) rn[u] = *(const v4u*)(X + (size_t)(tok0 + l0 + i + 4 + u) * CONVD + c0);
            }
#pragma unroll
            for (int u = 0; u < 4; ++u) {
                float cur[8], o[8];
                unpack8(rq[u], cur);
#pragma unroll
                for (int j = 0; j < 8; ++j) { o[j] = silu_f(bias[j] + r0[j] * wt[0][j] + r1[j] * wt[1][j] + r2[j] * wt[2][j] + cur[j] * wt[3][j]); r0[j] = r1[j]; r1[j] = r2[j]; r2[j] = cur[j]; }
                v4u q; q.x = pk2(o[0], o[1]); q.y = pk2(o[2], o[3]); q.z = pk2(o[4], o[5]); q.w = pk2(o[6], o[7]);
                *(v4u*)(XC + (size_t)(tok0 + l0 + i + u) * CONVD + c0) = q;
            }
        }
    }
    for (size_t i = (size_t)c.gt; i < (size_t)136 * 3 * CONVD; i += (size_t)c.NGT) {
        const int ch = (int)(i % CONVD); const int j = (int)((i / CONVD) % 3); const int s = (int)(i / (3 * CONVD));
        if (s < 8) o_p[((size_t)s * 3 + j) * CONVD + ch] = bf2f(X[(size_t)(s * 2048 + 2045 + j) * CONVD + ch]);
        else { const int b = s - 8; o_s[((size_t)b * 3 + j) * CONVD + ch] = bf2f(X[(size_t)(TP + b * 8 + 5 + j) * CONVD + ch]); }
    }
}
constexpr int SD_LD = 136;
constexpr int SD_C = 0, SD_B = 34816, SD_BT = 69632, SD_XT = 104448, SD_HB = 121856, SD_VEC = 139264;
__device__ __forceinline__ float softplus_f(float x) { return (x > 20.f) ? x : log1pf(__expf(x)); }
__device__ __forceinline__ void phase_ssd_scan(const Ctx& c) {
    const bf16* XC = c.W<bf16>(WS_XC); const float* DT = c.W<float>(WS_DT); bf16* Y = c.W<bf16>(WS_Y);
    float* o_p = c.out + 17825792 + 65536 + 122880 + 73728;
    float* o_s = c.out + 17825792 + 65536 + 122880 + 73728 + 2097152 + 1048576 + 1966080 + 1048576 + 1179648;
    const int tid = c.tid, lane = c.lane, w = c.wave, fr = lane & 15, fq = lane >> 4;
    LAS unsigned char* lds = c.lds;
    LAS float* csv = (LAS float*)(lds + SD_VEC); LAS float* dtv = csv + 128;
#define SD_FRAG(img, row, ks) (*(const LAS bf16x8*)(lds + (img) + ((row) * SD_LD + (ks) * 32 + 8 * fq) * 2))
    for (int unit = c.bid; unit < 8 * 32; unit += c.nblk) {
        const int s = unit >> 5, hd = unit & 31, g = hd >> 3;
        const float a = -__expf(c.in[c.z + 34][hd]), dtb = c.in[c.z + 33][hd], dk = c.in[c.z + 35][hd];
        f32x4 hacc[4];
#pragma unroll
        for (int jp = 0; jp < 4; ++jp) hacc[jp] = (f32x4){0.f, 0.f, 0.f, 0.f};
        v4u pfC[4], pfB[4], pfx0, pfx1; float pfd0 = 0.f, pfd1 = 0.f;
#define SD_PREFETCH(tk) do { \
            _Pragma("unroll") for (int k = 0; k < 4; ++k) { const int q = tid + 512 * k, row = q >> 4, cc = q & 15; \
                const bf16* src = XC + (size_t)((tk) + row) * CONVD + g * 128 + cc * 8; pfC[k] = *(const v4u*)(src + 2560); pfB[k] = *(const v4u*)(src + 2048); } \
            { const bf16* xs = XC + (size_t)((tk) + (tid & 127)) * CONVD + hd * 64 + (tid >> 7) * 16; pfx0 = *(const v4u*)xs; pfx1 = *(const v4u*)(xs + 8); } \
            if (w == 0) { pfd0 = DT[(size_t)((tk) + lane) * 32 + hd]; pfd1 = DT[(size_t)((tk) + 64 + lane) * 32 + hd]; } } while (0)
        SD_PREFETCH(s * 2048);
        for (int ch = 0; ch < 16; ++ch) {
            const int tokc = s * 2048 + ch * 128;
            if (w == 0) {
                const float dt0 = softplus_f(pfd0 + dtb), dt1 = softplus_f(pfd1 + dtb);
                float s0 = dt0 * a, s1 = dt1 * a;
#pragma unroll
                for (int o = 1; o < 64; o <<= 1) {
                    const float u0 = __builtin_bit_cast(float, __builtin_amdgcn_ds_bpermute(((lane - o) & 63) << 2, __builtin_bit_cast(int, s0)));
                    const float u1 = __builtin_bit_cast(float, __builtin_amdgcn_ds_bpermute(((lane - o) & 63) << 2, __builtin_bit_cast(int, s1)));
                    if (lane >= o) { s0 += u0; s1 += u1; }
                }
                const float tot0 = __builtin_bit_cast(float, __builtin_amdgcn_readlane(__builtin_bit_cast(int, s0), 63));
                csv[lane] = s0; csv[64 + lane] = tot0 + s1; dtv[lane] = dt0; dtv[64 + lane] = dt1;
            }
#pragma unroll
            for (int k = 0; k < 4; ++k) {
                const int q = tid + 512 * k, row = q >> 4, cc = q & 15;
                *(LAS v4u*)(lds + SD_C + (row * SD_LD + cc * 8) * 2) = pfC[k];
                *(LAS v4u*)(lds + SD_B + (row * SD_LD + cc * 8) * 2) = pfB[k];
            }
            const v4u x0 = pfx0, x1 = pfx1;
            if (ch + 1 < 16) SD_PREFETCH(tokc + 128);
#pragma unroll
            for (int jp = 0; jp < 4; ++jp) {
                v2u hq; hq.x = pk2(hacc[jp][0], hacc[jp][1]); hq.y = pk2(hacc[jp][2], hacc[jp][3]);
                *(LAS v2u*)(lds + SD_HB + ((16 * jp + fr) * SD_LD + 16 * w + 4 * fq) * 2) = hq;
            }
            __syncthreads();
            {
                const int srow = tid & 127, qq = tid >> 7;
                const float sc = __expf(csv[127] - csv[srow]) * dtv[srow];
#pragma unroll
                for (int k = 0; k < 4; ++k) {
                    const int n0 = qq * 32 + k * 8;
                    const v4u bq = *(const LAS v4u*)(lds + SD_B + (srow * SD_LD + n0) * 2);
                    const float f[8] = {bflo(bq.x), bfhi(bq.x), bflo(bq.y), bfhi(bq.y), bflo(bq.z), bfhi(bq.z), bflo(bq.w), bfhi(bq.w)};
#pragma unroll
                    for (int j = 0; j < 8; ++j) *(LAS bf16*)(lds + SD_BT + ((n0 + j) * SD_LD + srow) * 2) = (bf16)f2bf(f[j] * sc);
                }
                const unsigned xw[8] = {x0.x, x0.y, x0.z, x0.w, x1.x, x1.y, x1.z, x1.w};
#pragma unroll
                for (int j = 0; j < 8; ++j) {
                    *(LAS bf16*)(lds + SD_XT + ((qq * 16 + 2 * j) * SD_LD + srow) * 2) = (bf16)(xw[j] & 0xffffu);
                    *(LAS bf16*)(lds + SD_XT + ((qq * 16 + 2 * j + 1) * SD_LD + srow) * 2) = (bf16)(xw[j] >> 16);
                }
            }
            __syncthreads();
            const int jmax = w | 1;
            bf16x8 Cf[4];
#pragma unroll
            for (int ks = 0; ks < 4; ++ks) Cf[ks] = SD_FRAG(SD_C, 16 * w + fr, ks);
            f32x4 acc[8];
#pragma unroll
            for (int j = 0; j < 8; ++j) {
                acc[j] = (f32x4){0.f, 0.f, 0.f, 0.f};
                if (j <= jmax) {
#pragma unroll
                    for (int ks = 0; ks < 4; ++ks) acc[j] = __builtin_amdgcn_mfma_f32_16x16x32_bf16(SD_FRAG(SD_B, 16 * j + fr, ks), Cf[ks], acc[j], 0, 0, 0);
                }
            }
            {
                const float cdec = __expf(csv[127]);
                bf16x8 Bt[4];
#pragma unroll
                for (int ks = 0; ks < 4; ++ks) Bt[ks] = SD_FRAG(SD_BT, 16 * w + fr, ks);
#pragma unroll
                for (int jp = 0; jp < 4; ++jp) {
                    hacc[jp] = hacc[jp] * cdec;
#pragma unroll
                    for (int ks = 0; ks < 4; ++ks) hacc[jp] = __builtin_amdgcn_mfma_f32_16x16x32_bf16(Bt[ks], SD_FRAG(SD_XT, 16 * jp + fr, ks), hacc[jp], 0, 0, 0);
                }
            }
            __syncthreads();
            {
                const int t = 16 * w + fr; const float cst = csv[t];
#pragma unroll
                for (int j = 0; j < 8; ++j) {
                    if (j <= jmax) {
                        const f32x4 css = *(const LAS f32x4*)(csv + 16 * j + 4 * fq), dts = *(const LAS f32x4*)(dtv + 16 * j + 4 * fq);
                        float v[4];
#pragma unroll
                        for (int r = 0; r < 4; ++r) v[r] = (16 * j + 4 * fq + r <= t) ? acc[j][r] * __expf(cst - css[r]) * dts[r] : 0.f;
                        v2u lq; lq.x = pk2(v[0], v[1]); lq.y = pk2(v[2], v[3]);
                        *(LAS v2u*)(lds + SD_B + (t * SD_LD + 16 * j + 4 * fq) * 2) = lq;
                    }
                }
            }
            __syncthreads();
            {
                f32x4 a1[4], a2[4];
#pragma unroll
                for (int jp = 0; jp < 4; ++jp) { a1[jp] = (f32x4){0.f, 0.f, 0.f, 0.f}; a2[jp] = (f32x4){0.f, 0.f, 0.f, 0.f}; }
#pragma unroll
                for (int ks = 0; ks < 4; ++ks) {
                    if (ks <= (w >> 1)) {
                        const bf16x8 Lf = SD_FRAG(SD_B, 16 * w + fr, ks);
#pragma unroll
                        for (int jp = 0; jp < 4; ++jp) a1[jp] = __builtin_amdgcn_mfma_f32_16x16x32_bf16(SD_FRAG(SD_XT, 16 * jp + fr, ks), Lf, a1[jp], 0, 0, 0);
                    }
#pragma unroll
                    for (int jp = 0; jp < 4; ++jp) a2[jp] = __builtin_amdgcn_mfma_f32_16x16x32_bf16(SD_FRAG(SD_HB, 16 * jp + fr, ks), Cf[ks], a2[jp], 0, 0, 0);
                }
                const int t = 16 * w + fr; const float ecs = __expf(csv[t]);
                const size_t tok = (size_t)(tokc + t);
#pragma unroll
                for (int jp = 0; jp < 4; ++jp) {
                    const LAS bf16* xt = (const LAS bf16*)(lds + SD_XT) + (16 * jp + 4 * fq) * SD_LD + t;
                    const float x0 = bf2f(xt[0]), x1 = bf2f(xt[SD_LD]), x2 = bf2f(xt[2 * SD_LD]), x3 = bf2f(xt[3 * SD_LD]);
                    v2u yo; yo.x = pk2(a1[jp][0] + ecs * a2[jp][0] + dk * x0, a1[jp][1] + ecs * a2[jp][1] + dk * x1);
                    yo.y = pk2(a1[jp][2] + ecs * a2[jp][2] + dk * x2, a1[jp][3] + ecs * a2[jp][3] + dk * x3);
                    *(v2u*)(Y + tok * 2048 + hd * 64 + 16 * jp + 4 * fq) = yo;
                }
            }
            __syncthreads();
        }
#pragma unroll
        for (int jp = 0; jp < 4; ++jp) *(f32x4*)(o_p + (((size_t)s * 32 + hd) * 64 + 16 * jp + fr) * 128 + 16 * w + 4 * fq) = hacc[jp];
    }
#undef SD_FRAG
#undef SD_PREFETCH
    __syncthreads();
    {
        LAS float* Bw = (LAS float*)(lds + w * 8192);
        LAS float* Cw = Bw + 1024;
        for (int unit = c.gw; unit < 128 * 32; unit += c.NGW) {
            const int b = unit >> 5, hd = unit & 31, g = hd >> 3, tok0 = TP + b * 8, p = lane;
            const float a = -__expf(c.in[c.z + 34][hd]), dtb = c.in[c.z + 33][hd], dk = c.in[c.z + 35][hd];
            {
                const int tk = lane >> 3, c0 = (lane & 7) * 16;
                const bf16* src = XC + (size_t)(tok0 + tk) * CONVD + g * 128 + c0;
                const v4u b0 = *(const v4u*)(src + 2048), b1 = *(const v4u*)(src + 2048 + 8), c0v = *(const v4u*)(src + 2560), c1v = *(const v4u*)(src + 2560 + 8);
                LAS float* bd = Bw + tk * 128 + c0; LAS float* cd = Cw + tk * 128 + c0;
                *(LAS f32x4*)(bd) = (f32x4){bflo(b0.x), bfhi(b0.x), bflo(b0.y), bfhi(b0.y)}; *(LAS f32x4*)(bd + 4) = (f32x4){bflo(b0.z), bfhi(b0.z), bflo(b0.w), bfhi(b0.w)};
                *(LAS f32x4*)(bd + 8) = (f32x4){bflo(b1.x), bfhi(b1.x), bflo(b1.y), bfhi(b1.y)}; *(LAS f32x4*)(bd + 12) = (f32x4){bflo(b1.z), bfhi(b1.z), bflo(b1.w), bfhi(b1.w)};
                *(LAS f32x4*)(cd) = (f32x4){bflo(c0v.x), bfhi(c0v.x), bflo(c0v.y), bfhi(c0v.y)}; *(LAS f32x4*)(cd + 4) = (f32x4){bflo(c0v.z), bfhi(c0v.z), bflo(c0v.w), bfhi(c0v.w)};
                *(LAS f32x4*)(cd + 8) = (f32x4){bflo(c1v.x), bfhi(c1v.x), bflo(c1v.y), bfhi(c1v.y)}; *(LAS f32x4*)(cd + 12) = (f32x4){bflo(c1v.z), bfhi(c1v.z), bflo(c1v.w), bfhi(c1v.w)};
            }
            float xv[8], dA[8], coef[8], yv[8];
#pragma unroll
            for (int t = 0; t < 8; ++t) {
                xv[t] = bf2f(XC[(size_t)(tok0 + t) * CONVD + hd * 64 + p]);
                const float dtv_ = softplus_f(DT[(size_t)(tok0 + t) * 32 + hd] + dtb);
                dA[t] = __expf(dtv_ * a); coef[t] = dtv_ * xv[t]; yv[t] = dk * xv[t];
            }
            asm volatile("s_waitcnt lgkmcnt(0)" ::: "memory");
            const float* hin = c.in[c.z + 6] + (((size_t)b * 32 + hd) * 64 + p) * 128;
            float* hout = o_s + (((size_t)b * 32 + hd) * 64 + p) * 128;
#pragma unroll 1
            for (int qt = 0; qt < 4; ++qt) {
                float h[32];
#pragma unroll
                for (int i = 0; i < 8; ++i) { const f32x4 q = *(const f32x4*)(hin + qt * 32 + 4 * i); h[4 * i] = q[0]; h[4 * i + 1] = q[1]; h[4 * i + 2] = q[2]; h[4 * i + 3] = q[3]; }
#pragma unroll
                for (int t = 0; t < 8; ++t) {
                    float ya = 0.f, yb = 0.f;
#pragma unroll
                    for (int i = 0; i < 8; ++i) {
                        const f32x4 bq = *(const LAS f32x4*)(Bw + t * 128 + qt * 32 + 4 * i), cq = *(const LAS f32x4*)(Cw + t * 128 + qt * 32 + 4 * i);
                        h[4 * i] = h[4 * i] * dA[t] + coef[t] * bq[0]; ya += cq[0] * h[4 * i];
                        h[4 * i + 1] = h[4 * i + 1] * dA[t] + coef[t] * bq[1]; yb += cq[1] * h[4 * i + 1];
                        h[4 * i + 2] = h[4 * i + 2] * dA[t] + coef[t] * bq[2]; ya += cq[2] * h[4 * i + 2];
                        h[4 * i + 3] = h[4 * i + 3] * dA[t] + coef[t] * bq[3]; yb += cq[3] * h[4 * i + 3];
                    }
                    yv[t] += ya + yb;
                    asm volatile("" ::: "memory");
                }
#pragma unroll
                for (int i = 0; i < 8; ++i) *(f32x4*)(hout + qt * 32 + 4 * i) = (f32x4){h[4 * i], h[4 * i + 1], h[4 * i + 2], h[4 * i + 3]};
            }
#pragma unroll
            for (int t = 0; t < 8; ++t) Y[(size_t)(tok0 + t) * 2048 + hd * 64 + p] = (bf16)f2bf(yv[t]);
            asm volatile("" ::: "memory");
        }
    }
}
__device__ __forceinline__ void phase_ssd_gatenorm(const Ctx& c) {
    const bf16* Y = c.W<bf16>(WS_Y); const bf16* Z = c.W<bf16>(WS_Q); bf16* YN = c.W<bf16>(WS_YN);
    v4u yn[4], zn[4];
#pragma unroll
    for (int g = 0; g < 4; ++g) { yn[g] = *(const v4u*)(Y + (size_t)c.gw * 2048 + g * 512 + 8 * c.lane); zn[g] = *(const v4u*)(Z + (size_t)c.gw * 2048 + g * 512 + 8 * c.lane); }
    for (int t = c.gw; t < T; t += c.NGW) {
        v4u yq[4], zq[4];
#pragma unroll
        for (int g = 0; g < 4; ++g) { yq[g] = yn[g]; zq[g] = zn[g]; }
        if (t + c.NGW < T) {
#pragma unroll
            for (int g = 0; g < 4; ++g) { yn[g] = *(const v4u*)(Y + (size_t)(t + c.NGW) * 2048 + g * 512 + 8 * c.lane); zn[g] = *(const v4u*)(Z + (size_t)(t + c.NGW) * 2048 + g * 512 + 8 * c.lane); }
        }
#pragma unroll
        for (int g = 0; g < 4; ++g) {
            const int c0 = g * 512 + 8 * c.lane;
            const float yf[8] = {bflo(yq[g].x), bfhi(yq[g].x), bflo(yq[g].y), bfhi(yq[g].y), bflo(yq[g].z), bfhi(yq[g].z), bflo(yq[g].w), bfhi(yq[g].w)};
            const float zf[8] = {bflo(zq[g].x), bfhi(zq[g].x), bflo(zq[g].y), bfhi(zq[g].y), bflo(zq[g].z), bfhi(zq[g].z), bflo(zq[g].w), bfhi(zq[g].w)};
            float v[8]; float q = 0.f;
#pragma unroll
            for (int j = 0; j < 8; ++j) { v[j] = yf[j] * silu_f(zf[j]); q += v[j] * v[j]; }
            const float r = rsqrtf(wave_sum(q, c.lane) * (1.f / 512.f) + RMS_EPS);
            const f32x4 g0 = *(const f32x4*)(c.in[c.z + 36] + c0), g1 = *(const f32x4*)(c.in[c.z + 36] + c0 + 4);
            v4u o; o.x = pk2(v[0] * r * g0[0], v[1] * r * g0[1]); o.y = pk2(v[2] * r * g0[2], v[3] * r * g0[3]); o.z = pk2(v[4] * r * g1[0], v[5] * r * g1[1]); o.w = pk2(v[6] * r * g1[2], v[7] * r * g1[3]);
            *(v4u*)(YN + (size_t)t * 2048 + c0) = o;
        }
    }
}

__device__ __forceinline__ unsigned ord_key(float s) { const unsigned u = __builtin_bit_cast(unsigned, s); return (u & 0x80000000u) ? ~u : (u | 0x80000000u); }
__device__ __forceinline__ float ord_dec(unsigned k) { const unsigned u = (k & 0x80000000u) ? (k & 0x7fffffffu) : ~k; return __builtin_bit_cast(float, u); }
__device__ __forceinline__ void ins16(unsigned (&Lk)[16], unsigned x) {
#pragma unroll
    for (int k = 0; k < 16; ++k) { const unsigned hi = max(Lk[k], x); x = min(Lk[k], x); Lk[k] = hi; }
}
__device__ __forceinline__ void ce_desc(unsigned& a, unsigned& b) { const unsigned hi = max(a, b), lo = min(a, b); a = hi; b = lo; }
__device__ __forceinline__ void ce_asc(unsigned& a, unsigned& b) { const unsigned hi = max(a, b), lo = min(a, b); a = lo; b = hi; }
__device__ __forceinline__ void sort16_desc(unsigned (&a)[16]) {
#pragma unroll
    for (int k = 2; k <= 16; k <<= 1)
#pragma unroll
        for (int j = k >> 1; j > 0; j >>= 1)
#pragma unroll
            for (int i = 0; i < 16; ++i) { const int l = i ^ j; if (l > i) { if ((i & k) == 0) ce_desc(a[i], a[l]); else ce_asc(a[i], a[l]); } }
}
__device__ __forceinline__ void bmerge16_desc(unsigned (&a)[16]) {
#pragma unroll
    for (int j = 8; j > 0; j >>= 1)
#pragma unroll
        for (int i = 0; i < 16; ++i) { const int l = i ^ j; if (l > i) ce_desc(a[i], a[l]); }
}
__device__ __forceinline__ void xmerge16(unsigned (&a)[16], int o, int lane) {
    unsigned pq[16];
#pragma unroll
    for (int k = 0; k < 16; ++k) pq[k] = (unsigned)__builtin_amdgcn_ds_bpermute((lane ^ o) << 2, (int)a[k]);
#pragma unroll
    for (int k = 0; k < 16; ++k) a[k] = max(a[k], pq[15 - k]);
    bmerge16_desc(a);
}
struct CandTab { unsigned char v[52]; };
constexpr CandTab make_cands() { CandTab t{}; int n = 0; for (int i = 0; i < 16; ++i) for (int j = 0; j < 16; ++j) if ((i + 1) * (j + 1) <= 16) t.v[n++] = (unsigned char)(i * 16 + j); return t; }
__device__ __forceinline__ void phase_route(const Ctx& c, int layer, bool docvt) {
    constexpr CandTab CT = make_cands();
    const bf16* Q = c.W<bf16>(WS_Q); const bf16* KEYS = c.W<bf16>(WS_KEYS) + (size_t)layer * 8 * 2 * 128 * 128;
    int* IDX = c.W<int>(WS_IDX); float* GATE = c.W<float>(WS_GATE);
    const int lane = c.lane, fr = lane & 15, fq = lane >> 4;
    constexpr int RK_LD = 136, RK_BYTES = 2 * 128 * RK_LD * 2;
    LAS unsigned* lists = (LAS unsigned*)(c.lds + RK_BYTES + c.wave * 2048);
    const int h = c.bid & 7;
    {
        const bf16* kg = KEYS + (size_t)h * 2 * 128 * 128;
        for (int q = c.tid; q < 2 * 128 * 16; q += NTHR) { const int row = q >> 4, cc = q & 15; *(LAS v4u*)(c.lds + (row * RK_LD + cc * 8) * 2) = *(const v4u*)(kg + (size_t)row * 128 + cc * 8); }
    }
    __syncthreads();
    const bool cvt_first = ((c.wave >> 2) & 1) == 0;
    if (docvt && cvt_first) cvt_tables(c, layer);
    const int nb8 = c.nblk >> 3;
    for (int tg = (c.bid >> 3) + nb8 * c.wave; tg < 1088; tg += nb8 * NWAVES) {
        const int tok0 = tg * 16;
        const bf16* qrow = Q + (size_t)(tok0 + fr) * 2048 + h * 256 + 8 * fq;
#pragma unroll
        for (int side = 0; side < 2; ++side) {
            bf16x8 qf[4];
#pragma unroll
            for (int ks = 0; ks < 4; ++ks) qf[ks] = *(const bf16x8*)(qrow + side * 128 + ks * 32);
            const LAS unsigned char* kb = c.lds + ((side * 128 + fr) * RK_LD + 8 * fq) * 2;
            unsigned A[16], B[16];
#pragma unroll
            for (int nt = 0; nt < 8; ++nt) {
                f32x4 acc = {0.f, 0.f, 0.f, 0.f};
#pragma unroll
                for (int ks = 0; ks < 4; ++ks) acc = __builtin_amdgcn_mfma_f32_16x16x32_bf16(*(const LAS bf16x8*)(kb + (nt * 16 * RK_LD + ks * 32) * 2), qf[ks], acc, 0, 0, 0);
#pragma unroll
                for (int r = 0; r < 4; ++r) {
                    const unsigned key = (ord_key(acc[r]) & ~127u) | (unsigned)(127 - (16 * nt + 4 * fq + r));
                    if (nt < 4) A[nt * 4 + r] = key; else B[(nt - 4) * 4 + r] = key;
                }
            }
            sort16_desc(A); sort16_desc(B);
#pragma unroll
            for (int k = 0; k < 16; ++k) A[k] = max(A[k], B[15 - k]);
            bmerge16_desc(A);
            xmerge16(A, 16, lane); xmerge16(A, 32, lane);
            if (fq == 0) {
#pragma unroll
                for (int k = 0; k < 4; ++k) *(LAS v4u*)(lists + (fr * 2 + side) * 16 + 4 * k) = (v4u){A[4 * k], A[4 * k + 1], A[4 * k + 2], A[4 * k + 3]};
            }
        }
        asm volatile("s_waitcnt lgkmcnt(0)" ::: "memory");
        int fq2 = fq, fr2 = fr; asm volatile("" : "+v"(fq2), "+v"(fr2));
        unsigned Cd[16];
#pragma unroll
        for (int k = 0; k < 13; ++k) {
            const int ij = (fq2 == 0) ? CT.v[k] : (fq2 == 1) ? CT.v[13 + k] : (fq2 == 2) ? CT.v[26 + k] : ((39 + k < 50) ? CT.v[(39 + k < 50) ? 39 + k : 0] : 0);
            const bool ok = (fq2 < 3) || (39 + k < 50);
            const unsigned k0 = lists[(fr2 * 2) * 16 + (ij >> 4)], k1 = lists[(fr2 * 2 + 1) * 16 + (ij & 15)];
            const unsigned x = (ord_key(ord_dec(k0 & ~127u) + ord_dec(k1 & ~127u)) & ~255u) | (unsigned)(255 - ij);
            Cd[k] = ok ? x : 0u;
        }
        Cd[13] = 0u; Cd[14] = 0u; Cd[15] = 0u;
        sort16_desc(Cd);
        xmerge16(Cd, 16, lane); xmerge16(Cd, 32, lane);
        float e[16], su[16]; int id[16]; float mx = 0.f, den = 0.f;
#pragma unroll
        for (int k = 0; k < 16; ++k) {
            const int pay = 255 - (int)(Cd[k] & 255u), i = pay >> 4, j = pay & 15;
            const unsigned k0 = lists[(fr2 * 2) * 16 + i], k1 = lists[(fr2 * 2 + 1) * 16 + j];
            id[k] = (127 - (int)(k0 & 127u)) * 128 + (127 - (int)(k1 & 127u));
            const float sv = ord_dec(k0 & ~127u) + ord_dec(k1 & ~127u);
            if (k == 0) mx = sv;
            e[k] = __expf(sv - mx); den += e[k];
        }
        const float inv = 1.f / den;
        int oi[4]; float og[4];
#pragma unroll
        for (int r = 0; r < 4; ++r) {
            oi[r] = (fq2 == 0) ? id[r] : (fq2 == 1) ? id[4 + r] : (fq2 == 2) ? id[8 + r] : id[12 + r];
            og[r] = (fq2 == 0) ? e[r] : (fq2 == 1) ? e[4 + r] : (fq2 == 2) ? e[8 + r] : e[12 + r];
        }
#pragma unroll
        for (int r = 0; r < 4; ++r) og[r] *= inv;
        const size_t ob = (size_t)(tok0 + fr2) * 128 + h * 16 + 4 * fq2;
        *(int4*)(IDX + ob) = make_int4(oi[0], oi[1], oi[2], oi[3]);
        *(f32x4*)(GATE + ob) = (f32x4){og[0], og[1], og[2], og[3]};
        asm volatile("" ::: "memory");
        (void)su;
    }
    if (docvt && !cvt_first) cvt_tables(c, layer);
}

__device__ __forceinline__ unsigned shxu(unsigned v, int o, int lane) { return __builtin_bit_cast(unsigned, shx(__builtin_bit_cast(float, v), o, lane)); }
constexpr int GS_TOK = 128 * 12, GS_WAVE = 9 * GS_TOK;
__device__ __forceinline__ void sort_tokens_to_lds(const Ctx& c, LAS unsigned char* sl, int nslots, int nfull, int tok_extra) {
    const int* IDX = c.W<int>(WS_IDX); const float* GATE = c.W<float>(WS_GATE);
    const float* ISU = c.W<float>(WS_SMALL) + SM_ISU; const float* ISV = c.W<float>(WS_SMALL) + SM_ISV;
    const int lane = c.lane;
    for (int j = 0; j < nslots; ++j) {
        const size_t base = (size_t)((j < nfull) ? (c.gw + j * c.NGW) : tok_extra) * 128;
        unsigned k0 = ((unsigned)IDX[base + lane] << 7) | (unsigned)lane, k1 = ((unsigned)IDX[base + 64 + lane] << 7) | (unsigned)(64 + lane);
#pragma unroll
        for (int k = 2; k <= 128; k <<= 1) {
#pragma unroll
            for (int jd = k >> 1; jd > 0; jd >>= 1) {
                if (jd == 64) { const unsigned lo = min(k0, k1), hi = max(k0, k1); k0 = lo; k1 = hi; }
                else {
                    const unsigned p0 = shxu(k0, jd, lane), p1 = shxu(k1, jd, lane);
                    const bool lower = (lane & jd) == 0;
                    const bool asc0 = (k == 128) ? true : (k == 64) ? true : ((lane & k) == 0);
                    const bool asc1 = (k == 128) ? true : (k == 64) ? false : ((lane & k) == 0);
                    k0 = (lower == asc0) ? min(k0, p0) : max(k0, p0);
                    k1 = (lower == asc1) ? min(k1, p1) : max(k1, p1);
                }
            }
        }
        const int s0 = (int)(k0 & 127u), s1 = (int)(k1 & 127u);
        LAS int* li = (LAS int*)(sl + j * GS_TOK); LAS float* lg = (LAS float*)(sl + j * GS_TOK + 512); LAS float* lu = (LAS float*)(sl + j * GS_TOK + 1024);
        li[lane] = (int)(k0 >> 7); li[64 + lane] = (int)(k1 >> 7);
        const int e0 = (int)(k0 >> 7), e1 = (int)(k1 >> 7);
        lg[lane] = GATE[base + s0] * ISV[e0]; lg[64 + lane] = GATE[base + s1] * ISV[e1]; lu[lane] = ISU[e0]; lu[64 + lane] = ISU[e1];
    }
    asm volatile("s_waitcnt vmcnt(0) lgkmcnt(0)" ::: "memory");
}

typedef float f32x2 __attribute__((ext_vector_type(2)));
typedef _Float16 h2 __attribute__((ext_vector_type(2)));
typedef _Float16 v32h __attribute__((ext_vector_type(32)));
__device__ __forceinline__ v3u gt_row(const unsigned char* tab, int idx, unsigned lane12) {
    const unsigned char* rowp = tab + (size_t)((unsigned)idx * (unsigned)EROW);
    asm volatile("" : "+s"(rowp));
    return *(const __attribute__((address_space(1))) v3u*)((const __attribute__((address_space(1))) unsigned char*)rowp + lane12);
}
__device__ __forceinline__ void fp4_row(const v2u r, h2 (&y)[8]) {
    y[0] = __builtin_amdgcn_cvt_scalef32_pk_f16_fp4(r[0], 1.0f, 0); y[1] = __builtin_amdgcn_cvt_scalef32_pk_f16_fp4(r[0], 1.0f, 1);
    y[2] = __builtin_amdgcn_cvt_scalef32_pk_f16_fp4(r[0], 1.0f, 2); y[3] = __builtin_amdgcn_cvt_scalef32_pk_f16_fp4(r[0], 1.0f, 3);
    y[4] = __builtin_amdgcn_cvt_scalef32_pk_f16_fp4(r[1], 1.0f, 0); y[5] = __builtin_amdgcn_cvt_scalef32_pk_f16_fp4(r[1], 1.0f, 1);
    y[6] = __builtin_amdgcn_cvt_scalef32_pk_f16_fp4(r[1], 1.0f, 2); y[7] = __builtin_amdgcn_cvt_scalef32_pk_f16_fp4(r[1], 1.0f, 3);
}
__device__ __forceinline__ v2u gt_rowv(const unsigned char* tab, int idx, unsigned lane8) {
    const unsigned char* rowp = tab + (size_t)((unsigned)idx * (unsigned)VROW);
    asm volatile("" : "+s"(rowp));
    return *(const __attribute__((address_space(1))) v2u*)((const __attribute__((address_space(1))) unsigned char*)rowp + lane8);
}
__device__ __forceinline__ void phase_gather(const Ctx& c, int layer, bool dummy) {
    const unsigned char* EU = c.ws + WS_EU; const unsigned char* EV = c.ws + WS_EV;
    const float* H = c.W<float>(WS_H32); float* Ho = dummy ? c.W<float>(WS_R32) : c.W<float>(WS_H32); bf16* HB = dummy ? c.W<bf16>(WS_A0) : c.W<bf16>(WS_HB);
    const float* g = c.in[c.z + 40] + layer * D; const float* b = c.in[c.z + 41] + layer * D;
    const int lane = c.lane;
    const int nfull = T / c.NGW, rem = T - nfull * c.NGW;
    const bool pairmode = (2 * rem == c.NGW);
    const int half = pairmode ? (c.gw & 1) : 0;
    const int xsteps = pairmode ? 4 : ((c.gw < rem) ? 8 : 0);
    const int tok_extra = nfull * c.NGW + (pairmode ? (c.gw >> 1) : c.gw);
    const int nmain = nfull * 8, nit = nmain + xsteps;
    LAS unsigned char* sl = c.lds + c.wave * GS_WAVE;
    LAS float* xchg = (LAS float*)(c.lds + 8 * GS_WAVE + (c.wave >> 1) * 4096);
    volatile LAS int* flag = (volatile LAS int*)(c.lds + 8 * GS_WAVE + 4 * 4096) + (c.wave >> 1);
    if (c.tid < 4) ((volatile LAS int*)(c.lds + 8 * GS_WAVE + 4 * 4096))[c.tid] = 0;
    LAS float* lgb = (LAS float*)(c.lds + 8 * GS_WAVE + 4 * 4096 + 64);
    { const f32x4 q = (c.tid < 256) ? *(const f32x4*)(g + 4 * c.tid) : *(const f32x4*)(b + 4 * (c.tid - 256)); *(LAS f32x4*)(lgb + 4 * c.tid) = q; }
    __syncthreads();
    sort_tokens_to_lds(c, sl, nfull + (xsteps ? 1 : 0), nfull, tok_extra);
#define GT_SLOT(it) (((it) < nmain) ? ((it) >> 3) : nfull)
#define GT_BT(it) (((it) < nmain) ? ((it) & 7) : ((it) - nmain + 4 * half))
#define GT_TOK(it) (((it) < nmain) ? (c.gw + ((it) >> 3) * c.NGW) : tok_extra)
#define GT_IDX(it) (((it) < nit) ? ((const LAS int*)(sl + GT_SLOT(it) * GS_TOK))[GT_BT(it) * 16 + (lane & 15)] : 0)
#define GT_GS(P, it) (((const LAS float*)(sl + GT_SLOT((it) < nit ? (it) : 0) * GS_TOK + (P)))[GT_BT((it) < nit ? (it) : 0) * 16 + (lane & 15)])
#define GT_ROW(TAB, idxreg, e) gt_row((TAB), __builtin_amdgcn_readlane((idxreg), (e)), lane12)
#define GT_ROWV(idxreg, e) gt_rowv(EV, __builtin_amdgcn_readlane((idxreg), (e)), lane8)
    const unsigned lane12 = 12u * (unsigned)lane, lane8 = 8u * (unsigned)lane;
    int idx_c = GT_IDX(0), idx_n = GT_IDX(1);
    float gate_c = GT_GS(512, 0), scu_c = GT_GS(1024, 0);
    float xs[16], acc[16], xn[16];
    h2 xh[8];
    v3u ru[16];
    v2u rv[16];
    if (nit > 0) {
        const int t0 = GT_TOK(0);
#pragma unroll
        for (int k = 0; k < 4; ++k) { const f32x4 hx = *(const f32x4*)(H + (size_t)t0 * D + 16 * lane + 4 * k); xn[4 * k] = hx[0]; xn[4 * k + 1] = hx[1]; xn[4 * k + 2] = hx[2]; xn[4 * k + 3] = hx[3]; }
    }
#pragma unroll
    for (int e = 0; e < 16; ++e) { ru[e] = GT_ROW(EU, idx_c, e); rv[e] = GT_ROWV(idx_c, e); }
#pragma unroll
    for (int e = 0; e < 16; ++e) { asm volatile("" : "+v"(ru[e]), "+v"(rv[e])); }
#pragma unroll
    for (int i = 0; i < 16; ++i) { asm volatile("" : "+v"(xn[i])); }
    for (int it = 0; it < nit; ++it) {
        const int t = GT_TOK(it);
        const bool first = (it & 7) == 0, last = (it < nmain) ? ((it & 7) == 7) : (it == nit - 1);
        const int idx_nn = GT_IDX(it + 2);
        const float gate_n = GT_GS(512, it + 1), scu_n = GT_GS(1024, it + 1);
        const float mygate = gate_c, myscu = scu_c;
        if (first) {
            asm volatile("" ::: "memory");
#pragma unroll
            for (int i = 0; i < 16; ++i) { xs[i] = xn[i]; acc[i] = 0.f; }
#pragma unroll
            for (int j = 0; j < 8; ++j) xh[j] = (h2){(_Float16)xn[2 * j], (_Float16)xn[2 * j + 1]};
        }
        if (last && it + 1 < nit) {
            const int t1 = GT_TOK(it + 1);
#pragma unroll
            for (int k = 0; k < 4; ++k) { const f32x4 hx = *(const f32x4*)(H + (size_t)t1 * D + 16 * lane + 4 * k); xn[4 * k] = hx[0]; xn[4 * k + 1] = hx[1]; xn[4 * k + 2] = hx[2]; xn[4 * k + 3] = hx[3]; }
        }
        float pv[16];
#pragma unroll
        for (int e = 0; e < 16; e += 2) {
            const v32h y = __builtin_amdgcn_cvt_scalef32_pk32_f16_fp6((v6u){ru[e][0], ru[e][1], ru[e][2], ru[e + 1][0], ru[e + 1][1], ru[e + 1][2]}, 1.0f);
            float d0 = 0.f, d1 = 0.f, d2 = 0.f, d3 = 0.f;
#pragma unroll
            for (int j = 0; j < 8; j += 2) {
                d0 = __builtin_amdgcn_fdot2((h2){y[2 * j], y[2 * j + 1]}, xh[j], d0, false);
                d1 = __builtin_amdgcn_fdot2((h2){y[16 + 2 * j], y[17 + 2 * j]}, xh[j], d1, false);
                d2 = __builtin_amdgcn_fdot2((h2){y[2 * j + 2], y[2 * j + 3]}, xh[j + 1], d2, false);
                d3 = __builtin_amdgcn_fdot2((h2){y[18 + 2 * j], y[19 + 2 * j]}, xh[j + 1], d3, false);
            }
            pv[e] = d0 + d2; pv[e + 1] = d1 + d3;
            ru[e] = GT_ROW(EU, idx_n, e); ru[e + 1] = GT_ROW(EU, idx_n, e + 1);
        }
        const float tot = reduce16d(pv, lane);
        const float wgt = mygate * gelu_f(tot * myscu);
        const _Float16 wh = (_Float16)wgt;
        const int wpk = __builtin_bit_cast(int, (h2){wh, wh});
        h2 p[8];
#pragma unroll
        for (int e = 0; e < 16; e += 2) {
            const h2 w0 = __builtin_bit_cast(h2, __builtin_amdgcn_readlane(wpk, e));
            const h2 w1 = __builtin_bit_cast(h2, __builtin_amdgcn_readlane(wpk, e + 1));
            h2 ya[8], yb[8];
            fp4_row(rv[e], ya); fp4_row(rv[e + 1], yb);
#pragma unroll
            for (int j = 0; j < 8; ++j) p[j] = (e == 0) ? ya[j] * w0 : ya[j] * w0 + p[j];
#pragma unroll
            for (int j = 0; j < 8; ++j) p[j] = yb[j] * w1 + p[j];
            rv[e] = GT_ROWV(idx_n, e); rv[e + 1] = GT_ROWV(idx_n, e + 1);
        }
#pragma unroll
        for (int j = 0; j < 8; ++j) { acc[2 * j] += (float)p[j][0]; acc[2 * j + 1] += (float)p[j][1]; }
        if (last && it >= nmain && pairmode && half == 1) {
            int l3 = lane; asm volatile("" : "+v"(l3));
#pragma unroll
            for (int k = 0; k < 4; ++k) *(LAS f32x4*)(xchg + l3 * 16 + 4 * k) = (f32x4){acc[4 * k], acc[4 * k + 1], acc[4 * k + 2], acc[4 * k + 3]};
            asm volatile("s_waitcnt lgkmcnt(0)" ::: "memory");
            if (l3 == 0) *flag = 1;
        } else if (last) {
            int l2 = lane; asm volatile("" : "+v"(l2));
            if (it >= nmain && pairmode) {
                while (*flag == 0) __builtin_amdgcn_s_sleep(2);
                asm volatile("" ::: "memory");
#pragma unroll
                for (int k = 0; k < 4; ++k) { const f32x4 pa = *(const LAS f32x4*)(xchg + l2 * 16 + 4 * k); acc[4 * k] += pa[0]; acc[4 * k + 1] += pa[1]; acc[4 * k + 2] += pa[2]; acc[4 * k + 3] += pa[3]; }
            }
            f32x4 v[4];
#pragma unroll
            for (int k = 0; k < 4; ++k) v[k] = (f32x4){xs[4 * k], xs[4 * k + 1], xs[4 * k + 2], xs[4 * k + 3]} * ALPHA + (f32x4){acc[4 * k], acc[4 * k + 1], acc[4 * k + 2], acc[4 * k + 3]};
            float mean, rstd; ln_stats(v, mean, rstd, l2);
            float* o32 = ((layer == 3 && !dummy) ? c.out : Ho) + (size_t)t * D + 16 * l2;
            bf16* ob = (layer == 3 && !dummy) ? (bf16*)nullptr : HB + (size_t)t * D + 16 * l2;
            v4u wb[2];
#pragma unroll
            for (int k = 0; k < 4; ++k) {
                const f32x4 g4 = *(const LAS f32x4*)(lgb + 16 * l2 + 4 * k), b4 = *(const LAS f32x4*)(lgb + 1024 + 16 * l2 + 4 * k);
                const f32x4 o = (v[k] - mean) * rstd * g4 + b4;
                *(f32x4*)(o32 + 4 * k) = o;
                if (k & 1) { wb[k >> 1].z = pk2(o[0], o[1]); wb[k >> 1].w = pk2(o[2], o[3]); } else { wb[k >> 1].x = pk2(o[0], o[1]); wb[k >> 1].y = pk2(o[2], o[3]); }
            }
            if (ob) { *(v4u*)(ob) = wb[0]; *(v4u*)(ob + 8) = wb[1]; }
        }
        idx_c = idx_n; idx_n = idx_nn; gate_c = gate_n; scu_c = scu_n;
    }
#undef GT_ROW
#undef GT_ROWV
#undef GT_GS
#undef GT_IDX
#undef GT_TOK
#undef GT_SLOT
#undef GT_BT
}

#define XB_TMO      128
#define XB_XCNT(j)  (256  + 64 * (j))
#define XB_XSUB(j)  (1280 + 64 * (j))
#define XB_XGEN(j)  (2304 + 64 * (j))
#define XB_TOP      3328
#define XB_TOPGEN   3392
#define XCD_BAR_WORDS 3456
#define XB_SPIN_CAP (1u << 22)
__device__ __forceinline__ unsigned xb_ld(unsigned* p)              { return __hip_atomic_load(p, __ATOMIC_RELAXED, __HIP_MEMORY_SCOPE_AGENT); }
__device__ __forceinline__ unsigned xb_add(unsigned* p, unsigned v) { return __hip_atomic_fetch_add(p, v, __ATOMIC_RELAXED, __HIP_MEMORY_SCOPE_AGENT); }
__device__ __forceinline__ unsigned xb_xcc_id() { return (unsigned)__builtin_amdgcn_s_getreg((3 << 11) | 20) & 0xFu; }
#define XB_SPIN(cond, bar) do { unsigned _sp = 0; while (cond) { __builtin_amdgcn_s_sleep(1); \
    if ((++_sp & 255u) == 0u) { if (xb_ld(&(bar)[XB_TMO])) break; if (_sp > XB_SPIN_CAP) { atomicAdd(&(bar)[XB_TMO], 1u); break; } } } } while (0)
struct XcdBarrier { unsigned* bar; unsigned x; volatile LAS unsigned* st; };
__device__ __forceinline__ XcdBarrier xcd_barrier_post(unsigned* bar, volatile LAS unsigned* st) {
    XcdBarrier b; b.bar = bar; b.x = xb_xcc_id(); b.st = st;
    if (threadIdx.x == 0) (void)xb_add(&bar[XB_XCNT(b.x)], 1u);
    return b;
}
__device__ __forceinline__ void xcd_barrier_complete(unsigned* bar, unsigned x, unsigned& nloc, unsigned& nx) {
    const unsigned G = gridDim.x * gridDim.y * gridDim.z;
    unsigned sum, cnt, mine, sp = 0u;
    for (;;) {
        sum = 0u; cnt = 0u; mine = 0u;
#pragma unroll
        for (unsigned j = 0; j < 16; ++j) { const unsigned cc = xb_ld(&bar[XB_XCNT(j)]); sum += cc; cnt += (cc > 0u) ? 1u : 0u; mine = (j == x) ? cc : mine; }
        if (sum == G) break;
        __builtin_amdgcn_s_sleep(1);
        if ((++sp & 255u) == 0u) { if (xb_ld(&bar[XB_TMO])) break; if (sp > XB_SPIN_CAP) { atomicAdd(&bar[XB_TMO], 1u); break; } }
    }
    nloc = mine > 0u ? mine : 1u; nx = cnt > 0u ? cnt : 1u;
}
__device__ __forceinline__ void xcd_barrier(const XcdBarrier& b, int tid) {
    asm volatile("s_waitcnt vmcnt(0)" ::: "memory");
    __syncthreads();
    if (tid == 0) {
        unsigned* bar = b.bar;
        __builtin_amdgcn_s_waitcnt(0);
        unsigned nloc = b.st[0], nx = b.st[1];
        if (nloc == 0u) { xcd_barrier_complete(bar, b.x, nloc, nx); b.st[0] = nloc; b.st[1] = nx; }
        const unsigned old = xb_add(&bar[XB_XSUB(b.x)], 1u);
        const unsigned gen = old / nloc;
        if (old + 1u == (gen + 1u) * nloc) {
            __builtin_amdgcn_fence(__ATOMIC_RELEASE, "agent");
            asm volatile("s_waitcnt vmcnt(0)" ::: "memory");
            const unsigned og = xb_add(&bar[XB_TOP], 1u);
            const unsigned tg = og / nx;
            if (og + 1u == (tg + 1u) * nx) xb_add(&bar[XB_TOPGEN], 1u);
            else XB_SPIN(xb_ld(&bar[XB_TOPGEN]) == tg, bar);
            __builtin_amdgcn_fence(__ATOMIC_ACQUIRE, "agent");
            xb_add(&bar[XB_XGEN(b.x)], 1u);
            asm volatile("s_waitcnt vmcnt(0)" ::: "memory");
        } else {
            XB_SPIN(xb_ld(&bar[XB_XGEN(b.x)]) == gen, bar);
            __builtin_amdgcn_fence(__ATOMIC_ACQUIRE, "agent");
            asm volatile("s_waitcnt vmcnt(0)" ::: "memory");
        }
    }
    __syncthreads();
}

__global__ void __launch_bounds__(NTHR, 2) mega(Params P) {
    extern __shared__ __attribute__((aligned(16))) unsigned char lds_raw[];
    Ctx c;
    c.in = P.in; c.out = P.out; c.ws = P.ws; c.lds = (LAS unsigned char*)lds_raw; c.z = 0;
    c.tid = threadIdx.x; c.lane = c.tid & 63; c.wave = __builtin_amdgcn_readfirstlane(c.tid >> 6);
    c.gw = (int)blockIdx.x * NWAVES + c.wave; c.NGW = (int)gridDim.x * NWAVES; c.gt = (int)blockIdx.x * NTHR + c.tid; c.NGT = (int)gridDim.x * NTHR; c.bid = (int)blockIdx.x; c.nblk = (int)gridDim.x;
#define RF() do { int zs_ = 0; asm volatile("" : "+s"(zs_)); c.z = zs_; c.lds = (LAS unsigned char*)lds_raw + zs_; int z_ = 0; asm volatile("" : "+v"(z_)); const int l_ = (int)__builtin_amdgcn_mbcnt_hi(~0u, __builtin_amdgcn_mbcnt_lo(~0u, (unsigned)z_)); c.lane = l_; c.tid = c.wave * 64 + l_; c.bid = (int)blockIdx.x + zs_; c.nblk = (int)gridDim.x + zs_; c.gw = c.bid * NWAVES + c.wave; c.NGW = c.nblk * NWAVES; c.gt = c.bid * NTHR + c.tid; c.NGT = c.nblk * NTHR; } while (0)
    bf16* HB = c.W<bf16>(WS_HB); bf16* A0 = c.W<bf16>(WS_A0); bf16* A1 = c.W<bf16>(WS_A1); bf16* A2 = c.W<bf16>(WS_A2); bf16* Qb = c.W<bf16>(WS_Q);
    float* H32 = c.W<float>(WS_H32); float* R32 = c.W<float>(WS_R32);

    if (threadIdx.x < 16) ((volatile LAS unsigned*)(c.lds + MISC_OFF))[threadIdx.x] = 0u;
    __syncthreads();
    const XcdBarrier xbar = xcd_barrier_post(c.W<unsigned>(WS_CTL), (volatile LAS unsigned*)(c.lds + MISC_OFF));
#define GSYNC() do { RF(); xcd_barrier(xbar, c.tid); } while (0)
    RF(); prologue(c);
    GSYNC();
    for (int layer = 0; layer < 4; ++layer) {
        if (layer <= 1) {
            const bf16* Wt = c.W<bf16>(layer == 0 ? WS_W_S5IN : WS_W_PIN);
            RF(); run_gemm(c, HB, D, 0, Wt, 1024, 1024, EpiBf16<0>{A0, D, nullptr, nullptr, nullptr});
        } else if (layer == 2) {
            RF(); run_gemm(c, HB, D, 0, c.W<bf16>(WS_W_CIN), 2048, 1024, EpiBf16<1>{Qb, 2048, c.in[c.z + 24], nullptr, nullptr});
        } else {
            RF(); run_gemm_all(c, HB, D, 0, c.W<bf16>(WS_W_SIN), NPROJ, 1024, EpiSsdProj{Qb, c.W<bf16>(WS_XBC), c.W<float>(WS_DT)});
        }
        GSYNC();
        const bf16* Aout = A2; const bf16* Wout;
        if (layer == 0) {
            for (int r = 0; r < PR_S5; ++r) { RF(); phase_s5scan(c); }
            GSYNC();
            RF(); run_gemm(c, A1, D, 0, c.W<bf16>(WS_W_S5GLU), 1024, 1024, EpiBf16<3>{A2, D, c.in[c.z + 17], nullptr, A1});
            Wout = c.W<bf16>(WS_W_S5OUT);
        } else if (layer == 1) {
            RF(); phase_pool(c);
            GSYNC();
            RF(); run_gemm(c, A1, D, 256, c.W<bf16>(WS_W_PGRP), 1024, 256, EpiBf16<2>{A2, D, nullptr, c.in[c.z + 21], nullptr});
            Wout = c.W<bf16>(WS_W_POUT);
        } else if (layer == 2) {
            RF(); phase_cmlp_ln(c);
            GSYNC();
            RF(); phase_cmlp_mix(c);
            Aout = A1; Wout = c.W<bf16>(WS_W_COUT);
        } else {
            RF(); phase_ssd_conv(c);
            GSYNC();
            for (int r = 0; r < PR_SSD; ++r) { RF(); phase_ssd_scan(c); }
            GSYNC();
            RF(); phase_ssd_gatenorm(c);
            Aout = c.W<bf16>(WS_YN); Wout = c.W<bf16>(WS_W_SOUT);
        }
        GSYNC();
        if (layer == 3) { RF(); run_gemm(c, Aout, 2048, 0, Wout, 1024, 2048, EpiBf16<0>{A0, D, nullptr, nullptr, nullptr}); }
        else { RF(); run_gemm(c, Aout, 1024, 0, Wout, 1024, 1024, EpiBf16<0>{A0, D, nullptr, nullptr, nullptr}); }
        GSYNC();
        RF(); phase_ln1(c, layer);
        GSYNC();
        RF(); run_gemm(c, HB, D, 0, c.W<bf16>(WS_W_PQ) + (size_t)layer * 2048 * 1024, 2048, 1024, EpiBf16<0>{Qb, 2048, nullptr, nullptr, nullptr});
        GSYNC();
        for (int r = 0; r < PR_ROUTE; ++r) { RF(); phase_route(c, layer, layer > 0 && r == 0); }
        GSYNC();
        for (int r = 1; r < PR_GATHER; ++r) { RF(); phase_gather(c, layer, true); }
        RF(); phase_gather(c, layer, false);
        GSYNC();
    }
}
}

extern "C" void kernel_launch(void* const* d_in, const int* in_sizes, int n_in, void* d_out, int out_size, void* d_ws, size_t ws_size, hipStream_t stream) {
    static int grid = 0;
    if (grid == 0) {
        int dev = 0, cus = 0, per_cu = 0;
        if (hipGetDevice(&dev) != hipSuccess || hipDeviceGetAttribute(&cus, hipDeviceAttributeMultiprocessorCount, dev) != hipSuccess) { fprintf(stderr, "kernel_launch: device query failed\n"); grid = -1; return; }
        if (hipFuncSetAttribute((const void*)mk::mega, hipFuncAttributeMaxDynamicSharedMemorySize, mk::LDS_BYTES) != hipSuccess) { fprintf(stderr, "kernel_launch: hipFuncSetAttribute failed\n"); grid = -1; return; }
        if (hipOccupancyMaxActiveBlocksPerMultiprocessor(&per_cu, (const void*)mk::mega, mk::NTHR, mk::LDS_BYTES) != hipSuccess || per_cu < 1) { fprintf(stderr, "kernel_launch: occupancy query says %d blocks per CU\n", per_cu); grid = -1; return; }
        grid = cus;
        if (ws_size < mk::WS_END) { fprintf(stderr, "kernel_launch: workspace too small (%zu < %zu)\n", ws_size, (size_t)mk::WS_END); grid = -1; return; }
    }
    if (grid < 0) return;
    mk::Params p{};
    for (int i = 0; i < 46; ++i) p.in[i] = (const float*)d_in[i];
    p.out = (float*)d_out; p.ws = (unsigned char*)d_ws;
    if (hipMemsetAsync((char*)d_ws + mk::WS_CTL, 0, mk::CTL_BYTES, stream) != hipSuccess) { fprintf(stderr, "kernel_launch: memset failed\n"); return; }
    void* args[] = {&p};
    hipError_t e = hipLaunchCooperativeKernel((const void*)mk::mega, dim3(grid), dim3(mk::NTHR), args, mk::LDS_BYTES, stream);
    if (e != hipSuccess) fprintf(stderr, "cooperative launch failed: %s (grid %d)\n", hipGetErrorString(e), grid);
}
```

```cpp
#include <hip/hip_runtime.h>
#include <hip/hip_cooperative_groups.h>
#include <cstdio>
#include <cstdint>
#include <math.h>
namespace cg = cooperative_groups;

namespace pg8 {
#define PG8_LAS __attribute__((address_space(3)))
typedef unsigned short bf16_t;
typedef short bf16x8 __attribute__((ext_vector_type(8)));
typedef float f32x4 __attribute__((ext_vector_type(4)));
typedef unsigned u32x4 __attribute__((ext_vector_type(4)));
constexpr int BM = 256, BK = 64, HALF = 128, HTB = HALF * BK * 2, STAGE_BYTES = 8 * HTB, NXCD = 8, WGM = 8;
__host__ __device__ __forceinline__ int lds_byte(int r, int c) { const int st = (r >> 4) * 2 + (c >> 5), rr = r & 15, cc = c & 31, ob = rr * 64 + cc * 2; return st * 1024 + (ob ^ (((ob >> 9) & 1) << 5)); }
__host__ __device__ __forceinline__ void stage_rc(int b, int& R, int& C) { const int st = b / 1024, sb = b % 1024, swz = sb ^ (((sb >> 9) & 1) << 5); R = (st >> 1) * 16 + swz / 64; C = (st & 1) * 32 + (swz % 64) / 2; }
__host__ __device__ __forceinline__ int perm32(int rho) { const int n = rho >> 4, i = rho & 15; return 8 * (i >> 2) + 4 * n + (i & 3); }
struct Unit { int pm, pn; };
struct Gemm { const bf16_t* A; const bf16_t* Bt; int M, N, K, lda, a_pn_off; };
struct StaticOrder {
    int nM, nN, nwg, G, c;
    __host__ __device__ void init(int M, int N, int G_, int c_) { nM = M / BM; nN = N / BM; nwg = nM * nN; G = G_; c = c_; }
    __host__ __device__ bool next(int i, Unit& u) const {
        const long L = (long)i * G + c; if (L >= nwg) return false;
        int wgid = (int)L; { const int q = nwg / NXCD, r = nwg % NXCD, xcd = wgid % NXCD, off = wgid / NXCD; wgid = (xcd < r ? xcd * (q + 1) : r * (q + 1) + (xcd - r) * q) + off; }
        const int nig = WGM * nN, gid = wgid / nig, fm = gid * WGM, gsz = (nM - fm) < WGM ? (nM - fm) : WGM;
        u.pm = fm + ((wgid % nig) % gsz); u.pn = (wgid % nig) / gsz; return true;
    }
    __device__ __forceinline__ void a_ready(const Unit&) const {}
    __device__ __forceinline__ void done(const Unit&) const {}
};
__device__ __forceinline__ unsigned rne1(float f) { unsigned u = __builtin_bit_cast(unsigned, f); return (u + 0x7fffu + ((u >> 16) & 1u)) >> 16; }
__device__ __forceinline__ unsigned cvt_pk_bf16(float lo, float hi) { return rne1(lo) | (rne1(hi) << 16); }
template <class Epi, class Sched, bool ALIGN_EPI = false, bool SP2 = false>
__device__ __forceinline__ void gemm_phase(PG8_LAS unsigned char* lds, const Gemm g, const Sched& S, const Epi& E, int tid_in) {
    int tid_ = tid_in; asm volatile("" : "+v"(tid_));
    const int tid = tid_, wid = __builtin_amdgcn_readfirstlane(tid >> 6), lane = tid & 63, wr = wid >> 2, wc = wid & 3, fr = lane & 15, fq = lane >> 4;
    const int K = g.K, nt = K / BK;
    unsigned voffA[2], voffB[2];
#pragma unroll
    for (int i = 0; i < 2; ++i) { int R, C; stage_rc(tid * 16 + i * 8192, R, C); const int Rb = Epi::PERM ? ((R & ~31) + perm32(R & 31)) : R;
        voffA[i] = (unsigned)(R * g.lda + C) * 2u; voffB[i] = (unsigned)(Rb * K + C) * 2u; }
    const size_t kstep = (size_t)(BK * 2);
    const size_t hstepA = (size_t)HALF * g.lda * 2, tstepA = 2 * hstepA;
    const size_t hstepB = (size_t)HALF * K * 2, tstepB = 2 * hstepB;
    const size_t apn = (size_t)g.a_pn_off * 2;
    const unsigned ldsw = (unsigned)wid * 1024u;
    const int aoff = lds_byte(wr * 64 + fr, fq * 8), boff = lds_byte(wc * 32 + fr, fq * 8);
#define PG8_SA(b, h) (((b) * 2 + (h)) * HTB)
#define PG8_SB(b, h) ((4 + (b) * 2 + (h)) * HTB)
#define PG8_STAGE(bufoff, gbase, voff) do { _Pragma("unroll") for (int _i = 0; _i < 2; ++_i) \
        __builtin_amdgcn_global_load_lds((const unsigned*)((const char*)(gbase) + (voff)[_i]), (PG8_LAS unsigned*)(lds + (bufoff) + ldsw + _i * 8192), 16, 0, 0); } while (0)
#define PG8_LDA(dst, b, h) do { _Pragma("unroll") for (int m = 0; m < 4; ++m) _Pragma("unroll") for (int k = 0; k < 2; ++k) dst[m][k] = *(const PG8_LAS bf16x8*)(lds + PG8_SA(b, h) + aoff + m * 2048 + k * 1024); } while (0)
#define PG8_LDB(dst, b, h) do { _Pragma("unroll") for (int n = 0; n < 2; ++n) _Pragma("unroll") for (int k = 0; k < 2; ++k) dst[n][k] = *(const PG8_LAS bf16x8*)(lds + PG8_SB(b, h) + boff + n * 2048 + k * 1024); } while (0)
#define PG8_MMA(ai, bj, At, Bt) do { __builtin_amdgcn_s_setprio(1); _Pragma("unroll") for (int m = 0; m < 4; ++m) _Pragma("unroll") for (int n = 0; n < 2; ++n) _Pragma("unroll") for (int k = 0; k < 2; ++k) \
        acc[ai][bj][m][n] = __builtin_amdgcn_mfma_f32_16x16x32_bf16(Bt[n][k], At[m][k], acc[ai][bj][m][n], 0, 0, 0); __builtin_amdgcn_s_setprio(0); } while (0)
#define PG8_WAIT_V(n) asm volatile("s_waitcnt vmcnt(" #n ")" ::: "memory")
#define PG8_WAIT_L(n) asm volatile("s_waitcnt lgkmcnt(" #n ")" ::: "memory")
#define PG8_BAR __builtin_amdgcn_s_barrier()
#define PG8_SCHED __builtin_amdgcn_sched_barrier(0)
    Unit cur, nxt; int ui = 0;
    if (!S.next(0, cur)) return;
    f32x4 acc[2][2][4][2];
#pragma unroll
    for (int a = 0; a < 2; ++a)
#pragma unroll
        for (int b = 0; b < 2; ++b)
#pragma unroll
            for (int m = 0; m < 4; ++m)
#pragma unroll
                for (int n = 0; n < 2; ++n) acc[a][b][m][n] = (f32x4){0.f, 0.f, 0.f, 0.f};
    bf16x8 At[4][2], B0[2][2], B1[2][2];
    const char* cA = (const char*)g.A + (size_t)cur.pm * tstepA + (size_t)cur.pn * apn; const char* cB = (const char*)g.Bt + (size_t)cur.pn * tstepB;
    S.a_ready(cur);
    if constexpr (SP2) {
        PG8_STAGE(PG8_SB(0, 0), cB, voffB); PG8_STAGE(PG8_SB(0, 1), cB + hstepB, voffB); PG8_STAGE(PG8_SA(0, 0), cA, voffA); PG8_STAGE(PG8_SA(0, 1), cA + hstepA, voffA);
        if (wr == 1) PG8_BAR;
        PG8_WAIT_V(2); PG8_BAR;
        PG8_STAGE(PG8_SB(1, 0), cB + kstep, voffB); PG8_STAGE(PG8_SA(1, 0), cA + kstep, voffA); PG8_STAGE(PG8_SB(1, 1), cB + hstepB + kstep, voffB);
        PG8_WAIT_V(6); PG8_BAR;
    } else {
        PG8_STAGE(PG8_SB(0, 0), cB, voffB); PG8_STAGE(PG8_SA(0, 0), cA, voffA); PG8_STAGE(PG8_SB(0, 1), cB + hstepB, voffB); PG8_STAGE(PG8_SA(0, 1), cA + hstepA, voffA);
        if (wr == 1) PG8_BAR;
        PG8_WAIT_V(4); PG8_BAR;
        PG8_STAGE(PG8_SB(1, 0), cB + kstep, voffB); PG8_STAGE(PG8_SA(1, 0), cA + kstep, voffA); PG8_STAGE(PG8_SB(1, 1), cB + hstepB + kstep, voffB);
        PG8_WAIT_V(6); PG8_BAR;
    }
    for (;;) {
        const bool has_next = S.next(ui + 1, nxt);
        const char* nA = has_next ? (const char*)g.A + (size_t)nxt.pm * tstepA + (size_t)nxt.pn * apn : cA; const char* nB = has_next ? (const char*)g.Bt + (size_t)nxt.pn * tstepB : cB;
#pragma nounroll
        for (int t = 0; t < nt; t += 2) {
            const bool last = (t == nt - 2);
            const char* a1 = cA + (size_t)(t + 1) * kstep;
            const char* a2 = last ? nA : cA + (size_t)(t + 2) * kstep; const char* b2 = last ? nB : cB + (size_t)(t + 2) * kstep;
            const char* a3 = a2 + kstep; const char* b3 = b2 + kstep;
            if (last && has_next) S.a_ready(nxt);
            if constexpr (SP2) {
            PG8_LDB(B0, 0, 0); PG8_LDB(B1, 0, 1); PG8_SCHED; PG8_LDA(At, 0, 0); PG8_STAGE(PG8_SA(1, 1), a1 + hstepA, voffA);
            PG8_WAIT_V(8); PG8_WAIT_L(0); PG8_BAR; PG8_MMA(0, 0, At, B0); PG8_MMA(0, 1, At, B1); PG8_BAR; PG8_SCHED;
            PG8_LDA(At, 0, 1); PG8_STAGE(PG8_SB(0, 0), b2, voffB); PG8_STAGE(PG8_SB(0, 1), b2 + hstepB, voffB); PG8_STAGE(PG8_SA(0, 0), a2, voffA);
            PG8_WAIT_V(8); PG8_WAIT_L(0); PG8_BAR; PG8_MMA(1, 0, At, B0); PG8_MMA(1, 1, At, B1); PG8_BAR; PG8_SCHED;
            PG8_LDB(B0, 1, 0); PG8_LDB(B1, 1, 1); PG8_SCHED; PG8_LDA(At, 1, 0); PG8_STAGE(PG8_SA(0, 1), a2 + hstepA, voffA);
            PG8_WAIT_V(8); PG8_WAIT_L(0); PG8_BAR; PG8_MMA(0, 0, At, B0); PG8_MMA(0, 1, At, B1); PG8_BAR; PG8_SCHED;
            PG8_LDA(At, 1, 1); PG8_STAGE(PG8_SB(1, 0), b3, voffB); PG8_STAGE(PG8_SB(1, 1), b3 + hstepB, voffB); PG8_STAGE(PG8_SA(1, 0), a3, voffA);
            PG8_WAIT_V(8); PG8_WAIT_L(0); PG8_BAR; PG8_MMA(1, 0, At, B0); PG8_MMA(1, 1, At, B1); PG8_BAR; PG8_SCHED;
            } else {
            PG8_LDB(B0, 0, 0); PG8_SCHED; PG8_LDA(At, 0, 0); PG8_STAGE(PG8_SA(1, 1), a1 + hstepA, voffA);
            PG8_WAIT_L(8); PG8_BAR; PG8_WAIT_L(0); PG8_MMA(0, 0, At, B0); PG8_BAR; PG8_SCHED;
            PG8_LDB(B1, 0, 1); PG8_STAGE(PG8_SB(0, 0), b2, voffB);
            PG8_BAR; PG8_WAIT_L(0); PG8_MMA(0, 1, At, B1); PG8_BAR;
            PG8_LDA(At, 0, 1); PG8_STAGE(PG8_SA(0, 0), a2, voffA);
            PG8_BAR; PG8_WAIT_L(0); PG8_MMA(1, 0, At, B0); PG8_BAR; PG8_SCHED;
            PG8_STAGE(PG8_SB(0, 1), b2 + hstepB, voffB);
            PG8_WAIT_V(6); PG8_BAR; PG8_MMA(1, 1, At, B1); PG8_BAR;
            PG8_LDB(B0, 1, 0); PG8_SCHED; PG8_LDA(At, 1, 0); PG8_STAGE(PG8_SA(0, 1), a2 + hstepA, voffA);
            PG8_WAIT_L(8); PG8_BAR; PG8_WAIT_L(0); PG8_MMA(0, 0, At, B0); PG8_BAR; PG8_SCHED;
            PG8_LDB(B1, 1, 1); PG8_STAGE(PG8_SB(1, 0), b3, voffB);
            PG8_BAR; PG8_WAIT_L(0); PG8_MMA(0, 1, At, B1); PG8_BAR;
            PG8_LDA(At, 1, 1); PG8_STAGE(PG8_SA(1, 0), a3, voffA);
            PG8_BAR; PG8_WAIT_L(0); PG8_MMA(1, 0, At, B0); PG8_BAR; PG8_SCHED;
            PG8_STAGE(PG8_SB(1, 1), b3 + hstepB, voffB);
            PG8_WAIT_V(6); PG8_BAR; PG8_MMA(1, 1, At, B1); PG8_BAR;
            }
        }
        if constexpr (ALIGN_EPI) { if (wr == 0) PG8_BAR; }
        if constexpr (!Epi::AFTER_DRAIN) { E(acc, cur, wr, wc, fr, fq); S.done(cur); }
        if (!has_next) break;
#pragma unroll
        for (int a = 0; a < 2; ++a)
#pragma unroll
            for (int b = 0; b < 2; ++b)
#pragma unroll
                for (int m = 0; m < 4; ++m)
#pragma unroll
                    for (int n = 0; n < 2; ++n) acc[a][b][m][n] = (f32x4){0.f, 0.f, 0.f, 0.f};
        cur = nxt; cA = nA; cB = nB; ++ui;
        if constexpr (ALIGN_EPI) { if (wr == 1) PG8_BAR; }
    }
    PG8_WAIT_V(0);
    if constexpr (!ALIGN_EPI) { if (wr == 0) PG8_BAR; }
    PG8_BAR;
    if constexpr (Epi::AFTER_DRAIN) { E.fused(acc, cur, wr, wc, fr, fq, lds, wid, lane); S.done(cur); }
#undef PG8_SA
#undef PG8_SB
#undef PG8_STAGE
#undef PG8_LDA
#undef PG8_LDB
#undef PG8_MMA
#undef PG8_WAIT_V
#undef PG8_WAIT_L
#undef PG8_BAR
#undef PG8_SCHED
}
}

#ifndef PR_GATHER
#define PR_GATHER 1
#endif
#ifndef PR_ROUTE
#define PR_ROUTE 1
#endif
#ifndef PR_S5
#define PR_S5 1
#endif
#ifndef PR_SSD
#define PR_SSD 1
#endif
#ifndef PR_GEMM
#define PR_GEMM 1
#endif
#ifndef PR_MISC
#define PR_MISC 1
#endif
namespace mk {
#define LAS __attribute__((address_space(3)))
typedef unsigned short bf16;
typedef unsigned v4u __attribute__((ext_vector_type(4)));
typedef unsigned v2u __attribute__((ext_vector_type(2)));
typedef float f32x4 __attribute__((ext_vector_type(4)));
typedef short bf16x8 __attribute__((ext_vector_type(8)));
using bf16x2 = __attribute__((ext_vector_type(2))) __bf16;

constexpr int D = 1024, T = 17408, TP = 16384, NWAVES = 8, NTHR = 512;
constexpr float ALPHA = 1.6817928305074290f;
constexpr float LN_EPS = 1e-5f, RMS_EPS = 1e-5f;
constexpr int LDS_BYTES = 160 * 1024;
constexpr int NPROJ = 5376, CONVD = 3072;

constexpr size_t MiB = 1u << 20;
constexpr size_t WS_W_S5IN = 0, WS_W_S5GLU = 2 * MiB, WS_W_S5OUT = 4 * MiB, WS_W_PIN = 6 * MiB, WS_W_PGRP = 8 * MiB, WS_W_POUT = 9 * MiB,
                 WS_W_CIN = 11 * MiB, WS_W_COUT = 15 * MiB, WS_W_SIN = 17 * MiB  , WS_W_SOUT = 28 * MiB, WS_W_PQ = 32 * MiB  ,
                 WS_KEYS = 48 * MiB  , WS_SMALL = 50 * MiB, WS_CTL = 52 * MiB  ;
constexpr size_t CTL_BYTES = 16384;
constexpr int MISC_OFF = LDS_BYTES - 64;
constexpr size_t WS_EU = 64 * MiB, WS_EV = 96 * MiB;
constexpr size_t WS_H32 = 128 * MiB, WS_R32 = 196 * MiB, WS_HB = 264 * MiB, WS_A0 = 298 * MiB, WS_A1 = 332 * MiB, WS_A2 = 366 * MiB;
constexpr size_t WS_Q = 400 * MiB  , WS_IDX = 468 * MiB  , WS_GATE = 477 * MiB  , WS_DT = 486 * MiB  ;
constexpr size_t WS_XBC = 490 * MiB  , WS_XC = 592 * MiB  , WS_Y = 694 * MiB  , WS_YN = 762 * MiB  , WS_SCU = 830 * MiB  , WS_END = 839 * MiB;
constexpr size_t SM_LBR = 0, SM_LBI = 4096, SM_BBR = 8192, SM_BBI = 8192 + 65536, SM_ISU = 8192 + 131072, SM_ISV = SM_ISU + 16384;

struct Params { const float* in[46]; float* out; unsigned char* ws; };

__device__ __forceinline__ unsigned f2bf(float f) { unsigned u = __builtin_bit_cast(unsigned, f); return (u + 0x7fffu + ((u >> 16) & 1u)) >> 16; }
__device__ __forceinline__ unsigned f2bf_fast(float f) { return (__builtin_bit_cast(unsigned, f) + 0x8000u) >> 16; }
__device__ __forceinline__ unsigned pk2(float lo, float hi) { return pg8::cvt_pk_bf16(lo, hi); }
__device__ __forceinline__ float bflo(unsigned w) { return __builtin_bit_cast(float, w << 16); }
__device__ __forceinline__ float bfhi(unsigned w) { return __builtin_bit_cast(float, w & 0xffff0000u); }
__device__ __forceinline__ float bf2f(bf16 b) { return __builtin_bit_cast(float, ((unsigned)b) << 16); }
__device__ __forceinline__ float sigmoid_f(float x) { return __builtin_amdgcn_rcpf(1.f + __expf(-x)); }
__device__ __forceinline__ float silu_f(float x) { return x * sigmoid_f(x); }
__device__ __forceinline__ float gelu_f(float x) { return x * sigmoid_f(1.5957691216057308f * (x + 0.044715f * x * x * x)); }
template <int O> __device__ __forceinline__ float shx_c(float v, int lane) {
    const int iv = __builtin_bit_cast(int, v);
    if constexpr (O == 1) return __builtin_bit_cast(float, __builtin_amdgcn_update_dpp(0, iv, 0xB1, 0xf, 0xf, false));
    else if constexpr (O == 2) return __builtin_bit_cast(float, __builtin_amdgcn_update_dpp(0, iv, 0x4E, 0xf, 0xf, false));
    else if constexpr (O == 4) { const int a = __builtin_amdgcn_update_dpp(iv, iv, 0x104, 0xf, 0x5, false); return __builtin_bit_cast(float, __builtin_amdgcn_update_dpp(a, iv, 0x114, 0xf, 0xA, false)); }
    else if constexpr (O == 8) return __builtin_bit_cast(float, __builtin_amdgcn_update_dpp(0, iv, 0x128, 0xf, 0xf, false));
    else if constexpr (O < 32) return __builtin_bit_cast(float, __builtin_amdgcn_ds_swizzle(iv, (O << 10) | 0x1f));
    else return __builtin_bit_cast(float, __builtin_amdgcn_ds_bpermute((lane ^ O) << 2, iv));
}
__device__ __forceinline__ float shx(float v, int o, int lane) {
    switch (o) { case 1: return shx_c<1>(v, lane); case 2: return shx_c<2>(v, lane); case 4: return shx_c<4>(v, lane); case 8: return shx_c<8>(v, lane); case 16: return shx_c<16>(v, lane); default: return shx_c<32>(v, lane); }
}
__device__ __forceinline__ float wave_sum(float v, int lane) {
    v += shx_c<32>(v, lane); v += shx_c<16>(v, lane); v += shx_c<8>(v, lane); v += shx_c<4>(v, lane); v += shx_c<2>(v, lane); v += shx_c<1>(v, lane);
    return v;
}
__device__ __forceinline__ float dot2(unsigned w, unsigned x, float acc) { return __builtin_amdgcn_fdot2_f32_bf16(__builtin_bit_cast(bf16x2, w), __builtin_bit_cast(bf16x2, x), acc, false); }
__device__ __forceinline__ float reduce16(const float (&p)[16], int lane) {
    const bool b5 = lane & 32, b4 = lane & 16, b3 = lane & 8, b2 = lane & 4;
    float q[8], r[4], s[2], t;
#pragma unroll
    for (int i = 0; i < 8; ++i) { const float keep = b5 ? p[i + 8] : p[i], send = b5 ? p[i] : p[i + 8]; q[i] = keep + shx(send, 32, lane); }
#pragma unroll
    for (int i = 0; i < 4; ++i) { const float keep = b4 ? q[i + 4] : q[i], send = b4 ? q[i] : q[i + 4]; r[i] = keep + shx(send, 16, lane); }
#pragma unroll
    for (int i = 0; i < 2; ++i) { const float keep = b3 ? r[i + 2] : r[i], send = b3 ? r[i] : r[i + 2]; s[i] = keep + shx(send, 8, lane); }
    { const float keep = b2 ? s[1] : s[0], send = b2 ? s[0] : s[1]; t = keep + shx(send, 4, lane); }
    t += shx(t, 2, lane); t += shx(t, 1, lane);
    return t;
}
template <int CTRL> __device__ __forceinline__ float dppf(float v) { return __builtin_bit_cast(float, __builtin_amdgcn_update_dpp(0, __builtin_bit_cast(int, v), CTRL, 0xf, 0xf, false)); }
__device__ __forceinline__ float reduce8d(const float (&p)[8], int lane) {
    const bool b2 = lane & 4, b1 = lane & 2, b0 = lane & 1;
    float q[4], r[2], t;
#pragma unroll
    for (int i = 0; i < 4; ++i) { const float keep = b2 ? p[i + 4] : p[i], send = b2 ? p[i] : p[i + 4]; q[i] = keep + dppf<0x141>(send); }
#pragma unroll
    for (int i = 0; i < 2; ++i) { const float keep = b1 ? q[i + 2] : q[i], send = b1 ? q[i] : q[i + 2]; r[i] = keep + dppf<0x4E>(send); }
    { const float keep = b0 ? r[1] : r[0], send = b0 ? r[0] : r[1]; t = keep + dppf<0xB1>(send); }
    t += dppf<0x128>(t);
    t += shx_c<16>(t, lane); t += shx_c<32>(t, lane);
    return t;
}
__device__ __forceinline__ float reduce16d(const float (&p)[16], int lane) {
    const bool b3 = lane & 8, b2 = lane & 4, b1 = lane & 2, b0 = lane & 1;
    float o[8], q[4], r[2], t;
#pragma unroll
    for (int i = 0; i < 8; ++i) { const float keep = b3 ? p[i + 8] : p[i], send = b3 ? p[i] : p[i + 8]; o[i] = keep + dppf<0x128>(send); }
#pragma unroll
    for (int i = 0; i < 4; ++i) { const float keep = b2 ? o[i + 4] : o[i], send = b2 ? o[i] : o[i + 4]; q[i] = keep + dppf<0x141>(send); }
#pragma unroll
    for (int i = 0; i < 2; ++i) { const float keep = b1 ? q[i + 2] : q[i], send = b1 ? q[i] : q[i + 2]; r[i] = keep + dppf<0x4E>(send); }
    { const float keep = b0 ? r[1] : r[0], send = b0 ? r[0] : r[1]; t = keep + dppf<0xB1>(send); }
    t += shx_c<16>(t, lane); t += shx_c<32>(t, lane);
    return t;
}
__device__ __forceinline__ float reduce8(const float (&p)[8], int lane) {
    const bool b5 = lane & 32, b4 = lane & 16, b3 = lane & 8;
    float q[4], r[2], t;
#pragma unroll
    for (int i = 0; i < 4; ++i) { const float keep = b5 ? p[i + 4] : p[i], send = b5 ? p[i] : p[i + 4]; q[i] = keep + shx(send, 32, lane); }
#pragma unroll
    for (int i = 0; i < 2; ++i) { const float keep = b4 ? q[i + 2] : q[i], send = b4 ? q[i] : q[i + 2]; r[i] = keep + shx(send, 16, lane); }
    { const float keep = b3 ? r[1] : r[0], send = b3 ? r[0] : r[1]; t = keep + shx(send, 8, lane); }
    t += shx(t, 4, lane); t += shx(t, 2, lane); t += shx(t, 1, lane);
    return t;
}
__device__ __forceinline__ void seq_info(int s, int& tok0, int& L) { if (s < 8) { tok0 = s << 11; L = 2048; } else { tok0 = TP + ((s - 8) << 3); L = 8; } }
__device__ __forceinline__ void tok_info(int t, int& s, int& l, int& tok0) {
    if (t < TP) { s = t >> 11; l = t & 2047; tok0 = s << 11; } else { const int b = (t - TP) >> 3; s = 8 + b; l = (t - TP) & 7; tok0 = TP + (b << 3); }
}

template <int MODE> struct EpiBf16 {
    static constexpr bool PERM = true, AFTER_DRAIN = false;
    bf16* O; int ldc; const float* bias; const float* scale; const bf16* G;
    __device__ __forceinline__ void operator()(const pg8::f32x4 (&acc)[2][2][4][2], const pg8::Unit& u, int wr, int wc, int fr_, int fq_) const {
        int fr = fr_, fq = fq_; asm volatile("" : "+v"(fr), "+v"(fq));
        const int row0 = u.pm * 256 + wr * 64 + fr, col0 = u.pn * 256 + wc * 32 + 8 * fq;
        f32x4 bv[2][2], sv[2][2];
#pragma unroll
        for (int bj = 0; bj < 2; ++bj)
#pragma unroll
            for (int n = 0; n < 2; ++n) {
                bv[bj][n] = bias ? *(const f32x4*)(bias + col0 + bj * 128 + 4 * n) : (f32x4){0.f, 0.f, 0.f, 0.f};
                sv[bj][n] = (MODE == 2) ? *(const f32x4*)(scale + col0 + bj * 128 + 4 * n) : (f32x4){1.f, 1.f, 1.f, 1.f};
            }
#pragma unroll
        for (int ai = 0; ai < 2; ++ai)
#pragma unroll
            for (int m = 0; m < 4; ++m) {
                const size_t roff = (size_t)(row0 + ai * 128 + m * 16) * ldc + col0;
#pragma unroll
                for (int bj = 0; bj < 2; ++bj) {
                    f32x4 v0 = acc[ai][bj][m][0] + bv[bj][0], v1 = acc[ai][bj][m][1] + bv[bj][1];
                    if (MODE == 1) {
#pragma unroll
                        for (int j = 0; j < 4; ++j) { v0[j] = gelu_f(v0[j]); v1[j] = gelu_f(v1[j]); }
                    }
                    if (MODE == 2) { v0 = v0 * sv[bj][0]; v1 = v1 * sv[bj][1]; }
                    if (MODE == 3) {
                        const v4u gw = *(const v4u*)(G + roff + bj * 128);
                        v0[0] = bflo(gw.x) * sigmoid_f(v0[0]); v0[1] = bfhi(gw.x) * sigmoid_f(v0[1]); v0[2] = bflo(gw.y) * sigmoid_f(v0[2]); v0[3] = bfhi(gw.y) * sigmoid_f(v0[3]);
                        v1[0] = bflo(gw.z) * sigmoid_f(v1[0]); v1[1] = bfhi(gw.z) * sigmoid_f(v1[1]); v1[2] = bflo(gw.w) * sigmoid_f(v1[2]); v1[3] = bfhi(gw.w) * sigmoid_f(v1[3]);
                    }
                    v4u w; w.x = pk2(v0[0], v0[1]); w.y = pk2(v0[2], v0[3]); w.z = pk2(v1[0], v1[1]); w.w = pk2(v1[2], v1[3]);
                    *(v4u*)(O + roff + bj * 128) = w;
                }
            }
    }
    __device__ __forceinline__ void store4(int row, int col, f32x4 v) const {
        if (bias) v = v + *(const f32x4*)(bias + col);
        if (MODE == 1) { v[0] = gelu_f(v[0]); v[1] = gelu_f(v[1]); v[2] = gelu_f(v[2]); v[3] = gelu_f(v[3]); }
        if (MODE == 2) v = v * *(const f32x4*)(scale + col);
        if (MODE == 3) { const v2u gw = *(const v2u*)(G + (size_t)row * ldc + col);
            v[0] = bflo(gw.x) * sigmoid_f(v[0]); v[1] = bfhi(gw.x) * sigmoid_f(v[1]); v[2] = bflo(gw.y) * sigmoid_f(v[2]); v[3] = bfhi(gw.y) * sigmoid_f(v[3]); }
        v2u w; w.x = pk2(v[0], v[1]); w.y = pk2(v[2], v[3]);
        *(v2u*)(O + (size_t)row * ldc + col) = w;
    }
};
struct EpiResid {
    static constexpr bool PERM = false, AFTER_DRAIN = false;
    const float* H; float* R;
    __device__ __forceinline__ void operator()(const pg8::f32x4 (&acc)[2][2][4][2], const pg8::Unit& u, int wr, int wc, int fr_, int fq_) const {
        int fr = fr_, fq = fq_; asm volatile("" : "+v"(fr), "+v"(fq));
        const int row0 = u.pm * 256 + wr * 64 + fr, col0 = u.pn * 256 + wc * 32 + 4 * fq;
#pragma unroll
        for (int ai = 0; ai < 2; ++ai)
#pragma unroll
            for (int m = 0; m < 4; ++m) {
                const size_t roff = (size_t)(row0 + ai * 128 + m * 16) * D + col0;
#pragma unroll
                for (int bj = 0; bj < 2; ++bj)
#pragma unroll
                    for (int n = 0; n < 2; ++n) {
                        const f32x4 hv = *(const f32x4*)(H + roff + bj * 128 + n * 16);
                        *(f32x4*)(R + roff + bj * 128 + n * 16) = hv * ALPHA + acc[ai][bj][m][n];
                    }
            }
    }
    __device__ __forceinline__ void store4(int row, int col, f32x4 v) const {
        *(f32x4*)(R + (size_t)row * D + col) = *(const f32x4*)(H + (size_t)row * D + col) * ALPHA + v;
    }
};
struct EpiSsdProj {
    static constexpr bool PERM = true, AFTER_DRAIN = false;
    bf16* Z; bf16* XBC; float* DT;
    __device__ __forceinline__ void operator()(const pg8::f32x4 (&acc)[2][2][4][2], const pg8::Unit& u, int wr, int wc, int fr_, int fq_) const {
        int fr = fr_, fq = fq_; asm volatile("" : "+v"(fr), "+v"(fq));
        const int row0 = u.pm * 256 + wr * 64 + fr, col0 = u.pn * 256 + wc * 32 + 8 * fq;
#pragma unroll
        for (int ai = 0; ai < 2; ++ai)
#pragma unroll
            for (int m = 0; m < 4; ++m) {
                const size_t row = (size_t)(row0 + ai * 128 + m * 16);
#pragma unroll
                for (int bj = 0; bj < 2; ++bj) {
                    const f32x4 v0 = acc[ai][bj][m][0], v1 = acc[ai][bj][m][1];
                    const int col = col0 + bj * 128;
                    if (u.pn < 20) {
                        v4u w; w.x = pk2(v0[0], v0[1]); w.y = pk2(v0[2], v0[3]); w.z = pk2(v1[0], v1[1]); w.w = pk2(v1[2], v1[3]);
                        if (u.pn < 8) *(v4u*)(Z + row * 2048 + col) = w; else *(v4u*)(XBC + row * CONVD + (col - 2048)) = w;
                    } else if (col - 5120 < 32) {
                        *(f32x4*)(DT + row * 32 + (col - 5120)) = v0; *(f32x4*)(DT + row * 32 + (col - 5120) + 4) = v1;
                    }
                }
            }
    }
};

struct Ctx {
    const float* const* in; float* out; unsigned char* ws; LAS unsigned char* lds;
    int tid, lane, wave, gw, NGW, gt, NGT, bid, nblk;
    int z;
    template <class Tp> __device__ __forceinline__ Tp* W(size_t off) const { return (Tp*)(ws + (off + (size_t)(unsigned)z)); }
};

template <class Epi> __device__ __forceinline__ void run_gemm_m(const Ctx& c, int M, const bf16* A, int lda, int a_pn_off, const bf16* Bt, int N, int K, const Epi& E) {
    pg8::Gemm g{A, Bt, M, N, K, lda, a_pn_off};
    pg8::StaticOrder S; S.init(M, N, c.nblk, c.bid);
    for (int r = 0; r < PR_GEMM; ++r) pg8::gemm_phase<Epi, pg8::StaticOrder, true, true>(c.lds, g, S, E, c.tid);
}
constexpr int SG_LD = 136, SG_TILE = 64 * SG_LD * 2;
template <class Epi> __device__ __forceinline__ void small_gemm(const Ctx& c, const bf16* A, int lda, int a_pn_off, const bf16* Bt, int N, int K, const Epi& E) {
    int ln = c.lane; asm volatile("" : "+v"(ln));
    const int fr = ln & 15, fq = ln >> 4, w = c.wave, tid = w * 64 + ln;
    const int nct = N >> 6, ntiles = 16 * nct, nkt = K >> 7;
    const int r0 = tid >> 4, cc = tid & 15;
    LAS unsigned char* lds = c.lds;
    for (int tau = c.bid; tau < ntiles; tau += c.nblk) {
        const int mt = tau / nct, nt = tau - mt * nct, row0 = TP + mt * 64, col0 = nt * 64;
        const bf16* ap = A + (size_t)(row0 + r0) * lda + (size_t)(col0 >> 8) * a_pn_off + cc * 8;
        const bf16* bp = Bt + (size_t)(col0 + r0) * K + cc * 8;
        const size_t a32 = (size_t)32 * lda, b32 = (size_t)32 * K;
        v4u ra[2][2], rb[2][2];
        f32x4 acc0 = {0.f, 0.f, 0.f, 0.f}, acc1 = {0.f, 0.f, 0.f, 0.f};
#define SG_LOAD(st, kt) do { ra[st][0] = *(const v4u*)(ap + (kt) * 128); ra[st][1] = *(const v4u*)(ap + a32 + (kt) * 128); rb[st][0] = *(const v4u*)(bp + (kt) * 128); rb[st][1] = *(const v4u*)(bp + b32 + (kt) * 128); } while (0)
#define SG_WRITE(st, buf) do { LAS unsigned char* d_ = lds + (buf) * 2 * SG_TILE + (r0 * SG_LD + cc * 8) * 2; \
            *(LAS v4u*)(d_) = ra[st][0]; *(LAS v4u*)(d_ + 32 * SG_LD * 2) = ra[st][1]; *(LAS v4u*)(d_ + SG_TILE) = rb[st][0]; *(LAS v4u*)(d_ + SG_TILE + 32 * SG_LD * 2) = rb[st][1]; } while (0)
#define SG_COMPUTE(buf) do { const LAS unsigned char* a_ = lds + (buf) * 2 * SG_TILE + (((w >> 1) * 16 + fr) * SG_LD + 8 * fq) * 2; \
            const LAS unsigned char* b_ = lds + (buf) * 2 * SG_TILE + SG_TILE + (((w & 1) * 32 + fr) * SG_LD + 8 * fq) * 2; \
            _Pragma("unroll") for (int ks = 0; ks < 4; ++ks) { const bf16x8 af = *(const LAS bf16x8*)(a_ + ks * 64); \
                acc0 = __builtin_amdgcn_mfma_f32_16x16x32_bf16(*(const LAS bf16x8*)(b_ + ks * 64), af, acc0, 0, 0, 0); \
                acc1 = __builtin_amdgcn_mfma_f32_16x16x32_bf16(*(const LAS bf16x8*)(b_ + 16 * SG_LD * 2 + ks * 64), af, acc1, 0, 0, 0); } } while (0)
        SG_LOAD(0, 0);
        if (nkt > 1) SG_LOAD(1, 1);
        __syncthreads();
        SG_WRITE(0, 0);
        __syncthreads();
        for (int kt = 0; kt < nkt; kt += 2) {
            if (kt + 2 < nkt) SG_LOAD(0, kt + 2);
            SG_COMPUTE(0);
            if (kt + 1 < nkt) {
                SG_WRITE(1, 1);
                __syncthreads();
                if (kt + 3 < nkt) SG_LOAD(1, kt + 3);
                SG_COMPUTE(1);
                if (kt + 2 < nkt) { __syncthreads(); SG_WRITE(0, 0); __syncthreads(); }
            }
        }
#undef SG_LOAD
#undef SG_WRITE
#undef SG_COMPUTE
        E.store4(row0 + (w >> 1) * 16 + fr, col0 + (w & 1) * 32 + 4 * fq, acc0);
        E.store4(row0 + (w >> 1) * 16 + fr, col0 + (w & 1) * 32 + 16 + 4 * fq, acc1);
    }
    __syncthreads();
}
template <class Epi> __device__ __forceinline__ void run_gemm(const Ctx& c, const bf16* A, int lda, int a_pn_off, const bf16* Bt, int N, int K, const Epi& E) {
    run_gemm_m(c, TP, A, lda, a_pn_off, Bt, N, K, E);
    small_gemm(c, A, lda, a_pn_off, Bt, N, K, E);
}
template <class Epi> __device__ __forceinline__ void run_gemm_all(const Ctx& c, const bf16* A, int lda, int a_pn_off, const bf16* Bt, int N, int K, const Epi& E) {
    run_gemm_m(c, T, A, lda, a_pn_off, Bt, N, K, E);
}

__device__ __forceinline__ void transpose_item(const float* __restrict__ Wm, int K, int N, bf16* WT, LAS float* scr, int item, int lane) {
    const int nblk = N / 32, kb = item / nblk, nb = item % nblk, k0 = 64 * kb, n0 = 32 * nb;
#pragma unroll 8
    for (int i = 0; i < 32; ++i) { const int kk = 2 * i + (lane >> 5); scr[kk * 33 + (lane & 31)] = Wm[(size_t)(k0 + kk) * N + n0 + (lane & 31)]; }
    asm volatile("s_waitcnt lgkmcnt(0)" ::: "memory");
    const int cc = lane & 7;
#pragma unroll
    for (int j = 0; j < 4; ++j) {
        const int n = (lane >> 3) + 8 * j; const LAS float* s = scr + (8 * cc) * 33 + n;
        v4u o; o.x = pk2(s[0 * 33], s[1 * 33]); o.y = pk2(s[2 * 33], s[3 * 33]); o.z = pk2(s[4 * 33], s[5 * 33]); o.w = pk2(s[6 * 33], s[7 * 33]);
        *(v4u*)(WT + (size_t)(n0 + n) * K + k0 + 8 * cc) = o;
    }
    asm volatile("s_waitcnt lgkmcnt(0)" ::: "memory");
}
__device__ __forceinline__ void transpose_mat(const Ctx& c, const float* Wm, int K, int N, bf16* WT, int& base) {
    LAS float* scr = (LAS float*)(c.lds + c.wave * 16384);
    const int nitems = (K / 64) * (N / 32);
    int first = c.gw - (base % c.NGW); if (first < 0) first += c.NGW;
    for (int it = first; it < nitems; it += c.NGW) transpose_item(Wm, K, N, WT, scr, it, c.lane);
    base += nitems;
}
__device__ __forceinline__ void cvt_copy(const Ctx& c, const float* __restrict__ src, bf16* dst, size_t n) {
    for (size_t i = (size_t)c.gt * 8; i < n; i += (size_t)c.NGT * 8) {
        const f32x4 a = *(const f32x4*)(src + i), b = *(const f32x4*)(src + i + 4);
        v4u w; w.x = pk2(a[0], a[1]); w.y = pk2(a[2], a[3]); w.z = pk2(b[0], b[1]); w.w = pk2(b[2], b[3]);
        *(v4u*)(dst + i) = w;
    }
}
__device__ __forceinline__ float wave_max(float v, int lane) {
    v = fmaxf(v, shx_c<32>(v, lane)); v = fmaxf(v, shx_c<16>(v, lane)); v = fmaxf(v, shx_c<8>(v, lane)); v = fmaxf(v, shx_c<4>(v, lane)); v = fmaxf(v, shx_c<2>(v, lane)); v = fmaxf(v, shx_c<1>(v, lane));
    return v;
}
typedef float v16f __attribute__((ext_vector_type(16)));
typedef float v32f __attribute__((ext_vector_type(32)));
typedef unsigned v6u __attribute__((ext_vector_type(6)));
constexpr int EROW = 768, VROW = 512;
#ifndef FP6_PACK_INTERLEAVED
#define FP6_PACK_INTERLEAVED 1
#endif
typedef unsigned v3u __attribute__((ext_vector_type(3)));
__device__ __forceinline__ unsigned fp4_pack8(const f32x4 lo, const f32x4 hi, const float q) {
    unsigned d = 0;
    d = __builtin_amdgcn_cvt_scalef32_pk_fp4_f32(d, lo[0] * q, lo[1] * q, 1.0f, 0);
    d = __builtin_amdgcn_cvt_scalef32_pk_fp4_f32(d, lo[2] * q, lo[3] * q, 1.0f, 1);
    d = __builtin_amdgcn_cvt_scalef32_pk_fp4_f32(d, hi[0] * q, hi[1] * q, 1.0f, 2);
    d = __builtin_amdgcn_cvt_scalef32_pk_fp4_f32(d, hi[2] * q, hi[3] * q, 1.0f, 3);
    return d;
}
__device__ __forceinline__ void cvt_tables(const Ctx& c, int layer) {
    float* sm = c.W<float>(WS_SMALL);
    const int lane = c.lane;
    f32x4 na[4], nb[4];
    {
        const int r0 = 2 * c.gw, tb = r0 >> 14, row = r0 & 16383;
        const float* src = c.in[c.z + 44 + tb] + ((size_t)layer * 16384 + row) * D + 16 * lane;
#pragma unroll
        for (int k = 0; k < 4; ++k) { na[k] = *(const f32x4*)(src + 4 * k); nb[k] = *(const f32x4*)(src + D + 4 * k); }
    }
    for (int rp = c.gw; rp < 16384; rp += c.NGW) {
        const int r0 = 2 * rp, tb = r0 >> 14, row = r0 & 16383;
        f32x4 va[4], vb[4];
#pragma unroll
        for (int k = 0; k < 4; ++k) { va[k] = na[k]; vb[k] = nb[k]; }
        if (rp + c.NGW < 16384) {
            const int r1 = 2 * (rp + c.NGW), tb1 = r1 >> 14, row1 = r1 & 16383;
            const float* src1 = c.in[c.z + 44 + tb1] + ((size_t)layer * 16384 + row1) * D + 16 * lane;
#pragma unroll
            for (int k = 0; k < 4; ++k) { na[k] = *(const f32x4*)(src1 + 4 * k); nb[k] = *(const f32x4*)(src1 + D + 4 * k); }
        }
        float ma = 0.f, mb = 0.f;
#pragma unroll
        for (int k = 0; k < 4; ++k) {
            ma = fmaxf(fmaxf(fmaxf(fabsf(va[k][0]), fabsf(va[k][1])), fmaxf(fabsf(va[k][2]), fabsf(va[k][3]))), ma);
            mb = fmaxf(fmaxf(fmaxf(fabsf(vb[k][0]), fabsf(vb[k][1])), fmaxf(fabsf(vb[k][2]), fabsf(vb[k][3]))), mb);
        }
        ma = fmaxf(wave_max(ma, lane), 1e-30f); mb = fmaxf(wave_max(mb, lane), 1e-30f);
        {
            const float qa = 6.0f / ma, qb = 6.0f / mb;
            const unsigned a0 = fp4_pack8(va[0], va[1], qa), a1 = fp4_pack8(va[2], va[3], qa), b0 = fp4_pack8(vb[0], vb[1], qb), b1 = fp4_pack8(vb[2], vb[3], qb);
            unsigned char* dv = c.ws + (tb ? WS_EV : WS_EU) + (size_t)row * VROW + 8 * lane;
            *(v2u*)(dv) = (v2u){a0, a1};
            *(v2u*)(dv + VROW) = (v2u){b0, b1};
            if (lane == 0) { sm[(tb ? SM_ISV : SM_ISU) + row] = ma * (1.0f / 6.0f); sm[(tb ? SM_ISV : SM_ISU) + row + 1] = mb * (1.0f / 6.0f); }
        }
    }
}
__device__ __forceinline__ void prologue(const Ctx& c) {
    int tb_ = 0;
    transpose_mat(c, c.in[c.z + 7], 1024, 1024, c.W<bf16>(WS_W_S5IN), tb_);
    transpose_mat(c, c.in[c.z + 16], 1024, 1024, c.W<bf16>(WS_W_S5GLU), tb_);
    transpose_mat(c, c.in[c.z + 18], 1024, 1024, c.W<bf16>(WS_W_S5OUT), tb_);
    transpose_mat(c, c.in[c.z + 19], 1024, 1024, c.W<bf16>(WS_W_PIN), tb_);
    for (int g = 0; g < 4; ++g) transpose_mat(c, c.in[c.z + 20] + (size_t)g * 65536, 256, 256, c.W<bf16>(WS_W_PGRP) + (size_t)g * 65536, tb_);
    transpose_mat(c, c.in[c.z + 22], 1024, 1024, c.W<bf16>(WS_W_POUT), tb_);
    transpose_mat(c, c.in[c.z + 23], 1024, 2048, c.W<bf16>(WS_W_CIN), tb_);
    transpose_mat(c, c.in[c.z + 29], 1024, 1024, c.W<bf16>(WS_W_COUT), tb_);
    transpose_mat(c, c.in[c.z + 30], 1024, 5152, c.W<bf16>(WS_W_SIN), tb_);
    transpose_mat(c, c.in[c.z + 37], 2048, 1024, c.W<bf16>(WS_W_SOUT), tb_);
    for (int l = 0; l < 4; ++l) transpose_mat(c, c.in[c.z + 42] + (size_t)l * 1024 * 2048, 1024, 2048, c.W<bf16>(WS_W_PQ) + (size_t)l * 2048 * 1024, tb_);
    {
        v4u* z = (v4u*)(c.W<bf16>(WS_W_SIN) + (size_t)5152 * 1024);
        for (int i = c.gt; i < 224 * 1024 / 8; i += c.NGT) z[i] = (v4u){0u, 0u, 0u, 0u};
    }
    cvt_copy(c, c.in[c.z + 43], c.W<bf16>(WS_KEYS), (size_t)4 * 8 * 2 * 128 * 128);
    {
        bf16* HB = c.W<bf16>(WS_HB);
        const size_t NP = (size_t)T * D / 8, stride = (size_t)c.NGT;
        for (size_t i0 = (size_t)c.gt; i0 < NP; i0 += 4 * stride) {
            f32x4 a[4], b[4];
#pragma unroll
            for (int u = 0; u < 4; ++u) {
                const size_t i = (i0 + u * stride) * 8;
                if (i0 + u * stride < NP) { const float* src = (i < (size_t)TP * D) ? (c.in[c.z + 0] + i) : (c.in[c.z + 1] + (i - (size_t)TP * D)); a[u] = *(const f32x4*)(src); b[u] = *(const f32x4*)(src + 4); }
            }
#pragma unroll
            for (int u = 0; u < 4; ++u) {
                if (i0 + u * stride < NP) {
                    v4u w; w.x = pk2(a[u][0], a[u][1]); w.y = pk2(a[u][2], a[u][3]); w.z = pk2(b[u][0], b[u][1]); w.w = pk2(b[u][2], b[u][3]);
                    *(v4u*)(HB + (i0 + u * stride) * 8) = w;
                }
            }
        }
    }
    if (c.gt < 4096) {
        const int gp = c.gt, g = gp >> 6;
        float* sm = c.W<float>(WS_SMALL);
        const float dt = expf(c.in[c.z + 10][g]);
        const float lr = c.in[c.z + 8][gp], li = c.in[c.z + 9][gp];
        const float mag = expf(lr * dt);
        const float br = mag * cosf(li * dt), bi = mag * sinf(li * dt);
        const float den = lr * lr + li * li;
        const float fr = ((br - 1.f) * lr + bi * li) / den, fi = (bi * lr - (br - 1.f) * li) / den;
        sm[SM_LBR + gp] = br; sm[SM_LBI + gp] = bi;
        for (int i = 0; i < 16; ++i) {
            const float xr = c.in[c.z + 11][gp * 16 + i], xi = c.in[c.z + 12][gp * 16 + i];
            sm[SM_BBR + gp * 16 + i] = fr * xr - fi * xi; sm[SM_BBI + gp * 16 + i] = fr * xi + fi * xr;
        }
    }
    cvt_tables(c, 0);
}

__device__ __forceinline__ void ln_row_store(const f32x4 (&v)[4], float mean, float rstd, const float* __restrict__ g, const float* __restrict__ b, float* o32, bf16* ob, int lane) {
#pragma unroll
    for (int h = 0; h < 2; ++h) {
        const int c0 = h * 512 + 8 * lane;
        const f32x4 g0 = *(const f32x4*)(g + c0), g1 = *(const f32x4*)(g + c0 + 4), b0 = *(const f32x4*)(b + c0), b1 = *(const f32x4*)(b + c0 + 4);
        const f32x4 o0 = (v[2 * h] - mean) * rstd * g0 + b0, o1 = (v[2 * h + 1] - mean) * rstd * g1 + b1;
        *(f32x4*)(o32 + c0) = o0; *(f32x4*)(o32 + c0 + 4) = o1;
        if (ob) { v4u w; w.x = pk2(o0[0], o0[1]); w.y = pk2(o0[2], o0[3]); w.z = pk2(o1[0], o1[1]); w.w = pk2(o1[2], o1[3]); *(v4u*)(ob + c0) = w; }
    }
}
__device__ __forceinline__ void ln_stats(const f32x4 (&v)[4], float& mean, float& rstd, int lane) {
    float s = 0.f;
#pragma unroll
    for (int k = 0; k < 4; ++k) s += (v[k][0] + v[k][1]) + (v[k][2] + v[k][3]);
    mean = wave_sum(s, lane) * (1.f / D);
    float q = 0.f;
#pragma unroll
    for (int k = 0; k < 4; ++k) { const f32x4 d = v[k] - mean; q += (d[0] * d[0] + d[1] * d[1]) + (d[2] * d[2] + d[3] * d[3]); }
    rstd = rsqrtf(wave_sum(q, lane) * (1.f / D) + LN_EPS);
}
__device__ __forceinline__ void phase_ln1(const Ctx& c, int layer) {
    const bf16* MIX = c.W<bf16>(WS_A0); float* H = c.W<float>(WS_H32); bf16* HB = c.W<bf16>(WS_HB);
    const float* g = c.in[c.z + 38] + layer * D; const float* b = c.in[c.z + 39] + layer * D;
    const float* x0 = c.in[c.z + 0]; const float* x1 = c.in[c.z + 1] - (size_t)TP * D;
#define LN1_SRC(t) ((layer == 0) ? (((t) < TP) ? x0 : x1) : (const float*)H)
    f32x4 hn[4]; v4u mn[2];
#pragma unroll
    for (int h = 0; h < 2; ++h) { const float* hs = LN1_SRC(c.gw); hn[2 * h] = *(const f32x4*)(hs + (size_t)c.gw * D + h * 512 + 8 * c.lane); hn[2 * h + 1] = *(const f32x4*)(hs + (size_t)c.gw * D + h * 512 + 8 * c.lane + 4); mn[h] = *(const v4u*)(MIX + (size_t)c.gw * D + h * 512 + 8 * c.lane); }
    for (int t = c.gw; t < T; t += c.NGW) {
        f32x4 v[4];
#pragma unroll
        for (int h = 0; h < 2; ++h) {
            v[2 * h] = hn[2 * h] * ALPHA + (f32x4){bflo(mn[h].x), bfhi(mn[h].x), bflo(mn[h].y), bfhi(mn[h].y)};
            v[2 * h + 1] = hn[2 * h + 1] * ALPHA + (f32x4){bflo(mn[h].z), bfhi(mn[h].z), bflo(mn[h].w), bfhi(mn[h].w)};
        }
        if (t + c.NGW < T) {
#pragma unroll
            for (int h = 0; h < 2; ++h) { const float* hs = LN1_SRC(t + c.NGW); hn[2 * h] = *(const f32x4*)(hs + (size_t)(t + c.NGW) * D + h * 512 + 8 * c.lane); hn[2 * h + 1] = *(const f32x4*)(hs + (size_t)(t + c.NGW) * D + h * 512 + 8 * c.lane + 4); mn[h] = *(const v4u*)(MIX + (size_t)(t + c.NGW) * D + h * 512 + 8 * c.lane); }
        }
        float mean, rstd; ln_stats(v, mean, rstd, c.lane);
        ln_row_store(v, mean, rstd, g, b, H + (size_t)t * D, HB + (size_t)t * D, c.lane);
    }
#undef LN1_SRC
}

__device__ __forceinline__ bf16x8 mk8(float a0, float a1, float a2, float a3, float a4, float a5, float a6, float a7) {
    v4u w; w.x = pk2(a0, a1); w.y = pk2(a2, a3); w.z = pk2(a4, a5); w.w = pk2(a6, a7); return __builtin_bit_cast(bf16x8, w);
}
constexpr int S5_BU_LD = 132  , S5_H_LD = 136  , S5_WAVE_BYTES = 16 * S5_BU_LD * 4 + 16 * S5_H_LD * 2;
constexpr int S5_CE_OFF = 8 * S5_WAVE_BYTES;
#define S5_LOAD_FRAGS(g) \
        bf16x8 Bf[8]; \
        _Pragma("unroll") for (int nt = 0; nt < 8; ++nt) { \
            const int comp = 16 * nt + fr; \
            const float* src = sm + ((comp < 64) ? SM_BBR : SM_BBI) + (size_t)((g) * 64 + (comp & 63)) * 16 + 8 * (fq & 1); \
            const f32x4 a = *(const f32x4*)src, b = *(const f32x4*)(src + 4); \
            const bf16x8 v = mk8(a[0], a[1], a[2], a[3], b[0], b[1], b[2], b[3]); \
            Bf[nt] = (fq < 2) ? v : (bf16x8){0, 0, 0, 0, 0, 0, 0, 0}; } \
        bf16x8 Cf[4]; \
        _Pragma("unroll") for (int ks = 0; ks < 4; ++ks) { \
            const int comp0 = 32 * ks + 8 * fq; \
            const float* src = ((ks < 2) ? c.in[c.z + 13] : c.in[c.z + 14]) + (size_t)((g) * 16 + fr) * 64 + (comp0 & 63); \
            const f32x4 a = *(const f32x4*)src, b = *(const f32x4*)(src + 4); \
            const float sg = (ks < 2) ? 1.f : -1.f; \
            Cf[ks] = mk8(sg * a[0], sg * a[1], sg * a[2], sg * a[3], sg * b[0], sg * b[1], sg * b[2], sg * b[3]); } \
        const float lr = sm[SM_LBR + (g) * 64 + p], li = sm[SM_LBI + (g) * 64 + p]; \
        const f32x4 dk4 = *(const f32x4*)(c.in[c.z + 15] + (g) * 16 + 4 * fq);
__device__ __forceinline__ void phase_s5scan(const Ctx& c) {
    const bf16* U = c.W<bf16>(WS_A0); bf16* G = c.W<bf16>(WS_A1); float* YL = c.W<float>(WS_R32);
    const float* sm = c.W<float>(WS_SMALL);
    float* out = c.out;
    float* o_re_p = out + 17825792, *o_im_p = o_re_p + 32768, *o_re_s = out + 17825792 + 32768 * 2 + 122880 + 73728 + 2097152, *o_im_s = o_re_s + 524288;
    const int lane = c.lane, p = lane, fr = lane & 15, fq = lane >> 4, w = c.wave;
    LAS float* BuT = (LAS float*)(c.lds + w * S5_WAVE_BYTES);
    LAS bf16* Hi = (LAS bf16*)(c.lds + w * S5_WAVE_BYTES + 16 * S5_BU_LD * 4);
    LAS float* CE = (LAS float*)(c.lds + S5_CE_OFF);
    for (int pair = c.bid; pair < 256; pair += c.nblk) {
        const int unit = 2 * pair + (w >> 2), s = unit >> 6, g = unit & 63, seg = w & 3, tokS = s * 2048 + seg * 512;
        S5_LOAD_FRAGS(g)
        float hr = 0.f, hi = 0.f;
        bf16x8 uf_n = {0, 0, 0, 0, 0, 0, 0, 0}; v2u uq_n;
        if (fq < 2) uf_n = *(const bf16x8*)(U + (size_t)(tokS + fr) * D + g * 16 + 8 * fq);
        uq_n = *(const v2u*)(U + (size_t)(tokS + fr) * D + g * 16 + 4 * fq);
        for (int tile = 0; tile < 32; ++tile) {
            const int tb = tokS + tile * 16;
            const bf16x8 uf = uf_n; const v2u uq = uq_n;
            if (tile + 1 < 32) { if (fq < 2) uf_n = *(const bf16x8*)(U + (size_t)(tb + 16 + fr) * D + g * 16 + 8 * fq); uq_n = *(const v2u*)(U + (size_t)(tb + 16 + fr) * D + g * 16 + 4 * fq); }
#pragma unroll
            for (int nt = 0; nt < 8; ++nt) {
                f32x4 acc = {0.f, 0.f, 0.f, 0.f};
                acc = __builtin_amdgcn_mfma_f32_16x16x32_bf16(Bf[nt], uf, acc, 0, 0, 0);
                *(LAS f32x4*)(BuT + fr * S5_BU_LD + 16 * nt + 4 * fq) = acc;
            }
            asm volatile("s_waitcnt lgkmcnt(0)" ::: "memory");
#pragma unroll
            for (int t = 0; t < 16; ++t) {
                const float br = BuT[t * S5_BU_LD + p], bi = BuT[t * S5_BU_LD + 64 + p];
                const float nr = lr * hr - li * hi + br, ni = lr * hi + li * hr + bi;
                hr = nr; hi = ni;
                Hi[t * S5_H_LD + p] = (bf16)f2bf_fast(hr); Hi[t * S5_H_LD + 64 + p] = (bf16)f2bf_fast(hi);
            }
            asm volatile("s_waitcnt lgkmcnt(0)" ::: "memory");
            f32x4 y = {0.f, 0.f, 0.f, 0.f};
#pragma unroll
            for (int ks = 0; ks < 4; ++ks) y = __builtin_amdgcn_mfma_f32_16x16x32_bf16(Cf[ks], *(const LAS bf16x8*)(Hi + fr * S5_H_LD + 32 * ks + 8 * fq), y, 0, 0, 0);
            y[0] += dk4[0] * bflo(uq.x); y[1] += dk4[1] * bfhi(uq.x); y[2] += dk4[2] * bflo(uq.y); y[3] += dk4[3] * bfhi(uq.y);
            *(f32x4*)(YL + (size_t)(tb + fr) * D + g * 16 + 4 * fq) = y;
            asm volatile("" ::: "memory");
        }
        CE[((w >> 2) * 4 + seg) * 128 + p] = hr; CE[((w >> 2) * 4 + seg) * 128 + 64 + p] = hi;
        float pr = lr, pi = li;
#pragma unroll
        for (int k = 0; k < 9; ++k) { const float nr = pr * pr - pi * pi, ni = 2.f * pr * pi; pr = nr; pi = ni; }
        asm volatile("s_waitcnt vmcnt(0)" ::: "memory");
        __syncthreads();
        float sr = 0.f, si = 0.f;
        for (int kk = 0; kk < seg; ++kk) {
            const float er = CE[((w >> 2) * 4 + kk) * 128 + p], ei = CE[((w >> 2) * 4 + kk) * 128 + 64 + p];
            const float nr = pr * sr - pi * si + er, ni = pr * si + pi * sr + ei; sr = nr; si = ni;
        }
        if (seg == 3) { o_re_p[(s * 64 + g) * 64 + p] = pr * sr - pi * si + hr; o_im_p[(s * 64 + g) * 64 + p] = pr * si + pi * sr + hi; }
        float rr = sr, ri = si;
        f32x4 yl_n = *(const f32x4*)(YL + (size_t)(tokS + fr) * D + g * 16 + 4 * fq);
        for (int tile = 0; tile < 32; ++tile) {
            const int tb = tokS + tile * 16;
            const f32x4 yl = yl_n;
            if (tile + 1 < 32) yl_n = *(const f32x4*)(YL + (size_t)(tb + 16 + fr) * D + g * 16 + 4 * fq);
#pragma unroll
            for (int t = 0; t < 16; ++t) {
                const float nr = lr * rr - li * ri, ni = lr * ri + li * rr; rr = nr; ri = ni;
                Hi[t * S5_H_LD + p] = (bf16)f2bf_fast(rr); Hi[t * S5_H_LD + 64 + p] = (bf16)f2bf_fast(ri);
            }
            asm volatile("s_waitcnt lgkmcnt(0)" ::: "memory");
            f32x4 y = yl;
#pragma unroll
            for (int ks = 0; ks < 4; ++ks) y = __builtin_amdgcn_mfma_f32_16x16x32_bf16(Cf[ks], *(const LAS bf16x8*)(Hi + fr * S5_H_LD + 32 * ks + 8 * fq), y, 0, 0, 0);
            v2u o; o.x = pk2(gelu_f(y[0]), gelu_f(y[1])); o.y = pk2(gelu_f(y[2]), gelu_f(y[3]));
            *(v2u*)(G + (size_t)(tb + fr) * D + g * 16 + 4 * fq) = o;
            asm volatile("" ::: "memory");
        }
        __syncthreads();
    }
    for (int unit = 8 * 64 + c.gw; unit < 136 * 64; unit += c.NGW) {
        const int s = unit >> 6, g = unit & 63, tok0 = TP + ((s - 8) << 3);
        S5_LOAD_FRAGS(g)
        float hr = c.in[c.z + 2][((s - 8) * 64 + g) * 64 + p], hi = c.in[c.z + 3][((s - 8) * 64 + g) * 64 + p];
        const bool valid = fr < 8;
        bf16x8 uf = {0, 0, 0, 0, 0, 0, 0, 0}; v2u uq = {0u, 0u};
        if (valid) { if (fq < 2) uf = *(const bf16x8*)(U + (size_t)(tok0 + fr) * D + g * 16 + 8 * fq); uq = *(const v2u*)(U + (size_t)(tok0 + fr) * D + g * 16 + 4 * fq); }
#pragma unroll
        for (int nt = 0; nt < 8; ++nt) {
            f32x4 acc = {0.f, 0.f, 0.f, 0.f};
            acc = __builtin_amdgcn_mfma_f32_16x16x32_bf16(Bf[nt], uf, acc, 0, 0, 0);
            *(LAS f32x4*)(BuT + fr * S5_BU_LD + 16 * nt + 4 * fq) = acc;
        }
        asm volatile("s_waitcnt lgkmcnt(0)" ::: "memory");
#pragma unroll
        for (int t = 0; t < 16; ++t) {
            const float br = BuT[t * S5_BU_LD + p], bi = BuT[t * S5_BU_LD + 64 + p];
            const float nr = lr * hr - li * hi + br, ni = lr * hi + li * hr + bi;
            if (t < 8) { hr = nr; hi = ni; }
            Hi[t * S5_H_LD + p] = (bf16)f2bf_fast(hr); Hi[t * S5_H_LD + 64 + p] = (bf16)f2bf_fast(hi);
        }
        asm volatile("s_waitcnt lgkmcnt(0)" ::: "memory");
        f32x4 y = {0.f, 0.f, 0.f, 0.f};
#pragma unroll
        for (int ks = 0; ks < 4; ++ks) y = __builtin_amdgcn_mfma_f32_16x16x32_bf16(Cf[ks], *(const LAS bf16x8*)(Hi + fr * S5_H_LD + 32 * ks + 8 * fq), y, 0, 0, 0);
        if (valid) {
            v2u o; o.x = pk2(gelu_f(y[0] + dk4[0] * bflo(uq.x)), gelu_f(y[1] + dk4[1] * bfhi(uq.x))); o.y = pk2(gelu_f(y[2] + dk4[2] * bflo(uq.y)), gelu_f(y[3] + dk4[3] * bfhi(uq.y)));
            *(v2u*)(G + (size_t)(tok0 + fr) * D + g * 16 + 4 * fq) = o;
        }
        o_re_s[((s - 8) * 64 + g) * 64 + p] = hr; o_im_s[((s - 8) * 64 + g) * 64 + p] = hi;
        asm volatile("" ::: "memory");
    }
}
#undef S5_LOAD_FRAGS

__device__ __forceinline__ void unpack8(const v4u q, float (&f)[8]) { f[0] = bflo(q.x); f[1] = bfhi(q.x); f[2] = bflo(q.y); f[3] = bfhi(q.y); f[4] = bflo(q.z); f[5] = bfhi(q.z); f[6] = bflo(q.w); f[7] = bfhi(q.w); }
__device__ __forceinline__ void phase_pool(const Ctx& c) {
    const bf16* U = c.W<bf16>(WS_A0); bf16* P = c.W<bf16>(WS_A1);
    float* o_p = c.out + 17825792 + 65536, *o_s = c.out + 17825792 + 65536 + 122880 + 73728 + 2097152 + 1048576;
    for (int item = c.gt; item < 640 * 128; item += c.NGT) {
        const int rg = item >> 7, c0 = (item & 127) * 8, w = 2 << (c0 >> 8);
        int tok0, l0, n, sb;
        if (rg < 512) { tok0 = (rg >> 6) << 11; l0 = (rg & 63) * 32; n = 32; sb = -1; } else { sb = rg - 512; tok0 = TP + sb * 8; l0 = 0; n = 8; }
        float sum[8];
#pragma unroll
        for (int j = 0; j < 8; ++j) sum[j] = 0.f;
        for (int k = 1; k < w; ++k) {
            const int ll = l0 - k; float f[8];
            if (ll >= 0) unpack8(*(const v4u*)(U + (size_t)(tok0 + ll) * D + c0), f);
            else if (sb >= 0) { const float* sp = c.in[c.z + 4] + ((size_t)sb * 15 + (15 + ll)) * D + c0; const f32x4 a = *(const f32x4*)sp, b = *(const f32x4*)(sp + 4); f[0] = a[0]; f[1] = a[1]; f[2] = a[2]; f[3] = a[3]; f[4] = b[0]; f[5] = b[1]; f[6] = b[2]; f[7] = b[3]; }
            else {
#pragma unroll
                for (int j = 0; j < 8; ++j) f[j] = 0.f;
            }
#pragma unroll
            for (int j = 0; j < 8; ++j) sum[j] += f[j];
        }
        for (int i4 = 0; i4 < n; i4 += 4) {
          v4u rin[4], rout[4];
#pragma unroll
          for (int u = 0; u < 4; ++u) {
              const int l = l0 + i4 + u, lo = l - w + 1;
              rin[u] = *(const v4u*)(U + (size_t)(tok0 + l) * D + c0);
              rout[u] = (lo >= 0) ? *(const v4u*)(U + (size_t)(tok0 + lo) * D + c0) : (v4u){0u, 0u, 0u, 0u};
          }
#pragma unroll
          for (int u = 0; u < 4; ++u) {
            const int i = i4 + u;
            const int l = l0 + i; float cur[8], old[8];
            unpack8(rin[u], cur);
#pragma unroll
            for (int j = 0; j < 8; ++j) sum[j] += cur[j];
            const int pos = (sb >= 0 ? 16384 : 0) + l;
            const float inv = __builtin_amdgcn_rcpf((float)min(pos + 1, w));
            v4u o; o.x = pk2(sum[0] * inv - cur[0], sum[1] * inv - cur[1]); o.y = pk2(sum[2] * inv - cur[2], sum[3] * inv - cur[3]);
            o.z = pk2(sum[4] * inv - cur[4], sum[5] * inv - cur[5]); o.w = pk2(sum[6] * inv - cur[6], sum[7] * inv - cur[7]);
            *(v4u*)(P + (size_t)(tok0 + l) * D + c0) = o;
            const int lo = l - w + 1;
            if (lo >= 0) unpack8(rout[u], old);
            else if (sb >= 0) { const float* sp = c.in[c.z + 4] + ((size_t)sb * 15 + (15 + lo)) * D + c0; const f32x4 a = *(const f32x4*)sp, b = *(const f32x4*)(sp + 4); old[0] = a[0]; old[1] = a[1]; old[2] = a[2]; old[3] = a[3]; old[4] = b[0]; old[5] = b[1]; old[6] = b[2]; old[7] = b[3]; }
            else {
#pragma unroll
                for (int j = 0; j < 8; ++j) old[j] = 0.f;
            }
#pragma unroll
            for (int j = 0; j < 8; ++j) sum[j] -= old[j];
          }
        }
    }
    for (size_t i = (size_t)c.gt; i < (size_t)136 * 15 * D; i += (size_t)c.NGT) {
        const int ch = (int)(i & 1023); const int j = (int)((i >> 10) % 15); const int s = (int)(i / (15 * 1024));
        if (s < 8) o_p[((size_t)s * 15 + j) * D + ch] = bf2f(U[(size_t)(s * 2048 + 2033 + j) * D + ch]);
        else { const int b = s - 8; o_s[((size_t)b * 15 + j) * D + ch] = (j < 7) ? c.in[c.z + 4][((size_t)b * 15 + 8 + j) * D + ch] : bf2f(U[(size_t)(TP + b * 8 + (j - 7)) * D + ch]); }
    }
}

__device__ __forceinline__ void phase_cmlp_ln(const Ctx& c) {
    bf16* Z = c.W<bf16>(WS_Q);
    float* o_v = c.out + 17825792 + 65536 + 122880 + 73728 + 2097152 + 1048576 + 1966080;
    const float* g = c.in[c.z + 25]; const float* b = c.in[c.z + 26];
    v4u qn[2], qnn[2];
#pragma unroll
    for (int h = 0; h < 2; ++h) { qn[h] = *(const v4u*)(Z + (size_t)c.gw * 2048 + 1024 + h * 512 + 8 * c.lane); qnn[h] = *(const v4u*)(Z + (size_t)(c.gw + c.NGW) * 2048 + 1024 + h * 512 + 8 * c.lane); }
    for (int t = c.gw; t < T; t += c.NGW) {
        bf16* vr = Z + (size_t)t * 2048 + 1024;
        f32x4 v[4];
        const v4u qc[2] = {qn[0], qn[1]};
        qn[0] = qnn[0]; qn[1] = qnn[1];
        if (t + 2 * c.NGW < T) {
#pragma unroll
            for (int h = 0; h < 2; ++h) qnn[h] = *(const v4u*)(Z + (size_t)(t + 2 * c.NGW) * 2048 + 1024 + h * 512 + 8 * c.lane);
        }
#pragma unroll
        for (int h = 0; h < 2; ++h) {
            const v4u q = qc[h];
            v[2 * h] = (f32x4){bflo(q.x), bfhi(q.x), bflo(q.y), bfhi(q.y)}; v[2 * h + 1] = (f32x4){bflo(q.z), bfhi(q.z), bflo(q.w), bfhi(q.w)};
        }
        float mean, rstd; ln_stats(v, mean, rstd, c.lane);
#pragma unroll
        for (int h = 0; h < 2; ++h) {
            const int c0 = h * 512 + 8 * c.lane;
            const f32x4 g0 = *(const f32x4*)(g + c0), g1 = *(const f32x4*)(g + c0 + 4), b0 = *(const f32x4*)(b + c0), b1 = *(const f32x4*)(b + c0 + 4);
            const f32x4 o0 = (v[2 * h] - mean) * rstd * g0 + b0, o1 = (v[2 * h + 1] - mean) * rstd * g1 + b1;
            v4u w; w.x = pk2(o0[0], o0[1]); w.y = pk2(o0[2], o0[3]); w.z = pk2(o1[0], o1[1]); w.w = pk2(o1[2], o1[3]);
            *(v4u*)(vr + c0) = w;
            if (t >= TP) { *(f32x4*)(o_v + (size_t)(t - TP) * D + c0) = o0; *(f32x4*)(o_v + (size_t)(t - TP) * D + c0 + 4) = o1; }
        }
    }
}
constexpr int CM_LD = 136, CM_WS = 0  , CM_VT = 34816  ;
__device__ __forceinline__ void phase_cmlp_mix(const Ctx& c) {
    const bf16* Z = c.W<bf16>(WS_Q); bf16* O = c.W<bf16>(WS_A1);
    LAS unsigned char* lds = c.lds;
    const int tid = c.tid, lane = c.lane, w = c.wave, fr = lane & 15, fq = lane >> 4;
    for (int unit = c.bid; unit < 128 * 4; unit += c.nblk) {
        const int chunk = unit >> 2, hd = unit & 3, tokc = chunk * 128;
#pragma unroll
        for (int k = 0; k < 4; ++k) {
            const int q = tid + 512 * k, row = q >> 4, cc = q & 15;
            const float* src = c.in[c.z + 27] + ((size_t)hd * 128 + row) * 128 + cc * 8;
            const f32x4 a = *(const f32x4*)src, b = *(const f32x4*)(src + 4);
            float f[8] = {a[0], a[1], a[2], a[3], b[0], b[1], b[2], b[3]};
#pragma unroll
            for (int j = 0; j < 8; ++j) f[j] = (cc * 8 + j <= row) ? f[j] : 0.f;
            v4u o; o.x = pk2(f[0], f[1]); o.y = pk2(f[2], f[3]); o.z = pk2(f[4], f[5]); o.w = pk2(f[6], f[7]);
            *(LAS v4u*)(lds + CM_WS + (row * CM_LD + cc * 8) * 2) = o;
        }
        {
            const int srow = tid & 127, dq = tid >> 7;
            const bf16* vs = Z + (size_t)(tokc + srow) * 2048 + 1024 + hd * 256 + dq * 64;
#pragma unroll
            for (int k = 0; k < 8; ++k) {
                const v4u q = *(const v4u*)(vs + 8 * k);
                const unsigned xw[4] = {q.x, q.y, q.z, q.w};
#pragma unroll
                for (int j = 0; j < 4; ++j) {
                    *(LAS bf16*)(lds + CM_VT + ((dq * 64 + 8 * k + 2 * j) * CM_LD + srow) * 2) = (bf16)(xw[j] & 0xffffu);
                    *(LAS bf16*)(lds + CM_VT + ((dq * 64 + 8 * k + 2 * j + 1) * CM_LD + srow) * 2) = (bf16)(xw[j] >> 16);
                }
            }
        }
        __syncthreads();
        f32x4 acc[16];
#pragma unroll
        for (int jd = 0; jd < 16; ++jd) acc[jd] = (f32x4){0.f, 0.f, 0.f, 0.f};
#pragma unroll
        for (int ks = 0; ks < 4; ++ks) {
            if (ks <= (w >> 1)) {
                const bf16x8 wf = *(const LAS bf16x8*)(lds + CM_WS + ((16 * w + fr) * CM_LD + ks * 32 + 8 * fq) * 2);
#pragma unroll
                for (int jd = 0; jd < 16; ++jd)
                    acc[jd] = __builtin_amdgcn_mfma_f32_16x16x32_bf16(*(const LAS bf16x8*)(lds + CM_VT + ((16 * jd + fr) * CM_LD + ks * 32 + 8 * fq) * 2), wf, acc[jd], 0, 0, 0);
            }
        }
        {
            const int t = 16 * w + fr; const size_t tok = (size_t)(tokc + t);
            const float bs = c.in[c.z + 28][hd * 128 + t];
#pragma unroll
            for (int jd = 0; jd < 16; ++jd) {
                const v2u uq = *(const v2u*)(Z + tok * 2048 + hd * 256 + 16 * jd + 4 * fq);
                v2u o; o.x = pk2(bflo(uq.x) * (acc[jd][0] + bs), bfhi(uq.x) * (acc[jd][1] + bs)); o.y = pk2(bflo(uq.y) * (acc[jd][2] + bs), bfhi(uq.y) * (acc[jd][3] + bs));
                *(v2u*)(O + tok * D + hd * 256 + 16 * jd + 4 * fq) = o;
            }
        }
        __syncthreads();
    }
    for (size_t i = (size_t)c.gt; i < (size_t)(T - TP) * 128; i += (size_t)c.NGT) {
        const int t = TP + (int)(i >> 7), c0 = (int)(i & 127) * 8;
        const int hd = c0 >> 8, tp = (t - TP) & 7, base = t - tp;
        float acc[8];
        const float bs = c.in[c.z + 28][hd * 128 + tp];
#pragma unroll
        for (int j = 0; j < 8; ++j) acc[j] = bs;
        const float* wr = c.in[c.z + 27] + ((size_t)hd * 128 + tp) * 128;
        for (int sp = 0; sp <= tp; ++sp) {
            const float wv = wr[sp];
            const v4u q = *(const v4u*)(Z + (size_t)(base + sp) * 2048 + 1024 + c0);
            acc[0] += wv * bflo(q.x); acc[1] += wv * bfhi(q.x); acc[2] += wv * bflo(q.y); acc[3] += wv * bfhi(q.y);
            acc[4] += wv * bflo(q.z); acc[5] += wv * bfhi(q.z); acc[6] += wv * bflo(q.w); acc[7] += wv * bfhi(q.w);
        }
        const v4u uq = *(const v4u*)(Z + (size_t)t * 2048 + c0);
        v4u o; o.x = pk2(bflo(uq.x) * acc[0], bfhi(uq.x) * acc[1]); o.y = pk2(bflo(uq.y) * acc[2], bfhi(uq.y) * acc[3]);
        o.z = pk2(bflo(uq.z) * acc[4], bfhi(uq.z) * acc[5]); o.w = pk2(bflo(uq.w) * acc[6], bfhi(uq.w) * acc[7]);
        *(v4u*)(O + (size_t)t * D + c0) = o;
    }
}

__device__ __forceinline__ void phase_ssd_conv(const Ctx& c) {
    const bf16* X = c.W<bf16>(WS_XBC); bf16* XC = c.W<bf16>(WS_XC);
    float* o_p = c.out + 17825792 + 65536 + 122880, *o_s = c.out + 17825792 + 65536 + 122880 + 73728 + 2097152 + 1048576 + 1966080 + 1048576;
    for (int item = c.gt; item < 640 * 384; item += c.NGT) {
        const int rg = item / 384, c0 = (item % 384) * 8;
        int tok0, l0, n, sb;
        if (rg < 512) { tok0 = (rg >> 6) << 11; l0 = (rg & 63) * 32; n = 32; sb = -1; } else { sb = rg - 512; tok0 = TP + sb * 8; l0 = 0; n = 8; }
        float wt[4][8], bias[8];
#pragma unroll
        for (int k = 0; k < 4; ++k) { const f32x4 a = *(const f32x4*)(c.in[c.z + 31] + k * CONVD + c0), b = *(const f32x4*)(c.in[c.z + 31] + k * CONVD + c0 + 4);
            wt[k][0] = a[0]; wt[k][1] = a[1]; wt[k][2] = a[2]; wt[k][3] = a[3]; wt[k][4] = b[0]; wt[k][5] = b[1]; wt[k][6] = b[2]; wt[k][7] = b[3]; }
        { const f32x4 a = *(const f32x4*)(c.in[c.z + 32] + c0), b = *(const f32x4*)(c.in[c.z + 32] + c0 + 4); bias[0] = a[0]; bias[1] = a[1]; bias[2] = a[2]; bias[3] = a[3]; bias[4] = b[0]; bias[5] = b[1]; bias[6] = b[2]; bias[7] = b[3]; }
        float r0[8], r1[8], r2[8];
#pragma unroll
        for (int k = 0; k < 3; ++k) {
            const int src = l0 - 3 + k; float f[8];
            if (src >= 0) unpack8(*(const v4u*)(X + (size_t)(tok0 + src) * CONVD + c0), f);
            else if (sb >= 0) { const float* sp = c.in[c.z + 5] + ((size_t)sb * 3 + (3 + src)) * CONVD + c0; const f32x4 a = *(const f32x4*)sp, b = *(const f32x4*)(sp + 4); f[0] = a[0]; f[1] = a[1]; f[2] = a[2]; f[3] = a[3]; f[4] = b[0]; f[5] = b[1]; f[6] = b[2]; f[7] = b[3]; }
            else {
#pragma unroll
                for (int j = 0; j < 8; ++j) f[j] = 0.f;
            }
#pragma unroll
            for (int j = 0; j < 8; ++j) { if (k == 0) r0[j] = f[j]; else if (k == 1) r1[j] = f[j]; else r2[j] = f[j]; }
        }
        v4u rn[4];
#pragma unroll
        for (int u = 0; u < 4; ++u) rn[u] = *(const v4u*)(X + (size_t)(tok0 + l0 + u) * CONVD + c0);
        for (int i = 0; i < n; i += 4) {
            v4u rq[4];
#pragma unroll
            for (int u = 0; u < 4; ++u) rq[u] = rn[u];
            if (i + 4 < n) {
#pragma unroll
                for (int u = 0; u < 4; ++u) rn[u] = *(const v4u*)(X + (size_t)(tok0 + l0 + i + 4 + u) * CONVD + c0);
            }
#pragma unroll
            for (int u = 0; u < 4; ++u) {
                float cur[8], o[8];
                unpack8(rq[u], cur);
#pragma unroll
                for (int j = 0; j < 8; ++j) { o[j] = silu_f(bias[j] + r0[j] * wt[0][j] + r1[j] * wt[1][j] + r2[j] * wt[2][j] + cur[j] * wt[3][j]); r0[j] = r1[j]; r1[j] = r2[j]; r2[j] = cur[j]; }
                v4u q; q.x = pk2(o[0], o[1]); q.y = pk2(o[2], o[3]); q.z = pk2(o[4], o[5]); q.w = pk2(o[6], o[7]);
                *(v4u*)(XC + (size_t)(tok0 + l0 + i + u) * CONVD + c0) = q;
            }
        }
    }
    for (size_t i = (size_t)c.gt; i < (size_t)136 * 3 * CONVD; i += (size_t)c.NGT) {
        const int ch = (int)(i % CONVD); const int j = (int)((i / CONVD) % 3); const int s = (int)(i / (3 * CONVD));
        if (s < 8) o_p[((size_t)s * 3 + j) * CONVD + ch] = bf2f(X[(size_t)(s * 2048 + 2045 + j) * CONVD + ch]);
        else { const int b = s - 8; o_s[((size_t)b * 3 + j) * CONVD + ch] = bf2f(X[(size_t)(TP + b * 8 + 5 + j) * CONVD + ch]); }
    }
}
constexpr int SD_LD = 136;
constexpr int SD_C = 0, SD_B = 34816, SD_BT = 69632, SD_XT = 104448, SD_HB = 121856, SD_VEC = 139264;
__device__ __forceinline__ float softplus_f(float x) { return (x > 20.f) ? x : log1pf(__expf(x)); }
__device__ __forceinline__ void phase_ssd_scan(const Ctx& c) {
    const bf16* XC = c.W<bf16>(WS_XC); const float* DT = c.W<float>(WS_DT); bf16* Y = c.W<bf16>(WS_Y);
    float* o_p = c.out + 17825792 + 65536 + 122880 + 73728;
    float* o_s = c.out + 17825792 + 65536 + 122880 + 73728 + 2097152 + 1048576 + 1966080 + 1048576 + 1179648;
    const int tid = c.tid, lane = c.lane, w = c.wave, fr = lane & 15, fq = lane >> 4;
    LAS unsigned char* lds = c.lds;
    LAS float* csv = (LAS float*)(lds + SD_VEC); LAS float* dtv = csv + 128;
#define SD_FRAG(img, row, ks) (*(const LAS bf16x8*)(lds + (img) + ((row) * SD_LD + (ks) * 32 + 8 * fq) * 2))
    for (int unit = c.bid; unit < 8 * 32; unit += c.nblk) {
        const int s = unit >> 5, hd = unit & 31, g = hd >> 3;
        const float a = -__expf(c.in[c.z + 34][hd]), dtb = c.in[c.z + 33][hd], dk = c.in[c.z + 35][hd];
        f32x4 hacc[4];
#pragma unroll
        for (int jp = 0; jp < 4; ++jp) hacc[jp] = (f32x4){0.f, 0.f, 0.f, 0.f};
        v4u pfC[4], pfB[4], pfx0, pfx1; float pfd0 = 0.f, pfd1 = 0.f;
#define SD_PREFETCH(tk) do { \
            _Pragma("unroll") for (int k = 0; k < 4; ++k) { const int q = tid + 512 * k, row = q >> 4, cc = q & 15; \
                const bf16* src = XC + (size_t)((tk) + row) * CONVD + g * 128 + cc * 8; pfC[k] = *(const v4u*)(src + 2560); pfB[k] = *(const v4u*)(src + 2048); } \
            { const bf16* xs = XC + (size_t)((tk) + (tid & 127)) * CONVD + hd * 64 + (tid >> 7) * 16; pfx0 = *(const v4u*)xs; pfx1 = *(const v4u*)(xs + 8); } \
            if (w == 0) { pfd0 = DT[(size_t)((tk) + lane) * 32 + hd]; pfd1 = DT[(size_t)((tk) + 64 + lane) * 32 + hd]; } } while (0)
        SD_PREFETCH(s * 2048);
        for (int ch = 0; ch < 16; ++ch) {
            const int tokc = s * 2048 + ch * 128;
            if (w == 0) {
                const float dt0 = softplus_f(pfd0 + dtb), dt1 = softplus_f(pfd1 + dtb);
                float s0 = dt0 * a, s1 = dt1 * a;
#pragma unroll
                for (int o = 1; o < 64; o <<= 1) {
                    const float u0 = __builtin_bit_cast(float, __builtin_amdgcn_ds_bpermute(((lane - o) & 63) << 2, __builtin_bit_cast(int, s0)));
                    const float u1 = __builtin_bit_cast(float, __builtin_amdgcn_ds_bpermute(((lane - o) & 63) << 2, __builtin_bit_cast(int, s1)));
                    if (lane >= o) { s0 += u0; s1 += u1; }
                }
                const float tot0 = __builtin_bit_cast(float, __builtin_amdgcn_readlane(__builtin_bit_cast(int, s0), 63));
                csv[lane] = s0; csv[64 + lane] = tot0 + s1; dtv[lane] = dt0; dtv[64 + lane] = dt1;
            }
#pragma unroll
            for (int k = 0; k < 4; ++k) {
                const int q = tid + 512 * k, row = q >> 4, cc = q & 15;
                *(LAS v4u*)(lds + SD_C + (row * SD_LD + cc * 8) * 2) = pfC[k];
                *(LAS v4u*)(lds + SD_B + (row * SD_LD + cc * 8) * 2) = pfB[k];
            }
            const v4u x0 = pfx0, x1 = pfx1;
            if (ch + 1 < 16) SD_PREFETCH(tokc + 128);
#pragma unroll
            for (int jp = 0; jp < 4; ++jp) {
                v2u hq; hq.x = pk2(hacc[jp][0], hacc[jp][1]); hq.y = pk2(hacc[jp][2], hacc[jp][3]);
                *(LAS v2u*)(lds + SD_HB + ((16 * jp + fr) * SD_LD + 16 * w + 4 * fq) * 2) = hq;
            }
            __syncthreads();
            {
                const int srow = tid & 127, qq = tid >> 7;
                const float sc = __expf(csv[127] - csv[srow]) * dtv[srow];
#pragma unroll
                for (int k = 0; k < 4; ++k) {
                    const int n0 = qq * 32 + k * 8;
                    const v4u bq = *(const LAS v4u*)(lds + SD_B + (srow * SD_LD + n0) * 2);
                    const float f[8] = {bflo(bq.x), bfhi(bq.x), bflo(bq.y), bfhi(bq.y), bflo(bq.z), bfhi(bq.z), bflo(bq.w), bfhi(bq.w)};
#pragma unroll
                    for (int j = 0; j < 8; ++j) *(LAS bf16*)(lds + SD_BT + ((n0 + j) * SD_LD + srow) * 2) = (bf16)f2bf(f[j] * sc);
                }
                const unsigned xw[8] = {x0.x, x0.y, x0.z, x0.w, x1.x, x1.y, x1.z, x1.w};
#pragma unroll
                for (int j = 0; j < 8; ++j) {
                    *(LAS bf16*)(lds + SD_XT + ((qq * 16 + 2 * j) * SD_LD + srow) * 2) = (bf16)(xw[j] & 0xffffu);
                    *(LAS bf16*)(lds + SD_XT + ((qq * 16 + 2 * j + 1) * SD_LD + srow) * 2) = (bf16)(xw[j] >> 16);
                }
            }
            __syncthreads();
            const int jmax = w | 1;
            bf16x8 Cf[4];
#pragma unroll
            for (int ks = 0; ks < 4; ++ks) Cf[ks] = SD_FRAG(SD_C, 16 * w + fr, ks);
            f32x4 acc[8];
#pragma unroll
            for (int j = 0; j < 8; ++j) {
                acc[j] = (f32x4){0.f, 0.f, 0.f, 0.f};
                if (j <= jmax) {
#pragma unroll
                    for (int ks = 0; ks < 4; ++ks) acc[j] = __builtin_amdgcn_mfma_f32_16x16x32_bf16(SD_FRAG(SD_B, 16 * j + fr, ks), Cf[ks], acc[j], 0, 0, 0);
                }
            }
            {
                const float cdec = __expf(csv[127]);
                bf16x8 Bt[4];
#pragma unroll
                for (int ks = 0; ks < 4; ++ks) Bt[ks] = SD_FRAG(SD_BT, 16 * w + fr, ks);
#pragma unroll
                for (int jp = 0; jp < 4; ++jp) {
                    hacc[jp] = hacc[jp] * cdec;
#pragma unroll
                    for (int ks = 0; ks < 4; ++ks) hacc[jp] = __builtin_amdgcn_mfma_f32_16x16x32_bf16(Bt[ks], SD_FRAG(SD_XT, 16 * jp + fr, ks), hacc[jp], 0, 0, 0);
                }
            }
            __syncthreads();
            {
                const int t = 16 * w + fr; const float cst = csv[t];
#pragma unroll
                for (int j = 0; j < 8; ++j) {
                    if (j <= jmax) {
                        const f32x4 css = *(const LAS f32x4*)(csv + 16 * j + 4 * fq), dts = *(const LAS f32x4*)(dtv + 16 * j + 4 * fq);
                        float v[4];
#pragma unroll
                        for (int r = 0; r < 4; ++r) v[r] = (16 * j + 4 * fq + r <= t) ? acc[j][r] * __expf(cst - css[r]) * dts[r] : 0.f;
                        v2u lq; lq.x = pk2(v[0], v[1]); lq.y = pk2(v[2], v[3]);
                        *(LAS v2u*)(lds + SD_B + (t * SD_LD + 16 * j + 4 * fq) * 2) = lq;
                    }
                }
            }
            __syncthreads();
            {
                f32x4 a1[4], a2[4];
#pragma unroll
                for (int jp = 0; jp < 4; ++jp) { a1[jp] = (f32x4){0.f, 0.f, 0.f, 0.f}; a2[jp] = (f32x4){0.f, 0.f, 0.f, 0.f}; }
#pragma unroll
                for (int ks = 0; ks < 4; ++ks) {
                    if (ks <= (w >> 1)) {
                        const bf16x8 Lf = SD_FRAG(SD_B, 16 * w + fr, ks);
#pragma unroll
                        for (int jp = 0; jp < 4; ++jp) a1[jp] = __builtin_amdgcn_mfma_f32_16x16x32_bf16(SD_FRAG(SD_XT, 16 * jp + fr, ks), Lf, a1[jp], 0, 0, 0);
                    }
#pragma unroll
                    for (int jp = 0; jp < 4; ++jp) a2[jp] = __builtin_amdgcn_mfma_f32_16x16x32_bf16(SD_FRAG(SD_HB, 16 * jp + fr, ks), Cf[ks], a2[jp], 0, 0, 0);
                }
                const int t = 16 * w + fr; const float ecs = __expf(csv[t]);
                const size_t tok = (size_t)(tokc + t);
#pragma unroll
                for (int jp = 0; jp < 4; ++jp) {
                    const LAS bf16* xt = (const LAS bf16*)(lds + SD_XT) + (16 * jp + 4 * fq) * SD_LD + t;
                    const float x0 = bf2f(xt[0]), x1 = bf2f(xt[SD_LD]), x2 = bf2f(xt[2 * SD_LD]), x3 = bf2f(xt[3 * SD_LD]);
                    v2u yo; yo.x = pk2(a1[jp][0] + ecs * a2[jp][0] + dk * x0, a1[jp][1] + ecs * a2[jp][1] + dk * x1);
                    yo.y = pk2(a1[jp][2] + ecs * a2[jp][2] + dk * x2, a1[jp][3] + ecs * a2[jp][3] + dk * x3);
                    *(v2u*)(Y + tok * 2048 + hd * 64 + 16 * jp + 4 * fq) = yo;
                }
            }
            __syncthreads();
        }
#pragma unroll
        for (int jp = 0; jp < 4; ++jp) *(f32x4*)(o_p + (((size_t)s * 32 + hd) * 64 + 16 * jp + fr) * 128 + 16 * w + 4 * fq) = hacc[jp];
    }
#undef SD_FRAG
#undef SD_PREFETCH
    __syncthreads();
    {
        LAS float* Bw = (LAS float*)(lds + w * 8192);
        LAS float* Cw = Bw + 1024;
        for (int unit = c.gw; unit < 128 * 32; unit += c.NGW) {
            const int b = unit >> 5, hd = unit & 31, g = hd >> 3, tok0 = TP + b * 8, p = lane;
            const float a = -__expf(c.in[c.z + 34][hd]), dtb = c.in[c.z + 33][hd], dk = c.in[c.z + 35][hd];
            {
                const int tk = lane >> 3, c0 = (lane & 7) * 16;
                const bf16* src = XC + (size_t)(tok0 + tk) * CONVD + g * 128 + c0;
                const v4u b0 = *(const v4u*)(src + 2048), b1 = *(const v4u*)(src + 2048 + 8), c0v = *(const v4u*)(src + 2560), c1v = *(const v4u*)(src + 2560 + 8);
                LAS float* bd = Bw + tk * 128 + c0; LAS float* cd = Cw + tk * 128 + c0;
                *(LAS f32x4*)(bd) = (f32x4){bflo(b0.x), bfhi(b0.x), bflo(b0.y), bfhi(b0.y)}; *(LAS f32x4*)(bd + 4) = (f32x4){bflo(b0.z), bfhi(b0.z), bflo(b0.w), bfhi(b0.w)};
                *(LAS f32x4*)(bd + 8) = (f32x4){bflo(b1.x), bfhi(b1.x), bflo(b1.y), bfhi(b1.y)}; *(LAS f32x4*)(bd + 12) = (f32x4){bflo(b1.z), bfhi(b1.z), bflo(b1.w), bfhi(b1.w)};
                *(LAS f32x4*)(cd) = (f32x4){bflo(c0v.x), bfhi(c0v.x), bflo(c0v.y), bfhi(c0v.y)}; *(LAS f32x4*)(cd + 4) = (f32x4){bflo(c0v.z), bfhi(c0v.z), bflo(c0v.w), bfhi(c0v.w)};
                *(LAS f32x4*)(cd + 8) = (f32x4){bflo(c1v.x), bfhi(c1v.x), bflo(c1v.y), bfhi(c1v.y)}; *(LAS f32x4*)(cd + 12) = (f32x4){bflo(c1v.z), bfhi(c1v.z), bflo(c1v.w), bfhi(c1v.w)};
            }
            float xv[8], dA[8], coef[8], yv[8];
#pragma unroll
            for (int t = 0; t < 8; ++t) {
                xv[t] = bf2f(XC[(size_t)(tok0 + t) * CONVD + hd * 64 + p]);
                const float dtv_ = softplus_f(DT[(size_t)(tok0 + t) * 32 + hd] + dtb);
                dA[t] = __expf(dtv_ * a); coef[t] = dtv_ * xv[t]; yv[t] = dk * xv[t];
            }
            asm volatile("s_waitcnt lgkmcnt(0)" ::: "memory");
            const float* hin = c.in[c.z + 6] + (((size_t)b * 32 + hd) * 64 + p) * 128;
            float* hout = o_s + (((size_t)b * 32 + hd) * 64 + p) * 128;
#pragma unroll 1
            for (int qt = 0; qt < 4; ++qt) {
                float h[32];
#pragma unroll
                for (int i = 0; i < 8; ++i) { const f32x4 q = *(const f32x4*)(hin + qt * 32 + 4 * i); h[4 * i] = q[0]; h[4 * i + 1] = q[1]; h[4 * i + 2] = q[2]; h[4 * i + 3] = q[3]; }
#pragma unroll
                for (int t = 0; t < 8; ++t) {
                    float ya = 0.f, yb = 0.f;
#pragma unroll
                    for (int i = 0; i < 8; ++i) {
                        const f32x4 bq = *(const LAS f32x4*)(Bw + t * 128 + qt * 32 + 4 * i), cq = *(const LAS f32x4*)(Cw + t * 128 + qt * 32 + 4 * i);
                        h[4 * i] = h[4 * i] * dA[t] + coef[t] * bq[0]; ya += cq[0] * h[4 * i];
                        h[4 * i + 1] = h[4 * i + 1] * dA[t] + coef[t] * bq[1]; yb += cq[1] * h[4 * i + 1];
                        h[4 * i + 2] = h[4 * i + 2] * dA[t] + coef[t] * bq[2]; ya += cq[2] * h[4 * i + 2];
                        h[4 * i + 3] = h[4 * i + 3] * dA[t] + coef[t] * bq[3]; yb += cq[3] * h[4 * i + 3];
                    }
                    yv[t] += ya + yb;
                    asm volatile("" ::: "memory");
                }
#pragma unroll
                for (int i = 0; i < 8; ++i) *(f32x4*)(hout + qt * 32 + 4 * i) = (f32x4){h[4 * i], h[4 * i + 1], h[4 * i + 2], h[4 * i + 3]};
            }
#pragma unroll
            for (int t = 0; t < 8; ++t) Y[(size_t)(tok0 + t) * 2048 + hd * 64 + p] = (bf16)f2bf(yv[t]);
            asm volatile("" ::: "memory");
        }
    }
}
__device__ __forceinline__ void phase_ssd_gatenorm(const Ctx& c) {
    const bf16* Y = c.W<bf16>(WS_Y); const bf16* Z = c.W<bf16>(WS_Q); bf16* YN = c.W<bf16>(WS_YN);
    v4u yn[4], zn[4];
#pragma unroll
    for (int g = 0; g < 4; ++g) { yn[g] = *(const v4u*)(Y + (size_t)c.gw * 2048 + g * 512 + 8 * c.lane); zn[g] = *(const v4u*)(Z + (size_t)c.gw * 2048 + g * 512 + 8 * c.lane); }
    for (int t = c.gw; t < T; t += c.NGW) {
        v4u yq[4], zq[4];
#pragma unroll
        for (int g = 0; g < 4; ++g) { yq[g] = yn[g]; zq[g] = zn[g]; }
        if (t + c.NGW < T) {
#pragma unroll
            for (int g = 0; g < 4; ++g) { yn[g] = *(const v4u*)(Y + (size_t)(t + c.NGW) * 2048 + g * 512 + 8 * c.lane); zn[g] = *(const v4u*)(Z + (size_t)(t + c.NGW) * 2048 + g * 512 + 8 * c.lane); }
        }
#pragma unroll
        for (int g = 0; g < 4; ++g) {
            const int c0 = g * 512 + 8 * c.lane;
            const float yf[8] = {bflo(yq[g].x), bfhi(yq[g].x), bflo(yq[g].y), bfhi(yq[g].y), bflo(yq[g].z), bfhi(yq[g].z), bflo(yq[g].w), bfhi(yq[g].w)};
            const float zf[8] = {bflo(zq[g].x), bfhi(zq[g].x), bflo(zq[g].y), bfhi(zq[g].y), bflo(zq[g].z), bfhi(zq[g].z), bflo(zq[g].w), bfhi(zq[g].w)};
            float v[8]; float q = 0.f;
#pragma unroll
            for (int j = 0; j < 8; ++j) { v[j] = yf[j] * silu_f(zf[j]); q += v[j] * v[j]; }
            const float r = rsqrtf(wave_sum(q, c.lane) * (1.f / 512.f) + RMS_EPS);
            const f32x4 g0 = *(const f32x4*)(c.in[c.z + 36] + c0), g1 = *(const f32x4*)(c.in[c.z + 36] + c0 + 4);
            v4u o; o.x = pk2(v[0] * r * g0[0], v[1] * r * g0[1]); o.y = pk2(v[2] * r * g0[2], v[3] * r * g0[3]); o.z = pk2(v[4] * r * g1[0], v[5] * r * g1[1]); o.w = pk2(v[6] * r * g1[2], v[7] * r * g1[3]);
            *(v4u*)(YN + (size_t)t * 2048 + c0) = o;
        }
    }
}

__device__ __forceinline__ unsigned ord_key(float s) { const unsigned u = __builtin_bit_cast(unsigned, s); return (u & 0x80000000u) ? ~u : (u | 0x80000000u); }
__device__ __forceinline__ float ord_dec(unsigned k) { const unsigned u = (k & 0x80000000u) ? (k & 0x7fffffffu) : ~k; return __builtin_bit_cast(float, u); }
__device__ __forceinline__ void ins16(unsigned (&Lk)[16], unsigned x) {
#pragma unroll
    for (int k = 0; k < 16; ++k) { const unsigned hi = max(Lk[k], x); x = min(Lk[k], x); Lk[k] = hi; }
}
__device__ __forceinline__ void ce_desc(unsigned& a, unsigned& b) { const unsigned hi = max(a, b), lo = min(a, b); a = hi; b = lo; }
__device__ __forceinline__ void ce_asc(unsigned& a, unsigned& b) { const unsigned hi = max(a, b), lo = min(a, b); a = lo; b = hi; }
__device__ __forceinline__ void sort16_desc(unsigned (&a)[16]) {
#pragma unroll
    for (int k = 2; k <= 16; k <<= 1)
#pragma unroll
        for (int j = k >> 1; j > 0; j >>= 1)
#pragma unroll
            for (int i = 0; i < 16; ++i) { const int l = i ^ j; if (l > i) { if ((i & k) == 0) ce_desc(a[i], a[l]); else ce_asc(a[i], a[l]); } }
}
__device__ __forceinline__ void bmerge16_desc(unsigned (&a)[16]) {
#pragma unroll
    for (int j = 8; j > 0; j >>= 1)
#pragma unroll
        for (int i = 0; i < 16; ++i) { const int l = i ^ j; if (l > i) ce_desc(a[i], a[l]); }
}
__device__ __forceinline__ void xmerge16(unsigned (&a)[16], int o, int lane) {
    unsigned pq[16];
#pragma unroll
    for (int k = 0; k < 16; ++k) pq[k] = (unsigned)__builtin_amdgcn_ds_bpermute((lane ^ o) << 2, (int)a[k]);
#pragma unroll
    for (int k = 0; k < 16; ++k) a[k] = max(a[k], pq[15 - k]);
    bmerge16_desc(a);
}
struct CandTab { unsigned char v[52]; };
constexpr CandTab make_cands() { CandTab t{}; int n = 0; for (int i = 0; i < 16; ++i) for (int j = 0; j < 16; ++j) if ((i + 1) * (j + 1) <= 16) t.v[n++] = (unsigned char)(i * 16 + j); return t; }
__device__ __forceinline__ void phase_route(const Ctx& c, int layer, bool docvt) {
    constexpr CandTab CT = make_cands();
    const bf16* Q = c.W<bf16>(WS_Q); const bf16* KEYS = c.W<bf16>(WS_KEYS) + (size_t)layer * 8 * 2 * 128 * 128;
    int* IDX = c.W<int>(WS_IDX); float* GATE = c.W<float>(WS_GATE);
    const int lane = c.lane, fr = lane & 15, fq = lane >> 4;
    constexpr int RK_LD = 136, RK_BYTES = 2 * 128 * RK_LD * 2;
    LAS unsigned* lists = (LAS unsigned*)(c.lds + RK_BYTES + c.wave * 2048);
    const int h = c.bid & 7;
    {
        const bf16* kg = KEYS + (size_t)h * 2 * 128 * 128;
        for (int q = c.tid; q < 2 * 128 * 16; q += NTHR) { const int row = q >> 4, cc = q & 15; *(LAS v4u*)(c.lds + (row * RK_LD + cc * 8) * 2) = *(const v4u*)(kg + (size_t)row * 128 + cc * 8); }
    }
    __syncthreads();
    const bool cvt_first = ((c.wave >> 2) & 1) == 0;
    if (docvt && cvt_first) cvt_tables(c, layer);
    const int nb8 = c.nblk >> 3;
    for (int tg = (c.bid >> 3) + nb8 * c.wave; tg < 1088; tg += nb8 * NWAVES) {
        const int tok0 = tg * 16;
        const bf16* qrow = Q + (size_t)(tok0 + fr) * 2048 + h * 256 + 8 * fq;
#pragma unroll
        for (int side = 0; side < 2; ++side) {
            bf16x8 qf[4];
#pragma unroll
            for (int ks = 0; ks < 4; ++ks) qf[ks] = *(const bf16x8*)(qrow + side * 128 + ks * 32);
            const LAS unsigned char* kb = c.lds + ((side * 128 + fr) * RK_LD + 8 * fq) * 2;
            unsigned A[16], B[16];
#pragma unroll
            for (int nt = 0; nt < 8; ++nt) {
                f32x4 acc = {0.f, 0.f, 0.f, 0.f};
#pragma unroll
                for (int ks = 0; ks < 4; ++ks) acc = __builtin_amdgcn_mfma_f32_16x16x32_bf16(*(const LAS bf16x8*)(kb + (nt * 16 * RK_LD + ks * 32) * 2), qf[ks], acc, 0, 0, 0);
#pragma unroll
                for (int r = 0; r < 4; ++r) {
                    const unsigned key = (ord_key(acc[r]) & ~127u) | (unsigned)(127 - (16 * nt + 4 * fq + r));
                    if (nt < 4) A[nt * 4 + r] = key; else B[(nt - 4) * 4 + r] = key;
                }
            }
            sort16_desc(A); sort16_desc(B);
#pragma unroll
            for (int k = 0; k < 16; ++k) A[k] = max(A[k], B[15 - k]);
            bmerge16_desc(A);
            xmerge16(A, 16, lane); xmerge16(A, 32, lane);
            if (fq == 0) {
#pragma unroll
                for (int k = 0; k < 4; ++k) *(LAS v4u*)(lists + (fr * 2 + side) * 16 + 4 * k) = (v4u){A[4 * k], A[4 * k + 1], A[4 * k + 2], A[4 * k + 3]};
            }
        }
        asm volatile("s_waitcnt lgkmcnt(0)" ::: "memory");
        int fq2 = fq, fr2 = fr; asm volatile("" : "+v"(fq2), "+v"(fr2));
        unsigned Cd[16];
#pragma unroll
        for (int k = 0; k < 13; ++k) {
            const int ij = (fq2 == 0) ? CT.v[k] : (fq2 == 1) ? CT.v[13 + k] : (fq2 == 2) ? CT.v[26 + k] : ((39 + k < 50) ? CT.v[(39 + k < 50) ? 39 + k : 0] : 0);
            const bool ok = (fq2 < 3) || (39 + k < 50);
            const unsigned k0 = lists[(fr2 * 2) * 16 + (ij >> 4)], k1 = lists[(fr2 * 2 + 1) * 16 + (ij & 15)];
            const unsigned x = (ord_key(ord_dec(k0 & ~127u) + ord_dec(k1 & ~127u)) & ~255u) | (unsigned)(255 - ij);
            Cd[k] = ok ? x : 0u;
        }
        Cd[13] = 0u; Cd[14] = 0u; Cd[15] = 0u;
        sort16_desc(Cd);
        xmerge16(Cd, 16, lane); xmerge16(Cd, 32, lane);
        float e[16], su[16]; int id[16]; float mx = 0.f, den = 0.f;
#pragma unroll
        for (int k = 0; k < 16; ++k) {
            const int pay = 255 - (int)(Cd[k] & 255u), i = pay >> 4, j = pay & 15;
            const unsigned k0 = lists[(fr2 * 2) * 16 + i], k1 = lists[(fr2 * 2 + 1) * 16 + j];
            id[k] = (127 - (int)(k0 & 127u)) * 128 + (127 - (int)(k1 & 127u));
            const float sv = ord_dec(k0 & ~127u) + ord_dec(k1 & ~127u);
            if (k == 0) mx = sv;
            e[k] = __expf(sv - mx); den += e[k];
        }
        const float inv = 1.f / den;
        int oi[4]; float og[4];
#pragma unroll
        for (int r = 0; r < 4; ++r) {
            oi[r] = (fq2 == 0) ? id[r] : (fq2 == 1) ? id[4 + r] : (fq2 == 2) ? id[8 + r] : id[12 + r];
            og[r] = (fq2 == 0) ? e[r] : (fq2 == 1) ? e[4 + r] : (fq2 == 2) ? e[8 + r] : e[12 + r];
        }
#pragma unroll
        for (int r = 0; r < 4; ++r) og[r] *= inv;
        const size_t ob = (size_t)(tok0 + fr2) * 128 + h * 16 + 4 * fq2;
        *(int4*)(IDX + ob) = make_int4(oi[0], oi[1], oi[2], oi[3]);
        *(f32x4*)(GATE + ob) = (f32x4){og[0], og[1], og[2], og[3]};
        asm volatile("" ::: "memory");
        (void)su;
    }
    if (docvt && !cvt_first) cvt_tables(c, layer);
}

__device__ __forceinline__ unsigned shxu(unsigned v, int o, int lane) { return __builtin_bit_cast(unsigned, shx(__builtin_bit_cast(float, v), o, lane)); }
constexpr int GS_TOK = 128 * 12, GS_WAVE = 9 * GS_TOK;
__device__ __forceinline__ void sort_tokens_to_lds(const Ctx& c, LAS unsigned char* sl, int nslots, int nfull, int tok_extra) {
    const int* IDX = c.W<int>(WS_IDX); const float* GATE = c.W<float>(WS_GATE);
    const float* ISU = c.W<float>(WS_SMALL) + SM_ISU; const float* ISV = c.W<float>(WS_SMALL) + SM_ISV;
    const int lane = c.lane;
    for (int j = 0; j < nslots; ++j) {
        const size_t base = (size_t)((j < nfull) ? (c.gw + j * c.NGW) : tok_extra) * 128;
        unsigned k0 = ((unsigned)IDX[base + lane] << 7) | (unsigned)lane, k1 = ((unsigned)IDX[base + 64 + lane] << 7) | (unsigned)(64 + lane);
#pragma unroll
        for (int k = 2; k <= 128; k <<= 1) {
#pragma unroll
            for (int jd = k >> 1; jd > 0; jd >>= 1) {
                if (jd == 64) { const unsigned lo = min(k0, k1), hi = max(k0, k1); k0 = lo; k1 = hi; }
                else {
                    const unsigned p0 = shxu(k0, jd, lane), p1 = shxu(k1, jd, lane);
                    const bool lower = (lane & jd) == 0;
                    const bool asc0 = (k == 128) ? true : (k == 64) ? true : ((lane & k) == 0);
                    const bool asc1 = (k == 128) ? true : (k == 64) ? false : ((lane & k) == 0);
                    k0 = (lower == asc0) ? min(k0, p0) : max(k0, p0);
                    k1 = (lower == asc1) ? min(k1, p1) : max(k1, p1);
                }
            }
        }
        const int s0 = (int)(k0 & 127u), s1 = (int)(k1 & 127u);
        LAS int* li = (LAS int*)(sl + j * GS_TOK); LAS float* lg = (LAS float*)(sl + j * GS_TOK + 512); LAS float* lu = (LAS float*)(sl + j * GS_TOK + 1024);
        li[lane] = (int)(k0 >> 7); li[64 + lane] = (int)(k1 >> 7);
        const int e0 = (int)(k0 >> 7), e1 = (int)(k1 >> 7);
        lg[lane] = GATE[base + s0] * ISV[e0]; lg[64 + lane] = GATE[base + s1] * ISV[e1]; lu[lane] = ISU[e0]; lu[64 + lane] = ISU[e1];
    }
    asm volatile("s_waitcnt vmcnt(0) lgkmcnt(0)" ::: "memory");
}

typedef float f32x2 __attribute__((ext_vector_type(2)));
typedef _Float16 h2 __attribute__((ext_vector_type(2)));
typedef _Float16 v32h __attribute__((ext_vector_type(32)));
__device__ __forceinline__ v3u gt_row(const unsigned char* tab, int idx, unsigned lane12) {
    const unsigned char* rowp = tab + (size_t)((unsigned)idx * (unsigned)EROW);
    asm volatile("" : "+s"(rowp));
    return *(const __attribute__((address_space(1))) v3u*)((const __attribute__((address_space(1))) unsigned char*)rowp + lane12);
}
__device__ __forceinline__ void fp4_row(const v2u r, h2 (&y)[8]) {
    y[0] = __builtin_amdgcn_cvt_scalef32_pk_f16_fp4(r[0], 1.0f, 0); y[1] = __builtin_amdgcn_cvt_scalef32_pk_f16_fp4(r[0], 1.0f, 1);
    y[2] = __builtin_amdgcn_cvt_scalef32_pk_f16_fp4(r[0], 1.0f, 2); y[3] = __builtin_amdgcn_cvt_scalef32_pk_f16_fp4(r[0], 1.0f, 3);
    y[4] = __builtin_amdgcn_cvt_scalef32_pk_f16_fp4(r[1], 1.0f, 0); y[5] = __builtin_amdgcn_cvt_scalef32_pk_f16_fp4(r[1], 1.0f, 1);
    y[6] = __builtin_amdgcn_cvt_scalef32_pk_f16_fp4(r[1], 1.0f, 2); y[7] = __builtin_amdgcn_cvt_scalef32_pk_f16_fp4(r[1], 1.0f, 3);
}
__device__ __forceinline__ v2u gt_rowv(const unsigned char* tab, int idx, unsigned lane8) {
    const unsigned char* rowp = tab + (size_t)((unsigned)idx * (unsigned)VROW);
    asm volatile("" : "+s"(rowp));
    return *(const __attribute__((address_space(1))) v2u*)((const __attribute__((address_space(1))) unsigned char*)rowp + lane8);
}
__device__ __forceinline__ void phase_gather(const Ctx& c, int layer, bool dummy) {
    const unsigned char* EU = c.ws + WS_EU; const unsigned char* EV = c.ws + WS_EV;
    const float* H = c.W<float>(WS_H32); float* Ho = dummy ? c.W<float>(WS_R32) : c.W<float>(WS_H32); bf16* HB = dummy ? c.W<bf16>(WS_A0) : c.W<bf16>(WS_HB);
    const float* g = c.in[c.z + 40] + layer * D; const float* b = c.in[c.z + 41] + layer * D;
    const int lane = c.lane;
    const int nfull = T / c.NGW, rem = T - nfull * c.NGW;
    const bool pairmode = (2 * rem == c.NGW);
    const int half = pairmode ? (c.gw & 1) : 0;
    const int xsteps = pairmode ? 4 : ((c.gw < rem) ? 8 : 0);
    const int tok_extra = nfull * c.NGW + (pairmode ? (c.gw >> 1) : c.gw);
    const int nmain = nfull * 8, nit = nmain + xsteps;
    LAS unsigned char* sl = c.lds + c.wave * GS_WAVE;
    LAS float* xchg = (LAS float*)(c.lds + 8 * GS_WAVE + (c.wave >> 1) * 4096);
    volatile LAS int* flag = (volatile LAS int*)(c.lds + 8 * GS_WAVE + 4 * 4096) + (c.wave >> 1);
    if (c.tid < 4) ((volatile LAS int*)(c.lds + 8 * GS_WAVE + 4 * 4096))[c.tid] = 0;
    LAS float* lgb = (LAS float*)(c.lds + 8 * GS_WAVE + 4 * 4096 + 64);
    { const f32x4 q = (c.tid < 256) ? *(const f32x4*)(g + 4 * c.tid) : *(const f32x4*)(b + 4 * (c.tid - 256)); *(LAS f32x4*)(lgb + 4 * c.tid) = q; }
    __syncthreads();
    sort_tokens_to_lds(c, sl, nfull + (xsteps ? 1 : 0), nfull, tok_extra);
#define GT_SLOT(it) (((it) < nmain) ? ((it) >> 3) : nfull)
#define GT_BT(it) (((it) < nmain) ? ((it) & 7) : ((it) - nmain + 4 * half))
#define GT_TOK(it) (((it) < nmain) ? (c.gw + ((it) >> 3) * c.NGW) : tok_extra)
#define GT_IDX(it) (((it) < nit) ? ((const LAS int*)(sl + GT_SLOT(it) * GS_TOK))[GT_BT(it) * 16 + (lane & 15)] : 0)
#define GT_GS(P, it) (((const LAS float*)(sl + GT_SLOT((it) < nit ? (it) : 0) * GS_TOK + (P)))[GT_BT((it) < nit ? (it) : 0) * 16 + (lane & 15)])
#define GT_ROW(TAB, idxreg, e) gt_row((TAB), __builtin_amdgcn_readlane((idxreg), (e)), lane12)
#define GT_ROWV(idxreg, e) gt_rowv(EV, __builtin_amdgcn_readlane((idxreg), (e)), lane8)
#define GT_ROWU(idxreg, e) gt_rowv(EU, __builtin_amdgcn_readlane((idxreg), (e)), lane8)
    const unsigned lane12 = 12u * (unsigned)lane, lane8 = 8u * (unsigned)lane;
    int idx_c = GT_IDX(0), idx_n = GT_IDX(1);
    float gate_c = GT_GS(512, 0), scu_c = GT_GS(1024, 0);
    float xs[16], acc[16], xn[16];
    h2 xh[8];
    v2u ru[16], rv[16];
    if (nit > 0) {
        const int t0 = GT_TOK(0);
#pragma unroll
        for (int k = 0; k < 4; ++k) { const f32x4 hx = *(const f32x4*)(H + (size_t)t0 * D + 16 * lane + 4 * k); xn[4 * k] = hx[0]; xn[4 * k + 1] = hx[1]; xn[4 * k + 2] = hx[2]; xn[4 * k + 3] = hx[3]; }
    }
#pragma unroll
    for (int e = 0; e < 16; ++e) { ru[e] = GT_ROWU(idx_c, e); rv[e] = GT_ROWV(idx_c, e); }
#pragma unroll
    for (int e = 0; e < 16; ++e) { asm volatile("" : "+v"(ru[e]), "+v"(rv[e])); }
#pragma unroll
    for (int i = 0; i < 16; ++i) { asm volatile("" : "+v"(xn[i])); }
    for (int it = 0; it < nit; ++it) {
        const int t = GT_TOK(it);
        const bool first = (it & 7) == 0, last = (it < nmain) ? ((it & 7) == 7) : (it == nit - 1);
        const int idx_nn = GT_IDX(it + 2);
        const float gate_n = GT_GS(512, it + 1), scu_n = GT_GS(1024, it + 1);
        const float mygate = gate_c, myscu = scu_c;
        if (first) {
            asm volatile("" ::: "memory");
#pragma unroll
            for (int i = 0; i < 16; ++i) { xs[i] = xn[i]; acc[i] = 0.f; }
#pragma unroll
            for (int j = 0; j < 8; ++j) xh[j] = (h2){(_Float16)xn[2 * j], (_Float16)xn[2 * j + 1]};
        }
        if (last && it + 1 < nit) {
            const int t1 = GT_TOK(it + 1);
#pragma unroll
            for (int k = 0; k < 4; ++k) { const f32x4 hx = *(const f32x4*)(H + (size_t)t1 * D + 16 * lane + 4 * k); xn[4 * k] = hx[0]; xn[4 * k + 1] = hx[1]; xn[4 * k + 2] = hx[2]; xn[4 * k + 3] = hx[3]; }
        }
        float pv[16];
#pragma unroll
        for (int e = 0; e < 16; e += 2) {
            h2 ya[8], yb[8];
            fp4_row(ru[e], ya); fp4_row(ru[e + 1], yb);
            float d0 = 0.f, d1 = 0.f, d2 = 0.f, d3 = 0.f;
#pragma unroll
            for (int j = 0; j < 8; j += 2) {
                d0 = __builtin_amdgcn_fdot2(ya[j], xh[j], d0, false);
                d1 = __builtin_amdgcn_fdot2(yb[j], xh[j], d1, false);
                d2 = __builtin_amdgcn_fdot2(ya[j + 1], xh[j + 1], d2, false);
                d3 = __builtin_amdgcn_fdot2(yb[j + 1], xh[j + 1], d3, false);
            }
            pv[e] = d0 + d2; pv[e + 1] = d1 + d3;
            ru[e] = GT_ROWU(idx_n, e); ru[e + 1] = GT_ROWU(idx_n, e + 1);
        }
        const float tot = reduce16d(pv, lane);
        const float wgt = mygate * gelu_f(tot * myscu);
        const _Float16 wh = (_Float16)wgt;
        const int wpk = __builtin_bit_cast(int, (h2){wh, wh});
        h2 p[8];
#pragma unroll
        for (int e = 0; e < 16; e += 2) {
            const h2 w0 = __builtin_bit_cast(h2, __builtin_amdgcn_readlane(wpk, e));
            const h2 w1 = __builtin_bit_cast(h2, __builtin_amdgcn_readlane(wpk, e + 1));
            h2 ya[8], yb[8];
            fp4_row(rv[e], ya); fp4_row(rv[e + 1], yb);
#pragma unroll
            for (int j = 0; j < 8; ++j) p[j] = (e == 0) ? ya[j] * w0 : ya[j] * w0 + p[j];
#pragma unroll
            for (int j = 0; j < 8; ++j) p[j] = yb[j] * w1 + p[j];
            rv[e] = GT_ROWV(idx_n, e); rv[e + 1] = GT_ROWV(idx_n, e + 1);
        }
#pragma unroll
        for (int j = 0; j < 8; ++j) { acc[2 * j] += (float)p[j][0]; acc[2 * j + 1] += (float)p[j][1]; }
        if (last && it >= nmain && pairmode && half == 1) {
            int l3 = lane; asm volatile("" : "+v"(l3));
#pragma unroll
            for (int k = 0; k < 4; ++k) *(LAS f32x4*)(xchg + l3 * 16 + 4 * k) = (f32x4){acc[4 * k], acc[4 * k + 1], acc[4 * k + 2], acc[4 * k + 3]};
            asm volatile("s_waitcnt lgkmcnt(0)" ::: "memory");
            if (l3 == 0) *flag = 1;
        } else if (last) {
            int l2 = lane; asm volatile("" : "+v"(l2));
            if (it >= nmain && pairmode) {
                while (*flag == 0) __builtin_amdgcn_s_sleep(2);
                asm volatile("" ::: "memory");
#pragma unroll
                for (int k = 0; k < 4; ++k) { const f32x4 pa = *(const LAS f32x4*)(xchg + l2 * 16 + 4 * k); acc[4 * k] += pa[0]; acc[4 * k + 1] += pa[1]; acc[4 * k + 2] += pa[2]; acc[4 * k + 3] += pa[3]; }
            }
            f32x4 v[4];
#pragma unroll
            for (int k = 0; k < 4; ++k) v[k] = (f32x4){xs[4 * k], xs[4 * k + 1], xs[4 * k + 2], xs[4 * k + 3]} * ALPHA + (f32x4){acc[4 * k], acc[4 * k + 1], acc[4 * k + 2], acc[4 * k + 3]};
            float mean, rstd; ln_stats(v, mean, rstd, l2);
            float* o32 = ((layer == 3 && !dummy) ? c.out : Ho) + (size_t)t * D + 16 * l2;
            bf16* ob = (layer == 3 && !dummy) ? (bf16*)nullptr : HB + (size_t)t * D + 16 * l2;
            v4u wb[2];
#pragma unroll
            for (int k = 0; k < 4; ++k) {
                const f32x4 g4 = *(const LAS f32x4*)(lgb + 16 * l2 + 4 * k), b4 = *(const LAS f32x4*)(lgb + 1024 + 16 * l2 + 4 * k);
                const f32x4 o = (v[k] - mean) * rstd * g4 + b4;
                *(f32x4*)(o32 + 4 * k) = o;
                if (k & 1) { wb[k >> 1].z = pk2(o[0], o[1]); wb[k >> 1].w = pk2(o[2], o[3]); } else { wb[k >> 1].x = pk2(o[0], o[1]); wb[k >> 1].y = pk2(o[2], o[3]); }
            }
            if (ob) { *(v4u*)(ob) = wb[0]; *(v4u*)(ob + 8) = wb[1]; }
        }
        idx_c = idx_n; idx_n = idx_nn; gate_c = gate_n; scu_c = scu_n;
    }
#undef GT_ROW
#undef GT_ROWV
#undef GT_ROWU
#undef GT_GS
#undef GT_IDX
#undef GT_TOK
#undef GT_SLOT
#undef GT_BT
}

#define XB_TMO      128
#define XB_XCNT(j)  (256  + 64 * (j))
#define XB_XSUB(j)  (1280 + 64 * (j))
#define XB_XGEN(j)  (2304 + 64 * (j))
#define XB_TOP      3328
#define XB_TOPGEN   3392
#define XCD_BAR_WORDS 3456
#define XB_SPIN_CAP (1u << 22)
__device__ __forceinline__ unsigned xb_ld(unsigned* p)              { return __hip_atomic_load(p, __ATOMIC_RELAXED, __HIP_MEMORY_SCOPE_AGENT); }
__device__ __forceinline__ unsigned xb_add(unsigned* p, unsigned v) { return __hip_atomic_fetch_add(p, v, __ATOMIC_RELAXED, __HIP_MEMORY_SCOPE_AGENT); }
__device__ __forceinline__ unsigned xb_xcc_id() { return (unsigned)__builtin_amdgcn_s_getreg((3 << 11) | 20) & 0xFu; }
#define XB_SPIN(cond, bar) do { unsigned _sp = 0; while (cond) { __builtin_amdgcn_s_sleep(1); \
    if ((++_sp & 255u) == 0u) { if (xb_ld(&(bar)[XB_TMO])) break; if (_sp > XB_SPIN_CAP) { atomicAdd(&(bar)[XB_TMO], 1u); break; } } } } while (0)
struct XcdBarrier { unsigned* bar; unsigned x; volatile LAS unsigned* st; };
__device__ __forceinline__ XcdBarrier xcd_barrier_post(unsigned* bar, volatile LAS unsigned* st) {
    XcdBarrier b; b.bar = bar; b.x = xb_xcc_id(); b.st = st;
    if (threadIdx.x == 0) (void)xb_add(&bar[XB_XCNT(b.x)], 1u);
    return b;
}
__device__ __forceinline__ void xcd_barrier_complete(unsigned* bar, unsigned x, unsigned& nloc, unsigned& nx) {
    const unsigned G = gridDim.x * gridDim.y * gridDim.z;
    unsigned sum, cnt, mine, sp = 0u;
    for (;;) {
        sum = 0u; cnt = 0u; mine = 0u;
#pragma unroll
        for (unsigned j = 0; j < 16; ++j) { const unsigned cc = xb_ld(&bar[XB_XCNT(j)]); sum += cc; cnt += (cc > 0u) ? 1u : 0u; mine = (j == x) ? cc : mine; }
        if (sum == G) break;
        __builtin_amdgcn_s_sleep(1);
        if ((++sp & 255u) == 0u) { if (xb_ld(&bar[XB_TMO])) break; if (sp > XB_SPIN_CAP) { atomicAdd(&bar[XB_TMO], 1u); break; } }
    }
    nloc = mine > 0u ? mine : 1u; nx = cnt > 0u ? cnt : 1u;
}
__device__ __forceinline__ void xcd_barrier(const XcdBarrier& b, int tid) {
    asm volatile("s_waitcnt vmcnt(0)" ::: "memory");
    __syncthreads();
    if (tid == 0) {
        unsigned* bar = b.bar;
        __builtin_amdgcn_s_waitcnt(0);
        unsigned nloc = b.st[0], nx = b.st[1];
        if (nloc == 0u) { xcd_barrier_complete(bar, b.x, nloc, nx); b.st[0] = nloc; b.st[1] = nx; }
        const unsigned old = xb_add(&bar[XB_XSUB(b.x)], 1u);
        const unsigned gen = old / nloc;
        if (old + 1u == (gen + 1u) * nloc) {
            __builtin_amdgcn_fence(__ATOMIC_RELEASE, "agent");
            asm volatile("s_waitcnt vmcnt(0)" ::: "memory");
            const unsigned og = xb_add(&bar[XB_TOP], 1u);
            const unsigned tg = og / nx;
            if (og + 1u == (tg + 1u) * nx) xb_add(&bar[XB_TOPGEN], 1u);
            else XB_SPIN(xb_ld(&bar[XB_TOPGEN]) == tg, bar);
            __builtin_amdgcn_fence(__ATOMIC_ACQUIRE, "agent");
            xb_add(&bar[XB_XGEN(b.x)], 1u);
            asm volatile("s_waitcnt vmcnt(0)" ::: "memory");
        } else {
            XB_SPIN(xb_ld(&bar[XB_XGEN(b.x)]) == gen, bar);
            __builtin_amdgcn_fence(__ATOMIC_ACQUIRE, "agent");
            asm volatile("s_waitcnt vmcnt(0)" ::: "memory");
        }
    }
    __syncthreads();
}

__global__ void __launch_bounds__(NTHR, 2) mega(Params P) {
    extern __shared__ __attribute__((aligned(16))) unsigned char lds_raw[];
    Ctx c;
    c.in = P.in; c.out = P.out; c.ws = P.ws; c.lds = (LAS unsigned char*)lds_raw; c.z = 0;
    c.tid = threadIdx.x; c.lane = c.tid & 63; c.wave = __builtin_amdgcn_readfirstlane(c.tid >> 6);
    c.gw = (int)blockIdx.x * NWAVES + c.wave; c.NGW = (int)gridDim.x * NWAVES; c.gt = (int)blockIdx.x * NTHR + c.tid; c.NGT = (int)gridDim.x * NTHR; c.bid = (int)blockIdx.x; c.nblk = (int)gridDim.x;
#define RF() do { int zs_ = 0; asm volatile("" : "+s"(zs_)); c.z = zs_; c.lds = (LAS unsigned char*)lds_raw + zs_; int z_ = 0; asm volatile("" : "+v"(z_)); const int l_ = (int)__builtin_amdgcn_mbcnt_hi(~0u, __builtin_amdgcn_mbcnt_lo(~0u, (unsigned)z_)); c.lane = l_; c.tid = c.wave * 64 + l_; c.bid = (int)blockIdx.x + zs_; c.nblk = (int)gridDim.x + zs_; c.gw = c.bid * NWAVES + c.wave; c.NGW = c.nblk * NWAVES; c.gt = c.bid * NTHR + c.tid; c.NGT = c.nblk * NTHR; } while (0)
    bf16* HB = c.W<bf16>(WS_HB); bf16* A0 = c.W<bf16>(WS_A0); bf16* A1 = c.W<bf16>(WS_A1); bf16* A2 = c.W<bf16>(WS_A2); bf16* Qb = c.W<bf16>(WS_Q);
    float* H32 = c.W<float>(WS_H32); float* R32 = c.W<float>(WS_R32);

    if (threadIdx.x < 16) ((volatile LAS unsigned*)(c.lds + MISC_OFF))[threadIdx.x] = 0u;
    __syncthreads();
    const XcdBarrier xbar = xcd_barrier_post(c.W<unsigned>(WS_CTL), (volatile LAS unsigned*)(c.lds + MISC_OFF));
#define GSYNC() do { RF(); xcd_barrier(xbar, c.tid); } while (0)
    RF(); prologue(c);
    GSYNC();
    for (int layer = 0; layer < 4; ++layer) {
        if (layer <= 1) {
            const bf16* Wt = c.W<bf16>(layer == 0 ? WS_W_S5IN : WS_W_PIN);
            RF(); run_gemm(c, HB, D, 0, Wt, 1024, 1024, EpiBf16<0>{A0, D, nullptr, nullptr, nullptr});
        } else if (layer == 2) {
            RF(); run_gemm(c, HB, D, 0, c.W<bf16>(WS_W_CIN), 2048, 1024, EpiBf16<1>{Qb, 2048, c.in[c.z + 24], nullptr, nullptr});
        } else {
            RF(); run_gemm_all(c, HB, D, 0, c.W<bf16>(WS_W_SIN), NPROJ, 1024, EpiSsdProj{Qb, c.W<bf16>(WS_XBC), c.W<float>(WS_DT)});
        }
        GSYNC();
        const bf16* Aout = A2; const bf16* Wout;
        if (layer == 0) {
            for (int r = 0; r < PR_S5; ++r) { RF(); phase_s5scan(c); }
            GSYNC();
            RF(); run_gemm(c, A1, D, 0, c.W<bf16>(WS_W_S5GLU), 1024, 1024, EpiBf16<3>{A2, D, c.in[c.z + 17], nullptr, A1});
            Wout = c.W<bf16>(WS_W_S5OUT);
        } else if (layer == 1) {
            RF(); phase_pool(c);
            GSYNC();
            RF(); run_gemm(c, A1, D, 256, c.W<bf16>(WS_W_PGRP), 1024, 256, EpiBf16<2>{A2, D, nullptr, c.in[c.z + 21], nullptr});
            Wout = c.W<bf16>(WS_W_POUT);
        } else if (layer == 2) {
            RF(); phase_cmlp_ln(c);
            GSYNC();
            RF(); phase_cmlp_mix(c);
            Aout = A1; Wout = c.W<bf16>(WS_W_COUT);
        } else {
            RF(); phase_ssd_conv(c);
            GSYNC();
            for (int r = 0; r < PR_SSD; ++r) { RF(); phase_ssd_scan(c); }
            GSYNC();
            RF(); phase_ssd_gatenorm(c);
            Aout = c.W<bf16>(WS_YN); Wout = c.W<bf16>(WS_W_SOUT);
        }
        GSYNC();
        if (layer == 3) { RF(); run_gemm(c, Aout, 2048, 0, Wout, 1024, 2048, EpiBf16<0>{A0, D, nullptr, nullptr, nullptr}); }
        else { RF(); run_gemm(c, Aout, 1024, 0, Wout, 1024, 1024, EpiBf16<0>{A0, D, nullptr, nullptr, nullptr}); }
        GSYNC();
        RF(); phase_ln1(c, layer);
        GSYNC();
        RF(); run_gemm(c, HB, D, 0, c.W<bf16>(WS_W_PQ) + (size_t)layer * 2048 * 1024, 2048, 1024, EpiBf16<0>{Qb, 2048, nullptr, nullptr, nullptr});
        GSYNC();
        for (int r = 0; r < PR_ROUTE; ++r) { RF(); phase_route(c, layer, layer > 0 && r == 0); }
        GSYNC();
        for (int r = 1; r < PR_GATHER; ++r) { RF(); phase_gather(c, layer, true); }
        RF(); phase_gather(c, layer, false);
        GSYNC();
    }
}
}

extern "C" void kernel_launch(void* const* d_in, const int* in_sizes, int n_in, void* d_out, int out_size, void* d_ws, size_t ws_size, hipStream_t stream) {
    static int grid = 0;
    if (grid == 0) {
        int dev = 0, cus = 0, per_cu = 0;
        if (hipGetDevice(&dev) != hipSuccess || hipDeviceGetAttribute(&cus, hipDeviceAttributeMultiprocessorCount, dev) != hipSuccess) { fprintf(stderr, "kernel_launch: device query failed\n"); grid = -1; return; }
        if (hipFuncSetAttribute((const void*)mk::mega, hipFuncAttributeMaxDynamicSharedMemorySize, mk::LDS_BYTES) != hipSuccess) { fprintf(stderr, "kernel_launch: hipFuncSetAttribute failed\n"); grid = -1; return; }
        if (hipOccupancyMaxActiveBlocksPerMultiprocessor(&per_cu, (const void*)mk::mega, mk::NTHR, mk::LDS_BYTES) != hipSuccess || per_cu < 1) { fprintf(stderr, "kernel_launch: occupancy query says %d blocks per CU\n", per_cu); grid = -1; return; }
        grid = cus;
        if (ws_size < mk::WS_END) { fprintf(stderr, "kernel_launch: workspace too small (%zu < %zu)\n", ws_size, (size_t)mk::WS_END); grid = -1; return; }
    }
    if (grid < 0) return;
    mk::Params p{};
    for (int i = 0; i < 46; ++i) p.in[i] = (const float*)d_in[i];
    p.out = (float*)d_out; p.ws = (unsigned char*)d_ws;
    if (hipMemsetAsync((char*)d_ws + mk::WS_CTL, 0, mk::CTL_BYTES, stream) != hipSuccess) { fprintf(stderr, "kernel_launch: memset failed\n"); return; }
    void* args[] = {&p};
    hipError_t e = hipLaunchCooperativeKernel((const void*)mk::mega, dim3(grid), dim3(mk::NTHR), args, mk::LDS_BYTES, stream);
    if (e != hipSuccess) fprintf(stderr, "cooperative launch failed: %s (grid %d)\n", hipGetErrorString(e), grid);
}
```
